# Optimizing an MI355X kernel written in HIP

```python
import math
import jax, jax.numpy as jnp
from jax import lax
import numpy as np

D_MODEL = 1024
BATCH = 8
SEQ = 2048
DEPTH = 4

SSM_WIDTH = 512
SSM_GROUP = 16
SSM_GROUPS = SSM_WIDTH // SSM_GROUP
SSM_STATE = 64
DT_MIN = 1e-3
DT_MAX = 1e-1
HEAD_DIM = 128
HEADS_PER_GROUP = 4
DILATION_PATTERNS = ((128, 1), (512, 4), (2048, 16))
N_ATTN_GROUPS = len(DILATION_PATTERNS)
ATTN_HEADS = N_ATTN_GROUPS * HEADS_PER_GROUP
ATTN_QKV_WIDTH = ATTN_HEADS * HEAD_DIM
ATTN_WIDTH = HEADS_PER_GROUP * HEAD_DIM
IN_SPLITS = (SSM_WIDTH, SSM_WIDTH, ATTN_QKV_WIDTH, ATTN_QKV_WIDTH, ATTN_QKV_WIDTH,
             ATTN_WIDTH, D_MODEL, D_MODEL)
IN_COLS = sum(IN_SPLITS)
SPLIT_POINTS = tuple(int(s) for s in np.cumsum(IN_SPLITS)[:-1])
RMS_EPS = 1e-6

kernel_name = "hybrid_s5_dilated_attn_gated_block"


def rmsnorm(x, g):
    xf = x.astype(jnp.float32)
    inv = lax.rsqrt(jnp.mean(xf * xf, axis=-1, keepdims=True) + RMS_EPS)
    return (xf * inv * g.astype(jnp.float32)).astype(x.dtype)


def _ssm_combine(left, right):
    a_l, b_l = left
    a_r, b_r = right
    return a_r * a_l, a_r * b_l + b_r


def s5_branch(u, lam_re, lam_im, log_dt, b_re, b_im, c_re, c_im, d_skip, w_glu, b_glu):
    bsz, L, _ = u.shape
    uf = u.astype(jnp.float32)
    ug = uf.reshape(bsz, L, SSM_GROUPS, SSM_GROUP)
    lam = lax.complex(jnp.minimum(lam_re.astype(jnp.float32), -1e-4), lam_im.astype(jnp.float32))
    dt = jnp.exp(log_dt.astype(jnp.float32))[:, None]
    lam_bar = jnp.exp(lam * dt)
    b = lax.complex(b_re.astype(jnp.float32), b_im.astype(jnp.float32))
    b_bar = ((lam_bar - 1.0) / lam)[..., None] * b
    c = lax.complex(c_re.astype(jnp.float32), c_im.astype(jnp.float32))
    drive = jnp.einsum('gpc,blgc->blgp', b_bar, ug)
    decay = jnp.broadcast_to(lam_bar, drive.shape)
    _, states = lax.associative_scan(_ssm_combine, (decay, drive), axis=1)
    y = jnp.einsum('gcp,blgp->blgc', c, states).real.reshape(bsz, L, SSM_WIDTH)
    y = y + d_skip.astype(jnp.float32) * uf
    y = jax.nn.gelu(y)
    y = y * jax.nn.sigmoid(y @ w_glu.astype(jnp.float32) + b_glu.astype(jnp.float32))
    return y.astype(u.dtype)


def dilated_group_attention(q, k, v, window, dilation):
    bsz, L, hg, hd = q.shape
    span = window // dilation
    n = L // dilation
    nb = -(-n // span)
    pad = nb * span - n

    def to_sub(t):
        return t.reshape(bsz, n, dilation, hg, hd).transpose(0, 2, 3, 1, 4)

    qb = jnp.pad(to_sub(q), ((0, 0),) * 3 + ((0, pad), (0, 0))).reshape(bsz, dilation, hg, nb, span, hd)

    def kv_blocks(t):
        tp = jnp.pad(to_sub(t), ((0, 0),) * 3 + ((span, pad), (0, 0))).reshape(bsz, dilation, hg, nb + 1, span, hd)
        return jnp.concatenate([tp[:, :, :, :-1], tp[:, :, :, 1:]], axis=4)

    kb, vb = kv_blocks(k), kv_blocks(v)
    scores = jnp.einsum('brhnqd,brhnkd->brhnqk', qb, kb).astype(jnp.float32) * (hd ** -0.5)
    qi = jnp.arange(span)[:, None]
    ki = jnp.arange(2 * span)[None, :]
    blk = jnp.arange(nb)[:, None, None]
    dist = span + qi - ki
    valid = (dist >= 0) & (dist <= span) & (blk * span + ki - span >= 0)
    scores = jnp.where(valid, scores, -jnp.inf)
    lse = jax.nn.logsumexp(scores, axis=-1)
    p = jnp.exp(scores - lse[..., None])
    out = jnp.einsum('brhnqk,brhnkd->brhnqd', p.astype(v.dtype), vb)

    def from_sub(t):
        rest = t.shape[5:]
        t = t.reshape(bsz, dilation, hg, nb * span, *rest)[:, :, :, :n]
        t = jnp.moveaxis(t, 3, 1)
        return t.reshape(bsz, L, hg, *rest)

    return from_sub(out), from_sub(lse)


def dilated_attention_branch(q, k, v):
    bsz, L, _ = q.shape
    shp = (bsz, L, N_ATTN_GROUPS, HEADS_PER_GROUP, HEAD_DIM)
    q, k, v = q.reshape(shp), k.reshape(shp), v.reshape(shp)
    outs, lses = [], []
    for gi, (window, dilation) in enumerate(DILATION_PATTERNS):
        o, s = dilated_group_attention(q[:, :, gi], k[:, :, gi], v[:, :, gi], window, dilation)
        outs.append(o)
        lses.append(s)
    outs = jnp.stack(outs, axis=0)
    alpha = jax.nn.softmax(jnp.stack(lses, axis=0), axis=0)
    y = jnp.sum(alpha[..., None] * outs.astype(jnp.float32), axis=0)
    return y.reshape(bsz, L, ATTN_WIDTH).astype(q.dtype)


def setup_inputs(seed: int = 0) -> dict:
    key = jax.random.key(seed)
    ks = jax.random.split(key, 20)
    f32 = jnp.float32
    nrm = lambda k, shape, s: jax.random.normal(k, shape, f32) * s
    x = jax.random.normal(ks[0], (BATCH, SEQ, D_MODEL), f32)
    pre_norm_g = 1.0 + nrm(ks[1], (DEPTH, D_MODEL), 0.02)
    w_in = nrm(ks[2], (DEPTH, D_MODEL, IN_COLS), D_MODEL ** -0.5)
    lambda_re = -0.5 + nrm(ks[3], (DEPTH, SSM_GROUPS, SSM_STATE), 0.01)
    lambda_im = (math.pi * jnp.arange(SSM_STATE, dtype=f32))[None, None, :] + nrm(ks[4], (DEPTH, SSM_GROUPS, SSM_STATE), 0.01)
    log_dt = jax.random.uniform(ks[5], (DEPTH, SSM_GROUPS), f32, math.log(DT_MIN), math.log(DT_MAX))
    b_scale = (2.0 * SSM_GROUP) ** -0.5
    b_re = nrm(ks[6], (DEPTH, SSM_GROUPS, SSM_STATE, SSM_GROUP), b_scale)
    b_im = nrm(ks[7], (DEPTH, SSM_GROUPS, SSM_STATE, SSM_GROUP), b_scale)
    c_scale = (2.0 * SSM_STATE) ** -0.5
    c_re = nrm(ks[8], (DEPTH, SSM_GROUPS, SSM_GROUP, SSM_STATE), c_scale)
    c_im = nrm(ks[9], (DEPTH, SSM_GROUPS, SSM_GROUP, SSM_STATE), c_scale)
    d_skip = nrm(ks[10], (DEPTH, SSM_WIDTH), 1.0)
    w_glu = nrm(ks[11], (DEPTH, SSM_WIDTH, SSM_WIDTH), SSM_WIDTH ** -0.5)
    b_glu = nrm(ks[12], (DEPTH, SSM_WIDTH), 0.01)
    w_branch_s = nrm(ks[13], (DEPTH, SSM_WIDTH, D_MODEL), SSM_WIDTH ** -0.5)
    w_branch_a = nrm(ks[14], (DEPTH, ATTN_WIDTH, D_MODEL), ATTN_WIDTH ** -0.5)
    w_out = nrm(ks[15], (DEPTH, D_MODEL, D_MODEL), D_MODEL ** -0.5)
    post_norm_g = 1.0 + nrm(ks[16], (DEPTH, D_MODEL), 0.02)
    return {"x": x, "pre_norm_g": pre_norm_g, "w_in": w_in, "lambda_re": lambda_re,
            "lambda_im": lambda_im, "log_dt": log_dt, "b_re": b_re, "b_im": b_im,
            "c_re": c_re, "c_im": c_im, "d_skip": d_skip, "w_glu": w_glu, "b_glu": b_glu,
            "w_branch_s": w_branch_s, "w_branch_a": w_branch_a, "w_out": w_out,
            "post_norm_g": post_norm_g}


def reference(x, pre_norm_g, w_in, lambda_re, lambda_im, log_dt, b_re, b_im, c_re, c_im,
              d_skip, w_glu, b_glu, w_branch_s, w_branch_a, w_out, post_norm_g):
    for l in range(DEPTH):
        h = rmsnorm(x, pre_norm_g[l])
        proj = h @ w_in[l]
        u_s, z_s, q, k, v, z_a, g_s, g_a = jnp.split(proj, SPLIT_POINTS, axis=-1)
        y_s = s5_branch(u_s, lambda_re[l], lambda_im[l], log_dt[l], b_re[l], b_im[l],
                        c_re[l], c_im[l], d_skip[l], w_glu[l], b_glu[l]) * jax.nn.silu(z_s)
        y_a = dilated_attention_branch(q, k, v) * jax.nn.silu(z_a)
        merged = (jax.nn.sigmoid(g_s) * (y_s @ w_branch_s[l])
                  + jax.nn.sigmoid(g_a) * (y_a @ w_branch_a[l]))
        out = merged @ w_out[l]
        x = x + rmsnorm(out, post_norm_g[l]).astype(x.dtype)
    return x
```

```cpp
#include <hip/hip_runtime.h>
#include <cstdio>
#include <cstdint>

constexpr int D_MODEL = 1024, BATCH = 8, SEQ = 2048, DEPTH = 4, MTOK = BATCH * SEQ;
constexpr int SSM_W = 512, SSM_CH = 16, SSM_NG = 32, SSM_P = 64;
constexpr int HD = 128, HPG = 4, NGRP = 3, ATT_W = 512, IN_COLS = 8192;
constexpr int C_US = 0, C_ZS = 512, C_Q = 1024, C_K = 2560, C_V = 4096, C_ZA = 5632, C_GS = 6144, C_GA = 7168;
constexpr float RMS_EPS = 1e-6f;
constexpr float ATT_C2 = 0.08838834764831845f * 1.4426950408889634f;

constexpr size_t MiB = 1u << 20;
constexpr size_t OFF_CTL = 0;
constexpr size_t OFF_WIN = 1 * MiB;
constexpr size_t OFF_WGLU = 65 * MiB;
constexpr size_t OFF_WBS = 67 * MiB;
constexpr size_t OFF_WBA = 71 * MiB;
constexpr size_t OFF_WOUT = 75 * MiB;
constexpr size_t OFF_S5 = 83 * MiB;
constexpr size_t OFF_XB = 104 * MiB;
constexpr size_t OFF_ROWSS = 136 * MiB;
constexpr size_t OFF_PROJ = 137 * MiB;
constexpr size_t OFF_YPRE = 393 * MiB;
constexpr size_t OFF_AO = 409 * MiB;
constexpr size_t OFF_ALSE = 457 * MiB;
constexpr size_t OFF_T2 = 458 * MiB;
constexpr size_t OFF_T4 = 474 * MiB;
constexpr size_t WS_END = 506 * MiB;
constexpr size_t S5_A = 0;
constexpr size_t S5_BB = 1 * MiB;

typedef unsigned short bf16_t;
typedef short bf16x8 __attribute__((ext_vector_type(8)));
typedef float f32x4 __attribute__((ext_vector_type(4)));
typedef unsigned u32x4 __attribute__((ext_vector_type(4)));

__device__ __forceinline__ float bf2f(bf16_t h) { return __uint_as_float(((unsigned)h) << 16); }
__device__ __forceinline__ bf16_t f2bf(float f) { unsigned u = __float_as_uint(f); return (bf16_t)((u + 0x7fffu + ((u >> 16) & 1u)) >> 16); }
__device__ __forceinline__ float sigmoidf_(float v) { return 1.0f / (1.0f + __expf(-v)); }
__device__ __forceinline__ float siluf_(float v) { return v / (1.0f + __expf(-v)); }
__device__ __forceinline__ float gelu_tanh(float x) {
    const float z = 0.7978845608028654f * (x + 0.044715f * x * x * x);
    const float t = 1.0f - 2.0f / (1.0f + __expf(2.0f * z));
    return 0.5f * x * (1.0f + t);
}
__device__ __forceinline__ float wave_sum(float v) {
    v += __builtin_bit_cast(float, __builtin_amdgcn_ds_swizzle(__builtin_bit_cast(int, v), 0x041F));
    v += __builtin_bit_cast(float, __builtin_amdgcn_ds_swizzle(__builtin_bit_cast(int, v), 0x081F));
    v += __builtin_bit_cast(float, __builtin_amdgcn_ds_swizzle(__builtin_bit_cast(int, v), 0x101F));
    v += __builtin_bit_cast(float, __builtin_amdgcn_ds_swizzle(__builtin_bit_cast(int, v), 0x201F));
    v += __builtin_bit_cast(float, __builtin_amdgcn_ds_swizzle(__builtin_bit_cast(int, v), 0x401F));
    const auto rr = __builtin_amdgcn_permlane32_swap(__float_as_uint(v), __float_as_uint(v), false, false);
    return __uint_as_float(rr[0]) + __uint_as_float(rr[1]);
}
enum { IN_X = 0, IN_PREG, IN_WIN, IN_LRE, IN_LIM, IN_LDT, IN_BRE, IN_BIM, IN_CRE, IN_CIM, IN_DSKIP, IN_WGLU, IN_BGLU, IN_WBS, IN_WBA, IN_WOUT, IN_POSTG, N_IN };
struct Params { const float* in[N_IN]; float* out; unsigned char* ws; };
__device__ __forceinline__ int tid_opaque() { int t = threadIdx.x; asm volatile("" : "+v"(t)); return t; }

namespace nv {
__global__ void k_transpose(const float* __restrict__ W, const float* __restrict__ rs, bf16_t* __restrict__ Wt, int K, int N) {
    __shared__ float tile[32][33];
    const int n0 = blockIdx.x * 32, k0 = blockIdx.y * 32, tx = threadIdx.x, ty = threadIdx.y;
    for (int i = ty; i < 32; i += 8) { const int k = k0 + i; tile[i][tx] = W[(size_t)k * N + n0 + tx] * (rs ? rs[k] : 1.0f); }
    __syncthreads();
    for (int i = ty; i < 32; i += 8) { const int n = n0 + i; Wt[(size_t)n * K + k0 + tx] = f2bf(tile[tx][i]); }
}
__global__ void k_s5_tables(Params p) {
    const int lg = blockIdx.x, pp = threadIdx.x, idx = lg * 64 + pp;
    const float lre = fminf(p.in[IN_LRE][idx], -1e-4f), lim = p.in[IN_LIM][idx], dt = expf(p.in[IN_LDT][lg]);
    const float a = lre * dt, b = lim * dt, ea = expf(a), sb = sinf(b), cb = cosf(b);
    const float Are = ea * cb, Aim = ea * sb, sh = sinf(0.5f * b);
    const float Dre = expm1f(a) * cb - 2.0f * sh * sh, Dim = Aim;
    const float den = lre * lre + lim * lim;
    const float cre = (Dre * lre + Dim * lim) / den, cim = (Dim * lre - Dre * lim) / den;
    float* A = (float*)(p.ws + OFF_S5 + S5_A); float* Bb = (float*)(p.ws + OFF_S5 + S5_BB);
    A[idx * 2] = Are; A[idx * 2 + 1] = Aim;
    for (int c = 0; c < 16; ++c) { const float br = p.in[IN_BRE][idx * 16 + c], bi = p.in[IN_BIM][idx * 16 + c];
        Bb[(idx * 16 + c) * 2] = cre * br - cim * bi; Bb[(idx * 16 + c) * 2 + 1] = cre * bi + cim * br; }
}
__global__ void k_rows_x(Params p) {
    const int row = blockIdx.x, t = threadIdx.x;
    const f32x4 v = ((const f32x4*)(p.in[IN_X] + (size_t)row * D_MODEL))[t];
    ((f32x4*)(p.out + (size_t)row * D_MODEL))[t] = v;
    bf16_t* xb = (bf16_t*)(p.ws + OFF_XB) + (size_t)row * D_MODEL + t * 4;
    xb[0] = f2bf(v[0]); xb[1] = f2bf(v[1]); xb[2] = f2bf(v[2]); xb[3] = f2bf(v[3]);
    float ss = wave_sum(v[0] * v[0] + v[1] * v[1] + v[2] * v[2] + v[3] * v[3]);
    __shared__ float s[4];
    if ((t & 63) == 0) s[t >> 6] = ss;
    __syncthreads();
    if (t == 0) ((float*)(p.ws + OFF_ROWSS))[row] = s[0] + s[1] + s[2] + s[3];
}
template <class Epi> __global__ __launch_bounds__(256) void k_gemm(const bf16_t* __restrict__ A, int lda, const bf16_t* __restrict__ Bt, int ldb, int K, Epi epi) {
    const int tid = threadIdx.x, wave = tid >> 6, lane = tid & 63, wr = wave >> 1, wc = wave & 1;
    const int row0 = blockIdx.y * 128 + wr * 64, col0 = blockIdx.x * 128 + wc * 64;
    f32x4 acc[4][4];
    for (int i = 0; i < 4; ++i) for (int j = 0; j < 4; ++j) acc[i][j] = (f32x4){0.f, 0.f, 0.f, 0.f};
    const bf16_t* ap = A + (size_t)(row0 + (lane & 15)) * lda + 8 * (lane >> 4);
    const bf16_t* bp = Bt + (size_t)(col0 + (lane & 15)) * ldb + 8 * (lane >> 4);
    for (int k0 = 0; k0 < K; k0 += 32) {
        bf16x8 a[4], b[4];
#pragma unroll
        for (int i = 0; i < 4; ++i) { a[i] = *(const bf16x8*)(ap + (size_t)i * 16 * lda + k0); b[i] = *(const bf16x8*)(bp + (size_t)i * 16 * ldb + k0); }
#pragma unroll
        for (int i = 0; i < 4; ++i)
#pragma unroll
            for (int j = 0; j < 4; ++j) acc[i][j] = __builtin_amdgcn_mfma_f32_16x16x32_bf16(a[i], b[j], acc[i][j], 0, 0, 0);
    }
#pragma unroll
    for (int i = 0; i < 4; ++i)
#pragma unroll
        for (int j = 0; j < 4; ++j)
#pragma unroll
            for (int r = 0; r < 4; ++r) epi(row0 + i * 16 + (lane >> 4) * 4 + r, col0 + j * 16 + (lane & 15), acc[i][j][r]);
}
struct EpiInProj { const float* rowss; bf16_t* proj;
    __device__ void operator()(int row, int col, float acc) const {
        float v = acc * rsqrtf(rowss[row] * (1.0f / D_MODEL) + RMS_EPS);
        if ((col >= C_ZS && col < C_Q) || (col >= C_ZA && col < C_GS)) v = siluf_(v);
        else if (col >= C_GS) v = sigmoidf_(v);
        proj[(size_t)row * IN_COLS + col] = f2bf(v);
    } };
struct EpiGlu { const bf16_t* y1; const bf16_t* proj; const float* b_glu; bf16_t* ys;
    __device__ void operator()(int row, int col, float acc) const {
        const float gate = sigmoidf_(acc + b_glu[col]);
        ys[(size_t)row * SSM_W + col] = f2bf(bf2f(y1[(size_t)row * SSM_W + col]) * gate * bf2f(proj[(size_t)row * IN_COLS + C_ZS + col]));
    } };
struct EpiGate1 { const bf16_t* proj; bf16_t* m1;
    __device__ void operator()(int row, int col, float acc) const { m1[(size_t)row * D_MODEL + col] = f2bf(bf2f(proj[(size_t)row * IN_COLS + C_GS + col]) * acc); } };
struct EpiGate2 { const bf16_t* proj; const bf16_t* m1; bf16_t* mg;
    __device__ void operator()(int row, int col, float acc) const {
        mg[(size_t)row * D_MODEL + col] = f2bf(bf2f(m1[(size_t)row * D_MODEL + col]) + bf2f(proj[(size_t)row * IN_COLS + C_GA + col]) * acc); } };
struct EpiF32 { float* C; int ldc;
    __device__ void operator()(int row, int col, float acc) const { C[(size_t)row * ldc + col] = acc; } };

__global__ __launch_bounds__(256) void k_attn(Params p) {
    const int wave = threadIdx.x >> 6, lane = threadIdx.x & 63;
    const long wid = (long)blockIdx.x * 4 + wave;
    const int j = (int)(wid & 3), gi = (int)((wid >> 2) % 3), tok = (int)(wid / 12);
    const int d = gi == 0 ? 1 : (gi == 1 ? 4 : 16);
    const int t = tok % SEQ, i = t / d;
    const bf16_t* proj = (const bf16_t*)(p.ws + OFF_PROJ);
    const int hc = (gi * 4 + j) * HD + 2 * lane;
    const unsigned qq = *(const unsigned*)(proj + (size_t)tok * IN_COLS + C_Q + hc);
    const float q0 = bf2f((bf16_t)(qq & 0xffff)), q1 = bf2f((bf16_t)(qq >> 16));
    float m = -1e30f, l = 0.f, o0 = 0.f, o1 = 0.f;
    const int nk = i < 128 ? i : 128;
    for (int jj = nk; jj >= 0; --jj) {
        const size_t kt = (size_t)(tok - jj * d);
        const unsigned kk = *(const unsigned*)(proj + kt * IN_COLS + C_K + hc);
        const unsigned vv = *(const unsigned*)(proj + kt * IN_COLS + C_V + hc);
        float s = q0 * bf2f((bf16_t)(kk & 0xffff)) + q1 * bf2f((bf16_t)(kk >> 16));
        s = wave_sum(s) * ATT_C2;
        const float mn = fmaxf(m, s), al = exp2f(m - mn), pr = exp2f(s - mn);
        l = l * al + pr; o0 = o0 * al + pr * bf2f((bf16_t)(vv & 0xffff)); o1 = o1 * al + pr * bf2f((bf16_t)(vv >> 16)); m = mn;
    }
    const float il = 1.0f / l;
    bf16_t* ao = (bf16_t*)(p.ws + OFF_AO) + ((size_t)gi * MTOK + tok) * ATT_W + j * HD + 2 * lane;
    *(unsigned*)ao = (unsigned)f2bf(o0 * il) | ((unsigned)f2bf(o1 * il) << 16);
    if (lane == 0) ((float*)(p.ws + OFF_ALSE))[((size_t)gi * MTOK + tok) * 4 + j] = m + log2f(l);
}
__global__ __launch_bounds__(64) void k_s5(Params p, int layer) {
    const int b = blockIdx.x >> 5, g = blockIdx.x & 31, lane = threadIdx.x;
    const int idx = ((layer * 32 + g) * 64 + lane);
    const float* A = (const float*)(p.ws + OFF_S5 + S5_A); const float* Bb = (const float*)(p.ws + OFF_S5 + S5_BB);
    const float Are = A[idx * 2], Aim = A[idx * 2 + 1];
    float bre[16], bim[16], cre[16], cim[16];
#pragma unroll
    for (int c = 0; c < 16; ++c) { bre[c] = Bb[(idx * 16 + c) * 2]; bim[c] = Bb[(idx * 16 + c) * 2 + 1];
        cre[c] = p.in[IN_CRE][(size_t)((layer * 32 + g) * 16 + c) * 64 + lane]; cim[c] = p.in[IN_CIM][(size_t)((layer * 32 + g) * 16 + c) * 64 + lane]; }
    const bf16_t* proj = (const bf16_t*)(p.ws + OFF_PROJ); bf16_t* ypre = (bf16_t*)(p.ws + OFF_YPRE);
    float sre = 0.f, sim = 0.f;
    for (int t = 0; t < SEQ; ++t) {
        const size_t tok = (size_t)b * SEQ + t;
        const bf16x8 u0 = *(const bf16x8*)(proj + tok * IN_COLS + C_US + g * 16), u1 = *(const bf16x8*)(proj + tok * IN_COLS + C_US + g * 16 + 8);
        float dre = 0.f, dim = 0.f;
#pragma unroll
        for (int c = 0; c < 8; ++c) { const float ua = bf2f((bf16_t)u0[c]), ub = bf2f((bf16_t)u1[c]);
            dre += bre[c] * ua + bre[c + 8] * ub; dim += bim[c] * ua + bim[c + 8] * ub; }
        const float nre = Are * sre - Aim * sim + dre, nim = Are * sim + Aim * sre + dim;
        sre = nre; sim = nim;
        float mine = 0.f;
#pragma unroll
        for (int c = 0; c < 16; ++c) { const float y = wave_sum(cre[c] * sre - cim[c] * sim); if (lane == c) mine = y; }
        if (lane < 16) ypre[tok * SSM_W + g * 16 + lane] = f2bf(mine);
    }
}
__global__ void k_p4a(Params p, int layer) {
    const size_t e = (size_t)blockIdx.x * 256 + threadIdx.x; const size_t row = e >> 9; const int col = (int)(e & 511);
    bf16_t* ypre = (bf16_t*)(p.ws + OFF_YPRE); const bf16_t* proj = (const bf16_t*)(p.ws + OFF_PROJ);
    const float y0 = bf2f(ypre[e]) + p.in[IN_DSKIP][layer * SSM_W + col] * bf2f(proj[row * IN_COLS + C_US + col]);
    ypre[e] = f2bf(gelu_tanh(y0));
}
__global__ void k_merge(Params p) {
    const size_t e = (size_t)blockIdx.x * 256 + threadIdx.x; const size_t row = e >> 9; const int col = (int)(e & 511), j = col >> 7;
    bf16_t* ao = (bf16_t*)(p.ws + OFF_AO); const float* ls = (const float*)(p.ws + OFF_ALSE); const bf16_t* proj = (const bf16_t*)(p.ws + OFF_PROJ);
    const float l0 = ls[((size_t)0 * MTOK + row) * 4 + j], l1 = ls[((size_t)1 * MTOK + row) * 4 + j], l2 = ls[((size_t)2 * MTOK + row) * 4 + j];
    const float mx = fmaxf(l0, fmaxf(l1, l2)), w0 = exp2f(l0 - mx), w1 = exp2f(l1 - mx), w2 = exp2f(l2 - mx);
    const float y = (w0 * bf2f(ao[e]) + w1 * bf2f(ao[(size_t)MTOK * ATT_W + e]) + w2 * bf2f(ao[(size_t)2 * MTOK * ATT_W + e])) / (w0 + w1 + w2);
    ao[e] = f2bf(y * bf2f(proj[row * IN_COLS + C_ZA + col]));
}
__global__ void k_postnorm(Params p, int layer, const float* o) {
    const int row = blockIdx.x, t = threadIdx.x;
    const f32x4 v = ((const f32x4*)(o + (size_t)row * D_MODEL))[t];
    __shared__ float s[4], s2[4];
    float ss = wave_sum(v[0] * v[0] + v[1] * v[1] + v[2] * v[2] + v[3] * v[3]);
    if ((t & 63) == 0) s[t >> 6] = ss;
    __syncthreads();
    const float inv = rsqrtf((s[0] + s[1] + s[2] + s[3]) * (1.0f / D_MODEL) + RMS_EPS);
    const f32x4 g = ((const f32x4*)(p.in[IN_POSTG] + layer * D_MODEL))[t];
    f32x4 xv = ((f32x4*)(p.out + (size_t)row * D_MODEL))[t];
    xv = xv + v * inv * g;
    ((f32x4*)(p.out + (size_t)row * D_MODEL))[t] = xv;
    bf16_t* xb = (bf16_t*)(p.ws + OFF_XB) + (size_t)row * D_MODEL + t * 4;
    xb[0] = f2bf(xv[0]); xb[1] = f2bf(xv[1]); xb[2] = f2bf(xv[2]); xb[3] = f2bf(xv[3]);
    float q = wave_sum(xv[0] * xv[0] + xv[1] * xv[1] + xv[2] * xv[2] + xv[3] * xv[3]);
    if ((t & 63) == 0) s2[t >> 6] = q;
    __syncthreads();
    if (t == 0) ((float*)(p.ws + OFF_ROWSS))[row] = s2[0] + s2[1] + s2[2] + s2[3];
}
}

namespace pg8 {
#define PG8_LAS __attribute__((address_space(3)))
typedef unsigned short bf16_t;
typedef short bf16x8 __attribute__((ext_vector_type(8)));
typedef float f32x4 __attribute__((ext_vector_type(4)));
typedef unsigned u32x4 __attribute__((ext_vector_type(4)));
constexpr int BM = 256, BK = 64, HALF = 128, HTB = HALF * BK * 2  , STAGE_BYTES = 8 * HTB, NXCD = 8, WGM = 8;

__host__ __device__ __forceinline__ int lds_byte(int r, int c) { const int st = (r >> 4) * 2 + (c >> 5), rr = r & 15, cc = c & 31, ob = rr * 64 + cc * 2; return st * 1024 + (ob ^ (((ob >> 9) & 1) << 5)); }
__host__ __device__ __forceinline__ void stage_rc(int b, int& R, int& C) { const int st = b / 1024, sb = b % 1024, swz = sb ^ (((sb >> 9) & 1) << 5); R = (st >> 1) * 16 + swz / 64; C = (st & 1) * 32 + (swz % 64) / 2; }
__host__ __device__ __forceinline__ int perm32(int rho) { const int n = rho >> 4, i = rho & 15; return 8 * (i >> 2) + 4 * n + (i & 3); }

struct Unit { int pm, pn; };
struct Gemm { const bf16_t* A; const bf16_t* Bt; int M, N, K; };

struct StaticOrder {
    int nM, nN, nwg, G, c;
    __host__ __device__ void init(int M, int N, int G_, int c_) { nM = M / BM; nN = N / BM; nwg = nM * nN; G = G_; c = c_; }
    __host__ __device__ bool next(int i, Unit& u) const {
        const long L = (long)i * G + c; if (L >= nwg) return false;
        int wgid = (int)L; { const int q = nwg / NXCD, r = nwg % NXCD, xcd = wgid % NXCD, off = wgid / NXCD; wgid = (xcd < r ? xcd * (q + 1) : r * (q + 1) + (xcd - r) * q) + off; }
        const int nig = WGM * nN, gid = wgid / nig, fm = gid * WGM, gsz = (nM - fm) < WGM ? (nM - fm) : WGM;
        u.pm = fm + ((wgid % nig) % gsz); u.pn = (wgid % nig) / gsz; return true;
    }
    __device__ __forceinline__ void a_ready(const Unit&) const {}
    __device__ __forceinline__ void done(const Unit&) const {}
};

__device__ __forceinline__ unsigned cvt_pk_bf16(float lo, float hi) { unsigned r; asm volatile("v_cvt_pk_bf16_f32 %0, %1, %2" : "=v"(r) : "v"(lo), "v"(hi)); return r; }
template <class Epi, class Sched, bool ALIGN_EPI = false, bool SP2 = false>
__device__ __forceinline__ void gemm_phase(PG8_LAS unsigned char* lds, const Gemm g, const Sched& S, const Epi& E) {
    int tid_ = threadIdx.x; asm volatile("" : "+v"(tid_));
    const int tid = tid_, wid = __builtin_amdgcn_readfirstlane(tid >> 6), lane = tid & 63, wr = wid >> 2, wc = wid & 3, fr = lane & 15, fq = lane >> 4;
    const int K = g.K, nt = K / BK;
    unsigned voffA[2], voffB[2];
#pragma unroll
    for (int i = 0; i < 2; ++i) { int R, C; stage_rc(tid * 16 + i * 8192, R, C); const int Rb = Epi::PERM ? ((R & ~31) + perm32(R & 31)) : R;
        voffA[i] = (unsigned)(R * K + C) * 2u; voffB[i] = (unsigned)(Rb * K + C) * 2u; }
    const size_t kstep = (size_t)(BK * 2);
    const size_t hstep = (size_t)HALF * K * 2;
    const size_t tstep = 2 * hstep;
    const unsigned ldsw = (unsigned)wid * 1024u;
    const int aoff = lds_byte(wr * 64 + fr, fq * 8), boff = lds_byte(wc * 32 + fr, fq * 8);
#define PG8_SA(b, h) (((b) * 2 + (h)) * HTB)
#define PG8_SB(b, h) ((4 + (b) * 2 + (h)) * HTB)
#define PG8_STAGE(bufoff, gbase, voff) do { _Pragma("unroll") for (int _i = 0; _i < 2; ++_i) \
        __builtin_amdgcn_global_load_lds((const unsigned*)((const char*)(gbase) + (voff)[_i]), (PG8_LAS unsigned*)(lds + (bufoff) + ldsw + _i * 8192), 16, 0, 0); } while (0)
#define PG8_LDA(dst, b, h) do { _Pragma("unroll") for (int m = 0; m < 4; ++m) _Pragma("unroll") for (int k = 0; k < 2; ++k) dst[m][k] = *(const PG8_LAS bf16x8*)(lds + PG8_SA(b, h) + aoff + m * 2048 + k * 1024); } while (0)
#define PG8_LDB(dst, b, h) do { _Pragma("unroll") for (int n = 0; n < 2; ++n) _Pragma("unroll") for (int k = 0; k < 2; ++k) dst[n][k] = *(const PG8_LAS bf16x8*)(lds + PG8_SB(b, h) + boff + n * 2048 + k * 1024); } while (0)
#define PG8_MMA(ai, bj, At, Bt) do { __builtin_amdgcn_s_setprio(1); _Pragma("unroll") for (int m = 0; m < 4; ++m) _Pragma("unroll") for (int n = 0; n < 2; ++n) _Pragma("unroll") for (int k = 0; k < 2; ++k) \
        acc[ai][bj][m][n] = __builtin_amdgcn_mfma_f32_16x16x32_bf16(Bt[n][k], At[m][k], acc[ai][bj][m][n], 0, 0, 0); __builtin_amdgcn_s_setprio(0); } while (0)
#define PG8_WAIT_V(n) asm volatile("s_waitcnt vmcnt(" #n ")" ::: "memory")
#define PG8_WAIT_L(n) asm volatile("s_waitcnt lgkmcnt(" #n ")" ::: "memory")
#define PG8_BAR __builtin_amdgcn_s_barrier()
#define PG8_SCHED __builtin_amdgcn_sched_barrier(0)
    Unit cur, nxt; int ui = 0;
    if (!S.next(0, cur)) return;
    f32x4 acc[2][2][4][2];
#pragma unroll
    for (int a = 0; a < 2; ++a)
#pragma unroll
        for (int b = 0; b < 2; ++b)
#pragma unroll
            for (int m = 0; m < 4; ++m)
#pragma unroll
                for (int n = 0; n < 2; ++n) acc[a][b][m][n] = (f32x4){0.f, 0.f, 0.f, 0.f};
    bf16x8 At[4][2], B0[2][2], B1[2][2];
    const char* cA = (const char*)g.A + (size_t)cur.pm * tstep; const char* cB = (const char*)g.Bt + (size_t)cur.pn * tstep;
    S.a_ready(cur);
    if constexpr (SP2) {
        PG8_STAGE(PG8_SB(0, 0), cB, voffB); PG8_STAGE(PG8_SB(0, 1), cB + hstep, voffB); PG8_STAGE(PG8_SA(0, 0), cA, voffA); PG8_STAGE(PG8_SA(0, 1), cA + hstep, voffA);
        if (wr == 1) PG8_BAR;
        PG8_WAIT_V(2); PG8_BAR;
        PG8_STAGE(PG8_SB(1, 0), cB + kstep, voffB); PG8_STAGE(PG8_SA(1, 0), cA + kstep, voffA); PG8_STAGE(PG8_SB(1, 1), cB + hstep + kstep, voffB);
        PG8_WAIT_V(6); PG8_BAR;
    } else {
        PG8_STAGE(PG8_SB(0, 0), cB, voffB); PG8_STAGE(PG8_SA(0, 0), cA, voffA); PG8_STAGE(PG8_SB(0, 1), cB + hstep, voffB); PG8_STAGE(PG8_SA(0, 1), cA + hstep, voffA);
        if (wr == 1) PG8_BAR;
        PG8_WAIT_V(4); PG8_BAR;
        PG8_STAGE(PG8_SB(1, 0), cB + kstep, voffB); PG8_STAGE(PG8_SA(1, 0), cA + kstep, voffA); PG8_STAGE(PG8_SB(1, 1), cB + hstep + kstep, voffB);
        PG8_WAIT_V(6); PG8_BAR;
    }
    for (;;) {
        const bool has_next = S.next(ui + 1, nxt);
        const char* nA = has_next ? (const char*)g.A + (size_t)nxt.pm * tstep : cA; const char* nB = has_next ? (const char*)g.Bt + (size_t)nxt.pn * tstep : cB;
        for (int t = 0; t < nt; t += 2) {
            const bool last = (t == nt - 2);
            const char* a1 = cA + (size_t)(t + 1) * kstep;
            const char* a2 = last ? nA : cA + (size_t)(t + 2) * kstep; const char* b2 = last ? nB : cB + (size_t)(t + 2) * kstep;
            const char* a3 = a2 + kstep; const char* b3 = b2 + kstep;
            if (last && has_next) S.a_ready(nxt);
            if constexpr (SP2) {
            PG8_LDB(B0, 0, 0); PG8_LDB(B1, 0, 1); PG8_SCHED; PG8_LDA(At, 0, 0); PG8_STAGE(PG8_SA(1, 1), a1 + hstep, voffA);
            PG8_WAIT_V(8); PG8_WAIT_L(0); PG8_BAR; PG8_MMA(0, 0, At, B0); PG8_MMA(0, 1, At, B1); PG8_BAR; PG8_SCHED;
            PG8_LDA(At, 0, 1); PG8_STAGE(PG8_SB(0, 0), b2, voffB); PG8_STAGE(PG8_SB(0, 1), b2 + hstep, voffB); PG8_STAGE(PG8_SA(0, 0), a2, voffA);
            PG8_WAIT_V(8); PG8_WAIT_L(0); PG8_BAR; PG8_MMA(1, 0, At, B0); PG8_MMA(1, 1, At, B1); PG8_BAR; PG8_SCHED;
            PG8_LDB(B0, 1, 0); PG8_LDB(B1, 1, 1); PG8_SCHED; PG8_LDA(At, 1, 0); PG8_STAGE(PG8_SA(0, 1), a2 + hstep, voffA);
            PG8_WAIT_V(8); PG8_WAIT_L(0); PG8_BAR; PG8_MMA(0, 0, At, B0); PG8_MMA(0, 1, At, B1); PG8_BAR; PG8_SCHED;
            PG8_LDA(At, 1, 1); PG8_STAGE(PG8_SB(1, 0), b3, voffB); PG8_STAGE(PG8_SB(1, 1), b3 + hstep, voffB); PG8_STAGE(PG8_SA(1, 0), a3, voffA);
            PG8_WAIT_V(8); PG8_WAIT_L(0); PG8_BAR; PG8_MMA(1, 0, At, B0); PG8_MMA(1, 1, At, B1); PG8_BAR; PG8_SCHED;
            } else {
            PG8_LDB(B0, 0, 0); PG8_SCHED; PG8_LDA(At, 0, 0); PG8_STAGE(PG8_SA(1, 1), a1 + hstep, voffA);
            PG8_WAIT_L(8); PG8_BAR; PG8_WAIT_L(0); PG8_MMA(0, 0, At, B0); PG8_BAR; PG8_SCHED;
            PG8_LDB(B1, 0, 1); PG8_STAGE(PG8_SB(0, 0), b2, voffB);
            PG8_BAR; PG8_WAIT_L(0); PG8_MMA(0, 1, At, B1); PG8_BAR;
            PG8_LDA(At, 0, 1); PG8_STAGE(PG8_SA(0, 0), a2, voffA);
            PG8_BAR; PG8_WAIT_L(0); PG8_MMA(1, 0, At, B0); PG8_BAR; PG8_SCHED;
            PG8_STAGE(PG8_SB(0, 1), b2 + hstep, voffB);
            PG8_WAIT_V(6); PG8_BAR; PG8_MMA(1, 1, At, B1); PG8_BAR;
            PG8_LDB(B0, 1, 0); PG8_SCHED; PG8_LDA(At, 1, 0); PG8_STAGE(PG8_SA(0, 1), a2 + hstep, voffA);
            PG8_WAIT_L(8); PG8_BAR; PG8_WAIT_L(0); PG8_MMA(0, 0, At, B0); PG8_BAR; PG8_SCHED;
            PG8_LDB(B1, 1, 1); PG8_STAGE(PG8_SB(1, 0), b3, voffB);
            PG8_BAR; PG8_WAIT_L(0); PG8_MMA(0, 1, At, B1); PG8_BAR;
            PG8_LDA(At, 1, 1); PG8_STAGE(PG8_SA(1, 0), a3, voffA);
            PG8_BAR; PG8_WAIT_L(0); PG8_MMA(1, 0, At, B0); PG8_BAR; PG8_SCHED;
            PG8_STAGE(PG8_SB(1, 1), b3 + hstep, voffB);
            PG8_WAIT_V(6); PG8_BAR; PG8_MMA(1, 1, At, B1); PG8_BAR;
            }
        }
        if constexpr (ALIGN_EPI) { if (wr == 0) PG8_BAR; }
        if constexpr (!Epi::AFTER_DRAIN) { E(acc, cur, wr, wc, fr, fq); S.done(cur); }
        if (!has_next) break;
#pragma unroll
        for (int a = 0; a < 2; ++a)
#pragma unroll
            for (int b = 0; b < 2; ++b)
#pragma unroll
                for (int m = 0; m < 4; ++m)
#pragma unroll
                    for (int n = 0; n < 2; ++n) acc[a][b][m][n] = (f32x4){0.f, 0.f, 0.f, 0.f};
        cur = nxt; cA = nA; cB = nB; ++ui;
        if constexpr (ALIGN_EPI) { if (wr == 1) PG8_BAR; }
    }
    PG8_WAIT_V(0);
    if constexpr (!ALIGN_EPI) { if (wr == 0) PG8_BAR; }
    PG8_BAR;
    if constexpr (Epi::AFTER_DRAIN) { E.fused(acc, cur, wr, wc, fr, fq, lds, wid, lane); S.done(cur); }
#undef PG8_SA
#undef PG8_SB
#undef PG8_STAGE
#undef PG8_LDA
#undef PG8_LDB
#undef PG8_MMA
#undef PG8_WAIT_V
#undef PG8_WAIT_L
#undef PG8_BAR
#undef PG8_SCHED
}
}

namespace pg8 {
struct EpiInProj {
    static constexpr bool PERM = true, AFTER_DRAIN = false;
    bf16_t* O; const float* rowss;
    __device__ __forceinline__ void operator()(const f32x4 (&acc)[2][2][4][2], const Unit& u, int wr, int wc, int fr, int fq) const {
        const int row0 = u.pm * BM + wr * 64 + fr, colt = u.pn * BM, col0 = colt + wc * 32 + 8 * fq;
        const int mode = (colt >= C_GS) ? 2 : (((colt >= C_ZS && colt < C_Q) || (colt >= C_ZA && colt < C_GS)) ? 1 : 0);
#pragma unroll
        for (int ai = 0; ai < 2; ++ai)
#pragma unroll
            for (int m = 0; m < 4; ++m) {
                const int row = row0 + ai * HALF + m * 16;
                const float inv = rsqrtf(rowss[row] * (1.0f / D_MODEL) + RMS_EPS);
                bf16_t* rowp = O + (size_t)row * IN_COLS + col0;
#pragma unroll
                for (int bj = 0; bj < 2; ++bj) {
                    f32x4 v0 = acc[ai][bj][m][0] * inv, v1 = acc[ai][bj][m][1] * inv;
                    if (mode != 0) {
#pragma unroll
                        for (int e = 0; e < 4; ++e) {
                            const float s0 = __builtin_amdgcn_rcpf(1.0f + __builtin_amdgcn_exp2f(-1.4426950408889634f * v0[e]));
                            const float s1 = __builtin_amdgcn_rcpf(1.0f + __builtin_amdgcn_exp2f(-1.4426950408889634f * v1[e]));
                            v0[e] = (mode == 1) ? v0[e] * s0 : s0; v1[e] = (mode == 1) ? v1[e] * s1 : s1;
                        }
                    }
                    u32x4 w; w.x = cvt_pk_bf16(v0[0], v0[1]); w.y = cvt_pk_bf16(v0[2], v0[3]); w.z = cvt_pk_bf16(v1[0], v1[1]); w.w = cvt_pk_bf16(v1[2], v1[3]);
                    *(u32x4*)(rowp + bj * HALF) = w;
                }
            }
    }
};
}

#define LAS __attribute__((address_space(3)))
#define GAS __attribute__((address_space(1)))
#define LDS_WAIT() asm volatile("s_waitcnt lgkmcnt(0)" ::: "memory")
#define VM_WAIT() asm volatile("s_waitcnt vmcnt(0)" ::: "memory")
__device__ __forceinline__ unsigned pk2(float lo, float hi) { return (unsigned)f2bf(lo) | ((unsigned)f2bf(hi) << 16); }
#define XB_TMO      128
#define XB_XCNT(j)  (256  + 64 * (j))
#define XB_XSUB(j)  (1280 + 64 * (j))
#define XB_XGEN(j)  (2304 + 64 * (j))
#define XB_TOP      3328
#define XB_TOPGEN   3392
#define XCD_BAR_WORDS 3456
#define XB_SPIN_CAP (1u << 18)

__device__ __forceinline__ unsigned xb_ld(unsigned* p)              { return __hip_atomic_load(p, __ATOMIC_RELAXED, __HIP_MEMORY_SCOPE_AGENT); }
__device__ __forceinline__ unsigned xb_add(unsigned* p, unsigned v) { return __hip_atomic_fetch_add(p, v, __ATOMIC_RELAXED, __HIP_MEMORY_SCOPE_AGENT); }
__device__ __forceinline__ unsigned xb_xcc_id() { return (unsigned)__builtin_amdgcn_s_getreg((3 << 11) | 20) & 0xFu; }
#define XB_SPIN(cond, bar) do { unsigned _sp = 0; while (cond) { __builtin_amdgcn_s_sleep(1); \
    if ((++_sp & 255u) == 0u) { if (xb_ld(&(bar)[XB_TMO])) break; if (_sp > XB_SPIN_CAP) { atomicAdd(&(bar)[XB_TMO], 1u); break; } } } } while (0)

struct XcdBarrier {
    unsigned* bar; unsigned x;
    volatile LAS unsigned* st;
};

__device__ __forceinline__ XcdBarrier xcd_barrier_post(unsigned* bar, volatile LAS unsigned* st) {
    XcdBarrier b; b.bar = bar; b.x = xb_xcc_id(); b.st = st;
    if (threadIdx.x == 0) (void)xb_add(&bar[XB_XCNT(b.x)], 1u);
    return b;
}
__device__ __forceinline__ void xcd_barrier_complete(unsigned* bar, unsigned x, unsigned& nloc, unsigned& nx) {
    const unsigned G = gridDim.x * gridDim.y * gridDim.z;
    unsigned sum, cnt, mine, sp = 0u;
    for (;;) {
        sum = 0u; cnt = 0u; mine = 0u;
#pragma unroll
        for (unsigned j = 0; j < 16; ++j) { const unsigned c = xb_ld(&bar[XB_XCNT(j)]); sum += c; cnt += (c > 0u) ? 1u : 0u; mine = (j == x) ? c : mine; }
        if (sum == G) break;
        __builtin_amdgcn_s_sleep(1);
        if ((++sp & 255u) == 0u) { if (xb_ld(&bar[XB_TMO])) break; if (sp > XB_SPIN_CAP) { atomicAdd(&bar[XB_TMO], 1u); break; } }
    }
    nloc = mine > 0u ? mine : 1u; nx = cnt > 0u ? cnt : 1u;
}

__device__ __forceinline__ void xcd_barrier(const XcdBarrier& b) {
    asm volatile("s_waitcnt vmcnt(0)" ::: "memory");
    __syncthreads();
    if (threadIdx.x == 0) {
        unsigned* bar = b.bar;
        __builtin_amdgcn_s_waitcnt(0);
        unsigned nloc = b.st[0], nx = b.st[1];
        if (nloc == 0u) { xcd_barrier_complete(bar, b.x, nloc, nx); b.st[0] = nloc; b.st[1] = nx; }
        const unsigned old = xb_add(&bar[XB_XSUB(b.x)], 1u);
        const unsigned gen = old / nloc;
        if (old + 1u == (gen + 1u) * nloc) {
            __builtin_amdgcn_fence(__ATOMIC_RELEASE, "agent");
            asm volatile("s_waitcnt vmcnt(0)" ::: "memory");
            const unsigned og = xb_add(&bar[XB_TOP], 1u);
            const unsigned tg = og / nx;
            if (og + 1u == (tg + 1u) * nx) xb_add(&bar[XB_TOPGEN], 1u);
            else XB_SPIN(xb_ld(&bar[XB_TOPGEN]) == tg, bar);
            __builtin_amdgcn_fence(__ATOMIC_ACQUIRE, "agent");
            xb_add(&bar[XB_XGEN(b.x)], 1u);
            asm volatile("s_waitcnt vmcnt(0)" ::: "memory");
        } else {
            XB_SPIN(xb_ld(&bar[XB_XGEN(b.x)]) == gen, bar);
            __builtin_amdgcn_fence(__ATOMIC_ACQUIRE, "agent");
            asm volatile("s_waitcnt vmcnt(0)" ::: "memory");
        }
    }
    __syncthreads();
}

constexpr int NWAVES = 8, NTHREADS = NWAVES * 64;
constexpr int RING_BYTES = 131072;
constexpr int LDS_BYTES = 163840;
constexpr int MISC_OFF = LDS_BYTES - 256;
constexpr int CW_BAR = 4096;
constexpr int N_BAR_REGIONS = 32;
constexpr size_t CTL_ZERO_BYTES = 1 * MiB;
static_assert((CW_BAR + N_BAR_REGIONS * XCD_BAR_WORDS) * 4 <= (int)CTL_ZERO_BYTES, "ctl");

struct Frame { LAS unsigned char* lds; int tid, lane, wave, vcu, G; };

struct Args { Params p; int ph_lo, ph_hi, bar_region, pad; };
__device__ __forceinline__ const float* inptr(const Args& a, int i) { int z; asm volatile("s_mov_b32 %0, 0" : "=s"(z)); return a.p.in[i + z]; }

namespace swa {
constexpr int D = 128; constexpr float THR = 8.f; constexpr bool WSKIP = true;
constexpr float SCALE = 0.08838834764831845f;
constexpr int NW = 8, QBLK = 32, KVBLK = 64, QB = NW * QBLK;
constexpr int SHM_V = KVBLK * D * 2, SHM_K = KVBLK * D * 2;
constexpr int ATTN_LDS_BYTES = 2 * SHM_V + 2 * SHM_K + NW * 64 * 4;

typedef short s16x4 __attribute__((ext_vector_type(4)));
typedef float f32x16 __attribute__((ext_vector_type(16)));
template <class A, class Bt> struct same_t { static constexpr bool v = false; };
template <class A> struct same_t<A, A> { static constexpr bool v = true; };

#define KSWZ(row, colB) ((row) * 256 + ((colB) ^ (((row) & 7) << 4)))
#define SBAR() __builtin_amdgcn_sched_barrier(0)
__device__ __forceinline__ int v_st(int k, int c) { const int kk = (k & ~0xC) | ((k & 4) << 1) | ((k & 8) >> 1); return ((kk >> 3) * 4 + (c >> 5)) * 512 + ((kk & 7) * 32 + (c & 31)) * 2; }
__device__ __forceinline__ int v_rd_base(int lane) { return ((lane & 3) << 3) | (((lane >> 2) & 3) << 6) | (((lane >> 4) & 1) << 5) | (((lane >> 5) & 1) << 8); }
constexpr int v_rd_off(int d0, int ks, int half) { return d0 * 512 + ks * 4096 + half * 2048; }
__device__ __forceinline__ int crow(int r, int hi) { return (r & 3) + 8 * (r >> 2) + 4 * hi; }
__device__ __forceinline__ unsigned cvtpk(float lo, float hi) {
    unsigned r; asm volatile("v_cvt_pk_bf16_f32 %0, %1, %2" : "=v"(r) : "v"(lo), "v"(hi)); return r;
}
__device__ __forceinline__ bf16x8 pack8(f32x4 a, f32x4 b) {
    u32x4 w = {cvtpk(a[0], a[1]), cvtpk(a[2], a[3]), cvtpk(b[0], b[1]), cvtpk(b[2], b[3])};
    return *reinterpret_cast<bf16x8*>(&w);
}
template <class T> __device__ __forceinline__ bf16x8 load8(const T* p) {
    if constexpr (same_t<T, float>::v) { return pack8(*(const f32x4*)p, *(const f32x4*)(p + 4)); }
    else { return *reinterpret_cast<const bf16x8*>(p); }
}
__device__ __forceinline__ void mask_tile(f32x16& p0, f32x16& p1, int dq, unsigned W) {
    const float NEG = -__builtin_inff();
#pragma unroll
    for (int r = 0; r < 16; ++r) {
        const int c = (r & 3) + 8 * (r >> 2);
        if ((unsigned)(dq - c) >= W) p0[r] = NEG;
        if ((unsigned)(dq - c - 32) >= W) p1[r] = NEG;
    }
}
__device__ __forceinline__ void partialSM(f32x16& p0, f32x16& p1, float& m_reg, float& mn, float& alpha) {
    float pmax = p0[0]; for (int r = 1; r < 16; ++r) pmax = fmaxf(pmax, p0[r]); for (int r = 0; r < 16; ++r) pmax = fmaxf(pmax, p1[r]);
    { auto rr = __builtin_amdgcn_permlane32_swap(__float_as_uint(pmax), __float_as_uint(pmax), false, false);
      pmax = fmaxf(__uint_as_float(rr[0]), __uint_as_float(rr[1])); }
    constexpr float C2 = 1.4426950408889634f * SCALE;
    if (__builtin_expect(__all((pmax - m_reg) * SCALE <= THR), 1)) { mn = m_reg; alpha = 1.f; }
    else { mn = fmaxf(m_reg, pmax); alpha = __builtin_amdgcn_exp2f((m_reg - mn) * C2); m_reg = mn; }
    const float mnL = -mn * C2;
    for (int r = 0; r < 16; ++r) p0[r] = fmaf(p0[r], C2, mnL); for (int r = 0; r < 16; ++r) p1[r] = fmaf(p1[r], C2, mnL);
    for (int r = 0; r < 16; ++r) p0[r] = __builtin_amdgcn_exp2f(p0[r]);
}
__device__ __forceinline__ void finishSM(f32x16& p0, f32x16& p1, float alpha, float& l_reg, bf16x8& pa0, bf16x8& pa1, bf16x8& pa2, bf16x8& pa3) {
    for (int r = 0; r < 16; ++r) p1[r] = __builtin_amdgcn_exp2f(p1[r]);
    float ps = 0; for (int r = 0; r < 16; ++r) ps += p0[r]; for (int r = 0; r < 16; ++r) ps += p1[r];
    { auto rr = __builtin_amdgcn_permlane32_swap(__float_as_uint(ps), __float_as_uint(ps), false, false);
      ps = __uint_as_float(rr[0]) + __uint_as_float(rr[1]); }
    l_reg = l_reg * alpha + ps;
#define PK4(P, B_, OUT) do { unsigned a0 = cvtpk(P[B_+0], P[B_+1]), a1 = cvtpk(P[B_+2], P[B_+3]);                          \
        unsigned b0 = cvtpk(P[B_+4], P[B_+5]), b1 = cvtpk(P[B_+6], P[B_+7]);                                             \
        auto r0 = __builtin_amdgcn_permlane32_swap(a0, b0, false, false); auto r1 = __builtin_amdgcn_permlane32_swap(a1, b1, false, false); \
        u32x4 w = {r0[0], r1[0], r0[1], r1[1]}; OUT = *reinterpret_cast<bf16x8*>(&w); } while (0)
    PK4(p0, 0, pa0); PK4(p0, 8, pa1); PK4(p1, 0, pa2); PK4(p1, 8, pa3);
#undef PK4
}
template <int KB, bool SK>
__device__ __forceinline__ void qkt(f32x16& p0, f32x16& p1, const char* K_lds, int r32, int hi, const bf16x8* qr, bool act) {
    if (SK && !act) { const float NEG = -__builtin_inff();
#pragma unroll
        for (int r = 0; r < 16; ++r) { p0[r] = NEG; p1[r] = NEG; } return; }
    p0 = f32x16{}; p1 = f32x16{};
    const char* kb[4];
#pragma unroll
    for (int dd = 0; dd < 4; ++dd) kb[dd] = K_lds + KB * SHM_K + KSWZ(r32, (dd * 16 + hi * 8) * 2);
#pragma unroll
    for (int d0 = 0; d0 < 8; ++d0) { const char* a = kb[d0 & 3] + (d0 >> 2) * 128;
        bf16x8 b0 = *reinterpret_cast<const bf16x8*>(a);
        bf16x8 b1 = *reinterpret_cast<const bf16x8*>(a + 32 * 256);
        p0 = __builtin_amdgcn_mfma_f32_32x32x16_bf16(b0, qr[d0], p0, 0, 0, 0);
        p1 = __builtin_amdgcn_mfma_f32_32x32x16_bf16(b1, qr[d0], p1, 0, 0, 0); }
}
template <int VB, bool SK>
__device__ __forceinline__ void pv_tile(f32x16* o, int vb0, bf16x8 pa0, bf16x8 pa1, bf16x8 pa2, bf16x8 pa3, bool act) {
    if (SK && !act) return;
#define TRRD(dst, off) asm volatile("ds_read_b64_tr_b16 %0, %1 offset:%2" : "=&v"(dst) : "v"(vb0), "i"(off) : "memory")
#define PV_D0(d0) do { s16x4 l0, l1, l2, l3, h0, h1, h2, h3; constexpr int b_ = VB * SHM_V + v_rd_off(d0, 0, 0);     \
        TRRD(l0, b_); TRRD(h0, b_ + 2048); TRRD(l1, b_ + 4096); TRRD(h1, b_ + 6144); TRRD(l2, b_ + 8192); TRRD(h2, b_ + 10240); TRRD(l3, b_ + 12288); TRRD(h3, b_ + 14336); \
        asm volatile("s_waitcnt lgkmcnt(0)" ::: "memory"); SBAR();                 \
        o[d0] = __builtin_amdgcn_mfma_f32_32x32x16_bf16(pa0, (bf16x8){l0[0], l0[1], l0[2], l0[3], h0[0], h0[1], h0[2], h0[3]}, o[d0], 0, 0, 0);   \
        o[d0] = __builtin_amdgcn_mfma_f32_32x32x16_bf16(pa1, (bf16x8){l1[0], l1[1], l1[2], l1[3], h1[0], h1[1], h1[2], h1[3]}, o[d0], 0, 0, 0);   \
        o[d0] = __builtin_amdgcn_mfma_f32_32x32x16_bf16(pa2, (bf16x8){l2[0], l2[1], l2[2], l2[3], h2[0], h2[1], h2[2], h2[3]}, o[d0], 0, 0, 0);   \
        o[d0] = __builtin_amdgcn_mfma_f32_32x32x16_bf16(pa3, (bf16x8){l3[0], l3[1], l3[2], l3[3], h3[0], h3[1], h3[2], h3[3]}, o[d0], 0, 0, 0); } while (0)
    PV_D0(0); PV_D0(1); PV_D0(2); PV_D0(3);
#undef PV_D0
#undef TRRD
}

template <class TIn, class TOut> struct BlockRef { const TIn* Q; const TIn* K; const TIn* V; TOut* O; float* L; int P0, pitch, opitch, lpitch, nq; };
template <class TIn> struct Seam {
    bf16x8 qr[8];
    bf16x8 st_v0, st_v1, st_k0, st_k1; f32x4 sf0, sf1, sf2, sf3;
    f32x4 tq[16];
};
__device__ __forceinline__ int swa_jlo(int P0, int W) { const int lowk = P0 - W + 1; return lowk > 0 ? lowk / KVBLK : 0; }
#define ROW(p, k0, rr) ((p) + (size_t)((k0) + (rr)) * PITCH_ + sc)
#define VMW() asm volatile("s_waitcnt vmcnt(0)" ::: "memory")
#define VMWN(n) asm volatile("s_waitcnt vmcnt(%0)" :: "i"(n) : "memory")
#define SLOAD_H(Kp, Vp, k0) do { S.st_v0 = load8<TIn>(ROW(Vp, k0, sr)); S.st_v1 = load8<TIn>(ROW(Vp, k0, 32 + sr));              \
                         S.st_k0 = load8<TIn>(ROW(Kp, k0, sr)); S.st_k1 = load8<TIn>(ROW(Kp, k0, 32 + sr)); } while (0)
#define SWRITE_HK(bf) do { *(bf16x8*)(K_lds + (bf) * SHM_K + kws) = S.st_k0; *(bf16x8*)(K_lds + (bf) * SHM_K + kws + 32 * 256) = S.st_k1; } while (0)
#define SWRITE_HV(bf) do { *(bf16x8*)(V_lds + (bf) * SHM_V + vst0) = S.st_v0; *(bf16x8*)(V_lds + (bf) * SHM_V + vst1) = S.st_v1; } while (0)
#define SWRITE_H(bf) do { SWRITE_HV(bf); SWRITE_HK(bf); } while (0)
#define SLOAD_F(p, k0) do { S.sf0 = *(const f32x4*)ROW(p, k0, sr); S.sf1 = *(const f32x4*)(ROW(p, k0, sr) + 4);                \
                            S.sf2 = *(const f32x4*)ROW(p, k0, 32 + sr); S.sf3 = *(const f32x4*)(ROW(p, k0, 32 + sr) + 4); } while (0)
#define SWRITE_KF(bf) do { *(bf16x8*)(K_lds + (bf) * SHM_K + kws) = pack8(S.sf0, S.sf1); *(bf16x8*)(K_lds + (bf) * SHM_K + kws + 32 * 256) = pack8(S.sf2, S.sf3); } while (0)
#define SWRITE_VF(bf) do { *(bf16x8*)(V_lds + (bf) * SHM_V + vst0) = pack8(S.sf0, S.sf1); *(bf16x8*)(V_lds + (bf) * SHM_V + vst1) = pack8(S.sf2, S.sf3); } while (0)
template <class TIn, class TOut>
__device__ __forceinline__ void causal_swa_prime(const BlockRef<TIn, TOut>& cur, int W, char* lds, Seam<TIn>& S) {
    constexpr bool F32 = same_t<TIn, float>::v;
    const int tid = tid_opaque(), wid = __builtin_amdgcn_readfirstlane(tid >> 6), lane = tid & 63, r32 = lane & 31, hi = lane >> 5;
    const int sr = tid >> 4, sc = (tid & 15) * 8, kws = KSWZ(sr, sc * 2); char* K_lds = lds + 2 * SHM_V;
    const int kb0 = swa_jlo(cur.P0, W) * KVBLK;
    const int PITCH_ = cur.pitch; const int qrow_ = (wid * QBLK + r32 < cur.nq) ? wid * QBLK + r32 : cur.nq - 1;
    for (int d0 = 0; d0 < 8; ++d0) S.qr[d0] = load8<TIn>(cur.Q + (size_t)qrow_ * PITCH_ + d0 * 16 + hi * 8);
    if constexpr (F32) { SLOAD_F((const float*)cur.K, kb0); VMW(); SWRITE_KF(0); SBAR(); SLOAD_F((const float*)cur.V, kb0); }
    else { SLOAD_H(cur.K, cur.V, kb0); VMW(); SWRITE_HK(0); }
    __syncthreads();
}
template <class TIn, class TOut>
__device__ __forceinline__ void causal_swa_block(const BlockRef<TIn, TOut>& cur, const BlockRef<TIn, TOut>& nxt, int skv, int W, char* lds, Seam<TIn>& S) {
    constexpr bool F32 = same_t<TIn, float>::v;
    const int tid = tid_opaque(), wid = __builtin_amdgcn_readfirstlane(tid >> 6), lane = tid & 63, r32 = lane & 31, hi = lane >> 5;
    int PITCH_ = cur.pitch; const bool wact = (wid * QBLK < cur.nq);
    const int j_lo = swa_jlo(cur.P0, W);
    int j_hi = (cur.P0 + QB - 1) / KVBLK + 1; if (j_hi > skv / KVBLK) j_hi = skv / KVBLK;
    const int NT = j_hi - j_lo;
    const int kbn = swa_jlo(nxt.P0, W) * KVBLK;
    const int qlo = cur.P0 + wid * QBLK, qm = qlo + r32 - 4 * hi;
    char* V_lds = lds; char* K_lds = lds + 2 * SHM_V;
    float* ws = (float*)(lds + 2 * SHM_V + 2 * SHM_K) + wid * 64; float* li_l = ws, * al_l = ws + 32;
    float m_reg = -1e30f, l_reg = 0; f32x16 o[4] = {};
    const int sr = tid >> 4, sc = (tid & 15) * 8, vst0 = v_st(sr, sc), vst1 = v_st(32 + sr, sc), kws = KSWZ(sr, sc * 2);
    const int vb0 = (int)(uintptr_t)V_lds + v_rd_base(lane);
    const TIn* Kh = cur.K; const TIn* Vh = cur.V;
#define RESC(a) do { if (__any((a) < 1.f)) { if (hi == 0) al_l[r32] = (a); asm volatile("s_waitcnt lgkmcnt(0)" ::: "memory");              \
                     for (int d_ = 0; d_ < 4; ++d_) for (int r = 0; r < 16; ++r) o[d_][r] *= al_l[crow(r, hi)]; } } while (0)
#define KBASE(t) ((j_lo + (t)) * KVBLK)
#define ACT(t) (wact && KBASE(t) <= qlo + QBLK - 1 && KBASE(t) + KVBLK - 1 >= qlo - W + 1)
#define MASKT(P0_, P1_, t) do { const int kb_ = KBASE(t); if ((!SK || ACT(t)) && (kb_ + KVBLK - 1 > qlo || kb_ <= qlo + QBLK - 1 - W)) mask_tile(P0_, P1_, qm - kb_, (unsigned)W); } while (0)
    constexpr int NQL = F32 ? 16 : 8;
    constexpr bool SK = WSKIP && !F32;
#define SEAM_K0() do { VMWN(NQL); if constexpr (F32) { SWRITE_KF(0); SBAR(); SLOAD_F((const float*)nxt.V, kbn); } else { SWRITE_HK(0); } SBAR(); } while (0)
    f32x16 pA0, pA1, pB0, pB1; float mnA, mnB, alA, alB; bf16x8 pa0, pa1, pa2, pa3;
    if constexpr (F32) { VMW(); SWRITE_VF(0); SBAR(); } else { SWRITE_HV(0); SBAR(); }
    if (NT > 1) { if constexpr (F32) SLOAD_F((const float*)Kh, KBASE(1)); else SLOAD_H(Kh, Vh, KBASE(1)); }
    SBAR(); qkt<0, SK>(pA0, pA1, K_lds, r32, hi, S.qr, ACT(0));
    if constexpr (F32) { if (NT > 1) { VMW(); SWRITE_KF(1); SBAR(); SLOAD_F((const float*)Vh, KBASE(1)); } }
    MASKT(pA0, pA1, 0); partialSM(pA0, pA1, m_reg, mnA, alA);
    if (NT > 1) { VMW(); if constexpr (F32) { SWRITE_VF(1); SBAR(); if (NT > 2) SLOAD_F((const float*)Kh, KBASE(2)); } else SWRITE_H(1); }
    __syncthreads();
#define HALF_STEP(PX0, PX1, mnX, alX, PY0, PY1, alY, t, KB, VB, SB) do {                                                      \
        SBAR(); qkt<KB, SK>(PX0, PX1, K_lds, r32, hi, S.qr, ACT(t));                                             \
        finishSM(PY0, PY1, alY, l_reg, pa0, pa1, pa2, pa3); SBAR();                                                           \
        if ((t) + 1 < NT) { if constexpr (F32) { VMW(); SWRITE_KF(SB); SBAR(); SLOAD_F((const float*)Vh, KBASE((t) + 1)); }  \
                            else { SLOAD_H(Kh, Vh, KBASE((t) + 1)); } SBAR(); }                                               \
        pv_tile<VB, SK>(o, vb0, pa0, pa1, pa2, pa3, ACT((t) - 1)); MASKT(PX0, PX1, (t)); partialSM(PX0, PX1, m_reg, mnX, alX);                                        \
        __syncthreads();                                                                                                      \
        if ((t) + 1 < NT) { VMW(); if constexpr (F32) { SWRITE_VF(SB); SBAR(); if ((t) + 2 < NT) SLOAD_F((const float*)Kh, KBASE((t) + 2)); } \
                            else { SWRITE_H(SB); } }                                                                          \
        RESC(alX); __syncthreads(); } while (0)
    for (int t = 1; t + 1 < NT; t += 2) {
        HALF_STEP(pB0, pB1, mnB, alB, pA0, pA1, alA, t, 1, 0, 0);
        HALF_STEP(pA0, pA1, mnA, alA, pB0, pB1, alB, t + 1, 0, 1, 1);
    }
    const bool even = (NT & 1) == 0;
    if (even) { SBAR(); qkt<1, SK>(pB0, pB1, K_lds, r32, hi, S.qr, ACT(NT - 1)); SBAR(); }
#define QROW(e) (nxt.Q + (size_t)(wid * QBLK + r32) * D + ((e) >> 1) * 16 + hi * 8 + ((e) & 1) * 4)
    if constexpr (F32) { SLOAD_F((const float*)nxt.K, kbn); SBAR();
#pragma unroll
        for (int e = 0; e < 8; ++e) S.tq[e] = *(const f32x4*)QROW(e); }
    else { PITCH_ = nxt.pitch; SLOAD_H(nxt.K, nxt.V, kbn); SBAR();
        const int qrow_ = (wid * QBLK + r32 < nxt.nq) ? wid * QBLK + r32 : nxt.nq - 1;
#pragma unroll
        for (int d0 = 0; d0 < 8; ++d0) S.qr[d0] = load8<TIn>(nxt.Q + (size_t)qrow_ * PITCH_ + d0 * 16 + hi * 8); }
    SBAR();
    finishSM(pA0, pA1, alA, l_reg, pa0, pa1, pa2, pa3); SBAR();
    if constexpr (F32) {
#pragma unroll
        for (int e = 8; e < 16; ++e) S.tq[e] = *(const f32x4*)QROW(e); SBAR(); }
#undef QROW
    pv_tile<0, SK>(o, vb0, pa0, pa1, pa2, pa3, ACT(even ? NT - 2 : NT - 1));
    if (even) { MASKT(pB0, pB1, NT - 1); partialSM(pB0, pB1, m_reg, mnB, alB); __syncthreads(); RESC(alB);
        finishSM(pB0, pB1, alB, l_reg, pa0, pa1, pa2, pa3); SBAR(); pv_tile<1, SK>(o, vb0, pa0, pa1, pa2, pa3, ACT(NT - 1)); }
    SBAR(); SEAM_K0();
    if (hi == 0) li_l[r32] = l_reg; asm volatile("s_waitcnt lgkmcnt(0)" ::: "memory");
    float rli[16];
#pragma unroll
    for (int r = 0; r < 16; ++r) rli[r] = __builtin_amdgcn_rcpf(li_l[crow(r, hi)]);
    const int OP_ = cur.opitch; TOut* Ow = cur.O + (size_t)(wid * QBLK) * OP_;
    if (wact) {
    if (hi == 0) cur.L[(size_t)(wid * QBLK + r32) * cur.lpitch] = m_reg * (1.4426950408889634f * SCALE) + __builtin_amdgcn_logf(l_reg);
#pragma unroll
    for (int r = 0; r < 16; ++r) { const int orow = crow(r, hi);
#pragma unroll
        for (int d0 = 0; d0 < 4; ++d0) { const float v = o[d0][r] * rli[r];
            if constexpr (same_t<TOut, float>::v) { Ow[(size_t)orow * OP_ + d0 * 32 + r32] = v; }
            else { const float vn = __builtin_bit_cast(float, __builtin_amdgcn_mov_dpp(__builtin_bit_cast(int, v), 0xB1, 0xF, 0xF, true));
                   if ((r32 & 1) == 0) *(unsigned*)(Ow + (size_t)orow * OP_ + d0 * 32 + r32) = cvtpk(v, vn); } } }
    }
    if constexpr (F32) {
#pragma unroll
        for (int d0 = 0; d0 < 8; ++d0) S.qr[d0] = pack8(S.tq[2 * d0], S.tq[2 * d0 + 1]); }
    __syncthreads();
#undef RESC
#undef KBASE
#undef ACT
#undef MASKT
#undef SEAM_K0
#undef HALF_STEP
}
#undef ROW
#undef VMW
#undef VMWN
#undef SLOAD_H
#undef SWRITE_HK
#undef SWRITE_HV
#undef SWRITE_H
#undef SLOAD_F
#undef SWRITE_KF
#undef SWRITE_VF

typedef BlockRef<bf16_t, bf16_t> Ref;
}
#undef KSWZ

__device__ __forceinline__ swa::Ref attn_ref(unsigned char* ws, int L, int& skv) {
    int gi, b, h, c, qb;
    if (L < 256) { gi = 0; b = L >> 5; h = (L >> 3) & 3; qb = L & 7; c = 0; }
    else if (L < 512) { L -= 256; gi = 1; b = L >> 5; h = (L >> 3) & 3; c = (L >> 1) & 3; qb = L & 1; }
    else { L -= 512; gi = 2; b = L >> 6; h = (L >> 4) & 3; c = L & 15; qb = 0; }
    const int d = gi == 0 ? 1 : (gi == 1 ? 4 : 16);
    const bf16_t* base = (const bf16_t*)(ws + OFF_PROJ) + ((size_t)b * SEQ + c) * IN_COLS + (gi * 4 + h) * HD;
    const size_t tok0 = (size_t)b * SEQ + c + (size_t)qb * 256 * d;
    swa::Ref r;
    r.Q = base + C_Q + (size_t)qb * 256 * d * IN_COLS; r.K = base + C_K; r.V = base + C_V;
    r.O = (bf16_t*)(ws + OFF_AO) + ((size_t)gi * MTOK + tok0) * ATT_W + h * HD; r.opitch = d * ATT_W;
    r.L = (float*)(ws + OFF_ALSE) + ((size_t)gi * MTOK + tok0) * 4 + h; r.lpitch = d * 4;
    r.P0 = qb * 256; r.pitch = d * IN_COLS; r.nq = gi == 2 ? 128 : 256;
    skv = SEQ / d;
    return r;
}
constexpr int N_ATTN_BLOCKS = 1024;
__device__ __forceinline__ void attn_phase(const Frame& F, unsigned char* ws) {
    int L = F.vcu; if (L >= N_ATTN_BLOCKS) return;
    char* lds = (char*)F.lds;
    int skv, skvn; swa::Ref cur = attn_ref(ws, L, skv);
    swa::Seam<bf16_t> S;
    swa::causal_swa_prime<bf16_t, bf16_t>(cur, 129, lds, S);
    for (;;) {
        const int Ln = L + F.G; const bool last = Ln >= N_ATTN_BLOCKS;
        swa::Ref nxt = cur; skvn = skv; if (!last) nxt = attn_ref(ws, Ln, skvn);
        swa::causal_swa_block<bf16_t, bf16_t>(cur, nxt, skv, 129, lds, S);
        if (last) break;
        cur = nxt; skv = skvn; L = Ln;
    }
}

namespace s5 {
constexpr size_t T_WST = 2 * MiB;
constexpr size_t T_WO = 10 * MiB;
constexpr size_t T_KT = 18 * MiB;
constexpr size_t T_A16 = 20 * MiB;
constexpr int RSTR = 528;
constexpr int U_OFF = 0, L_OFF = 128 * RSTR;
constexpr int LDS_NEED = 2 * 128 * RSTR;
__device__ __forceinline__ void tables_wg(const Args& a, LAS unsigned char* lds, int lg) {
    typedef float f32x2 __attribute__((ext_vector_type(2)));
    LAS f32x2* PW = (LAS f32x2*)lds; LAS f32x2* BB = PW + 17 * 64; LAS f32x2* CT = BB + 64 * 16;
    const int tid = tid_opaque(); unsigned char* ws = a.p.ws;
    if (tid < 64) {
        const int idx = lg * 64 + tid;
        const float lre = fminf(inptr(a, IN_LRE)[idx], -1e-4f), lim = inptr(a, IN_LIM)[idx], dt = expf(inptr(a, IN_LDT)[lg]);
        const float ar = lre * dt, b = lim * dt, ea = expf(ar), sb = sinf(b), cb = cosf(b);
        const float Are = ea * cb, Aim = ea * sb, sh = sinf(0.5f * b);
        const float Dre = expm1f(ar) * cb - 2.0f * sh * sh, Dim = Aim;
        const float den = lre * lre + lim * lim;
        const float cre = (Dre * lre + Dim * lim) / den, cim = (Dim * lre - Dre * lim) / den;
        float* A = (float*)(ws + OFF_S5 + S5_A); float* Bb = (float*)(ws + OFF_S5 + S5_BB);
        A[idx * 2] = Are; A[idx * 2 + 1] = Aim;
        const float* bre = inptr(a, IN_BRE) + idx * 16; const float* bim = inptr(a, IN_BIM) + idx * 16;
        for (int c = 0; c < 16; ++c) { const float br = bre[c], bi = bim[c]; const f32x2 v = {cre * br - cim * bi, cre * bi + cim * br};
            Bb[(idx * 16 + c) * 2] = v.x; Bb[(idx * 16 + c) * 2 + 1] = v.y; BB[tid * 16 + c] = v; }
        float pr = 1.f, pi = 0.f;
        for (int k = 0; k <= 16; ++k) { PW[k * 64 + tid] = (f32x2){pr, pi}; const float nr = pr * Are - pi * Aim, ni = pr * Aim + pi * Are; pr = nr; pi = ni; }
        const f32x2 a16 = PW[16 * 64 + tid];
        ((f32x2*)(ws + OFF_S5 + T_A16))[idx] = a16;
    } else {
        const float* cr = inptr(a, IN_CRE) + (size_t)lg * 1024; const float* ci = inptr(a, IN_CIM) + (size_t)lg * 1024;
        for (int e = tid - 64; e < 1024; e += NTHREADS - 64) { const int c = e >> 6, pp = e & 63; CT[pp * 16 + c] = (f32x2){cr[e], ci[e]}; }
    }
    __syncthreads();
    bf16_t* WST = (bf16_t*)(ws + OFF_S5 + T_WST) + (size_t)lg * 128 * 256;
    for (int e = tid; e < 4096; e += NTHREADS) {
        const int i = e >> 5, kk0 = (e & 31) * 8, s = kk0 >> 4, c0 = kk0 & 15, pp = i & 63; const bool im = i >= 64;
        const f32x2 w = PW[(15 - s) * 64 + pp]; float v[8];
#pragma unroll
        for (int j = 0; j < 8; ++j) { const f32x2 bb = BB[pp * 16 + c0 + j]; v[j] = im ? (w.x * bb.y + w.y * bb.x) : (w.x * bb.x - w.y * bb.y); }
        u32x4 o; o.x = pk2(v[0], v[1]); o.y = pk2(v[2], v[3]); o.z = pk2(v[4], v[5]); o.w = pk2(v[6], v[7]);
        *(u32x4*)(WST + (size_t)i * 256 + kk0) = o;
    }
    bf16_t* WO = (bf16_t*)(ws + OFF_S5 + T_WO) + (size_t)lg * 256 * 128;
    for (int e = tid; e < 4096; e += NTHREADS) {
        const int row = e >> 4, i0 = (e & 15) * 8, t = row >> 4, c = row & 15; float v[8];
#pragma unroll
        for (int j = 0; j < 8; ++j) { const int ip = i0 + j, pp = ip & 63; const f32x2 cc = CT[pp * 16 + c], w = PW[(t + 1) * 64 + pp];
            v[j] = ip < 64 ? (cc.x * w.x - cc.y * w.y) : -(cc.x * w.y + cc.y * w.x); }
        u32x4 o; o.x = pk2(v[0], v[1]); o.y = pk2(v[2], v[3]); o.z = pk2(v[4], v[5]); o.w = pk2(v[6], v[7]);
        *(u32x4*)(WO + (size_t)row * 128 + i0) = o;
    }
    bf16_t* KT = (bf16_t*)(ws + OFF_S5 + T_KT) + (size_t)lg * 17 * 256;
    { const int la = tid >> 5, c = (tid >> 1) & 15, h = tid & 1; float acc[8];
#pragma unroll
      for (int j = 0; j < 8; ++j) acc[j] = 0.f;
      for (int pp = 0; pp < 64; ++pp) { const f32x2 cc = CT[pp * 16 + c], w = PW[la * 64 + pp]; const float zr = cc.x * w.x - cc.y * w.y, zi = cc.x * w.y + cc.y * w.x;
#pragma unroll
          for (int j = 0; j < 8; ++j) { const f32x2 bb = BB[pp * 16 + 8 * h + j]; acc[j] += zr * bb.x - zi * bb.y; } }
      u32x4 o; o.x = pk2(acc[0], acc[1]); o.y = pk2(acc[2], acc[3]); o.z = pk2(acc[4], acc[5]); o.w = pk2(acc[6], acc[7]);
      *(u32x4*)(KT + ((la + 1) * 16 + c) * 16 + 8 * h) = o;
      if (tid < 32) { unsigned z_ = 0u; asm volatile("" : "+v"(z_)); *(u32x4*)(KT + tid * 8) = (u32x4){z_, z_, z_, z_}; } }
    __syncthreads();
}
__device__ __forceinline__ void unit(LAS unsigned char* lds, unsigned char* ws, int layer, int b, int g) {
    int tid_ = threadIdx.x; asm volatile("" : "+v"(tid_));
    const int tid = tid_, wave = __builtin_amdgcn_readfirstlane(tid >> 6), lane = tid & 63, q = lane >> 4, r16 = lane & 15;
    const int lg = layer * 32 + g;
    const bf16_t* usrc = (const bf16_t*)(ws + OFF_PROJ) + (size_t)b * SEQ * IN_COLS + C_US + g * 16;
#pragma unroll
    for (int k = 0; k < 8; ++k) { const int piece = tid + NTHREADS * k, tok = piece >> 1, half = piece & 1;
        const bf16x8 v = *(const bf16x8*)(usrc + (size_t)tok * IN_COLS + half * 8);
        *(LAS bf16x8*)(lds + U_OFF + (tok >> 4) * RSTR + (tok & 15) * 32 + half * 16) = v; }
    __syncthreads();
    { const bf16_t* W = (const bf16_t*)(ws + OFF_S5 + T_WST) + ((size_t)lg * 128 + wave * 16 + r16) * 256 + 8 * q;
      bf16x8 af[8];
#pragma unroll
      for (int ks = 0; ks < 8; ++ks) af[ks] = *(const bf16x8*)(W + ks * 32);
      for (int nt = 0; nt < 8; ++nt) {
          f32x4 acc = {0.f, 0.f, 0.f, 0.f};
          const LAS unsigned char* ub = lds + U_OFF + (nt * 16 + r16) * RSTR + q * 16;
#pragma unroll
          for (int ks = 0; ks < 8; ++ks) acc = __builtin_amdgcn_mfma_f32_16x16x32_bf16(af[ks], *(const LAS bf16x8*)(ub + ks * 64), acc, 0, 0, 0);
          *(LAS f32x4*)(lds + L_OFF + (nt * 16 + r16) * RSTR + (wave * 16 + 4 * q) * 4) = acc;
      } }
    __syncthreads();
    if (wave == 0) {
        typedef float f32x2 __attribute__((ext_vector_type(2)));
        const f32x2 a16 = ((const f32x2*)(ws + OFF_S5 + T_A16))[lg * 64 + lane];
        float sre = 0.f, sim = 0.f;
        for (int j = 0; j < 128; ++j) {
            LAS float* row = (LAS float*)(lds + L_OFF + j * RSTR);
            const float lre = row[lane], lim = row[64 + lane];
            asm volatile("s_waitcnt lgkmcnt(0)" ::: "memory");
            ((LAS bf16_t*)row)[lane] = f2bf(sre); ((LAS bf16_t*)row)[64 + lane] = f2bf(sim);
            const float nre = a16.x * sre - a16.y * sim + lre, nim = a16.x * sim + a16.y * sre + lim; sre = nre; sim = nim;
        }
    }
    __syncthreads();
    { const bf16_t* KT = (const bf16_t*)(ws + OFF_S5 + T_KT) + (size_t)lg * 17 * 256;
      const bf16_t* WO = (const bf16_t*)(ws + OFF_S5 + T_WO) + (size_t)lg * 256 * 128;
      bf16_t* ypre = (bf16_t*)(ws + OFF_YPRE) + (size_t)b * SEQ * SSM_W + g * 16 + 4 * q;
#pragma unroll 1
      for (int tt = 0; tt < 2; ++tt) {
          const int t = tt ? 15 - wave : wave, nks = (t >> 1) + 1;
          bf16x8 kf[8], wf[4];
#pragma unroll
          for (int ks = 0; ks < 8; ++ks) { const int lag1 = t - (2 * ks + (q >> 1)) + 1; kf[ks] = *(const bf16x8*)(KT + ((lag1 > 0 ? lag1 : 0) * 16 + r16) * 16 + 8 * (q & 1)); }
#pragma unroll
          for (int k2 = 0; k2 < 4; ++k2) wf[k2] = *(const bf16x8*)(WO + (size_t)(t * 16 + r16) * 128 + k2 * 32 + 8 * q);
          for (int nt = 0; nt < 8; ++nt) {
              f32x4 acc = {0.f, 0.f, 0.f, 0.f};
              const LAS unsigned char* ub = lds + U_OFF + (nt * 16 + r16) * RSTR + q * 16;
              const LAS unsigned char* sb = lds + L_OFF + (nt * 16 + r16) * RSTR + q * 16;
#pragma unroll
              for (int ks = 0; ks < 8; ++ks) if (ks < nks) acc = __builtin_amdgcn_mfma_f32_16x16x32_bf16(kf[ks], *(const LAS bf16x8*)(ub + ks * 64), acc, 0, 0, 0);
#pragma unroll
              for (int k2 = 0; k2 < 4; ++k2) acc = __builtin_amdgcn_mfma_f32_16x16x32_bf16(wf[k2], *(const LAS bf16x8*)(sb + k2 * 64), acc, 0, 0, 0);
              const int tok = 16 * (nt * 16 + r16) + t;
              *(unsigned long long*)(ypre + (size_t)tok * SSM_W) = (unsigned long long)pk2(acc[0], acc[1]) | ((unsigned long long)pk2(acc[2], acc[3]) << 32);
          }
      } }
    __syncthreads();
}
}


namespace p4 {
constexpr int XS5 = 1040, XS10 = 2064;
constexpr int R0 = 0, R1 = 64 * XS5;
constexpr int RED_OFF = 2 * 64 * XS5, RED2_OFF = RED_OFF + 2048;
static_assert(64 * XS10 <= RED_OFF && RED2_OFF + 2048 <= MISC_OFF, "P4 LDS map");
constexpr size_t OFF_MG = OFF_T4;
typedef unsigned u32x2 __attribute__((ext_vector_type(2)));

template <int NB, int KS, int NSTEPS>
__device__ __forceinline__ void sk_gemm(f32x4 (&acc)[4][NB], const LAS unsigned char* X, int xs, const bf16_t* W, int ldw, int r16, int q) {
    static_assert(NSTEPS % 2 == 0, "even step count");
    const unsigned voff = (unsigned)(r16 * ldw + 8 * q) * 2u;
    const LAS unsigned char* xp = X + r16 * xs + q * 16;
    bf16x8 w0[KS][NB], w1[KS][NB];
#define SK_LOAD(wb, st) do { _Pragma("unroll") for (int kk = 0; kk < KS; ++kk) _Pragma("unroll") for (int n = 0; n < NB; ++n) wb[kk][n] = *(const bf16x8*)((const char*)(W + (size_t)(n * 16) * ldw + ((st) * KS + kk) * 32) + voff); } while (0)
#define SK_COMP(wb, st) do { _Pragma("unroll") for (int kk = 0; kk < KS; ++kk) { bf16x8 xf[4]; _Pragma("unroll") for (int m = 0; m < 4; ++m) xf[m] = *(const LAS bf16x8*)(xp + m * 16 * xs + ((st) * KS + kk) * 64); \
        _Pragma("unroll") for (int m = 0; m < 4; ++m) _Pragma("unroll") for (int n = 0; n < NB; ++n) acc[m][n] = __builtin_amdgcn_mfma_f32_16x16x32_bf16(wb[kk][n], xf[m], acc[m][n], 0, 0, 0); } } while (0)
    SK_LOAD(w0, 0);
#pragma unroll 1
    for (int st = 0; st < NSTEPS; st += 2) {
        SK_LOAD(w1, st + 1); __builtin_amdgcn_sched_barrier(0);
        SK_COMP(w0, st); __builtin_amdgcn_sched_barrier(0);
        if (st + 2 < NSTEPS) SK_LOAD(w0, st + 2);
        __builtin_amdgcn_sched_barrier(0);
        SK_COMP(w1, st + 1); __builtin_amdgcn_sched_barrier(0);
    }
#undef SK_LOAD
#undef SK_COMP
}
__device__ __forceinline__ float sig_fast(float v) { return __builtin_amdgcn_rcpf(1.0f + __builtin_amdgcn_exp2f(-1.4426950408889634f * v)); }
__device__ __forceinline__ float gelu_fast(float x) {
    const float z2 = 1.5957691216057308f * (x + 0.044715f * x * x * x);
    return x * sig_fast(z2);
}
__device__ __forceinline__ float blo(unsigned w) { return __uint_as_float(w << 16); }
__device__ __forceinline__ float bhi(unsigned w) { return __uint_as_float(w & 0xffff0000u); }
__device__ __forceinline__ float sum_q(float v) {
    v += __builtin_bit_cast(float, __builtin_amdgcn_ds_swizzle(__builtin_bit_cast(int, v), 0x401F));
    const auto rr = __builtin_amdgcn_permlane32_swap(__float_as_uint(v), __float_as_uint(v), false, false);
    return __uint_as_float(rr[0]) + __uint_as_float(rr[1]);
}

__device__ __forceinline__ void unit(const Args& a, LAS unsigned char* lds, unsigned char* ws, int layer, int u) {
    const int tid = tid_opaque(), wave = __builtin_amdgcn_readfirstlane(tid >> 6), lane = tid & 63, q = lane >> 4, r16 = lane & 15;
    const size_t row0 = (size_t)u * 64;
    const bf16_t* proj = (const bf16_t*)(ws + OFF_PROJ);
    {
        const int cc = (tid & 63) * 8, rb = tid >> 6, j = cc >> 7;
        const float* dsk = inptr(a, IN_DSKIP) + layer * SSM_W + cc;
        const f32x4 d0 = *(const f32x4*)dsk, d1 = *(const f32x4*)(dsk + 4);
        const bf16_t* ypre = (const bf16_t*)(ws + OFF_YPRE); const bf16_t* ao = (const bf16_t*)(ws + OFF_AO); const float* ls = (const float*)(ws + OFF_ALSE);
#pragma unroll 2
        for (int k = 0; k < 8; ++k) {
            const int row = rb + 8 * k; const size_t tok = row0 + row;
            const u32x4 yp = *(const u32x4*)(ypre + tok * SSM_W + cc), uu = *(const u32x4*)(proj + tok * IN_COLS + C_US + cc);
            u32x4 o;
            o.x = pk2(gelu_fast(blo(yp.x) + d0[0] * blo(uu.x)), gelu_fast(bhi(yp.x) + d0[1] * bhi(uu.x)));
            o.y = pk2(gelu_fast(blo(yp.y) + d0[2] * blo(uu.y)), gelu_fast(bhi(yp.y) + d0[3] * bhi(uu.y)));
            o.z = pk2(gelu_fast(blo(yp.z) + d1[0] * blo(uu.z)), gelu_fast(bhi(yp.z) + d1[1] * bhi(uu.z)));
            o.w = pk2(gelu_fast(blo(yp.w) + d1[2] * blo(uu.w)), gelu_fast(bhi(yp.w) + d1[3] * bhi(uu.w)));
            *(LAS u32x4*)(lds + R0 + row * XS5 + cc * 2) = o;
            const float l0 = ls[((size_t)0 * MTOK + tok) * 4 + j], l1 = ls[((size_t)1 * MTOK + tok) * 4 + j], l2 = ls[((size_t)2 * MTOK + tok) * 4 + j];
            const float mx = fmaxf(l0, fmaxf(l1, l2)); float w0 = __builtin_amdgcn_exp2f(l0 - mx), w1 = __builtin_amdgcn_exp2f(l1 - mx), w2 = __builtin_amdgcn_exp2f(l2 - mx);
            const float iw = __builtin_amdgcn_rcpf(w0 + w1 + w2); w0 *= iw; w1 *= iw; w2 *= iw;
            const u32x4 a0 = *(const u32x4*)(ao + ((size_t)0 * MTOK + tok) * ATT_W + cc), a1 = *(const u32x4*)(ao + ((size_t)1 * MTOK + tok) * ATT_W + cc), a2 = *(const u32x4*)(ao + ((size_t)2 * MTOK + tok) * ATT_W + cc);
            const u32x4 za = *(const u32x4*)(proj + tok * IN_COLS + C_ZA + cc);
#define MRG(A0, A1, A2, Z) pk2((w0 * blo(A0) + w1 * blo(A1) + w2 * blo(A2)) * blo(Z), (w0 * bhi(A0) + w1 * bhi(A1) + w2 * bhi(A2)) * bhi(Z))
            u32x4 y; y.x = MRG(a0.x, a1.x, a2.x, za.x); y.y = MRG(a0.y, a1.y, a2.y, za.y); y.z = MRG(a0.z, a1.z, a2.z, za.z); y.w = MRG(a0.w, a1.w, a2.w, za.w);
#undef MRG
            *(LAS u32x4*)(lds + R1 + row * XS5 + cc * 2) = y;
        }
    }
    __syncthreads();
    {
        f32x4 acc[4][4];
#pragma unroll
        for (int m = 0; m < 4; ++m)
#pragma unroll
            for (int n = 0; n < 4; ++n) acc[m][n] = (f32x4){0.f, 0.f, 0.f, 0.f};
        const int nb = wave * 64;
        sk_gemm<4, 2, 8>(acc, lds + R0, XS5, (const bf16_t*)(ws + OFF_WGLU) + (size_t)layer * SSM_W * SSM_W + (size_t)nb * SSM_W, SSM_W, r16, q);
        __syncthreads();
        const float* bg = inptr(a, IN_BGLU) + layer * SSM_W;
#pragma unroll
        for (int n = 0; n < 4; ++n) {
            const int col = nb + n * 16 + 4 * q; const f32x4 b4 = *(const f32x4*)(bg + col);
#pragma unroll
            for (int m = 0; m < 4; ++m) {
                const int row = m * 16 + r16;
                LAS u32x2* yp = (LAS u32x2*)(lds + R0 + row * XS5 + col * 2); const u32x2 y1 = *yp;
                const u32x2 zs = *(const u32x2*)(proj + (row0 + row) * IN_COLS + C_ZS + col);
                u32x2 o;
                o.x = pk2(blo(y1.x) * sig_fast(acc[m][n][0] + b4[0]) * blo(zs.x), bhi(y1.x) * sig_fast(acc[m][n][1] + b4[1]) * bhi(zs.x));
                o.y = pk2(blo(y1.y) * sig_fast(acc[m][n][2] + b4[2]) * blo(zs.y), bhi(y1.y) * sig_fast(acc[m][n][3] + b4[3]) * bhi(zs.y));
                *yp = o;
            }
        }
    }
    __syncthreads();
    bf16_t* MG = (bf16_t*)(ws + OFF_MG) + (size_t)u * 64 * D_MODEL;
#pragma unroll 1
    for (int qt = 0; qt < 4; ++qt) {
        f32x4 as[4][2], aa[4][2];
#pragma unroll
        for (int m = 0; m < 4; ++m)
#pragma unroll
            for (int n = 0; n < 2; ++n) { as[m][n] = (f32x4){0.f, 0.f, 0.f, 0.f}; aa[m][n] = (f32x4){0.f, 0.f, 0.f, 0.f}; }
        const int nb = wave * 128 + qt * 32;
        sk_gemm<2, 4, 4>(as, lds + R0, XS5, (const bf16_t*)(ws + OFF_WBS) + (size_t)layer * D_MODEL * SSM_W + (size_t)nb * SSM_W, SSM_W, r16, q);
        sk_gemm<2, 4, 4>(aa, lds + R1, XS5, (const bf16_t*)(ws + OFF_WBA) + (size_t)layer * D_MODEL * ATT_W + (size_t)nb * ATT_W, ATT_W, r16, q);
#pragma unroll
        for (int m = 0; m < 4; ++m)
#pragma unroll
            for (int n = 0; n < 2; ++n) {
                const int row = m * 16 + r16, col = nb + n * 16 + 4 * q;
                const u32x2 gs = *(const u32x2*)(proj + (row0 + row) * IN_COLS + C_GS + col), ga = *(const u32x2*)(proj + (row0 + row) * IN_COLS + C_GA + col);
                u32x2 o;
                o.x = pk2(blo(gs.x) * as[m][n][0] + blo(ga.x) * aa[m][n][0], bhi(gs.x) * as[m][n][1] + bhi(ga.x) * aa[m][n][1]);
                o.y = pk2(blo(gs.y) * as[m][n][2] + blo(ga.y) * aa[m][n][2], bhi(gs.y) * as[m][n][3] + bhi(ga.y) * aa[m][n][3]);
                *(u32x2*)(MG + (size_t)row * D_MODEL + col) = o;
            }
    }
    VM_WAIT(); __syncthreads();
#pragma unroll 4
    for (int k = 0; k < 16; ++k) { const int piece = tid + NTHREADS * k, row = piece >> 7, ch = piece & 127;
        *(LAS u32x4*)(lds + row * XS10 + ch * 16) = *(const u32x4*)(MG + (size_t)row * D_MODEL + ch * 8); }
    __syncthreads();
    {
        f32x4 acc[4][8];
#pragma unroll
        for (int m = 0; m < 4; ++m)
#pragma unroll
            for (int n = 0; n < 8; ++n) acc[m][n] = (f32x4){0.f, 0.f, 0.f, 0.f};
        const int nb = wave * 128;
        sk_gemm<8, 1, 32>(acc, lds, XS10, (const bf16_t*)(ws + OFF_WOUT) + (size_t)layer * D_MODEL * D_MODEL + (size_t)nb * D_MODEL, D_MODEL, r16, q);
        LAS float* RED = (LAS float*)(lds + RED_OFF); LAS float* RED2 = (LAS float*)(lds + RED2_OFF);
        float inv[4];
#pragma unroll
        for (int m = 0; m < 4; ++m) { float s = 0.f;
#pragma unroll
            for (int n = 0; n < 8; ++n) s += (acc[m][n][0] * acc[m][n][0] + acc[m][n][1] * acc[m][n][1]) + (acc[m][n][2] * acc[m][n][2] + acc[m][n][3] * acc[m][n][3]);
            s = sum_q(s); if (q == 0) RED[(m * 16 + r16) * 8 + wave] = s; }
        __syncthreads();
#pragma unroll
        for (int m = 0; m < 4; ++m) { const LAS f32x4* rp = (const LAS f32x4*)(RED + (m * 16 + r16) * 8); const f32x4 r0 = rp[0], r1 = rp[1];
            inv[m] = rsqrtf(((r0[0] + r0[1]) + (r0[2] + r0[3]) + (r1[0] + r1[1]) + (r1[2] + r1[3])) * (1.0f / D_MODEL) + RMS_EPS); }
        const float* pg = inptr(a, IN_POSTG) + layer * D_MODEL; float* xo = a.p.out; bf16_t* xb = (bf16_t*)(ws + OFF_XB);
        float s2[4] = {0.f, 0.f, 0.f, 0.f};
#pragma unroll
        for (int n = 0; n < 8; ++n) {
            asm volatile("" ::: "memory");
            const int col = nb + n * 16 + 4 * q; const f32x4 g4 = *(const f32x4*)(pg + col);
#pragma unroll
            for (int m = 0; m < 4; ++m) {
                const size_t off = (row0 + m * 16 + r16) * D_MODEL + col;
                f32x4 xv = *(const f32x4*)(xo + off);
                xv = xv + acc[m][n] * inv[m] * g4;
                *(f32x4*)(xo + off) = xv;
                u32x2 o; o.x = pk2(xv[0], xv[1]); o.y = pk2(xv[2], xv[3]); *(u32x2*)(xb + off) = o;
                s2[m] += (xv[0] * xv[0] + xv[1] * xv[1]) + (xv[2] * xv[2] + xv[3] * xv[3]);
            }
        }
#pragma unroll
        for (int m = 0; m < 4; ++m) { const float s = sum_q(s2[m]); if (q == 0) RED2[(m * 16 + r16) * 8 + wave] = s; }
        __syncthreads();
        if (tid < 64) { const LAS f32x4* rp = (const LAS f32x4*)(RED2 + tid * 8); const f32x4 r0 = rp[0], r1 = rp[1];
            ((float*)(ws + OFF_ROWSS))[row0 + tid] = (r0[0] + r0[1]) + (r0[2] + r0[3]) + (r1[0] + r1[1]) + (r1[2] + r1[3]); }
    }
    __syncthreads();
}
}

__device__ __forceinline__ void p0_transpose_item(const float* W, const float* rs, int K, int N, bf16_t* WT, LAS float* scr, int item, int lane) {
    const int nblk = N / 32, kb = item / nblk, nb = item % nblk, k0 = 64 * kb, n0 = 32 * nb;
#pragma unroll 8
    for (int i = 0; i < 32; ++i) { const int kk = 2 * i + (lane >> 5); float v = W[(size_t)(k0 + kk) * N + n0 + (lane & 31)]; if (rs) v *= rs[k0 + kk]; scr[kk * 33 + (lane & 31)] = v; }
    LDS_WAIT(); asm volatile("" ::: "memory");
    const int c = lane & 7;
#pragma unroll
    for (int j = 0; j < 4; ++j) { const int n = (lane >> 3) + 8 * j; const LAS float* s = scr + (8 * c) * 33 + n;
        u32x4 o; o.x = pk2(s[0 * 33], s[1 * 33]); o.y = pk2(s[2 * 33], s[3 * 33]); o.z = pk2(s[4 * 33], s[5 * 33]); o.w = pk2(s[6 * 33], s[7 * 33]);
        *(u32x4*)(WT + (size_t)(n0 + n) * K + k0 + 8 * c) = o; }
    LDS_WAIT(); asm volatile("" ::: "memory");
}
__device__ __forceinline__ void p0_prologue(const Frame& F, const Args& a) {
    LAS float* scr = (LAS float*)(F.lds + F.wave * 16384);
    const int gw = F.vcu * NWAVES + F.wave, NGW = F.G * NWAVES;
    constexpr int I_IN = (D_MODEL / 64) * (IN_COLS / 32), I_GLU = (SSM_W / 64) * (SSM_W / 32), I_BS = (SSM_W / 64) * (D_MODEL / 32), I_OUT = (D_MODEL / 64) * (D_MODEL / 32);
    constexpr int PER_L = I_IN + I_GLU + 2 * I_BS + I_OUT, NITEMS = DEPTH * PER_L;
    unsigned char* ws = a.p.ws;
    for (int lg = F.vcu; lg < DEPTH * SSM_NG; lg += F.G) s5::tables_wg(a, F.lds, lg);
    for (int it = gw; it < NITEMS; it += NGW) {
        const int l = it / PER_L; int r = it - l * PER_L;
        int widx, K, N; size_t dst;
        if (r < I_IN) { widx = IN_WIN; K = D_MODEL; N = IN_COLS; dst = OFF_WIN; }
        else if ((r -= I_IN) < I_GLU) { widx = IN_WGLU; K = SSM_W; N = SSM_W; dst = OFF_WGLU; }
        else if ((r -= I_GLU) < I_BS) { widx = IN_WBS; K = SSM_W; N = D_MODEL; dst = OFF_WBS; }
        else if ((r -= I_BS) < I_BS) { widx = IN_WBA; K = ATT_W; N = D_MODEL; dst = OFF_WBA; }
        else { r -= I_BS; widx = IN_WOUT; K = D_MODEL; N = D_MODEL; dst = OFF_WOUT; }
        const float* W = inptr(a, widx) + (size_t)l * K * N;
        const float* rs = (widx == IN_WIN) ? inptr(a, IN_PREG) + l * D_MODEL : nullptr;
        p0_transpose_item(W, rs, K, N, (bf16_t*)(ws + dst) + (size_t)l * K * N, scr, r, F.lane);
    }
    const float* X = inptr(a, IN_X);
    for (int m = gw; m < MTOK; m += NGW) {
        const f32x4* xr = (const f32x4*)(X + (size_t)m * D_MODEL) + F.lane; f32x4* orow = (f32x4*)(a.p.out + (size_t)m * D_MODEL) + F.lane;
        unsigned long long* o8 = (unsigned long long*)((bf16_t*)(ws + OFF_XB) + (size_t)m * D_MODEL) + F.lane;
        float s = 0.f;
#pragma unroll
        for (int j = 0; j < 4; ++j) { const f32x4 v = xr[64 * j]; orow[64 * j] = v; s += (v[0] * v[0] + v[1] * v[1]) + (v[2] * v[2] + v[3] * v[3]);
            o8[64 * j] = (unsigned long long)pk2(v[0], v[1]) | ((unsigned long long)pk2(v[2], v[3]) << 32); }
        s = wave_sum(s);
        if (F.lane == 0) ((float*)(ws + OFF_ROWSS))[m] = s;
    }
}

constexpr int N_PHASES = 1 + 3 * DEPTH;
__global__ void __launch_bounds__(NTHREADS, 2) mega(Args a) {
    extern __shared__ __attribute__((aligned(16))) unsigned char lds_raw[];
    Frame F; F.lds = (LAS unsigned char*)lds_raw; F.tid = threadIdx.x; F.lane = F.tid & 63; F.wave = __builtin_amdgcn_readfirstlane(F.tid >> 6);
    F.G = gridDim.x; { const int bx = blockIdx.x; F.vcu = (F.G % 8 == 0) ? (bx % 8) * (F.G / 8) + bx / 8 : bx; }
    volatile LAS unsigned* MISC = (volatile LAS unsigned*)(F.lds + MISC_OFF);
    if (F.tid < 64) MISC[F.tid] = 0u;
    __syncthreads();
    XcdBarrier bar = xcd_barrier_post((unsigned*)(a.p.ws + OFF_CTL) + CW_BAR + a.bar_region * XCD_BAR_WORDS, MISC + 8);
    for (int ph = a.ph_lo; ph < a.ph_hi; ++ph) {
        if (ph > a.ph_lo) xcd_barrier(bar);
        size_t wz_ = 0; asm volatile("" : "+s"(wz_)); unsigned char* ws = a.p.ws + wz_;
        int vcu_ = F.vcu; asm volatile("" : "+s"(vcu_));
        Frame Fp; Fp.lds = F.lds; Fp.tid = tid_opaque(); Fp.lane = Fp.tid & 63; Fp.wave = __builtin_amdgcn_readfirstlane(Fp.tid >> 6); Fp.G = F.G; Fp.vcu = vcu_;
        if (ph == 0) { p0_prologue(Fp, a); continue; }
        const int l = (ph - 1) / 3, k = (ph - 1) % 3;
        if (k == 0) {
            pg8::Gemm g{(const bf16_t*)(ws + OFF_XB), (const bf16_t*)(ws + OFF_WIN) + (size_t)l * IN_COLS * D_MODEL, MTOK, IN_COLS, D_MODEL};
            int bid_ = blockIdx.x; asm volatile("" : "+s"(bid_));
            pg8::StaticOrder S; S.init(MTOK, IN_COLS, Fp.G, bid_);
            pg8::EpiInProj E{(bf16_t*)(ws + OFF_PROJ), (const float*)(ws + OFF_ROWSS)};
            pg8::gemm_phase<pg8::EpiInProj, pg8::StaticOrder, true, true>(Fp.lds, g, S, E);
        }
        else if (k == 1) {
            for (int u = Fp.vcu; u < BATCH * SSM_NG; u += Fp.G) s5::unit(Fp.lds, ws, l, u >> 5, u & 31);
            attn_phase(Fp, ws);
        }
        else {
            for (int u = Fp.vcu; u < MTOK / 64; u += Fp.G) p4::unit(a, Fp.lds, ws, l, u);
        }
    }
}

#ifndef ONE_LAUNCH
#define ONE_LAUNCH 1
#endif
#ifndef OPT_P0
#define OPT_P0 1
#endif
#ifndef OPT_P1
#define OPT_P1 1
#endif
#ifndef OPT_P2
#define OPT_P2 1
#endif
#ifndef OPT_P4
#define OPT_P4 1
#endif
extern "C" void kernel_launch(void* const* d_in, const int* in_sizes, int n_in, void* d_out, int out_size, void* d_ws, size_t ws_size, hipStream_t stream) {
    static int grid = 0;
    if (grid == 0) {
        if (n_in != 17 || out_size != MTOK * D_MODEL || ws_size < WS_END) { fprintf(stderr, "kernel_launch: unexpected shapes/workspace (n_in %d out %d ws %zu)\n", n_in, out_size, ws_size); grid = -1; return; }
        int dev = 0, cus = 0, per_cu = 0;
        if (hipGetDevice(&dev) != hipSuccess || hipDeviceGetAttribute(&cus, hipDeviceAttributeMultiprocessorCount, dev) != hipSuccess) { grid = -1; return; }
        if (hipFuncSetAttribute((const void*)mega, hipFuncAttributeMaxDynamicSharedMemorySize, LDS_BYTES) != hipSuccess) { fprintf(stderr, "kernel_launch: hipFuncSetAttribute failed\n"); grid = -1; return; }
        if (hipOccupancyMaxActiveBlocksPerMultiprocessor(&per_cu, (const void*)mega, NTHREADS, LDS_BYTES) != hipSuccess || per_cu < 1) { fprintf(stderr, "kernel_launch: occupancy query says %d blocks/CU\n", per_cu); per_cu = 1; }
        (void)hipGetLastError();
        grid = cus * (per_cu < 1 ? 1 : 1);
    }
    if (grid < 0) return;
    Params p{};
    for (int i = 0; i < N_IN; ++i) p.in[i] = (const float*)d_in[i];
    p.out = (float*)d_out; p.ws = (unsigned char*)d_ws;
    unsigned char* ws = p.ws;
    (void)hipMemsetAsync(ws + OFF_CTL, 0, CTL_ZERO_BYTES, stream);
    int bar_region = 0;
    auto launch_mega = [&](int lo, int hi) { Args a{}; a.p = p; a.ph_lo = lo; a.ph_hi = hi; a.bar_region = bar_region++; a.pad = 0;
        hipLaunchKernelGGL(mega, dim3(grid), dim3(NTHREADS), LDS_BYTES, stream, a); };
    bf16_t* WIN = (bf16_t*)(ws + OFF_WIN); bf16_t* WGLU = (bf16_t*)(ws + OFF_WGLU); bf16_t* WBS = (bf16_t*)(ws + OFF_WBS); bf16_t* WBA = (bf16_t*)(ws + OFF_WBA); bf16_t* WOUT = (bf16_t*)(ws + OFF_WOUT);
    bf16_t* XB = (bf16_t*)(ws + OFF_XB); bf16_t* PROJ = (bf16_t*)(ws + OFF_PROJ); bf16_t* YPRE = (bf16_t*)(ws + OFF_YPRE); bf16_t* AO = (bf16_t*)(ws + OFF_AO);
    bf16_t* T2 = (bf16_t*)(ws + OFF_T2); bf16_t* T4 = (bf16_t*)(ws + OFF_T4); bf16_t* T5 = AO + (size_t)MTOK * ATT_W; float* OUTF = (float*)(ws + OFF_PROJ);
    const float* ROWSS = (const float*)(ws + OFF_ROWSS);
#if ONE_LAUNCH
    launch_mega(0, N_PHASES);
    return;
#endif
#if OPT_P0
    launch_mega(0, 1);
#else
    const dim3 tb(32, 8);
    for (int l = 0; l < DEPTH; ++l) {
        nv::k_transpose<<<dim3(IN_COLS / 32, D_MODEL / 32), tb, 0, stream>>>(p.in[IN_WIN] + (size_t)l * D_MODEL * IN_COLS, p.in[IN_PREG] + l * D_MODEL, WIN + (size_t)l * IN_COLS * D_MODEL, D_MODEL, IN_COLS);
        nv::k_transpose<<<dim3(SSM_W / 32, SSM_W / 32), tb, 0, stream>>>(p.in[IN_WGLU] + (size_t)l * SSM_W * SSM_W, nullptr, WGLU + (size_t)l * SSM_W * SSM_W, SSM_W, SSM_W);
        nv::k_transpose<<<dim3(D_MODEL / 32, SSM_W / 32), tb, 0, stream>>>(p.in[IN_WBS] + (size_t)l * SSM_W * D_MODEL, nullptr, WBS + (size_t)l * D_MODEL * SSM_W, SSM_W, D_MODEL);
        nv::k_transpose<<<dim3(D_MODEL / 32, ATT_W / 32), tb, 0, stream>>>(p.in[IN_WBA] + (size_t)l * ATT_W * D_MODEL, nullptr, WBA + (size_t)l * D_MODEL * ATT_W, ATT_W, D_MODEL);
        nv::k_transpose<<<dim3(D_MODEL / 32, D_MODEL / 32), tb, 0, stream>>>(p.in[IN_WOUT] + (size_t)l * D_MODEL * D_MODEL, nullptr, WOUT + (size_t)l * D_MODEL * D_MODEL, D_MODEL, D_MODEL);
    }
    nv::k_s5_tables<<<DEPTH * SSM_NG, 64, 0, stream>>>(p);
    nv::k_rows_x<<<MTOK, 256, 0, stream>>>(p);
#endif
    for (int l = 0; l < DEPTH; ++l) {
#if OPT_P1
        launch_mega(1 + 3 * l, 2 + 3 * l);
#else
        nv::k_gemm<nv::EpiInProj><<<dim3(IN_COLS / 128, MTOK / 128), 256, 0, stream>>>(XB, D_MODEL, WIN + (size_t)l * IN_COLS * D_MODEL, D_MODEL, D_MODEL, nv::EpiInProj{ROWSS, PROJ});
#endif
#if OPT_P2
        launch_mega(2 + 3 * l, 3 + 3 * l);
#else
        nv::k_attn<<<MTOK * 12 / 4, 256, 0, stream>>>(p);
        nv::k_s5<<<BATCH * SSM_NG, 64, 0, stream>>>(p, l);
#endif
#if OPT_P4
        launch_mega(3 + 3 * l, 4 + 3 * l);
#else
        nv::k_p4a<<<MTOK * SSM_W / 256, 256, 0, stream>>>(p, l);
        nv::k_gemm<nv::EpiGlu><<<dim3(SSM_W / 128, MTOK / 128), 256, 0, stream>>>(YPRE, SSM_W, WGLU + (size_t)l * SSM_W * SSM_W, SSM_W, SSM_W, nv::EpiGlu{YPRE, PROJ, p.in[IN_BGLU] + l * SSM_W, T2});
        nv::k_merge<<<MTOK * ATT_W / 256, 256, 0, stream>>>(p);
        nv::k_gemm<nv::EpiGate1><<<dim3(D_MODEL / 128, MTOK / 128), 256, 0, stream>>>(T2, SSM_W, WBS + (size_t)l * D_MODEL * SSM_W, SSM_W, SSM_W, nv::EpiGate1{PROJ, T4});
        nv::k_gemm<nv::EpiGate2><<<dim3(D_MODEL / 128, MTOK / 128), 256, 0, stream>>>(AO, ATT_W, WBA + (size_t)l * D_MODEL * ATT_W, ATT_W, ATT_W, nv::EpiGate2{PROJ, T4, T5});
        nv::k_gemm<nv::EpiF32><<<dim3(D_MODEL / 128, MTOK / 128), 256, 0, stream>>>(T5, D_MODEL, WOUT + (size_t)l * D_MODEL * D_MODEL, D_MODEL, D_MODEL, nv::EpiF32{OUTF, D_MODEL});
        nv::k_postnorm<<<MTOK, 256, 0, stream>>>(p, l, OUTF);
#endif
    }
}
```

```cpp
#include <hip/hip_runtime.h>
#include <cstdio>
#include <cstdint>
#ifndef ATTN_DMA
#define ATTN_DMA 3
#endif
#ifndef ATTN_WAVE
#define ATTN_WAVE 0
#endif
#ifndef EXP_MEMSET2
#define EXP_MEMSET2 0
#endif
#ifndef EXP_HALF
#define EXP_HALF 0
#endif
#ifndef EXP_NOSTORE
#define EXP_NOSTORE 0
#endif
#ifndef TS_ID
#define TS_ID 0
#endif
#ifndef P1_NT
#define P1_NT 0
#endif
#ifndef P1_SHAPE
#define P1_SHAPE 1
#endif
#ifndef W_TOUCH
#define W_TOUCH 1
#endif
#ifndef W_TOUCH2
#define W_TOUCH2 2
#endif
#ifndef SEAM_RELAX
#define SEAM_RELAX 1
#endif
#ifndef GRP_DELAY_NS
#define GRP_DELAY_NS 0
#endif
#ifndef GRP_DELAY_MOD
#define GRP_DELAY_MOD 2
#endif
#define TS_BEGIN(id) do { if (TS_ID == (id)) ts_t0 = __builtin_amdgcn_s_memrealtime(); } while (0)
#define TS_END(id) do { if (TS_ID == (id)) ts_sum += __builtin_amdgcn_s_memrealtime() - ts_t0; } while (0)

constexpr int D_MODEL = 1024, BATCH = 8, SEQ = 2048, DEPTH = 4, MTOK = BATCH * SEQ;
constexpr int SSM_W = 512, SSM_CH = 16, SSM_NG = 32, SSM_P = 64;
constexpr int HD = 128, HPG = 4, NGRP = 3, ATT_W = 512, IN_COLS = 8192;
constexpr int C_US = 0, C_ZS = 512, C_Q = 1024, C_K = 2560, C_V = 4096, C_ZA = 5632, C_GS = 6144, C_GA = 7168;
constexpr int GZ_W = 1024, GZ_ZS = 0, GZ_ZA = 512, G8_W = 2048, G8_GS = 0, G8_GA = 1024;
constexpr float RMS_EPS = 1e-6f;
constexpr float ATT_C2 = 0.08838834764831845f * 1.4426950408889634f;

constexpr size_t MiB = 1u << 20;
constexpr size_t OFF_CTL = 0;
constexpr size_t OFF_WIN = 370 * MiB;
constexpr size_t OFF_WGLU = 434 * MiB;
constexpr size_t OFF_WBS = 436 * MiB;
constexpr size_t OFF_WBA = 440 * MiB;
constexpr size_t OFF_WOUT = 444 * MiB;
constexpr size_t OFF_S5 = 452 * MiB;
constexpr size_t OFF_XB = 473 * MiB;
constexpr size_t OFF_ROWSS = 505 * MiB;
constexpr size_t OFF_PROJ = 1 * MiB;
constexpr size_t OFF_GZ = OFF_PROJ, OFF_G8 = OFF_PROJ + 32 * MiB, OFF_QKV = OFF_PROJ + 96 * MiB;
constexpr size_t OFF_YPRE = 257 * MiB;
constexpr size_t OFF_AO = 273 * MiB;
constexpr size_t OFF_ALSE = 321 * MiB;
constexpr size_t OFF_T2 = 322 * MiB;
constexpr size_t OFF_UG = OFF_T2;
constexpr size_t OFF_T4 = 338 * MiB;
constexpr size_t WS_END = 506 * MiB;
constexpr size_t S5_A = 0;
constexpr size_t S5_BB = 1 * MiB;

typedef unsigned short bf16_t;
typedef short bf16x8 __attribute__((ext_vector_type(8)));
typedef float f32x4 __attribute__((ext_vector_type(4)));
typedef unsigned u32x4 __attribute__((ext_vector_type(4)));

__device__ __forceinline__ float bf2f(bf16_t h) { return __uint_as_float(((unsigned)h) << 16); }
__device__ __forceinline__ bf16_t f2bf(float f) { unsigned u = __float_as_uint(f); return (bf16_t)((u + 0x7fffu + ((u >> 16) & 1u)) >> 16); }
__device__ __forceinline__ float sigmoidf_(float v) { return 1.0f / (1.0f + __expf(-v)); }
__device__ __forceinline__ float siluf_(float v) { return v / (1.0f + __expf(-v)); }
__device__ __forceinline__ float gelu_tanh(float x) {
    const float z = 0.7978845608028654f * (x + 0.044715f * x * x * x);
    const float t = 1.0f - 2.0f / (1.0f + __expf(2.0f * z));
    return 0.5f * x * (1.0f + t);
}
__device__ __forceinline__ float wave_sum(float v) {
    v += __builtin_bit_cast(float, __builtin_amdgcn_ds_swizzle(__builtin_bit_cast(int, v), 0x041F));
    v += __builtin_bit_cast(float, __builtin_amdgcn_ds_swizzle(__builtin_bit_cast(int, v), 0x081F));
    v += __builtin_bit_cast(float, __builtin_amdgcn_ds_swizzle(__builtin_bit_cast(int, v), 0x101F));
    v += __builtin_bit_cast(float, __builtin_amdgcn_ds_swizzle(__builtin_bit_cast(int, v), 0x201F));
    v += __builtin_bit_cast(float, __builtin_amdgcn_ds_swizzle(__builtin_bit_cast(int, v), 0x401F));
    const auto rr = __builtin_amdgcn_permlane32_swap(__float_as_uint(v), __float_as_uint(v), false, false);
    return __uint_as_float(rr[0]) + __uint_as_float(rr[1]);
}
__device__ __forceinline__ float sig_fast(float v) { return __builtin_amdgcn_rcpf(1.0f + __builtin_amdgcn_exp2f(-1.4426950408889634f * v)); }
__device__ __forceinline__ float gelu_fast(float x) {
    const float z2 = 1.5957691216057308f * (x + 0.044715f * x * x * x);
    return x * sig_fast(z2);
}
__device__ __forceinline__ float blo(unsigned w) { return __uint_as_float(w << 16); }
__device__ __forceinline__ float bhi(unsigned w) { return __uint_as_float(w & 0xffff0000u); }
enum { IN_X = 0, IN_PREG, IN_WIN, IN_LRE, IN_LIM, IN_LDT, IN_BRE, IN_BIM, IN_CRE, IN_CIM, IN_DSKIP, IN_WGLU, IN_BGLU, IN_WBS, IN_WBA, IN_WOUT, IN_POSTG, N_IN };
struct Params { const float* in[N_IN]; float* out; unsigned char* ws; };
__device__ __forceinline__ int tid_from(int wave_s) { unsigned z = 0u; asm volatile("" : "+v"(z)); return (wave_s << 6) | (int)__builtin_amdgcn_mbcnt_hi(~0u, __builtin_amdgcn_mbcnt_lo(~0u, z)); }

namespace nv {
__global__ void k_transpose(const float* __restrict__ W, const float* __restrict__ rs, bf16_t* __restrict__ Wt, int K, int N) {
    __shared__ float tile[32][33];
    const int n0 = blockIdx.x * 32, k0 = blockIdx.y * 32, tx = threadIdx.x, ty = threadIdx.y;
    for (int i = ty; i < 32; i += 8) { const int k = k0 + i; tile[i][tx] = W[(size_t)k * N + n0 + tx] * (rs ? rs[k] : 1.0f); }
    __syncthreads();
    for (int i = ty; i < 32; i += 8) { const int n = n0 + i; Wt[(size_t)n * K + k0 + tx] = f2bf(tile[tx][i]); }
}
__global__ void k_s5_tables(Params p) {
    const int lg = blockIdx.x, pp = threadIdx.x, idx = lg * 64 + pp;
    const float lre = fminf(p.in[IN_LRE][idx], -1e-4f), lim = p.in[IN_LIM][idx], dt = expf(p.in[IN_LDT][lg]);
    const float a = lre * dt, b = lim * dt, ea = expf(a), sb = sinf(b), cb = cosf(b);
    const float Are = ea * cb, Aim = ea * sb, sh = sinf(0.5f * b);
    const float Dre = expm1f(a) * cb - 2.0f * sh * sh, Dim = Aim;
    const float den = lre * lre + lim * lim;
    const float cre = (Dre * lre + Dim * lim) / den, cim = (Dim * lre - Dre * lim) / den;
    float* A = (float*)(p.ws + OFF_S5 + S5_A); float* Bb = (float*)(p.ws + OFF_S5 + S5_BB);
    A[idx * 2] = Are; A[idx * 2 + 1] = Aim;
    for (int c = 0; c < 16; ++c) { const float br = p.in[IN_BRE][idx * 16 + c], bi = p.in[IN_BIM][idx * 16 + c];
        Bb[(idx * 16 + c) * 2] = cre * br - cim * bi; Bb[(idx * 16 + c) * 2 + 1] = cre * bi + cim * br; }
}
__global__ void k_rows_x(Params p) {
    const int row = blockIdx.x, t = threadIdx.x;
    const f32x4 v = ((const f32x4*)(p.in[IN_X] + (size_t)row * D_MODEL))[t];
    ((f32x4*)(p.out + (size_t)row * D_MODEL))[t] = v;
    bf16_t* xb = (bf16_t*)(p.ws + OFF_XB) + (size_t)row * D_MODEL + t * 4;
    xb[0] = f2bf(v[0]); xb[1] = f2bf(v[1]); xb[2] = f2bf(v[2]); xb[3] = f2bf(v[3]);
    float ss = wave_sum(v[0] * v[0] + v[1] * v[1] + v[2] * v[2] + v[3] * v[3]);
    __shared__ float s[4];
    if ((t & 63) == 0) s[t >> 6] = ss;
    __syncthreads();
    if (t == 0) ((float*)(p.ws + OFF_ROWSS))[row] = s[0] + s[1] + s[2] + s[3];
}
template <class Epi> __global__ __launch_bounds__(256) void k_gemm(const bf16_t* __restrict__ A, int lda, const bf16_t* __restrict__ Bt, int ldb, int K, Epi epi) {
    const int tid = threadIdx.x, wave = tid >> 6, lane = tid & 63, wr = wave >> 1, wc = wave & 1;
    const int row0 = blockIdx.y * 128 + wr * 64, col0 = blockIdx.x * 128 + wc * 64;
    f32x4 acc[4][4];
    for (int i = 0; i < 4; ++i) for (int j = 0; j < 4; ++j) acc[i][j] = (f32x4){0.f, 0.f, 0.f, 0.f};
    const bf16_t* ap = A + (size_t)(row0 + (lane & 15)) * lda + 8 * (lane >> 4);
    const bf16_t* bp = Bt + (size_t)(col0 + (lane & 15)) * ldb + 8 * (lane >> 4);
    for (int k0 = 0; k0 < K; k0 += 32) {
        bf16x8 a[4], b[4];
#pragma unroll
        for (int i = 0; i < 4; ++i) { a[i] = *(const bf16x8*)(ap + (size_t)i * 16 * lda + k0); b[i] = *(const bf16x8*)(bp + (size_t)i * 16 * ldb + k0); }
#pragma unroll
        for (int i = 0; i < 4; ++i)
#pragma unroll
            for (int j = 0; j < 4; ++j) acc[i][j] = __builtin_amdgcn_mfma_f32_16x16x32_bf16(a[i], b[j], acc[i][j], 0, 0, 0);
    }
#pragma unroll
    for (int i = 0; i < 4; ++i)
#pragma unroll
        for (int j = 0; j < 4; ++j)
#pragma unroll
            for (int r = 0; r < 4; ++r) epi(row0 + i * 16 + (lane >> 4) * 4 + r, col0 + j * 16 + (lane & 15), acc[i][j][r]);
}
struct EpiInProj { const float* rowss; bf16_t* proj;
    __device__ void operator()(int row, int col, float acc) const {
        float v = acc * rsqrtf(rowss[row] * (1.0f / D_MODEL) + RMS_EPS);
        if ((col >= C_ZS && col < C_Q) || (col >= C_ZA && col < C_GS)) v = siluf_(v);
        else if (col >= C_GS) v = sigmoidf_(v);
        proj[(size_t)row * IN_COLS + col] = f2bf(v);
    } };
struct EpiGlu { const bf16_t* y1; const bf16_t* proj; const float* b_glu; bf16_t* ys;
    __device__ void operator()(int row, int col, float acc) const {
        const float gate = sigmoidf_(acc + b_glu[col]);
        ys[(size_t)row * SSM_W + col] = f2bf(bf2f(y1[(size_t)row * SSM_W + col]) * gate * bf2f(proj[(size_t)row * IN_COLS + C_ZS + col]));
    } };
struct EpiGate1 { const bf16_t* proj; bf16_t* m1;
    __device__ void operator()(int row, int col, float acc) const { m1[(size_t)row * D_MODEL + col] = f2bf(bf2f(proj[(size_t)row * IN_COLS + C_GS + col]) * acc); } };
struct EpiGate2 { const bf16_t* proj; const bf16_t* m1; bf16_t* mg;
    __device__ void operator()(int row, int col, float acc) const {
        mg[(size_t)row * D_MODEL + col] = f2bf(bf2f(m1[(size_t)row * D_MODEL + col]) + bf2f(proj[(size_t)row * IN_COLS + C_GA + col]) * acc); } };
struct EpiF32 { float* C; int ldc;
    __device__ void operator()(int row, int col, float acc) const { C[(size_t)row * ldc + col] = acc; } };

__global__ __launch_bounds__(256) void k_attn(Params p) {
    const int wave = threadIdx.x >> 6, lane = threadIdx.x & 63;
    const long wid = (long)blockIdx.x * 4 + wave;
    const int j = (int)(wid & 3), gi = (int)((wid >> 2) % 3), tok = (int)(wid / 12);
    const int d = gi == 0 ? 1 : (gi == 1 ? 4 : 16);
    const int t = tok % SEQ, i = t / d;
    const bf16_t* proj = (const bf16_t*)(p.ws + OFF_PROJ);
    const int hc = (gi * 4 + j) * HD + 2 * lane;
    const unsigned qq = *(const unsigned*)(proj + (size_t)tok * IN_COLS + C_Q + hc);
    const float q0 = bf2f((bf16_t)(qq & 0xffff)), q1 = bf2f((bf16_t)(qq >> 16));
    float m = -1e30f, l = 0.f, o0 = 0.f, o1 = 0.f;
    const int nk = i < 128 ? i : 128;
    for (int jj = nk; jj >= 0; --jj) {
        const size_t kt = (size_t)(tok - jj * d);
        const unsigned kk = *(const unsigned*)(proj + kt * IN_COLS + C_K + hc);
        const unsigned vv = *(const unsigned*)(proj + kt * IN_COLS + C_V + hc);
        float s = q0 * bf2f((bf16_t)(kk & 0xffff)) + q1 * bf2f((bf16_t)(kk >> 16));
        s = wave_sum(s) * ATT_C2;
        const float mn = fmaxf(m, s), al = exp2f(m - mn), pr = exp2f(s - mn);
        l = l * al + pr; o0 = o0 * al + pr * bf2f((bf16_t)(vv & 0xffff)); o1 = o1 * al + pr * bf2f((bf16_t)(vv >> 16)); m = mn;
    }
    const float il = 1.0f / l;
    bf16_t* ao = (bf16_t*)(p.ws + OFF_AO) + ((size_t)gi * MTOK + tok) * ATT_W + j * HD + 2 * lane;
    *(unsigned*)ao = (unsigned)f2bf(o0 * il) | ((unsigned)f2bf(o1 * il) << 16);
    if (lane == 0) ((float*)(p.ws + OFF_ALSE))[((size_t)gi * MTOK + tok) * 4 + j] = m + log2f(l);
}
__global__ __launch_bounds__(64) void k_s5(Params p, int layer) {
    const int b = blockIdx.x >> 5, g = blockIdx.x & 31, lane = threadIdx.x;
    const int idx = ((layer * 32 + g) * 64 + lane);
    const float* A = (const float*)(p.ws + OFF_S5 + S5_A); const float* Bb = (const float*)(p.ws + OFF_S5 + S5_BB);
    const float Are = A[idx * 2], Aim = A[idx * 2 + 1];
    float bre[16], bim[16], cre[16], cim[16];
#pragma unroll
    for (int c = 0; c < 16; ++c) { bre[c] = Bb[(idx * 16 + c) * 2]; bim[c] = Bb[(idx * 16 + c) * 2 + 1];
        cre[c] = p.in[IN_CRE][(size_t)((layer * 32 + g) * 16 + c) * 64 + lane]; cim[c] = p.in[IN_CIM][(size_t)((layer * 32 + g) * 16 + c) * 64 + lane]; }
    const bf16_t* proj = (const bf16_t*)(p.ws + OFF_PROJ); bf16_t* ypre = (bf16_t*)(p.ws + OFF_YPRE);
    float sre = 0.f, sim = 0.f;
    for (int t = 0; t < SEQ; ++t) {
        const size_t tok = (size_t)b * SEQ + t;
        const bf16x8 u0 = *(const bf16x8*)(proj + tok * IN_COLS + C_US + g * 16), u1 = *(const bf16x8*)(proj + tok * IN_COLS + C_US + g * 16 + 8);
        float dre = 0.f, dim = 0.f;
#pragma unroll
        for (int c = 0; c < 8; ++c) { const float ua = bf2f((bf16_t)u0[c]), ub = bf2f((bf16_t)u1[c]);
            dre += bre[c] * ua + bre[c + 8] * ub; dim += bim[c] * ua + bim[c + 8] * ub; }
        const float nre = Are * sre - Aim * sim + dre, nim = Are * sim + Aim * sre + dim;
        sre = nre; sim = nim;
        float mine = 0.f;
#pragma unroll
        for (int c = 0; c < 16; ++c) { const float y = wave_sum(cre[c] * sre - cim[c] * sim); if (lane == c) mine = y; }
        if (lane < 16) ypre[tok * SSM_W + g * 16 + lane] = f2bf(mine);
    }
}
__global__ void k_p4a(Params p, int layer) {
    const size_t e = (size_t)blockIdx.x * 256 + threadIdx.x; const size_t row = e >> 9; const int col = (int)(e & 511);
    bf16_t* ypre = (bf16_t*)(p.ws + OFF_YPRE); const bf16_t* proj = (const bf16_t*)(p.ws + OFF_PROJ);
    const float y0 = bf2f(ypre[e]) + p.in[IN_DSKIP][layer * SSM_W + col] * bf2f(proj[row * IN_COLS + C_US + col]);
    ypre[e] = f2bf(gelu_tanh(y0));
}
__global__ void k_merge(Params p) {
    const size_t e = (size_t)blockIdx.x * 256 + threadIdx.x; const size_t row = e >> 9; const int col = (int)(e & 511), j = col >> 7;
    bf16_t* ao = (bf16_t*)(p.ws + OFF_AO); const float* ls = (const float*)(p.ws + OFF_ALSE); const bf16_t* proj = (const bf16_t*)(p.ws + OFF_PROJ);
    const float l0 = ls[((size_t)0 * MTOK + row) * 4 + j], l1 = ls[((size_t)1 * MTOK + row) * 4 + j], l2 = ls[((size_t)2 * MTOK + row) * 4 + j];
    const float mx = fmaxf(l0, fmaxf(l1, l2)), w0 = exp2f(l0 - mx), w1 = exp2f(l1 - mx), w2 = exp2f(l2 - mx);
    const float y = (w0 * bf2f(ao[e]) + w1 * bf2f(ao[(size_t)MTOK * ATT_W + e]) + w2 * bf2f(ao[(size_t)2 * MTOK * ATT_W + e])) / (w0 + w1 + w2);
    ao[e] = f2bf(y * bf2f(proj[row * IN_COLS + C_ZA + col]));
}
__global__ void k_postnorm(Params p, int layer, const float* o) {
    const int row = blockIdx.x, t = threadIdx.x;
    const f32x4 v = ((const f32x4*)(o + (size_t)row * D_MODEL))[t];
    __shared__ float s[4], s2[4];
    float ss = wave_sum(v[0] * v[0] + v[1] * v[1] + v[2] * v[2] + v[3] * v[3]);
    if ((t & 63) == 0) s[t >> 6] = ss;
    __syncthreads();
    const float inv = rsqrtf((s[0] + s[1] + s[2] + s[3]) * (1.0f / D_MODEL) + RMS_EPS);
    const f32x4 g = ((const f32x4*)(p.in[IN_POSTG] + layer * D_MODEL))[t];
    f32x4 xv = ((f32x4*)(p.out + (size_t)row * D_MODEL))[t];
    xv = xv + v * inv * g;
    ((f32x4*)(p.out + (size_t)row * D_MODEL))[t] = xv;
    bf16_t* xb = (bf16_t*)(p.ws + OFF_XB) + (size_t)row * D_MODEL + t * 4;
    xb[0] = f2bf(xv[0]); xb[1] = f2bf(xv[1]); xb[2] = f2bf(xv[2]); xb[3] = f2bf(xv[3]);
    float q = wave_sum(xv[0] * xv[0] + xv[1] * xv[1] + xv[2] * xv[2] + xv[3] * xv[3]);
    if ((t & 63) == 0) s2[t >> 6] = q;
    __syncthreads();
    if (t == 0) ((float*)(p.ws + OFF_ROWSS))[row] = s2[0] + s2[1] + s2[2] + s2[3];
}
}

namespace pg8 {
#define PG8_LAS __attribute__((address_space(3)))
typedef unsigned short bf16_t;
typedef short bf16x8 __attribute__((ext_vector_type(8)));
typedef float f32x4 __attribute__((ext_vector_type(4)));
typedef unsigned u32x4 __attribute__((ext_vector_type(4)));
constexpr int BM = 256, BK = 64, HALF = 128, HTB = HALF * BK * 2  , STAGE_BYTES = 8 * HTB, NXCD = 8, WGM = 8;

__host__ __device__ __forceinline__ int lds_byte(int r, int c) { const int st = (r >> 4) * 2 + (c >> 5), rr = r & 15, cc = c & 31, ob = rr * 64 + cc * 2; return st * 1024 + (ob ^ (((ob >> 9) & 1) << 5)); }
__host__ __device__ __forceinline__ void stage_rc(int b, int& R, int& C) { const int st = b / 1024, sb = b % 1024, swz = sb ^ (((sb >> 9) & 1) << 5); R = (st >> 1) * 16 + swz / 64; C = (st & 1) * 32 + (swz % 64) / 2; }
__host__ __device__ __forceinline__ int perm32(int rho) { const int n = rho >> 4, i = rho & 15; return 8 * (i >> 2) + 4 * n + (i & 3); }

struct Unit { int pm, pn; };
struct Gemm { const bf16_t* A; const bf16_t* Bt; int M, N, K; };

struct StaticOrder {
    int nM, nN, nwg, G, c;
    __host__ __device__ void init(int M, int N, int G_, int c_) { nM = M / BM; nN = N / BM; nwg = nM * nN; G = G_; c = c_; }
    __host__ __device__ bool next(int i, Unit& u) const {
        const long L = (long)i * G + c; if (L >= nwg) return false;
        int wgid = (int)L; { const int q = nwg / NXCD, r = nwg % NXCD, xcd = wgid % NXCD, off = wgid / NXCD; wgid = (xcd < r ? xcd * (q + 1) : r * (q + 1) + (xcd - r) * q) + off; }
        const int nig = WGM * nN, gid = wgid / nig, fm = gid * WGM, gsz = (nM - fm) < WGM ? (nM - fm) : WGM;
        u.pm = fm + ((wgid % nig) % gsz); u.pn = (wgid % nig) / gsz;
        if (P1_SHAPE && G == 256 && nM == 64 && nN == 32) {
            const int b = c % 8, j = c / 8;
            u.pm = b * 8 + 4 * (i >> 2) + (j & 3); u.pn = 8 * (i & 3) + (j >> 2);
        }
        return true;
    }
    __device__ __forceinline__ void a_ready(const Unit&) const {}
    __device__ __forceinline__ void done(const Unit&) const {}
};

__device__ __forceinline__ unsigned cvt_pk_bf16(float lo, float hi) { unsigned r; asm volatile("v_cvt_pk_bf16_f32 %0, %1, %2" : "=v"(r) : "v"(lo), "v"(hi)); return r; }
template <class Epi, class Sched, bool ALIGN_EPI = false, bool SP2 = false>
__device__ __forceinline__ void gemm_phase(PG8_LAS unsigned char* lds, const Gemm g, const Sched& S, const Epi& E, int wave_s, unsigned long long& ts_sum, unsigned long long& ts_t0) {
    const int tid = tid_from(wave_s), wid = wave_s, lane = tid & 63, wr = wid >> 2, wc = wid & 3, fr = lane & 15, fq = lane >> 4;
    const int K = g.K, nt = K / BK;
    unsigned voffA[2], voffB[2];
#pragma unroll
    for (int i = 0; i < 2; ++i) { int R, C; stage_rc(tid * 16 + i * 8192, R, C); const int Rb = Epi::PERM ? ((R & ~31) + perm32(R & 31)) : R;
        voffA[i] = (unsigned)(R * K + C) * 2u; voffB[i] = (unsigned)(Rb * K + C) * 2u; }
    const size_t kstep = (size_t)(BK * 2);
    const size_t hstep = (size_t)HALF * K * 2;
    const size_t tstep = 2 * hstep;
    const unsigned ldsw = (unsigned)wid * 1024u;
    const int aoff = lds_byte(wr * 64 + fr, fq * 8), boff = lds_byte(wc * 32 + fr, fq * 8);
#define PG8_SA(b, h) (((b) * 2 + (h)) * HTB)
#define PG8_SB(b, h) ((4 + (b) * 2 + (h)) * HTB)
#define PG8_STAGE(bufoff, gbase, voff) do { _Pragma("unroll") for (int _i = 0; _i < 2; ++_i) \
        __builtin_amdgcn_global_load_lds((const unsigned*)((const char*)(gbase) + (voff)[_i]), (PG8_LAS unsigned*)(lds + (bufoff) + ldsw + _i * 8192), 16, 0, 0); } while (0)
#define PG8_LDA(dst, b, h) do { _Pragma("unroll") for (int m = 0; m < 4; ++m) _Pragma("unroll") for (int k = 0; k < 2; ++k) dst[m][k] = *(const PG8_LAS bf16x8*)(lds + PG8_SA(b, h) + aoff + m * 2048 + k * 1024); } while (0)
#define PG8_LDB(dst, b, h) do { _Pragma("unroll") for (int n = 0; n < 2; ++n) _Pragma("unroll") for (int k = 0; k < 2; ++k) dst[n][k] = *(const PG8_LAS bf16x8*)(lds + PG8_SB(b, h) + boff + n * 2048 + k * 1024); } while (0)
#define PG8_MMA(ai, bj, At, Bt) do { __builtin_amdgcn_s_setprio(1); _Pragma("unroll") for (int m = 0; m < 4; ++m) _Pragma("unroll") for (int n = 0; n < 2; ++n) _Pragma("unroll") for (int k = 0; k < 2; ++k) \
        acc[ai][bj][m][n] = __builtin_amdgcn_mfma_f32_16x16x32_bf16(Bt[n][k], At[m][k], acc[ai][bj][m][n], 0, 0, 0); __builtin_amdgcn_s_setprio(0); } while (0)
#define PG8_WAIT_V(n) asm volatile("s_waitcnt vmcnt(" #n ")" ::: "memory")
#define PG8_WAIT_L(n) asm volatile("s_waitcnt lgkmcnt(" #n ")" ::: "memory")
#define PG8_BAR __builtin_amdgcn_s_barrier()
#define PG8_SCHED __builtin_amdgcn_sched_barrier(0)
    Unit cur, nxt; int ui = 0;
    if (!S.next(0, cur)) return;
    f32x4 acc[2][2][4][2];
#pragma unroll
    for (int a = 0; a < 2; ++a)
#pragma unroll
        for (int b = 0; b < 2; ++b)
#pragma unroll
            for (int m = 0; m < 4; ++m)
#pragma unroll
                for (int n = 0; n < 2; ++n) acc[a][b][m][n] = (f32x4){0.f, 0.f, 0.f, 0.f};
    bf16x8 At[4][2], B0[2][2], B1[2][2];
    const char* cA = (const char*)g.A + (size_t)cur.pm * tstep; const char* cB = (const char*)g.Bt + (size_t)cur.pn * tstep;
    S.a_ready(cur);
    if constexpr (SP2) {
        PG8_STAGE(PG8_SB(0, 0), cB, voffB); PG8_STAGE(PG8_SB(0, 1), cB + hstep, voffB); PG8_STAGE(PG8_SA(0, 0), cA, voffA); PG8_STAGE(PG8_SA(0, 1), cA + hstep, voffA);
        if (wr == 1) PG8_BAR;
        PG8_WAIT_V(2); PG8_BAR;
        PG8_STAGE(PG8_SB(1, 0), cB + kstep, voffB); PG8_STAGE(PG8_SA(1, 0), cA + kstep, voffA); PG8_STAGE(PG8_SB(1, 1), cB + hstep + kstep, voffB);
        PG8_WAIT_V(6); PG8_BAR;
    } else {
        PG8_STAGE(PG8_SB(0, 0), cB, voffB); PG8_STAGE(PG8_SA(0, 0), cA, voffA); PG8_STAGE(PG8_SB(0, 1), cB + hstep, voffB); PG8_STAGE(PG8_SA(0, 1), cA + hstep, voffA);
        if (wr == 1) PG8_BAR;
        PG8_WAIT_V(4); PG8_BAR;
        PG8_STAGE(PG8_SB(1, 0), cB + kstep, voffB); PG8_STAGE(PG8_SA(1, 0), cA + kstep, voffA); PG8_STAGE(PG8_SB(1, 1), cB + hstep + kstep, voffB);
        PG8_WAIT_V(6); PG8_BAR;
    }
    for (;;) {
        const bool has_next = S.next(ui + 1, nxt);
        const char* nA = has_next ? (const char*)g.A + (size_t)nxt.pm * tstep : cA; const char* nB = has_next ? (const char*)g.Bt + (size_t)nxt.pn * tstep : cB;
        if constexpr (Epi::ROWSUMS)
            __builtin_amdgcn_global_load_lds((const unsigned*)(E.rowss + cur.pm * BM + 32 * wid + (tid_from(wave_s) & 31)), (PG8_LAS unsigned*)(lds + STAGE_BYTES + (ui & 1) * 2048 + wid * 256), 4, 0, 0);
        for (int t = 0; t < nt; t += 2) {
            const bool last = (t == nt - 2);
            const char* a1 = cA + (size_t)(t + 1) * kstep;
            const char* a2 = last ? nA : cA + (size_t)(t + 2) * kstep; const char* b2 = last ? nB : cB + (size_t)(t + 2) * kstep;
            const char* a3 = a2 + kstep; const char* b3 = b2 + kstep;
            if (last && has_next) S.a_ready(nxt);
            if constexpr (SP2) {
            const unsigned seam = (unsigned)__builtin_amdgcn_readfirstlane((Epi::ROWSUMS && SEAM_RELAX && t == 0 && ui > 0) ? 1 : 0);
            PG8_LDB(B0, 0, 0); PG8_LDB(B1, 0, 1); PG8_SCHED; PG8_LDA(At, 0, 0); PG8_STAGE(PG8_SA(1, 1), a1 + hstep, voffA);
            asm volatile("s_waitcnt vmcnt(25)\n\ts_cmp_lg_u32 %0, 0\n\ts_cbranch_scc1 1\n\ts_waitcnt vmcnt(8)" :: "s"(seam) : "scc", "memory");
            PG8_WAIT_L(0); PG8_BAR; PG8_MMA(0, 0, At, B0); PG8_MMA(0, 1, At, B1); PG8_BAR; PG8_SCHED;
            PG8_LDA(At, 0, 1); PG8_STAGE(PG8_SB(0, 0), b2, voffB); PG8_STAGE(PG8_SB(0, 1), b2 + hstep, voffB); PG8_STAGE(PG8_SA(0, 0), a2, voffA);
            asm volatile("s_waitcnt vmcnt(25)\n\ts_cmp_lg_u32 %0, 0\n\ts_cbranch_scc1 1\n\ts_waitcnt vmcnt(8)" :: "s"(seam) : "scc", "memory");
            PG8_WAIT_L(0); PG8_BAR; PG8_MMA(1, 0, At, B0); PG8_MMA(1, 1, At, B1); PG8_BAR; PG8_SCHED;
            PG8_LDB(B0, 1, 0); PG8_LDB(B1, 1, 1); PG8_SCHED; PG8_LDA(At, 1, 0); PG8_STAGE(PG8_SA(0, 1), a2 + hstep, voffA);
            PG8_WAIT_V(8); PG8_WAIT_L(0); PG8_BAR; PG8_MMA(0, 0, At, B0); PG8_MMA(0, 1, At, B1); PG8_BAR; PG8_SCHED;
            PG8_LDA(At, 1, 1); PG8_STAGE(PG8_SB(1, 0), b3, voffB); PG8_STAGE(PG8_SB(1, 1), b3 + hstep, voffB); PG8_STAGE(PG8_SA(1, 0), a3, voffA);
            PG8_WAIT_V(8); PG8_WAIT_L(0); PG8_BAR; PG8_MMA(1, 0, At, B0); PG8_MMA(1, 1, At, B1); PG8_BAR; PG8_SCHED;
            } else {
            PG8_LDB(B0, 0, 0); PG8_SCHED; PG8_LDA(At, 0, 0); PG8_STAGE(PG8_SA(1, 1), a1 + hstep, voffA);
            PG8_WAIT_L(8); PG8_BAR; PG8_WAIT_L(0); PG8_MMA(0, 0, At, B0); PG8_BAR; PG8_SCHED;
            PG8_LDB(B1, 0, 1); PG8_STAGE(PG8_SB(0, 0), b2, voffB);
            PG8_BAR; PG8_WAIT_L(0); PG8_MMA(0, 1, At, B1); PG8_BAR;
            PG8_LDA(At, 0, 1); PG8_STAGE(PG8_SA(0, 0), a2, voffA);
            PG8_BAR; PG8_WAIT_L(0); PG8_MMA(1, 0, At, B0); PG8_BAR; PG8_SCHED;
            PG8_STAGE(PG8_SB(0, 1), b2 + hstep, voffB);
            PG8_WAIT_V(6); PG8_BAR; PG8_MMA(1, 1, At, B1); PG8_BAR;
            PG8_LDB(B0, 1, 0); PG8_SCHED; PG8_LDA(At, 1, 0); PG8_STAGE(PG8_SA(0, 1), a2 + hstep, voffA);
            PG8_WAIT_L(8); PG8_BAR; PG8_WAIT_L(0); PG8_MMA(0, 0, At, B0); PG8_BAR; PG8_SCHED;
            PG8_LDB(B1, 1, 1); PG8_STAGE(PG8_SB(1, 0), b3, voffB);
            PG8_BAR; PG8_WAIT_L(0); PG8_MMA(0, 1, At, B1); PG8_BAR;
            PG8_LDA(At, 1, 1); PG8_STAGE(PG8_SA(1, 0), a3, voffA);
            PG8_BAR; PG8_WAIT_L(0); PG8_MMA(1, 0, At, B0); PG8_BAR; PG8_SCHED;
            PG8_STAGE(PG8_SB(1, 1), b3 + hstep, voffB);
            PG8_WAIT_V(6); PG8_BAR; PG8_MMA(1, 1, At, B1); PG8_BAR;
            }
        }
        if constexpr (ALIGN_EPI) { if (wr == 0) PG8_BAR; }
        TS_BEGIN(11);
        if constexpr (!Epi::AFTER_DRAIN) { E(acc, cur, wr, wc, fr, fq, (const PG8_LAS float*)(lds + STAGE_BYTES + (ui & 1) * 2048)); S.done(cur); }
        TS_END(11);
        if (!has_next) break;
#pragma unroll
        for (int a = 0; a < 2; ++a)
#pragma unroll
            for (int b = 0; b < 2; ++b)
#pragma unroll
                for (int m = 0; m < 4; ++m)
#pragma unroll
                    for (int n = 0; n < 2; ++n) acc[a][b][m][n] = (f32x4){0.f, 0.f, 0.f, 0.f};
        cur = nxt; cA = nA; cB = nB; ++ui;
        if constexpr (ALIGN_EPI) { if (wr == 1) PG8_BAR; }
    }
    PG8_WAIT_V(0);
    if constexpr (!ALIGN_EPI) { if (wr == 0) PG8_BAR; }
    PG8_BAR;
    if constexpr (Epi::AFTER_DRAIN) { E.fused(acc, cur, wr, wc, fr, fq, lds, wid, lane); S.done(cur); }
#undef PG8_SA
#undef PG8_SB
#undef PG8_STAGE
#undef PG8_LDA
#undef PG8_LDB
#undef PG8_MMA
#undef PG8_WAIT_V
#undef PG8_WAIT_L
#undef PG8_BAR
#undef PG8_SCHED
}
}

namespace pg8 {
struct EpiInProj {
    static constexpr bool PERM = true, AFTER_DRAIN = false, ROWSUMS = true;
    unsigned char* ws; const float* rowss;
    __device__ __forceinline__ void operator()(const f32x4 (&acc)[2][2][4][2], const Unit& u, int wr, int wc, int fr, int fq, const PG8_LAS float* rs) const {
        const int row0 = u.pm * BM + wr * 64 + fr, colt = u.pn * BM, cl = wc * 32 + 8 * fq;
        const int mode = (colt >= C_GS) ? 2 : (((colt >= C_ZS && colt < C_Q) || (colt >= C_ZA && colt < C_GS)) ? 1 : 0);
        bf16_t* base; int kind = 0, sh = 0; size_t bjs;
        if (colt < C_ZS) { base = (bf16_t*)(ws + OFF_UG) + (size_t)(colt >> 4) * SEQ * 16; bjs = (size_t)8 * SEQ * 16; kind = 1; }
        else if (colt < C_Q) { base = (bf16_t*)(ws + OFF_GZ) + GZ_ZS + (colt - C_ZS); bjs = HALF; }
        else if (colt < C_ZA) { const int j = (colt - C_Q) >> 8, kd = j / 6, jj = j - 6 * kd, gi = jj >> 1; sh = 2 * gi; kind = 2;
            base = (bf16_t*)(ws + OFF_QKV) + ((size_t)((kd * 3 + gi) * BATCH) * HPG + 2 * (jj & 1)) * SEQ * HD; bjs = (size_t)SEQ * HD; }
        else if (colt < C_GS) { base = (bf16_t*)(ws + OFF_GZ) + GZ_ZA + (colt - C_ZA); bjs = HALF; }
        else { base = (bf16_t*)(ws + OFF_G8); bjs = HALF; kind = 3; }
        float inv[2][4];
#pragma unroll
        for (int ai = 0; ai < 2; ++ai)
#pragma unroll
            for (int m = 0; m < 4; ++m) { const int rl = wr * 64 + fr + ai * HALF + m * 16; inv[ai][m] = rsqrtf(rs[(rl >> 5) * 64 + (rl & 31)] * (1.0f / D_MODEL) + RMS_EPS); }
#pragma unroll
        for (int ai = 0; ai < 2; ++ai)
#pragma unroll
            for (int m = 0; m < 4; ++m) {
                const int row = row0 + ai * HALF + m * 16, b = row >> 11, t = row & (SEQ - 1);
                unsigned ro;
                if (kind == 3) { const unsigned go = (unsigned)row * G8_W + (unsigned)(colt - C_GS) + (unsigned)cl;
#pragma unroll
                    for (int bj = 0; bj < 2; ++bj) { const f32x4 v0 = acc[ai][bj][m][0] * inv[ai][m], v1 = acc[ai][bj][m][1] * inv[ai][m]; unsigned lo = 0u, hi = 0u;
#pragma unroll
                        for (int e = 0; e < 4; ++e) { const float s0 = __builtin_amdgcn_rcpf(1.0f + __builtin_amdgcn_exp2f(-1.4426950408889634f * v0[e])), s1 = __builtin_amdgcn_rcpf(1.0f + __builtin_amdgcn_exp2f(-1.4426950408889634f * v1[e]));
                            lo |= (unsigned)(s0 * 255.0f + 0.5f) << (8 * e); hi |= (unsigned)(s1 * 255.0f + 0.5f) << (8 * e); }
                        { typedef unsigned u32x2g __attribute__((ext_vector_type(2))); const u32x2g gw_ = {lo, hi};
                          asm volatile("global_store_dwordx2 %0, %1, %2" :: "v"(go + (unsigned)(bj * HALF)), "v"(gw_), "s"(base) : "memory"); } }
                    continue; }
                if (kind == 0) ro = ((unsigned)row * GZ_W + (unsigned)cl) * 2u;
                else if (kind == 1) ro = (((unsigned)(b * SSM_NG + (cl >> 4)) * SEQ + (unsigned)t) * 16u + (unsigned)(cl & 8)) * 2u;
                else { const int pos = ((t & ((1 << sh) - 1)) << (11 - sh)) + (t >> sh); ro = (((unsigned)b * HPG * SEQ + (unsigned)pos) * HD + (unsigned)cl) * 2u; }
#pragma unroll
                for (int bj = 0; bj < 2; ++bj) {
                    f32x4 v0 = acc[ai][bj][m][0] * inv[ai][m], v1 = acc[ai][bj][m][1] * inv[ai][m];
                    if (mode != 0) {
#pragma unroll
                        for (int e = 0; e < 4; ++e) {
                            const float s0 = __builtin_amdgcn_rcpf(1.0f + __builtin_amdgcn_exp2f(-1.4426950408889634f * v0[e]));
                            const float s1 = __builtin_amdgcn_rcpf(1.0f + __builtin_amdgcn_exp2f(-1.4426950408889634f * v1[e]));
                            v0[e] = (mode == 1) ? v0[e] * s0 : s0; v1[e] = (mode == 1) ? v1[e] * s1 : s1;
                        }
                    }
                    u32x4 w; w.x = cvt_pk_bf16(v0[0], v0[1]); w.y = cvt_pk_bf16(v0[2], v0[3]); w.z = cvt_pk_bf16(v1[0], v1[1]); w.w = cvt_pk_bf16(v1[2], v1[3]);
#if EXP_NOSTORE
                    asm volatile("" :: "v"(w.x), "v"(w.y), "v"(w.z), "v"(w.w));
#else
#if P1_NT
                    __builtin_nontemporal_store(w, (u32x4*)(rowp + bj * bjs));
#else
                    asm volatile("global_store_dwordx4 %0, %1, %2" :: "v"(ro + (unsigned)bj * (unsigned)bjs * 2u), "v"(w), "s"(base) : "memory");
#endif
#endif
                }
            }
    }
};
}

#define LAS __attribute__((address_space(3)))
#define GAS __attribute__((address_space(1)))
#define LDS_WAIT() asm volatile("s_waitcnt lgkmcnt(0)" ::: "memory")
#define VM_WAIT() asm volatile("s_waitcnt vmcnt(0)" ::: "memory")
__device__ __forceinline__ unsigned pk2(float lo, float hi) { return (unsigned)f2bf(lo) | ((unsigned)f2bf(hi) << 16); }
#define XB_TMO      128
#define XB_XCNT(j)  (256  + 64 * (j))
#define XB_XSUB(j)  (1280 + 64 * (j))
#define XB_XGEN(j)  (2304 + 64 * (j))
#define XB_TOP      3328
#define XB_TOPGEN   3392
#define XCD_BAR_WORDS 3456
#define XB_SPIN_CAP (1u << 18)

__device__ __forceinline__ unsigned xb_ld(unsigned* p)              { return __hip_atomic_load(p, __ATOMIC_RELAXED, __HIP_MEMORY_SCOPE_AGENT); }
__device__ __forceinline__ unsigned xb_add(unsigned* p, unsigned v) { return __hip_atomic_fetch_add(p, v, __ATOMIC_RELAXED, __HIP_MEMORY_SCOPE_AGENT); }
__device__ __forceinline__ unsigned xb_xcc_id() { return (unsigned)__builtin_amdgcn_s_getreg((3 << 11) | 20) & 0xFu; }
#define XB_SPIN(cond, bar) do { unsigned _sp = 0; while (cond) { __builtin_amdgcn_s_sleep(1); \
    if ((++_sp & 255u) == 0u) { if (xb_ld(&(bar)[XB_TMO])) break; if (_sp > XB_SPIN_CAP) { atomicAdd(&(bar)[XB_TMO], 1u); break; } } } } while (0)

struct XcdBarrier {
    int w;
    unsigned G;
    unsigned* bar; unsigned x;
    volatile LAS unsigned* st;
};

__device__ __forceinline__ XcdBarrier xcd_barrier_post(unsigned* bar, volatile LAS unsigned* st, int wave_s, unsigned G) {
    XcdBarrier b; b.w = wave_s; b.G = G; b.bar = bar; b.x = xb_xcc_id(); b.st = st;
    if (tid_from(wave_s) == 0) (void)xb_add(&bar[XB_XCNT(b.x)], 1u);
    return b;
}
__device__ __forceinline__ void xcd_barrier_complete(unsigned* bar, unsigned x, unsigned& nloc, unsigned& nx, unsigned G) {
    unsigned sum, cnt, mine, sp = 0u;
    for (;;) {
        sum = 0u; cnt = 0u; mine = 0u;
#pragma unroll
        for (unsigned j = 0; j < 16; ++j) { const unsigned c = xb_ld(&bar[XB_XCNT(j)]); sum += c; cnt += (c > 0u) ? 1u : 0u; mine = (j == x) ? c : mine; }
        if (sum == G) break;
        __builtin_amdgcn_s_sleep(1);
        if ((++sp & 255u) == 0u) { if (xb_ld(&bar[XB_TMO])) break; if (sp > XB_SPIN_CAP) { atomicAdd(&bar[XB_TMO], 1u); break; } }
    }
    nloc = mine > 0u ? mine : 1u; nx = cnt > 0u ? cnt : 1u;
}

__device__ __forceinline__ void xcd_barrier(const XcdBarrier& b) {
    asm volatile("s_waitcnt vmcnt(0)" ::: "memory");
    __syncthreads();
    if (tid_from(b.w) == 0) {
        unsigned* bar = b.bar;
        __builtin_amdgcn_s_waitcnt(0);
        unsigned nloc = b.st[0], nx = b.st[1];
        if (nloc == 0u) { xcd_barrier_complete(bar, b.x, nloc, nx, b.G); b.st[0] = nloc; b.st[1] = nx; }
        const unsigned old = xb_add(&bar[XB_XSUB(b.x)], 1u);
        const unsigned gen = old / nloc;
        if (old + 1u == (gen + 1u) * nloc) {
            __builtin_amdgcn_fence(__ATOMIC_RELEASE, "agent");
            asm volatile("s_waitcnt vmcnt(0)" ::: "memory");
            const unsigned og = xb_add(&bar[XB_TOP], 1u);
            const unsigned tg = og / nx;
            if (og + 1u == (tg + 1u) * nx) xb_add(&bar[XB_TOPGEN], 1u);
            else XB_SPIN(xb_ld(&bar[XB_TOPGEN]) == tg, bar);
            __builtin_amdgcn_fence(__ATOMIC_ACQUIRE, "agent");
            xb_add(&bar[XB_XGEN(b.x)], 1u);
            asm volatile("s_waitcnt vmcnt(0)" ::: "memory");
        } else {
            XB_SPIN(xb_ld(&bar[XB_XGEN(b.x)]) == gen, bar);
            __builtin_amdgcn_fence(__ATOMIC_ACQUIRE, "agent");
            asm volatile("s_waitcnt vmcnt(0)" ::: "memory");
        }
    }
    __syncthreads();
}

constexpr int NWAVES = 8, NTHREADS = NWAVES * 64;
constexpr int RING_BYTES = 131072;
constexpr int LDS_BYTES = 163840;
constexpr int MISC_OFF = LDS_BYTES - 256;
constexpr int CW_BAR = 4096;
constexpr int N_BAR_REGIONS = 32;
constexpr size_t CTL_ZERO_BYTES = 1 * MiB;
static_assert((CW_BAR + N_BAR_REGIONS * XCD_BAR_WORDS) * 4 <= (int)CTL_ZERO_BYTES, "ctl");

#ifndef PROBE_DUP
#define PROBE_DUP 0
#endif
struct Frame { LAS unsigned char* lds; int wave, vcu, G; };

struct Args { Params p; int ph_lo, ph_hi, bar_region, pad; };
__device__ __forceinline__ const float* inptr(const Args& a, int i) { int z; asm volatile("s_mov_b32 %0, 0" : "=s"(z)); return a.p.in[i + z]; }

namespace swa {
constexpr int D = 128; constexpr float THR = 8.f; constexpr bool WSKIP = true;
constexpr float SCALE = 0.08838834764831845f;
constexpr int NW = 8, QBLK = 32, KVBLK = 64, QB = NW * QBLK;
constexpr int SHM_V = KVBLK * D * 2, SHM_K = KVBLK * D * 2;
constexpr int ATTN_LDS_BYTES = 2 * SHM_V + 2 * SHM_K + NW * 64 * 4;

typedef short s16x4 __attribute__((ext_vector_type(4)));
typedef float f32x16 __attribute__((ext_vector_type(16)));
template <class A, class Bt> struct same_t { static constexpr bool v = false; };
template <class A> struct same_t<A, A> { static constexpr bool v = true; };

#define KSWZ(row, colB) ((row) * 256 + ((colB) ^ (((row) & 7) << 4)))
#define SBAR() __builtin_amdgcn_sched_barrier(0)
__device__ __forceinline__ int v_st(int k, int c) { const int kk = (k & ~0xC) | ((k & 4) << 1) | ((k & 8) >> 1); return ((kk >> 3) * 4 + (c >> 5)) * 512 + ((kk & 7) * 32 + (c & 31)) * 2; }
__device__ __forceinline__ int v_rd_base(int lane) { return ((lane & 3) << 3) | (((lane >> 2) & 3) << 6) | (((lane >> 4) & 1) << 5) | (((lane >> 5) & 1) << 8); }
constexpr int v_rd_off(int d0, int ks, int half) { return d0 * 512 + ks * 4096 + half * 2048; }
__device__ __forceinline__ int crow(int r, int hi) { return (r & 3) + 8 * (r >> 2) + 4 * hi; }
__device__ __forceinline__ unsigned cvtpk(float lo, float hi) {
    unsigned r; asm volatile("v_cvt_pk_bf16_f32 %0, %1, %2" : "=v"(r) : "v"(lo), "v"(hi)); return r;
}
__device__ __forceinline__ bf16x8 pack8(f32x4 a, f32x4 b) {
    u32x4 w = {cvtpk(a[0], a[1]), cvtpk(a[2], a[3]), cvtpk(b[0], b[1]), cvtpk(b[2], b[3])};
    return *reinterpret_cast<bf16x8*>(&w);
}
template <class T> __device__ __forceinline__ bf16x8 load8(const T* p) {
    if constexpr (same_t<T, float>::v) { return pack8(*(const f32x4*)p, *(const f32x4*)(p + 4)); }
    else { return *reinterpret_cast<const bf16x8*>(p); }
}
__device__ __forceinline__ void mask_tile(f32x16& p0, f32x16& p1, int dq, unsigned W) {
    const float NEG = -__builtin_inff();
#pragma unroll
    for (int r = 0; r < 16; ++r) {
        const int c = (r & 3) + 8 * (r >> 2);
        if ((unsigned)(dq - c) >= W) p0[r] = NEG;
        if ((unsigned)(dq - c - 32) >= W) p1[r] = NEG;
    }
}
__device__ __forceinline__ void partialSM(f32x16& p0, f32x16& p1, float& m_reg, float& mn, float& alpha) {
    float pmax = p0[0]; for (int r = 1; r < 16; ++r) pmax = fmaxf(pmax, p0[r]); for (int r = 0; r < 16; ++r) pmax = fmaxf(pmax, p1[r]);
    { auto rr = __builtin_amdgcn_permlane32_swap(__float_as_uint(pmax), __float_as_uint(pmax), false, false);
      pmax = fmaxf(__uint_as_float(rr[0]), __uint_as_float(rr[1])); }
    constexpr float C2 = 1.4426950408889634f * SCALE;
    if (__builtin_expect(__all((pmax - m_reg) * SCALE <= THR), 1)) { mn = m_reg; alpha = 1.f; }
    else { mn = fmaxf(m_reg, pmax); alpha = __builtin_amdgcn_exp2f((m_reg - mn) * C2); m_reg = mn; }
    const float mnL = -mn * C2;
    for (int r = 0; r < 16; ++r) p0[r] = fmaf(p0[r], C2, mnL); for (int r = 0; r < 16; ++r) p1[r] = fmaf(p1[r], C2, mnL);
    for (int r = 0; r < 16; ++r) p0[r] = __builtin_amdgcn_exp2f(p0[r]);
}
__device__ __forceinline__ void finishSM(f32x16& p0, f32x16& p1, float alpha, float& l_reg, bf16x8& pa0, bf16x8& pa1, bf16x8& pa2, bf16x8& pa3) {
    for (int r = 0; r < 16; ++r) p1[r] = __builtin_amdgcn_exp2f(p1[r]);
    float ps = 0; for (int r = 0; r < 16; ++r) ps += p0[r]; for (int r = 0; r < 16; ++r) ps += p1[r];
    { auto rr = __builtin_amdgcn_permlane32_swap(__float_as_uint(ps), __float_as_uint(ps), false, false);
      ps = __uint_as_float(rr[0]) + __uint_as_float(rr[1]); }
    l_reg = l_reg * alpha + ps;
#define PK4(P, B_, OUT) do { unsigned a0 = cvtpk(P[B_+0], P[B_+1]), a1 = cvtpk(P[B_+2], P[B_+3]);                          \
        unsigned b0 = cvtpk(P[B_+4], P[B_+5]), b1 = cvtpk(P[B_+6], P[B_+7]);                                             \
        auto r0 = __builtin_amdgcn_permlane32_swap(a0, b0, false, false); auto r1 = __builtin_amdgcn_permlane32_swap(a1, b1, false, false); \
        u32x4 w = {r0[0], r1[0], r0[1], r1[1]}; OUT = *reinterpret_cast<bf16x8*>(&w); } while (0)
    PK4(p0, 0, pa0); PK4(p0, 8, pa1); PK4(p1, 0, pa2); PK4(p1, 8, pa3);
#undef PK4
}
template <int KB, bool SK>
__device__ __forceinline__ void qkt(f32x16& p0, f32x16& p1, const char* K_lds, int r32, int hi, const bf16x8* qr, bool act) {
    if (SK && !act) { const float NEG = -__builtin_inff();
#pragma unroll
        for (int r = 0; r < 16; ++r) { p0[r] = NEG; p1[r] = NEG; } return; }
    p0 = f32x16{}; p1 = f32x16{};
    const char* kb[4];
#pragma unroll
    for (int dd = 0; dd < 4; ++dd) kb[dd] = K_lds + KB * SHM_K + KSWZ(r32, (dd * 16 + hi * 8) * 2);
#pragma unroll
    for (int d0 = 0; d0 < 8; ++d0) { const char* a = kb[d0 & 3] + (d0 >> 2) * 128;
        bf16x8 b0 = *reinterpret_cast<const bf16x8*>(a);
        bf16x8 b1 = *reinterpret_cast<const bf16x8*>(a + 32 * 256);
        p0 = __builtin_amdgcn_mfma_f32_32x32x16_bf16(b0, qr[d0], p0, 0, 0, 0);
        p1 = __builtin_amdgcn_mfma_f32_32x32x16_bf16(b1, qr[d0], p1, 0, 0, 0); }
}
template <int VB, bool SK>
__device__ __forceinline__ void pv_tile(f32x16* o, int vb0, bf16x8 pa0, bf16x8 pa1, bf16x8 pa2, bf16x8 pa3, bool act) {
    if (SK && !act) return;
#define TRRD(dst, off) asm volatile("ds_read_b64_tr_b16 %0, %1 offset:%2" : "=&v"(dst) : "v"(vb0), "i"(off) : "memory")
#define PV_D0(d0) do { s16x4 l0, l1, l2, l3, h0, h1, h2, h3; constexpr int b_ = VB * SHM_V + v_rd_off(d0, 0, 0);     \
        TRRD(l0, b_); TRRD(h0, b_ + 2048); TRRD(l1, b_ + 4096); TRRD(h1, b_ + 6144); TRRD(l2, b_ + 8192); TRRD(h2, b_ + 10240); TRRD(l3, b_ + 12288); TRRD(h3, b_ + 14336); \
        asm volatile("s_waitcnt lgkmcnt(0)" ::: "memory"); SBAR();                 \
        o[d0] = __builtin_amdgcn_mfma_f32_32x32x16_bf16(pa0, (bf16x8){l0[0], l0[1], l0[2], l0[3], h0[0], h0[1], h0[2], h0[3]}, o[d0], 0, 0, 0);   \
        o[d0] = __builtin_amdgcn_mfma_f32_32x32x16_bf16(pa1, (bf16x8){l1[0], l1[1], l1[2], l1[3], h1[0], h1[1], h1[2], h1[3]}, o[d0], 0, 0, 0);   \
        o[d0] = __builtin_amdgcn_mfma_f32_32x32x16_bf16(pa2, (bf16x8){l2[0], l2[1], l2[2], l2[3], h2[0], h2[1], h2[2], h2[3]}, o[d0], 0, 0, 0);   \
        o[d0] = __builtin_amdgcn_mfma_f32_32x32x16_bf16(pa3, (bf16x8){l3[0], l3[1], l3[2], l3[3], h3[0], h3[1], h3[2], h3[3]}, o[d0], 0, 0, 0); } while (0)
    PV_D0(0); PV_D0(1); PV_D0(2); PV_D0(3);
#undef PV_D0
#undef TRRD
}

template <class TIn, class TOut> struct BlockRef { const TIn* Q; const TIn* K; const TIn* V; TOut* O; float* L; int P0, pitch, opitch, lpitch, nq; };
template <class TIn> struct Seam {
    bf16x8 qr[8];
    bf16x8 st_v0, st_v1, st_k0, st_k1; f32x4 sf0, sf1, sf2, sf3;
    f32x4 tq[16];
};
__device__ __forceinline__ int swa_jlo(int P0, int W) { const int lowk = P0 - W + 1; return lowk > 0 ? lowk / KVBLK : 0; }
#define ROW(p, k0, rr) ((p) + (size_t)((k0) + (rr)) * PITCH_ + sc)
#define VMW() asm volatile("s_waitcnt vmcnt(0)" ::: "memory")
#define VMWN(n) asm volatile("s_waitcnt vmcnt(%0)" :: "i"(n) : "memory")
#define SLOAD_H(Kp, Vp, k0) do { S.st_v0 = load8<TIn>(ROW(Vp, k0, sr)); S.st_v1 = load8<TIn>(ROW(Vp, k0, 32 + sr));              \
                         S.st_k0 = load8<TIn>(ROW(Kp, k0, sr)); S.st_k1 = load8<TIn>(ROW(Kp, k0, 32 + sr)); } while (0)
#define SWRITE_HK(bf) do { *(bf16x8*)(K_lds + (bf) * SHM_K + kws) = S.st_k0; *(bf16x8*)(K_lds + (bf) * SHM_K + kws + 32 * 256) = S.st_k1; } while (0)
#define SWRITE_HV(bf) do { *(bf16x8*)(V_lds + (bf) * SHM_V + vst0) = S.st_v0; *(bf16x8*)(V_lds + (bf) * SHM_V + vst1) = S.st_v1; } while (0)
#define SWRITE_H(bf) do { SWRITE_HV(bf); SWRITE_HK(bf); } while (0)
#define SLOAD_F(p, k0) do { S.sf0 = *(const f32x4*)ROW(p, k0, sr); S.sf1 = *(const f32x4*)(ROW(p, k0, sr) + 4);                \
                            S.sf2 = *(const f32x4*)ROW(p, k0, 32 + sr); S.sf3 = *(const f32x4*)(ROW(p, k0, 32 + sr) + 4); } while (0)
#define SWRITE_KF(bf) do { *(bf16x8*)(K_lds + (bf) * SHM_K + kws) = pack8(S.sf0, S.sf1); *(bf16x8*)(K_lds + (bf) * SHM_K + kws + 32 * 256) = pack8(S.sf2, S.sf3); } while (0)
#define SWRITE_VF(bf) do { *(bf16x8*)(V_lds + (bf) * SHM_V + vst0) = pack8(S.sf0, S.sf1); *(bf16x8*)(V_lds + (bf) * SHM_V + vst1) = pack8(S.sf2, S.sf3); } while (0)
template <class TIn, class TOut>
__device__ __forceinline__ void causal_swa_prime(const BlockRef<TIn, TOut>& cur, int W, char* lds, Seam<TIn>& S, int wave_s) {
    constexpr bool F32 = same_t<TIn, float>::v;
    const int tid = tid_from(wave_s), wid = wave_s, lane = tid & 63, r32 = lane & 31, hi = lane >> 5;
    const int sr = tid >> 4, sc = (tid & 15) * 8, kws = KSWZ(sr, sc * 2); char* K_lds = lds + 2 * SHM_V;
    const int kb0 = swa_jlo(cur.P0, W) * KVBLK;
    const int PITCH_ = cur.pitch; const int qrow_ = (wid * QBLK + r32 < cur.nq) ? wid * QBLK + r32 : cur.nq - 1;
    for (int d0 = 0; d0 < 8; ++d0) S.qr[d0] = load8<TIn>(cur.Q + (size_t)qrow_ * PITCH_ + d0 * 16 + hi * 8);
    if constexpr (F32) { SLOAD_F((const float*)cur.K, kb0); VMW(); SWRITE_KF(0); SBAR(); SLOAD_F((const float*)cur.V, kb0); }
    else { SLOAD_H(cur.K, cur.V, kb0); VMW(); SWRITE_HK(0); }
    __syncthreads();
}
template <class TIn, class TOut>
__device__ __forceinline__ void causal_swa_block(const BlockRef<TIn, TOut>& cur, const BlockRef<TIn, TOut>& nxt, int skv, int W, char* lds, Seam<TIn>& S, int wave_s) {
    constexpr bool F32 = same_t<TIn, float>::v;
    const int tid = tid_from(wave_s), wid = wave_s, lane = tid & 63, r32 = lane & 31, hi = lane >> 5;
    int PITCH_ = cur.pitch; const bool wact = (wid * QBLK < cur.nq);
    const int j_lo = swa_jlo(cur.P0, W);
    int j_hi = (cur.P0 + QB - 1) / KVBLK + 1; if (j_hi > skv / KVBLK) j_hi = skv / KVBLK;
    const int NT = j_hi - j_lo;
    const int kbn = swa_jlo(nxt.P0, W) * KVBLK;
    const int qlo = cur.P0 + wid * QBLK, qm = qlo + r32 - 4 * hi;
    char* V_lds = lds; char* K_lds = lds + 2 * SHM_V;
    float* ws = (float*)(lds + 2 * SHM_V + 2 * SHM_K) + wid * 64; float* li_l = ws, * al_l = ws + 32;
    float m_reg = -1e30f, l_reg = 0; f32x16 o[4] = {};
    const int sr = tid >> 4, sc = (tid & 15) * 8, vst0 = v_st(sr, sc), vst1 = v_st(32 + sr, sc), kws = KSWZ(sr, sc * 2);
    const int vb0 = (int)(uintptr_t)V_lds + v_rd_base(lane);
    const TIn* Kh = cur.K; const TIn* Vh = cur.V;
#define RESC(a) do { if (__any((a) < 1.f)) { if (hi == 0) al_l[r32] = (a); asm volatile("s_waitcnt lgkmcnt(0)" ::: "memory");              \
                     for (int d_ = 0; d_ < 4; ++d_) for (int r = 0; r < 16; ++r) o[d_][r] *= al_l[crow(r, hi)]; } } while (0)
#define KBASE(t) ((j_lo + (t)) * KVBLK)
#define ACT(t) (wact && KBASE(t) <= qlo + QBLK - 1 && KBASE(t) + KVBLK - 1 >= qlo - W + 1)
#define MASKT(P0_, P1_, t) do { const int kb_ = KBASE(t); if ((!SK || ACT(t)) && (kb_ + KVBLK - 1 > qlo || kb_ <= qlo + QBLK - 1 - W)) mask_tile(P0_, P1_, qm - kb_, (unsigned)W); } while (0)
    constexpr int NQL = F32 ? 16 : 8;
    constexpr bool SK = WSKIP && !F32;
#define SEAM_K0() do { VMWN(NQL); if constexpr (F32) { SWRITE_KF(0); SBAR(); SLOAD_F((const float*)nxt.V, kbn); } else { SWRITE_HK(0); } SBAR(); } while (0)
    f32x16 pA0, pA1, pB0, pB1; float mnA, mnB, alA, alB; bf16x8 pa0, pa1, pa2, pa3;
    if constexpr (F32) { VMW(); SWRITE_VF(0); SBAR(); } else { SWRITE_HV(0); SBAR(); }
    if (NT > 1) { if constexpr (F32) SLOAD_F((const float*)Kh, KBASE(1)); else SLOAD_H(Kh, Vh, KBASE(1)); }
    SBAR(); qkt<0, SK>(pA0, pA1, K_lds, r32, hi, S.qr, ACT(0));
    if constexpr (F32) { if (NT > 1) { VMW(); SWRITE_KF(1); SBAR(); SLOAD_F((const float*)Vh, KBASE(1)); } }
    MASKT(pA0, pA1, 0); partialSM(pA0, pA1, m_reg, mnA, alA);
    if (NT > 1) { VMW(); if constexpr (F32) { SWRITE_VF(1); SBAR(); if (NT > 2) SLOAD_F((const float*)Kh, KBASE(2)); } else SWRITE_H(1); }
    __syncthreads();
#define HALF_STEP(PX0, PX1, mnX, alX, PY0, PY1, alY, t, KB, VB, SB) do {                                                      \
        SBAR(); if constexpr (!F32) { if ((t) + 1 < NT) { SLOAD_H(Kh, Vh, KBASE((t) + 1)); SBAR(); } }     \
        qkt<KB, SK>(PX0, PX1, K_lds, r32, hi, S.qr, ACT(t));                                             \
        finishSM(PY0, PY1, alY, l_reg, pa0, pa1, pa2, pa3); SBAR();                                                           \
        if constexpr (F32) { if ((t) + 1 < NT) { VMW(); SWRITE_KF(SB); SBAR(); SLOAD_F((const float*)Vh, KBASE((t) + 1)); SBAR(); } }  \
        pv_tile<VB, SK>(o, vb0, pa0, pa1, pa2, pa3, ACT((t) - 1)); MASKT(PX0, PX1, (t)); partialSM(PX0, PX1, m_reg, mnX, alX);                                        \
        __syncthreads();                                                                                                      \
        if ((t) + 1 < NT) { VMW(); if constexpr (F32) { SWRITE_VF(SB); SBAR(); if ((t) + 2 < NT) SLOAD_F((const float*)Kh, KBASE((t) + 2)); } \
                            else { SWRITE_H(SB); } }                                                                          \
        RESC(alX); __syncthreads(); } while (0)
    for (int t = 1; t + 1 < NT; t += 2) {
        HALF_STEP(pB0, pB1, mnB, alB, pA0, pA1, alA, t, 1, 0, 0);
        HALF_STEP(pA0, pA1, mnA, alA, pB0, pB1, alB, t + 1, 0, 1, 1);
    }
    const bool even = (NT & 1) == 0;
    if (even) { SBAR(); qkt<1, SK>(pB0, pB1, K_lds, r32, hi, S.qr, ACT(NT - 1)); SBAR(); }
#define QROW(e) (nxt.Q + (size_t)(wid * QBLK + r32) * D + ((e) >> 1) * 16 + hi * 8 + ((e) & 1) * 4)
    if constexpr (F32) { SLOAD_F((const float*)nxt.K, kbn); SBAR();
#pragma unroll
        for (int e = 0; e < 8; ++e) S.tq[e] = *(const f32x4*)QROW(e); }
    else { PITCH_ = nxt.pitch; SLOAD_H(nxt.K, nxt.V, kbn); SBAR();
        const int qrow_ = (wid * QBLK + r32 < nxt.nq) ? wid * QBLK + r32 : nxt.nq - 1;
#pragma unroll
        for (int d0 = 0; d0 < 8; ++d0) S.qr[d0] = load8<TIn>(nxt.Q + (size_t)qrow_ * PITCH_ + d0 * 16 + hi * 8); }
    SBAR();
    finishSM(pA0, pA1, alA, l_reg, pa0, pa1, pa2, pa3); SBAR();
    if constexpr (F32) {
#pragma unroll
        for (int e = 8; e < 16; ++e) S.tq[e] = *(const f32x4*)QROW(e); SBAR(); }
#undef QROW
    pv_tile<0, SK>(o, vb0, pa0, pa1, pa2, pa3, ACT(even ? NT - 2 : NT - 1));
    if (even) { MASKT(pB0, pB1, NT - 1); partialSM(pB0, pB1, m_reg, mnB, alB); __syncthreads(); RESC(alB);
        finishSM(pB0, pB1, alB, l_reg, pa0, pa1, pa2, pa3); SBAR(); pv_tile<1, SK>(o, vb0, pa0, pa1, pa2, pa3, ACT(NT - 1)); }
    SBAR(); SEAM_K0();
    if (hi == 0) li_l[r32] = l_reg; asm volatile("s_waitcnt lgkmcnt(0)" ::: "memory");
    float rli[16];
#pragma unroll
    for (int r = 0; r < 16; ++r) rli[r] = __builtin_amdgcn_rcpf(li_l[crow(r, hi)]);
    const int OP_ = cur.opitch; TOut* Ow = cur.O + (size_t)(wid * QBLK) * OP_;
    if (wact) {
    if (hi == 0) cur.L[(size_t)(wid * QBLK + r32) * cur.lpitch] = m_reg * (1.4426950408889634f * SCALE) + __builtin_amdgcn_logf(l_reg);
#pragma unroll
    for (int r = 0; r < 16; ++r) { const int orow = crow(r, hi);
#pragma unroll
        for (int d0 = 0; d0 < 4; ++d0) { const float v = o[d0][r] * rli[r];
            if constexpr (same_t<TOut, float>::v) { Ow[(size_t)orow * OP_ + d0 * 32 + r32] = v; }
            else { const float vn = __builtin_bit_cast(float, __builtin_amdgcn_mov_dpp(__builtin_bit_cast(int, v), 0xB1, 0xF, 0xF, true));
                   if ((r32 & 1) == 0) *(unsigned*)(Ow + (size_t)orow * OP_ + d0 * 32 + r32) = cvtpk(v, vn); } } }
    }
    if constexpr (F32) {
#pragma unroll
        for (int d0 = 0; d0 < 8; ++d0) S.qr[d0] = pack8(S.tq[2 * d0], S.tq[2 * d0 + 1]); }
    __syncthreads();
#undef RESC
#undef KBASE
#undef ACT
#undef MASKT
#undef SEAM_K0
#undef HALF_STEP
}
#undef ROW
#undef VMW
#undef VMWN
#undef SLOAD_H
#undef SWRITE_HK
#undef SWRITE_HV
#undef SWRITE_H
#undef SLOAD_F
#undef SWRITE_KF
#undef SWRITE_VF

constexpr int DMA_KR = 0, DMA_VR = 3 * SHM_K, DMA_SCR = DMA_VR + 3 * SHM_V, DMA_LDS_BYTES = DMA_SCR + NW * 64 * 4;
template <class TIn, class TOut>
__device__ __forceinline__ void block_dma(const BlockRef<TIn, TOut>& cur, int skv, int W, char* lds, int wave_s) {
    const int tid = tid_from(wave_s), wid = wave_s, lane = tid & 63, r32 = lane & 31, hi = lane >> 5;
    const int j_lo = swa_jlo(cur.P0, W);
    int j_hi = (cur.P0 + QB - 1) / KVBLK + 1; if (j_hi > skv / KVBLK) j_hi = skv / KVBLK;
    const int NT = j_hi - j_lo, PITCH_ = cur.pitch;
    const bool wact = (wid * QBLK < cur.nq);
    const int qlo = cur.P0 + wid * QBLK, qm = qlo + r32 - 4 * hi;
    float* wsf = (float*)(lds + DMA_SCR) + wid * 64; float* li_l = wsf; float* al_l = wsf + 32;
    int kOff[2], vOff[2];
#pragma unroll
    for (int j = 0; j < 2; ++j) kOff[j] = (4 * (2 * wid + j) + (lane >> 4)) * PITCH_ + (((lane & 15) ^ ((lane >> 4) + 4 * j)) * 8);
    { const int kk = wid * 8 + ((lane & 31) >> 2), k = (kk & ~0xC) | ((kk & 4) << 1) | ((kk & 8) >> 1);
#pragma unroll
      for (int j = 0; j < 2; ++j) vOff[j] = k * PITCH_ + (((2 * j + (lane >> 5)) & 3) * 32 + (lane & 3) * 8); }
    typedef __attribute__((address_space(3))) unsigned lds_u32;
    const unsigned ldsb = (unsigned)(size_t)(__attribute__((address_space(3))) char*)lds;
#define DMA_TILE(t, slot) do { const TIn* kt_ = cur.K + (size_t)(j_lo + (t)) * KVBLK * PITCH_; const TIn* vt_ = cur.V + (size_t)(j_lo + (t)) * KVBLK * PITCH_; \
        _Pragma("unroll") for (int j = 0; j < 2; ++j) { \
            __builtin_amdgcn_global_load_lds((const unsigned*)(kt_ + kOff[j]), (lds_u32*)(size_t)(ldsb + DMA_KR + (slot) * SHM_K + (2 * wid + j) * 1024), 16, 0, 0); \
            __builtin_amdgcn_global_load_lds((const unsigned*)(vt_ + vOff[j]), (lds_u32*)(size_t)(ldsb + DMA_VR + (slot) * SHM_V + (2 * wid + j) * 1024), 16, 0, 0); } } while (0)
    bf16x8 qr[8];
    { const int qrow_ = (wid * QBLK + r32 < cur.nq) ? wid * QBLK + r32 : cur.nq - 1;
#pragma unroll
      for (int d0 = 0; d0 < 8; ++d0) qr[d0] = load8<TIn>(cur.Q + (size_t)qrow_ * PITCH_ + d0 * 16 + hi * 8); }
    DMA_TILE(0, 0);
    if (NT > 1) DMA_TILE(1, 1);
    float m_reg = -1e30f, l_reg = 0; f32x16 o[4] = {};
    const int vbase = (int)ldsb + DMA_VR + v_rd_base(lane);
    int slot = 0, slot2 = 2;
#pragma unroll 1
    for (int t = 0; t < NT; ++t) {
        if (t + 1 < NT) asm volatile("s_waitcnt vmcnt(4)" ::: "memory"); else asm volatile("s_waitcnt vmcnt(0)" ::: "memory");
        asm volatile("s_waitcnt lgkmcnt(0)" ::: "memory"); __builtin_amdgcn_s_barrier(); asm volatile("" ::: "memory");
        if (t + 2 < NT) DMA_TILE(t + 2, slot2);
        const int kb_ = (j_lo + t) * KVBLK;
        const bool act = wact && kb_ <= qlo + QBLK - 1 && kb_ + KVBLK - 1 >= qlo - W + 1;
        if (act) {
            f32x16 p0, p1; float mn, al; bf16x8 pa0, pa1, pa2, pa3;
            SBAR(); qkt<0, false>(p0, p1, lds + DMA_KR + slot * SHM_K, r32, hi, qr, true);
            if (kb_ + KVBLK - 1 > qlo || kb_ <= qlo + QBLK - 1 - W) mask_tile(p0, p1, qm - kb_, (unsigned)W);
            partialSM(p0, p1, m_reg, mn, al);
            finishSM(p0, p1, al, l_reg, pa0, pa1, pa2, pa3); SBAR();
            if (__any(al < 1.f)) { if (hi == 0) al_l[r32] = al; asm volatile("s_waitcnt lgkmcnt(0)" ::: "memory");
                for (int d_ = 0; d_ < 4; ++d_) for (int r = 0; r < 16; ++r) o[d_][r] *= al_l[crow(r, hi)]; }
            pv_tile<0, false>(o, vbase + slot * SHM_V, pa0, pa1, pa2, pa3, true);
        }
        slot = slot == 2 ? 0 : slot + 1; slot2 = slot2 == 2 ? 0 : slot2 + 1;
    }
#undef DMA_TILE
    if (wact) {
        if (hi == 0) li_l[r32] = l_reg; asm volatile("s_waitcnt lgkmcnt(0)" ::: "memory");
        float rli[16];
#pragma unroll
        for (int r = 0; r < 16; ++r) rli[r] = __builtin_amdgcn_rcpf(li_l[crow(r, hi)]);
        const int OP_ = cur.opitch; TOut* Ow = cur.O + (size_t)(wid * QBLK) * OP_;
        if (hi == 0) cur.L[(size_t)(wid * QBLK + r32) * cur.lpitch] = m_reg * (1.4426950408889634f * SCALE) + __builtin_amdgcn_logf(l_reg);
#pragma unroll
        for (int r = 0; r < 16; ++r) { const int orow = crow(r, hi);
#pragma unroll
            for (int d0 = 0; d0 < 4; ++d0) { const float v = o[d0][r] * rli[r];
                const float vn = __builtin_bit_cast(float, __builtin_amdgcn_mov_dpp(__builtin_bit_cast(int, v), 0xB1, 0xF, 0xF, true));
                if ((r32 & 1) == 0) *(unsigned*)(Ow + (size_t)orow * OP_ + d0 * 32 + r32) = cvtpk(v, vn); } }
    }
    asm volatile("s_waitcnt lgkmcnt(0)" ::: "memory"); __builtin_amdgcn_s_barrier(); asm volatile("" ::: "memory");
}
typedef BlockRef<bf16_t, bf16_t> Ref;
}
#undef KSWZ

__device__ __forceinline__ swa::Ref attn_ref(unsigned char* ws, int L, int& skv) {
    int gi, b, h, c, qb;
    if (L < 256) { gi = 0; b = L >> 5; h = (L >> 3) & 3; qb = L & 7; c = 0; }
    else if (L < 512) { L -= 256; gi = 1; b = L >> 5; h = (L >> 3) & 3; c = (L >> 1) & 3; qb = L & 1; }
    else { L -= 512; gi = 2; const int v = L & 255, idx = (v & 31) * 2 + (L >> 8); b = v >> 5; h = idx >> 4; c = idx & 15; qb = 0; }
    const int d = gi == 0 ? 1 : (gi == 1 ? 4 : 16);
    const int n = SEQ / d;
    const size_t hb = ((size_t)(gi * BATCH + b) * HPG + h) * SEQ * HD + (size_t)c * n * HD, kstep = (size_t)3 * BATCH * HPG * SEQ * HD;
    const bf16_t* qkv = (const bf16_t*)(ws + OFF_QKV);
    const size_t tok0 = (size_t)b * SEQ + c + (size_t)qb * 256 * d;
    swa::Ref r;
    r.Q = qkv + hb + (size_t)qb * 256 * HD; r.K = qkv + kstep + hb; r.V = qkv + 2 * kstep + hb;
    r.O = (bf16_t*)(ws + OFF_AO) + ((size_t)gi * MTOK + tok0) * ATT_W + h * HD; r.opitch = d * ATT_W;
    r.L = (float*)(ws + OFF_ALSE) + ((size_t)gi * MTOK + tok0) * 4 + h; r.lpitch = d * 4;
    r.P0 = qb * 256; r.pitch = HD; r.nq = gi == 2 ? 128 : 256;
    skv = SEQ / d;
    return r;
}
namespace wsa2 {
using swa::f32x16; using swa::s16x4; using swa::crow; using swa::cvtpk; using swa::v_rd_base; using swa::SCALE; using swa::THR;
constexpr int BLK_K = 8192, SLOT = 16384, NSLOT = 9, SCR = NSLOT * SLOT, LDS_NEED = SCR + NWAVES * 256;
static_assert(LDS_NEED <= MISC_OFF, "wsa2 LDS");
#define W2_KSWZ(row, colB) ((row) * 256 + ((colB) ^ (((row) & 7) << 4)))
#define W2_SBAR() __builtin_amdgcn_sched_barrier(0)
__device__ __forceinline__ void unit(const swa::Ref& u, LAS unsigned char* lds, int wave_s) {
    const int tid = tid_from(wave_s), wid = wave_s, lane = tid & 63, r32 = lane & 31, hi = lane >> 5;
    const int I0 = u.P0, i0 = I0 + 32 * wid;
    const bool wact = 32 * wid < u.nq;
    const int B0 = (I0 >= 128 ? I0 - 128 : 0) >> 5;
    const int kfirst = i0 >= 128 ? i0 - 128 : 0, nblk = wact ? ((i0 - kfirst) >> 5) + 1 : 0, fw = (kfirst >> 5) - B0;
    const int ilast = I0 + u.nq - 32, klast = ilast >= 128 ? ilast - 128 : 0;
    const int nbtot = (ilast >> 5) - B0 + 1, niter = ((ilast - klast) >> 5) + 1;
    const int krow = 4 * wid + (lane >> 4), kchunk = (lane & 15) ^ (4 * (wid & 1) + (lane >> 4));
    const int kk = (wid >> 1) * 8 + ((lane & 31) >> 2), vkey = (kk & ~0xC) | ((kk & 4) << 1) | ((kk & 8) >> 1), vcol = ((2 * (wid & 1) + (lane >> 5)) & 3) * 32 + (lane & 3) * 8;
    const bf16_t* ksrc = u.K + (size_t)(B0 * 32 + krow) * HD + kchunk * 8;
    const bf16_t* vsrc = u.V + (size_t)(B0 * 32 + vkey) * HD + vcol;
    typedef __attribute__((address_space(3))) unsigned lds_u32;
    const unsigned ldsb = (unsigned)(size_t)lds;
#define W2_DMA(b, slot) do { __builtin_amdgcn_global_load_lds((const unsigned*)(ksrc + (size_t)(b) * 32 * HD), (lds_u32*)(size_t)(ldsb + (slot) * SLOT + wid * 1024), 16, 0, 0); \
        __builtin_amdgcn_global_load_lds((const unsigned*)(vsrc + (size_t)(b) * 32 * HD), (lds_u32*)(size_t)(ldsb + (slot) * SLOT + BLK_K + wid * 1024), 16, 0, 0); } while (0)
    for (int b = 0; b < 8 && b < nbtot; ++b) W2_DMA(b, b);
    bf16x8 qr[8];
    { const int qrow = wact ? 32 * wid + r32 : u.nq - 1;
#pragma unroll
      for (int d0 = 0; d0 < 8; ++d0) qr[d0] = *(const bf16x8*)(u.Q + (size_t)qrow * HD + d0 * 16 + hi * 8); }
    LAS float* li_l = (LAS float*)(lds + SCR + wid * 256); LAS float* al_l = li_l + 32;
    float m_reg = -1e30f, l_reg = 0.f; f32x16 o[4] = {};
    constexpr float C2 = 1.4426950408889634f * SCALE;
    int koff[4];
#pragma unroll
    for (int dd = 0; dd < 4; ++dd) koff[dd] = W2_KSWZ(r32, (dd * 16 + hi * 8) * 2);
    const unsigned vrb = ldsb + BLK_K + (unsigned)v_rd_base(lane);
#pragma unroll 1
    for (int i = 0; i < niter; ++i) {
        asm volatile("s_waitcnt vmcnt(0)" ::: "memory");
        asm volatile("s_waitcnt lgkmcnt(0)" ::: "memory"); __builtin_amdgcn_s_barrier(); asm volatile("" ::: "memory");
        if (i + 8 < nbtot) { const int s8 = (i + 8) % NSLOT; W2_DMA(i + 8, s8); }
        if (i < nblk) {
            const int rel = fw + i, slot = rel % NSLOT, k0 = (B0 + rel) * 32;
            const LAS unsigned char* kb = lds + slot * SLOT;
            f32x16 p = {};
#pragma unroll
            for (int d0 = 0; d0 < 8; ++d0) { const bf16x8 kf = *(const LAS bf16x8*)(kb + koff[d0 & 3] + (d0 >> 2) * 128);
                p = __builtin_amdgcn_mfma_f32_32x32x16_bf16(kf, qr[d0], p, 0, 0, 0); }
            if (k0 == i0 || k0 + 128 == i0) {
                const int dq = i0 + r32 - k0 - 4 * hi; const float NEG = -__builtin_inff();
#pragma unroll
                for (int r = 0; r < 16; ++r) { const int c = (r & 3) + 8 * (r >> 2); if ((unsigned)(dq - c) >= 129u) p[r] = NEG; }
            }
            float pmax = p[0];
#pragma unroll
            for (int r = 1; r < 16; ++r) pmax = fmaxf(pmax, p[r]);
            { auto rr = __builtin_amdgcn_permlane32_swap(__float_as_uint(pmax), __float_as_uint(pmax), false, false); pmax = fmaxf(__uint_as_float(rr[0]), __uint_as_float(rr[1])); }
            float mn, alpha;
            if (__builtin_expect(__all((pmax - m_reg) * SCALE <= THR), 1)) { mn = m_reg; alpha = 1.f; }
            else { mn = fmaxf(m_reg, pmax); alpha = __builtin_amdgcn_exp2f((m_reg - mn) * C2); m_reg = mn; }
            const float mnL = -mn * C2;
#pragma unroll
            for (int r = 0; r < 16; ++r) p[r] = __builtin_amdgcn_exp2f(fmaf(p[r], C2, mnL));
            float ps = 0.f;
#pragma unroll
            for (int r = 0; r < 16; ++r) ps += p[r];
            { auto rr = __builtin_amdgcn_permlane32_swap(__float_as_uint(ps), __float_as_uint(ps), false, false); ps = __uint_as_float(rr[0]) + __uint_as_float(rr[1]); }
            l_reg = l_reg * alpha + ps;
            bf16x8 pa0, pa1;
#define W2_PK4(B_, OUT) do { unsigned a0 = cvtpk(p[B_+0], p[B_+1]), a1 = cvtpk(p[B_+2], p[B_+3]), b0 = cvtpk(p[B_+4], p[B_+5]), b1 = cvtpk(p[B_+6], p[B_+7]); \
            auto r0 = __builtin_amdgcn_permlane32_swap(a0, b0, false, false); auto r1 = __builtin_amdgcn_permlane32_swap(a1, b1, false, false); \
            u32x4 w = {r0[0], r1[0], r0[1], r1[1]}; OUT = *reinterpret_cast<bf16x8*>(&w); } while (0)
            W2_PK4(0, pa0); W2_PK4(8, pa1);
#undef W2_PK4
            if (__any(alpha < 1.f)) {
                if (hi == 0) al_l[r32] = alpha;
                asm volatile("s_waitcnt lgkmcnt(0)" ::: "memory");
#pragma unroll
                for (int d_ = 0; d_ < 4; ++d_)
#pragma unroll
                    for (int r = 0; r < 16; ++r) o[d_][r] *= al_l[crow(r, hi)];
            }
            const unsigned vb0 = vrb + (unsigned)(slot * SLOT);
#define W2_TR(dst, off) asm volatile("ds_read_b64_tr_b16 %0, %1 offset:%2" : "=&v"(dst) : "v"(vb0), "i"(off) : "memory")
#define W2_PV(d0) do { s16x4 l0, l1, h0, h1; W2_TR(l0, (d0) * 512); W2_TR(h0, (d0) * 512 + 2048); W2_TR(l1, (d0) * 512 + 4096); W2_TR(h1, (d0) * 512 + 6144); \
            asm volatile("s_waitcnt lgkmcnt(0)" ::: "memory"); W2_SBAR(); \
            o[d0] = __builtin_amdgcn_mfma_f32_32x32x16_bf16(pa0, (bf16x8){l0[0], l0[1], l0[2], l0[3], h0[0], h0[1], h0[2], h0[3]}, o[d0], 0, 0, 0); \
            o[d0] = __builtin_amdgcn_mfma_f32_32x32x16_bf16(pa1, (bf16x8){l1[0], l1[1], l1[2], l1[3], h1[0], h1[1], h1[2], h1[3]}, o[d0], 0, 0, 0); } while (0)
            W2_PV(0); W2_PV(1); W2_PV(2); W2_PV(3);
#undef W2_PV
#undef W2_TR
        }
    }
#undef W2_DMA
    if (wact) {
        if (hi == 0) li_l[r32] = l_reg;
        asm volatile("s_waitcnt lgkmcnt(0)" ::: "memory");
        float rli[16];
#pragma unroll
        for (int r = 0; r < 16; ++r) rli[r] = __builtin_amdgcn_rcpf(li_l[crow(r, hi)]);
        if (hi == 0) u.L[(size_t)(32 * wid + r32) * u.lpitch] = m_reg * C2 + __builtin_amdgcn_logf(l_reg);
        const int OP = u.opitch; bf16_t* Ow = u.O + (size_t)(32 * wid) * OP;
#pragma unroll
        for (int r = 0; r < 16; ++r) { const int orow = crow(r, hi);
#pragma unroll
            for (int d0 = 0; d0 < 4; ++d0) { const float v = o[d0][r] * rli[r];
                const float vn = __builtin_bit_cast(float, __builtin_amdgcn_mov_dpp(__builtin_bit_cast(int, v), 0xB1, 0xF, 0xF, true));
                if ((r32 & 1) == 0) *(unsigned*)(Ow + (size_t)orow * OP + d0 * 32 + r32) = cvtpk(v, vn); } }
    }
    asm volatile("s_waitcnt lgkmcnt(0)" ::: "memory"); __builtin_amdgcn_s_barrier(); asm volatile("" ::: "memory");
}
#undef W2_KSWZ
#undef W2_SBAR
}

constexpr int N_ATTN_BLOCKS = 1024;

namespace wsa3 {
using swa::f32x16; using swa::s16x4; using swa::crow; using swa::cvtpk; using swa::v_rd_base; using swa::SCALE; using swa::THR;
constexpr int BLK_K = 8192, SLOT = 16384, NSLOT = 9, SCR = NSLOT * SLOT, LDS_NEED = SCR + NWAVES * 256;
static_assert(LDS_NEED <= MISC_OFF, "wsa3 LDS");
#define W3_KSWZ(row, colB) ((row) * 256 + ((colB) ^ (((row) & 7) << 4)))
#define W3_SBAR() __builtin_amdgcn_sched_barrier(0)
__device__ __forceinline__ void wait_vm_ops(int n) {
    switch (n >> 1) {
    case 0: asm volatile("s_waitcnt vmcnt(0)" ::: "memory"); break;
    case 1: asm volatile("s_waitcnt vmcnt(2)" ::: "memory"); break;
    case 2: asm volatile("s_waitcnt vmcnt(4)" ::: "memory"); break;
    case 3: asm volatile("s_waitcnt vmcnt(6)" ::: "memory"); break;
    case 4: asm volatile("s_waitcnt vmcnt(8)" ::: "memory"); break;
    case 5: asm volatile("s_waitcnt vmcnt(10)" ::: "memory"); break;
    case 6: asm volatile("s_waitcnt vmcnt(12)" ::: "memory"); break;
    case 7: asm volatile("s_waitcnt vmcnt(14)" ::: "memory"); break;
    case 8: asm volatile("s_waitcnt vmcnt(16)" ::: "memory"); break;
    case 9: asm volatile("s_waitcnt vmcnt(18)" ::: "memory"); break;
    case 10: asm volatile("s_waitcnt vmcnt(20)" ::: "memory"); break;
    case 11: asm volatile("s_waitcnt vmcnt(22)" ::: "memory"); break;
    case 12: asm volatile("s_waitcnt vmcnt(24)" ::: "memory"); break;
    case 13: asm volatile("s_waitcnt vmcnt(26)" ::: "memory"); break;
    case 14: asm volatile("s_waitcnt vmcnt(28)" ::: "memory"); break;
    case 15: asm volatile("s_waitcnt vmcnt(30)" ::: "memory"); break;
    case 16: asm volatile("s_waitcnt vmcnt(32)" ::: "memory"); break;
    case 17: asm volatile("s_waitcnt vmcnt(34)" ::: "memory"); break;
    case 18: asm volatile("s_waitcnt vmcnt(36)" ::: "memory"); break;
    case 19: asm volatile("s_waitcnt vmcnt(38)" ::: "memory"); break;
    case 20: asm volatile("s_waitcnt vmcnt(40)" ::: "memory"); break;
    case 21: asm volatile("s_waitcnt vmcnt(42)" ::: "memory"); break;
    case 22: asm volatile("s_waitcnt vmcnt(44)" ::: "memory"); break;
    case 23: asm volatile("s_waitcnt vmcnt(46)" ::: "memory"); break;
    case 24: asm volatile("s_waitcnt vmcnt(48)" ::: "memory"); break;
    case 25: asm volatile("s_waitcnt vmcnt(50)" ::: "memory"); break;
    case 26: asm volatile("s_waitcnt vmcnt(52)" ::: "memory"); break;
    case 27: asm volatile("s_waitcnt vmcnt(54)" ::: "memory"); break;
    case 28: asm volatile("s_waitcnt vmcnt(56)" ::: "memory"); break;
    case 29: asm volatile("s_waitcnt vmcnt(58)" ::: "memory"); break;
    case 30: asm volatile("s_waitcnt vmcnt(60)" ::: "memory"); break;
    default: asm volatile("s_waitcnt vmcnt(62)" ::: "memory"); break;
    }
}
__device__ __forceinline__ void phase(const Frame& F, unsigned char* ws, int layer, unsigned long long& ts_sum, unsigned long long& ts_t0) {
    const int wid = F.wave, tid = tid_from(wid), lane = tid & 63, r32 = lane & 31, hi = lane >> 5;
    LAS unsigned char* lds = F.lds;
    const int nU = F.vcu < N_ATTN_BLOCKS ? (N_ATTN_BLOCKS - 1 - F.vcu) / F.G + 1 : 0;
    if (nU == 0) return;
    const int krow = 4 * wid + (lane >> 4), kchunk = (lane & 15) ^ (4 * (wid & 1) + (lane >> 4));
    const int kk = (wid >> 1) * 8 + ((lane & 31) >> 2), vkey = (kk & ~0xC) | ((kk & 4) << 1) | ((kk & 8) >> 1), vcol = ((2 * (wid & 1) + (lane >> 5)) & 3) * 32 + (lane & 3) * 8;
    const unsigned klane = (unsigned)(krow * HD + kchunk * 8) * 2u, vlane = (unsigned)(vkey * HD + vcol) * 2u;
    typedef __attribute__((address_space(3))) unsigned lds_u32;
    const unsigned ldsb = (unsigned)(size_t)lds;
    LAS float* li_l = (LAS float*)(lds + SCR + wid * 256); LAS float* al_l = li_l + 32;
    constexpr float C2 = 1.4426950408889634f * SCALE;
    int koff[4];
#pragma unroll
    for (int dd = 0; dd < 4; ++dd) koff[dd] = W3_KSWZ(r32, (dd * 16 + hi * 8) * 2);
    const unsigned vrb = ldsb + BLK_K + (unsigned)v_rd_base(lane);
    int kI = -1, tI = 5, jI = 0, nbI = 0, issued = 0, consumed = 0, islot = 0, qmark = -1, smark = -1, nst = 0;
    const char* kbI = nullptr; const char* vbI = nullptr;
    bf16x8 qn[8], qr[8];
#define W3_SETUP_I() do { int skv_; const swa::Ref ri = attn_ref(ws, F.vcu + kI * F.G, skv_); \
        const int I0_ = ri.P0, B0_ = (I0_ >= 128 ? I0_ - 128 : 0) >> 5; nbI = ((I0_ + ri.nq - 32) >> 5) - B0_ + 1; tI = 0; jI = 0; \
        kbI = (const char*)(ri.K + (size_t)B0_ * 32 * HD); vbI = (const char*)(ri.V + (size_t)B0_ * 32 * HD); \
        const int qrow_ = 32 * wid < ri.nq ? 32 * wid + r32 : ri.nq - 1; const bf16_t* qp_ = ri.Q + (size_t)qrow_ * HD + hi * 8; \
        _Pragma("unroll") for (int d0 = 0; d0 < 8; ++d0) asm volatile("global_load_dwordx4 %0, %1, off" : "=v"(qn[d0]) : "v"(qp_ + d0 * 16) : "memory"); \
        qmark = issued; } while (0)
#define W3_ISSUE(kC_) do { for (;;) { \
        if (tI >= 5) { if (kI + 1 >= nU || kI >= (kC_) + 1) break; ++kI; W3_SETUP_I(); } \
        if (issued - consumed >= NSLOT) break; \
        __builtin_amdgcn_global_load_lds((const unsigned*)(kbI + (size_t)jI * (32 * HD * 2) + klane), (lds_u32*)(size_t)(ldsb + islot * SLOT + wid * 1024), 16, 0, 2); \
        __builtin_amdgcn_global_load_lds((const unsigned*)(vbI + (size_t)jI * (32 * HD * 2) + vlane), (lds_u32*)(size_t)(ldsb + islot * SLOT + BLK_K + wid * 1024), 16, 0, 2); \
        ++issued; islot = islot == NSLOT - 1 ? 0 : islot + 1; \
        jI += 5; while (tI < 5 && jI >= nbI) { ++tI; jI = tI; } } } while (0)
    asm volatile("s_waitcnt lgkmcnt(0)" ::: "memory"); __builtin_amdgcn_s_barrier(); asm volatile("" ::: "memory");
    W3_ISSUE(-1);
    int spos = 0;
#pragma unroll 1
    for (int kC = 0; kC < nU; ++kC) {
        if (W_TOUCH2 == 2 && kC == nU - 1 && F.vcu < 256 && wid < 3) {
            const int ln_ = tid_from(wid) & 63, cu_ = F.vcu; const char* tp_;
            if (wid == 0) tp_ = (const char*)(ws + OFF_WOUT) + (size_t)layer * D_MODEL * D_MODEL * 2 + ((size_t)cu_ * 64 + ln_) * 128;
            else if (wid == 1) tp_ = (ln_ < 32 ? (const char*)(ws + OFF_WBS) + (size_t)layer * D_MODEL * SSM_W * 2 : (const char*)(ws + OFF_WBA) + (size_t)layer * D_MODEL * ATT_W * 2) + ((size_t)cu_ * 32 + (ln_ & 31)) * 128;
            else tp_ = (const char*)(ws + OFF_WGLU) + (size_t)layer * SSM_W * SSM_W * 2 + ((size_t)cu_ * 16 + (ln_ & 15)) * 128;
            __builtin_amdgcn_global_load_lds((const unsigned*)tp_, (lds_u32*)(size_t)(ldsb + 155648 + wid * 256), 4, 0, 0);
        }
        int skv; const swa::Ref u = attn_ref(ws, F.vcu + kC * F.G, skv);
        const int I0 = u.P0, i0 = I0 + 32 * wid;
        const bool wact = 32 * wid < u.nq;
        const int B0 = (I0 >= 128 ? I0 - 128 : 0) >> 5;
        const int kfirst = i0 >= 128 ? i0 - 128 : 0, nblk = wact ? ((i0 - kfirst) >> 5) + 1 : 0, fw = (kfirst >> 5) - B0;
        const int nbtot = ((I0 + u.nq - 32) >> 5) - B0 + 1;
        float m_reg = -1e30f, l_reg = 0.f; f32x16 o[4] = {};
#pragma unroll 1
        for (int t = 0; t < 5; ++t) {
            const int cnt = t < nbtot ? (nbtot - t + 4) / 5 : 0;
            if (cnt == 0) continue;
            TS_BEGIN(31);
            { const int endp = spos + cnt; wait_vm_ops(2 * (issued - endp) + (qmark >= endp ? 8 : 0) + (smark >= endp ? nst : 0)); }
            asm volatile("s_waitcnt lgkmcnt(0)" ::: "memory"); __builtin_amdgcn_s_barrier(); asm volatile("" ::: "memory");
            if (t == 0) {
                asm volatile("" : "+v"(qn[0]), "+v"(qn[1]), "+v"(qn[2]), "+v"(qn[3]), "+v"(qn[4]), "+v"(qn[5]), "+v"(qn[6]), "+v"(qn[7]));
#pragma unroll
                for (int d0 = 0; d0 < 8; ++d0) qr[d0] = qn[d0];
            }
            TS_END(31); TS_BEGIN(34);
            consumed = spos; W3_ISSUE(kC);
            TS_END(34); TS_BEGIN(32);
            const int rj = (t - fw) % 5, j = fw + (rj < 0 ? rj + 5 : rj);
            if (j < fw + nblk) {
                const int slot = (spos + (j - t) / 5) % NSLOT, k0 = (B0 + j) * 32;
                const LAS unsigned char* kb = lds + slot * SLOT;
                f32x16 p = {};
#pragma unroll
                for (int d0 = 0; d0 < 8; ++d0) { const bf16x8 kf = *(const LAS bf16x8*)(kb + koff[d0 & 3] + (d0 >> 2) * 128);
                    p = __builtin_amdgcn_mfma_f32_32x32x16_bf16(kf, qr[d0], p, 0, 0, 0); }
                if (k0 == i0 || k0 + 128 == i0) {
                    const int dq = i0 + r32 - k0 - 4 * hi; const float NEG = -__builtin_inff();
#pragma unroll
                    for (int r = 0; r < 16; ++r) { const int c = (r & 3) + 8 * (r >> 2); if ((unsigned)(dq - c) >= 129u) p[r] = NEG; }
                }
                float pmax = p[0];
#pragma unroll
                for (int r = 1; r < 16; ++r) pmax = fmaxf(pmax, p[r]);
                { auto rr = __builtin_amdgcn_permlane32_swap(__float_as_uint(pmax), __float_as_uint(pmax), false, false); pmax = fmaxf(__uint_as_float(rr[0]), __uint_as_float(rr[1])); }
                float mn, alpha;
                if (__builtin_expect(__all((pmax - m_reg) * SCALE <= THR), 1)) { mn = m_reg; alpha = 1.f; }
                else { mn = fmaxf(m_reg, pmax); alpha = __builtin_amdgcn_exp2f((m_reg - mn) * C2); m_reg = mn; }
                const float mnL = -mn * C2;
#pragma unroll
                for (int r = 0; r < 16; ++r) p[r] = __builtin_amdgcn_exp2f(fmaf(p[r], C2, mnL));
                float ps = 0.f;
#pragma unroll
                for (int r = 0; r < 16; ++r) ps += p[r];
                { auto rr = __builtin_amdgcn_permlane32_swap(__float_as_uint(ps), __float_as_uint(ps), false, false); ps = __uint_as_float(rr[0]) + __uint_as_float(rr[1]); }
                l_reg = l_reg * alpha + ps;
                bf16x8 pa0, pa1;
#define W3_PK4(B_, OUT) do { unsigned a0 = cvtpk(p[B_+0], p[B_+1]), a1 = cvtpk(p[B_+2], p[B_+3]), b0 = cvtpk(p[B_+4], p[B_+5]), b1 = cvtpk(p[B_+6], p[B_+7]); \
                auto r0 = __builtin_amdgcn_permlane32_swap(a0, b0, false, false); auto r1 = __builtin_amdgcn_permlane32_swap(a1, b1, false, false); \
                u32x4 w = {r0[0], r1[0], r0[1], r1[1]}; OUT = *reinterpret_cast<bf16x8*>(&w); } while (0)
                W3_PK4(0, pa0); W3_PK4(8, pa1);
#undef W3_PK4
                if (__any(alpha < 1.f)) {
                    if (hi == 0) al_l[r32] = alpha;
                    asm volatile("s_waitcnt lgkmcnt(0)" ::: "memory");
#pragma unroll
                    for (int d_ = 0; d_ < 4; ++d_)
#pragma unroll
                        for (int r = 0; r < 16; ++r) o[d_][r] *= al_l[crow(r, hi)];
                }
                const unsigned vb0 = vrb + (unsigned)(slot * SLOT);
#define W3_TR(dst, off) asm volatile("ds_read_b64_tr_b16 %0, %1 offset:%2" : "=&v"(dst) : "v"(vb0), "i"(off) : "memory")
#define W3_PV(d0) do { s16x4 l0, l1, h0, h1; W3_TR(l0, (d0) * 512); W3_TR(h0, (d0) * 512 + 2048); W3_TR(l1, (d0) * 512 + 4096); W3_TR(h1, (d0) * 512 + 6144); \
                asm volatile("s_waitcnt lgkmcnt(0)" ::: "memory"); W3_SBAR(); \
                o[d0] = __builtin_amdgcn_mfma_f32_32x32x16_bf16(pa0, (bf16x8){l0[0], l0[1], l0[2], l0[3], h0[0], h0[1], h0[2], h0[3]}, o[d0], 0, 0, 0); \
                o[d0] = __builtin_amdgcn_mfma_f32_32x32x16_bf16(pa1, (bf16x8){l1[0], l1[1], l1[2], l1[3], h1[0], h1[1], h1[2], h1[3]}, o[d0], 0, 0, 0); } while (0)
                W3_PV(0); W3_PV(1); W3_PV(2); W3_PV(3);
#undef W3_PV
#undef W3_TR
            }
            spos += cnt;
            TS_END(32);
        }
        TS_BEGIN(33);
        if (wact) {
            if (hi == 0) li_l[r32] = l_reg;
            asm volatile("s_waitcnt lgkmcnt(0)" ::: "memory");
            float rli[16];
#pragma unroll
            for (int r = 0; r < 16; ++r) rli[r] = __builtin_amdgcn_rcpf(li_l[crow(r, hi)]);
            { const float lse = m_reg * C2 + __builtin_amdgcn_logf(l_reg); const unsigned lo_ = (unsigned)((32 * wid + r32) * u.lpitch) * 4u;
              asm volatile("global_store_dword %0, %1, %2" :: "v"(lo_), "v"(lse), "s"(u.L) : "memory"); }
            const int OP = u.opitch; const bf16_t* Ow = u.O + (size_t)(32 * wid) * OP;
            const unsigned lane_off = (unsigned)(4 * hi * OP + 4 * r32) * 2u;
#pragma unroll
            for (int r = 0; r < 16; ++r) { const unsigned vo = lane_off + (unsigned)(((r & 3) + 8 * (r >> 2)) * OP) * 2u;
                typedef unsigned u32x2_ __attribute__((ext_vector_type(2)));
                u32x2_ w; w.x = cvtpk(o[0][r] * rli[r], o[1][r] * rli[r]); w.y = cvtpk(o[2][r] * rli[r], o[3][r] * rli[r]);
                asm volatile("global_store_dwordx2 %0, %1, %2" :: "v"(vo), "v"(w), "s"(Ow) : "memory"); }
            smark = issued; nst = 17;
        } else { smark = -1; nst = 0; }
        TS_END(33);
    }
#undef W3_ISSUE
#undef W3_SETUP_I
    asm volatile("s_waitcnt lgkmcnt(0)" ::: "memory"); __builtin_amdgcn_s_barrier(); asm volatile("" ::: "memory");
}
#undef W3_KSWZ
#undef W3_SBAR
}


__device__ __forceinline__ void attn_phase(const Frame& F, unsigned char* ws, int layer, unsigned long long& ts_sum, unsigned long long& ts_t0) {
#if ATTN_DMA == 3
    wsa3::phase(F, ws, layer, ts_sum, ts_t0);
    return;
#endif
#if ATTN_DMA == 2
#if EXP_HALF == 2
    if (F.vcu & 1) return;
    for (int L = F.vcu; L < N_ATTN_BLOCKS; L += F.G) { for (int e = 0; e < 2; ++e) { int skv; const swa::Ref cur = attn_ref(ws, L + e, skv); wsa2::unit(cur, F.lds, F.wave); } }
    return;
#endif
    for (int L = F.vcu; L < N_ATTN_BLOCKS; L += F.G) { int skv; const swa::Ref cur = attn_ref(ws, L, skv); wsa2::unit(cur, F.lds, F.wave); }
    return;
#elif ATTN_DMA == 1
    for (int L = F.vcu; L < N_ATTN_BLOCKS; L += F.G) { int skv; const swa::Ref cur = attn_ref(ws, L, skv); swa::block_dma<bf16_t, bf16_t>(cur, skv, 129, (char*)F.lds, F.wave); }
    return;
#endif
    int L = F.vcu; if (L >= N_ATTN_BLOCKS) return;
    char* lds = (char*)F.lds;
    int skv, skvn; swa::Ref cur = attn_ref(ws, L, skv);
    swa::Seam<bf16_t> S;
    swa::causal_swa_prime<bf16_t, bf16_t>(cur, 129, lds, S, F.wave);
    for (;;) {
        const int Ln = L + F.G; const bool last = Ln >= N_ATTN_BLOCKS;
        swa::Ref nxt = cur; skvn = skv; if (!last) nxt = attn_ref(ws, Ln, skvn);
        swa::causal_swa_block<bf16_t, bf16_t>(cur, nxt, skv, 129, lds, S, F.wave);
        if (last) break;
        cur = nxt; skv = skvn; L = Ln;
    }
}

namespace wsa {
using swa::f32x16; using swa::s16x4; using swa::crow; using swa::cvtpk; using swa::v_st; using swa::v_rd_base; using swa::SCALE; using swa::THR;
constexpr int VBUF = 8192;
constexpr int WAVE_LDS = 2 * VBUF + 256;
struct Item { const bf16_t* Q; const bf16_t* K; const bf16_t* V; bf16_t* O; float* L; int i0, pitch, opitch, lpitch; };
constexpr int N_ITEMS = 3 * 2048;
__device__ __forceinline__ Item decode(unsigned char* ws, int it) {
    const int gi = it >> 11, r = it & 2047, b = r >> 8, h = (r >> 6) & 3;
    int c, qw, d;
    if (gi == 0) { c = 0; qw = r & 63; d = 1; } else if (gi == 1) { c = (r >> 4) & 3; qw = r & 15; d = 4; } else { c = (r >> 2) & 15; qw = r & 3; d = 16; }
    Item x; x.i0 = 32 * qw; x.pitch = HD; x.opitch = d * ATT_W; x.lpitch = d * 4;
    const size_t hb = ((size_t)(gi * BATCH + b) * HPG + h) * SEQ * HD + (size_t)c * (SEQ / d) * HD, kstep = (size_t)3 * BATCH * HPG * SEQ * HD;
    const bf16_t* qkv = (const bf16_t*)(ws + OFF_QKV);
    const size_t tok0 = (size_t)b * SEQ + c + (size_t)x.i0 * d;
    x.Q = qkv + hb + (size_t)x.i0 * HD; x.K = qkv + kstep + hb; x.V = qkv + 2 * kstep + hb;
    x.O = (bf16_t*)(ws + OFF_AO) + ((size_t)gi * MTOK + tok0) * ATT_W + h * HD;
    x.L = (float*)(ws + OFF_ALSE) + ((size_t)gi * MTOK + tok0) * 4 + h;
    return x;
}
#define WSA_SBAR() __builtin_amdgcn_sched_barrier(0)
__device__ __forceinline__ void wave_item(const Item& it, LAS unsigned char* wl, int lane) {
    const int r32 = lane & 31, hi = lane >> 5, pitch = it.pitch;
    LAS float* li_l = (LAS float*)(wl + 2 * VBUF); LAS float* al_l = li_l + 32;
    const int kfirst = it.i0 >= 128 ? it.i0 - 128 : 0, nblk = ((it.i0 - kfirst) >> 5) + 1;
    const bf16_t* qp = it.Q + (size_t)r32 * pitch + hi * 8;
    const bf16_t* kp = it.K + (size_t)(kfirst + r32) * pitch + hi * 8;
    const int vkey = lane >> 4, vch = (lane & 15) * 8;
    const bf16_t* vp = it.V + (size_t)(kfirst + vkey) * pitch + vch;
    int vst_off[8];
#pragma unroll
    for (int i = 0; i < 8; ++i) vst_off[i] = v_st(vkey + 4 * i, vch);
    bf16x8 qr[8], kf[8], vs[8];
#pragma unroll
    for (int d0 = 0; d0 < 8; ++d0) qr[d0] = *(const bf16x8*)(qp + d0 * 16);
#pragma unroll
    for (int d0 = 0; d0 < 8; ++d0) kf[d0] = *(const bf16x8*)(kp + d0 * 16);
#pragma unroll
    for (int i = 0; i < 8; ++i) vs[i] = *(const bf16x8*)(vp + (size_t)(4 * i) * pitch);
#pragma unroll
    for (int i = 0; i < 8; ++i) *(LAS bf16x8*)(wl + vst_off[i]) = vs[i];
    float m_reg = -1e30f, l_reg = 0.f; f32x16 o[4] = {};
    const unsigned vbase = (unsigned)(size_t)wl + (unsigned)v_rd_base(lane);
    constexpr float C2 = 1.4426950408889634f * SCALE;
#pragma unroll 1
    for (int blk = 0; blk < nblk; ++blk) {
        const int k0 = kfirst + 32 * blk; const bool more = blk + 1 < nblk;
        if (more) {
#pragma unroll
            for (int i = 0; i < 8; ++i) vs[i] = *(const bf16x8*)(vp + (size_t)(32 * (blk + 1) + 4 * i) * pitch);
        }
        f32x16 p = {};
#pragma unroll
        for (int d0 = 0; d0 < 8; ++d0) p = __builtin_amdgcn_mfma_f32_32x32x16_bf16(kf[d0], qr[d0], p, 0, 0, 0);
        if (more) {
#pragma unroll
            for (int d0 = 0; d0 < 8; ++d0) kf[d0] = *(const bf16x8*)(kp + (size_t)(32 * (blk + 1)) * pitch + d0 * 16);
        }
        if (k0 == it.i0 || k0 + 128 == it.i0) {
            const int dq = it.i0 + r32 - k0 - 4 * hi; const float NEG = -__builtin_inff();
#pragma unroll
            for (int r = 0; r < 16; ++r) { const int c = (r & 3) + 8 * (r >> 2); if ((unsigned)(dq - c) >= 129u) p[r] = NEG; }
        }
        float pmax = p[0];
#pragma unroll
        for (int r = 1; r < 16; ++r) pmax = fmaxf(pmax, p[r]);
        { auto rr = __builtin_amdgcn_permlane32_swap(__float_as_uint(pmax), __float_as_uint(pmax), false, false); pmax = fmaxf(__uint_as_float(rr[0]), __uint_as_float(rr[1])); }
        float mn, alpha;
        if (__builtin_expect(__all((pmax - m_reg) * SCALE <= THR), 1)) { mn = m_reg; alpha = 1.f; }
        else { mn = fmaxf(m_reg, pmax); alpha = __builtin_amdgcn_exp2f((m_reg - mn) * C2); m_reg = mn; }
        const float mnL = -mn * C2;
#pragma unroll
        for (int r = 0; r < 16; ++r) p[r] = __builtin_amdgcn_exp2f(fmaf(p[r], C2, mnL));
        float ps = 0.f;
#pragma unroll
        for (int r = 0; r < 16; ++r) ps += p[r];
        { auto rr = __builtin_amdgcn_permlane32_swap(__float_as_uint(ps), __float_as_uint(ps), false, false); ps = __uint_as_float(rr[0]) + __uint_as_float(rr[1]); }
        l_reg = l_reg * alpha + ps;
        bf16x8 pa0, pa1;
#define WSA_PK4(B_, OUT) do { unsigned a0 = cvtpk(p[B_+0], p[B_+1]), a1 = cvtpk(p[B_+2], p[B_+3]), b0 = cvtpk(p[B_+4], p[B_+5]), b1 = cvtpk(p[B_+6], p[B_+7]); \
        auto r0 = __builtin_amdgcn_permlane32_swap(a0, b0, false, false); auto r1 = __builtin_amdgcn_permlane32_swap(a1, b1, false, false); \
        u32x4 w = {r0[0], r1[0], r0[1], r1[1]}; OUT = *reinterpret_cast<bf16x8*>(&w); } while (0)
        WSA_PK4(0, pa0); WSA_PK4(8, pa1);
#undef WSA_PK4
        if (__any(alpha < 1.f)) {
            if (hi == 0) al_l[r32] = alpha;
            asm volatile("s_waitcnt lgkmcnt(0)" ::: "memory");
#pragma unroll
            for (int d_ = 0; d_ < 4; ++d_)
#pragma unroll
                for (int r = 0; r < 16; ++r) o[d_][r] *= al_l[crow(r, hi)];
        }
        const unsigned vb0 = vbase + (unsigned)((blk & 1) * VBUF);
#define WSA_TR(dst, off) asm volatile("ds_read_b64_tr_b16 %0, %1 offset:%2" : "=&v"(dst) : "v"(vb0), "i"(off) : "memory")
#define WSA_PV(d0) do { s16x4 l0, l1, h0, h1; WSA_TR(l0, (d0) * 512); WSA_TR(h0, (d0) * 512 + 2048); WSA_TR(l1, (d0) * 512 + 4096); WSA_TR(h1, (d0) * 512 + 6144); \
        asm volatile("s_waitcnt lgkmcnt(0)" ::: "memory"); WSA_SBAR(); \
        o[d0] = __builtin_amdgcn_mfma_f32_32x32x16_bf16(pa0, (bf16x8){l0[0], l0[1], l0[2], l0[3], h0[0], h0[1], h0[2], h0[3]}, o[d0], 0, 0, 0); \
        o[d0] = __builtin_amdgcn_mfma_f32_32x32x16_bf16(pa1, (bf16x8){l1[0], l1[1], l1[2], l1[3], h1[0], h1[1], h1[2], h1[3]}, o[d0], 0, 0, 0); } while (0)
        WSA_PV(0); WSA_PV(1); WSA_PV(2); WSA_PV(3);
#undef WSA_PV
#undef WSA_TR
        if (more) {
            LAS unsigned char* nb = wl + ((blk + 1) & 1) * VBUF;
#pragma unroll
            for (int i = 0; i < 8; ++i) *(LAS bf16x8*)(nb + vst_off[i]) = vs[i];
        }
        asm volatile("s_waitcnt lgkmcnt(0)" ::: "memory");
    }
    if (hi == 0) li_l[r32] = l_reg;
    asm volatile("s_waitcnt lgkmcnt(0)" ::: "memory");
    float rli[16];
#pragma unroll
    for (int r = 0; r < 16; ++r) rli[r] = __builtin_amdgcn_rcpf(li_l[crow(r, hi)]);
    if (hi == 0) it.L[(size_t)r32 * it.lpitch] = m_reg * C2 + __builtin_amdgcn_logf(l_reg);
    const int OP = it.opitch;
#pragma unroll
    for (int r = 0; r < 16; ++r) { const int orow = crow(r, hi);
#pragma unroll
        for (int d0 = 0; d0 < 4; ++d0) { const float v = o[d0][r] * rli[r];
            const float vn = __builtin_bit_cast(float, __builtin_amdgcn_mov_dpp(__builtin_bit_cast(int, v), 0xB1, 0xF, 0xF, true));
            if ((r32 & 1) == 0) *(unsigned*)(it.O + (size_t)orow * OP + d0 * 32 + r32) = cvtpk(v, vn); } }
    asm volatile("s_waitcnt lgkmcnt(0)" ::: "memory");
}
#undef WSA_SBAR
__device__ __forceinline__ void phase(const Frame& F, unsigned char* ws) {
    const int lane = tid_from(F.wave) & 63;
    LAS unsigned char* wl = F.lds + F.wave * WAVE_LDS;
#pragma unroll 1
    for (int it = F.vcu * NWAVES + F.wave; it < N_ITEMS; it += F.G * NWAVES) { const Item x = decode(ws, it); wave_item(x, wl, lane); }
}
}

namespace s5 {
constexpr size_t T_WST = 2 * MiB;
constexpr size_t T_WO = 10 * MiB;
constexpr size_t T_KT = 18 * MiB;
constexpr size_t T_A16 = 20 * MiB;
constexpr int RSTR = 528;
constexpr int U_OFF = 0, L_OFF = 128 * RSTR;
constexpr int LDS_NEED = 2 * 128 * RSTR + 4096;
__device__ __forceinline__ void tables_wg(const Args& a, LAS unsigned char* lds, int lg, int wave_s) {
    typedef float f32x2 __attribute__((ext_vector_type(2)));
    LAS f32x2* PW = (LAS f32x2*)lds; LAS f32x2* BB = PW + 17 * 64; LAS f32x2* CT = BB + 64 * 16;
    const int tid = tid_from(wave_s); unsigned char* ws = a.p.ws;
    if (tid < 64) {
        const int idx = lg * 64 + tid;
        const float lre = fminf(inptr(a, IN_LRE)[idx], -1e-4f), lim = inptr(a, IN_LIM)[idx], dt = expf(inptr(a, IN_LDT)[lg]);
        const float ar = lre * dt, b = lim * dt, ea = expf(ar), sb = sinf(b), cb = cosf(b);
        const float Are = ea * cb, Aim = ea * sb, sh = sinf(0.5f * b);
        const float Dre = expm1f(ar) * cb - 2.0f * sh * sh, Dim = Aim;
        const float den = lre * lre + lim * lim;
        const float cre = (Dre * lre + Dim * lim) / den, cim = (Dim * lre - Dre * lim) / den;
        float* A = (float*)(ws + OFF_S5 + S5_A); float* Bb = (float*)(ws + OFF_S5 + S5_BB);
        A[idx * 2] = Are; A[idx * 2 + 1] = Aim;
        const float* bre = inptr(a, IN_BRE) + idx * 16; const float* bim = inptr(a, IN_BIM) + idx * 16;
        for (int c = 0; c < 16; ++c) { const float br = bre[c], bi = bim[c]; const f32x2 v = {cre * br - cim * bi, cre * bi + cim * br};
            Bb[(idx * 16 + c) * 2] = v.x; Bb[(idx * 16 + c) * 2 + 1] = v.y; BB[tid * 16 + c] = v; }
        float pr = 1.f, pi = 0.f; asm volatile("" : "+v"(pr), "+v"(pi));
        for (int k = 0; k <= 16; ++k) { PW[k * 64 + tid] = (f32x2){pr, pi}; const float nr = pr * Are - pi * Aim, ni = pr * Aim + pi * Are; pr = nr; pi = ni; }
        const f32x2 a16 = PW[16 * 64 + tid];
        ((f32x2*)(ws + OFF_S5 + T_A16))[idx] = a16;
    } else {
        const float* cr = inptr(a, IN_CRE) + (size_t)lg * 1024; const float* ci = inptr(a, IN_CIM) + (size_t)lg * 1024;
        for (int e = tid - 64; e < 1024; e += NTHREADS - 64) { const int c = e >> 6, pp = e & 63; CT[pp * 16 + c] = (f32x2){cr[e], ci[e]}; }
    }
    __syncthreads();
    bf16_t* WST = (bf16_t*)(ws + OFF_S5 + T_WST) + (size_t)lg * 128 * 256;
    for (int e = tid; e < 4096; e += NTHREADS) {
        const int i = e >> 5, kk0 = (e & 31) * 8, s = kk0 >> 4, c0 = kk0 & 15, pp = i & 63; const bool im = i >= 64;
        const f32x2 w = PW[(15 - s) * 64 + pp]; float v[8];
#pragma unroll
        for (int j = 0; j < 8; ++j) { const f32x2 bb = BB[pp * 16 + c0 + j]; v[j] = im ? (w.x * bb.y + w.y * bb.x) : (w.x * bb.x - w.y * bb.y); }
        u32x4 o; o.x = pk2(v[0], v[1]); o.y = pk2(v[2], v[3]); o.z = pk2(v[4], v[5]); o.w = pk2(v[6], v[7]);
        *(u32x4*)(WST + (size_t)((((i >> 4) * 8 + ((e & 31) >> 2)) * 64 + ((e & 31) & 3) * 16 + (i & 15)) * 8)) = o;
    }
    bf16_t* WO = (bf16_t*)(ws + OFF_S5 + T_WO) + (size_t)lg * 256 * 128;
    for (int e = tid; e < 4096; e += NTHREADS) {
        const int row = e >> 4, i0 = (e & 15) * 8, t = row >> 4, c = row & 15; float v[8];
#pragma unroll
        for (int j = 0; j < 8; ++j) { const int ip = i0 + j, pp = ip & 63; const f32x2 cc = CT[pp * 16 + c], w = PW[(t + 1) * 64 + pp];
            v[j] = ip < 64 ? (cc.x * w.x - cc.y * w.y) : -(cc.x * w.y + cc.y * w.x); }
        u32x4 o; o.x = pk2(v[0], v[1]); o.y = pk2(v[2], v[3]); o.z = pk2(v[4], v[5]); o.w = pk2(v[6], v[7]);
        *(u32x4*)(WO + (size_t)(((t * 4 + ((e & 15) >> 2)) * 64 + ((e & 15) & 3) * 16 + c) * 8)) = o;
    }
    bf16_t* KT = (bf16_t*)(ws + OFF_S5 + T_KT) + (size_t)lg * 17 * 256;
    { const int la = tid >> 5, c = (tid >> 1) & 15, h = tid & 1; float acc[8];
#pragma unroll
      for (int j = 0; j < 8; ++j) acc[j] = 0.f;
      for (int pp = 0; pp < 64; ++pp) { const f32x2 cc = CT[pp * 16 + c], w = PW[la * 64 + pp]; const float zr = cc.x * w.x - cc.y * w.y, zi = cc.x * w.y + cc.y * w.x;
#pragma unroll
          for (int j = 0; j < 8; ++j) { const f32x2 bb = BB[pp * 16 + 8 * h + j]; acc[j] += zr * bb.x - zi * bb.y; } }
      u32x4 o; o.x = pk2(acc[0], acc[1]); o.y = pk2(acc[2], acc[3]); o.z = pk2(acc[4], acc[5]); o.w = pk2(acc[6], acc[7]);
      *(u32x4*)(KT + ((la + 1) * 16 + c) * 16 + 8 * h) = o;
      if (tid < 32) { unsigned z_ = 0u; asm volatile("" : "+v"(z_)); *(u32x4*)(KT + tid * 8) = (u32x4){z_, z_, z_, z_}; } }
    __syncthreads();
}
__device__ __forceinline__ void unit(LAS unsigned char* lds, unsigned char* ws, int layer, int b, int g, int wave_s, const float* dsk_l) {
    const int tid = tid_from(wave_s), wave = wave_s, lane = tid & 63, q = lane >> 4, r16 = lane & 15;
    const int lg = layer * 32 + g;
    const bf16_t* usrc = (const bf16_t*)(ws + OFF_UG) + (size_t)(b * SSM_NG + g) * SEQ * 16;
    if (W_TOUCH2 == 1) {
        const int ln_ = tid_from(wave_s) & 63, cu_ = b * SSM_NG + g;
        const char* tp_ = nullptr;
        if (wave == 0) tp_ = (const char*)(ws + OFF_WOUT) + (size_t)layer * D_MODEL * D_MODEL * 2 + ((size_t)cu_ * 64 + ln_) * 128;
        else if (wave == 1) tp_ = (ln_ < 32 ? (const char*)(ws + OFF_WBS) + (size_t)layer * D_MODEL * SSM_W * 2 : (const char*)(ws + OFF_WBA) + (size_t)layer * D_MODEL * ATT_W * 2) + ((size_t)cu_ * 32 + (ln_ & 31)) * 128;
        else if (wave == 2) tp_ = (const char*)(ws + OFF_WGLU) + (size_t)layer * SSM_W * SSM_W * 2 + ((size_t)cu_ * 16 + (ln_ & 15)) * 128;
        if (wave < 3) __builtin_amdgcn_global_load_lds((const unsigned*)tp_, (LAS unsigned*)(lds + 143360 + wave * 256), 4, 0, 0);
    }
    __builtin_amdgcn_s_waitcnt(0);
    bf16x8 uv[8], af[8], kfA[8], wfA[4], kfB[8], wfB[4];
#pragma unroll
    for (int k = 0; k < 8; ++k) uv[k] = __builtin_nontemporal_load((const bf16x8*)(usrc + (size_t)(tid + NTHREADS * k) * 8));
    { const bf16_t* W = (const bf16_t*)(ws + OFF_S5 + T_WST) + (size_t)lg * 128 * 256 + (size_t)(wave * 8 * 64 + lane) * 8;
#pragma unroll
      for (int ks = 0; ks < 8; ++ks) af[ks] = __builtin_nontemporal_load((const bf16x8*)(W + ks * 512));
      const bf16_t* KT = (const bf16_t*)(ws + OFF_S5 + T_KT) + (size_t)lg * 17 * 256;
      const bf16_t* WO = (const bf16_t*)(ws + OFF_S5 + T_WO) + (size_t)lg * 256 * 128;
#pragma unroll
      for (int ks = 0; ks < 8; ++ks) { const int lagA = wave - (2 * ks + (q >> 1)) + 1, lagB = (15 - wave) - (2 * ks + (q >> 1)) + 1;
          kfA[ks] = *(const bf16x8*)(KT + ((lagA > 0 ? lagA : 0) * 16 + r16) * 16 + 8 * (q & 1)); kfB[ks] = *(const bf16x8*)(KT + ((lagB > 0 ? lagB : 0) * 16 + r16) * 16 + 8 * (q & 1)); }
#pragma unroll
      for (int k2 = 0; k2 < 4; ++k2) { wfA[k2] = __builtin_nontemporal_load((const bf16x8*)(WO + (size_t)((wave * 4 + k2) * 64 + lane) * 8)); wfB[k2] = __builtin_nontemporal_load((const bf16x8*)(WO + (size_t)(((15 - wave) * 4 + k2) * 64 + lane) * 8)); } }
#pragma unroll
    for (int k = 0; k < 8; ++k) { const int piece = tid + NTHREADS * k, tok = piece >> 1, half = piece & 1;
        *(LAS bf16x8*)(lds + U_OFF + (tok >> 4) * RSTR + (tok & 15) * 32 + half * 16) = uv[k]; }
    asm volatile("s_waitcnt lgkmcnt(0)" ::: "memory"); __builtin_amdgcn_s_barrier(); asm volatile("" ::: "memory");
    {
      for (int nt = 0; nt < 8; ++nt) {
          f32x4 acc = {0.f, 0.f, 0.f, 0.f};
          const LAS unsigned char* ub = lds + U_OFF + (nt * 16 + r16) * RSTR + q * 16;
#pragma unroll
          for (int ks = 0; ks < 8; ++ks) acc = __builtin_amdgcn_mfma_f32_16x16x32_bf16(af[ks], *(const LAS bf16x8*)(ub + ks * 64), acc, 0, 0, 0);
          *(LAS f32x4*)(lds + L_OFF + (nt * 16 + r16) * RSTR + (wave * 16 + 4 * q) * 4) = acc;
      } }
    asm volatile("s_waitcnt lgkmcnt(0)" ::: "memory"); __builtin_amdgcn_s_barrier(); asm volatile("" ::: "memory");
    {
        typedef float f32x2 __attribute__((ext_vector_type(2)));
        const f32x2 a16 = ((const f32x2*)(ws + OFF_S5 + T_A16))[lg * 64 + lane];
        LAS float* EW = (LAS float*)(lds + 2 * 128 * RSTR);
        float lre[16], lim[16], qre[16], qim[16];
#pragma unroll
        for (int jj = 0; jj < 16; ++jj) { const LAS float* row = (const LAS float*)(lds + L_OFF + (wave * 16 + jj) * RSTR); lre[jj] = row[lane]; lim[jj] = row[64 + lane]; }
        float sre = 0.f, sim = 0.f;
#pragma unroll
        for (int jj = 0; jj < 16; ++jj) { qre[jj] = sre; qim[jj] = sim;
            const float nre = a16.x * sre - a16.y * sim + lre[jj], nim = a16.x * sim + a16.y * sre + lim[jj]; sre = nre; sim = nim; }
        EW[wave * 128 + lane] = sre; EW[wave * 128 + 64 + lane] = sim;
        float pr = a16.x, pi = a16.y;
#pragma unroll
        for (int k = 0; k < 4; ++k) { const float nr = pr * pr - pi * pi, ni = 2.f * pr * pi; pr = nr; pi = ni; }
        __syncthreads();
        float ere[7], eim[7];
#pragma unroll
        for (int v = 0; v < 7; ++v) { ere[v] = EW[v * 128 + lane]; eim[v] = EW[v * 128 + 64 + lane]; }
        float gre = 0.f, gim = 0.f;
#pragma unroll
        for (int v = 0; v < 7; ++v) if (v < wave) { const float nre = pr * gre - pi * gim + ere[v], nim = pr * gim + pi * gre + eim[v]; gre = nre; gim = nim; }
#pragma unroll
        for (int jj = 0; jj < 16; ++jj) {
            LAS bf16_t* row = (LAS bf16_t*)(lds + L_OFF + (wave * 16 + jj) * RSTR);
            row[lane] = f2bf(qre[jj] + gre); row[64 + lane] = f2bf(qim[jj] + gim);
            const float nre = a16.x * gre - a16.y * gim, nim = a16.x * gim + a16.y * gre; gre = nre; gim = nim;
        }
    }
    __syncthreads();
    {
      bf16_t* ypre = (bf16_t*)(ws + OFF_YPRE) + (size_t)b * SEQ * SSM_W + g * 16 + 4 * q;
      const f32x4 dk = *(const f32x4*)(dsk_l + g * 16 + 4 * q);
#pragma unroll
      for (int tt = 0; tt < 2; ++tt) {
          const int t = tt ? 15 - wave : wave, nks = (t >> 1) + 1;
          bf16x8 kf[8], wf[4];
#pragma unroll
          for (int ks = 0; ks < 8; ++ks) kf[ks] = tt ? kfB[ks] : kfA[ks];
#pragma unroll
          for (int k2 = 0; k2 < 4; ++k2) wf[k2] = tt ? wfB[k2] : wfA[k2];
#pragma unroll 1
          for (int nt = 0; nt < 8; ++nt) {
              f32x4 acc = {0.f, 0.f, 0.f, 0.f}, accB = {0.f, 0.f, 0.f, 0.f}, accC = {0.f, 0.f, 0.f, 0.f};
              const LAS unsigned char* ub = lds + U_OFF + (nt * 16 + r16) * RSTR + q * 16;
              const LAS unsigned char* sb = lds + L_OFF + (nt * 16 + r16) * RSTR + q * 16;
#pragma unroll
              for (int ks = 0; ks < 8; ks += 2) { if (ks < nks) acc = __builtin_amdgcn_mfma_f32_16x16x32_bf16(kf[ks], *(const LAS bf16x8*)(ub + ks * 64), acc, 0, 0, 0);
                  if (ks + 1 < nks) accB = __builtin_amdgcn_mfma_f32_16x16x32_bf16(kf[ks + 1], *(const LAS bf16x8*)(ub + (ks + 1) * 64), accB, 0, 0, 0); }
#pragma unroll
              for (int k2 = 0; k2 < 4; ++k2) accC = __builtin_amdgcn_mfma_f32_16x16x32_bf16(wf[k2], *(const LAS bf16x8*)(sb + k2 * 64), accC, 0, 0, 0);
              acc = acc + accB + accC;
              const int tok = 16 * (nt * 16 + r16) + t;
              typedef unsigned u32x2_ __attribute__((ext_vector_type(2)));
              const u32x2_ uu = *(const LAS u32x2_*)(lds + U_OFF + (nt * 16 + r16) * RSTR + t * 32 + q * 8);
              const float y0 = gelu_fast(acc[0] + dk[0] * blo(uu.x)), y1 = gelu_fast(acc[1] + dk[1] * bhi(uu.x)), y2 = gelu_fast(acc[2] + dk[2] * blo(uu.y)), y3 = gelu_fast(acc[3] + dk[3] * bhi(uu.y));
              *(unsigned long long*)(ypre + (size_t)tok * SSM_W) = (unsigned long long)pk2(y0, y1) | ((unsigned long long)pk2(y2, y3) << 32);
          }
      } }
    __syncthreads();
}
}


namespace p4 {
constexpr int XT = 8192, WT = 65536, SLOT = XT + WT;
constexpr int RED_OFF = 2 * SLOT, RED2_OFF = RED_OFF + 2048;
constexpr int JUNK_OFF = RED2_OFF + 2048;
static_assert(JUNK_OFF + 2048 <= MISC_OFF, "P4 LDS map");
constexpr size_t OFF_MG = OFF_T4;
typedef unsigned u32x2 __attribute__((ext_vector_type(2)));
#define P4_WAIT_V(n) asm volatile("s_waitcnt vmcnt(" #n ")" ::: "memory")
#define P4_WAIT_L(n) asm volatile("s_waitcnt lgkmcnt(" #n ")" ::: "memory")
#define P4_BAR __builtin_amdgcn_s_barrier()

struct G64 { const bf16_t* X; const bf16_t* W; int lxs, lws; };
struct Geo { int rr, ch0, foff, wave; };
__device__ __forceinline__ Geo make_geo(int wave, int lane) {
    Geo g; g.rr = lane >> 3; g.ch0 = (lane & 7) ^ (g.rr >> 1); g.wave = wave;
    const int fr = lane & 15, fq = lane >> 4;
    g.foff = fr * 128 + ((fq ^ (fr >> 1)) & 7) * 16;
    return g;
}
__device__ __forceinline__ void stage64_piece(LAS unsigned char* lds, const Geo& g, const G64& d, int kt, int slot, int p) {
    const unsigned ldsw = (unsigned)g.wave * 1024u;
    if (p == 0) { const unsigned vo = ((unsigned)g.rr << d.lxs) + (unsigned)((g.ch0 ^ ((g.wave & 1) << 2)) * 16);
        __builtin_amdgcn_global_load_lds((const unsigned*)((const char*)d.X + (size_t)kt * 128 + ((size_t)(8 * g.wave) << d.lxs) + vo), (LAS unsigned*)(lds + slot * SLOT + ldsw), 16, 0, 0); }
    else { const int i = p - 1; const unsigned vo = ((unsigned)(16 * (g.rr >> 2) + (g.rr & 3)) << d.lws) + (unsigned)((g.ch0 ^ ((i & 1) << 2)) * 16);
        __builtin_amdgcn_global_load_lds((const unsigned*)((const char*)d.W + (size_t)kt * 128 + ((size_t)(64 * g.wave + 32 * (i & 1) + 4 * (i >> 1)) << d.lws) + vo), (LAS unsigned*)(lds + slot * SLOT + XT + ldsw * 8 + i * 1024), 16, 0, 0); }
}
__device__ __forceinline__ void stage64(LAS unsigned char* lds, const Geo& g, const G64& d, int kt, int slot, int parts) {
    if (parts & 1) stage64_piece(lds, g, d, kt, slot, 0);
    if (parts & 2) {
#pragma unroll
        for (int p = 1; p < 9; ++p) stage64_piece(lds, g, d, kt, slot, p);
    }
}
template <int NKT>
__device__ __forceinline__ void run64(f32x4 (&acc)[4][4], LAS unsigned char* lds, const Geo& g, const G64& cur, const G64& nxt, int nparts, int rot, int nrot) {
#define P4_READS(k) do { _Pragma("unroll") for (int m = 0; m < 4; ++m) xf[m] = *(const LAS bf16x8*)(sb + (g.foff ^ ((k) * 64)) + m * 2048); \
        _Pragma("unroll") for (int n = 0; n < 4; ++n) wf[n] = *(const LAS bf16x8*)(sb + XT + g.wave * 8192 + (g.foff ^ ((k) * 64)) + n * 2048); } while (0)
#define P4_MFMA(e) do { acc[((e) >> 2) & 3][(e) & 3] = __builtin_amdgcn_mfma_f32_16x16x32_bf16(wf[(e) & 3], xf[((e) >> 2) & 3], acc[((e) >> 2) & 3][(e) & 3], 0, 0, 0); } while (0)
#pragma unroll 1
    for (int kt = 0; kt + 1 < NKT; ++kt) {
        const int slot = kt & 1, ktn = (kt + 1 + rot) & (NKT - 1);
        P4_WAIT_V(0); P4_WAIT_L(0); P4_BAR;
        const LAS unsigned char* sb = lds + slot * SLOT; bf16x8 xf[4], wf[4];
        P4_READS(0);
#pragma unroll
        for (int i = 0; i < 5; ++i) { P4_MFMA(3 * i); P4_MFMA(3 * i + 1); P4_MFMA(3 * i + 2); stage64_piece(lds, g, cur, ktn, slot ^ 1, i); __builtin_amdgcn_sched_barrier(0); }
        P4_MFMA(15);
        __builtin_amdgcn_sched_barrier(0);
        P4_READS(1);
#pragma unroll
        for (int i = 0; i < 4; ++i) { P4_MFMA(4 * i); P4_MFMA(4 * i + 1); P4_MFMA(4 * i + 2); P4_MFMA(4 * i + 3); stage64_piece(lds, g, cur, ktn, slot ^ 1, 5 + i); __builtin_amdgcn_sched_barrier(0); }
    }
    {   const int kt = NKT - 1, slot = kt & 1;
        P4_WAIT_V(0); P4_WAIT_L(0); P4_BAR;
        if (nparts) stage64(lds, g, nxt, nrot, slot ^ 1, nparts);
        const LAS unsigned char* sb = lds + slot * SLOT; bf16x8 xf[4], wf[4];
#pragma unroll
        for (int k = 0; k < 2; ++k) { P4_READS(k);
#pragma unroll
            for (int e = 0; e < 16; ++e) P4_MFMA(e); }
    }
    P4_WAIT_L(0); P4_BAR;
#undef P4_READS
#undef P4_MFMA
}
__device__ __forceinline__ float sum_q(float v) {
    v += __builtin_bit_cast(float, __builtin_amdgcn_ds_swizzle(__builtin_bit_cast(int, v), 0x401F));
    const auto rr = __builtin_amdgcn_permlane32_swap(__float_as_uint(v), __float_as_uint(v), false, false);
    return __uint_as_float(rr[0]) + __uint_as_float(rr[1]);
}
#define P4_ZERO(A) do { _Pragma("unroll") for (int m_ = 0; m_ < 4; ++m_) _Pragma("unroll") for (int n_ = 0; n_ < 4; ++n_) A[m_][n_] = (f32x4){0.f, 0.f, 0.f, 0.f}; } while (0)

__device__ __forceinline__ void unit(const Args& a, LAS unsigned char* lds, unsigned char* ws, int layer, int u, unsigned long long& ts_sum, unsigned long long& ts_t0, int wave_s, bool dry = false) {
    const int tid = tid_from(wave_s), wave = wave_s, lane = tid & 63, q = lane >> 4, r16 = lane & 15;
    const size_t row0 = (size_t)u * 64;
    const bf16_t* gz = (const bf16_t*)(ws + OFF_GZ);
    const unsigned lo5 = (unsigned)(r16 * SSM_W + 16 * q), lo10 = (unsigned)(r16 * D_MODEL + 16 * q); static_assert(GZ_W == D_MODEL, "lop == lo10");
#define lop lo10
    const bf16_t* projr = gz + row0 * GZ_W;
    const unsigned char* g8r = (const unsigned char*)(ws + OFF_G8) + row0 * G8_W; const unsigned lo8 = (unsigned)(r16 * G8_W + 16 * q);
    bf16_t* Y1 = (bf16_t*)(ws + OFF_YPRE) + row0 * SSM_W;
    bf16_t* YA = (bf16_t*)(ws + OFF_AO) + row0 * ATT_W;
    bf16_t* YS = (bf16_t*)(ws + OFF_AO) + ((size_t)MTOK + row0) * ATT_W;
    bf16_t* MG = (bf16_t*)(ws + OFF_MG) + row0 * D_MODEL;
    if (W_TOUCH && layer + 1 < DEPTH && u < 256) {
        const char* wn_ = (const char*)(ws + OFF_WIN) + (size_t)(layer + 1) * IN_COLS * D_MODEL * 2 + ((size_t)u * 512 + (size_t)wave * 64 + (size_t)(tid_from(wave_s) & 63)) * 128;
        __builtin_amdgcn_global_load_lds((const unsigned*)wn_, (LAS unsigned*)(lds + JUNK_OFF + wave * 256), 4, 0, 0);
    }
    { const Geo geo0 = make_geo(wave, lane); const G64 dGLU0{Y1, (const bf16_t*)(ws + OFF_WGLU) + (size_t)layer * SSM_W * SSM_W, 10, 10}; stage64(lds, geo0, dGLU0, u & 7, 0, 3); }
    TS_BEGIN(41);
    {
        const int cc = (tid & 63) * 8, rb = tid >> 6, j = cc >> 7;
        const bf16_t* ao = (const bf16_t*)(ws + OFF_AO); const float* ls = (const float*)(ws + OFF_ALSE);
#pragma unroll 1
        for (int kb = 0; kb < 8; kb += 4) {
            u32x4 a0[4], a1[4], a2[4], za[4]; float l0[4], l1[4], l2[4];
#pragma unroll
            for (int i = 0; i < 4; ++i) { const int row = rb + 8 * (kb + i); const size_t tok = row0 + row;
                l0[i] = ls[((size_t)0 * MTOK + tok) * 4 + j]; l1[i] = ls[((size_t)1 * MTOK + tok) * 4 + j]; l2[i] = ls[((size_t)2 * MTOK + tok) * 4 + j];
                a0[i] = __builtin_nontemporal_load((const u32x4*)(ao + ((size_t)0 * MTOK + tok) * ATT_W + cc)); a1[i] = __builtin_nontemporal_load((const u32x4*)(ao + ((size_t)1 * MTOK + tok) * ATT_W + cc)); a2[i] = __builtin_nontemporal_load((const u32x4*)(ao + ((size_t)2 * MTOK + tok) * ATT_W + cc));
                za[i] = __builtin_nontemporal_load((const u32x4*)(gz + tok * GZ_W + GZ_ZA + cc)); }
#pragma unroll
            for (int i = 0; i < 4; ++i) { const int row = rb + 8 * (kb + i);
                const float mx = fmaxf(l0[i], fmaxf(l1[i], l2[i])); float w0 = __builtin_amdgcn_exp2f(l0[i] - mx), w1 = __builtin_amdgcn_exp2f(l1[i] - mx), w2 = __builtin_amdgcn_exp2f(l2[i] - mx);
                const float iw = __builtin_amdgcn_rcpf(w0 + w1 + w2); w0 *= iw; w1 *= iw; w2 *= iw;
#define MRG(A0, A1, A2, Z) pk2((w0 * blo(A0) + w1 * blo(A1) + w2 * blo(A2)) * blo(Z), (w0 * bhi(A0) + w1 * bhi(A1) + w2 * bhi(A2)) * bhi(Z))
                u32x4 y; y.x = MRG(a0[i].x, a1[i].x, a2[i].x, za[i].x); y.y = MRG(a0[i].y, a1[i].y, a2[i].y, za[i].y); y.z = MRG(a0[i].z, a1[i].z, a2[i].z, za[i].z); y.w = MRG(a0[i].w, a1[i].w, a2[i].w, za[i].w);
#undef MRG
                *(u32x4*)(YA + (size_t)row * ATT_W + cc) = y; }
        }
    }
    VM_WAIT(); __syncthreads();
    TS_END(41); TS_BEGIN(42);
    const int nbw = wave * 64;
    const int r8 = u & 7, r16t = u & 15;
    const Geo geo = make_geo(wave, lane);
    const G64 dGLU{Y1, (const bf16_t*)(ws + OFF_WGLU) + (size_t)layer * SSM_W * SSM_W, 10, 10};
    const bf16_t* WBSl = (const bf16_t*)(ws + OFF_WBS) + (size_t)layer * D_MODEL * SSM_W; const bf16_t* WBAl = (const bf16_t*)(ws + OFF_WBA) + (size_t)layer * D_MODEL * ATT_W;
    const bf16_t* WOl = (const bf16_t*)(ws + OFF_WOUT) + (size_t)layer * D_MODEL * D_MODEL;
    const G64 dOUT0{MG, WOl, 11, 11}, dOUT1{MG, WOl + (size_t)512 * D_MODEL, 11, 11};
    {
        f32x4 acc[4][4]; P4_ZERO(acc);
        const G64 dBS0{YS, WBSl, 10, 10};
        const float* bg = inptr(a, IN_BGLU) + layer * SSM_W;
        f32x4 b4[4];
#pragma unroll
        for (int n = 0; n < 4; ++n) b4[n] = *(const f32x4*)(bg + (nbw + n * 4) + (unsigned)(((tid_from(wave_s) >> 4) & 3) * 16));
        run64<8>(acc, lds, geo, dGLU, dBS0, 2, r8, r8);
        {   u32x4 y1[4][2], zs[4][2];
#pragma unroll
            for (int m = 0; m < 4; ++m)
#pragma unroll
                for (int h = 0; h < 2; ++h) { y1[m][h] = *(const u32x4*)(Y1 + (m * 16 * SSM_W + nbw + h * 8) + lo5); zs[m][h] = __builtin_nontemporal_load((const u32x4*)(projr + (GZ_ZS + m * 16 * GZ_W + nbw + h * 8) + lop)); }
#pragma unroll
            for (int m = 0; m < 4; ++m) { u32x4 o[2];
#pragma unroll
                for (int n = 0; n < 4; ++n) { const unsigned yx = y1[m][n >> 1][(n & 1) * 2], yy = y1[m][n >> 1][(n & 1) * 2 + 1], zx = zs[m][n >> 1][(n & 1) * 2], zy = zs[m][n >> 1][(n & 1) * 2 + 1];
                    o[n >> 1][(n & 1) * 2] = pk2(blo(yx) * sig_fast(acc[m][n][0] + b4[n][0]) * blo(zx), bhi(yx) * sig_fast(acc[m][n][1] + b4[n][1]) * bhi(zx));
                    o[n >> 1][(n & 1) * 2 + 1] = pk2(blo(yy) * sig_fast(acc[m][n][2] + b4[n][2]) * blo(zy), bhi(yy) * sig_fast(acc[m][n][3] + b4[n][3]) * bhi(zy)); }
#pragma unroll
                for (int h = 0; h < 2; ++h) *(u32x4*)(YS + (m * 16 * SSM_W + nbw + h * 8) + lo5) = o[h]; }
        }
        VM_WAIT(); __syncthreads();
        stage64(lds, geo, dBS0, r8, 0, 1);
    }
    TS_END(42); TS_BEGIN(43);
#pragma unroll 1
    for (int ps = 0; ps < 2; ++ps) {
        f32x4 as[4][4], aa[4][4]; P4_ZERO(as); P4_ZERO(aa);
        const G64 dBS{YS, WBSl + (size_t)ps * 512 * SSM_W, 10, 10}, dBA{YA, WBAl + (size_t)ps * 512 * ATT_W, 10, 10};
        const G64 dBSn{YS, WBSl + (size_t)512 * SSM_W, 10, 10};
        run64<8>(as, lds, geo, dBS, dBA, 3, r8, r8);
        if (ps == 0) run64<8>(aa, lds, geo, dBA, dBSn, 3, r8, r8);
        else run64<8>(aa, lds, geo, dBA, dOUT0, 2, r8, r16t);
        {   u32x4 gs[4], ga[4];
#pragma unroll
            for (int m = 0; m < 4; ++m) { const int bo = m * 16 * G8_W + ps * 512 + nbw; gs[m] = __builtin_nontemporal_load((const u32x4*)(g8r + (G8_GS + bo) + lo8)); ga[m] = __builtin_nontemporal_load((const u32x4*)(g8r + (G8_GA + bo) + lo8)); }
#define P4_UB(w, e) ((float)(((w) >> (8 * (e))) & 0xffu) * (1.0f / 255.0f))
#pragma unroll
            for (int m = 0; m < 4; ++m) { u32x4 o[2];
#pragma unroll
                for (int n = 0; n < 4; ++n) { const unsigned gsw = gs[m][n], gaw = ga[m][n];
                    o[n >> 1][(n & 1) * 2] = pk2(P4_UB(gsw, 0) * as[m][n][0] + P4_UB(gaw, 0) * aa[m][n][0], P4_UB(gsw, 1) * as[m][n][1] + P4_UB(gaw, 1) * aa[m][n][1]);
                    o[n >> 1][(n & 1) * 2 + 1] = pk2(P4_UB(gsw, 2) * as[m][n][2] + P4_UB(gaw, 2) * aa[m][n][2], P4_UB(gsw, 3) * as[m][n][3] + P4_UB(gaw, 3) * aa[m][n][3]); }
#pragma unroll
                for (int h = 0; h < 2; ++h) *(u32x4*)(MG + (m * 16 * D_MODEL + ps * 512 + nbw + h * 8) + lo10) = o[h]; }
#undef P4_UB
        }
    }
    VM_WAIT(); __syncthreads();
    stage64(lds, geo, dOUT0, r16t, 0, 1);
    TS_END(43); TS_BEGIN(44);
    {
        f32x4 acc0[4][4], acc1[4][4]; P4_ZERO(acc0); P4_ZERO(acc1);
        run64<16>(acc0, lds, geo, dOUT0, dOUT1, 3, r16t, r16t);
        run64<16>(acc1, lds, geo, dOUT1, dOUT1, 0, r16t, 0);
        TS_END(44); TS_BEGIN(45);
        LAS float* RED = (LAS float*)(lds + RED_OFF); LAS float* RED2 = (LAS float*)(lds + RED2_OFF);
        float inv[4];
#pragma unroll
        for (int m = 0; m < 4; ++m) { float s = 0.f;
#pragma unroll
            for (int n = 0; n < 4; ++n) { s += (acc0[m][n][0] * acc0[m][n][0] + acc0[m][n][1] * acc0[m][n][1]) + (acc0[m][n][2] * acc0[m][n][2] + acc0[m][n][3] * acc0[m][n][3]);
                                          s += (acc1[m][n][0] * acc1[m][n][0] + acc1[m][n][1] * acc1[m][n][1]) + (acc1[m][n][2] * acc1[m][n][2] + acc1[m][n][3] * acc1[m][n][3]); }
            s = sum_q(s); if (q == 0) RED[(m * 16 + r16) * 8 + wave] = s; }
        __syncthreads();
#pragma unroll
        for (int m = 0; m < 4; ++m) { const LAS f32x4* rp = (const LAS f32x4*)(RED + (m * 16 + r16) * 8); const f32x4 r0 = rp[0], r1 = rp[1];
            inv[m] = rsqrtf(((r0[0] + r0[1]) + (r0[2] + r0[3]) + (r1[0] + r1[1]) + (r1[2] + r1[3])) * (1.0f / D_MODEL) + RMS_EPS); }
        const float* pg = inptr(a, IN_POSTG) + layer * D_MODEL; float* xor_ = a.p.out + row0 * D_MODEL; bf16_t* xbr = (bf16_t*)(ws + OFF_XB) + row0 * D_MODEL;
        float s2[4] = {0.f, 0.f, 0.f, 0.f};
        const unsigned lq4 = (unsigned)(((tid_from(wave_s) >> 4) & 3) * 16);
#define P4_RES(ACC, PS) do { f32x4 g4[4]; u32x4 xp[4][2]; \
            _Pragma("unroll") for (int n = 0; n < 4; ++n) g4[n] = *(const f32x4*)(pg + ((PS) * 512 + nbw + n * 4) + lq4); \
            _Pragma("unroll") for (int m = 0; m < 4; ++m) _Pragma("unroll") for (int h = 0; h < 2; ++h) xp[m][h] = *(const u32x4*)(xbr + (m * 16 * D_MODEL + (PS) * 512 + nbw + h * 8) + lo10); \
            __builtin_amdgcn_s_waitcnt(0);     \
            _Pragma("unroll") for (int m = 0; m < 4; ++m) { u32x4 o[2]; \
                _Pragma("unroll") for (int n = 0; n < 4; ++n) { const int bo = m * 16 * D_MODEL + (PS) * 512 + nbw + n * 4; const unsigned px = xp[m][n >> 1][(n & 1) * 2], py = xp[m][n >> 1][(n & 1) * 2 + 1]; \
                    f32x4 xv = {blo(px), bhi(px), blo(py), bhi(py)}; xv = xv + ACC[m][n] * inv[m] * g4[n]; \
                    o[n >> 1][(n & 1) * 2] = pk2(xv[0], xv[1]); o[n >> 1][(n & 1) * 2 + 1] = pk2(xv[2], xv[3]); \
                    if (!dry && layer == DEPTH - 1) *(f32x4*)(xor_ + bo + lo10) = xv; \
                    s2[m] += (xv[0] * xv[0] + xv[1] * xv[1]) + (xv[2] * xv[2] + xv[3] * xv[3]); } \
                if (!dry) { if (layer != DEPTH - 1) { _Pragma("unroll") for (int h = 0; h < 2; ++h) *(u32x4*)(xbr + (m * 16 * D_MODEL + (PS) * 512 + nbw + h * 8) + lo10) = o[h]; } } \
                else { asm volatile("" :: "v"(o[0].x), "v"(o[0].y), "v"(o[1].x), "v"(o[1].y)); } } } while (0)
        P4_RES(acc0, 0); P4_RES(acc1, 1);
#undef P4_RES
#pragma unroll
        for (int m = 0; m < 4; ++m) { const float s = sum_q(s2[m]); if (q == 0) RED2[(m * 16 + r16) * 8 + wave] = s; }
        __syncthreads();
        if (wave == 0 && !dry) { const int tl = tid_from(wave_s) & 63;
            const LAS f32x4* rp = (const LAS f32x4*)(RED2 + tl * 8); const f32x4 r0 = rp[0], r1 = rp[1];
            ((float*)(ws + OFF_ROWSS))[row0 + tl] = (r0[0] + r0[1]) + (r0[2] + r0[3]) + (r1[0] + r1[1]) + (r1[2] + r1[3]); }
    }
    VM_WAIT(); __syncthreads();
    TS_END(45);
}
#undef P4_ZERO
#undef lop
}

__device__ __forceinline__ void p0_transpose_item(const float* W, const float* rs, int K, int N, bf16_t* WT, LAS float* scr, int item, int lane, bool vperm, bool ntst) {
    const int nblk = N / 32, kb = item / nblk, nb = item % nblk, k0 = 64 * kb, n0 = 32 * nb;
    const int kr = lane >> 3, n4 = (lane & 7) * 4;
    f32x4 v[8];
#pragma unroll
    for (int i = 0; i < 8; ++i) v[i] = __builtin_nontemporal_load((const f32x4*)(W + (size_t)(k0 + 8 * i + kr) * N + n0 + n4));
    if (rs) {
#pragma unroll
        for (int i = 0; i < 8; ++i) v[i] = v[i] * rs[k0 + 8 * i + kr];
    }
#pragma unroll
    for (int i = 0; i < 8; ++i) { LAS float* d = scr + (8 * i + kr) * 33 + n4; d[0] = v[i][0]; d[1] = v[i][1]; d[2] = v[i][2]; d[3] = v[i][3]; }
    LDS_WAIT(); asm volatile("" ::: "memory");
    const int c = lane & 7;
#pragma unroll
    for (int j = 0; j < 4; ++j) { const int n = (lane >> 3) + 8 * j; const LAS float* s = scr + (8 * c) * 33 + n;
        u32x4 o; o.x = pk2(s[0 * 33], s[1 * 33]); o.y = pk2(s[2 * 33], s[3 * 33]); o.z = pk2(s[4 * 33], s[5 * 33]); o.w = pk2(s[6 * 33], s[7 * 33]);
        int nd = n0 + n;
        if (vperm && nd >= C_V && nd < C_ZA) { const int cc = nd & 127; nd = (nd & ~127) + (cc & 3) * 32 + (cc >> 2); }
        if (ntst) __builtin_nontemporal_store(o, (u32x4*)(WT + (size_t)nd * K + k0 + 8 * c)); else *(u32x4*)(WT + (size_t)nd * K + k0 + 8 * c) = o; }
    LDS_WAIT(); asm volatile("" ::: "memory");
}
__device__ __forceinline__ void p0_prologue(const Frame& F, const Args& a) {
    const int lane_ = tid_from(F.wave) & 63;
    LAS float* scr = (LAS float*)(F.lds + F.wave * 16384);
    const int gw = F.vcu * NWAVES + F.wave, NGW = F.G * NWAVES;
    constexpr int I_IN = (D_MODEL / 64) * (IN_COLS / 32), I_GLU = (SSM_W / 64) * (SSM_W / 32), I_BS = (SSM_W / 64) * (D_MODEL / 32), I_OUT = (D_MODEL / 64) * (D_MODEL / 32);
    constexpr int PER_L = I_IN + I_GLU + 2 * I_BS + I_OUT, NITEMS = DEPTH * PER_L;
    unsigned char* ws = a.p.ws;
    for (int lg = F.vcu; lg < DEPTH * SSM_NG; lg += F.G) s5::tables_wg(a, F.lds, lg, F.wave);
    constexpr int NTAB = DEPTH * SSM_NG, RA = 7;
    const bool bal = F.G > NTAB && RA * NGW < NITEMS;
    const int NA = bal ? RA * NGW : NITEMS, gw2 = gw - NTAB * NWAVES, NGW2 = (F.G - NTAB) * NWAVES;
    for (int k = 0; ; ++k) {
        const int it = (!bal || k < RA) ? gw + k * NGW : (gw2 >= 0 ? NA + gw2 + (k - RA) * NGW2 : NITEMS);
        if (it >= NITEMS || (bal && k < RA && it >= NA)) break;
        const int l = it / PER_L; int r = it - l * PER_L;
        int widx, K, N; size_t dst;
        if (r < I_IN) { widx = IN_WIN; K = D_MODEL; N = IN_COLS; dst = OFF_WIN; }
        else if ((r -= I_IN) < I_GLU) { widx = IN_WGLU; K = SSM_W; N = SSM_W; dst = OFF_WGLU; }
        else if ((r -= I_GLU) < I_BS) { widx = IN_WBS; K = SSM_W; N = D_MODEL; dst = OFF_WBS; }
        else if ((r -= I_BS) < I_BS) { widx = IN_WBA; K = ATT_W; N = D_MODEL; dst = OFF_WBA; }
        else { r -= I_BS; widx = IN_WOUT; K = D_MODEL; N = D_MODEL; dst = OFF_WOUT; }
        const float* W = inptr(a, widx) + (size_t)l * K * N;
        const float* rs = (widx == IN_WIN) ? inptr(a, IN_PREG) + l * D_MODEL : nullptr;
        p0_transpose_item(W, rs, K, N, (bf16_t*)(ws + dst) + (size_t)l * K * N, scr, r, lane_, ATTN_DMA == 3 && widx == IN_WIN, l > 0);
    }
    const float* X = inptr(a, IN_X);
    for (int m = gw; m < MTOK; m += 2 * NGW) {
        const int m1 = m + NGW; const bool has1 = m1 < MTOK;
        const f32x4* xr0 = (const f32x4*)(X + (size_t)m * D_MODEL) + lane_; const f32x4* xr1 = (const f32x4*)(X + (size_t)(has1 ? m1 : m) * D_MODEL) + lane_;
        f32x4 v0[4], v1[4];
#pragma unroll
        for (int j = 0; j < 4; ++j) { v0[j] = __builtin_nontemporal_load(xr0 + 64 * j); v1[j] = __builtin_nontemporal_load(xr1 + 64 * j); }
#pragma unroll
        for (int r = 0; r < 2; ++r) {
            if (r == 1 && !has1) break;
            const int mm = r ? m1 : m;
            unsigned long long* o8 = (unsigned long long*)((bf16_t*)(ws + OFF_XB) + (size_t)mm * D_MODEL) + lane_;
            float sq = 0.f;
#pragma unroll
            for (int j = 0; j < 4; ++j) { const f32x4 v = r ? v1[j] : v0[j]; sq += (v[0] * v[0] + v[1] * v[1]) + (v[2] * v[2] + v[3] * v[3]);
                o8[64 * j] = (unsigned long long)pk2(v[0], v[1]) | ((unsigned long long)pk2(v[2], v[3]) << 32); }
            sq = wave_sum(sq);
            if (lane_ == 0) ((float*)(ws + OFF_ROWSS))[mm] = sq;
        }
    }
}

constexpr int N_PHASES = 1 + 3 * DEPTH;
__global__ void __launch_bounds__(NTHREADS, 2) mega(Args a) {
    extern __shared__ __attribute__((aligned(16))) unsigned char lds_raw[];
    Frame F; F.lds = (LAS unsigned char*)lds_raw; F.wave = __builtin_amdgcn_readfirstlane((int)threadIdx.x >> 6);
    F.G = gridDim.x; { const int bx = blockIdx.x; F.vcu = (F.G % 8 == 0) ? (bx % 8) * (F.G / 8) + bx / 8 : bx; }
    volatile LAS unsigned* MISC = (volatile LAS unsigned*)(F.lds + MISC_OFF);
    { const int t0_ = tid_from(F.wave); if (t0_ < 64) MISC[t0_] = 0u; }
    __syncthreads();
    const bool grouped = (F.G % 8 == 0) && (a.ph_lo == 0) && (a.ph_hi == N_PHASES);
    unsigned* bw = (unsigned*)(a.p.ws + OFF_CTL) + CW_BAR + a.bar_region * XCD_BAR_WORDS;
    XcdBarrier gbar = xcd_barrier_post(bw, MISC + 8, F.wave, (unsigned)F.G);
    XcdBarrier lbar = gbar;
    if (grouped) lbar = xcd_barrier_post(bw + (1 + (blockIdx.x & 7)) * XCD_BAR_WORDS, MISC + 10, F.wave, (unsigned)F.G / 8u);
    unsigned long long ts_sum = 0, ts_t0 = 0;
    TS_BEGIN(100);
    for (int ph = a.ph_lo; ph < a.ph_hi; ++ph) {
        TS_BEGIN(9); if (ph > 0 && (ph - 1) % 3 == 0) TS_BEGIN(93); if (ph > 0 && (ph - 1) % 3 == 1) TS_BEGIN(91); if (ph > 0 && (ph - 1) % 3 == 2) TS_BEGIN(92);
        if (ph > a.ph_lo) { if (ph == 1 || !grouped) xcd_barrier(gbar); else xcd_barrier(lbar); }
        if (GRP_DELAY_NS != 0 && grouped && ph == 1) {
            const unsigned long long ticks_ = (unsigned long long)((blockIdx.x & 7) % GRP_DELAY_MOD) * (GRP_DELAY_NS / 10), t0_ = __builtin_amdgcn_s_memrealtime();
            while (__builtin_amdgcn_s_memrealtime() - t0_ < ticks_) __builtin_amdgcn_s_sleep(8);
        }
        TS_END(9); if (ph > 0 && (ph - 1) % 3 == 0) TS_END(93); if (ph > 0 && (ph - 1) % 3 == 1) TS_END(91); if (ph > 0 && (ph - 1) % 3 == 2) TS_END(92);
#if PROBE_DUP == 6
        if (ph > a.ph_lo) { if (ph == 1 || !grouped) xcd_barrier(gbar); else xcd_barrier(lbar); }
#endif
        size_t wz_ = 0; asm volatile("" : "+s"(wz_)); unsigned char* ws = a.p.ws + wz_;
        int vcu_ = F.vcu; asm volatile("" : "+s"(vcu_));
        Frame Fp; Fp.lds = F.lds; Fp.wave = F.wave; Fp.G = F.G; Fp.vcu = vcu_;
#if PROBE_DUP == 5
        if (ph == 0) {
#pragma unroll 1
            for (int rep = 0; rep < 2; ++rep) { p0_prologue(Fp, a); __syncthreads(); }
            continue; }
#endif
        if (ph == 0) { TS_BEGIN(10); p0_prologue(Fp, a); TS_END(10); continue; }
        const int l = (ph - 1) / 3, k = (ph - 1) % 3;
        if (k == 0) {
            TS_BEGIN(1); if (l == 0) TS_BEGIN(18); if (l == 3) TS_BEGIN(19);
            pg8::Gemm g{(const bf16_t*)(ws + OFF_XB), (const bf16_t*)(ws + OFF_WIN) + (size_t)l * IN_COLS * D_MODEL, MTOK, IN_COLS, D_MODEL};
            int bid_ = blockIdx.x; asm volatile("" : "+s"(bid_));
            pg8::StaticOrder S; S.init(MTOK, IN_COLS, Fp.G, bid_);
            pg8::EpiInProj E{ws, (const float*)(ws + OFF_ROWSS)};
#if PROBE_DUP == 1
#pragma unroll 1
            for (int rep = 0; rep < 2; ++rep)
#endif
            pg8::gemm_phase<pg8::EpiInProj, pg8::StaticOrder, true, true>(Fp.lds, g, S, E, Fp.wave, ts_sum, ts_t0);
            TS_END(1); if (l == 0) TS_END(18); if (l == 3) TS_END(19);
        }
#if EXP_HALF
        else if (EXP_HALF == 1 && (blockIdx.x & 7) >= 4) { }
#endif
        else if (k == 1) {
            TS_BEGIN(2);
#if PROBE_DUP == 2
#pragma unroll 1
            for (int rep = 0; rep < 2; ++rep)
#endif
            for (int u = Fp.vcu; u < BATCH * SSM_NG; u += Fp.G) s5::unit(Fp.lds, ws, l, u >> 5, u & 31, Fp.wave, inptr(a, IN_DSKIP) + l * SSM_W);
            TS_END(2); TS_BEGIN(3);
#if PROBE_DUP == 3
#pragma unroll 1
            for (int rep = 0; rep < 2; ++rep)
#endif
#if ATTN_WAVE
            wsa::phase(Fp, ws);
            __syncthreads();
#else
            attn_phase(Fp, ws, l, ts_sum, ts_t0);
#endif
            TS_END(3);
        }
        else {
            TS_BEGIN(4);
#if PROBE_DUP == 4
#pragma unroll 1
            for (int rep = 0; rep < 2; ++rep)
            for (int u = Fp.vcu; u < MTOK / 64; u += Fp.G) p4::unit(a, Fp.lds, ws, l, u, ts_sum, ts_t0, Fp.wave, rep == 0);
#else
#if EXP_HALF == 2
            if (!(Fp.vcu & 1)) for (int u = Fp.vcu; u < MTOK / 64; u += Fp.G) { for (int e = 0; e < 2; ++e) p4::unit(a, Fp.lds, ws, l, u + e, ts_sum, ts_t0, Fp.wave); }
#else
            for (int u = Fp.vcu; u < MTOK / 64; u += Fp.G) p4::unit(a, Fp.lds, ws, l, u, ts_sum, ts_t0, Fp.wave);
#endif
#endif
            TS_END(4);
        }
    }
    TS_END(100);
    if (TS_ID != 0 && blockIdx.x == 0 && tid_from(F.wave) == 0) { asm volatile("s_waitcnt vmcnt(0)" ::: "memory"); a.p.out[0] += (float)ts_sum * 0.001f; }
}

#ifndef ONE_LAUNCH
#define ONE_LAUNCH 1
#endif
#ifndef OPT_P0
#define OPT_P0 1
#endif
#ifndef OPT_P1
#define OPT_P1 1
#endif
#ifndef OPT_P2
#define OPT_P2 1
#endif
#ifndef OPT_P4
#define OPT_P4 1
#endif
extern "C" void kernel_launch(void* const* d_in, const int* in_sizes, int n_in, void* d_out, int out_size, void* d_ws, size_t ws_size, hipStream_t stream) {
    static int grid = 0;
    if (grid == 0) {
        if (n_in != 17 || out_size != MTOK * D_MODEL || ws_size < WS_END) { fprintf(stderr, "kernel_launch: unexpected shapes/workspace (n_in %d out %d ws %zu)\n", n_in, out_size, ws_size); grid = -1; return; }
        int dev = 0, cus = 0, per_cu = 0;
        if (hipGetDevice(&dev) != hipSuccess || hipDeviceGetAttribute(&cus, hipDeviceAttributeMultiprocessorCount, dev) != hipSuccess) { grid = -1; return; }
        if (hipFuncSetAttribute((const void*)mega, hipFuncAttributeMaxDynamicSharedMemorySize, LDS_BYTES) != hipSuccess) { fprintf(stderr, "kernel_launch: hipFuncSetAttribute failed\n"); grid = -1; return; }
        if (hipOccupancyMaxActiveBlocksPerMultiprocessor(&per_cu, (const void*)mega, NTHREADS, LDS_BYTES) != hipSuccess || per_cu < 1) { fprintf(stderr, "kernel_launch: occupancy query says %d blocks/CU\n", per_cu); per_cu = 1; }
        (void)hipGetLastError();
        grid = cus * (per_cu < 1 ? 1 : 1);
    }
    if (grid < 0) return;
    Params p{};
    for (int i = 0; i < N_IN; ++i) p.in[i] = (const float*)d_in[i];
    p.out = (float*)d_out; p.ws = (unsigned char*)d_ws;
    unsigned char* ws = p.ws;
#if ONE_LAUNCH
    (void)hipMemsetAsync(ws + OFF_CTL + (size_t)CW_BAR * 4, 0, (size_t)9 * XCD_BAR_WORDS * 4, stream);
#else
    (void)hipMemsetAsync(ws + OFF_CTL, 0, CTL_ZERO_BYTES, stream);
#endif
#if EXP_MEMSET2
    (void)hipMemsetAsync(ws + OFF_T2, 0, CTL_ZERO_BYTES, stream);
#endif
    int bar_region = 0;
    auto launch_mega = [&](int lo, int hi) { Args a{}; a.p = p; a.ph_lo = lo; a.ph_hi = hi; a.bar_region = bar_region++; a.pad = 0;
        hipLaunchKernelGGL(mega, dim3(grid), dim3(NTHREADS), LDS_BYTES, stream, a); };
    bf16_t* WIN = (bf16_t*)(ws + OFF_WIN); bf16_t* WGLU = (bf16_t*)(ws + OFF_WGLU); bf16_t* WBS = (bf16_t*)(ws + OFF_WBS); bf16_t* WBA = (bf16_t*)(ws + OFF_WBA); bf16_t* WOUT = (bf16_t*)(ws + OFF_WOUT);
    bf16_t* XB = (bf16_t*)(ws + OFF_XB); bf16_t* PROJ = (bf16_t*)(ws + OFF_PROJ); bf16_t* YPRE = (bf16_t*)(ws + OFF_YPRE); bf16_t* AO = (bf16_t*)(ws + OFF_AO);
    bf16_t* T2 = (bf16_t*)(ws + OFF_T2); bf16_t* T4 = (bf16_t*)(ws + OFF_T4); bf16_t* T5 = AO + (size_t)MTOK * ATT_W; float* OUTF = (float*)(ws + OFF_PROJ);
    const float* ROWSS = (const float*)(ws + OFF_ROWSS);
#if ONE_LAUNCH
    launch_mega(0, N_PHASES);
    return;
#endif
#if OPT_P0
    launch_mega(0, 1);
#else
    const dim3 tb(32, 8);
    for (int l = 0; l < DEPTH; ++l) {
        nv::k_transpose<<<dim3(IN_COLS / 32, D_MODEL / 32), tb, 0, stream>>>(p.in[IN_WIN] + (size_t)l * D_MODEL * IN_COLS, p.in[IN_PREG] + l * D_MODEL, WIN + (size_t)l * IN_COLS * D_MODEL, D_MODEL, IN_COLS);
        nv::k_transpose<<<dim3(SSM_W / 32, SSM_W / 32), tb, 0, stream>>>(p.in[IN_WGLU] + (size_t)l * SSM_W * SSM_W, nullptr, WGLU + (size_t)l * SSM_W * SSM_W, SSM_W, SSM_W);
        nv::k_transpose<<<dim3(D_MODEL / 32, SSM_W / 32), tb, 0, stream>>>(p.in[IN_WBS] + (size_t)l * SSM_W * D_MODEL, nullptr, WBS + (size_t)l * D_MODEL * SSM_W, SSM_W, D_MODEL);
        nv::k_transpose<<<dim3(D_MODEL / 32, ATT_W / 32), tb, 0, stream>>>(p.in[IN_WBA] + (size_t)l * ATT_W * D_MODEL, nullptr, WBA + (size_t)l * D_MODEL * ATT_W, ATT_W, D_MODEL);
        nv::k_transpose<<<dim3(D_MODEL / 32, D_MODEL / 32), tb, 0, stream>>>(p.in[IN_WOUT] + (size_t)l * D_MODEL * D_MODEL, nullptr, WOUT + (size_t)l * D_MODEL * D_MODEL, D_MODEL, D_MODEL);
    }
    nv::k_s5_tables<<<DEPTH * SSM_NG, 64, 0, stream>>>(p);
    nv::k_rows_x<<<MTOK, 256, 0, stream>>>(p);
#endif
    for (int l = 0; l < DEPTH; ++l) {
#if OPT_P1
        launch_mega(1 + 3 * l, 2 + 3 * l);
#else
        nv::k_gemm<nv::EpiInProj><<<dim3(IN_COLS / 128, MTOK / 128), 256, 0, stream>>>(XB, D_MODEL, WIN + (size_t)l * IN_COLS * D_MODEL, D_MODEL, D_MODEL, nv::EpiInProj{ROWSS, PROJ});
#endif
#if OPT_P2
        launch_mega(2 + 3 * l, 3 + 3 * l);
#else
        nv::k_attn<<<MTOK * 12 / 4, 256, 0, stream>>>(p);
        nv::k_s5<<<BATCH * SSM_NG, 64, 0, stream>>>(p, l);
#endif
#if OPT_P4
        launch_mega(3 + 3 * l, 4 + 3 * l);
#else
        nv::k_p4a<<<MTOK * SSM_W / 256, 256, 0, stream>>>(p, l);
        nv::k_gemm<nv::EpiGlu><<<dim3(SSM_W / 128, MTOK / 128), 256, 0, stream>>>(YPRE, SSM_W, WGLU + (size_t)l * SSM_W * SSM_W, SSM_W, SSM_W, nv::EpiGlu{YPRE, PROJ, p.in[IN_BGLU] + l * SSM_W, T2});
        nv::k_merge<<<MTOK * ATT_W / 256, 256, 0, stream>>>(p);
        nv::k_gemm<nv::EpiGate1><<<dim3(D_MODEL / 128, MTOK / 128), 256, 0, stream>>>(T2, SSM_W, WBS + (size_t)l * D_MODEL * SSM_W, SSM_W, SSM_W, nv::EpiGate1{PROJ, T4});
        nv::k_gemm<nv::EpiGate2><<<dim3(D_MODEL / 128, MTOK / 128), 256, 0, stream>>>(AO, ATT_W, WBA + (size_t)l * D_MODEL * ATT_W, ATT_W, ATT_W, nv::EpiGate2{PROJ, T4, T5});
        nv::k_gemm<nv::EpiF32><<<dim3(D_MODEL / 128, MTOK / 128), 256, 0, stream>>>(T5, D_MODEL, WOUT + (size_t)l * D_MODEL * D_MODEL, D_MODEL, D_MODEL, nv::EpiF32{OUTF, D_MODEL});
        nv::k_postnorm<<<MTOK, 256, 0, stream>>>(p, l, OUTF);
#endif
    }
}
```

```cpp
#include <hip/hip_runtime.h>
#include <cstdio>
#include <cstdint>
#ifndef ATTN_DMA
#define ATTN_DMA 3
#endif
#ifndef ATTN_WAVE
#define ATTN_WAVE 0
#endif
#ifndef EXP_MEMSET2
#define EXP_MEMSET2 0
#endif
#ifndef EXP_HALF
#define EXP_HALF 0
#endif
#ifndef EXP_NOSTORE
#define EXP_NOSTORE 0
#endif
#ifndef TS_ID
#define TS_ID 0
#endif
#ifndef P1_NT
#define P1_NT 0
#endif
#ifndef P1_SHAPE
#define P1_SHAPE 1
#endif
#ifndef W_TOUCH
#define W_TOUCH 1
#endif
#ifndef W_TOUCH2
#define W_TOUCH2 2
#endif
#ifndef SEAM_RELAX
#define SEAM_RELAX 1
#endif
#ifndef GRP_DELAY_NS
#define GRP_DELAY_NS 0
#endif
#ifndef GRP_DELAY_MOD
#define GRP_DELAY_MOD 2
#endif
#define TS_BEGIN(id) do { if (TS_ID == (id)) ts_t0 = __builtin_amdgcn_s_memrealtime(); } while (0)
#define TS_END(id) do { if (TS_ID == (id)) ts_sum += __builtin_amdgcn_s_memrealtime() - ts_t0; } while (0)

constexpr int D_MODEL = 1024, BATCH = 8, SEQ = 2048, DEPTH = 4, MTOK = BATCH * SEQ;
constexpr int SSM_W = 512, SSM_CH = 16, SSM_NG = 32, SSM_P = 64;
constexpr int HD = 128, HPG = 4, NGRP = 3, ATT_W = 512, IN_COLS = 8192;
constexpr int C_US = 0, C_ZS = 512, C_Q = 1024, C_K = 2560, C_V = 4096, C_ZA = 5632, C_GS = 6144, C_GA = 7168;
constexpr int GZ_W = 1024, GZ_ZS = 0, GZ_ZA = 512, G8_W = 2048, G8_GS = 0, G8_GA = 1024;
constexpr float RMS_EPS = 1e-6f;
constexpr float ATT_C2 = 0.08838834764831845f * 1.4426950408889634f;

constexpr size_t MiB = 1u << 20;
constexpr size_t OFF_CTL = 0;
constexpr size_t OFF_WIN = 370 * MiB;
constexpr size_t OFF_WGLU = 434 * MiB;
constexpr size_t OFF_WBS = 436 * MiB;
constexpr size_t OFF_WBA = 440 * MiB;
constexpr size_t OFF_WOUT = 444 * MiB;
constexpr size_t OFF_S5 = 452 * MiB;
constexpr size_t OFF_XB = 473 * MiB;
constexpr size_t OFF_ROWSS = 505 * MiB;
constexpr size_t OFF_PROJ = 1 * MiB;
constexpr size_t OFF_GZ = OFF_PROJ, OFF_G8 = OFF_PROJ + 32 * MiB, OFF_QKV = OFF_PROJ + 96 * MiB;
constexpr size_t OFF_YPRE = 257 * MiB;
constexpr size_t OFF_AO = 273 * MiB;
constexpr size_t OFF_ALSE = 321 * MiB;
constexpr size_t OFF_T2 = 322 * MiB;
constexpr size_t OFF_UG = OFF_T2;
constexpr size_t OFF_T4 = 338 * MiB;
constexpr size_t WS_END = 506 * MiB;
constexpr size_t S5_A = 0;
constexpr size_t S5_BB = 1 * MiB;

typedef unsigned short bf16_t;
typedef short bf16x8 __attribute__((ext_vector_type(8)));
typedef float f32x4 __attribute__((ext_vector_type(4)));
typedef unsigned u32x4 __attribute__((ext_vector_type(4)));

__device__ __forceinline__ float bf2f(bf16_t h) { return __uint_as_float(((unsigned)h) << 16); }
__device__ __forceinline__ bf16_t f2bf(float f) { unsigned u = __float_as_uint(f); return (bf16_t)((u + 0x7fffu + ((u >> 16) & 1u)) >> 16); }
__device__ __forceinline__ float sigmoidf_(float v) { return 1.0f / (1.0f + __expf(-v)); }
__device__ __forceinline__ float siluf_(float v) { return v / (1.0f + __expf(-v)); }
__device__ __forceinline__ float gelu_tanh(float x) {
    const float z = 0.7978845608028654f * (x + 0.044715f * x * x * x);
    const float t = 1.0f - 2.0f / (1.0f + __expf(2.0f * z));
    return 0.5f * x * (1.0f + t);
}
__device__ __forceinline__ float wave_sum(float v) {
    v += __builtin_bit_cast(float, __builtin_amdgcn_ds_swizzle(__builtin_bit_cast(int, v), 0x041F));
    v += __builtin_bit_cast(float, __builtin_amdgcn_ds_swizzle(__builtin_bit_cast(int, v), 0x081F));
    v += __builtin_bit_cast(float, __builtin_amdgcn_ds_swizzle(__builtin_bit_cast(int, v), 0x101F));
    v += __builtin_bit_cast(float, __builtin_amdgcn_ds_swizzle(__builtin_bit_cast(int, v), 0x201F));
    v += __builtin_bit_cast(float, __builtin_amdgcn_ds_swizzle(__builtin_bit_cast(int, v), 0x401F));
    const auto rr = __builtin_amdgcn_permlane32_swap(__float_as_uint(v), __float_as_uint(v), false, false);
    return __uint_as_float(rr[0]) + __uint_as_float(rr[1]);
}
__device__ __forceinline__ float sig_fast(float v) { return __builtin_amdgcn_rcpf(1.0f + __builtin_amdgcn_exp2f(-1.4426950408889634f * v)); }
__device__ __forceinline__ float gelu_fast(float x) {
    const float z2 = 1.5957691216057308f * (x + 0.044715f * x * x * x);
    return x * sig_fast(z2);
}
__device__ __forceinline__ float blo(unsigned w) { return __uint_as_float(w << 16); }
__device__ __forceinline__ float bhi(unsigned w) { return __uint_as_float(w & 0xffff0000u); }
enum { IN_X = 0, IN_PREG, IN_WIN, IN_LRE, IN_LIM, IN_LDT, IN_BRE, IN_BIM, IN_CRE, IN_CIM, IN_DSKIP, IN_WGLU, IN_BGLU, IN_WBS, IN_WBA, IN_WOUT, IN_POSTG, N_IN };
struct Params { const float* in[N_IN]; float* out; unsigned char* ws; };
__device__ __forceinline__ int tid_from(int wave_s) { unsigned z = 0u; asm volatile("" : "+v"(z)); return (wave_s << 6) | (int)__builtin_amdgcn_mbcnt_hi(~0u, __builtin_amdgcn_mbcnt_lo(~0u, z)); }

namespace nv {
__global__ void k_transpose(const float* __restrict__ W, const float* __restrict__ rs, bf16_t* __restrict__ Wt, int K, int N) {
    __shared__ float tile[32][33];
    const int n0 = blockIdx.x * 32, k0 = blockIdx.y * 32, tx = threadIdx.x, ty = threadIdx.y;
    for (int i = ty; i < 32; i += 8) { const int k = k0 + i; tile[i][tx] = W[(size_t)k * N + n0 + tx] * (rs ? rs[k] : 1.0f); }
    __syncthreads();
    for (int i = ty; i < 32; i += 8) { const int n = n0 + i; Wt[(size_t)n * K + k0 + tx] = f2bf(tile[tx][i]); }
}
__global__ void k_s5_tables(Params p) {
    const int lg = blockIdx.x, pp = threadIdx.x, idx = lg * 64 + pp;
    const float lre = fminf(p.in[IN_LRE][idx], -1e-4f), lim = p.in[IN_LIM][idx], dt = expf(p.in[IN_LDT][lg]);
    const float a = lre * dt, b = lim * dt, ea = expf(a), sb = sinf(b), cb = cosf(b);
    const float Are = ea * cb, Aim = ea * sb, sh = sinf(0.5f * b);
    const float Dre = expm1f(a) * cb - 2.0f * sh * sh, Dim = Aim;
    const float den = lre * lre + lim * lim;
    const float cre = (Dre * lre + Dim * lim) / den, cim = (Dim * lre - Dre * lim) / den;
    float* A = (float*)(p.ws + OFF_S5 + S5_A); float* Bb = (float*)(p.ws + OFF_S5 + S5_BB);
    A[idx * 2] = Are; A[idx * 2 + 1] = Aim;
    for (int c = 0; c < 16; ++c) { const float br = p.in[IN_BRE][idx * 16 + c], bi = p.in[IN_BIM][idx * 16 + c];
        Bb[(idx * 16 + c) * 2] = cre * br - cim * bi; Bb[(idx * 16 + c) * 2 + 1] = cre * bi + cim * br; }
}
__global__ void k_rows_x(Params p) {
    const int row = blockIdx.x, t = threadIdx.x;
    const f32x4 v = ((const f32x4*)(p.in[IN_X] + (size_t)row * D_MODEL))[t];
    ((f32x4*)(p.out + (size_t)row * D_MODEL))[t] = v;
    bf16_t* xb = (bf16_t*)(p.ws + OFF_XB) + (size_t)row * D_MODEL + t * 4;
    xb[0] = f2bf(v[0]); xb[1] = f2bf(v[1]); xb[2] = f2bf(v[2]); xb[3] = f2bf(v[3]);
    float ss = wave_sum(v[0] * v[0] + v[1] * v[1] + v[2] * v[2] + v[3] * v[3]);
    __shared__ float s[4];
    if ((t & 63) == 0) s[t >> 6] = ss;
    __syncthreads();
    if (t == 0) ((float*)(p.ws + OFF_ROWSS))[row] = s[0] + s[1] + s[2] + s[3];
}
template <class Epi> __global__ __launch_bounds__(256) void k_gemm(const bf16_t* __restrict__ A, int lda, const bf16_t* __restrict__ Bt, int ldb, int K, Epi epi) {
    const int tid = threadIdx.x, wave = tid >> 6, lane = tid & 63, wr = wave >> 1, wc = wave & 1;
    const int row0 = blockIdx.y * 128 + wr * 64, col0 = blockIdx.x * 128 + wc * 64;
    f32x4 acc[4][4];
    for (int i = 0; i < 4; ++i) for (int j = 0; j < 4; ++j) acc[i][j] = (f32x4){0.f, 0.f, 0.f, 0.f};
    const bf16_t* ap = A + (size_t)(row0 + (lane & 15)) * lda + 8 * (lane >> 4);
    const bf16_t* bp = Bt + (size_t)(col0 + (lane & 15)) * ldb + 8 * (lane >> 4);
    for (int k0 = 0; k0 < K; k0 += 32) {
        bf16x8 a[4], b[4];
#pragma unroll
        for (int i = 0; i < 4; ++i) { a[i] = *(const bf16x8*)(ap + (size_t)i * 16 * lda + k0); b[i] = *(const bf16x8*)(bp + (size_t)i * 16 * ldb + k0); }
#pragma unroll
        for (int i = 0; i < 4; ++i)
#pragma unroll
            for (int j = 0; j < 4; ++j) acc[i][j] = __builtin_amdgcn_mfma_f32_16x16x32_bf16(a[i], b[j], acc[i][j], 0, 0, 0);
    }
#pragma unroll
    for (int i = 0; i < 4; ++i)
#pragma unroll
        for (int j = 0; j < 4; ++j)
#pragma unroll
            for (int r = 0; r < 4; ++r) epi(row0 + i * 16 + (lane >> 4) * 4 + r, col0 + j * 16 + (lane & 15), acc[i][j][r]);
}
struct EpiInProj { const float* rowss; bf16_t* proj;
    __device__ void operator()(int row, int col, float acc) const {
        float v = acc * rsqrtf(rowss[row] * (1.0f / D_MODEL) + RMS_EPS);
        if ((col >= C_ZS && col < C_Q) || (col >= C_ZA && col < C_GS)) v = siluf_(v);
        else if (col >= C_GS) v = sigmoidf_(v);
        proj[(size_t)row * IN_COLS + col] = f2bf(v);
    } };
struct EpiGlu { const bf16_t* y1; const bf16_t* proj; const float* b_glu; bf16_t* ys;
    __device__ void operator()(int row, int col, float acc) const {
        const float gate = sigmoidf_(acc + b_glu[col]);
        ys[(size_t)row * SSM_W + col] = f2bf(bf2f(y1[(size_t)row * SSM_W + col]) * gate * bf2f(proj[(size_t)row * IN_COLS + C_ZS + col]));
    } };
struct EpiGate1 { const bf16_t* proj; bf16_t* m1;
    __device__ void operator()(int row, int col, float acc) const { m1[(size_t)row * D_MODEL + col] = f2bf(bf2f(proj[(size_t)row * IN_COLS + C_GS + col]) * acc); } };
struct EpiGate2 { const bf16_t* proj; const bf16_t* m1; bf16_t* mg;
    __device__ void operator()(int row, int col, float acc) const {
        mg[(size_t)row * D_MODEL + col] = f2bf(bf2f(m1[(size_t)row * D_MODEL + col]) + bf2f(proj[(size_t)row * IN_COLS + C_GA + col]) * acc); } };
struct EpiF32 { float* C; int ldc;
    __device__ void operator()(int row, int col, float acc) const { C[(size_t)row * ldc + col] = acc; } };

__global__ __launch_bounds__(256) void k_attn(Params p) {
    const int wave = threadIdx.x >> 6, lane = threadIdx.x & 63;
    const long wid = (long)blockIdx.x * 4 + wave;
    const int j = (int)(wid & 3), gi = (int)((wid >> 2) % 3), tok = (int)(wid / 12);
    const int d = gi == 0 ? 1 : (gi == 1 ? 4 : 16);
    const int t = tok % SEQ, i = t / d;
    const bf16_t* proj = (const bf16_t*)(p.ws + OFF_PROJ);
    const int hc = (gi * 4 + j) * HD + 2 * lane;
    const unsigned qq = *(const unsigned*)(proj + (size_t)tok * IN_COLS + C_Q + hc);
    const float q0 = bf2f((bf16_t)(qq & 0xffff)), q1 = bf2f((bf16_t)(qq >> 16));
    float m = -1e30f, l = 0.f, o0 = 0.f, o1 = 0.f;
    const int nk = i < 128 ? i : 128;
    for (int jj = nk; jj >= 0; --jj) {
        const size_t kt = (size_t)(tok - jj * d);
        const unsigned kk = *(const unsigned*)(proj + kt * IN_COLS + C_K + hc);
        const unsigned vv = *(const unsigned*)(proj + kt * IN_COLS + C_V + hc);
        float s = q0 * bf2f((bf16_t)(kk & 0xffff)) + q1 * bf2f((bf16_t)(kk >> 16));
        s = wave_sum(s) * ATT_C2;
        const float mn = fmaxf(m, s), al = exp2f(m - mn), pr = exp2f(s - mn);
        l = l * al + pr; o0 = o0 * al + pr * bf2f((bf16_t)(vv & 0xffff)); o1 = o1 * al + pr * bf2f((bf16_t)(vv >> 16)); m = mn;
    }
    const float il = 1.0f / l;
    bf16_t* ao = (bf16_t*)(p.ws + OFF_AO) + ((size_t)gi * MTOK + tok) * ATT_W + j * HD + 2 * lane;
    *(unsigned*)ao = (unsigned)f2bf(o0 * il) | ((unsigned)f2bf(o1 * il) << 16);
    if (lane == 0) ((float*)(p.ws + OFF_ALSE))[((size_t)gi * MTOK + tok) * 4 + j] = m + log2f(l);
}
__global__ __launch_bounds__(64) void k_s5(Params p, int layer) {
    const int b = blockIdx.x >> 5, g = blockIdx.x & 31, lane = threadIdx.x;
    const int idx = ((layer * 32 + g) * 64 + lane);
    const float* A = (const float*)(p.ws + OFF_S5 + S5_A); const float* Bb = (const float*)(p.ws + OFF_S5 + S5_BB);
    const float Are = A[idx * 2], Aim = A[idx * 2 + 1];
    float bre[16], bim[16], cre[16], cim[16];
#pragma unroll
    for (int c = 0; c < 16; ++c) { bre[c] = Bb[(idx * 16 + c) * 2]; bim[c] = Bb[(idx * 16 + c) * 2 + 1];
        cre[c] = p.in[IN_CRE][(size_t)((layer * 32 + g) * 16 + c) * 64 + lane]; cim[c] = p.in[IN_CIM][(size_t)((layer * 32 + g) * 16 + c) * 64 + lane]; }
    const bf16_t* proj = (const bf16_t*)(p.ws + OFF_PROJ); bf16_t* ypre = (bf16_t*)(p.ws + OFF_YPRE);
    float sre = 0.f, sim = 0.f;
    for (int t = 0; t < SEQ; ++t) {
        const size_t tok = (size_t)b * SEQ + t;
        const bf16x8 u0 = *(const bf16x8*)(proj + tok * IN_COLS + C_US + g * 16), u1 = *(const bf16x8*)(proj + tok * IN_COLS + C_US + g * 16 + 8);
        float dre = 0.f, dim = 0.f;
#pragma unroll
        for (int c = 0; c < 8; ++c) { const float ua = bf2f((bf16_t)u0[c]), ub = bf2f((bf16_t)u1[c]);
            dre += bre[c] * ua + bre[c + 8] * ub; dim += bim[c] * ua + bim[c + 8] * ub; }
        const float nre = Are * sre - Aim * sim + dre, nim = Are * sim + Aim * sre + dim;
        sre = nre; sim = nim;
        float mine = 0.f;
#pragma unroll
        for (int c = 0; c < 16; ++c) { const float y = wave_sum(cre[c] * sre - cim[c] * sim); if (lane == c) mine = y; }
        if (lane < 16) ypre[tok * SSM_W + g * 16 + lane] = f2bf(mine);
    }
}
__global__ void k_p4a(Params p, int layer) {
    const size_t e = (size_t)blockIdx.x * 256 + threadIdx.x; const size_t row = e >> 9; const int col = (int)(e & 511);
    bf16_t* ypre = (bf16_t*)(p.ws + OFF_YPRE); const bf16_t* proj = (const bf16_t*)(p.ws + OFF_PROJ);
    const float y0 = bf2f(ypre[e]) + p.in[IN_DSKIP][layer * SSM_W + col] * bf2f(proj[row * IN_COLS + C_US + col]);
    ypre[e] = f2bf(gelu_tanh(y0));
}
__global__ void k_merge(Params p) {
    const size_t e = (size_t)blockIdx.x * 256 + threadIdx.x; const size_t row = e >> 9; const int col = (int)(e & 511), j = col >> 7;
    bf16_t* ao = (bf16_t*)(p.ws + OFF_AO); const float* ls = (const float*)(p.ws + OFF_ALSE); const bf16_t* proj = (const bf16_t*)(p.ws + OFF_PROJ);
    const float l0 = ls[((size_t)0 * MTOK + row) * 4 + j], l1 = ls[((size_t)1 * MTOK + row) * 4 + j], l2 = ls[((size_t)2 * MTOK + row) * 4 + j];
    const float mx = fmaxf(l0, fmaxf(l1, l2)), w0 = exp2f(l0 - mx), w1 = exp2f(l1 - mx), w2 = exp2f(l2 - mx);
    const float y = (w0 * bf2f(ao[e]) + w1 * bf2f(ao[(size_t)MTOK * ATT_W + e]) + w2 * bf2f(ao[(size_t)2 * MTOK * ATT_W + e])) / (w0 + w1 + w2);
    ao[e] = f2bf(y * bf2f(proj[row * IN_COLS + C_ZA + col]));
}
__global__ void k_postnorm(Params p, int layer, const float* o) {
    const int row = blockIdx.x, t = threadIdx.x;
    const f32x4 v = ((const f32x4*)(o + (size_t)row * D_MODEL))[t];
    __shared__ float s[4], s2[4];
    float ss = wave_sum(v[0] * v[0] + v[1] * v[1] + v[2] * v[2] + v[3] * v[3]);
    if ((t & 63) == 0) s[t >> 6] = ss;
    __syncthreads();
    const float inv = rsqrtf((s[0] + s[1] + s[2] + s[3]) * (1.0f / D_MODEL) + RMS_EPS);
    const f32x4 g = ((const f32x4*)(p.in[IN_POSTG] + layer * D_MODEL))[t];
    f32x4 xv = ((f32x4*)(p.out + (size_t)row * D_MODEL))[t];
    xv = xv + v * inv * g;
    ((f32x4*)(p.out + (size_t)row * D_MODEL))[t] = xv;
    bf16_t* xb = (bf16_t*)(p.ws + OFF_XB) + (size_t)row * D_MODEL + t * 4;
    xb[0] = f2bf(xv[0]); xb[1] = f2bf(xv[1]); xb[2] = f2bf(xv[2]); xb[3] = f2bf(xv[3]);
    float q = wave_sum(xv[0] * xv[0] + xv[1] * xv[1] + xv[2] * xv[2] + xv[3] * xv[3]);
    if ((t & 63) == 0) s2[t >> 6] = q;
    __syncthreads();
    if (t == 0) ((float*)(p.ws + OFF_ROWSS))[row] = s2[0] + s2[1] + s2[2] + s2[3];
}
}

namespace pg8 {
#define PG8_LAS __attribute__((address_space(3)))
typedef unsigned short bf16_t;
typedef short bf16x8 __attribute__((ext_vector_type(8)));
typedef float f32x4 __attribute__((ext_vector_type(4)));
typedef unsigned u32x4 __attribute__((ext_vector_type(4)));
constexpr int BM = 256, BK = 64, HALF = 128, HTB = HALF * BK * 2  , STAGE_BYTES = 8 * HTB, NXCD = 8, WGM = 8;

__host__ __device__ __forceinline__ int lds_byte(int r, int c) { const int st = (r >> 4) * 2 + (c >> 5), rr = r & 15, cc = c & 31, ob = rr * 64 + cc * 2; return st * 1024 + (ob ^ (((ob >> 9) & 1) << 5)); }
__host__ __device__ __forceinline__ void stage_rc(int b, int& R, int& C) { const int st = b / 1024, sb = b % 1024, swz = sb ^ (((sb >> 9) & 1) << 5); R = (st >> 1) * 16 + swz / 64; C = (st & 1) * 32 + (swz % 64) / 2; }
__host__ __device__ __forceinline__ int perm32(int rho) { const int n = rho >> 4, i = rho & 15; return 8 * (i >> 2) + 4 * n + (i & 3); }

struct Unit { int pm, pn; };
struct Gemm { const bf16_t* A; const bf16_t* Bt; int M, N, K; };

struct StaticOrder {
    int nM, nN, nwg, G, c;
    __host__ __device__ void init(int M, int N, int G_, int c_) { nM = M / BM; nN = N / BM; nwg = nM * nN; G = G_; c = c_; }
    __host__ __device__ bool next(int i, Unit& u) const {
        const long L = (long)i * G + c; if (L >= nwg) return false;
        int wgid = (int)L; { const int q = nwg / NXCD, r = nwg % NXCD, xcd = wgid % NXCD, off = wgid / NXCD; wgid = (xcd < r ? xcd * (q + 1) : r * (q + 1) + (xcd - r) * q) + off; }
        const int nig = WGM * nN, gid = wgid / nig, fm = gid * WGM, gsz = (nM - fm) < WGM ? (nM - fm) : WGM;
        u.pm = fm + ((wgid % nig) % gsz); u.pn = (wgid % nig) / gsz;
        if (P1_SHAPE && G == 256 && nM == 64 && nN == 32) {
            const int b = c % 8, j = c / 8;
            u.pm = b * 8 + 4 * (i >> 2) + (j & 3); u.pn = 8 * ((i + b) & 3) + (j >> 2);
        }
        return true;
    }
    __device__ __forceinline__ void a_ready(const Unit&) const {}
    __device__ __forceinline__ void done(const Unit&) const {}
};

__device__ __forceinline__ unsigned cvt_pk_bf16(float lo, float hi) { unsigned r; asm volatile("v_cvt_pk_bf16_f32 %0, %1, %2" : "=v"(r) : "v"(lo), "v"(hi)); return r; }
template <class Epi, class Sched, bool ALIGN_EPI = false, bool SP2 = false>
__device__ __forceinline__ void gemm_phase(PG8_LAS unsigned char* lds, const Gemm g, const Sched& S, const Epi& E, int wave_s, unsigned long long& ts_sum, unsigned long long& ts_t0) {
    const int tid = tid_from(wave_s), wid = wave_s, lane = tid & 63, wr = wid >> 2, wc = wid & 3, fr = lane & 15, fq = lane >> 4;
    const int K = g.K, nt = K / BK;
    unsigned voffA[2], voffB[2];
#pragma unroll
    for (int i = 0; i < 2; ++i) { int R, C; stage_rc(tid * 16 + i * 8192, R, C); const int Rb = Epi::PERM ? ((R & ~31) + perm32(R & 31)) : R;
        voffA[i] = (unsigned)(R * K + C) * 2u; voffB[i] = (unsigned)(Rb * K + C) * 2u; }
    const size_t kstep = (size_t)(BK * 2);
    const size_t hstep = (size_t)HALF * K * 2;
    const size_t tstep = 2 * hstep;
    const unsigned ldsw = (unsigned)wid * 1024u;
    const int aoff = lds_byte(wr * 64 + fr, fq * 8), boff = lds_byte(wc * 32 + fr, fq * 8);
#define PG8_SA(b, h) (((b) * 2 + (h)) * HTB)
#define PG8_SB(b, h) ((4 + (b) * 2 + (h)) * HTB)
#define PG8_STAGE(bufoff, gbase, voff) do { _Pragma("unroll") for (int _i = 0; _i < 2; ++_i) \
        __builtin_amdgcn_global_load_lds((const unsigned*)((const char*)(gbase) + (voff)[_i]), (PG8_LAS unsigned*)(lds + (bufoff) + ldsw + _i * 8192), 16, 0, 0); } while (0)
#define PG8_LDA(dst, b, h) do { _Pragma("unroll") for (int m = 0; m < 4; ++m) _Pragma("unroll") for (int k = 0; k < 2; ++k) dst[m][k] = *(const PG8_LAS bf16x8*)(lds + PG8_SA(b, h) + aoff + m * 2048 + k * 1024); } while (0)
#define PG8_LDB(dst, b, h) do { _Pragma("unroll") for (int n = 0; n < 2; ++n) _Pragma("unroll") for (int k = 0; k < 2; ++k) dst[n][k] = *(const PG8_LAS bf16x8*)(lds + PG8_SB(b, h) + boff + n * 2048 + k * 1024); } while (0)
#define PG8_MMA(ai, bj, At, Bt) do { __builtin_amdgcn_s_setprio(1); _Pragma("unroll") for (int m = 0; m < 4; ++m) _Pragma("unroll") for (int n = 0; n < 2; ++n) _Pragma("unroll") for (int k = 0; k < 2; ++k) \
        acc[ai][bj][m][n] = __builtin_amdgcn_mfma_f32_16x16x32_bf16(Bt[n][k], At[m][k], acc[ai][bj][m][n], 0, 0, 0); __builtin_amdgcn_s_setprio(0); } while (0)
#define PG8_WAIT_V(n) asm volatile("s_waitcnt vmcnt(" #n ")" ::: "memory")
#define PG8_WAIT_L(n) asm volatile("s_waitcnt lgkmcnt(" #n ")" ::: "memory")
#define PG8_BAR __builtin_amdgcn_s_barrier()
#define PG8_SCHED __builtin_amdgcn_sched_barrier(0)
    Unit cur, nxt; int ui = 0;
    if (!S.next(0, cur)) return;
    f32x4 acc[2][2][4][2];
#pragma unroll
    for (int a = 0; a < 2; ++a)
#pragma unroll
        for (int b = 0; b < 2; ++b)
#pragma unroll
            for (int m = 0; m < 4; ++m)
#pragma unroll
                for (int n = 0; n < 2; ++n) acc[a][b][m][n] = (f32x4){0.f, 0.f, 0.f, 0.f};
    bf16x8 At[4][2], B0[2][2], B1[2][2];
    const char* cA = (const char*)g.A + (size_t)cur.pm * tstep; const char* cB = (const char*)g.Bt + (size_t)cur.pn * tstep;
    S.a_ready(cur);
    if constexpr (SP2) {
        PG8_STAGE(PG8_SB(0, 0), cB, voffB); PG8_STAGE(PG8_SB(0, 1), cB + hstep, voffB); PG8_STAGE(PG8_SA(0, 0), cA, voffA); PG8_STAGE(PG8_SA(0, 1), cA + hstep, voffA);
        if (wr == 1) PG8_BAR;
        PG8_WAIT_V(2); PG8_BAR;
        PG8_STAGE(PG8_SB(1, 0), cB + kstep, voffB); PG8_STAGE(PG8_SA(1, 0), cA + kstep, voffA); PG8_STAGE(PG8_SB(1, 1), cB + hstep + kstep, voffB);
        PG8_WAIT_V(6); PG8_BAR;
    } else {
        PG8_STAGE(PG8_SB(0, 0), cB, voffB); PG8_STAGE(PG8_SA(0, 0), cA, voffA); PG8_STAGE(PG8_SB(0, 1), cB + hstep, voffB); PG8_STAGE(PG8_SA(0, 1), cA + hstep, voffA);
        if (wr == 1) PG8_BAR;
        PG8_WAIT_V(4); PG8_BAR;
        PG8_STAGE(PG8_SB(1, 0), cB + kstep, voffB); PG8_STAGE(PG8_SA(1, 0), cA + kstep, voffA); PG8_STAGE(PG8_SB(1, 1), cB + hstep + kstep, voffB);
        PG8_WAIT_V(6); PG8_BAR;
    }
    for (;;) {
        const bool has_next = S.next(ui + 1, nxt);
        const char* nA = has_next ? (const char*)g.A + (size_t)nxt.pm * tstep : cA; const char* nB = has_next ? (const char*)g.Bt + (size_t)nxt.pn * tstep : cB;
        if constexpr (Epi::ROWSUMS)
            __builtin_amdgcn_global_load_lds((const unsigned*)(E.rowss + cur.pm * BM + 32 * wid + (tid_from(wave_s) & 31)), (PG8_LAS unsigned*)(lds + STAGE_BYTES + (ui & 1) * 2048 + wid * 256), 4, 0, 0);
        for (int t = 0; t < nt; t += 2) {
            const bool last = (t == nt - 2);
            const char* a1 = cA + (size_t)(t + 1) * kstep;
            const char* a2 = last ? nA : cA + (size_t)(t + 2) * kstep; const char* b2 = last ? nB : cB + (size_t)(t + 2) * kstep;
            const char* a3 = a2 + kstep; const char* b3 = b2 + kstep;
            if (last && has_next) S.a_ready(nxt);
            if constexpr (SP2) {
            const unsigned seam = (unsigned)__builtin_amdgcn_readfirstlane((Epi::ROWSUMS && SEAM_RELAX && t == 0 && ui > 0) ? 1 : 0);
            PG8_LDB(B0, 0, 0); PG8_LDB(B1, 0, 1); PG8_SCHED; PG8_LDA(At, 0, 0); PG8_STAGE(PG8_SA(1, 1), a1 + hstep, voffA);
            asm volatile("s_waitcnt vmcnt(25)\n\ts_cmp_lg_u32 %0, 0\n\ts_cbranch_scc1 1\n\ts_waitcnt vmcnt(8)" :: "s"(seam) : "scc", "memory");
            PG8_WAIT_L(0); PG8_BAR; PG8_MMA(0, 0, At, B0); PG8_MMA(0, 1, At, B1); PG8_BAR; PG8_SCHED;
            PG8_LDA(At, 0, 1); PG8_STAGE(PG8_SB(0, 0), b2, voffB); PG8_STAGE(PG8_SB(0, 1), b2 + hstep, voffB); PG8_STAGE(PG8_SA(0, 0), a2, voffA);
            asm volatile("s_waitcnt vmcnt(25)\n\ts_cmp_lg_u32 %0, 0\n\ts_cbranch_scc1 1\n\ts_waitcnt vmcnt(8)" :: "s"(seam) : "scc", "memory");
            PG8_WAIT_L(0); PG8_BAR; PG8_MMA(1, 0, At, B0); PG8_MMA(1, 1, At, B1); PG8_BAR; PG8_SCHED;
            PG8_LDB(B0, 1, 0); PG8_LDB(B1, 1, 1); PG8_SCHED; PG8_LDA(At, 1, 0); PG8_STAGE(PG8_SA(0, 1), a2 + hstep, voffA);
            PG8_WAIT_V(8); PG8_WAIT_L(0); PG8_BAR; PG8_MMA(0, 0, At, B0); PG8_MMA(0, 1, At, B1); PG8_BAR; PG8_SCHED;
            PG8_LDA(At, 1, 1); PG8_STAGE(PG8_SB(1, 0), b3, voffB); PG8_STAGE(PG8_SB(1, 1), b3 + hstep, voffB); PG8_STAGE(PG8_SA(1, 0), a3, voffA);
            PG8_WAIT_V(8); PG8_WAIT_L(0); PG8_BAR; PG8_MMA(1, 0, At, B0); PG8_MMA(1, 1, At, B1); PG8_BAR; PG8_SCHED;
            } else {
            PG8_LDB(B0, 0, 0); PG8_SCHED; PG8_LDA(At, 0, 0); PG8_STAGE(PG8_SA(1, 1), a1 + hstep, voffA);
            PG8_WAIT_L(8); PG8_BAR; PG8_WAIT_L(0); PG8_MMA(0, 0, At, B0); PG8_BAR; PG8_SCHED;
            PG8_LDB(B1, 0, 1); PG8_STAGE(PG8_SB(0, 0), b2, voffB);
            PG8_BAR; PG8_WAIT_L(0); PG8_MMA(0, 1, At, B1); PG8_BAR;
            PG8_LDA(At, 0, 1); PG8_STAGE(PG8_SA(0, 0), a2, voffA);
            PG8_BAR; PG8_WAIT_L(0); PG8_MMA(1, 0, At, B0); PG8_BAR; PG8_SCHED;
            PG8_STAGE(PG8_SB(0, 1), b2 + hstep, voffB);
            PG8_WAIT_V(6); PG8_BAR; PG8_MMA(1, 1, At, B1); PG8_BAR;
            PG8_LDB(B0, 1, 0); PG8_SCHED; PG8_LDA(At, 1, 0); PG8_STAGE(PG8_SA(0, 1), a2 + hstep, voffA);
            PG8_WAIT_L(8); PG8_BAR; PG8_WAIT_L(0); PG8_MMA(0, 0, At, B0); PG8_BAR; PG8_SCHED;
            PG8_LDB(B1, 1, 1); PG8_STAGE(PG8_SB(1, 0), b3, voffB);
            PG8_BAR; PG8_WAIT_L(0); PG8_MMA(0, 1, At, B1); PG8_BAR;
            PG8_LDA(At, 1, 1); PG8_STAGE(PG8_SA(1, 0), a3, voffA);
            PG8_BAR; PG8_WAIT_L(0); PG8_MMA(1, 0, At, B0); PG8_BAR; PG8_SCHED;
            PG8_STAGE(PG8_SB(1, 1), b3 + hstep, voffB);
            PG8_WAIT_V(6); PG8_BAR; PG8_MMA(1, 1, At, B1); PG8_BAR;
            }
        }
        if constexpr (ALIGN_EPI) { if (wr == 0) PG8_BAR; }
        TS_BEGIN(11);
        if constexpr (!Epi::AFTER_DRAIN) { E(acc, cur, wr, wc, fr, fq, (const PG8_LAS float*)(lds + STAGE_BYTES + (ui & 1) * 2048)); S.done(cur); }
        TS_END(11);
        if (!has_next) break;
#pragma unroll
        for (int a = 0; a < 2; ++a)
#pragma unroll
            for (int b = 0; b < 2; ++b)
#pragma unroll
                for (int m = 0; m < 4; ++m)
#pragma unroll
                    for (int n = 0; n < 2; ++n) acc[a][b][m][n] = (f32x4){0.f, 0.f, 0.f, 0.f};
        cur = nxt; cA = nA; cB = nB; ++ui;
        if constexpr (ALIGN_EPI) { if (wr == 1) PG8_BAR; }
    }
    PG8_WAIT_V(0);
    if constexpr (!ALIGN_EPI) { if (wr == 0) PG8_BAR; }
    PG8_BAR;
    if constexpr (Epi::AFTER_DRAIN) { E.fused(acc, cur, wr, wc, fr, fq, lds, wid, lane); S.done(cur); }
#undef PG8_SA
#undef PG8_SB
#undef PG8_STAGE
#undef PG8_LDA
#undef PG8_LDB
#undef PG8_MMA
#undef PG8_WAIT_V
#undef PG8_WAIT_L
#undef PG8_BAR
#undef PG8_SCHED
}
}

namespace pg8 {
struct EpiInProj {
    static constexpr bool PERM = true, AFTER_DRAIN = false, ROWSUMS = true;
    unsigned char* ws; const float* rowss;
    __device__ __forceinline__ void operator()(const f32x4 (&acc)[2][2][4][2], const Unit& u, int wr, int wc, int fr, int fq, const PG8_LAS float* rs) const {
        const int row0 = u.pm * BM + wr * 64 + fr, colt = u.pn * BM, cl = wc * 32 + 8 * fq;
        const int mode = (colt >= C_GS) ? 2 : (((colt >= C_ZS && colt < C_Q) || (colt >= C_ZA && colt < C_GS)) ? 1 : 0);
        bf16_t* base; int kind = 0, sh = 0; size_t bjs;
        if (colt < C_ZS) { base = (bf16_t*)(ws + OFF_UG) + (size_t)(colt >> 4) * SEQ * 16; bjs = (size_t)8 * SEQ * 16; kind = 1; }
        else if (colt < C_Q) { base = (bf16_t*)(ws + OFF_GZ) + GZ_ZS + (colt - C_ZS); bjs = HALF; }
        else if (colt < C_ZA) { const int j = (colt - C_Q) >> 8, kd = j / 6, jj = j - 6 * kd, gi = jj >> 1; sh = 2 * gi; kind = 2;
            base = (bf16_t*)(ws + OFF_QKV) + ((size_t)((kd * 3 + gi) * BATCH) * HPG + 2 * (jj & 1)) * SEQ * HD; bjs = (size_t)SEQ * HD; }
        else if (colt < C_GS) { base = (bf16_t*)(ws + OFF_GZ) + GZ_ZA + (colt - C_ZA); bjs = HALF; }
        else { base = (bf16_t*)(ws + OFF_G8); bjs = HALF; kind = 3; }
        float inv[2][4];
#pragma unroll
        for (int ai = 0; ai < 2; ++ai)
#pragma unroll
            for (int m = 0; m < 4; ++m) { const int rl = wr * 64 + fr + ai * HALF + m * 16; inv[ai][m] = rsqrtf(rs[(rl >> 5) * 64 + (rl & 31)] * (1.0f / D_MODEL) + RMS_EPS); }
#pragma unroll
        for (int ai = 0; ai < 2; ++ai)
#pragma unroll
            for (int m = 0; m < 4; ++m) {
                const int row = row0 + ai * HALF + m * 16, b = row >> 11, t = row & (SEQ - 1);
                unsigned ro;
                if (kind == 3) { const unsigned go = (unsigned)row * G8_W + (unsigned)(colt - C_GS) + (unsigned)cl;
#pragma unroll
                    for (int bj = 0; bj < 2; ++bj) { const f32x4 v0 = acc[ai][bj][m][0] * inv[ai][m], v1 = acc[ai][bj][m][1] * inv[ai][m]; unsigned lo = 0u, hi = 0u;
#pragma unroll
                        for (int e = 0; e < 4; ++e) { const float s0 = __builtin_amdgcn_rcpf(1.0f + __builtin_amdgcn_exp2f(-1.4426950408889634f * v0[e])), s1 = __builtin_amdgcn_rcpf(1.0f + __builtin_amdgcn_exp2f(-1.4426950408889634f * v1[e]));
                            lo |= (unsigned)(s0 * 255.0f + 0.5f) << (8 * e); hi |= (unsigned)(s1 * 255.0f + 0.5f) << (8 * e); }
                        { typedef unsigned u32x2g __attribute__((ext_vector_type(2))); const u32x2g gw_ = {lo, hi};
                          asm volatile("global_store_dwordx2 %0, %1, %2" :: "v"(go + (unsigned)(bj * HALF)), "v"(gw_), "s"(base) : "memory"); } }
                    continue; }
                if (kind == 0) ro = ((unsigned)row * GZ_W + (unsigned)cl) * 2u;
                else if (kind == 1) ro = (((unsigned)(b * SSM_NG + (cl >> 4)) * SEQ + (unsigned)t) * 16u + (unsigned)(cl & 8)) * 2u;
                else { const int pos = ((t & ((1 << sh) - 1)) << (11 - sh)) + (t >> sh); ro = (((unsigned)b * HPG * SEQ + (unsigned)pos) * HD + (unsigned)cl) * 2u; }
#pragma unroll
                for (int bj = 0; bj < 2; ++bj) {
                    f32x4 v0 = acc[ai][bj][m][0] * inv[ai][m], v1 = acc[ai][bj][m][1] * inv[ai][m];
                    if (mode != 0) {
#pragma unroll
                        for (int e = 0; e < 4; ++e) {
                            const float s0 = __builtin_amdgcn_rcpf(1.0f + __builtin_amdgcn_exp2f(-1.4426950408889634f * v0[e]));
                            const float s1 = __builtin_amdgcn_rcpf(1.0f + __builtin_amdgcn_exp2f(-1.4426950408889634f * v1[e]));
                            v0[e] = (mode == 1) ? v0[e] * s0 : s0; v1[e] = (mode == 1) ? v1[e] * s1 : s1;
                        }
                    }
                    u32x4 w; w.x = cvt_pk_bf16(v0[0], v0[1]); w.y = cvt_pk_bf16(v0[2], v0[3]); w.z = cvt_pk_bf16(v1[0], v1[1]); w.w = cvt_pk_bf16(v1[2], v1[3]);
#if EXP_NOSTORE
                    asm volatile("" :: "v"(w.x), "v"(w.y), "v"(w.z), "v"(w.w));
#else
#if P1_NT
                    __builtin_nontemporal_store(w, (u32x4*)(rowp + bj * bjs));
#else
                    asm volatile("global_store_dwordx4 %0, %1, %2" :: "v"(ro + (unsigned)bj * (unsigned)bjs * 2u), "v"(w), "s"(base) : "memory");
#endif
#endif
                }
            }
    }
};
}

#define LAS __attribute__((address_space(3)))
#define GAS __attribute__((address_space(1)))
#define LDS_WAIT() asm volatile("s_waitcnt lgkmcnt(0)" ::: "memory")
#define VM_WAIT() asm volatile("s_waitcnt vmcnt(0)" ::: "memory")
__device__ __forceinline__ unsigned pk2(float lo, float hi) { return (unsigned)f2bf(lo) | ((unsigned)f2bf(hi) << 16); }
#define XB_TMO      128
#define XB_XCNT(j)  (256  + 64 * (j))
#define XB_XSUB(j)  (1280 + 64 * (j))
#define XB_XGEN(j)  (2304 + 64 * (j))
#define XB_TOP      3328
#define XB_TOPGEN   3392
#define XCD_BAR_WORDS 3456
#define XB_SPIN_CAP (1u << 18)

__device__ __forceinline__ unsigned xb_ld(unsigned* p)              { return __hip_atomic_load(p, __ATOMIC_RELAXED, __HIP_MEMORY_SCOPE_AGENT); }
__device__ __forceinline__ unsigned xb_add(unsigned* p, unsigned v) { return __hip_atomic_fetch_add(p, v, __ATOMIC_RELAXED, __HIP_MEMORY_SCOPE_AGENT); }
__device__ __forceinline__ unsigned xb_xcc_id() { return (unsigned)__builtin_amdgcn_s_getreg((3 << 11) | 20) & 0xFu; }
#define XB_SPIN(cond, bar) do { unsigned _sp = 0; while (cond) { __builtin_amdgcn_s_sleep(1); \
    if ((++_sp & 255u) == 0u) { if (xb_ld(&(bar)[XB_TMO])) break; if (_sp > XB_SPIN_CAP) { atomicAdd(&(bar)[XB_TMO], 1u); break; } } } } while (0)

struct XcdBarrier {
    int w;
    unsigned G;
    unsigned* bar; unsigned x;
    volatile LAS unsigned* st;
};

__device__ __forceinline__ XcdBarrier xcd_barrier_post(unsigned* bar, volatile LAS unsigned* st, int wave_s, unsigned G) {
    XcdBarrier b; b.w = wave_s; b.G = G; b.bar = bar; b.x = xb_xcc_id(); b.st = st;
    if (tid_from(wave_s) == 0) (void)xb_add(&bar[XB_XCNT(b.x)], 1u);
    return b;
}
__device__ __forceinline__ void xcd_barrier_complete(unsigned* bar, unsigned x, unsigned& nloc, unsigned& nx, unsigned G) {
    unsigned sum, cnt, mine, sp = 0u;
    for (;;) {
        sum = 0u; cnt = 0u; mine = 0u;
#pragma unroll
        for (unsigned j = 0; j < 16; ++j) { const unsigned c = xb_ld(&bar[XB_XCNT(j)]); sum += c; cnt += (c > 0u) ? 1u : 0u; mine = (j == x) ? c : mine; }
        if (sum == G) break;
        __builtin_amdgcn_s_sleep(1);
        if ((++sp & 255u) == 0u) { if (xb_ld(&bar[XB_TMO])) break; if (sp > XB_SPIN_CAP) { atomicAdd(&bar[XB_TMO], 1u); break; } }
    }
    nloc = mine > 0u ? mine : 1u; nx = cnt > 0u ? cnt : 1u;
}

__device__ __forceinline__ void xcd_barrier(const XcdBarrier& b) {
    asm volatile("s_waitcnt vmcnt(0)" ::: "memory");
    __syncthreads();
    if (tid_from(b.w) == 0) {
        unsigned* bar = b.bar;
        __builtin_amdgcn_s_waitcnt(0);
        unsigned nloc = b.st[0], nx = b.st[1];
        if (nloc == 0u) { xcd_barrier_complete(bar, b.x, nloc, nx, b.G); b.st[0] = nloc; b.st[1] = nx; }
        const unsigned old = xb_add(&bar[XB_XSUB(b.x)], 1u);
        const unsigned gen = old / nloc;
        if (old + 1u == (gen + 1u) * nloc) {
            __builtin_amdgcn_fence(__ATOMIC_RELEASE, "agent");
            asm volatile("s_waitcnt vmcnt(0)" ::: "memory");
            const unsigned og = xb_add(&bar[XB_TOP], 1u);
            const unsigned tg = og / nx;
            if (og + 1u == (tg + 1u) * nx) xb_add(&bar[XB_TOPGEN], 1u);
            else XB_SPIN(xb_ld(&bar[XB_TOPGEN]) == tg, bar);
            __builtin_amdgcn_fence(__ATOMIC_ACQUIRE, "agent");
            xb_add(&bar[XB_XGEN(b.x)], 1u);
            asm volatile("s_waitcnt vmcnt(0)" ::: "memory");
        } else {
            XB_SPIN(xb_ld(&bar[XB_XGEN(b.x)]) == gen, bar);
            __builtin_amdgcn_fence(__ATOMIC_ACQUIRE, "agent");
            asm volatile("s_waitcnt vmcnt(0)" ::: "memory");
        }
    }
    __syncthreads();
}

constexpr int NWAVES = 8, NTHREADS = NWAVES * 64;
constexpr int RING_BYTES = 131072;
constexpr int LDS_BYTES = 163840;
constexpr int MISC_OFF = LDS_BYTES - 256;
constexpr int CW_BAR = 4096;
constexpr int N_BAR_REGIONS = 32;
constexpr size_t CTL_ZERO_BYTES = 1 * MiB;
static_assert((CW_BAR + N_BAR_REGIONS * XCD_BAR_WORDS) * 4 <= (int)CTL_ZERO_BYTES, "ctl");

#ifndef PROBE_DUP
#define PROBE_DUP 0
#endif
struct Frame { LAS unsigned char* lds; int wave, vcu, G; };

struct Args { Params p; int ph_lo, ph_hi, bar_region, pad; };
__device__ __forceinline__ const float* inptr(const Args& a, int i) { int z; asm volatile("s_mov_b32 %0, 0" : "=s"(z)); return a.p.in[i + z]; }

namespace swa {
constexpr int D = 128; constexpr float THR = 8.f; constexpr bool WSKIP = true;
constexpr float SCALE = 0.08838834764831845f;
constexpr int NW = 8, QBLK = 32, KVBLK = 64, QB = NW * QBLK;
constexpr int SHM_V = KVBLK * D * 2, SHM_K = KVBLK * D * 2;
constexpr int ATTN_LDS_BYTES = 2 * SHM_V + 2 * SHM_K + NW * 64 * 4;

typedef short s16x4 __attribute__((ext_vector_type(4)));
typedef float f32x16 __attribute__((ext_vector_type(16)));
template <class A, class Bt> struct same_t { static constexpr bool v = false; };
template <class A> struct same_t<A, A> { static constexpr bool v = true; };

#define KSWZ(row, colB) ((row) * 256 + ((colB) ^ (((row) & 7) << 4)))
#define SBAR() __builtin_amdgcn_sched_barrier(0)
__device__ __forceinline__ int v_st(int k, int c) { const int kk = (k & ~0xC) | ((k & 4) << 1) | ((k & 8) >> 1); return ((kk >> 3) * 4 + (c >> 5)) * 512 + ((kk & 7) * 32 + (c & 31)) * 2; }
__device__ __forceinline__ int v_rd_base(int lane) { return ((lane & 3) << 3) | (((lane >> 2) & 3) << 6) | (((lane >> 4) & 1) << 5) | (((lane >> 5) & 1) << 8); }
constexpr int v_rd_off(int d0, int ks, int half) { return d0 * 512 + ks * 4096 + half * 2048; }
__device__ __forceinline__ int crow(int r, int hi) { return (r & 3) + 8 * (r >> 2) + 4 * hi; }
__device__ __forceinline__ unsigned cvtpk(float lo, float hi) {
    unsigned r; asm volatile("v_cvt_pk_bf16_f32 %0, %1, %2" : "=v"(r) : "v"(lo), "v"(hi)); return r;
}
__device__ __forceinline__ bf16x8 pack8(f32x4 a, f32x4 b) {
    u32x4 w = {cvtpk(a[0], a[1]), cvtpk(a[2], a[3]), cvtpk(b[0], b[1]), cvtpk(b[2], b[3])};
    return *reinterpret_cast<bf16x8*>(&w);
}
template <class T> __device__ __forceinline__ bf16x8 load8(const T* p) {
    if constexpr (same_t<T, float>::v) { return pack8(*(const f32x4*)p, *(const f32x4*)(p + 4)); }
    else { return *reinterpret_cast<const bf16x8*>(p); }
}
__device__ __forceinline__ void mask_tile(f32x16& p0, f32x16& p1, int dq, unsigned W) {
    const float NEG = -__builtin_inff();
#pragma unroll
    for (int r = 0; r < 16; ++r) {
        const int c = (r & 3) + 8 * (r >> 2);
        if ((unsigned)(dq - c) >= W) p0[r] = NEG;
        if ((unsigned)(dq - c - 32) >= W) p1[r] = NEG;
    }
}
__device__ __forceinline__ void partialSM(f32x16& p0, f32x16& p1, float& m_reg, float& mn, float& alpha) {
    float pmax = p0[0]; for (int r = 1; r < 16; ++r) pmax = fmaxf(pmax, p0[r]); for (int r = 0; r < 16; ++r) pmax = fmaxf(pmax, p1[r]);
    { auto rr = __builtin_amdgcn_permlane32_swap(__float_as_uint(pmax), __float_as_uint(pmax), false, false);
      pmax = fmaxf(__uint_as_float(rr[0]), __uint_as_float(rr[1])); }
    constexpr float C2 = 1.4426950408889634f * SCALE;
    if (__builtin_expect(__all((pmax - m_reg) * SCALE <= THR), 1)) { mn = m_reg; alpha = 1.f; }
    else { mn = fmaxf(m_reg, pmax); alpha = __builtin_amdgcn_exp2f((m_reg - mn) * C2); m_reg = mn; }
    const float mnL = -mn * C2;
    for (int r = 0; r < 16; ++r) p0[r] = fmaf(p0[r], C2, mnL); for (int r = 0; r < 16; ++r) p1[r] = fmaf(p1[r], C2, mnL);
    for (int r = 0; r < 16; ++r) p0[r] = __builtin_amdgcn_exp2f(p0[r]);
}
__device__ __forceinline__ void finishSM(f32x16& p0, f32x16& p1, float alpha, float& l_reg, bf16x8& pa0, bf16x8& pa1, bf16x8& pa2, bf16x8& pa3) {
    for (int r = 0; r < 16; ++r) p1[r] = __builtin_amdgcn_exp2f(p1[r]);
    float ps = 0; for (int r = 0; r < 16; ++r) ps += p0[r]; for (int r = 0; r < 16; ++r) ps += p1[r];
    { auto rr = __builtin_amdgcn_permlane32_swap(__float_as_uint(ps), __float_as_uint(ps), false, false);
      ps = __uint_as_float(rr[0]) + __uint_as_float(rr[1]); }
    l_reg = l_reg * alpha + ps;
#define PK4(P, B_, OUT) do { unsigned a0 = cvtpk(P[B_+0], P[B_+1]), a1 = cvtpk(P[B_+2], P[B_+3]);                          \
        unsigned b0 = cvtpk(P[B_+4], P[B_+5]), b1 = cvtpk(P[B_+6], P[B_+7]);                                             \
        auto r0 = __builtin_amdgcn_permlane32_swap(a0, b0, false, false); auto r1 = __builtin_amdgcn_permlane32_swap(a1, b1, false, false); \
        u32x4 w = {r0[0], r1[0], r0[1], r1[1]}; OUT = *reinterpret_cast<bf16x8*>(&w); } while (0)
    PK4(p0, 0, pa0); PK4(p0, 8, pa1); PK4(p1, 0, pa2); PK4(p1, 8, pa3);
#undef PK4
}
template <int KB, bool SK>
__device__ __forceinline__ void qkt(f32x16& p0, f32x16& p1, const char* K_lds, int r32, int hi, const bf16x8* qr, bool act) {
    if (SK && !act) { const float NEG = -__builtin_inff();
#pragma unroll
        for (int r = 0; r < 16; ++r) { p0[r] = NEG; p1[r] = NEG; } return; }
    p0 = f32x16{}; p1 = f32x16{};
    const char* kb[4];
#pragma unroll
    for (int dd = 0; dd < 4; ++dd) kb[dd] = K_lds + KB * SHM_K + KSWZ(r32, (dd * 16 + hi * 8) * 2);
#pragma unroll
    for (int d0 = 0; d0 < 8; ++d0) { const char* a = kb[d0 & 3] + (d0 >> 2) * 128;
        bf16x8 b0 = *reinterpret_cast<const bf16x8*>(a);
        bf16x8 b1 = *reinterpret_cast<const bf16x8*>(a + 32 * 256);
        p0 = __builtin_amdgcn_mfma_f32_32x32x16_bf16(b0, qr[d0], p0, 0, 0, 0);
        p1 = __builtin_amdgcn_mfma_f32_32x32x16_bf16(b1, qr[d0], p1, 0, 0, 0); }
}
template <int VB, bool SK>
__device__ __forceinline__ void pv_tile(f32x16* o, int vb0, bf16x8 pa0, bf16x8 pa1, bf16x8 pa2, bf16x8 pa3, bool act) {
    if (SK && !act) return;
#define TRRD(dst, off) asm volatile("ds_read_b64_tr_b16 %0, %1 offset:%2" : "=&v"(dst) : "v"(vb0), "i"(off) : "memory")
#define PV_D0(d0) do { s16x4 l0, l1, l2, l3, h0, h1, h2, h3; constexpr int b_ = VB * SHM_V + v_rd_off(d0, 0, 0);     \
        TRRD(l0, b_); TRRD(h0, b_ + 2048); TRRD(l1, b_ + 4096); TRRD(h1, b_ + 6144); TRRD(l2, b_ + 8192); TRRD(h2, b_ + 10240); TRRD(l3, b_ + 12288); TRRD(h3, b_ + 14336); \
        asm volatile("s_waitcnt lgkmcnt(0)" ::: "memory"); SBAR();                 \
        o[d0] = __builtin_amdgcn_mfma_f32_32x32x16_bf16(pa0, (bf16x8){l0[0], l0[1], l0[2], l0[3], h0[0], h0[1], h0[2], h0[3]}, o[d0], 0, 0, 0);   \
        o[d0] = __builtin_amdgcn_mfma_f32_32x32x16_bf16(pa1, (bf16x8){l1[0], l1[1], l1[2], l1[3], h1[0], h1[1], h1[2], h1[3]}, o[d0], 0, 0, 0);   \
        o[d0] = __builtin_amdgcn_mfma_f32_32x32x16_bf16(pa2, (bf16x8){l2[0], l2[1], l2[2], l2[3], h2[0], h2[1], h2[2], h2[3]}, o[d0], 0, 0, 0);   \
        o[d0] = __builtin_amdgcn_mfma_f32_32x32x16_bf16(pa3, (bf16x8){l3[0], l3[1], l3[2], l3[3], h3[0], h3[1], h3[2], h3[3]}, o[d0], 0, 0, 0); } while (0)
    PV_D0(0); PV_D0(1); PV_D0(2); PV_D0(3);
#undef PV_D0
#undef TRRD
}

template <class TIn, class TOut> struct BlockRef { const TIn* Q; const TIn* K; const TIn* V; TOut* O; float* L; int P0, pitch, opitch, lpitch, nq; };
template <class TIn> struct Seam {
    bf16x8 qr[8];
    bf16x8 st_v0, st_v1, st_k0, st_k1; f32x4 sf0, sf1, sf2, sf3;
    f32x4 tq[16];
};
__device__ __forceinline__ int swa_jlo(int P0, int W) { const int lowk = P0 - W + 1; return lowk > 0 ? lowk / KVBLK : 0; }
#define ROW(p, k0, rr) ((p) + (size_t)((k0) + (rr)) * PITCH_ + sc)
#define VMW() asm volatile("s_waitcnt vmcnt(0)" ::: "memory")
#define VMWN(n) asm volatile("s_waitcnt vmcnt(%0)" :: "i"(n) : "memory")
#define SLOAD_H(Kp, Vp, k0) do { S.st_v0 = load8<TIn>(ROW(Vp, k0, sr)); S.st_v1 = load8<TIn>(ROW(Vp, k0, 32 + sr));              \
                         S.st_k0 = load8<TIn>(ROW(Kp, k0, sr)); S.st_k1 = load8<TIn>(ROW(Kp, k0, 32 + sr)); } while (0)
#define SWRITE_HK(bf) do { *(bf16x8*)(K_lds + (bf) * SHM_K + kws) = S.st_k0; *(bf16x8*)(K_lds + (bf) * SHM_K + kws + 32 * 256) = S.st_k1; } while (0)
#define SWRITE_HV(bf) do { *(bf16x8*)(V_lds + (bf) * SHM_V + vst0) = S.st_v0; *(bf16x8*)(V_lds + (bf) * SHM_V + vst1) = S.st_v1; } while (0)
#define SWRITE_H(bf) do { SWRITE_HV(bf); SWRITE_HK(bf); } while (0)
#define SLOAD_F(p, k0) do { S.sf0 = *(const f32x4*)ROW(p, k0, sr); S.sf1 = *(const f32x4*)(ROW(p, k0, sr) + 4);                \
                            S.sf2 = *(const f32x4*)ROW(p, k0, 32 + sr); S.sf3 = *(const f32x4*)(ROW(p, k0, 32 + sr) + 4); } while (0)
#define SWRITE_KF(bf) do { *(bf16x8*)(K_lds + (bf) * SHM_K + kws) = pack8(S.sf0, S.sf1); *(bf16x8*)(K_lds + (bf) * SHM_K + kws + 32 * 256) = pack8(S.sf2, S.sf3); } while (0)
#define SWRITE_VF(bf) do { *(bf16x8*)(V_lds + (bf) * SHM_V + vst0) = pack8(S.sf0, S.sf1); *(bf16x8*)(V_lds + (bf) * SHM_V + vst1) = pack8(S.sf2, S.sf3); } while (0)
template <class TIn, class TOut>
__device__ __forceinline__ void causal_swa_prime(const BlockRef<TIn, TOut>& cur, int W, char* lds, Seam<TIn>& S, int wave_s) {
    constexpr bool F32 = same_t<TIn, float>::v;
    const int tid = tid_from(wave_s), wid = wave_s, lane = tid & 63, r32 = lane & 31, hi = lane >> 5;
    const int sr = tid >> 4, sc = (tid & 15) * 8, kws = KSWZ(sr, sc * 2); char* K_lds = lds + 2 * SHM_V;
    const int kb0 = swa_jlo(cur.P0, W) * KVBLK;
    const int PITCH_ = cur.pitch; const int qrow_ = (wid * QBLK + r32 < cur.nq) ? wid * QBLK + r32 : cur.nq - 1;
    for (int d0 = 0; d0 < 8; ++d0) S.qr[d0] = load8<TIn>(cur.Q + (size_t)qrow_ * PITCH_ + d0 * 16 + hi * 8);
    if constexpr (F32) { SLOAD_F((const float*)cur.K, kb0); VMW(); SWRITE_KF(0); SBAR(); SLOAD_F((const float*)cur.V, kb0); }
    else { SLOAD_H(cur.K, cur.V, kb0); VMW(); SWRITE_HK(0); }
    __syncthreads();
}
template <class TIn, class TOut>
__device__ __forceinline__ void causal_swa_block(const BlockRef<TIn, TOut>& cur, const BlockRef<TIn, TOut>& nxt, int skv, int W, char* lds, Seam<TIn>& S, int wave_s) {
    constexpr bool F32 = same_t<TIn, float>::v;
    const int tid = tid_from(wave_s), wid = wave_s, lane = tid & 63, r32 = lane & 31, hi = lane >> 5;
    int PITCH_ = cur.pitch; const bool wact = (wid * QBLK < cur.nq);
    const int j_lo = swa_jlo(cur.P0, W);
    int j_hi = (cur.P0 + QB - 1) / KVBLK + 1; if (j_hi > skv / KVBLK) j_hi = skv / KVBLK;
    const int NT = j_hi - j_lo;
    const int kbn = swa_jlo(nxt.P0, W) * KVBLK;
    const int qlo = cur.P0 + wid * QBLK, qm = qlo + r32 - 4 * hi;
    char* V_lds = lds; char* K_lds = lds + 2 * SHM_V;
    float* ws = (float*)(lds + 2 * SHM_V + 2 * SHM_K) + wid * 64; float* li_l = ws, * al_l = ws + 32;
    float m_reg = -1e30f, l_reg = 0; f32x16 o[4] = {};
    const int sr = tid >> 4, sc = (tid & 15) * 8, vst0 = v_st(sr, sc), vst1 = v_st(32 + sr, sc), kws = KSWZ(sr, sc * 2);
    const int vb0 = (int)(uintptr_t)V_lds + v_rd_base(lane);
    const TIn* Kh = cur.K; const TIn* Vh = cur.V;
#define RESC(a) do { if (__any((a) < 1.f)) { if (hi == 0) al_l[r32] = (a); asm volatile("s_waitcnt lgkmcnt(0)" ::: "memory");              \
                     for (int d_ = 0; d_ < 4; ++d_) for (int r = 0; r < 16; ++r) o[d_][r] *= al_l[crow(r, hi)]; } } while (0)
#define KBASE(t) ((j_lo + (t)) * KVBLK)
#define ACT(t) (wact && KBASE(t) <= qlo + QBLK - 1 && KBASE(t) + KVBLK - 1 >= qlo - W + 1)
#define MASKT(P0_, P1_, t) do { const int kb_ = KBASE(t); if ((!SK || ACT(t)) && (kb_ + KVBLK - 1 > qlo || kb_ <= qlo + QBLK - 1 - W)) mask_tile(P0_, P1_, qm - kb_, (unsigned)W); } while (0)
    constexpr int NQL = F32 ? 16 : 8;
    constexpr bool SK = WSKIP && !F32;
#define SEAM_K0() do { VMWN(NQL); if constexpr (F32) { SWRITE_KF(0); SBAR(); SLOAD_F((const float*)nxt.V, kbn); } else { SWRITE_HK(0); } SBAR(); } while (0)
    f32x16 pA0, pA1, pB0, pB1; float mnA, mnB, alA, alB; bf16x8 pa0, pa1, pa2, pa3;
    if constexpr (F32) { VMW(); SWRITE_VF(0); SBAR(); } else { SWRITE_HV(0); SBAR(); }
    if (NT > 1) { if constexpr (F32) SLOAD_F((const float*)Kh, KBASE(1)); else SLOAD_H(Kh, Vh, KBASE(1)); }
    SBAR(); qkt<0, SK>(pA0, pA1, K_lds, r32, hi, S.qr, ACT(0));
    if constexpr (F32) { if (NT > 1) { VMW(); SWRITE_KF(1); SBAR(); SLOAD_F((const float*)Vh, KBASE(1)); } }
    MASKT(pA0, pA1, 0); partialSM(pA0, pA1, m_reg, mnA, alA);
    if (NT > 1) { VMW(); if constexpr (F32) { SWRITE_VF(1); SBAR(); if (NT > 2) SLOAD_F((const float*)Kh, KBASE(2)); } else SWRITE_H(1); }
    __syncthreads();
#define HALF_STEP(PX0, PX1, mnX, alX, PY0, PY1, alY, t, KB, VB, SB) do {                                                      \
        SBAR(); if constexpr (!F32) { if ((t) + 1 < NT) { SLOAD_H(Kh, Vh, KBASE((t) + 1)); SBAR(); } }     \
        qkt<KB, SK>(PX0, PX1, K_lds, r32, hi, S.qr, ACT(t));                                             \
        finishSM(PY0, PY1, alY, l_reg, pa0, pa1, pa2, pa3); SBAR();                                                           \
        if constexpr (F32) { if ((t) + 1 < NT) { VMW(); SWRITE_KF(SB); SBAR(); SLOAD_F((const float*)Vh, KBASE((t) + 1)); SBAR(); } }  \
        pv_tile<VB, SK>(o, vb0, pa0, pa1, pa2, pa3, ACT((t) - 1)); MASKT(PX0, PX1, (t)); partialSM(PX0, PX1, m_reg, mnX, alX);                                        \
        __syncthreads();                                                                                                      \
        if ((t) + 1 < NT) { VMW(); if constexpr (F32) { SWRITE_VF(SB); SBAR(); if ((t) + 2 < NT) SLOAD_F((const float*)Kh, KBASE((t) + 2)); } \
                            else { SWRITE_H(SB); } }                                                                          \
        RESC(alX); __syncthreads(); } while (0)
    for (int t = 1; t + 1 < NT; t += 2) {
        HALF_STEP(pB0, pB1, mnB, alB, pA0, pA1, alA, t, 1, 0, 0);
        HALF_STEP(pA0, pA1, mnA, alA, pB0, pB1, alB, t + 1, 0, 1, 1);
    }
    const bool even = (NT & 1) == 0;
    if (even) { SBAR(); qkt<1, SK>(pB0, pB1, K_lds, r32, hi, S.qr, ACT(NT - 1)); SBAR(); }
#define QROW(e) (nxt.Q + (size_t)(wid * QBLK + r32) * D + ((e) >> 1) * 16 + hi * 8 + ((e) & 1) * 4)
    if constexpr (F32) { SLOAD_F((const float*)nxt.K, kbn); SBAR();
#pragma unroll
        for (int e = 0; e < 8; ++e) S.tq[e] = *(const f32x4*)QROW(e); }
    else { PITCH_ = nxt.pitch; SLOAD_H(nxt.K, nxt.V, kbn); SBAR();
        const int qrow_ = (wid * QBLK + r32 < nxt.nq) ? wid * QBLK + r32 : nxt.nq - 1;
#pragma unroll
        for (int d0 = 0; d0 < 8; ++d0) S.qr[d0] = load8<TIn>(nxt.Q + (size_t)qrow_ * PITCH_ + d0 * 16 + hi * 8); }
    SBAR();
    finishSM(pA0, pA1, alA, l_reg, pa0, pa1, pa2, pa3); SBAR();
    if constexpr (F32) {
#pragma unroll
        for (int e = 8; e < 16; ++e) S.tq[e] = *(const f32x4*)QROW(e); SBAR(); }
#undef QROW
    pv_tile<0, SK>(o, vb0, pa0, pa1, pa2, pa3, ACT(even ? NT - 2 : NT - 1));
    if (even) { MASKT(pB0, pB1, NT - 1); partialSM(pB0, pB1, m_reg, mnB, alB); __syncthreads(); RESC(alB);
        finishSM(pB0, pB1, alB, l_reg, pa0, pa1, pa2, pa3); SBAR(); pv_tile<1, SK>(o, vb0, pa0, pa1, pa2, pa3, ACT(NT - 1)); }
    SBAR(); SEAM_K0();
    if (hi == 0) li_l[r32] = l_reg; asm volatile("s_waitcnt lgkmcnt(0)" ::: "memory");
    float rli[16];
#pragma unroll
    for (int r = 0; r < 16; ++r) rli[r] = __builtin_amdgcn_rcpf(li_l[crow(r, hi)]);
    const int OP_ = cur.opitch; TOut* Ow = cur.O + (size_t)(wid * QBLK) * OP_;
    if (wact) {
    if (hi == 0) cur.L[(size_t)(wid * QBLK + r32) * cur.lpitch] = m_reg * (1.4426950408889634f * SCALE) + __builtin_amdgcn_logf(l_reg);
#pragma unroll
    for (int r = 0; r < 16; ++r) { const int orow = crow(r, hi);
#pragma unroll
        for (int d0 = 0; d0 < 4; ++d0) { const float v = o[d0][r] * rli[r];
            if constexpr (same_t<TOut, float>::v) { Ow[(size_t)orow * OP_ + d0 * 32 + r32] = v; }
            else { const float vn = __builtin_bit_cast(float, __builtin_amdgcn_mov_dpp(__builtin_bit_cast(int, v), 0xB1, 0xF, 0xF, true));
                   if ((r32 & 1) == 0) *(unsigned*)(Ow + (size_t)orow * OP_ + d0 * 32 + r32) = cvtpk(v, vn); } } }
    }
    if constexpr (F32) {
#pragma unroll
        for (int d0 = 0; d0 < 8; ++d0) S.qr[d0] = pack8(S.tq[2 * d0], S.tq[2 * d0 + 1]); }
    __syncthreads();
#undef RESC
#undef KBASE
#undef ACT
#undef MASKT
#undef SEAM_K0
#undef HALF_STEP
}
#undef ROW
#undef VMW
#undef VMWN
#undef SLOAD_H
#undef SWRITE_HK
#undef SWRITE_HV
#undef SWRITE_H
#undef SLOAD_F
#undef SWRITE_KF
#undef SWRITE_VF

constexpr int DMA_KR = 0, DMA_VR = 3 * SHM_K, DMA_SCR = DMA_VR + 3 * SHM_V, DMA_LDS_BYTES = DMA_SCR + NW * 64 * 4;
template <class TIn, class TOut>
__device__ __forceinline__ void block_dma(const BlockRef<TIn, TOut>& cur, int skv, int W, char* lds, int wave_s) {
    const int tid = tid_from(wave_s), wid = wave_s, lane = tid & 63, r32 = lane & 31, hi = lane >> 5;
    const int j_lo = swa_jlo(cur.P0, W);
    int j_hi = (cur.P0 + QB - 1) / KVBLK + 1; if (j_hi > skv / KVBLK) j_hi = skv / KVBLK;
    const int NT = j_hi - j_lo, PITCH_ = cur.pitch;
    const bool wact = (wid * QBLK < cur.nq);
    const int qlo = cur.P0 + wid * QBLK, qm = qlo + r32 - 4 * hi;
    float* wsf = (float*)(lds + DMA_SCR) + wid * 64; float* li_l = wsf; float* al_l = wsf + 32;
    int kOff[2], vOff[2];
#pragma unroll
    for (int j = 0; j < 2; ++j) kOff[j] = (4 * (2 * wid + j) + (lane >> 4)) * PITCH_ + (((lane & 15) ^ ((lane >> 4) + 4 * j)) * 8);
    { const int kk = wid * 8 + ((lane & 31) >> 2), k = (kk & ~0xC) | ((kk & 4) << 1) | ((kk & 8) >> 1);
#pragma unroll
      for (int j = 0; j < 2; ++j) vOff[j] = k * PITCH_ + (((2 * j + (lane >> 5)) & 3) * 32 + (lane & 3) * 8); }
    typedef __attribute__((address_space(3))) unsigned lds_u32;
    const unsigned ldsb = (unsigned)(size_t)(__attribute__((address_space(3))) char*)lds;
#define DMA_TILE(t, slot) do { const TIn* kt_ = cur.K + (size_t)(j_lo + (t)) * KVBLK * PITCH_; const TIn* vt_ = cur.V + (size_t)(j_lo + (t)) * KVBLK * PITCH_; \
        _Pragma("unroll") for (int j = 0; j < 2; ++j) { \
            __builtin_amdgcn_global_load_lds((const unsigned*)(kt_ + kOff[j]), (lds_u32*)(size_t)(ldsb + DMA_KR + (slot) * SHM_K + (2 * wid + j) * 1024), 16, 0, 0); \
            __builtin_amdgcn_global_load_lds((const unsigned*)(vt_ + vOff[j]), (lds_u32*)(size_t)(ldsb + DMA_VR + (slot) * SHM_V + (2 * wid + j) * 1024), 16, 0, 0); } } while (0)
    bf16x8 qr[8];
    { const int qrow_ = (wid * QBLK + r32 < cur.nq) ? wid * QBLK + r32 : cur.nq - 1;
#pragma unroll
      for (int d0 = 0; d0 < 8; ++d0) qr[d0] = load8<TIn>(cur.Q + (size_t)qrow_ * PITCH_ + d0 * 16 + hi * 8); }
    DMA_TILE(0, 0);
    if (NT > 1) DMA_TILE(1, 1);
    float m_reg = -1e30f, l_reg = 0; f32x16 o[4] = {};
    const int vbase = (int)ldsb + DMA_VR + v_rd_base(lane);
    int slot = 0, slot2 = 2;
#pragma unroll 1
    for (int t = 0; t < NT; ++t) {
        if (t + 1 < NT) asm volatile("s_waitcnt vmcnt(4)" ::: "memory"); else asm volatile("s_waitcnt vmcnt(0)" ::: "memory");
        asm volatile("s_waitcnt lgkmcnt(0)" ::: "memory"); __builtin_amdgcn_s_barrier(); asm volatile("" ::: "memory");
        if (t + 2 < NT) DMA_TILE(t + 2, slot2);
        const int kb_ = (j_lo + t) * KVBLK;
        const bool act = wact && kb_ <= qlo + QBLK - 1 && kb_ + KVBLK - 1 >= qlo - W + 1;
        if (act) {
            f32x16 p0, p1; float mn, al; bf16x8 pa0, pa1, pa2, pa3;
            SBAR(); qkt<0, false>(p0, p1, lds + DMA_KR + slot * SHM_K, r32, hi, qr, true);
            if (kb_ + KVBLK - 1 > qlo || kb_ <= qlo + QBLK - 1 - W) mask_tile(p0, p1, qm - kb_, (unsigned)W);
            partialSM(p0, p1, m_reg, mn, al);
            finishSM(p0, p1, al, l_reg, pa0, pa1, pa2, pa3); SBAR();
            if (__any(al < 1.f)) { if (hi == 0) al_l[r32] = al; asm volatile("s_waitcnt lgkmcnt(0)" ::: "memory");
                for (int d_ = 0; d_ < 4; ++d_) for (int r = 0; r < 16; ++r) o[d_][r] *= al_l[crow(r, hi)]; }
            pv_tile<0, false>(o, vbase + slot * SHM_V, pa0, pa1, pa2, pa3, true);
        }
        slot = slot == 2 ? 0 : slot + 1; slot2 = slot2 == 2 ? 0 : slot2 + 1;
    }
#undef DMA_TILE
    if (wact) {
        if (hi == 0) li_l[r32] = l_reg; asm volatile("s_waitcnt lgkmcnt(0)" ::: "memory");
        float rli[16];
#pragma unroll
        for (int r = 0; r < 16; ++r) rli[r] = __builtin_amdgcn_rcpf(li_l[crow(r, hi)]);
        const int OP_ = cur.opitch; TOut* Ow = cur.O + (size_t)(wid * QBLK) * OP_;
        if (hi == 0) cur.L[(size_t)(wid * QBLK + r32) * cur.lpitch] = m_reg * (1.4426950408889634f * SCALE) + __builtin_amdgcn_logf(l_reg);
#pragma unroll
        for (int r = 0; r < 16; ++r) { const int orow = crow(r, hi);
#pragma unroll
            for (int d0 = 0; d0 < 4; ++d0) { const float v = o[d0][r] * rli[r];
                const float vn = __builtin_bit_cast(float, __builtin_amdgcn_mov_dpp(__builtin_bit_cast(int, v), 0xB1, 0xF, 0xF, true));
                if ((r32 & 1) == 0) *(unsigned*)(Ow + (size_t)orow * OP_ + d0 * 32 + r32) = cvtpk(v, vn); } }
    }
    asm volatile("s_waitcnt lgkmcnt(0)" ::: "memory"); __builtin_amdgcn_s_barrier(); asm volatile("" ::: "memory");
}
typedef BlockRef<bf16_t, bf16_t> Ref;
}
#undef KSWZ

__device__ __forceinline__ swa::Ref attn_ref(unsigned char* ws, int L, int& skv) {
    int gi, b, h, c, qb;
    if (L < 256) { gi = 0; b = L >> 5; h = (L >> 3) & 3; qb = L & 7; c = 0; }
    else if (L < 512) { L -= 256; gi = 1; b = L >> 5; h = (L >> 3) & 3; c = (L >> 1) & 3; qb = L & 1; }
    else { L -= 512; gi = 2; const int v = L & 255, idx = (v & 31) * 2 + (L >> 8); b = v >> 5; h = idx >> 4; c = idx & 15; qb = 0; }
    const int d = gi == 0 ? 1 : (gi == 1 ? 4 : 16);
    const int n = SEQ / d;
    const size_t hb = ((size_t)(gi * BATCH + b) * HPG + h) * SEQ * HD + (size_t)c * n * HD, kstep = (size_t)3 * BATCH * HPG * SEQ * HD;
    const bf16_t* qkv = (const bf16_t*)(ws + OFF_QKV);
    const size_t tok0 = (size_t)b * SEQ + c + (size_t)qb * 256 * d;
    swa::Ref r;
    r.Q = qkv + hb + (size_t)qb * 256 * HD; r.K = qkv + kstep + hb; r.V = qkv + 2 * kstep + hb;
    r.O = (bf16_t*)(ws + OFF_AO) + ((size_t)gi * MTOK + tok0) * ATT_W + h * HD; r.opitch = d * ATT_W;
    r.L = (float*)(ws + OFF_ALSE) + ((size_t)gi * MTOK + tok0) * 4 + h; r.lpitch = d * 4;
    r.P0 = qb * 256; r.pitch = HD; r.nq = gi == 2 ? 128 : 256;
    skv = SEQ / d;
    return r;
}
namespace wsa2 {
using swa::f32x16; using swa::s16x4; using swa::crow; using swa::cvtpk; using swa::v_rd_base; using swa::SCALE; using swa::THR;
constexpr int BLK_K = 8192, SLOT = 16384, NSLOT = 9, SCR = NSLOT * SLOT, LDS_NEED = SCR + NWAVES * 256;
static_assert(LDS_NEED <= MISC_OFF, "wsa2 LDS");
#define W2_KSWZ(row, colB) ((row) * 256 + ((colB) ^ (((row) & 7) << 4)))
#define W2_SBAR() __builtin_amdgcn_sched_barrier(0)
__device__ __forceinline__ void unit(const swa::Ref& u, LAS unsigned char* lds, int wave_s) {
    const int tid = tid_from(wave_s), wid = wave_s, lane = tid & 63, r32 = lane & 31, hi = lane >> 5;
    const int I0 = u.P0, i0 = I0 + 32 * wid;
    const bool wact = 32 * wid < u.nq;
    const int B0 = (I0 >= 128 ? I0 - 128 : 0) >> 5;
    const int kfirst = i0 >= 128 ? i0 - 128 : 0, nblk = wact ? ((i0 - kfirst) >> 5) + 1 : 0, fw = (kfirst >> 5) - B0;
    const int ilast = I0 + u.nq - 32, klast = ilast >= 128 ? ilast - 128 : 0;
    const int nbtot = (ilast >> 5) - B0 + 1, niter = ((ilast - klast) >> 5) + 1;
    const int krow = 4 * wid + (lane >> 4), kchunk = (lane & 15) ^ (4 * (wid & 1) + (lane >> 4));
    const int kk = (wid >> 1) * 8 + ((lane & 31) >> 2), vkey = (kk & ~0xC) | ((kk & 4) << 1) | ((kk & 8) >> 1), vcol = ((2 * (wid & 1) + (lane >> 5)) & 3) * 32 + (lane & 3) * 8;
    const bf16_t* ksrc = u.K + (size_t)(B0 * 32 + krow) * HD + kchunk * 8;
    const bf16_t* vsrc = u.V + (size_t)(B0 * 32 + vkey) * HD + vcol;
    typedef __attribute__((address_space(3))) unsigned lds_u32;
    const unsigned ldsb = (unsigned)(size_t)lds;
#define W2_DMA(b, slot) do { __builtin_amdgcn_global_load_lds((const unsigned*)(ksrc + (size_t)(b) * 32 * HD), (lds_u32*)(size_t)(ldsb + (slot) * SLOT + wid * 1024), 16, 0, 0); \
        __builtin_amdgcn_global_load_lds((const unsigned*)(vsrc + (size_t)(b) * 32 * HD), (lds_u32*)(size_t)(ldsb + (slot) * SLOT + BLK_K + wid * 1024), 16, 0, 0); } while (0)
    for (int b = 0; b < 8 && b < nbtot; ++b) W2_DMA(b, b);
    bf16x8 qr[8];
    { const int qrow = wact ? 32 * wid + r32 : u.nq - 1;
#pragma unroll
      for (int d0 = 0; d0 < 8; ++d0) qr[d0] = *(const bf16x8*)(u.Q + (size_t)qrow * HD + d0 * 16 + hi * 8); }
    LAS float* li_l = (LAS float*)(lds + SCR + wid * 256); LAS float* al_l = li_l + 32;
    float m_reg = -1e30f, l_reg = 0.f; f32x16 o[4] = {};
    constexpr float C2 = 1.4426950408889634f * SCALE;
    int koff[4];
#pragma unroll
    for (int dd = 0; dd < 4; ++dd) koff[dd] = W2_KSWZ(r32, (dd * 16 + hi * 8) * 2);
    const unsigned vrb = ldsb + BLK_K + (unsigned)v_rd_base(lane);
#pragma unroll 1
    for (int i = 0; i < niter; ++i) {
        asm volatile("s_waitcnt vmcnt(0)" ::: "memory");
        asm volatile("s_waitcnt lgkmcnt(0)" ::: "memory"); __builtin_amdgcn_s_barrier(); asm volatile("" ::: "memory");
        if (i + 8 < nbtot) { const int s8 = (i + 8) % NSLOT; W2_DMA(i + 8, s8); }
        if (i < nblk) {
            const int rel = fw + i, slot = rel % NSLOT, k0 = (B0 + rel) * 32;
            const LAS unsigned char* kb = lds + slot * SLOT;
            f32x16 p = {};
#pragma unroll
            for (int d0 = 0; d0 < 8; ++d0) { const bf16x8 kf = *(const LAS bf16x8*)(kb + koff[d0 & 3] + (d0 >> 2) * 128);
                p = __builtin_amdgcn_mfma_f32_32x32x16_bf16(kf, qr[d0], p, 0, 0, 0); }
            if (k0 == i0 || k0 + 128 == i0) {
                const int dq = i0 + r32 - k0 - 4 * hi; const float NEG = -__builtin_inff();
#pragma unroll
                for (int r = 0; r < 16; ++r) { const int c = (r & 3) + 8 * (r >> 2); if ((unsigned)(dq - c) >= 129u) p[r] = NEG; }
            }
            float pmax = p[0];
#pragma unroll
            for (int r = 1; r < 16; ++r) pmax = fmaxf(pmax, p[r]);
            { auto rr = __builtin_amdgcn_permlane32_swap(__float_as_uint(pmax), __float_as_uint(pmax), false, false); pmax = fmaxf(__uint_as_float(rr[0]), __uint_as_float(rr[1])); }
            float mn, alpha;
            if (__builtin_expect(__all((pmax - m_reg) * SCALE <= THR), 1)) { mn = m_reg; alpha = 1.f; }
            else { mn = fmaxf(m_reg, pmax); alpha = __builtin_amdgcn_exp2f((m_reg - mn) * C2); m_reg = mn; }
            const float mnL = -mn * C2;
#pragma unroll
            for (int r = 0; r < 16; ++r) p[r] = __builtin_amdgcn_exp2f(fmaf(p[r], C2, mnL));
            float ps = 0.f;
#pragma unroll
            for (int r = 0; r < 16; ++r) ps += p[r];
            { auto rr = __builtin_amdgcn_permlane32_swap(__float_as_uint(ps), __float_as_uint(ps), false, false); ps = __uint_as_float(rr[0]) + __uint_as_float(rr[1]); }
            l_reg = l_reg * alpha + ps;
            bf16x8 pa0, pa1;
#define W2_PK4(B_, OUT) do { unsigned a0 = cvtpk(p[B_+0], p[B_+1]), a1 = cvtpk(p[B_+2], p[B_+3]), b0 = cvtpk(p[B_+4], p[B_+5]), b1 = cvtpk(p[B_+6], p[B_+7]); \
            auto r0 = __builtin_amdgcn_permlane32_swap(a0, b0, false, false); auto r1 = __builtin_amdgcn_permlane32_swap(a1, b1, false, false); \
            u32x4 w = {r0[0], r1[0], r0[1], r1[1]}; OUT = *reinterpret_cast<bf16x8*>(&w); } while (0)
            W2_PK4(0, pa0); W2_PK4(8, pa1);
#undef W2_PK4
            if (__any(alpha < 1.f)) {
                if (hi == 0) al_l[r32] = alpha;
                asm volatile("s_waitcnt lgkmcnt(0)" ::: "memory");
#pragma unroll
                for (int d_ = 0; d_ < 4; ++d_)
#pragma unroll
                    for (int r = 0; r < 16; ++r) o[d_][r] *= al_l[crow(r, hi)];
            }
            const unsigned vb0 = vrb + (unsigned)(slot * SLOT);
#define W2_TR(dst, off) asm volatile("ds_read_b64_tr_b16 %0, %1 offset:%2" : "=&v"(dst) : "v"(vb0), "i"(off) : "memory")
#define W2_PV(d0) do { s16x4 l0, l1, h0, h1; W2_TR(l0, (d0) * 512); W2_TR(h0, (d0) * 512 + 2048); W2_TR(l1, (d0) * 512 + 4096); W2_TR(h1, (d0) * 512 + 6144); \
            asm volatile("s_waitcnt lgkmcnt(0)" ::: "memory"); W2_SBAR(); \
            o[d0] = __builtin_amdgcn_mfma_f32_32x32x16_bf16(pa0, (bf16x8){l0[0], l0[1], l0[2], l0[3], h0[0], h0[1], h0[2], h0[3]}, o[d0], 0, 0, 0); \
            o[d0] = __builtin_amdgcn_mfma_f32_32x32x16_bf16(pa1, (bf16x8){l1[0], l1[1], l1[2], l1[3], h1[0], h1[1], h1[2], h1[3]}, o[d0], 0, 0, 0); } while (0)
            W2_PV(0); W2_PV(1); W2_PV(2); W2_PV(3);
#undef W2_PV
#undef W2_TR
        }
    }
#undef W2_DMA
    if (wact) {
        if (hi == 0) li_l[r32] = l_reg;
        asm volatile("s_waitcnt lgkmcnt(0)" ::: "memory");
        float rli[16];
#pragma unroll
        for (int r = 0; r < 16; ++r) rli[r] = __builtin_amdgcn_rcpf(li_l[crow(r, hi)]);
        if (hi == 0) u.L[(size_t)(32 * wid + r32) * u.lpitch] = m_reg * C2 + __builtin_amdgcn_logf(l_reg);
        const int OP = u.opitch; bf16_t* Ow = u.O + (size_t)(32 * wid) * OP;
#pragma unroll
        for (int r = 0; r < 16; ++r) { const int orow = crow(r, hi);
#pragma unroll
            for (int d0 = 0; d0 < 4; ++d0) { const float v = o[d0][r] * rli[r];
                const float vn = __builtin_bit_cast(float, __builtin_amdgcn_mov_dpp(__builtin_bit_cast(int, v), 0xB1, 0xF, 0xF, true));
                if ((r32 & 1) == 0) *(unsigned*)(Ow + (size_t)orow * OP + d0 * 32 + r32) = cvtpk(v, vn); } }
    }
    asm volatile("s_waitcnt lgkmcnt(0)" ::: "memory"); __builtin_amdgcn_s_barrier(); asm volatile("" ::: "memory");
}
#undef W2_KSWZ
#undef W2_SBAR
}

constexpr int N_ATTN_BLOCKS = 1024;

namespace wsa3 {
using swa::f32x16; using swa::s16x4; using swa::crow; using swa::cvtpk; using swa::v_rd_base; using swa::SCALE; using swa::THR;
constexpr int BLK_K = 8192, SLOT = 16384, NSLOT = 9, SCR = NSLOT * SLOT, LDS_NEED = SCR + NWAVES * 256;
static_assert(LDS_NEED <= MISC_OFF, "wsa3 LDS");
#define W3_KSWZ(row, colB) ((row) * 256 + ((colB) ^ (((row) & 7) << 4)))
#define W3_SBAR() __builtin_amdgcn_sched_barrier(0)
__device__ __forceinline__ void wait_vm_ops(int n) {
    switch (n >> 1) {
    case 0: asm volatile("s_waitcnt vmcnt(0)" ::: "memory"); break;
    case 1: asm volatile("s_waitcnt vmcnt(2)" ::: "memory"); break;
    case 2: asm volatile("s_waitcnt vmcnt(4)" ::: "memory"); break;
    case 3: asm volatile("s_waitcnt vmcnt(6)" ::: "memory"); break;
    case 4: asm volatile("s_waitcnt vmcnt(8)" ::: "memory"); break;
    case 5: asm volatile("s_waitcnt vmcnt(10)" ::: "memory"); break;
    case 6: asm volatile("s_waitcnt vmcnt(12)" ::: "memory"); break;
    case 7: asm volatile("s_waitcnt vmcnt(14)" ::: "memory"); break;
    case 8: asm volatile("s_waitcnt vmcnt(16)" ::: "memory"); break;
    case 9: asm volatile("s_waitcnt vmcnt(18)" ::: "memory"); break;
    case 10: asm volatile("s_waitcnt vmcnt(20)" ::: "memory"); break;
    case 11: asm volatile("s_waitcnt vmcnt(22)" ::: "memory"); break;
    case 12: asm volatile("s_waitcnt vmcnt(24)" ::: "memory"); break;
    case 13: asm volatile("s_waitcnt vmcnt(26)" ::: "memory"); break;
    case 14: asm volatile("s_waitcnt vmcnt(28)" ::: "memory"); break;
    case 15: asm volatile("s_waitcnt vmcnt(30)" ::: "memory"); break;
    case 16: asm volatile("s_waitcnt vmcnt(32)" ::: "memory"); break;
    case 17: asm volatile("s_waitcnt vmcnt(34)" ::: "memory"); break;
    case 18: asm volatile("s_waitcnt vmcnt(36)" ::: "memory"); break;
    case 19: asm volatile("s_waitcnt vmcnt(38)" ::: "memory"); break;
    case 20: asm volatile("s_waitcnt vmcnt(40)" ::: "memory"); break;
    case 21: asm volatile("s_waitcnt vmcnt(42)" ::: "memory"); break;
    case 22: asm volatile("s_waitcnt vmcnt(44)" ::: "memory"); break;
    case 23: asm volatile("s_waitcnt vmcnt(46)" ::: "memory"); break;
    case 24: asm volatile("s_waitcnt vmcnt(48)" ::: "memory"); break;
    case 25: asm volatile("s_waitcnt vmcnt(50)" ::: "memory"); break;
    case 26: asm volatile("s_waitcnt vmcnt(52)" ::: "memory"); break;
    case 27: asm volatile("s_waitcnt vmcnt(54)" ::: "memory"); break;
    case 28: asm volatile("s_waitcnt vmcnt(56)" ::: "memory"); break;
    case 29: asm volatile("s_waitcnt vmcnt(58)" ::: "memory"); break;
    case 30: asm volatile("s_waitcnt vmcnt(60)" ::: "memory"); break;
    default: asm volatile("s_waitcnt vmcnt(62)" ::: "memory"); break;
    }
}
__device__ __forceinline__ void phase(const Frame& F, unsigned char* ws, int layer, unsigned long long& ts_sum, unsigned long long& ts_t0) {
    const int wid = F.wave, tid = tid_from(wid), lane = tid & 63, r32 = lane & 31, hi = lane >> 5;
    LAS unsigned char* lds = F.lds;
    const int nU = F.vcu < N_ATTN_BLOCKS ? (N_ATTN_BLOCKS - 1 - F.vcu) / F.G + 1 : 0;
    if (nU == 0) return;
    const int krow = 4 * wid + (lane >> 4), kchunk = (lane & 15) ^ (4 * (wid & 1) + (lane >> 4));
    const int kk = (wid >> 1) * 8 + ((lane & 31) >> 2), vkey = (kk & ~0xC) | ((kk & 4) << 1) | ((kk & 8) >> 1), vcol = ((2 * (wid & 1) + (lane >> 5)) & 3) * 32 + (lane & 3) * 8;
    const unsigned klane = (unsigned)(krow * HD + kchunk * 8) * 2u, vlane = (unsigned)(vkey * HD + vcol) * 2u;
    typedef __attribute__((address_space(3))) unsigned lds_u32;
    const unsigned ldsb = (unsigned)(size_t)lds;
    LAS float* li_l = (LAS float*)(lds + SCR + wid * 256); LAS float* al_l = li_l + 32;
    constexpr float C2 = 1.4426950408889634f * SCALE;
    int koff[4];
#pragma unroll
    for (int dd = 0; dd < 4; ++dd) koff[dd] = W3_KSWZ(r32, (dd * 16 + hi * 8) * 2);
    const unsigned vrb = ldsb + BLK_K + (unsigned)v_rd_base(lane);
    int kI = -1, tI = 5, jI = 0, nbI = 0, issued = 0, consumed = 0, islot = 0, qmark = -1, smark = -1, nst = 0;
    const char* kbI = nullptr; const char* vbI = nullptr;
    bf16x8 qn[8], qr[8];
#define W3_SETUP_I() do { int skv_; const swa::Ref ri = attn_ref(ws, F.vcu + kI * F.G, skv_); \
        const int I0_ = ri.P0, B0_ = (I0_ >= 128 ? I0_ - 128 : 0) >> 5; nbI = ((I0_ + ri.nq - 32) >> 5) - B0_ + 1; tI = 0; jI = 0; \
        kbI = (const char*)(ri.K + (size_t)B0_ * 32 * HD); vbI = (const char*)(ri.V + (size_t)B0_ * 32 * HD); \
        const int qrow_ = 32 * wid < ri.nq ? 32 * wid + r32 : ri.nq - 1; const bf16_t* qp_ = ri.Q + (size_t)qrow_ * HD + hi * 8; \
        _Pragma("unroll") for (int d0 = 0; d0 < 8; ++d0) asm volatile("global_load_dwordx4 %0, %1, off" : "=v"(qn[d0]) : "v"(qp_ + d0 * 16) : "memory"); \
        qmark = issued; } while (0)
#define W3_ISSUE(kC_) do { for (;;) { \
        if (tI >= 5) { if (kI + 1 >= nU || kI >= (kC_) + 1) break; ++kI; W3_SETUP_I(); } \
        if (issued - consumed >= NSLOT) break; \
        __builtin_amdgcn_global_load_lds((const unsigned*)(kbI + (size_t)jI * (32 * HD * 2) + klane), (lds_u32*)(size_t)(ldsb + islot * SLOT + wid * 1024), 16, 0, 2); \
        __builtin_amdgcn_global_load_lds((const unsigned*)(vbI + (size_t)jI * (32 * HD * 2) + vlane), (lds_u32*)(size_t)(ldsb + islot * SLOT + BLK_K + wid * 1024), 16, 0, 2); \
        ++issued; islot = islot == NSLOT - 1 ? 0 : islot + 1; \
        jI += 5; while (tI < 5 && jI >= nbI) { ++tI; jI = tI; } } } while (0)
    asm volatile("s_waitcnt lgkmcnt(0)" ::: "memory"); __builtin_amdgcn_s_barrier(); asm volatile("" ::: "memory");
    W3_ISSUE(-1);
    int spos = 0;
#pragma unroll 1
    for (int kC = 0; kC < nU; ++kC) {
        if (W_TOUCH2 == 2 && kC == nU - 1 && F.vcu < 256 && wid < 3) {
            const int ln_ = tid_from(wid) & 63, cu_ = F.vcu; const char* tp_;
            if (wid == 0) tp_ = (const char*)(ws + OFF_WOUT) + (size_t)layer * D_MODEL * D_MODEL * 2 + ((size_t)cu_ * 64 + ln_) * 128;
            else if (wid == 1) tp_ = (ln_ < 32 ? (const char*)(ws + OFF_WBS) + (size_t)layer * D_MODEL * SSM_W * 2 : (const char*)(ws + OFF_WBA) + (size_t)layer * D_MODEL * ATT_W * 2) + ((size_t)cu_ * 32 + (ln_ & 31)) * 128;
            else tp_ = (const char*)(ws + OFF_WGLU) + (size_t)layer * SSM_W * SSM_W * 2 + ((size_t)cu_ * 16 + (ln_ & 15)) * 128;
            __builtin_amdgcn_global_load_lds((const unsigned*)tp_, (lds_u32*)(size_t)(ldsb + 155648 + wid * 256), 4, 0, 0);
        }
        int skv; const swa::Ref u = attn_ref(ws, F.vcu + kC * F.G, skv);
        const int I0 = u.P0, i0 = I0 + 32 * wid;
        const bool wact = 32 * wid < u.nq;
        const int B0 = (I0 >= 128 ? I0 - 128 : 0) >> 5;
        const int kfirst = i0 >= 128 ? i0 - 128 : 0, nblk = wact ? ((i0 - kfirst) >> 5) + 1 : 0, fw = (kfirst >> 5) - B0;
        const int nbtot = ((I0 + u.nq - 32) >> 5) - B0 + 1;
        float m_reg = -1e30f, l_reg = 0.f; f32x16 o[4] = {};
#pragma unroll 1
        for (int t = 0; t < 5; ++t) {
            const int cnt = t < nbtot ? (nbtot - t + 4) / 5 : 0;
            if (cnt == 0) continue;
            TS_BEGIN(31);
            { const int endp = spos + cnt; wait_vm_ops(2 * (issued - endp) + (qmark >= endp ? 8 : 0) + (smark >= endp ? nst : 0)); }
            asm volatile("s_waitcnt lgkmcnt(0)" ::: "memory"); __builtin_amdgcn_s_barrier(); asm volatile("" ::: "memory");
            if (t == 0) {
                asm volatile("" : "+v"(qn[0]), "+v"(qn[1]), "+v"(qn[2]), "+v"(qn[3]), "+v"(qn[4]), "+v"(qn[5]), "+v"(qn[6]), "+v"(qn[7]));
#pragma unroll
                for (int d0 = 0; d0 < 8; ++d0) qr[d0] = qn[d0];
            }
            TS_END(31); TS_BEGIN(34);
            consumed = spos; W3_ISSUE(kC);
            TS_END(34); TS_BEGIN(32);
            const int rj = (t - fw) % 5, j = fw + (rj < 0 ? rj + 5 : rj);
            if (j < fw + nblk) {
                const int slot = (spos + (j - t) / 5) % NSLOT, k0 = (B0 + j) * 32;
                const LAS unsigned char* kb = lds + slot * SLOT;
                f32x16 p = {};
#pragma unroll
                for (int d0 = 0; d0 < 8; ++d0) { const bf16x8 kf = *(const LAS bf16x8*)(kb + koff[d0 & 3] + (d0 >> 2) * 128);
                    p = __builtin_amdgcn_mfma_f32_32x32x16_bf16(kf, qr[d0], p, 0, 0, 0); }
                if (k0 == i0 || k0 + 128 == i0) {
                    const int dq = i0 + r32 - k0 - 4 * hi; const float NEG = -__builtin_inff();
#pragma unroll
                    for (int r = 0; r < 16; ++r) { const int c = (r & 3) + 8 * (r >> 2); if ((unsigned)(dq - c) >= 129u) p[r] = NEG; }
                }
                float pmax = p[0];
#pragma unroll
                for (int r = 1; r < 16; ++r) pmax = fmaxf(pmax, p[r]);
                { auto rr = __builtin_amdgcn_permlane32_swap(__float_as_uint(pmax), __float_as_uint(pmax), false, false); pmax = fmaxf(__uint_as_float(rr[0]), __uint_as_float(rr[1])); }
                float mn, alpha;
                if (__builtin_expect(__all((pmax - m_reg) * SCALE <= THR), 1)) { mn = m_reg; alpha = 1.f; }
                else { mn = fmaxf(m_reg, pmax); alpha = __builtin_amdgcn_exp2f((m_reg - mn) * C2); m_reg = mn; }
                const float mnL = -mn * C2;
#pragma unroll
                for (int r = 0; r < 16; ++r) p[r] = __builtin_amdgcn_exp2f(fmaf(p[r], C2, mnL));
                float ps = 0.f;
#pragma unroll
                for (int r = 0; r < 16; ++r) ps += p[r];
                { auto rr = __builtin_amdgcn_permlane32_swap(__float_as_uint(ps), __float_as_uint(ps), false, false); ps = __uint_as_float(rr[0]) + __uint_as_float(rr[1]); }
                l_reg = l_reg * alpha + ps;
                bf16x8 pa0, pa1;
#define W3_PK4(B_, OUT) do { unsigned a0 = cvtpk(p[B_+0], p[B_+1]), a1 = cvtpk(p[B_+2], p[B_+3]), b0 = cvtpk(p[B_+4], p[B_+5]), b1 = cvtpk(p[B_+6], p[B_+7]); \
                auto r0 = __builtin_amdgcn_permlane32_swap(a0, b0, false, false); auto r1 = __builtin_amdgcn_permlane32_swap(a1, b1, false, false); \
                u32x4 w = {r0[0], r1[0], r0[1], r1[1]}; OUT = *reinterpret_cast<bf16x8*>(&w); } while (0)
                W3_PK4(0, pa0); W3_PK4(8, pa1);
#undef W3_PK4
                if (__any(alpha < 1.f)) {
                    if (hi == 0) al_l[r32] = alpha;
                    asm volatile("s_waitcnt lgkmcnt(0)" ::: "memory");
#pragma unroll
                    for (int d_ = 0; d_ < 4; ++d_)
#pragma unroll
                        for (int r = 0; r < 16; ++r) o[d_][r] *= al_l[crow(r, hi)];
                }
                const unsigned vb0 = vrb + (unsigned)(slot * SLOT);
#define W3_TR(dst, off) asm volatile("ds_read_b64_tr_b16 %0, %1 offset:%2" : "=&v"(dst) : "v"(vb0), "i"(off) : "memory")
#define W3_PV(d0) do { s16x4 l0, l1, h0, h1; W3_TR(l0, (d0) * 512); W3_TR(h0, (d0) * 512 + 2048); W3_TR(l1, (d0) * 512 + 4096); W3_TR(h1, (d0) * 512 + 6144); \
                asm volatile("s_waitcnt lgkmcnt(0)" ::: "memory"); W3_SBAR(); \
                o[d0] = __builtin_amdgcn_mfma_f32_32x32x16_bf16(pa0, (bf16x8){l0[0], l0[1], l0[2], l0[3], h0[0], h0[1], h0[2], h0[3]}, o[d0], 0, 0, 0); \
                o[d0] = __builtin_amdgcn_mfma_f32_32x32x16_bf16(pa1, (bf16x8){l1[0], l1[1], l1[2], l1[3], h1[0], h1[1], h1[2], h1[3]}, o[d0], 0, 0, 0); } while (0)
                W3_PV(0); W3_PV(1); W3_PV(2); W3_PV(3);
#undef W3_PV
#undef W3_TR
            }
            spos += cnt;
            TS_END(32);
        }
        TS_BEGIN(33);
        if (wact) {
            if (hi == 0) li_l[r32] = l_reg;
            asm volatile("s_waitcnt lgkmcnt(0)" ::: "memory");
            float rli[16];
#pragma unroll
            for (int r = 0; r < 16; ++r) rli[r] = __builtin_amdgcn_rcpf(li_l[crow(r, hi)]);
            { const float lse = m_reg * C2 + __builtin_amdgcn_logf(l_reg); const unsigned lo_ = (unsigned)((32 * wid + r32) * u.lpitch) * 4u;
              asm volatile("global_store_dword %0, %1, %2" :: "v"(lo_), "v"(lse), "s"(u.L) : "memory"); }
            const int OP = u.opitch; const bf16_t* Ow = u.O + (size_t)(32 * wid) * OP;
            const unsigned lane_off = (unsigned)(4 * hi * OP + 4 * r32) * 2u;
#pragma unroll
            for (int r = 0; r < 16; ++r) { const unsigned vo = lane_off + (unsigned)(((r & 3) + 8 * (r >> 2)) * OP) * 2u;
                typedef unsigned u32x2_ __attribute__((ext_vector_type(2)));
                u32x2_ w; w.x = cvtpk(o[0][r] * rli[r], o[1][r] * rli[r]); w.y = cvtpk(o[2][r] * rli[r], o[3][r] * rli[r]);
                asm volatile("global_store_dwordx2 %0, %1, %2" :: "v"(vo), "v"(w), "s"(Ow) : "memory"); }
            smark = issued; nst = 17;
        } else { smark = -1; nst = 0; }
        TS_END(33);
    }
#undef W3_ISSUE
#undef W3_SETUP_I
    asm volatile("s_waitcnt lgkmcnt(0)" ::: "memory"); __builtin_amdgcn_s_barrier(); asm volatile("" ::: "memory");
}
#undef W3_KSWZ
#undef W3_SBAR
}


__device__ __forceinline__ void attn_phase(const Frame& F, unsigned char* ws, int layer, unsigned long long& ts_sum, unsigned long long& ts_t0) {
#if ATTN_DMA == 3
    wsa3::phase(F, ws, layer, ts_sum, ts_t0);
    return;
#endif
#if ATTN_DMA == 2
#if EXP_HALF == 2
    if (F.vcu & 1) return;
    for (int L = F.vcu; L < N_ATTN_BLOCKS; L += F.G) { for (int e = 0; e < 2; ++e) { int skv; const swa::Ref cur = attn_ref(ws, L + e, skv); wsa2::unit(cur, F.lds, F.wave); } }
    return;
#endif
    for (int L = F.vcu; L < N_ATTN_BLOCKS; L += F.G) { int skv; const swa::Ref cur = attn_ref(ws, L, skv); wsa2::unit(cur, F.lds, F.wave); }
    return;
#elif ATTN_DMA == 1
    for (int L = F.vcu; L < N_ATTN_BLOCKS; L += F.G) { int skv; const swa::Ref cur = attn_ref(ws, L, skv); swa::block_dma<bf16_t, bf16_t>(cur, skv, 129, (char*)F.lds, F.wave); }
    return;
#endif
    int L = F.vcu; if (L >= N_ATTN_BLOCKS) return;
    char* lds = (char*)F.lds;
    int skv, skvn; swa::Ref cur = attn_ref(ws, L, skv);
    swa::Seam<bf16_t> S;
    swa::causal_swa_prime<bf16_t, bf16_t>(cur, 129, lds, S, F.wave);
    for (;;) {
        const int Ln = L + F.G; const bool last = Ln >= N_ATTN_BLOCKS;
        swa::Ref nxt = cur; skvn = skv; if (!last) nxt = attn_ref(ws, Ln, skvn);
        swa::causal_swa_block<bf16_t, bf16_t>(cur, nxt, skv, 129, lds, S, F.wave);
        if (last) break;
        cur = nxt; skv = skvn; L = Ln;
    }
}

namespace wsa {
using swa::f32x16; using swa::s16x4; using swa::crow; using swa::cvtpk; using swa::v_st; using swa::v_rd_base; using swa::SCALE; using swa::THR;
constexpr int VBUF = 8192;
constexpr int WAVE_LDS = 2 * VBUF + 256;
struct Item { const bf16_t* Q; const bf16_t* K; const bf16_t* V; bf16_t* O; float* L; int i0, pitch, opitch, lpitch; };
constexpr int N_ITEMS = 3 * 2048;
__device__ __forceinline__ Item decode(unsigned char* ws, int it) {
    const int gi = it >> 11, r = it & 2047, b = r >> 8, h = (r >> 6) & 3;
    int c, qw, d;
    if (gi == 0) { c = 0; qw = r & 63; d = 1; } else if (gi == 1) { c = (r >> 4) & 3; qw = r & 15; d = 4; } else { c = (r >> 2) & 15; qw = r & 3; d = 16; }
    Item x; x.i0 = 32 * qw; x.pitch = HD; x.opitch = d * ATT_W; x.lpitch = d * 4;
    const size_t hb = ((size_t)(gi * BATCH + b) * HPG + h) * SEQ * HD + (size_t)c * (SEQ / d) * HD, kstep = (size_t)3 * BATCH * HPG * SEQ * HD;
    const bf16_t* qkv = (const bf16_t*)(ws + OFF_QKV);
    const size_t tok0 = (size_t)b * SEQ + c + (size_t)x.i0 * d;
    x.Q = qkv + hb + (size_t)x.i0 * HD; x.K = qkv + kstep + hb; x.V = qkv + 2 * kstep + hb;
    x.O = (bf16_t*)(ws + OFF_AO) + ((size_t)gi * MTOK + tok0) * ATT_W + h * HD;
    x.L = (float*)(ws + OFF_ALSE) + ((size_t)gi * MTOK + tok0) * 4 + h;
    return x;
}
#define WSA_SBAR() __builtin_amdgcn_sched_barrier(0)
__device__ __forceinline__ void wave_item(const Item& it, LAS unsigned char* wl, int lane) {
    const int r32 = lane & 31, hi = lane >> 5, pitch = it.pitch;
    LAS float* li_l = (LAS float*)(wl + 2 * VBUF); LAS float* al_l = li_l + 32;
    const int kfirst = it.i0 >= 128 ? it.i0 - 128 : 0, nblk = ((it.i0 - kfirst) >> 5) + 1;
    const bf16_t* qp = it.Q + (size_t)r32 * pitch + hi * 8;
    const bf16_t* kp = it.K + (size_t)(kfirst + r32) * pitch + hi * 8;
    const int vkey = lane >> 4, vch = (lane & 15) * 8;
    const bf16_t* vp = it.V + (size_t)(kfirst + vkey) * pitch + vch;
    int vst_off[8];
#pragma unroll
    for (int i = 0; i < 8; ++i) vst_off[i] = v_st(vkey + 4 * i, vch);
    bf16x8 qr[8], kf[8], vs[8];
#pragma unroll
    for (int d0 = 0; d0 < 8; ++d0) qr[d0] = *(const bf16x8*)(qp + d0 * 16);
#pragma unroll
    for (int d0 = 0; d0 < 8; ++d0) kf[d0] = *(const bf16x8*)(kp + d0 * 16);
#pragma unroll
    for (int i = 0; i < 8; ++i) vs[i] = *(const bf16x8*)(vp + (size_t)(4 * i) * pitch);
#pragma unroll
    for (int i = 0; i < 8; ++i) *(LAS bf16x8*)(wl + vst_off[i]) = vs[i];
    float m_reg = -1e30f, l_reg = 0.f; f32x16 o[4] = {};
    const unsigned vbase = (unsigned)(size_t)wl + (unsigned)v_rd_base(lane);
    constexpr float C2 = 1.4426950408889634f * SCALE;
#pragma unroll 1
    for (int blk = 0; blk < nblk; ++blk) {
        const int k0 = kfirst + 32 * blk; const bool more = blk + 1 < nblk;
        if (more) {
#pragma unroll
            for (int i = 0; i < 8; ++i) vs[i] = *(const bf16x8*)(vp + (size_t)(32 * (blk + 1) + 4 * i) * pitch);
        }
        f32x16 p = {};
#pragma unroll
        for (int d0 = 0; d0 < 8; ++d0) p = __builtin_amdgcn_mfma_f32_32x32x16_bf16(kf[d0], qr[d0], p, 0, 0, 0);
        if (more) {
#pragma unroll
            for (int d0 = 0; d0 < 8; ++d0) kf[d0] = *(const bf16x8*)(kp + (size_t)(32 * (blk + 1)) * pitch + d0 * 16);
        }
        if (k0 == it.i0 || k0 + 128 == it.i0) {
            const int dq = it.i0 + r32 - k0 - 4 * hi; const float NEG = -__builtin_inff();
#pragma unroll
            for (int r = 0; r < 16; ++r) { const int c = (r & 3) + 8 * (r >> 2); if ((unsigned)(dq - c) >= 129u) p[r] = NEG; }
        }
        float pmax = p[0];
#pragma unroll
        for (int r = 1; r < 16; ++r) pmax = fmaxf(pmax, p[r]);
        { auto rr = __builtin_amdgcn_permlane32_swap(__float_as_uint(pmax), __float_as_uint(pmax), false, false); pmax = fmaxf(__uint_as_float(rr[0]), __uint_as_float(rr[1])); }
        float mn, alpha;
        if (__builtin_expect(__all((pmax - m_reg) * SCALE <= THR), 1)) { mn = m_reg; alpha = 1.f; }
        else { mn = fmaxf(m_reg, pmax); alpha = __builtin_amdgcn_exp2f((m_reg - mn) * C2); m_reg = mn; }
        const float mnL = -mn * C2;
#pragma unroll
        for (int r = 0; r < 16; ++r) p[r] = __builtin_amdgcn_exp2f(fmaf(p[r], C2, mnL));
        float ps = 0.f;
#pragma unroll
        for (int r = 0; r < 16; ++r) ps += p[r];
        { auto rr = __builtin_amdgcn_permlane32_swap(__float_as_uint(ps), __float_as_uint(ps), false, false); ps = __uint_as_float(rr[0]) + __uint_as_float(rr[1]); }
        l_reg = l_reg * alpha + ps;
        bf16x8 pa0, pa1;
#define WSA_PK4(B_, OUT) do { unsigned a0 = cvtpk(p[B_+0], p[B_+1]), a1 = cvtpk(p[B_+2], p[B_+3]), b0 = cvtpk(p[B_+4], p[B_+5]), b1 = cvtpk(p[B_+6], p[B_+7]); \
        auto r0 = __builtin_amdgcn_permlane32_swap(a0, b0, false, false); auto r1 = __builtin_amdgcn_permlane32_swap(a1, b1, false, false); \
        u32x4 w = {r0[0], r1[0], r0[1], r1[1]}; OUT = *reinterpret_cast<bf16x8*>(&w); } while (0)
        WSA_PK4(0, pa0); WSA_PK4(8, pa1);
#undef WSA_PK4
        if (__any(alpha < 1.f)) {
            if (hi == 0) al_l[r32] = alpha;
            asm volatile("s_waitcnt lgkmcnt(0)" ::: "memory");
#pragma unroll
            for (int d_ = 0; d_ < 4; ++d_)
#pragma unroll
                for (int r = 0; r < 16; ++r) o[d_][r] *= al_l[crow(r, hi)];
        }
        const unsigned vb0 = vbase + (unsigned)((blk & 1) * VBUF);
#define WSA_TR(dst, off) asm volatile("ds_read_b64_tr_b16 %0, %1 offset:%2" : "=&v"(dst) : "v"(vb0), "i"(off) : "memory")
#define WSA_PV(d0) do { s16x4 l0, l1, h0, h1; WSA_TR(l0, (d0) * 512); WSA_TR(h0, (d0) * 512 + 2048); WSA_TR(l1, (d0) * 512 + 4096); WSA_TR(h1, (d0) * 512 + 6144); \
        asm volatile("s_waitcnt lgkmcnt(0)" ::: "memory"); WSA_SBAR(); \
        o[d0] = __builtin_amdgcn_mfma_f32_32x32x16_bf16(pa0, (bf16x8){l0[0], l0[1], l0[2], l0[3], h0[0], h0[1], h0[2], h0[3]}, o[d0], 0, 0, 0); \
        o[d0] = __builtin_amdgcn_mfma_f32_32x32x16_bf16(pa1, (bf16x8){l1[0], l1[1], l1[2], l1[3], h1[0], h1[1], h1[2], h1[3]}, o[d0], 0, 0, 0); } while (0)
        WSA_PV(0); WSA_PV(1); WSA_PV(2); WSA_PV(3);
#undef WSA_PV
#undef WSA_TR
        if (more) {
            LAS unsigned char* nb = wl + ((blk + 1) & 1) * VBUF;
#pragma unroll
            for (int i = 0; i < 8; ++i) *(LAS bf16x8*)(nb + vst_off[i]) = vs[i];
        }
        asm volatile("s_waitcnt lgkmcnt(0)" ::: "memory");
    }
    if (hi == 0) li_l[r32] = l_reg;
    asm volatile("s_waitcnt lgkmcnt(0)" ::: "memory");
    float rli[16];
#pragma unroll
    for (int r = 0; r < 16; ++r) rli[r] = __builtin_amdgcn_rcpf(li_l[crow(r, hi)]);
    if (hi == 0) it.L[(size_t)r32 * it.lpitch] = m_reg * C2 + __builtin_amdgcn_logf(l_reg);
    const int OP = it.opitch;
#pragma unroll
    for (int r = 0; r < 16; ++r) { const int orow = crow(r, hi);
#pragma unroll
        for (int d0 = 0; d0 < 4; ++d0) { const float v = o[d0][r] * rli[r];
            const float vn = __builtin_bit_cast(float, __builtin_amdgcn_mov_dpp(__builtin_bit_cast(int, v), 0xB1, 0xF, 0xF, true));
            if ((r32 & 1) == 0) *(unsigned*)(it.O + (size_t)orow * OP + d0 * 32 + r32) = cvtpk(v, vn); } }
    asm volatile("s_waitcnt lgkmcnt(0)" ::: "memory");
}
#undef WSA_SBAR
__device__ __forceinline__ void phase(const Frame& F, unsigned char* ws) {
    const int lane = tid_from(F.wave) & 63;
    LAS unsigned char* wl = F.lds + F.wave * WAVE_LDS;
#pragma unroll 1
    for (int it = F.vcu * NWAVES + F.wave; it < N_ITEMS; it += F.G * NWAVES) { const Item x = decode(ws, it); wave_item(x, wl, lane); }
}
}

namespace s5 {
constexpr size_t T_WST = 2 * MiB;
constexpr size_t T_WO = 10 * MiB;
constexpr size_t T_KT = 18 * MiB;
constexpr size_t T_A16 = 20 * MiB;
constexpr int RSTR = 528;
constexpr int U_OFF = 0, L_OFF = 128 * RSTR;
constexpr int LDS_NEED = 2 * 128 * RSTR + 4096;
__device__ __forceinline__ void tables_wg(const Args& a, LAS unsigned char* lds, int lg, int wave_s) {
    typedef float f32x2 __attribute__((ext_vector_type(2)));
    LAS f32x2* PW = (LAS f32x2*)lds; LAS f32x2* BB = PW + 17 * 64; LAS f32x2* CT = BB + 64 * 16;
    const int tid = tid_from(wave_s); unsigned char* ws = a.p.ws;
    if (tid < 64) {
        const int idx = lg * 64 + tid;
        const float lre = fminf(inptr(a, IN_LRE)[idx], -1e-4f), lim = inptr(a, IN_LIM)[idx], dt = expf(inptr(a, IN_LDT)[lg]);
        const float ar = lre * dt, b = lim * dt, ea = expf(ar), sb = sinf(b), cb = cosf(b);
        const float Are = ea * cb, Aim = ea * sb, sh = sinf(0.5f * b);
        const float Dre = expm1f(ar) * cb - 2.0f * sh * sh, Dim = Aim;
        const float den = lre * lre + lim * lim;
        const float cre = (Dre * lre + Dim * lim) / den, cim = (Dim * lre - Dre * lim) / den;
        float* A = (float*)(ws + OFF_S5 + S5_A); float* Bb = (float*)(ws + OFF_S5 + S5_BB);
        A[idx * 2] = Are; A[idx * 2 + 1] = Aim;
        const float* bre = inptr(a, IN_BRE) + idx * 16; const float* bim = inptr(a, IN_BIM) + idx * 16;
        for (int c = 0; c < 16; ++c) { const float br = bre[c], bi = bim[c]; const f32x2 v = {cre * br - cim * bi, cre * bi + cim * br};
            Bb[(idx * 16 + c) * 2] = v.x; Bb[(idx * 16 + c) * 2 + 1] = v.y; BB[tid * 16 + c] = v; }
        float pr = 1.f, pi = 0.f; asm volatile("" : "+v"(pr), "+v"(pi));
        for (int k = 0; k <= 16; ++k) { PW[k * 64 + tid] = (f32x2){pr, pi}; const float nr = pr * Are - pi * Aim, ni = pr * Aim + pi * Are; pr = nr; pi = ni; }
        const f32x2 a16 = PW[16 * 64 + tid];
        ((f32x2*)(ws + OFF_S5 + T_A16))[idx] = a16;
    } else {
        const float* cr = inptr(a, IN_CRE) + (size_t)lg * 1024; const float* ci = inptr(a, IN_CIM) + (size_t)lg * 1024;
        for (int e = tid - 64; e < 1024; e += NTHREADS - 64) { const int c = e >> 6, pp = e & 63; CT[pp * 16 + c] = (f32x2){cr[e], ci[e]}; }
    }
    __syncthreads();
    bf16_t* WST = (bf16_t*)(ws + OFF_S5 + T_WST) + (size_t)lg * 128 * 256;
    for (int e = tid; e < 4096; e += NTHREADS) {
        const int i = e >> 5, kk0 = (e & 31) * 8, s = kk0 >> 4, c0 = kk0 & 15, pp = i & 63; const bool im = i >= 64;
        const f32x2 w = PW[(15 - s) * 64 + pp]; float v[8];
#pragma unroll
        for (int j = 0; j < 8; ++j) { const f32x2 bb = BB[pp * 16 + c0 + j]; v[j] = im ? (w.x * bb.y + w.y * bb.x) : (w.x * bb.x - w.y * bb.y); }
        u32x4 o; o.x = pk2(v[0], v[1]); o.y = pk2(v[2], v[3]); o.z = pk2(v[4], v[5]); o.w = pk2(v[6], v[7]);
        *(u32x4*)(WST + (size_t)((((i >> 4) * 8 + ((e & 31) >> 2)) * 64 + ((e & 31) & 3) * 16 + (i & 15)) * 8)) = o;
    }
    bf16_t* WO = (bf16_t*)(ws + OFF_S5 + T_WO) + (size_t)lg * 256 * 128;
    for (int e = tid; e < 4096; e += NTHREADS) {
        const int row = e >> 4, i0 = (e & 15) * 8, t = row >> 4, c = row & 15; float v[8];
#pragma unroll
        for (int j = 0; j < 8; ++j) { const int ip = i0 + j, pp = ip & 63; const f32x2 cc = CT[pp * 16 + c], w = PW[(t + 1) * 64 + pp];
            v[j] = ip < 64 ? (cc.x * w.x - cc.y * w.y) : -(cc.x * w.y + cc.y * w.x); }
        u32x4 o; o.x = pk2(v[0], v[1]); o.y = pk2(v[2], v[3]); o.z = pk2(v[4], v[5]); o.w = pk2(v[6], v[7]);
        *(u32x4*)(WO + (size_t)(((t * 4 + ((e & 15) >> 2)) * 64 + ((e & 15) & 3) * 16 + c) * 8)) = o;
    }
    bf16_t* KT = (bf16_t*)(ws + OFF_S5 + T_KT) + (size_t)lg * 17 * 256;
    { const int la = tid >> 5, c = (tid >> 1) & 15, h = tid & 1; float acc[8];
#pragma unroll
      for (int j = 0; j < 8; ++j) acc[j] = 0.f;
      for (int pp = 0; pp < 64; ++pp) { const f32x2 cc = CT[pp * 16 + c], w = PW[la * 64 + pp]; const float zr = cc.x * w.x - cc.y * w.y, zi = cc.x * w.y + cc.y * w.x;
#pragma unroll
          for (int j = 0; j < 8; ++j) { const f32x2 bb = BB[pp * 16 + 8 * h + j]; acc[j] += zr * bb.x - zi * bb.y; } }
      u32x4 o; o.x = pk2(acc[0], acc[1]); o.y = pk2(acc[2], acc[3]); o.z = pk2(acc[4], acc[5]); o.w = pk2(acc[6], acc[7]);
      *(u32x4*)(KT + ((la + 1) * 16 + c) * 16 + 8 * h) = o;
      if (tid < 32) { unsigned z_ = 0u; asm volatile("" : "+v"(z_)); *(u32x4*)(KT + tid * 8) = (u32x4){z_, z_, z_, z_}; } }
    __syncthreads();
}
__device__ __forceinline__ void unit(LAS unsigned char* lds, unsigned char* ws, int layer, int b, int g, int wave_s, const float* dsk_l) {
    const int tid = tid_from(wave_s), wave = wave_s, lane = tid & 63, q = lane >> 4, r16 = lane & 15;
    const int lg = layer * 32 + g;
    const bf16_t* usrc = (const bf16_t*)(ws + OFF_UG) + (size_t)(b * SSM_NG + g) * SEQ * 16;
    if (W_TOUCH2 == 1) {
        const int ln_ = tid_from(wave_s) & 63, cu_ = b * SSM_NG + g;
        const char* tp_ = nullptr;
        if (wave == 0) tp_ = (const char*)(ws + OFF_WOUT) + (size_t)layer * D_MODEL * D_MODEL * 2 + ((size_t)cu_ * 64 + ln_) * 128;
        else if (wave == 1) tp_ = (ln_ < 32 ? (const char*)(ws + OFF_WBS) + (size_t)layer * D_MODEL * SSM_W * 2 : (const char*)(ws + OFF_WBA) + (size_t)layer * D_MODEL * ATT_W * 2) + ((size_t)cu_ * 32 + (ln_ & 31)) * 128;
        else if (wave == 2) tp_ = (const char*)(ws + OFF_WGLU) + (size_t)layer * SSM_W * SSM_W * 2 + ((size_t)cu_ * 16 + (ln_ & 15)) * 128;
        if (wave < 3) __builtin_amdgcn_global_load_lds((const unsigned*)tp_, (LAS unsigned*)(lds + 143360 + wave * 256), 4, 0, 0);
    }
    __builtin_amdgcn_s_waitcnt(0);
    bf16x8 uv[8], af[8], kfA[8], wfA[4], kfB[8], wfB[4];
#pragma unroll
    for (int k = 0; k < 8; ++k) uv[k] = __builtin_nontemporal_load((const bf16x8*)(usrc + (size_t)(tid + NTHREADS * k) * 8));
    { const bf16_t* W = (const bf16_t*)(ws + OFF_S5 + T_WST) + (size_t)lg * 128 * 256 + (size_t)(wave * 8 * 64 + lane) * 8;
#pragma unroll
      for (int ks = 0; ks < 8; ++ks) af[ks] = __builtin_nontemporal_load((const bf16x8*)(W + ks * 512));
      const bf16_t* KT = (const bf16_t*)(ws + OFF_S5 + T_KT) + (size_t)lg * 17 * 256;
      const bf16_t* WO = (const bf16_t*)(ws + OFF_S5 + T_WO) + (size_t)lg * 256 * 128;
#pragma unroll
      for (int ks = 0; ks < 8; ++ks) { const int lagA = wave - (2 * ks + (q >> 1)) + 1, lagB = (15 - wave) - (2 * ks + (q >> 1)) + 1;
          kfA[ks] = *(const bf16x8*)(KT + ((lagA > 0 ? lagA : 0) * 16 + r16) * 16 + 8 * (q & 1)); kfB[ks] = *(const bf16x8*)(KT + ((lagB > 0 ? lagB : 0) * 16 + r16) * 16 + 8 * (q & 1)); }
#pragma unroll
      for (int k2 = 0; k2 < 4; ++k2) { wfA[k2] = __builtin_nontemporal_load((const bf16x8*)(WO + (size_t)((wave * 4 + k2) * 64 + lane) * 8)); wfB[k2] = __builtin_nontemporal_load((const bf16x8*)(WO + (size_t)(((15 - wave) * 4 + k2) * 64 + lane) * 8)); } }
#pragma unroll
    for (int k = 0; k < 8; ++k) { const int piece = tid + NTHREADS * k, tok = piece >> 1, half = piece & 1;
        *(LAS bf16x8*)(lds + U_OFF + (tok >> 4) * RSTR + (tok & 15) * 32 + half * 16) = uv[k]; }
    asm volatile("s_waitcnt lgkmcnt(0)" ::: "memory"); __builtin_amdgcn_s_barrier(); asm volatile("" ::: "memory");
    {
      for (int nt = 0; nt < 8; ++nt) {
          f32x4 acc = {0.f, 0.f, 0.f, 0.f};
          const LAS unsigned char* ub = lds + U_OFF + (nt * 16 + r16) * RSTR + q * 16;
#pragma unroll
          for (int ks = 0; ks < 8; ++ks) acc = __builtin_amdgcn_mfma_f32_16x16x32_bf16(af[ks], *(const LAS bf16x8*)(ub + ks * 64), acc, 0, 0, 0);
          *(LAS f32x4*)(lds + L_OFF + (nt * 16 + r16) * RSTR + (wave * 16 + 4 * q) * 4) = acc;
      } }
    asm volatile("s_waitcnt lgkmcnt(0)" ::: "memory"); __builtin_amdgcn_s_barrier(); asm volatile("" ::: "memory");
    {
        typedef float f32x2 __attribute__((ext_vector_type(2)));
        const f32x2 a16 = ((const f32x2*)(ws + OFF_S5 + T_A16))[lg * 64 + lane];
        LAS float* EW = (LAS float*)(lds + 2 * 128 * RSTR);
        float lre[16], lim[16], qre[16], qim[16];
#pragma unroll
        for (int jj = 0; jj < 16; ++jj) { const LAS float* row = (const LAS float*)(lds + L_OFF + (wave * 16 + jj) * RSTR); lre[jj] = row[lane]; lim[jj] = row[64 + lane]; }
        float sre = 0.f, sim = 0.f;
#pragma unroll
        for (int jj = 0; jj < 16; ++jj) { qre[jj] = sre; qim[jj] = sim;
            const float nre = a16.x * sre - a16.y * sim + lre[jj], nim = a16.x * sim + a16.y * sre + lim[jj]; sre = nre; sim = nim; }
        EW[wave * 128 + lane] = sre; EW[wave * 128 + 64 + lane] = sim;
        float pr = a16.x, pi = a16.y;
#pragma unroll
        for (int k = 0; k < 4; ++k) { const float nr = pr * pr - pi * pi, ni = 2.f * pr * pi; pr = nr; pi = ni; }
        __syncthreads();
        float ere[7], eim[7];
#pragma unroll
        for (int v = 0; v < 7; ++v) { ere[v] = EW[v * 128 + lane]; eim[v] = EW[v * 128 + 64 + lane]; }
        float gre = 0.f, gim = 0.f;
#pragma unroll
        for (int v = 0; v < 7; ++v) if (v < wave) { const float nre = pr * gre - pi * gim + ere[v], nim = pr * gim + pi * gre + eim[v]; gre = nre; gim = nim; }
#pragma unroll
        for (int jj = 0; jj < 16; ++jj) {
            LAS bf16_t* row = (LAS bf16_t*)(lds + L_OFF + (wave * 16 + jj) * RSTR);
            row[lane] = f2bf(qre[jj] + gre); row[64 + lane] = f2bf(qim[jj] + gim);
            const float nre = a16.x * gre - a16.y * gim, nim = a16.x * gim + a16.y * gre; gre = nre; gim = nim;
        }
    }
    __syncthreads();
    {
      bf16_t* ypre = (bf16_t*)(ws + OFF_YPRE) + (size_t)b * SEQ * SSM_W + g * 16 + 4 * q;
      const f32x4 dk = *(const f32x4*)(dsk_l + g * 16 + 4 * q);
#pragma unroll
      for (int tt = 0; tt < 2; ++tt) {
          const int t = tt ? 15 - wave : wave, nks = (t >> 1) + 1;
          bf16x8 kf[8], wf[4];
#pragma unroll
          for (int ks = 0; ks < 8; ++ks) kf[ks] = tt ? kfB[ks] : kfA[ks];
#pragma unroll
          for (int k2 = 0; k2 < 4; ++k2) wf[k2] = tt ? wfB[k2] : wfA[k2];
#pragma unroll 1
          for (int nt = 0; nt < 8; ++nt) {
              f32x4 acc = {0.f, 0.f, 0.f, 0.f}, accB = {0.f, 0.f, 0.f, 0.f}, accC = {0.f, 0.f, 0.f, 0.f};
              const LAS unsigned char* ub = lds + U_OFF + (nt * 16 + r16) * RSTR + q * 16;
              const LAS unsigned char* sb = lds + L_OFF + (nt * 16 + r16) * RSTR + q * 16;
#pragma unroll
              for (int ks = 0; ks < 8; ks += 2) { if (ks < nks) acc = __builtin_amdgcn_mfma_f32_16x16x32_bf16(kf[ks], *(const LAS bf16x8*)(ub + ks * 64), acc, 0, 0, 0);
                  if (ks + 1 < nks) accB = __builtin_amdgcn_mfma_f32_16x16x32_bf16(kf[ks + 1], *(const LAS bf16x8*)(ub + (ks + 1) * 64), accB, 0, 0, 0); }
#pragma unroll
              for (int k2 = 0; k2 < 4; ++k2) accC = __builtin_amdgcn_mfma_f32_16x16x32_bf16(wf[k2], *(const LAS bf16x8*)(sb + k2 * 64), accC, 0, 0, 0);
              acc = acc + accB + accC;
              const int tok = 16 * (nt * 16 + r16) + t;
              typedef unsigned u32x2_ __attribute__((ext_vector_type(2)));
              const u32x2_ uu = *(const LAS u32x2_*)(lds + U_OFF + (nt * 16 + r16) * RSTR + t * 32 + q * 8);
              const float y0 = gelu_fast(acc[0] + dk[0] * blo(uu.x)), y1 = gelu_fast(acc[1] + dk[1] * bhi(uu.x)), y2 = gelu_fast(acc[2] + dk[2] * blo(uu.y)), y3 = gelu_fast(acc[3] + dk[3] * bhi(uu.y));
              *(unsigned long long*)(ypre + (size_t)tok * SSM_W) = (unsigned long long)pk2(y0, y1) | ((unsigned long long)pk2(y2, y3) << 32);
          }
      } }
    __syncthreads();
}
}


namespace p4 {
constexpr int XT = 8192, WT = 65536, SLOT = XT + WT;
constexpr int RED_OFF = 2 * SLOT, RED2_OFF = RED_OFF + 2048;
constexpr int JUNK_OFF = RED2_OFF + 2048;
static_assert(JUNK_OFF + 2048 <= MISC_OFF, "P4 LDS map");
constexpr size_t OFF_MG = OFF_T4;
typedef unsigned u32x2 __attribute__((ext_vector_type(2)));
#define P4_WAIT_V(n) asm volatile("s_waitcnt vmcnt(" #n ")" ::: "memory")
#define P4_WAIT_L(n) asm volatile("s_waitcnt lgkmcnt(" #n ")" ::: "memory")
#define P4_BAR __builtin_amdgcn_s_barrier()

struct G64 { const bf16_t* X; const bf16_t* W; int lxs, lws; };
struct Geo { int rr, ch0, foff, wave; };
__device__ __forceinline__ Geo make_geo(int wave, int lane) {
    Geo g; g.rr = lane >> 3; g.ch0 = (lane & 7) ^ (g.rr >> 1); g.wave = wave;
    const int fr = lane & 15, fq = lane >> 4;
    g.foff = fr * 128 + ((fq ^ (fr >> 1)) & 7) * 16;
    return g;
}
__device__ __forceinline__ void stage64_piece(LAS unsigned char* lds, const Geo& g, const G64& d, int kt, int slot, int p) {
    const unsigned ldsw = (unsigned)g.wave * 1024u;
    if (p == 0) { const unsigned vo = ((unsigned)g.rr << d.lxs) + (unsigned)((g.ch0 ^ ((g.wave & 1) << 2)) * 16);
        __builtin_amdgcn_global_load_lds((const unsigned*)((const char*)d.X + (size_t)kt * 128 + ((size_t)(8 * g.wave) << d.lxs) + vo), (LAS unsigned*)(lds + slot * SLOT + ldsw), 16, 0, 0); }
    else { const int i = p - 1; const unsigned vo = ((unsigned)(16 * (g.rr >> 2) + (g.rr & 3)) << d.lws) + (unsigned)((g.ch0 ^ ((i & 1) << 2)) * 16);
        __builtin_amdgcn_global_load_lds((const unsigned*)((const char*)d.W + (size_t)kt * 128 + ((size_t)(64 * g.wave + 32 * (i & 1) + 4 * (i >> 1)) << d.lws) + vo), (LAS unsigned*)(lds + slot * SLOT + XT + ldsw * 8 + i * 1024), 16, 0, 0); }
}
__device__ __forceinline__ void stage64(LAS unsigned char* lds, const Geo& g, const G64& d, int kt, int slot, int parts) {
    if (parts & 1) stage64_piece(lds, g, d, kt, slot, 0);
    if (parts & 2) {
#pragma unroll
        for (int p = 1; p < 9; ++p) stage64_piece(lds, g, d, kt, slot, p);
    }
}
template <int NKT>
__device__ __forceinline__ void run64(f32x4 (&acc)[4][4], LAS unsigned char* lds, const Geo& g, const G64& cur, const G64& nxt, int nparts, int rot, int nrot) {
#define P4_READS(k) do { _Pragma("unroll") for (int m = 0; m < 4; ++m) xf[m] = *(const LAS bf16x8*)(sb + (g.foff ^ ((k) * 64)) + m * 2048); \
        _Pragma("unroll") for (int n = 0; n < 4; ++n) wf[n] = *(const LAS bf16x8*)(sb + XT + g.wave * 8192 + (g.foff ^ ((k) * 64)) + n * 2048); } while (0)
#define P4_MFMA(e) do { acc[((e) >> 2) & 3][(e) & 3] = __builtin_amdgcn_mfma_f32_16x16x32_bf16(wf[(e) & 3], xf[((e) >> 2) & 3], acc[((e) >> 2) & 3][(e) & 3], 0, 0, 0); } while (0)
#pragma unroll 1
    for (int kt = 0; kt + 1 < NKT; ++kt) {
        const int slot = kt & 1, ktn = (kt + 1 + rot) & (NKT - 1);
        P4_WAIT_V(0); P4_WAIT_L(0); P4_BAR;
        const LAS unsigned char* sb = lds + slot * SLOT; bf16x8 xf[4], wf[4];
        P4_READS(0);
#pragma unroll
        for (int i = 0; i < 5; ++i) { P4_MFMA(3 * i); P4_MFMA(3 * i + 1); P4_MFMA(3 * i + 2); stage64_piece(lds, g, cur, ktn, slot ^ 1, i); __builtin_amdgcn_sched_barrier(0); }
        P4_MFMA(15);
        __builtin_amdgcn_sched_barrier(0);
        P4_READS(1);
#pragma unroll
        for (int i = 0; i < 4; ++i) { P4_MFMA(4 * i); P4_MFMA(4 * i + 1); P4_MFMA(4 * i + 2); P4_MFMA(4 * i + 3); stage64_piece(lds, g, cur, ktn, slot ^ 1, 5 + i); __builtin_amdgcn_sched_barrier(0); }
    }
    {   const int kt = NKT - 1, slot = kt & 1;
        P4_WAIT_V(0); P4_WAIT_L(0); P4_BAR;
        if (nparts) stage64(lds, g, nxt, nrot, slot ^ 1, nparts);
        const LAS unsigned char* sb = lds + slot * SLOT; bf16x8 xf[4], wf[4];
#pragma unroll
        for (int k = 0; k < 2; ++k) { P4_READS(k);
#pragma unroll
            for (int e = 0; e < 16; ++e) P4_MFMA(e); }
    }
    P4_WAIT_L(0); P4_BAR;
#undef P4_READS
#undef P4_MFMA
}
__device__ __forceinline__ float sum_q(float v) {
    v += __builtin_bit_cast(float, __builtin_amdgcn_ds_swizzle(__builtin_bit_cast(int, v), 0x401F));
    const auto rr = __builtin_amdgcn_permlane32_swap(__float_as_uint(v), __float_as_uint(v), false, false);
    return __uint_as_float(rr[0]) + __uint_as_float(rr[1]);
}
#define P4_ZERO(A) do { _Pragma("unroll") for (int m_ = 0; m_ < 4; ++m_) _Pragma("unroll") for (int n_ = 0; n_ < 4; ++n_) A[m_][n_] = (f32x4){0.f, 0.f, 0.f, 0.f}; } while (0)

__device__ __forceinline__ void unit(const Args& a, LAS unsigned char* lds, unsigned char* ws, int layer, int u, unsigned long long& ts_sum, unsigned long long& ts_t0, int wave_s, bool dry = false) {
    const int tid = tid_from(wave_s), wave = wave_s, lane = tid & 63, q = lane >> 4, r16 = lane & 15;
    const size_t row0 = (size_t)u * 64;
    const bf16_t* gz = (const bf16_t*)(ws + OFF_GZ);
    const unsigned lo5 = (unsigned)(r16 * SSM_W + 16 * q), lo10 = (unsigned)(r16 * D_MODEL + 16 * q); static_assert(GZ_W == D_MODEL, "lop == lo10");
#define lop lo10
    const bf16_t* projr = gz + row0 * GZ_W;
    const unsigned char* g8r = (const unsigned char*)(ws + OFF_G8) + row0 * G8_W; const unsigned lo8 = (unsigned)(r16 * G8_W + 16 * q);
    bf16_t* Y1 = (bf16_t*)(ws + OFF_YPRE) + row0 * SSM_W;
    bf16_t* YA = (bf16_t*)(ws + OFF_AO) + row0 * ATT_W;
    bf16_t* YS = (bf16_t*)(ws + OFF_AO) + ((size_t)MTOK + row0) * ATT_W;
    bf16_t* MG = (bf16_t*)(ws + OFF_MG) + row0 * D_MODEL;
    if (W_TOUCH && layer + 1 < DEPTH && u < 256) {
        const char* wn_ = (const char*)(ws + OFF_WIN) + (size_t)(layer + 1) * IN_COLS * D_MODEL * 2 + ((size_t)u * 512 + (size_t)wave * 64 + (size_t)(tid_from(wave_s) & 63)) * 128;
        __builtin_amdgcn_global_load_lds((const unsigned*)wn_, (LAS unsigned*)(lds + JUNK_OFF + wave * 256), 4, 0, 0);
    }
    { const Geo geo0 = make_geo(wave, lane); const G64 dGLU0{Y1, (const bf16_t*)(ws + OFF_WGLU) + (size_t)layer * SSM_W * SSM_W, 10, 10}; stage64(lds, geo0, dGLU0, u & 7, 0, 3); }
    TS_BEGIN(41);
    {
        const int cc = (tid & 63) * 8, rb = tid >> 6, j = cc >> 7;
        const bf16_t* ao = (const bf16_t*)(ws + OFF_AO); const float* ls = (const float*)(ws + OFF_ALSE);
#pragma unroll 1
        for (int kb = 0; kb < 8; kb += 4) {
            u32x4 a0[4], a1[4], a2[4], za[4]; float l0[4], l1[4], l2[4];
#pragma unroll
            for (int i = 0; i < 4; ++i) { const int row = rb + 8 * (kb + i); const size_t tok = row0 + row;
                l0[i] = ls[((size_t)0 * MTOK + tok) * 4 + j]; l1[i] = ls[((size_t)1 * MTOK + tok) * 4 + j]; l2[i] = ls[((size_t)2 * MTOK + tok) * 4 + j];
                a0[i] = __builtin_nontemporal_load((const u32x4*)(ao + ((size_t)0 * MTOK + tok) * ATT_W + cc)); a1[i] = __builtin_nontemporal_load((const u32x4*)(ao + ((size_t)1 * MTOK + tok) * ATT_W + cc)); a2[i] = __builtin_nontemporal_load((const u32x4*)(ao + ((size_t)2 * MTOK + tok) * ATT_W + cc));
                za[i] = __builtin_nontemporal_load((const u32x4*)(gz + tok * GZ_W + GZ_ZA + cc)); }
#pragma unroll
            for (int i = 0; i < 4; ++i) { const int row = rb + 8 * (kb + i);
                const float mx = fmaxf(l0[i], fmaxf(l1[i], l2[i])); float w0 = __builtin_amdgcn_exp2f(l0[i] - mx), w1 = __builtin_amdgcn_exp2f(l1[i] - mx), w2 = __builtin_amdgcn_exp2f(l2[i] - mx);
                const float iw = __builtin_amdgcn_rcpf(w0 + w1 + w2); w0 *= iw; w1 *= iw; w2 *= iw;
#define MRG(A0, A1, A2, Z) pk2((w0 * blo(A0) + w1 * blo(A1) + w2 * blo(A2)) * blo(Z), (w0 * bhi(A0) + w1 * bhi(A1) + w2 * bhi(A2)) * bhi(Z))
                u32x4 y; y.x = MRG(a0[i].x, a1[i].x, a2[i].x, za[i].x); y.y = MRG(a0[i].y, a1[i].y, a2[i].y, za[i].y); y.z = MRG(a0[i].z, a1[i].z, a2[i].z, za[i].z); y.w = MRG(a0[i].w, a1[i].w, a2[i].w, za[i].w);
#undef MRG
                *(u32x4*)(YA + (size_t)row * ATT_W + cc) = y; }
        }
    }
    VM_WAIT(); __syncthreads();
    TS_END(41); TS_BEGIN(42);
    const int nbw = wave * 64;
    const int r8 = u & 7, r16t = u & 15;
    const Geo geo = make_geo(wave, lane);
    const G64 dGLU{Y1, (const bf16_t*)(ws + OFF_WGLU) + (size_t)layer * SSM_W * SSM_W, 10, 10};
    const bf16_t* WBSl = (const bf16_t*)(ws + OFF_WBS) + (size_t)layer * D_MODEL * SSM_W; const bf16_t* WBAl = (const bf16_t*)(ws + OFF_WBA) + (size_t)layer * D_MODEL * ATT_W;
    const bf16_t* WOl = (const bf16_t*)(ws + OFF_WOUT) + (size_t)layer * D_MODEL * D_MODEL;
    const G64 dOUT0{MG, WOl, 11, 11}, dOUT1{MG, WOl + (size_t)512 * D_MODEL, 11, 11};
    {
        f32x4 acc[4][4]; P4_ZERO(acc);
        const G64 dBS0{YS, WBSl, 10, 10};
        const float* bg = inptr(a, IN_BGLU) + layer * SSM_W;
        f32x4 b4[4];
#pragma unroll
        for (int n = 0; n < 4; ++n) b4[n] = *(const f32x4*)(bg + (nbw + n * 4) + (unsigned)(((tid_from(wave_s) >> 4) & 3) * 16));
        run64<8>(acc, lds, geo, dGLU, dBS0, 2, r8, r8);
        {   u32x4 y1[4][2], zs[4][2];
#pragma unroll
            for (int m = 0; m < 4; ++m)
#pragma unroll
                for (int h = 0; h < 2; ++h) { y1[m][h] = *(const u32x4*)(Y1 + (m * 16 * SSM_W + nbw + h * 8) + lo5); zs[m][h] = __builtin_nontemporal_load((const u32x4*)(projr + (GZ_ZS + m * 16 * GZ_W + nbw + h * 8) + lop)); }
#pragma unroll
            for (int m = 0; m < 4; ++m) { u32x4 o[2];
#pragma unroll
                for (int n = 0; n < 4; ++n) { const unsigned yx = y1[m][n >> 1][(n & 1) * 2], yy = y1[m][n >> 1][(n & 1) * 2 + 1], zx = zs[m][n >> 1][(n & 1) * 2], zy = zs[m][n >> 1][(n & 1) * 2 + 1];
                    o[n >> 1][(n & 1) * 2] = pk2(blo(yx) * sig_fast(acc[m][n][0] + b4[n][0]) * blo(zx), bhi(yx) * sig_fast(acc[m][n][1] + b4[n][1]) * bhi(zx));
                    o[n >> 1][(n & 1) * 2 + 1] = pk2(blo(yy) * sig_fast(acc[m][n][2] + b4[n][2]) * blo(zy), bhi(yy) * sig_fast(acc[m][n][3] + b4[n][3]) * bhi(zy)); }
#pragma unroll
                for (int h = 0; h < 2; ++h) *(u32x4*)(YS + (m * 16 * SSM_W + nbw + h * 8) + lo5) = o[h]; }
        }
        VM_WAIT(); __syncthreads();
        stage64(lds, geo, dBS0, r8, 0, 1);
    }
    TS_END(42); TS_BEGIN(43);
#pragma unroll 1
    for (int ps = 0; ps < 2; ++ps) {
        f32x4 as[4][4], aa[4][4]; P4_ZERO(as); P4_ZERO(aa);
        const G64 dBS{YS, WBSl + (size_t)ps * 512 * SSM_W, 10, 10}, dBA{YA, WBAl + (size_t)ps * 512 * ATT_W, 10, 10};
        const G64 dBSn{YS, WBSl + (size_t)512 * SSM_W, 10, 10};
        run64<8>(as, lds, geo, dBS, dBA, 3, r8, r8);
        if (ps == 0) run64<8>(aa, lds, geo, dBA, dBSn, 3, r8, r8);
        else run64<8>(aa, lds, geo, dBA, dOUT0, 2, r8, r16t);
        {   u32x4 gs[4], ga[4];
#pragma unroll
            for (int m = 0; m < 4; ++m) { const int bo = m * 16 * G8_W + ps * 512 + nbw; gs[m] = __builtin_nontemporal_load((const u32x4*)(g8r + (G8_GS + bo) + lo8)); ga[m] = __builtin_nontemporal_load((const u32x4*)(g8r + (G8_GA + bo) + lo8)); }
#define P4_UB(w, e) ((float)(((w) >> (8 * (e))) & 0xffu) * (1.0f / 255.0f))
#pragma unroll
            for (int m = 0; m < 4; ++m) { u32x4 o[2];
#pragma unroll
                for (int n = 0; n < 4; ++n) { const unsigned gsw = gs[m][n], gaw = ga[m][n];
                    o[n >> 1][(n & 1) * 2] = pk2(P4_UB(gsw, 0) * as[m][n][0] + P4_UB(gaw, 0) * aa[m][n][0], P4_UB(gsw, 1) * as[m][n][1] + P4_UB(gaw, 1) * aa[m][n][1]);
                    o[n >> 1][(n & 1) * 2 + 1] = pk2(P4_UB(gsw, 2) * as[m][n][2] + P4_UB(gaw, 2) * aa[m][n][2], P4_UB(gsw, 3) * as[m][n][3] + P4_UB(gaw, 3) * aa[m][n][3]); }
#pragma unroll
                for (int h = 0; h < 2; ++h) *(u32x4*)(MG + (m * 16 * D_MODEL + ps * 512 + nbw + h * 8) + lo10) = o[h]; }
#undef P4_UB
        }
    }
    VM_WAIT(); __syncthreads();
    stage64(lds, geo, dOUT0, r16t, 0, 1);
    TS_END(43); TS_BEGIN(44);
    {
        f32x4 acc0[4][4], acc1[4][4]; P4_ZERO(acc0); P4_ZERO(acc1);
        run64<16>(acc0, lds, geo, dOUT0, dOUT1, 3, r16t, r16t);
        run64<16>(acc1, lds, geo, dOUT1, dOUT1, 0, r16t, 0);
        TS_END(44); TS_BEGIN(45);
        LAS float* RED = (LAS float*)(lds + RED_OFF); LAS float* RED2 = (LAS float*)(lds + RED2_OFF);
        float inv[4];
#pragma unroll
        for (int m = 0; m < 4; ++m) { float s = 0.f;
#pragma unroll
            for (int n = 0; n < 4; ++n) { s += (acc0[m][n][0] * acc0[m][n][0] + acc0[m][n][1] * acc0[m][n][1]) + (acc0[m][n][2] * acc0[m][n][2] + acc0[m][n][3] * acc0[m][n][3]);
                                          s += (acc1[m][n][0] * acc1[m][n][0] + acc1[m][n][1] * acc1[m][n][1]) + (acc1[m][n][2] * acc1[m][n][2] + acc1[m][n][3] * acc1[m][n][3]); }
            s = sum_q(s); if (q == 0) RED[(m * 16 + r16) * 8 + wave] = s; }
        __syncthreads();
#pragma unroll
        for (int m = 0; m < 4; ++m) { const LAS f32x4* rp = (const LAS f32x4*)(RED + (m * 16 + r16) * 8); const f32x4 r0 = rp[0], r1 = rp[1];
            inv[m] = rsqrtf(((r0[0] + r0[1]) + (r0[2] + r0[3]) + (r1[0] + r1[1]) + (r1[2] + r1[3])) * (1.0f / D_MODEL) + RMS_EPS); }
        const float* pg = inptr(a, IN_POSTG) + layer * D_MODEL; float* xor_ = a.p.out + row0 * D_MODEL; bf16_t* xbr = (bf16_t*)(ws + OFF_XB) + row0 * D_MODEL;
        float s2[4] = {0.f, 0.f, 0.f, 0.f};
        const unsigned lq4 = (unsigned)(((tid_from(wave_s) >> 4) & 3) * 16);
#define P4_RES(ACC, PS) do { f32x4 g4[4]; u32x4 xp[4][2]; \
            _Pragma("unroll") for (int n = 0; n < 4; ++n) g4[n] = *(const f32x4*)(pg + ((PS) * 512 + nbw + n * 4) + lq4); \
            _Pragma("unroll") for (int m = 0; m < 4; ++m) _Pragma("unroll") for (int h = 0; h < 2; ++h) xp[m][h] = *(const u32x4*)(xbr + (m * 16 * D_MODEL + (PS) * 512 + nbw + h * 8) + lo10); \
            __builtin_amdgcn_s_waitcnt(0);     \
            _Pragma("unroll") for (int m = 0; m < 4; ++m) { u32x4 o[2]; \
                _Pragma("unroll") for (int n = 0; n < 4; ++n) { const int bo = m * 16 * D_MODEL + (PS) * 512 + nbw + n * 4; const unsigned px = xp[m][n >> 1][(n & 1) * 2], py = xp[m][n >> 1][(n & 1) * 2 + 1]; \
                    f32x4 xv = {blo(px), bhi(px), blo(py), bhi(py)}; xv = xv + ACC[m][n] * inv[m] * g4[n]; \
                    o[n >> 1][(n & 1) * 2] = pk2(xv[0], xv[1]); o[n >> 1][(n & 1) * 2 + 1] = pk2(xv[2], xv[3]); \
                    if (!dry && layer == DEPTH - 1) *(f32x4*)(xor_ + bo + lo10) = xv; \
                    s2[m] += (xv[0] * xv[0] + xv[1] * xv[1]) + (xv[2] * xv[2] + xv[3] * xv[3]); } \
                if (!dry) { if (layer != DEPTH - 1) { _Pragma("unroll") for (int h = 0; h < 2; ++h) *(u32x4*)(xbr + (m * 16 * D_MODEL + (PS) * 512 + nbw + h * 8) + lo10) = o[h]; } } \
                else { asm volatile("" :: "v"(o[0].x), "v"(o[0].y), "v"(o[1].x), "v"(o[1].y)); } } } while (0)
        P4_RES(acc0, 0); P4_RES(acc1, 1);
#undef P4_RES
#pragma unroll
        for (int m = 0; m < 4; ++m) { const float s = sum_q(s2[m]); if (q == 0) RED2[(m * 16 + r16) * 8 + wave] = s; }
        __syncthreads();
        if (wave == 0 && !dry) { const int tl = tid_from(wave_s) & 63;
            const LAS f32x4* rp = (const LAS f32x4*)(RED2 + tl * 8); const f32x4 r0 = rp[0], r1 = rp[1];
            ((float*)(ws + OFF_ROWSS))[row0 + tl] = (r0[0] + r0[1]) + (r0[2] + r0[3]) + (r1[0] + r1[1]) + (r1[2] + r1[3]); }
    }
    VM_WAIT(); __syncthreads();
    TS_END(45);
}
#undef P4_ZERO
#undef lop
}

__device__ __forceinline__ void p0_transpose_item(const float* W, const float* rs, int K, int N, bf16_t* WT, LAS float* scr, int item, int lane, bool vperm, bool ntst) {
    const int nblk = N / 32, kb = item / nblk, nb = item % nblk, k0 = 64 * kb, n0 = 32 * nb;
    const int kr = lane >> 3, n4 = (lane & 7) * 4;
    f32x4 v[8];
#pragma unroll
    for (int i = 0; i < 8; ++i) v[i] = __builtin_nontemporal_load((const f32x4*)(W + (size_t)(k0 + 8 * i + kr) * N + n0 + n4));
    if (rs) {
#pragma unroll
        for (int i = 0; i < 8; ++i) v[i] = v[i] * rs[k0 + 8 * i + kr];
    }
#pragma unroll
    for (int i = 0; i < 8; ++i) { LAS float* d = scr + (8 * i + kr) * 33 + n4; d[0] = v[i][0]; d[1] = v[i][1]; d[2] = v[i][2]; d[3] = v[i][3]; }
    LDS_WAIT(); asm volatile("" ::: "memory");
    const int c = lane & 7;
#pragma unroll
    for (int j = 0; j < 4; ++j) { const int n = (lane >> 3) + 8 * j; const LAS float* s = scr + (8 * c) * 33 + n;
        u32x4 o; o.x = pk2(s[0 * 33], s[1 * 33]); o.y = pk2(s[2 * 33], s[3 * 33]); o.z = pk2(s[4 * 33], s[5 * 33]); o.w = pk2(s[6 * 33], s[7 * 33]);
        int nd = n0 + n;
        if (vperm && nd >= C_V && nd < C_ZA) { const int cc = nd & 127; nd = (nd & ~127) + (cc & 3) * 32 + (cc >> 2); }
        if (ntst) __builtin_nontemporal_store(o, (u32x4*)(WT + (size_t)nd * K + k0 + 8 * c)); else *(u32x4*)(WT + (size_t)nd * K + k0 + 8 * c) = o; }
    LDS_WAIT(); asm volatile("" ::: "memory");
}
__device__ __forceinline__ void p0_prologue(const Frame& F, const Args& a) {
    const int lane_ = tid_from(F.wave) & 63;
    LAS float* scr = (LAS float*)(F.lds + F.wave * 16384);
    const int gw = F.vcu * NWAVES + F.wave, NGW = F.G * NWAVES;
    constexpr int I_IN = (D_MODEL / 64) * (IN_COLS / 32), I_GLU = (SSM_W / 64) * (SSM_W / 32), I_BS = (SSM_W / 64) * (D_MODEL / 32), I_OUT = (D_MODEL / 64) * (D_MODEL / 32);
    constexpr int PER_L = I_IN + I_GLU + 2 * I_BS + I_OUT, NITEMS = DEPTH * PER_L;
    unsigned char* ws = a.p.ws;
    for (int lg = F.vcu; lg < DEPTH * SSM_NG; lg += F.G) s5::tables_wg(a, F.lds, lg, F.wave);
    constexpr int NTAB = DEPTH * SSM_NG, RA = 7;
    const bool bal = F.G > NTAB && RA * NGW < NITEMS;
    const int NA = bal ? RA * NGW : NITEMS, gw2 = gw - NTAB * NWAVES, NGW2 = (F.G - NTAB) * NWAVES;
    for (int k = 0; ; ++k) {
        const int it = (!bal || k < RA) ? gw + k * NGW : (gw2 >= 0 ? NA + gw2 + (k - RA) * NGW2 : NITEMS);
        if (it >= NITEMS || (bal && k < RA && it >= NA)) break;
        const int l = it / PER_L; int r = it - l * PER_L;
        int widx, K, N; size_t dst;
        if (r < I_IN) { widx = IN_WIN; K = D_MODEL; N = IN_COLS; dst = OFF_WIN; }
        else if ((r -= I_IN) < I_GLU) { widx = IN_WGLU; K = SSM_W; N = SSM_W; dst = OFF_WGLU; }
        else if ((r -= I_GLU) < I_BS) { widx = IN_WBS; K = SSM_W; N = D_MODEL; dst = OFF_WBS; }
        else if ((r -= I_BS) < I_BS) { widx = IN_WBA; K = ATT_W; N = D_MODEL; dst = OFF_WBA; }
        else { r -= I_BS; widx = IN_WOUT; K = D_MODEL; N = D_MODEL; dst = OFF_WOUT; }
        const float* W = inptr(a, widx) + (size_t)l * K * N;
        const float* rs = (widx == IN_WIN) ? inptr(a, IN_PREG) + l * D_MODEL : nullptr;
        p0_transpose_item(W, rs, K, N, (bf16_t*)(ws + dst) + (size_t)l * K * N, scr, r, lane_, ATTN_DMA == 3 && widx == IN_WIN, l > 0);
    }
    const float* X = inptr(a, IN_X);
    for (int m = gw; m < MTOK; m += 2 * NGW) {
        const int m1 = m + NGW; const bool has1 = m1 < MTOK;
        const f32x4* xr0 = (const f32x4*)(X + (size_t)m * D_MODEL) + lane_; const f32x4* xr1 = (const f32x4*)(X + (size_t)(has1 ? m1 : m) * D_MODEL) + lane_;
        f32x4 v0[4], v1[4];
#pragma unroll
        for (int j = 0; j < 4; ++j) { v0[j] = __builtin_nontemporal_load(xr0 + 64 * j); v1[j] = __builtin_nontemporal_load(xr1 + 64 * j); }
#pragma unroll
        for (int r = 0; r < 2; ++r) {
            if (r == 1 && !has1) break;
            const int mm = r ? m1 : m;
            unsigned long long* o8 = (unsigned long long*)((bf16_t*)(ws + OFF_XB) + (size_t)mm * D_MODEL) + lane_;
            float sq = 0.f;
#pragma unroll
            for (int j = 0; j < 4; ++j) { const f32x4 v = r ? v1[j] : v0[j]; sq += (v[0] * v[0] + v[1] * v[1]) + (v[2] * v[2] + v[3] * v[3]);
                o8[64 * j] = (unsigned long long)pk2(v[0], v[1]) | ((unsigned long long)pk2(v[2], v[3]) << 32); }
            sq = wave_sum(sq);
            if (lane_ == 0) ((float*)(ws + OFF_ROWSS))[mm] = sq;
        }
    }
}

constexpr int N_PHASES = 1 + 3 * DEPTH;
__global__ void __launch_bounds__(NTHREADS, 2) mega(Args a) {
    extern __shared__ __attribute__((aligned(16))) unsigned char lds_raw[];
    Frame F; F.lds = (LAS unsigned char*)lds_raw; F.wave = __builtin_amdgcn_readfirstlane((int)threadIdx.x >> 6);
    F.G = gridDim.x; { const int bx = blockIdx.x; F.vcu = (F.G % 8 == 0) ? (bx % 8) * (F.G / 8) + bx / 8 : bx; }
    volatile LAS unsigned* MISC = (volatile LAS unsigned*)(F.lds + MISC_OFF);
    { const int t0_ = tid_from(F.wave); if (t0_ < 64) MISC[t0_] = 0u; }
    __syncthreads();
    const bool grouped = (F.G % 8 == 0) && (a.ph_lo == 0) && (a.ph_hi == N_PHASES);
    unsigned* bw = (unsigned*)(a.p.ws + OFF_CTL) + CW_BAR + a.bar_region * XCD_BAR_WORDS;
    XcdBarrier gbar = xcd_barrier_post(bw, MISC + 8, F.wave, (unsigned)F.G);
    XcdBarrier lbar = gbar;
    if (grouped) lbar = xcd_barrier_post(bw + (1 + (blockIdx.x & 7)) * XCD_BAR_WORDS, MISC + 10, F.wave, (unsigned)F.G / 8u);
    unsigned long long ts_sum = 0, ts_t0 = 0;
    TS_BEGIN(100);
    for (int ph = a.ph_lo; ph < a.ph_hi; ++ph) {
        TS_BEGIN(9); if (ph > 0 && (ph - 1) % 3 == 0) TS_BEGIN(93); if (ph > 0 && (ph - 1) % 3 == 1) TS_BEGIN(91); if (ph > 0 && (ph - 1) % 3 == 2) TS_BEGIN(92);
        if (ph > a.ph_lo) { if (ph == 1 || !grouped) xcd_barrier(gbar); else xcd_barrier(lbar); }
        if (GRP_DELAY_NS != 0 && grouped && ph == 1) {
            const unsigned long long ticks_ = (unsigned long long)((blockIdx.x & 7) % GRP_DELAY_MOD) * (GRP_DELAY_NS / 10), t0_ = __builtin_amdgcn_s_memrealtime();
            while (__builtin_amdgcn_s_memrealtime() - t0_ < ticks_) __builtin_amdgcn_s_sleep(8);
        }
        TS_END(9); if (ph > 0 && (ph - 1) % 3 == 0) TS_END(93); if (ph > 0 && (ph - 1) % 3 == 1) TS_END(91); if (ph > 0 && (ph - 1) % 3 == 2) TS_END(92);
#if PROBE_DUP == 6
        if (ph > a.ph_lo) { if (ph == 1 || !grouped) xcd_barrier(gbar); else xcd_barrier(lbar); }
#endif
        size_t wz_ = 0; asm volatile("" : "+s"(wz_)); unsigned char* ws = a.p.ws + wz_;
        int vcu_ = F.vcu; asm volatile("" : "+s"(vcu_));
        Frame Fp; Fp.lds = F.lds; Fp.wave = F.wave; Fp.G = F.G; Fp.vcu = vcu_;
#if PROBE_DUP == 5
        if (ph == 0) {
#pragma unroll 1
            for (int rep = 0; rep < 2; ++rep) { p0_prologue(Fp, a); __syncthreads(); }
            continue; }
#endif
        if (ph == 0) { TS_BEGIN(10); p0_prologue(Fp, a); TS_END(10); continue; }
        const int l = (ph - 1) / 3, k = (ph - 1) % 3;
        if (k == 0) {
            TS_BEGIN(1); if (l == 0) TS_BEGIN(18); if (l == 3) TS_BEGIN(19);
            pg8::Gemm g{(const bf16_t*)(ws + OFF_XB), (const bf16_t*)(ws + OFF_WIN) + (size_t)l * IN_COLS * D_MODEL, MTOK, IN_COLS, D_MODEL};
            int bid_ = blockIdx.x; asm volatile("" : "+s"(bid_));
            pg8::StaticOrder S; S.init(MTOK, IN_COLS, Fp.G, bid_);
            pg8::EpiInProj E{ws, (const float*)(ws + OFF_ROWSS)};
#if PROBE_DUP == 1
#pragma unroll 1
            for (int rep = 0; rep < 2; ++rep)
#endif
            pg8::gemm_phase<pg8::EpiInProj, pg8::StaticOrder, true, true>(Fp.lds, g, S, E, Fp.wave, ts_sum, ts_t0);
            TS_END(1); if (l == 0) TS_END(18); if (l == 3) TS_END(19);
        }
#if EXP_HALF
        else if (EXP_HALF == 1 && (blockIdx.x & 7) >= 4) { }
#endif
        else if (k == 1) {
            TS_BEGIN(2);
#if PROBE_DUP == 2
#pragma unroll 1
            for (int rep = 0; rep < 2; ++rep)
#endif
            for (int u = Fp.vcu; u < BATCH * SSM_NG; u += Fp.G) s5::unit(Fp.lds, ws, l, u >> 5, u & 31, Fp.wave, inptr(a, IN_DSKIP) + l * SSM_W);
            TS_END(2); TS_BEGIN(3);
#if PROBE_DUP == 3
#pragma unroll 1
            for (int rep = 0; rep < 2; ++rep)
#endif
#if ATTN_WAVE
            wsa::phase(Fp, ws);
            __syncthreads();
#else
            attn_phase(Fp, ws, l, ts_sum, ts_t0);
#endif
            TS_END(3);
        }
        else {
            TS_BEGIN(4);
#if PROBE_DUP == 4
#pragma unroll 1
            for (int rep = 0; rep < 2; ++rep)
            for (int u = Fp.vcu; u < MTOK / 64; u += Fp.G) p4::unit(a, Fp.lds, ws, l, u, ts_sum, ts_t0, Fp.wave, rep == 0);
#else
#if EXP_HALF == 2
            if (!(Fp.vcu & 1)) for (int u = Fp.vcu; u < MTOK / 64; u += Fp.G) { for (int e = 0; e < 2; ++e) p4::unit(a, Fp.lds, ws, l, u + e, ts_sum, ts_t0, Fp.wave); }
#else
            for (int u = Fp.vcu; u < MTOK / 64; u += Fp.G) p4::unit(a, Fp.lds, ws, l, u, ts_sum, ts_t0, Fp.wave);
#endif
#endif
            TS_END(4);
        }
    }
    TS_END(100);
    if (TS_ID != 0 && blockIdx.x == 0 && tid_from(F.wave) == 0) { asm volatile("s_waitcnt vmcnt(0)" ::: "memory"); a.p.out[0] += (float)ts_sum * 0.001f; }
}

#ifndef ONE_LAUNCH
#define ONE_LAUNCH 1
#endif
#ifndef OPT_P0
#define OPT_P0 1
#endif
#ifndef OPT_P1
#define OPT_P1 1
#endif
#ifndef OPT_P2
#define OPT_P2 1
#endif
#ifndef OPT_P4
#define OPT_P4 1
#endif
extern "C" void kernel_launch(void* const* d_in, const int* in_sizes, int n_in, void* d_out, int out_size, void* d_ws, size_t ws_size, hipStream_t stream) {
    static int grid = 0;
    if (grid == 0) {
        if (n_in != 17 || out_size != MTOK * D_MODEL || ws_size < WS_END) { fprintf(stderr, "kernel_launch: unexpected shapes/workspace (n_in %d out %d ws %zu)\n", n_in, out_size, ws_size); grid = -1; return; }
        int dev = 0, cus = 0, per_cu = 0;
        if (hipGetDevice(&dev) != hipSuccess || hipDeviceGetAttribute(&cus, hipDeviceAttributeMultiprocessorCount, dev) != hipSuccess) { grid = -1; return; }
        if (hipFuncSetAttribute((const void*)mega, hipFuncAttributeMaxDynamicSharedMemorySize, LDS_BYTES) != hipSuccess) { fprintf(stderr, "kernel_launch: hipFuncSetAttribute failed\n"); grid = -1; return; }
        if (hipOccupancyMaxActiveBlocksPerMultiprocessor(&per_cu, (const void*)mega, NTHREADS, LDS_BYTES) != hipSuccess || per_cu < 1) { fprintf(stderr, "kernel_launch: occupancy query says %d blocks/CU\n", per_cu); per_cu = 1; }
        (void)hipGetLastError();
        grid = cus * (per_cu < 1 ? 1 : 1);
    }
    if (grid < 0) return;
    Params p{};
    for (int i = 0; i < N_IN; ++i) p.in[i] = (const float*)d_in[i];
    p.out = (float*)d_out; p.ws = (unsigned char*)d_ws;
    unsigned char* ws = p.ws;
#if ONE_LAUNCH
    (void)hipMemsetAsync(ws + OFF_CTL + (size_t)CW_BAR * 4, 0, (size_t)9 * XCD_BAR_WORDS * 4, stream);
#else
    (void)hipMemsetAsync(ws + OFF_CTL, 0, CTL_ZERO_BYTES, stream);
#endif
#if EXP_MEMSET2
    (void)hipMemsetAsync(ws + OFF_T2, 0, CTL_ZERO_BYTES, stream);
#endif
    int bar_region = 0;
    auto launch_mega = [&](int lo, int hi) { Args a{}; a.p = p; a.ph_lo = lo; a.ph_hi = hi; a.bar_region = bar_region++; a.pad = 0;
        hipLaunchKernelGGL(mega, dim3(grid), dim3(NTHREADS), LDS_BYTES, stream, a); };
    bf16_t* WIN = (bf16_t*)(ws + OFF_WIN); bf16_t* WGLU = (bf16_t*)(ws + OFF_WGLU); bf16_t* WBS = (bf16_t*)(ws + OFF_WBS); bf16_t* WBA = (bf16_t*)(ws + OFF_WBA); bf16_t* WOUT = (bf16_t*)(ws + OFF_WOUT);
    bf16_t* XB = (bf16_t*)(ws + OFF_XB); bf16_t* PROJ = (bf16_t*)(ws + OFF_PROJ); bf16_t* YPRE = (bf16_t*)(ws + OFF_YPRE); bf16_t* AO = (bf16_t*)(ws + OFF_AO);
    bf16_t* T2 = (bf16_t*)(ws + OFF_T2); bf16_t* T4 = (bf16_t*)(ws + OFF_T4); bf16_t* T5 = AO + (size_t)MTOK * ATT_W; float* OUTF = (float*)(ws + OFF_PROJ);
    const float* ROWSS = (const float*)(ws + OFF_ROWSS);
#if ONE_LAUNCH
    launch_mega(0, N_PHASES);
    return;
#endif
#if OPT_P0
    launch_mega(0, 1);
#else
    const dim3 tb(32, 8);
    for (int l = 0; l < DEPTH; ++l) {
        nv::k_transpose<<<dim3(IN_COLS / 32, D_MODEL / 32), tb, 0, stream>>>(p.in[IN_WIN] + (size_t)l * D_MODEL * IN_COLS, p.in[IN_PREG] + l * D_MODEL, WIN + (size_t)l * IN_COLS * D_MODEL, D_MODEL, IN_COLS);
        nv::k_transpose<<<dim3(SSM_W / 32, SSM_W / 32), tb, 0, stream>>>(p.in[IN_WGLU] + (size_t)l * SSM_W * SSM_W, nullptr, WGLU + (size_t)l * SSM_W * SSM_W, SSM_W, SSM_W);
        nv::k_transpose<<<dim3(D_MODEL / 32, SSM_W / 32), tb, 0, stream>>>(p.in[IN_WBS] + (size_t)l * SSM_W * D_MODEL, nullptr, WBS + (size_t)l * D_MODEL * SSM_W, SSM_W, D_MODEL);
        nv::k_transpose<<<dim3(D_MODEL / 32, ATT_W / 32), tb, 0, stream>>>(p.in[IN_WBA] + (size_t)l * ATT_W * D_MODEL, nullptr, WBA + (size_t)l * D_MODEL * ATT_W, ATT_W, D_MODEL);
        nv::k_transpose<<<dim3(D_MODEL / 32, D_MODEL / 32), tb, 0, stream>>>(p.in[IN_WOUT] + (size_t)l * D_MODEL * D_MODEL, nullptr, WOUT + (size_t)l * D_MODEL * D_MODEL, D_MODEL, D_MODEL);
    }
    nv::k_s5_tables<<<DEPTH * SSM_NG, 64, 0, stream>>>(p);
    nv::k_rows_x<<<MTOK, 256, 0, stream>>>(p);
#endif
    for (int l = 0; l < DEPTH; ++l) {
#if OPT_P1
        launch_mega(1 + 3 * l, 2 + 3 * l);
#else
        nv::k_gemm<nv::EpiInProj><<<dim3(IN_COLS / 128, MTOK / 128), 256, 0, stream>>>(XB, D_MODEL, WIN + (size_t)l * IN_COLS * D_MODEL, D_MODEL, D_MODEL, nv::EpiInProj{ROWSS, PROJ});
#endif
#if OPT_P2
        launch_mega(2 + 3 * l, 3 + 3 * l);
#else
        nv::k_attn<<<MTOK * 12 / 4, 256, 0, stream>>>(p);
        nv::k_s5<<<BATCH * SSM_NG, 64, 0, stream>>>(p, l);
#endif
#if OPT_P4
        launch_mega(3 + 3 * l, 4 + 3 * l);
#else
        nv::k_p4a<<<MTOK * SSM_W / 256, 256, 0, stream>>>(p, l);
        nv::k_gemm<nv::EpiGlu><<<dim3(SSM_W / 128, MTOK / 128), 256, 0, stream>>>(YPRE, SSM_W, WGLU + (size_t)l * SSM_W * SSM_W, SSM_W, SSM_W, nv::EpiGlu{YPRE, PROJ, p.in[IN_BGLU] + l * SSM_W, T2});
        nv::k_merge<<<MTOK * ATT_W / 256, 256, 0, stream>>>(p);
        nv::k_gemm<nv::EpiGate1><<<dim3(D_MODEL / 128, MTOK / 128), 256, 0, stream>>>(T2, SSM_W, WBS + (size_t)l * D_MODEL * SSM_W, SSM_W, SSM_W, nv::EpiGate1{PROJ, T4});
        nv::k_gemm<nv::EpiGate2><<<dim3(D_MODEL / 128, MTOK / 128), 256, 0, stream>>>(AO, ATT_W, WBA + (size_t)l * D_MODEL * ATT_W, ATT_W, ATT_W, nv::EpiGate2{PROJ, T4, T5});
        nv::k_gemm<nv::EpiF32><<<dim3(D_MODEL / 128, MTOK / 128), 256, 0, stream>>>(T5, D_MODEL, WOUT + (size_t)l * D_MODEL * D_MODEL, D_MODEL, D_MODEL, nv::EpiF32{OUTF, D_MODEL});
        nv::k_postnorm<<<MTOK, 256, 0, stream>>>(p, l, OUTF);
#endif
    }
}
```

```cpp
#include <hip/hip_runtime.h>
#include <cstdio>
#include <cstdint>
#ifndef ATTN_DMA
#define ATTN_DMA 3
#endif
#ifndef ATTN_WAVE
#define ATTN_WAVE 0
#endif
#ifndef EXP_MEMSET2
#define EXP_MEMSET2 0
#endif
#ifndef EXP_HALF
#define EXP_HALF 0
#endif
#ifndef EXP_NOSTORE
#define EXP_NOSTORE 0
#endif
#ifndef TS_ID
#define TS_ID 0
#endif
#ifndef P1_NT
#define P1_NT 0
#endif
#ifndef P1_SHAPE
#define P1_SHAPE 1
#endif
#ifndef W_TOUCH
#define W_TOUCH 1
#endif
#ifndef W_TOUCH2
#define W_TOUCH2 2
#endif
#ifndef P1_XROT
#define P1_XROT 1
#endif
#ifndef SEAM_RELAX
#define SEAM_RELAX 1
#endif
#ifndef GRP_DELAY_NS
#define GRP_DELAY_NS 0
#endif
#ifndef GRP_DELAY_MOD
#define GRP_DELAY_MOD 2
#endif
#define TS_BEGIN(id) do { if (TS_ID == (id)) ts_t0 = __builtin_amdgcn_s_memrealtime(); } while (0)
#define TS_END(id) do { if (TS_ID == (id)) ts_sum += __builtin_amdgcn_s_memrealtime() - ts_t0; } while (0)

constexpr int D_MODEL = 1024, BATCH = 8, SEQ = 2048, DEPTH = 4, MTOK = BATCH * SEQ;
constexpr int SSM_W = 512, SSM_CH = 16, SSM_NG = 32, SSM_P = 64;
constexpr int HD = 128, HPG = 4, NGRP = 3, ATT_W = 512, IN_COLS = 8192;
constexpr int C_US = 0, C_ZS = 512, C_Q = 1024, C_K = 2560, C_V = 4096, C_ZA = 5632, C_GS = 6144, C_GA = 7168;
constexpr int GZ_W = 1024, GZ_ZS = 0, GZ_ZA = 512, G8_W = 2048, G8_GS = 0, G8_GA = 1024;
constexpr float RMS_EPS = 1e-6f;
constexpr float ATT_C2 = 0.08838834764831845f * 1.4426950408889634f;

constexpr size_t MiB = 1u << 20;
constexpr size_t OFF_CTL = 0;
constexpr size_t OFF_WIN = 370 * MiB;
constexpr size_t OFF_WGLU = 434 * MiB;
constexpr size_t OFF_WBS = 436 * MiB;
constexpr size_t OFF_WBA = 440 * MiB;
constexpr size_t OFF_WOUT = 444 * MiB;
constexpr size_t OFF_S5 = 452 * MiB;
constexpr size_t OFF_XB = 473 * MiB;
constexpr size_t OFF_ROWSS = 505 * MiB;
constexpr size_t OFF_PROJ = 1 * MiB;
constexpr size_t OFF_GZ = OFF_PROJ, OFF_G8 = OFF_PROJ + 32 * MiB, OFF_QKV = OFF_PROJ + 96 * MiB;
constexpr size_t OFF_YPRE = 257 * MiB;
constexpr size_t OFF_AO = 273 * MiB;
constexpr size_t OFF_ALSE = 321 * MiB;
constexpr size_t OFF_T2 = 322 * MiB;
constexpr size_t OFF_UG = OFF_T2;
constexpr size_t OFF_T4 = 338 * MiB;
constexpr size_t WS_END = 506 * MiB;
constexpr size_t S5_A = 0;
constexpr size_t S5_BB = 1 * MiB;

typedef unsigned short bf16_t;
typedef short bf16x8 __attribute__((ext_vector_type(8)));
typedef float f32x4 __attribute__((ext_vector_type(4)));
typedef unsigned u32x4 __attribute__((ext_vector_type(4)));

__device__ __forceinline__ float bf2f(bf16_t h) { return __uint_as_float(((unsigned)h) << 16); }
__device__ __forceinline__ bf16_t f2bf(float f) { unsigned u = __float_as_uint(f); return (bf16_t)((u + 0x7fffu + ((u >> 16) & 1u)) >> 16); }
__device__ __forceinline__ float sigmoidf_(float v) { return 1.0f / (1.0f + __expf(-v)); }
__device__ __forceinline__ float siluf_(float v) { return v / (1.0f + __expf(-v)); }
__device__ __forceinline__ float gelu_tanh(float x) {
    const float z = 0.7978845608028654f * (x + 0.044715f * x * x * x);
    const float t = 1.0f - 2.0f / (1.0f + __expf(2.0f * z));
    return 0.5f * x * (1.0f + t);
}
__device__ __forceinline__ float wave_sum(float v) {
    v += __builtin_bit_cast(float, __builtin_amdgcn_ds_swizzle(__builtin_bit_cast(int, v), 0x041F));
    v += __builtin_bit_cast(float, __builtin_amdgcn_ds_swizzle(__builtin_bit_cast(int, v), 0x081F));
    v += __builtin_bit_cast(float, __builtin_amdgcn_ds_swizzle(__builtin_bit_cast(int, v), 0x101F));
    v += __builtin_bit_cast(float, __builtin_amdgcn_ds_swizzle(__builtin_bit_cast(int, v), 0x201F));
    v += __builtin_bit_cast(float, __builtin_amdgcn_ds_swizzle(__builtin_bit_cast(int, v), 0x401F));
    const auto rr = __builtin_amdgcn_permlane32_swap(__float_as_uint(v), __float_as_uint(v), false, false);
    return __uint_as_float(rr[0]) + __uint_as_float(rr[1]);
}
__device__ __forceinline__ float sig_fast(float v) { return __builtin_amdgcn_rcpf(1.0f + __builtin_amdgcn_exp2f(-1.4426950408889634f * v)); }
__device__ __forceinline__ float gelu_fast(float x) {
    const float z2 = 1.5957691216057308f * (x + 0.044715f * x * x * x);
    return x * sig_fast(z2);
}
__device__ __forceinline__ float blo(unsigned w) { return __uint_as_float(w << 16); }
__device__ __forceinline__ float bhi(unsigned w) { return __uint_as_float(w & 0xffff0000u); }
enum { IN_X = 0, IN_PREG, IN_WIN, IN_LRE, IN_LIM, IN_LDT, IN_BRE, IN_BIM, IN_CRE, IN_CIM, IN_DSKIP, IN_WGLU, IN_BGLU, IN_WBS, IN_WBA, IN_WOUT, IN_POSTG, N_IN };
struct Params { const float* in[N_IN]; float* out; unsigned char* ws; };
__device__ __forceinline__ int tid_from(int wave_s) { unsigned z = 0u; asm volatile("" : "+v"(z)); return (wave_s << 6) | (int)__builtin_amdgcn_mbcnt_hi(~0u, __builtin_amdgcn_mbcnt_lo(~0u, z)); }

namespace nv {
__global__ void k_transpose(const float* __restrict__ W, const float* __restrict__ rs, bf16_t* __restrict__ Wt, int K, int N) {
    __shared__ float tile[32][33];
    const int n0 = blockIdx.x * 32, k0 = blockIdx.y * 32, tx = threadIdx.x, ty = threadIdx.y;
    for (int i = ty; i < 32; i += 8) { const int k = k0 + i; tile[i][tx] = W[(size_t)k * N + n0 + tx] * (rs ? rs[k] : 1.0f); }
    __syncthreads();
    for (int i = ty; i < 32; i += 8) { const int n = n0 + i; Wt[(size_t)n * K + k0 + tx] = f2bf(tile[tx][i]); }
}
__global__ void k_s5_tables(Params p) {
    const int lg = blockIdx.x, pp = threadIdx.x, idx = lg * 64 + pp;
    const float lre = fminf(p.in[IN_LRE][idx], -1e-4f), lim = p.in[IN_LIM][idx], dt = expf(p.in[IN_LDT][lg]);
    const float a = lre * dt, b = lim * dt, ea = expf(a), sb = sinf(b), cb = cosf(b);
    const float Are = ea * cb, Aim = ea * sb, sh = sinf(0.5f * b);
    const float Dre = expm1f(a) * cb - 2.0f * sh * sh, Dim = Aim;
    const float den = lre * lre + lim * lim;
    const float cre = (Dre * lre + Dim * lim) / den, cim = (Dim * lre - Dre * lim) / den;
    float* A = (float*)(p.ws + OFF_S5 + S5_A); float* Bb = (float*)(p.ws + OFF_S5 + S5_BB);
    A[idx * 2] = Are; A[idx * 2 + 1] = Aim;
    for (int c = 0; c < 16; ++c) { const float br = p.in[IN_BRE][idx * 16 + c], bi = p.in[IN_BIM][idx * 16 + c];
        Bb[(idx * 16 + c) * 2] = cre * br - cim * bi; Bb[(idx * 16 + c) * 2 + 1] = cre * bi + cim * br; }
}
__global__ void k_rows_x(Params p) {
    const int row = blockIdx.x, t = threadIdx.x;
    const f32x4 v = ((const f32x4*)(p.in[IN_X] + (size_t)row * D_MODEL))[t];
    ((f32x4*)(p.out + (size_t)row * D_MODEL))[t] = v;
    bf16_t* xb = (bf16_t*)(p.ws + OFF_XB) + (size_t)row * D_MODEL + t * 4;
    xb[0] = f2bf(v[0]); xb[1] = f2bf(v[1]); xb[2] = f2bf(v[2]); xb[3] = f2bf(v[3]);
    float ss = wave_sum(v[0] * v[0] + v[1] * v[1] + v[2] * v[2] + v[3] * v[3]);
    __shared__ float s[4];
    if ((t & 63) == 0) s[t >> 6] = ss;
    __syncthreads();
    if (t == 0) ((float*)(p.ws + OFF_ROWSS))[row] = s[0] + s[1] + s[2] + s[3];
}
template <class Epi> __global__ __launch_bounds__(256) void k_gemm(const bf16_t* __restrict__ A, int lda, const bf16_t* __restrict__ Bt, int ldb, int K, Epi epi) {
    const int tid = threadIdx.x, wave = tid >> 6, lane = tid & 63, wr = wave >> 1, wc = wave & 1;
    const int row0 = blockIdx.y * 128 + wr * 64, col0 = blockIdx.x * 128 + wc * 64;
    f32x4 acc[4][4];
    for (int i = 0; i < 4; ++i) for (int j = 0; j < 4; ++j) acc[i][j] = (f32x4){0.f, 0.f, 0.f, 0.f};
    const bf16_t* ap = A + (size_t)(row0 + (lane & 15)) * lda + 8 * (lane >> 4);
    const bf16_t* bp = Bt + (size_t)(col0 + (lane & 15)) * ldb + 8 * (lane >> 4);
    for (int k0 = 0; k0 < K; k0 += 32) {
        bf16x8 a[4], b[4];
#pragma unroll
        for (int i = 0; i < 4; ++i) { a[i] = *(const bf16x8*)(ap + (size_t)i * 16 * lda + k0); b[i] = *(const bf16x8*)(bp + (size_t)i * 16 * ldb + k0); }
#pragma unroll
        for (int i = 0; i < 4; ++i)
#pragma unroll
            for (int j = 0; j < 4; ++j) acc[i][j] = __builtin_amdgcn_mfma_f32_16x16x32_bf16(a[i], b[j], acc[i][j], 0, 0, 0);
    }
#pragma unroll
    for (int i = 0; i < 4; ++i)
#pragma unroll
        for (int j = 0; j < 4; ++j)
#pragma unroll
            for (int r = 0; r < 4; ++r) epi(row0 + i * 16 + (lane >> 4) * 4 + r, col0 + j * 16 + (lane & 15), acc[i][j][r]);
}
struct EpiInProj { const float* rowss; bf16_t* proj;
    __device__ void operator()(int row, int col, float acc) const {
        float v = acc * rsqrtf(rowss[row] * (1.0f / D_MODEL) + RMS_EPS);
        if ((col >= C_ZS && col < C_Q) || (col >= C_ZA && col < C_GS)) v = siluf_(v);
        else if (col >= C_GS) v = sigmoidf_(v);
        proj[(size_t)row * IN_COLS + col] = f2bf(v);
    } };
struct EpiGlu { const bf16_t* y1; const bf16_t* proj; const float* b_glu; bf16_t* ys;
    __device__ void operator()(int row, int col, float acc) const {
        const float gate = sigmoidf_(acc + b_glu[col]);
        ys[(size_t)row * SSM_W + col] = f2bf(bf2f(y1[(size_t)row * SSM_W + col]) * gate * bf2f(proj[(size_t)row * IN_COLS + C_ZS + col]));
    } };
struct EpiGate1 { const bf16_t* proj; bf16_t* m1;
    __device__ void operator()(int row, int col, float acc) const { m1[(size_t)row * D_MODEL + col] = f2bf(bf2f(proj[(size_t)row * IN_COLS + C_GS + col]) * acc); } };
struct EpiGate2 { const bf16_t* proj; const bf16_t* m1; bf16_t* mg;
    __device__ void operator()(int row, int col, float acc) const {
        mg[(size_t)row * D_MODEL + col] = f2bf(bf2f(m1[(size_t)row * D_MODEL + col]) + bf2f(proj[(size_t)row * IN_COLS + C_GA + col]) * acc); } };
struct EpiF32 { float* C; int ldc;
    __device__ void operator()(int row, int col, float acc) const { C[(size_t)row * ldc + col] = acc; } };

__global__ __launch_bounds__(256) void k_attn(Params p) {
    const int wave = threadIdx.x >> 6, lane = threadIdx.x & 63;
    const long wid = (long)blockIdx.x * 4 + wave;
    const int j = (int)(wid & 3), gi = (int)((wid >> 2) % 3), tok = (int)(wid / 12);
    const int d = gi == 0 ? 1 : (gi == 1 ? 4 : 16);
    const int t = tok % SEQ, i = t / d;
    const bf16_t* proj = (const bf16_t*)(p.ws + OFF_PROJ);
    const int hc = (gi * 4 + j) * HD + 2 * lane;
    const unsigned qq = *(const unsigned*)(proj + (size_t)tok * IN_COLS + C_Q + hc);
    const float q0 = bf2f((bf16_t)(qq & 0xffff)), q1 = bf2f((bf16_t)(qq >> 16));
    float m = -1e30f, l = 0.f, o0 = 0.f, o1 = 0.f;
    const int nk = i < 128 ? i : 128;
    for (int jj = nk; jj >= 0; --jj) {
        const size_t kt = (size_t)(tok - jj * d);
        const unsigned kk = *(const unsigned*)(proj + kt * IN_COLS + C_K + hc);
        const unsigned vv = *(const unsigned*)(proj + kt * IN_COLS + C_V + hc);
        float s = q0 * bf2f((bf16_t)(kk & 0xffff)) + q1 * bf2f((bf16_t)(kk >> 16));
        s = wave_sum(s) * ATT_C2;
        const float mn = fmaxf(m, s), al = exp2f(m - mn), pr = exp2f(s - mn);
        l = l * al + pr; o0 = o0 * al + pr * bf2f((bf16_t)(vv & 0xffff)); o1 = o1 * al + pr * bf2f((bf16_t)(vv >> 16)); m = mn;
    }
    const float il = 1.0f / l;
    bf16_t* ao = (bf16_t*)(p.ws + OFF_AO) + ((size_t)gi * MTOK + tok) * ATT_W + j * HD + 2 * lane;
    *(unsigned*)ao = (unsigned)f2bf(o0 * il) | ((unsigned)f2bf(o1 * il) << 16);
    if (lane == 0) ((float*)(p.ws + OFF_ALSE))[((size_t)gi * MTOK + tok) * 4 + j] = m + log2f(l);
}
__global__ __launch_bounds__(64) void k_s5(Params p, int layer) {
    const int b = blockIdx.x >> 5, g = blockIdx.x & 31, lane = threadIdx.x;
    const int idx = ((layer * 32 + g) * 64 + lane);
    const float* A = (const float*)(p.ws + OFF_S5 + S5_A); const float* Bb = (const float*)(p.ws + OFF_S5 + S5_BB);
    const float Are = A[idx * 2], Aim = A[idx * 2 + 1];
    float bre[16], bim[16], cre[16], cim[16];
#pragma unroll
    for (int c = 0; c < 16; ++c) { bre[c] = Bb[(idx * 16 + c) * 2]; bim[c] = Bb[(idx * 16 + c) * 2 + 1];
        cre[c] = p.in[IN_CRE][(size_t)((layer * 32 + g) * 16 + c) * 64 + lane]; cim[c] = p.in[IN_CIM][(size_t)((layer * 32 + g) * 16 + c) * 64 + lane]; }
    const bf16_t* proj = (const bf16_t*)(p.ws + OFF_PROJ); bf16_t* ypre = (bf16_t*)(p.ws + OFF_YPRE);
    float sre = 0.f, sim = 0.f;
    for (int t = 0; t < SEQ; ++t) {
        const size_t tok = (size_t)b * SEQ + t;
        const bf16x8 u0 = *(const bf16x8*)(proj + tok * IN_COLS + C_US + g * 16), u1 = *(const bf16x8*)(proj + tok * IN_COLS + C_US + g * 16 + 8);
        float dre = 0.f, dim = 0.f;
#pragma unroll
        for (int c = 0; c < 8; ++c) { const float ua = bf2f((bf16_t)u0[c]), ub = bf2f((bf16_t)u1[c]);
            dre += bre[c] * ua + bre[c + 8] * ub; dim += bim[c] * ua + bim[c + 8] * ub; }
        const float nre = Are * sre - Aim * sim + dre, nim = Are * sim + Aim * sre + dim;
        sre = nre; sim = nim;
        float mine = 0.f;
#pragma unroll
        for (int c = 0; c < 16; ++c) { const float y = wave_sum(cre[c] * sre - cim[c] * sim); if (lane == c) mine = y; }
        if (lane < 16) ypre[tok * SSM_W + g * 16 + lane] = f2bf(mine);
    }
}
__global__ void k_p4a(Params p, int layer) {
    const size_t e = (size_t)blockIdx.x * 256 + threadIdx.x; const size_t row = e >> 9; const int col = (int)(e & 511);
    bf16_t* ypre = (bf16_t*)(p.ws + OFF_YPRE); const bf16_t* proj = (const bf16_t*)(p.ws + OFF_PROJ);
    const float y0 = bf2f(ypre[e]) + p.in[IN_DSKIP][layer * SSM_W + col] * bf2f(proj[row * IN_COLS + C_US + col]);
    ypre[e] = f2bf(gelu_tanh(y0));
}
__global__ void k_merge(Params p) {
    const size_t e = (size_t)blockIdx.x * 256 + threadIdx.x; const size_t row = e >> 9; const int col = (int)(e & 511), j = col >> 7;
    bf16_t* ao = (bf16_t*)(p.ws + OFF_AO); const float* ls = (const float*)(p.ws + OFF_ALSE); const bf16_t* proj = (const bf16_t*)(p.ws + OFF_PROJ);
    const float l0 = ls[((size_t)0 * MTOK + row) * 4 + j], l1 = ls[((size_t)1 * MTOK + row) * 4 + j], l2 = ls[((size_t)2 * MTOK + row) * 4 + j];
    const float mx = fmaxf(l0, fmaxf(l1, l2)), w0 = exp2f(l0 - mx), w1 = exp2f(l1 - mx), w2 = exp2f(l2 - mx);
    const float y = (w0 * bf2f(ao[e]) + w1 * bf2f(ao[(size_t)MTOK * ATT_W + e]) + w2 * bf2f(ao[(size_t)2 * MTOK * ATT_W + e])) / (w0 + w1 + w2);
    ao[e] = f2bf(y * bf2f(proj[row * IN_COLS + C_ZA + col]));
}
__global__ void k_postnorm(Params p, int layer, const float* o) {
    const int row = blockIdx.x, t = threadIdx.x;
    const f32x4 v = ((const f32x4*)(o + (size_t)row * D_MODEL))[t];
    __shared__ float s[4], s2[4];
    float ss = wave_sum(v[0] * v[0] + v[1] * v[1] + v[2] * v[2] + v[3] * v[3]);
    if ((t & 63) == 0) s[t >> 6] = ss;
    __syncthreads();
    const float inv = rsqrtf((s[0] + s[1] + s[2] + s[3]) * (1.0f / D_MODEL) + RMS_EPS);
    const f32x4 g = ((const f32x4*)(p.in[IN_POSTG] + layer * D_MODEL))[t];
    f32x4 xv = ((f32x4*)(p.out + (size_t)row * D_MODEL))[t];
    xv = xv + v * inv * g;
    ((f32x4*)(p.out + (size_t)row * D_MODEL))[t] = xv;
    bf16_t* xb = (bf16_t*)(p.ws + OFF_XB) + (size_t)row * D_MODEL + t * 4;
    xb[0] = f2bf(xv[0]); xb[1] = f2bf(xv[1]); xb[2] = f2bf(xv[2]); xb[3] = f2bf(xv[3]);
    float q = wave_sum(xv[0] * xv[0] + xv[1] * xv[1] + xv[2] * xv[2] + xv[3] * xv[3]);
    if ((t & 63) == 0) s2[t >> 6] = q;
    __syncthreads();
    if (t == 0) ((float*)(p.ws + OFF_ROWSS))[row] = s2[0] + s2[1] + s2[2] + s2[3];
}
}

namespace pg8 {
#define PG8_LAS __attribute__((address_space(3)))
typedef unsigned short bf16_t;
typedef short bf16x8 __attribute__((ext_vector_type(8)));
typedef float f32x4 __attribute__((ext_vector_type(4)));
typedef unsigned u32x4 __attribute__((ext_vector_type(4)));
constexpr int BM = 256, BK = 64, HALF = 128, HTB = HALF * BK * 2  , STAGE_BYTES = 8 * HTB, NXCD = 8, WGM = 8;

__host__ __device__ __forceinline__ int lds_byte(int r, int c) { const int st = (r >> 4) * 2 + (c >> 5), rr = r & 15, cc = c & 31, ob = rr * 64 + cc * 2; return st * 1024 + (ob ^ (((ob >> 9) & 1) << 5)); }
__host__ __device__ __forceinline__ void stage_rc(int b, int& R, int& C) { const int st = b / 1024, sb = b % 1024, swz = sb ^ (((sb >> 9) & 1) << 5); R = (st >> 1) * 16 + swz / 64; C = (st & 1) * 32 + (swz % 64) / 2; }
__host__ __device__ __forceinline__ int perm32(int rho) { const int n = rho >> 4, i = rho & 15; return 8 * (i >> 2) + 4 * n + (i & 3); }

struct Unit { int pm, pn; };
struct Gemm { const bf16_t* A; const bf16_t* Bt; int M, N, K, rot = 0; };

struct StaticOrder {
    int nM, nN, nwg, G, c;
    __host__ __device__ void init(int M, int N, int G_, int c_) { nM = M / BM; nN = N / BM; nwg = nM * nN; G = G_; c = c_; }
    __host__ __device__ bool next(int i, Unit& u) const {
        const long L = (long)i * G + c; if (L >= nwg) return false;
        int wgid = (int)L; { const int q = nwg / NXCD, r = nwg % NXCD, xcd = wgid % NXCD, off = wgid / NXCD; wgid = (xcd < r ? xcd * (q + 1) : r * (q + 1) + (xcd - r) * q) + off; }
        const int nig = WGM * nN, gid = wgid / nig, fm = gid * WGM, gsz = (nM - fm) < WGM ? (nM - fm) : WGM;
        u.pm = fm + ((wgid % nig) % gsz); u.pn = (wgid % nig) / gsz;
        if (P1_SHAPE && G == 256 && nM == 64 && nN == 32) {
            const int b = c % 8, j = c / 8;
            u.pm = b * 8 + 4 * (i >> 2) + (j & 3); u.pn = 8 * ((i + b) & 3) + (j >> 2);
        }
        return true;
    }
    __device__ __forceinline__ void a_ready(const Unit&) const {}
    __device__ __forceinline__ void done(const Unit&) const {}
};

__device__ __forceinline__ unsigned cvt_pk_bf16(float lo, float hi) { unsigned r; asm volatile("v_cvt_pk_bf16_f32 %0, %1, %2" : "=v"(r) : "v"(lo), "v"(hi)); return r; }
template <class Epi, class Sched, bool ALIGN_EPI = false, bool SP2 = false>
__device__ __forceinline__ void gemm_phase(PG8_LAS unsigned char* lds, const Gemm g, const Sched& S, const Epi& E, int wave_s, unsigned long long& ts_sum, unsigned long long& ts_t0) {
    const int tid = tid_from(wave_s), wid = wave_s, lane = tid & 63, wr = wid >> 2, wc = wid & 3, fr = lane & 15, fq = lane >> 4;
    const int K = g.K, nt = K / BK;
    unsigned voffA[2], voffB[2];
#pragma unroll
    for (int i = 0; i < 2; ++i) { int R, C; stage_rc(tid * 16 + i * 8192, R, C); const int Rb = Epi::PERM ? ((R & ~31) + perm32(R & 31)) : R;
        voffA[i] = (unsigned)(R * K + C) * 2u; voffB[i] = (unsigned)(Rb * K + C) * 2u; }
    const size_t kstep = (size_t)(BK * 2);
    const size_t hstep = (size_t)HALF * K * 2;
    const size_t tstep = 2 * hstep;
    const unsigned ldsw = (unsigned)wid * 1024u;
    const int aoff = lds_byte(wr * 64 + fr, fq * 8), boff = lds_byte(wc * 32 + fr, fq * 8);
#define PG8_SA(b, h) (((b) * 2 + (h)) * HTB)
#define PG8_SB(b, h) ((4 + (b) * 2 + (h)) * HTB)
#define PG8_STAGE(bufoff, gbase, voff) do { _Pragma("unroll") for (int _i = 0; _i < 2; ++_i) \
        __builtin_amdgcn_global_load_lds((const unsigned*)((const char*)(gbase) + (voff)[_i]), (PG8_LAS unsigned*)(lds + (bufoff) + ldsw + _i * 8192), 16, 0, 0); } while (0)
#define PG8_LDA(dst, b, h) do { _Pragma("unroll") for (int m = 0; m < 4; ++m) _Pragma("unroll") for (int k = 0; k < 2; ++k) dst[m][k] = *(const PG8_LAS bf16x8*)(lds + PG8_SA(b, h) + aoff + m * 2048 + k * 1024); } while (0)
#define PG8_LDB(dst, b, h) do { _Pragma("unroll") for (int n = 0; n < 2; ++n) _Pragma("unroll") for (int k = 0; k < 2; ++k) dst[n][k] = *(const PG8_LAS bf16x8*)(lds + PG8_SB(b, h) + boff + n * 2048 + k * 1024); } while (0)
#define PG8_MMA(ai, bj, At, Bt) do { __builtin_amdgcn_s_setprio(1); _Pragma("unroll") for (int m = 0; m < 4; ++m) _Pragma("unroll") for (int n = 0; n < 2; ++n) _Pragma("unroll") for (int k = 0; k < 2; ++k) \
        acc[ai][bj][m][n] = __builtin_amdgcn_mfma_f32_16x16x32_bf16(Bt[n][k], At[m][k], acc[ai][bj][m][n], 0, 0, 0); __builtin_amdgcn_s_setprio(0); } while (0)
#define PG8_WAIT_V(n) asm volatile("s_waitcnt vmcnt(" #n ")" ::: "memory")
#define PG8_WAIT_L(n) asm volatile("s_waitcnt lgkmcnt(" #n ")" ::: "memory")
#define PG8_BAR __builtin_amdgcn_s_barrier()
#define PG8_SCHED __builtin_amdgcn_sched_barrier(0)
    Unit cur, nxt; int ui = 0;
    if (!S.next(0, cur)) return;
    f32x4 acc[2][2][4][2];
#pragma unroll
    for (int a = 0; a < 2; ++a)
#pragma unroll
        for (int b = 0; b < 2; ++b)
#pragma unroll
            for (int m = 0; m < 4; ++m)
#pragma unroll
                for (int n = 0; n < 2; ++n) acc[a][b][m][n] = (f32x4){0.f, 0.f, 0.f, 0.f};
    bf16x8 At[4][2], B0[2][2], B1[2][2];
    const char* cA = (const char*)g.A + (size_t)cur.pm * tstep; const char* cB = (const char*)g.Bt + (size_t)cur.pn * tstep;
    const size_t r0 = (size_t)g.rot * kstep;
    S.a_ready(cur);
    if constexpr (SP2) {
        PG8_STAGE(PG8_SB(0, 0), cB + r0, voffB); PG8_STAGE(PG8_SB(0, 1), cB + r0 + hstep, voffB); PG8_STAGE(PG8_SA(0, 0), cA + r0, voffA); PG8_STAGE(PG8_SA(0, 1), cA + r0 + hstep, voffA);
        if (wr == 1) PG8_BAR;
        PG8_WAIT_V(2); PG8_BAR;
        PG8_STAGE(PG8_SB(1, 0), cB + r0 + kstep, voffB); PG8_STAGE(PG8_SA(1, 0), cA + r0 + kstep, voffA); PG8_STAGE(PG8_SB(1, 1), cB + r0 + hstep + kstep, voffB);
        PG8_WAIT_V(6); PG8_BAR;
    } else {
        PG8_STAGE(PG8_SB(0, 0), cB + r0, voffB); PG8_STAGE(PG8_SA(0, 0), cA + r0, voffA); PG8_STAGE(PG8_SB(0, 1), cB + r0 + hstep, voffB); PG8_STAGE(PG8_SA(0, 1), cA + r0 + hstep, voffA);
        if (wr == 1) PG8_BAR;
        PG8_WAIT_V(4); PG8_BAR;
        PG8_STAGE(PG8_SB(1, 0), cB + r0 + kstep, voffB); PG8_STAGE(PG8_SA(1, 0), cA + r0 + kstep, voffA); PG8_STAGE(PG8_SB(1, 1), cB + r0 + hstep + kstep, voffB);
        PG8_WAIT_V(6); PG8_BAR;
    }
    for (;;) {
        const bool has_next = S.next(ui + 1, nxt);
        const char* nA = has_next ? (const char*)g.A + (size_t)nxt.pm * tstep : cA; const char* nB = has_next ? (const char*)g.Bt + (size_t)nxt.pn * tstep : cB;
        if constexpr (Epi::ROWSUMS)
            __builtin_amdgcn_global_load_lds((const unsigned*)(E.rowss + cur.pm * BM + 32 * wid + (tid_from(wave_s) & 31)), (PG8_LAS unsigned*)(lds + STAGE_BYTES + (ui & 1) * 2048 + wid * 256), 4, 0, 0);
        for (int t = 0; t < nt; t += 2) {
            const bool last = (t == nt - 2);
            const char* a1 = cA + (size_t)(((t + g.rot) & (nt - 1)) + 1) * kstep;
            const size_t o2 = (size_t)((t + 2 + g.rot) & (nt - 1)) * kstep;
            const char* a2 = last ? nA + r0 : cA + o2; const char* b2 = last ? nB + r0 : cB + o2;
            const char* a3 = a2 + kstep; const char* b3 = b2 + kstep;
            if (last && has_next) S.a_ready(nxt);
            if constexpr (SP2) {
            const unsigned seam = (unsigned)__builtin_amdgcn_readfirstlane((Epi::ROWSUMS && SEAM_RELAX && t == 0 && ui > 0) ? 1 : 0);
            PG8_LDB(B0, 0, 0); PG8_LDB(B1, 0, 1); PG8_SCHED; PG8_LDA(At, 0, 0); PG8_STAGE(PG8_SA(1, 1), a1 + hstep, voffA);
            asm volatile("s_waitcnt vmcnt(25)\n\ts_cmp_lg_u32 %0, 0\n\ts_cbranch_scc1 1\n\ts_waitcnt vmcnt(8)" :: "s"(seam) : "scc", "memory");
            PG8_WAIT_L(0); PG8_BAR; PG8_MMA(0, 0, At, B0); PG8_MMA(0, 1, At, B1); PG8_BAR; PG8_SCHED;
            PG8_LDA(At, 0, 1); PG8_STAGE(PG8_SB(0, 0), b2, voffB); PG8_STAGE(PG8_SB(0, 1), b2 + hstep, voffB); PG8_STAGE(PG8_SA(0, 0), a2, voffA);
            asm volatile("s_waitcnt vmcnt(25)\n\ts_cmp_lg_u32 %0, 0\n\ts_cbranch_scc1 1\n\ts_waitcnt vmcnt(8)" :: "s"(seam) : "scc", "memory");
            PG8_WAIT_L(0); PG8_BAR; PG8_MMA(1, 0, At, B0); PG8_MMA(1, 1, At, B1); PG8_BAR; PG8_SCHED;
            PG8_LDB(B0, 1, 0); PG8_LDB(B1, 1, 1); PG8_SCHED; PG8_LDA(At, 1, 0); PG8_STAGE(PG8_SA(0, 1), a2 + hstep, voffA);
            PG8_WAIT_V(8); PG8_WAIT_L(0); PG8_BAR; PG8_MMA(0, 0, At, B0); PG8_MMA(0, 1, At, B1); PG8_BAR; PG8_SCHED;
            PG8_LDA(At, 1, 1); PG8_STAGE(PG8_SB(1, 0), b3, voffB); PG8_STAGE(PG8_SB(1, 1), b3 + hstep, voffB); PG8_STAGE(PG8_SA(1, 0), a3, voffA);
            PG8_WAIT_V(8); PG8_WAIT_L(0); PG8_BAR; PG8_MMA(1, 0, At, B0); PG8_MMA(1, 1, At, B1); PG8_BAR; PG8_SCHED;
            } else {
            PG8_LDB(B0, 0, 0); PG8_SCHED; PG8_LDA(At, 0, 0); PG8_STAGE(PG8_SA(1, 1), a1 + hstep, voffA);
            PG8_WAIT_L(8); PG8_BAR; PG8_WAIT_L(0); PG8_MMA(0, 0, At, B0); PG8_BAR; PG8_SCHED;
            PG8_LDB(B1, 0, 1); PG8_STAGE(PG8_SB(0, 0), b2, voffB);
            PG8_BAR; PG8_WAIT_L(0); PG8_MMA(0, 1, At, B1); PG8_BAR;
            PG8_LDA(At, 0, 1); PG8_STAGE(PG8_SA(0, 0), a2, voffA);
            PG8_BAR; PG8_WAIT_L(0); PG8_MMA(1, 0, At, B0); PG8_BAR; PG8_SCHED;
            PG8_STAGE(PG8_SB(0, 1), b2 + hstep, voffB);
            PG8_WAIT_V(6); PG8_BAR; PG8_MMA(1, 1, At, B1); PG8_BAR;
            PG8_LDB(B0, 1, 0); PG8_SCHED; PG8_LDA(At, 1, 0); PG8_STAGE(PG8_SA(0, 1), a2 + hstep, voffA);
            PG8_WAIT_L(8); PG8_BAR; PG8_WAIT_L(0); PG8_MMA(0, 0, At, B0); PG8_BAR; PG8_SCHED;
            PG8_LDB(B1, 1, 1); PG8_STAGE(PG8_SB(1, 0), b3, voffB);
            PG8_BAR; PG8_WAIT_L(0); PG8_MMA(0, 1, At, B1); PG8_BAR;
            PG8_LDA(At, 1, 1); PG8_STAGE(PG8_SA(1, 0), a3, voffA);
            PG8_BAR; PG8_WAIT_L(0); PG8_MMA(1, 0, At, B0); PG8_BAR; PG8_SCHED;
            PG8_STAGE(PG8_SB(1, 1), b3 + hstep, voffB);
            PG8_WAIT_V(6); PG8_BAR; PG8_MMA(1, 1, At, B1); PG8_BAR;
            }
        }
        if constexpr (ALIGN_EPI) { if (wr == 0) PG8_BAR; }
        TS_BEGIN(11);
        if constexpr (!Epi::AFTER_DRAIN) { E(acc, cur, wr, wc, fr, fq, (const PG8_LAS float*)(lds + STAGE_BYTES + (ui & 1) * 2048)); S.done(cur); }
        TS_END(11);
        if (!has_next) break;
#pragma unroll
        for (int a = 0; a < 2; ++a)
#pragma unroll
            for (int b = 0; b < 2; ++b)
#pragma unroll
                for (int m = 0; m < 4; ++m)
#pragma unroll
                    for (int n = 0; n < 2; ++n) acc[a][b][m][n] = (f32x4){0.f, 0.f, 0.f, 0.f};
        cur = nxt; cA = nA; cB = nB; ++ui;
        if constexpr (ALIGN_EPI) { if (wr == 1) PG8_BAR; }
    }
    PG8_WAIT_V(0);
    if constexpr (!ALIGN_EPI) { if (wr == 0) PG8_BAR; }
    PG8_BAR;
    if constexpr (Epi::AFTER_DRAIN) { E.fused(acc, cur, wr, wc, fr, fq, lds, wid, lane); S.done(cur); }
#undef PG8_SA
#undef PG8_SB
#undef PG8_STAGE
#undef PG8_LDA
#undef PG8_LDB
#undef PG8_MMA
#undef PG8_WAIT_V
#undef PG8_WAIT_L
#undef PG8_BAR
#undef PG8_SCHED
}
}

namespace pg8 {
struct EpiInProj {
    static constexpr bool PERM = true, AFTER_DRAIN = false, ROWSUMS = true;
    unsigned char* ws; const float* rowss;
    __device__ __forceinline__ void operator()(const f32x4 (&acc)[2][2][4][2], const Unit& u, int wr, int wc, int fr, int fq, const PG8_LAS float* rs) const {
        const int row0 = u.pm * BM + wr * 64 + fr, colt = u.pn * BM, cl = wc * 32 + 8 * fq;
        const int mode = (colt >= C_GS) ? 2 : (((colt >= C_ZS && colt < C_Q) || (colt >= C_ZA && colt < C_GS)) ? 1 : 0);
        bf16_t* base; int kind = 0, sh = 0; size_t bjs;
        if (colt < C_ZS) { base = (bf16_t*)(ws + OFF_UG) + (size_t)(colt >> 4) * SEQ * 16; bjs = (size_t)8 * SEQ * 16; kind = 1; }
        else if (colt < C_Q) { base = (bf16_t*)(ws + OFF_GZ) + GZ_ZS + (colt - C_ZS); bjs = HALF; }
        else if (colt < C_ZA) { const int j = (colt - C_Q) >> 8, kd = j / 6, jj = j - 6 * kd, gi = jj >> 1; sh = 2 * gi; kind = 2;
            base = (bf16_t*)(ws + OFF_QKV) + ((size_t)((kd * 3 + gi) * BATCH) * HPG + 2 * (jj & 1)) * SEQ * HD; bjs = (size_t)SEQ * HD; }
        else if (colt < C_GS) { base = (bf16_t*)(ws + OFF_GZ) + GZ_ZA + (colt - C_ZA); bjs = HALF; }
        else { base = (bf16_t*)(ws + OFF_G8); bjs = HALF; kind = 3; }
        float inv[2][4];
#pragma unroll
        for (int ai = 0; ai < 2; ++ai)
#pragma unroll
            for (int m = 0; m < 4; ++m) { const int rl = wr * 64 + fr + ai * HALF + m * 16; inv[ai][m] = rsqrtf(rs[(rl >> 5) * 64 + (rl & 31)] * (1.0f / D_MODEL) + RMS_EPS); }
#pragma unroll
        for (int ai = 0; ai < 2; ++ai)
#pragma unroll
            for (int m = 0; m < 4; ++m) {
                const int row = row0 + ai * HALF + m * 16, b = row >> 11, t = row & (SEQ - 1);
                unsigned ro;
                if (kind == 3) { const unsigned go = (unsigned)row * G8_W + (unsigned)(colt - C_GS) + (unsigned)cl;
#pragma unroll
                    for (int bj = 0; bj < 2; ++bj) { const f32x4 v0 = acc[ai][bj][m][0] * inv[ai][m], v1 = acc[ai][bj][m][1] * inv[ai][m]; unsigned lo = 0u, hi = 0u;
#pragma unroll
                        for (int e = 0; e < 4; ++e) { const float s0 = __builtin_amdgcn_rcpf(1.0f + __builtin_amdgcn_exp2f(-1.4426950408889634f * v0[e])), s1 = __builtin_amdgcn_rcpf(1.0f + __builtin_amdgcn_exp2f(-1.4426950408889634f * v1[e]));
                            lo |= (unsigned)(s0 * 255.0f + 0.5f) << (8 * e); hi |= (unsigned)(s1 * 255.0f + 0.5f) << (8 * e); }
                        { typedef unsigned u32x2g __attribute__((ext_vector_type(2))); const u32x2g gw_ = {lo, hi};
                          asm volatile("global_store_dwordx2 %0, %1, %2" :: "v"(go + (unsigned)(bj * HALF)), "v"(gw_), "s"(base) : "memory"); } }
                    continue; }
                if (kind == 0) ro = ((unsigned)row * GZ_W + (unsigned)cl) * 2u;
                else if (kind == 1) ro = (((unsigned)(b * SSM_NG + (cl >> 4)) * SEQ + (unsigned)t) * 16u + (unsigned)(cl & 8)) * 2u;
                else { const int pos = ((t & ((1 << sh) - 1)) << (11 - sh)) + (t >> sh); ro = (((unsigned)b * HPG * SEQ + (unsigned)pos) * HD + (unsigned)cl) * 2u; }
#pragma unroll
                for (int bj = 0; bj < 2; ++bj) {
                    f32x4 v0 = acc[ai][bj][m][0] * inv[ai][m], v1 = acc[ai][bj][m][1] * inv[ai][m];
                    if (mode != 0) {
#pragma unroll
                        for (int e = 0; e < 4; ++e) {
                            const float s0 = __builtin_amdgcn_rcpf(1.0f + __builtin_amdgcn_exp2f(-1.4426950408889634f * v0[e]));
                            const float s1 = __builtin_amdgcn_rcpf(1.0f + __builtin_amdgcn_exp2f(-1.4426950408889634f * v1[e]));
                            v0[e] = (mode == 1) ? v0[e] * s0 : s0; v1[e] = (mode == 1) ? v1[e] * s1 : s1;
                        }
                    }
                    u32x4 w; w.x = cvt_pk_bf16(v0[0], v0[1]); w.y = cvt_pk_bf16(v0[2], v0[3]); w.z = cvt_pk_bf16(v1[0], v1[1]); w.w = cvt_pk_bf16(v1[2], v1[3]);
#if EXP_NOSTORE
                    asm volatile("" :: "v"(w.x), "v"(w.y), "v"(w.z), "v"(w.w));
#else
#if P1_NT
                    __builtin_nontemporal_store(w, (u32x4*)(rowp + bj * bjs));
#else
                    asm volatile("global_store_dwordx4 %0, %1, %2" :: "v"(ro + (unsigned)bj * (unsigned)bjs * 2u), "v"(w), "s"(base) : "memory");
#endif
#endif
                }
            }
    }
};
}

#define LAS __attribute__((address_space(3)))
#define GAS __attribute__((address_space(1)))
#define LDS_WAIT() asm volatile("s_waitcnt lgkmcnt(0)" ::: "memory")
#define VM_WAIT() asm volatile("s_waitcnt vmcnt(0)" ::: "memory")
__device__ __forceinline__ unsigned pk2(float lo, float hi) { return (unsigned)f2bf(lo) | ((unsigned)f2bf(hi) << 16); }
#define XB_TMO      128
#define XB_XCNT(j)  (256  + 64 * (j))
#define XB_XSUB(j)  (1280 + 64 * (j))
#define XB_XGEN(j)  (2304 + 64 * (j))
#define XB_TOP      3328
#define XB_TOPGEN   3392
#define XCD_BAR_WORDS 3456
#define XB_SPIN_CAP (1u << 18)

__device__ __forceinline__ unsigned xb_ld(unsigned* p)              { return __hip_atomic_load(p, __ATOMIC_RELAXED, __HIP_MEMORY_SCOPE_AGENT); }
__device__ __forceinline__ unsigned xb_add(unsigned* p, unsigned v) { return __hip_atomic_fetch_add(p, v, __ATOMIC_RELAXED, __HIP_MEMORY_SCOPE_AGENT); }
__device__ __forceinline__ unsigned xb_xcc_id() { return (unsigned)__builtin_amdgcn_s_getreg((3 << 11) | 20) & 0xFu; }
#define XB_SPIN(cond, bar) do { unsigned _sp = 0; while (cond) { __builtin_amdgcn_s_sleep(1); \
    if ((++_sp & 255u) == 0u) { if (xb_ld(&(bar)[XB_TMO])) break; if (_sp > XB_SPIN_CAP) { atomicAdd(&(bar)[XB_TMO], 1u); break; } } } } while (0)

struct XcdBarrier {
    int w;
    unsigned G;
    unsigned* bar; unsigned x;
    volatile LAS unsigned* st;
};

__device__ __forceinline__ XcdBarrier xcd_barrier_post(unsigned* bar, volatile LAS unsigned* st, int wave_s, unsigned G) {
    XcdBarrier b; b.w = wave_s; b.G = G; b.bar = bar; b.x = xb_xcc_id(); b.st = st;
    if (tid_from(wave_s) == 0) (void)xb_add(&bar[XB_XCNT(b.x)], 1u);
    return b;
}
__device__ __forceinline__ void xcd_barrier_complete(unsigned* bar, unsigned x, unsigned& nloc, unsigned& nx, unsigned G) {
    unsigned sum, cnt, mine, sp = 0u;
    for (;;) {
        sum = 0u; cnt = 0u; mine = 0u;
#pragma unroll
        for (unsigned j = 0; j < 16; ++j) { const unsigned c = xb_ld(&bar[XB_XCNT(j)]); sum += c; cnt += (c > 0u) ? 1u : 0u; mine = (j == x) ? c : mine; }
        if (sum == G) break;
        __builtin_amdgcn_s_sleep(1);
        if ((++sp & 255u) == 0u) { if (xb_ld(&bar[XB_TMO])) break; if (sp > XB_SPIN_CAP) { atomicAdd(&bar[XB_TMO], 1u); break; } }
    }
    nloc = mine > 0u ? mine : 1u; nx = cnt > 0u ? cnt : 1u;
}

__device__ __forceinline__ void xcd_barrier(const XcdBarrier& b) {
    asm volatile("s_waitcnt vmcnt(0)" ::: "memory");
    __syncthreads();
    if (tid_from(b.w) == 0) {
        unsigned* bar = b.bar;
        __builtin_amdgcn_s_waitcnt(0);
        unsigned nloc = b.st[0], nx = b.st[1];
        if (nloc == 0u) { xcd_barrier_complete(bar, b.x, nloc, nx, b.G); b.st[0] = nloc; b.st[1] = nx; }
        const unsigned old = xb_add(&bar[XB_XSUB(b.x)], 1u);
        const unsigned gen = old / nloc;
        if (old + 1u == (gen + 1u) * nloc) {
            __builtin_amdgcn_fence(__ATOMIC_RELEASE, "agent");
            asm volatile("s_waitcnt vmcnt(0)" ::: "memory");
            const unsigned og = xb_add(&bar[XB_TOP], 1u);
            const unsigned tg = og / nx;
            if (og + 1u == (tg + 1u) * nx) xb_add(&bar[XB_TOPGEN], 1u);
            else XB_SPIN(xb_ld(&bar[XB_TOPGEN]) == tg, bar);
            __builtin_amdgcn_fence(__ATOMIC_ACQUIRE, "agent");
            xb_add(&bar[XB_XGEN(b.x)], 1u);
            asm volatile("s_waitcnt vmcnt(0)" ::: "memory");
        } else {
            XB_SPIN(xb_ld(&bar[XB_XGEN(b.x)]) == gen, bar);
            __builtin_amdgcn_fence(__ATOMIC_ACQUIRE, "agent");
            asm volatile("s_waitcnt vmcnt(0)" ::: "memory");
        }
    }
    __syncthreads();
}

constexpr int NWAVES = 8, NTHREADS = NWAVES * 64;
constexpr int RING_BYTES = 131072;
constexpr int LDS_BYTES = 163840;
constexpr int MISC_OFF = LDS_BYTES - 256;
constexpr int CW_BAR = 4096;
constexpr int N_BAR_REGIONS = 32;
constexpr size_t CTL_ZERO_BYTES = 1 * MiB;
static_assert((CW_BAR + N_BAR_REGIONS * XCD_BAR_WORDS) * 4 <= (int)CTL_ZERO_BYTES, "ctl");

#ifndef PROBE_DUP
#define PROBE_DUP 0
#endif
struct Frame { LAS unsigned char* lds; int wave, vcu, G; };

struct Args { Params p; int ph_lo, ph_hi, bar_region, pad; };
__device__ __forceinline__ const float* inptr(const Args& a, int i) { int z; asm volatile("s_mov_b32 %0, 0" : "=s"(z)); return a.p.in[i + z]; }

namespace swa {
constexpr int D = 128; constexpr float THR = 8.f; constexpr bool WSKIP = true;
constexpr float SCALE = 0.08838834764831845f;
constexpr int NW = 8, QBLK = 32, KVBLK = 64, QB = NW * QBLK;
constexpr int SHM_V = KVBLK * D * 2, SHM_K = KVBLK * D * 2;
constexpr int ATTN_LDS_BYTES = 2 * SHM_V + 2 * SHM_K + NW * 64 * 4;

typedef short s16x4 __attribute__((ext_vector_type(4)));
typedef float f32x16 __attribute__((ext_vector_type(16)));
template <class A, class Bt> struct same_t { static constexpr bool v = false; };
template <class A> struct same_t<A, A> { static constexpr bool v = true; };

#define KSWZ(row, colB) ((row) * 256 + ((colB) ^ (((row) & 7) << 4)))
#define SBAR() __builtin_amdgcn_sched_barrier(0)
__device__ __forceinline__ int v_st(int k, int c) { const int kk = (k & ~0xC) | ((k & 4) << 1) | ((k & 8) >> 1); return ((kk >> 3) * 4 + (c >> 5)) * 512 + ((kk & 7) * 32 + (c & 31)) * 2; }
__device__ __forceinline__ int v_rd_base(int lane) { return ((lane & 3) << 3) | (((lane >> 2) & 3) << 6) | (((lane >> 4) & 1) << 5) | (((lane >> 5) & 1) << 8); }
constexpr int v_rd_off(int d0, int ks, int half) { return d0 * 512 + ks * 4096 + half * 2048; }
__device__ __forceinline__ int crow(int r, int hi) { return (r & 3) + 8 * (r >> 2) + 4 * hi; }
__device__ __forceinline__ unsigned cvtpk(float lo, float hi) {
    unsigned r; asm volatile("v_cvt_pk_bf16_f32 %0, %1, %2" : "=v"(r) : "v"(lo), "v"(hi)); return r;
}
__device__ __forceinline__ bf16x8 pack8(f32x4 a, f32x4 b) {
    u32x4 w = {cvtpk(a[0], a[1]), cvtpk(a[2], a[3]), cvtpk(b[0], b[1]), cvtpk(b[2], b[3])};
    return *reinterpret_cast<bf16x8*>(&w);
}
template <class T> __device__ __forceinline__ bf16x8 load8(const T* p) {
    if constexpr (same_t<T, float>::v) { return pack8(*(const f32x4*)p, *(const f32x4*)(p + 4)); }
    else { return *reinterpret_cast<const bf16x8*>(p); }
}
__device__ __forceinline__ void mask_tile(f32x16& p0, f32x16& p1, int dq, unsigned W) {
    const float NEG = -__builtin_inff();
#pragma unroll
    for (int r = 0; r < 16; ++r) {
        const int c = (r & 3) + 8 * (r >> 2);
        if ((unsigned)(dq - c) >= W) p0[r] = NEG;
        if ((unsigned)(dq - c - 32) >= W) p1[r] = NEG;
    }
}
__device__ __forceinline__ void partialSM(f32x16& p0, f32x16& p1, float& m_reg, float& mn, float& alpha) {
    float pmax = p0[0]; for (int r = 1; r < 16; ++r) pmax = fmaxf(pmax, p0[r]); for (int r = 0; r < 16; ++r) pmax = fmaxf(pmax, p1[r]);
    { auto rr = __builtin_amdgcn_permlane32_swap(__float_as_uint(pmax), __float_as_uint(pmax), false, false);
      pmax = fmaxf(__uint_as_float(rr[0]), __uint_as_float(rr[1])); }
    constexpr float C2 = 1.4426950408889634f * SCALE;
    if (__builtin_expect(__all((pmax - m_reg) * SCALE <= THR), 1)) { mn = m_reg; alpha = 1.f; }
    else { mn = fmaxf(m_reg, pmax); alpha = __builtin_amdgcn_exp2f((m_reg - mn) * C2); m_reg = mn; }
    const float mnL = -mn * C2;
    for (int r = 0; r < 16; ++r) p0[r] = fmaf(p0[r], C2, mnL); for (int r = 0; r < 16; ++r) p1[r] = fmaf(p1[r], C2, mnL);
    for (int r = 0; r < 16; ++r) p0[r] = __builtin_amdgcn_exp2f(p0[r]);
}
__device__ __forceinline__ void finishSM(f32x16& p0, f32x16& p1, float alpha, float& l_reg, bf16x8& pa0, bf16x8& pa1, bf16x8& pa2, bf16x8& pa3) {
    for (int r = 0; r < 16; ++r) p1[r] = __builtin_amdgcn_exp2f(p1[r]);
    float ps = 0; for (int r = 0; r < 16; ++r) ps += p0[r]; for (int r = 0; r < 16; ++r) ps += p1[r];
    { auto rr = __builtin_amdgcn_permlane32_swap(__float_as_uint(ps), __float_as_uint(ps), false, false);
      ps = __uint_as_float(rr[0]) + __uint_as_float(rr[1]); }
    l_reg = l_reg * alpha + ps;
#define PK4(P, B_, OUT) do { unsigned a0 = cvtpk(P[B_+0], P[B_+1]), a1 = cvtpk(P[B_+2], P[B_+3]);                          \
        unsigned b0 = cvtpk(P[B_+4], P[B_+5]), b1 = cvtpk(P[B_+6], P[B_+7]);                                             \
        auto r0 = __builtin_amdgcn_permlane32_swap(a0, b0, false, false); auto r1 = __builtin_amdgcn_permlane32_swap(a1, b1, false, false); \
        u32x4 w = {r0[0], r1[0], r0[1], r1[1]}; OUT = *reinterpret_cast<bf16x8*>(&w); } while (0)
    PK4(p0, 0, pa0); PK4(p0, 8, pa1); PK4(p1, 0, pa2); PK4(p1, 8, pa3);
#undef PK4
}
template <int KB, bool SK>
__device__ __forceinline__ void qkt(f32x16& p0, f32x16& p1, const char* K_lds, int r32, int hi, const bf16x8* qr, bool act) {
    if (SK && !act) { const float NEG = -__builtin_inff();
#pragma unroll
        for (int r = 0; r < 16; ++r) { p0[r] = NEG; p1[r] = NEG; } return; }
    p0 = f32x16{}; p1 = f32x16{};
    const char* kb[4];
#pragma unroll
    for (int dd = 0; dd < 4; ++dd) kb[dd] = K_lds + KB * SHM_K + KSWZ(r32, (dd * 16 + hi * 8) * 2);
#pragma unroll
    for (int d0 = 0; d0 < 8; ++d0) { const char* a = kb[d0 & 3] + (d0 >> 2) * 128;
        bf16x8 b0 = *reinterpret_cast<const bf16x8*>(a);
        bf16x8 b1 = *reinterpret_cast<const bf16x8*>(a + 32 * 256);
        p0 = __builtin_amdgcn_mfma_f32_32x32x16_bf16(b0, qr[d0], p0, 0, 0, 0);
        p1 = __builtin_amdgcn_mfma_f32_32x32x16_bf16(b1, qr[d0], p1, 0, 0, 0); }
}
template <int VB, bool SK>
__device__ __forceinline__ void pv_tile(f32x16* o, int vb0, bf16x8 pa0, bf16x8 pa1, bf16x8 pa2, bf16x8 pa3, bool act) {
    if (SK && !act) return;
#define TRRD(dst, off) asm volatile("ds_read_b64_tr_b16 %0, %1 offset:%2" : "=&v"(dst) : "v"(vb0), "i"(off) : "memory")
#define PV_D0(d0) do { s16x4 l0, l1, l2, l3, h0, h1, h2, h3; constexpr int b_ = VB * SHM_V + v_rd_off(d0, 0, 0);     \
        TRRD(l0, b_); TRRD(h0, b_ + 2048); TRRD(l1, b_ + 4096); TRRD(h1, b_ + 6144); TRRD(l2, b_ + 8192); TRRD(h2, b_ + 10240); TRRD(l3, b_ + 12288); TRRD(h3, b_ + 14336); \
        asm volatile("s_waitcnt lgkmcnt(0)" ::: "memory"); SBAR();                 \
        o[d0] = __builtin_amdgcn_mfma_f32_32x32x16_bf16(pa0, (bf16x8){l0[0], l0[1], l0[2], l0[3], h0[0], h0[1], h0[2], h0[3]}, o[d0], 0, 0, 0);   \
        o[d0] = __builtin_amdgcn_mfma_f32_32x32x16_bf16(pa1, (bf16x8){l1[0], l1[1], l1[2], l1[3], h1[0], h1[1], h1[2], h1[3]}, o[d0], 0, 0, 0);   \
        o[d0] = __builtin_amdgcn_mfma_f32_32x32x16_bf16(pa2, (bf16x8){l2[0], l2[1], l2[2], l2[3], h2[0], h2[1], h2[2], h2[3]}, o[d0], 0, 0, 0);   \
        o[d0] = __builtin_amdgcn_mfma_f32_32x32x16_bf16(pa3, (bf16x8){l3[0], l3[1], l3[2], l3[3], h3[0], h3[1], h3[2], h3[3]}, o[d0], 0, 0, 0); } while (0)
    PV_D0(0); PV_D0(1); PV_D0(2); PV_D0(3);
#undef PV_D0
#undef TRRD
}

template <class TIn, class TOut> struct BlockRef { const TIn* Q; const TIn* K; const TIn* V; TOut* O; float* L; int P0, pitch, opitch, lpitch, nq; };
template <class TIn> struct Seam {
    bf16x8 qr[8];
    bf16x8 st_v0, st_v1, st_k0, st_k1; f32x4 sf0, sf1, sf2, sf3;
    f32x4 tq[16];
};
__device__ __forceinline__ int swa_jlo(int P0, int W) { const int lowk = P0 - W + 1; return lowk > 0 ? lowk / KVBLK : 0; }
#define ROW(p, k0, rr) ((p) + (size_t)((k0) + (rr)) * PITCH_ + sc)
#define VMW() asm volatile("s_waitcnt vmcnt(0)" ::: "memory")
#define VMWN(n) asm volatile("s_waitcnt vmcnt(%0)" :: "i"(n) : "memory")
#define SLOAD_H(Kp, Vp, k0) do { S.st_v0 = load8<TIn>(ROW(Vp, k0, sr)); S.st_v1 = load8<TIn>(ROW(Vp, k0, 32 + sr));              \
                         S.st_k0 = load8<TIn>(ROW(Kp, k0, sr)); S.st_k1 = load8<TIn>(ROW(Kp, k0, 32 + sr)); } while (0)
#define SWRITE_HK(bf) do { *(bf16x8*)(K_lds + (bf) * SHM_K + kws) = S.st_k0; *(bf16x8*)(K_lds + (bf) * SHM_K + kws + 32 * 256) = S.st_k1; } while (0)
#define SWRITE_HV(bf) do { *(bf16x8*)(V_lds + (bf) * SHM_V + vst0) = S.st_v0; *(bf16x8*)(V_lds + (bf) * SHM_V + vst1) = S.st_v1; } while (0)
#define SWRITE_H(bf) do { SWRITE_HV(bf); SWRITE_HK(bf); } while (0)
#define SLOAD_F(p, k0) do { S.sf0 = *(const f32x4*)ROW(p, k0, sr); S.sf1 = *(const f32x4*)(ROW(p, k0, sr) + 4);                \
                            S.sf2 = *(const f32x4*)ROW(p, k0, 32 + sr); S.sf3 = *(const f32x4*)(ROW(p, k0, 32 + sr) + 4); } while (0)
#define SWRITE_KF(bf) do { *(bf16x8*)(K_lds + (bf) * SHM_K + kws) = pack8(S.sf0, S.sf1); *(bf16x8*)(K_lds + (bf) * SHM_K + kws + 32 * 256) = pack8(S.sf2, S.sf3); } while (0)
#define SWRITE_VF(bf) do { *(bf16x8*)(V_lds + (bf) * SHM_V + vst0) = pack8(S.sf0, S.sf1); *(bf16x8*)(V_lds + (bf) * SHM_V + vst1) = pack8(S.sf2, S.sf3); } while (0)
template <class TIn, class TOut>
__device__ __forceinline__ void causal_swa_prime(const BlockRef<TIn, TOut>& cur, int W, char* lds, Seam<TIn>& S, int wave_s) {
    constexpr bool F32 = same_t<TIn, float>::v;
    const int tid = tid_from(wave_s), wid = wave_s, lane = tid & 63, r32 = lane & 31, hi = lane >> 5;
    const int sr = tid >> 4, sc = (tid & 15) * 8, kws = KSWZ(sr, sc * 2); char* K_lds = lds + 2 * SHM_V;
    const int kb0 = swa_jlo(cur.P0, W) * KVBLK;
    const int PITCH_ = cur.pitch; const int qrow_ = (wid * QBLK + r32 < cur.nq) ? wid * QBLK + r32 : cur.nq - 1;
    for (int d0 = 0; d0 < 8; ++d0) S.qr[d0] = load8<TIn>(cur.Q + (size_t)qrow_ * PITCH_ + d0 * 16 + hi * 8);
    if constexpr (F32) { SLOAD_F((const float*)cur.K, kb0); VMW(); SWRITE_KF(0); SBAR(); SLOAD_F((const float*)cur.V, kb0); }
    else { SLOAD_H(cur.K, cur.V, kb0); VMW(); SWRITE_HK(0); }
    __syncthreads();
}
template <class TIn, class TOut>
__device__ __forceinline__ void causal_swa_block(const BlockRef<TIn, TOut>& cur, const BlockRef<TIn, TOut>& nxt, int skv, int W, char* lds, Seam<TIn>& S, int wave_s) {
    constexpr bool F32 = same_t<TIn, float>::v;
    const int tid = tid_from(wave_s), wid = wave_s, lane = tid & 63, r32 = lane & 31, hi = lane >> 5;
    int PITCH_ = cur.pitch; const bool wact = (wid * QBLK < cur.nq);
    const int j_lo = swa_jlo(cur.P0, W);
    int j_hi = (cur.P0 + QB - 1) / KVBLK + 1; if (j_hi > skv / KVBLK) j_hi = skv / KVBLK;
    const int NT = j_hi - j_lo;
    const int kbn = swa_jlo(nxt.P0, W) * KVBLK;
    const int qlo = cur.P0 + wid * QBLK, qm = qlo + r32 - 4 * hi;
    char* V_lds = lds; char* K_lds = lds + 2 * SHM_V;
    float* ws = (float*)(lds + 2 * SHM_V + 2 * SHM_K) + wid * 64; float* li_l = ws, * al_l = ws + 32;
    float m_reg = -1e30f, l_reg = 0; f32x16 o[4] = {};
    const int sr = tid >> 4, sc = (tid & 15) * 8, vst0 = v_st(sr, sc), vst1 = v_st(32 + sr, sc), kws = KSWZ(sr, sc * 2);
    const int vb0 = (int)(uintptr_t)V_lds + v_rd_base(lane);
    const TIn* Kh = cur.K; const TIn* Vh = cur.V;
#define RESC(a) do { if (__any((a) < 1.f)) { if (hi == 0) al_l[r32] = (a); asm volatile("s_waitcnt lgkmcnt(0)" ::: "memory");              \
                     for (int d_ = 0; d_ < 4; ++d_) for (int r = 0; r < 16; ++r) o[d_][r] *= al_l[crow(r, hi)]; } } while (0)
#define KBASE(t) ((j_lo + (t)) * KVBLK)
#define ACT(t) (wact && KBASE(t) <= qlo + QBLK - 1 && KBASE(t) + KVBLK - 1 >= qlo - W + 1)
#define MASKT(P0_, P1_, t) do { const int kb_ = KBASE(t); if ((!SK || ACT(t)) && (kb_ + KVBLK - 1 > qlo || kb_ <= qlo + QBLK - 1 - W)) mask_tile(P0_, P1_, qm - kb_, (unsigned)W); } while (0)
    constexpr int NQL = F32 ? 16 : 8;
    constexpr bool SK = WSKIP && !F32;
#define SEAM_K0() do { VMWN(NQL); if constexpr (F32) { SWRITE_KF(0); SBAR(); SLOAD_F((const float*)nxt.V, kbn); } else { SWRITE_HK(0); } SBAR(); } while (0)
    f32x16 pA0, pA1, pB0, pB1; float mnA, mnB, alA, alB; bf16x8 pa0, pa1, pa2, pa3;
    if constexpr (F32) { VMW(); SWRITE_VF(0); SBAR(); } else { SWRITE_HV(0); SBAR(); }
    if (NT > 1) { if constexpr (F32) SLOAD_F((const float*)Kh, KBASE(1)); else SLOAD_H(Kh, Vh, KBASE(1)); }
    SBAR(); qkt<0, SK>(pA0, pA1, K_lds, r32, hi, S.qr, ACT(0));
    if constexpr (F32) { if (NT > 1) { VMW(); SWRITE_KF(1); SBAR(); SLOAD_F((const float*)Vh, KBASE(1)); } }
    MASKT(pA0, pA1, 0); partialSM(pA0, pA1, m_reg, mnA, alA);
    if (NT > 1) { VMW(); if constexpr (F32) { SWRITE_VF(1); SBAR(); if (NT > 2) SLOAD_F((const float*)Kh, KBASE(2)); } else SWRITE_H(1); }
    __syncthreads();
#define HALF_STEP(PX0, PX1, mnX, alX, PY0, PY1, alY, t, KB, VB, SB) do {                                                      \
        SBAR(); if constexpr (!F32) { if ((t) + 1 < NT) { SLOAD_H(Kh, Vh, KBASE((t) + 1)); SBAR(); } }     \
        qkt<KB, SK>(PX0, PX1, K_lds, r32, hi, S.qr, ACT(t));                                             \
        finishSM(PY0, PY1, alY, l_reg, pa0, pa1, pa2, pa3); SBAR();                                                           \
        if constexpr (F32) { if ((t) + 1 < NT) { VMW(); SWRITE_KF(SB); SBAR(); SLOAD_F((const float*)Vh, KBASE((t) + 1)); SBAR(); } }  \
        pv_tile<VB, SK>(o, vb0, pa0, pa1, pa2, pa3, ACT((t) - 1)); MASKT(PX0, PX1, (t)); partialSM(PX0, PX1, m_reg, mnX, alX);                                        \
        __syncthreads();                                                                                                      \
        if ((t) + 1 < NT) { VMW(); if constexpr (F32) { SWRITE_VF(SB); SBAR(); if ((t) + 2 < NT) SLOAD_F((const float*)Kh, KBASE((t) + 2)); } \
                            else { SWRITE_H(SB); } }                                                                          \
        RESC(alX); __syncthreads(); } while (0)
    for (int t = 1; t + 1 < NT; t += 2) {
        HALF_STEP(pB0, pB1, mnB, alB, pA0, pA1, alA, t, 1, 0, 0);
        HALF_STEP(pA0, pA1, mnA, alA, pB0, pB1, alB, t + 1, 0, 1, 1);
    }
    const bool even = (NT & 1) == 0;
    if (even) { SBAR(); qkt<1, SK>(pB0, pB1, K_lds, r32, hi, S.qr, ACT(NT - 1)); SBAR(); }
#define QROW(e) (nxt.Q + (size_t)(wid * QBLK + r32) * D + ((e) >> 1) * 16 + hi * 8 + ((e) & 1) * 4)
    if constexpr (F32) { SLOAD_F((const float*)nxt.K, kbn); SBAR();
#pragma unroll
        for (int e = 0; e < 8; ++e) S.tq[e] = *(const f32x4*)QROW(e); }
    else { PITCH_ = nxt.pitch; SLOAD_H(nxt.K, nxt.V, kbn); SBAR();
        const int qrow_ = (wid * QBLK + r32 < nxt.nq) ? wid * QBLK + r32 : nxt.nq - 1;
#pragma unroll
        for (int d0 = 0; d0 < 8; ++d0) S.qr[d0] = load8<TIn>(nxt.Q + (size_t)qrow_ * PITCH_ + d0 * 16 + hi * 8); }
    SBAR();
    finishSM(pA0, pA1, alA, l_reg, pa0, pa1, pa2, pa3); SBAR();
    if constexpr (F32) {
#pragma unroll
        for (int e = 8; e < 16; ++e) S.tq[e] = *(const f32x4*)QROW(e); SBAR(); }
#undef QROW
    pv_tile<0, SK>(o, vb0, pa0, pa1, pa2, pa3, ACT(even ? NT - 2 : NT - 1));
    if (even) { MASKT(pB0, pB1, NT - 1); partialSM(pB0, pB1, m_reg, mnB, alB); __syncthreads(); RESC(alB);
        finishSM(pB0, pB1, alB, l_reg, pa0, pa1, pa2, pa3); SBAR(); pv_tile<1, SK>(o, vb0, pa0, pa1, pa2, pa3, ACT(NT - 1)); }
    SBAR(); SEAM_K0();
    if (hi == 0) li_l[r32] = l_reg; asm volatile("s_waitcnt lgkmcnt(0)" ::: "memory");
    float rli[16];
#pragma unroll
    for (int r = 0; r < 16; ++r) rli[r] = __builtin_amdgcn_rcpf(li_l[crow(r, hi)]);
    const int OP_ = cur.opitch; TOut* Ow = cur.O + (size_t)(wid * QBLK) * OP_;
    if (wact) {
    if (hi == 0) cur.L[(size_t)(wid * QBLK + r32) * cur.lpitch] = m_reg * (1.4426950408889634f * SCALE) + __builtin_amdgcn_logf(l_reg);
#pragma unroll
    for (int r = 0; r < 16; ++r) { const int orow = crow(r, hi);
#pragma unroll
        for (int d0 = 0; d0 < 4; ++d0) { const float v = o[d0][r] * rli[r];
            if constexpr (same_t<TOut, float>::v) { Ow[(size_t)orow * OP_ + d0 * 32 + r32] = v; }
            else { const float vn = __builtin_bit_cast(float, __builtin_amdgcn_mov_dpp(__builtin_bit_cast(int, v), 0xB1, 0xF, 0xF, true));
                   if ((r32 & 1) == 0) *(unsigned*)(Ow + (size_t)orow * OP_ + d0 * 32 + r32) = cvtpk(v, vn); } } }
    }
    if constexpr (F32) {
#pragma unroll
        for (int d0 = 0; d0 < 8; ++d0) S.qr[d0] = pack8(S.tq[2 * d0], S.tq[2 * d0 + 1]); }
    __syncthreads();
#undef RESC
#undef KBASE
#undef ACT
#undef MASKT
#undef SEAM_K0
#undef HALF_STEP
}
#undef ROW
#undef VMW
#undef VMWN
#undef SLOAD_H
#undef SWRITE_HK
#undef SWRITE_HV
#undef SWRITE_H
#undef SLOAD_F
#undef SWRITE_KF
#undef SWRITE_VF

constexpr int DMA_KR = 0, DMA_VR = 3 * SHM_K, DMA_SCR = DMA_VR + 3 * SHM_V, DMA_LDS_BYTES = DMA_SCR + NW * 64 * 4;
template <class TIn, class TOut>
__device__ __forceinline__ void block_dma(const BlockRef<TIn, TOut>& cur, int skv, int W, char* lds, int wave_s) {
    const int tid = tid_from(wave_s), wid = wave_s, lane = tid & 63, r32 = lane & 31, hi = lane >> 5;
    const int j_lo = swa_jlo(cur.P0, W);
    int j_hi = (cur.P0 + QB - 1) / KVBLK + 1; if (j_hi > skv / KVBLK) j_hi = skv / KVBLK;
    const int NT = j_hi - j_lo, PITCH_ = cur.pitch;
    const bool wact = (wid * QBLK < cur.nq);
    const int qlo = cur.P0 + wid * QBLK, qm = qlo + r32 - 4 * hi;
    float* wsf = (float*)(lds + DMA_SCR) + wid * 64; float* li_l = wsf; float* al_l = wsf + 32;
    int kOff[2], vOff[2];
#pragma unroll
    for (int j = 0; j < 2; ++j) kOff[j] = (4 * (2 * wid + j) + (lane >> 4)) * PITCH_ + (((lane & 15) ^ ((lane >> 4) + 4 * j)) * 8);
    { const int kk = wid * 8 + ((lane & 31) >> 2), k = (kk & ~0xC) | ((kk & 4) << 1) | ((kk & 8) >> 1);
#pragma unroll
      for (int j = 0; j < 2; ++j) vOff[j] = k * PITCH_ + (((2 * j + (lane >> 5)) & 3) * 32 + (lane & 3) * 8); }
    typedef __attribute__((address_space(3))) unsigned lds_u32;
    const unsigned ldsb = (unsigned)(size_t)(__attribute__((address_space(3))) char*)lds;
#define DMA_TILE(t, slot) do { const TIn* kt_ = cur.K + (size_t)(j_lo + (t)) * KVBLK * PITCH_; const TIn* vt_ = cur.V + (size_t)(j_lo + (t)) * KVBLK * PITCH_; \
        _Pragma("unroll") for (int j = 0; j < 2; ++j) { \
            __builtin_amdgcn_global_load_lds((const unsigned*)(kt_ + kOff[j]), (lds_u32*)(size_t)(ldsb + DMA_KR + (slot) * SHM_K + (2 * wid + j) * 1024), 16, 0, 0); \
            __builtin_amdgcn_global_load_lds((const unsigned*)(vt_ + vOff[j]), (lds_u32*)(size_t)(ldsb + DMA_VR + (slot) * SHM_V + (2 * wid + j) * 1024), 16, 0, 0); } } while (0)
    bf16x8 qr[8];
    { const int qrow_ = (wid * QBLK + r32 < cur.nq) ? wid * QBLK + r32 : cur.nq - 1;
#pragma unroll
      for (int d0 = 0; d0 < 8; ++d0) qr[d0] = load8<TIn>(cur.Q + (size_t)qrow_ * PITCH_ + d0 * 16 + hi * 8); }
    DMA_TILE(0, 0);
    if (NT > 1) DMA_TILE(1, 1);
    float m_reg = -1e30f, l_reg = 0; f32x16 o[4] = {};
    const int vbase = (int)ldsb + DMA_VR + v_rd_base(lane);
    int slot = 0, slot2 = 2;
#pragma unroll 1
    for (int t = 0; t < NT; ++t) {
        if (t + 1 < NT) asm volatile("s_waitcnt vmcnt(4)" ::: "memory"); else asm volatile("s_waitcnt vmcnt(0)" ::: "memory");
        asm volatile("s_waitcnt lgkmcnt(0)" ::: "memory"); __builtin_amdgcn_s_barrier(); asm volatile("" ::: "memory");
        if (t + 2 < NT) DMA_TILE(t + 2, slot2);
        const int kb_ = (j_lo + t) * KVBLK;
        const bool act = wact && kb_ <= qlo + QBLK - 1 && kb_ + KVBLK - 1 >= qlo - W + 1;
        if (act) {
            f32x16 p0, p1; float mn, al; bf16x8 pa0, pa1, pa2, pa3;
            SBAR(); qkt<0, false>(p0, p1, lds + DMA_KR + slot * SHM_K, r32, hi, qr, true);
            if (kb_ + KVBLK - 1 > qlo || kb_ <= qlo + QBLK - 1 - W) mask_tile(p0, p1, qm - kb_, (unsigned)W);
            partialSM(p0, p1, m_reg, mn, al);
            finishSM(p0, p1, al, l_reg, pa0, pa1, pa2, pa3); SBAR();
            if (__any(al < 1.f)) { if (hi == 0) al_l[r32] = al; asm volatile("s_waitcnt lgkmcnt(0)" ::: "memory");
                for (int d_ = 0; d_ < 4; ++d_) for (int r = 0; r < 16; ++r) o[d_][r] *= al_l[crow(r, hi)]; }
            pv_tile<0, false>(o, vbase + slot * SHM_V, pa0, pa1, pa2, pa3, true);
        }
        slot = slot == 2 ? 0 : slot + 1; slot2 = slot2 == 2 ? 0 : slot2 + 1;
    }
#undef DMA_TILE
    if (wact) {
        if (hi == 0) li_l[r32] = l_reg; asm volatile("s_waitcnt lgkmcnt(0)" ::: "memory");
        float rli[16];
#pragma unroll
        for (int r = 0; r < 16; ++r) rli[r] = __builtin_amdgcn_rcpf(li_l[crow(r, hi)]);
        const int OP_ = cur.opitch; TOut* Ow = cur.O + (size_t)(wid * QBLK) * OP_;
        if (hi == 0) cur.L[(size_t)(wid * QBLK + r32) * cur.lpitch] = m_reg * (1.4426950408889634f * SCALE) + __builtin_amdgcn_logf(l_reg);
#pragma unroll
        for (int r = 0; r < 16; ++r) { const int orow = crow(r, hi);
#pragma unroll
            for (int d0 = 0; d0 < 4; ++d0) { const float v = o[d0][r] * rli[r];
                const float vn = __builtin_bit_cast(float, __builtin_amdgcn_mov_dpp(__builtin_bit_cast(int, v), 0xB1, 0xF, 0xF, true));
                if ((r32 & 1) == 0) *(unsigned*)(Ow + (size_t)orow * OP_ + d0 * 32 + r32) = cvtpk(v, vn); } }
    }
    asm volatile("s_waitcnt lgkmcnt(0)" ::: "memory"); __builtin_amdgcn_s_barrier(); asm volatile("" ::: "memory");
}
typedef BlockRef<bf16_t, bf16_t> Ref;
}
#undef KSWZ

__device__ __forceinline__ swa::Ref attn_ref(unsigned char* ws, int L, int& skv) {
    int gi, b, h, c, qb;
    if (L < 256) { gi = 0; b = L >> 5; h = (L >> 3) & 3; qb = L & 7; c = 0; }
    else if (L < 512) { L -= 256; gi = 1; b = L >> 5; h = (L >> 3) & 3; c = (L >> 1) & 3; qb = L & 1; }
    else { L -= 512; gi = 2; const int v = L & 255, idx = (v & 31) * 2 + (L >> 8); b = v >> 5; h = idx >> 4; c = idx & 15; qb = 0; }
    const int d = gi == 0 ? 1 : (gi == 1 ? 4 : 16);
    const int n = SEQ / d;
    const size_t hb = ((size_t)(gi * BATCH + b) * HPG + h) * SEQ * HD + (size_t)c * n * HD, kstep = (size_t)3 * BATCH * HPG * SEQ * HD;
    const bf16_t* qkv = (const bf16_t*)(ws + OFF_QKV);
    const size_t tok0 = (size_t)b * SEQ + c + (size_t)qb * 256 * d;
    swa::Ref r;
    r.Q = qkv + hb + (size_t)qb * 256 * HD; r.K = qkv + kstep + hb; r.V = qkv + 2 * kstep + hb;
    r.O = (bf16_t*)(ws + OFF_AO) + ((size_t)gi * MTOK + tok0) * ATT_W + h * HD; r.opitch = d * ATT_W;
    r.L = (float*)(ws + OFF_ALSE) + ((size_t)gi * MTOK + tok0) * 4 + h; r.lpitch = d * 4;
    r.P0 = qb * 256; r.pitch = HD; r.nq = gi == 2 ? 128 : 256;
    skv = SEQ / d;
    return r;
}
namespace wsa2 {
using swa::f32x16; using swa::s16x4; using swa::crow; using swa::cvtpk; using swa::v_rd_base; using swa::SCALE; using swa::THR;
constexpr int BLK_K = 8192, SLOT = 16384, NSLOT = 9, SCR = NSLOT * SLOT, LDS_NEED = SCR + NWAVES * 256;
static_assert(LDS_NEED <= MISC_OFF, "wsa2 LDS");
#define W2_KSWZ(row, colB) ((row) * 256 + ((colB) ^ (((row) & 7) << 4)))
#define W2_SBAR() __builtin_amdgcn_sched_barrier(0)
__device__ __forceinline__ void unit(const swa::Ref& u, LAS unsigned char* lds, int wave_s) {
    const int tid = tid_from(wave_s), wid = wave_s, lane = tid & 63, r32 = lane & 31, hi = lane >> 5;
    const int I0 = u.P0, i0 = I0 + 32 * wid;
    const bool wact = 32 * wid < u.nq;
    const int B0 = (I0 >= 128 ? I0 - 128 : 0) >> 5;
    const int kfirst = i0 >= 128 ? i0 - 128 : 0, nblk = wact ? ((i0 - kfirst) >> 5) + 1 : 0, fw = (kfirst >> 5) - B0;
    const int ilast = I0 + u.nq - 32, klast = ilast >= 128 ? ilast - 128 : 0;
    const int nbtot = (ilast >> 5) - B0 + 1, niter = ((ilast - klast) >> 5) + 1;
    const int krow = 4 * wid + (lane >> 4), kchunk = (lane & 15) ^ (4 * (wid & 1) + (lane >> 4));
    const int kk = (wid >> 1) * 8 + ((lane & 31) >> 2), vkey = (kk & ~0xC) | ((kk & 4) << 1) | ((kk & 8) >> 1), vcol = ((2 * (wid & 1) + (lane >> 5)) & 3) * 32 + (lane & 3) * 8;
    const bf16_t* ksrc = u.K + (size_t)(B0 * 32 + krow) * HD + kchunk * 8;
    const bf16_t* vsrc = u.V + (size_t)(B0 * 32 + vkey) * HD + vcol;
    typedef __attribute__((address_space(3))) unsigned lds_u32;
    const unsigned ldsb = (unsigned)(size_t)lds;
#define W2_DMA(b, slot) do { __builtin_amdgcn_global_load_lds((const unsigned*)(ksrc + (size_t)(b) * 32 * HD), (lds_u32*)(size_t)(ldsb + (slot) * SLOT + wid * 1024), 16, 0, 0); \
        __builtin_amdgcn_global_load_lds((const unsigned*)(vsrc + (size_t)(b) * 32 * HD), (lds_u32*)(size_t)(ldsb + (slot) * SLOT + BLK_K + wid * 1024), 16, 0, 0); } while (0)
    for (int b = 0; b < 8 && b < nbtot; ++b) W2_DMA(b, b);
    bf16x8 qr[8];
    { const int qrow = wact ? 32 * wid + r32 : u.nq - 1;
#pragma unroll
      for (int d0 = 0; d0 < 8; ++d0) qr[d0] = *(const bf16x8*)(u.Q + (size_t)qrow * HD + d0 * 16 + hi * 8); }
    LAS float* li_l = (LAS float*)(lds + SCR + wid * 256); LAS float* al_l = li_l + 32;
    float m_reg = -1e30f, l_reg = 0.f; f32x16 o[4] = {};
    constexpr float C2 = 1.4426950408889634f * SCALE;
    int koff[4];
#pragma unroll
    for (int dd = 0; dd < 4; ++dd) koff[dd] = W2_KSWZ(r32, (dd * 16 + hi * 8) * 2);
    const unsigned vrb = ldsb + BLK_K + (unsigned)v_rd_base(lane);
#pragma unroll 1
    for (int i = 0; i < niter; ++i) {
        asm volatile("s_waitcnt vmcnt(0)" ::: "memory");
        asm volatile("s_waitcnt lgkmcnt(0)" ::: "memory"); __builtin_amdgcn_s_barrier(); asm volatile("" ::: "memory");
        if (i + 8 < nbtot) { const int s8 = (i + 8) % NSLOT; W2_DMA(i + 8, s8); }
        if (i < nblk) {
            const int rel = fw + i, slot = rel % NSLOT, k0 = (B0 + rel) * 32;
            const LAS unsigned char* kb = lds + slot * SLOT;
            f32x16 p = {};
#pragma unroll
            for (int d0 = 0; d0 < 8; ++d0) { const bf16x8 kf = *(const LAS bf16x8*)(kb + koff[d0 & 3] + (d0 >> 2) * 128);
                p = __builtin_amdgcn_mfma_f32_32x32x16_bf16(kf, qr[d0], p, 0, 0, 0); }
            if (k0 == i0 || k0 + 128 == i0) {
                const int dq = i0 + r32 - k0 - 4 * hi; const float NEG = -__builtin_inff();
#pragma unroll
                for (int r = 0; r < 16; ++r) { const int c = (r & 3) + 8 * (r >> 2); if ((unsigned)(dq - c) >= 129u) p[r] = NEG; }
            }
            float pmax = p[0];
#pragma unroll
            for (int r = 1; r < 16; ++r) pmax = fmaxf(pmax, p[r]);
            { auto rr = __builtin_amdgcn_permlane32_swap(__float_as_uint(pmax), __float_as_uint(pmax), false, false); pmax = fmaxf(__uint_as_float(rr[0]), __uint_as_float(rr[1])); }
            float mn, alpha;
            if (__builtin_expect(__all((pmax - m_reg) * SCALE <= THR), 1)) { mn = m_reg; alpha = 1.f; }
            else { mn = fmaxf(m_reg, pmax); alpha = __builtin_amdgcn_exp2f((m_reg - mn) * C2); m_reg = mn; }
            const float mnL = -mn * C2;
#pragma unroll
            for (int r = 0; r < 16; ++r) p[r] = __builtin_amdgcn_exp2f(fmaf(p[r], C2, mnL));
            float ps = 0.f;
#pragma unroll
            for (int r = 0; r < 16; ++r) ps += p[r];
            { auto rr = __builtin_amdgcn_permlane32_swap(__float_as_uint(ps), __float_as_uint(ps), false, false); ps = __uint_as_float(rr[0]) + __uint_as_float(rr[1]); }
            l_reg = l_reg * alpha + ps;
            bf16x8 pa0, pa1;
#define W2_PK4(B_, OUT) do { unsigned a0 = cvtpk(p[B_+0], p[B_+1]), a1 = cvtpk(p[B_+2], p[B_+3]), b0 = cvtpk(p[B_+4], p[B_+5]), b1 = cvtpk(p[B_+6], p[B_+7]); \
            auto r0 = __builtin_amdgcn_permlane32_swap(a0, b0, false, false); auto r1 = __builtin_amdgcn_permlane32_swap(a1, b1, false, false); \
            u32x4 w = {r0[0], r1[0], r0[1], r1[1]}; OUT = *reinterpret_cast<bf16x8*>(&w); } while (0)
            W2_PK4(0, pa0); W2_PK4(8, pa1);
#undef W2_PK4
            if (__any(alpha < 1.f)) {
                if (hi == 0) al_l[r32] = alpha;
                asm volatile("s_waitcnt lgkmcnt(0)" ::: "memory");
#pragma unroll
                for (int d_ = 0; d_ < 4; ++d_)
#pragma unroll
                    for (int r = 0; r < 16; ++r) o[d_][r] *= al_l[crow(r, hi)];
            }
            const unsigned vb0 = vrb + (unsigned)(slot * SLOT);
#define W2_TR(dst, off) asm volatile("ds_read_b64_tr_b16 %0, %1 offset:%2" : "=&v"(dst) : "v"(vb0), "i"(off) : "memory")
#define W2_PV(d0) do { s16x4 l0, l1, h0, h1; W2_TR(l0, (d0) * 512); W2_TR(h0, (d0) * 512 + 2048); W2_TR(l1, (d0) * 512 + 4096); W2_TR(h1, (d0) * 512 + 6144); \
            asm volatile("s_waitcnt lgkmcnt(0)" ::: "memory"); W2_SBAR(); \
            o[d0] = __builtin_amdgcn_mfma_f32_32x32x16_bf16(pa0, (bf16x8){l0[0], l0[1], l0[2], l0[3], h0[0], h0[1], h0[2], h0[3]}, o[d0], 0, 0, 0); \
            o[d0] = __builtin_amdgcn_mfma_f32_32x32x16_bf16(pa1, (bf16x8){l1[0], l1[1], l1[2], l1[3], h1[0], h1[1], h1[2], h1[3]}, o[d0], 0, 0, 0); } while (0)
            W2_PV(0); W2_PV(1); W2_PV(2); W2_PV(3);
#undef W2_PV
#undef W2_TR
        }
    }
#undef W2_DMA
    if (wact) {
        if (hi == 0) li_l[r32] = l_reg;
        asm volatile("s_waitcnt lgkmcnt(0)" ::: "memory");
        float rli[16];
#pragma unroll
        for (int r = 0; r < 16; ++r) rli[r] = __builtin_amdgcn_rcpf(li_l[crow(r, hi)]);
        if (hi == 0) u.L[(size_t)(32 * wid + r32) * u.lpitch] = m_reg * C2 + __builtin_amdgcn_logf(l_reg);
        const int OP = u.opitch; bf16_t* Ow = u.O + (size_t)(32 * wid) * OP;
#pragma unroll
        for (int r = 0; r < 16; ++r) { const int orow = crow(r, hi);
#pragma unroll
            for (int d0 = 0; d0 < 4; ++d0) { const float v = o[d0][r] * rli[r];
                const float vn = __builtin_bit_cast(float, __builtin_amdgcn_mov_dpp(__builtin_bit_cast(int, v), 0xB1, 0xF, 0xF, true));
                if ((r32 & 1) == 0) *(unsigned*)(Ow + (size_t)orow * OP + d0 * 32 + r32) = cvtpk(v, vn); } }
    }
    asm volatile("s_waitcnt lgkmcnt(0)" ::: "memory"); __builtin_amdgcn_s_barrier(); asm volatile("" ::: "memory");
}
#undef W2_KSWZ
#undef W2_SBAR
}

constexpr int N_ATTN_BLOCKS = 1024;

namespace wsa3 {
using swa::f32x16; using swa::s16x4; using swa::crow; using swa::cvtpk; using swa::v_rd_base; using swa::SCALE; using swa::THR;
constexpr int BLK_K = 8192, SLOT = 16384, NSLOT = 9, SCR = NSLOT * SLOT, LDS_NEED = SCR + NWAVES * 256;
static_assert(LDS_NEED <= MISC_OFF, "wsa3 LDS");
#define W3_KSWZ(row, colB) ((row) * 256 + ((colB) ^ (((row) & 7) << 4)))
#define W3_SBAR() __builtin_amdgcn_sched_barrier(0)
__device__ __forceinline__ void wait_vm_ops(int n) {
    switch (n >> 1) {
    case 0: asm volatile("s_waitcnt vmcnt(0)" ::: "memory"); break;
    case 1: asm volatile("s_waitcnt vmcnt(2)" ::: "memory"); break;
    case 2: asm volatile("s_waitcnt vmcnt(4)" ::: "memory"); break;
    case 3: asm volatile("s_waitcnt vmcnt(6)" ::: "memory"); break;
    case 4: asm volatile("s_waitcnt vmcnt(8)" ::: "memory"); break;
    case 5: asm volatile("s_waitcnt vmcnt(10)" ::: "memory"); break;
    case 6: asm volatile("s_waitcnt vmcnt(12)" ::: "memory"); break;
    case 7: asm volatile("s_waitcnt vmcnt(14)" ::: "memory"); break;
    case 8: asm volatile("s_waitcnt vmcnt(16)" ::: "memory"); break;
    case 9: asm volatile("s_waitcnt vmcnt(18)" ::: "memory"); break;
    case 10: asm volatile("s_waitcnt vmcnt(20)" ::: "memory"); break;
    case 11: asm volatile("s_waitcnt vmcnt(22)" ::: "memory"); break;
    case 12: asm volatile("s_waitcnt vmcnt(24)" ::: "memory"); break;
    case 13: asm volatile("s_waitcnt vmcnt(26)" ::: "memory"); break;
    case 14: asm volatile("s_waitcnt vmcnt(28)" ::: "memory"); break;
    case 15: asm volatile("s_waitcnt vmcnt(30)" ::: "memory"); break;
    case 16: asm volatile("s_waitcnt vmcnt(32)" ::: "memory"); break;
    case 17: asm volatile("s_waitcnt vmcnt(34)" ::: "memory"); break;
    case 18: asm volatile("s_waitcnt vmcnt(36)" ::: "memory"); break;
    case 19: asm volatile("s_waitcnt vmcnt(38)" ::: "memory"); break;
    case 20: asm volatile("s_waitcnt vmcnt(40)" ::: "memory"); break;
    case 21: asm volatile("s_waitcnt vmcnt(42)" ::: "memory"); break;
    case 22: asm volatile("s_waitcnt vmcnt(44)" ::: "memory"); break;
    case 23: asm volatile("s_waitcnt vmcnt(46)" ::: "memory"); break;
    case 24: asm volatile("s_waitcnt vmcnt(48)" ::: "memory"); break;
    case 25: asm volatile("s_waitcnt vmcnt(50)" ::: "memory"); break;
    case 26: asm volatile("s_waitcnt vmcnt(52)" ::: "memory"); break;
    case 27: asm volatile("s_waitcnt vmcnt(54)" ::: "memory"); break;
    case 28: asm volatile("s_waitcnt vmcnt(56)" ::: "memory"); break;
    case 29: asm volatile("s_waitcnt vmcnt(58)" ::: "memory"); break;
    case 30: asm volatile("s_waitcnt vmcnt(60)" ::: "memory"); break;
    default: asm volatile("s_waitcnt vmcnt(62)" ::: "memory"); break;
    }
}
__device__ __forceinline__ void phase(const Frame& F, unsigned char* ws, int layer, unsigned long long& ts_sum, unsigned long long& ts_t0) {
    const int wid = F.wave, tid = tid_from(wid), lane = tid & 63, r32 = lane & 31, hi = lane >> 5;
    LAS unsigned char* lds = F.lds;
    const int nU = F.vcu < N_ATTN_BLOCKS ? (N_ATTN_BLOCKS - 1 - F.vcu) / F.G + 1 : 0;
    if (nU == 0) return;
    const int krow = 4 * wid + (lane >> 4), kchunk = (lane & 15) ^ (4 * (wid & 1) + (lane >> 4));
    const int kk = (wid >> 1) * 8 + ((lane & 31) >> 2), vkey = (kk & ~0xC) | ((kk & 4) << 1) | ((kk & 8) >> 1), vcol = ((2 * (wid & 1) + (lane >> 5)) & 3) * 32 + (lane & 3) * 8;
    const unsigned klane = (unsigned)(krow * HD + kchunk * 8) * 2u, vlane = (unsigned)(vkey * HD + vcol) * 2u;
    typedef __attribute__((address_space(3))) unsigned lds_u32;
    const unsigned ldsb = (unsigned)(size_t)lds;
    LAS float* li_l = (LAS float*)(lds + SCR + wid * 256); LAS float* al_l = li_l + 32;
    constexpr float C2 = 1.4426950408889634f * SCALE;
    int koff[4];
#pragma unroll
    for (int dd = 0; dd < 4; ++dd) koff[dd] = W3_KSWZ(r32, (dd * 16 + hi * 8) * 2);
    const unsigned vrb = ldsb + BLK_K + (unsigned)v_rd_base(lane);
    int kI = -1, tI = 5, jI = 0, nbI = 0, issued = 0, consumed = 0, islot = 0, qmark = -1, smark = -1, nst = 0;
    const char* kbI = nullptr; const char* vbI = nullptr;
    bf16x8 qn[8], qr[8];
#define W3_SETUP_I() do { int skv_; const swa::Ref ri = attn_ref(ws, F.vcu + kI * F.G, skv_); \
        const int I0_ = ri.P0, B0_ = (I0_ >= 128 ? I0_ - 128 : 0) >> 5; nbI = ((I0_ + ri.nq - 32) >> 5) - B0_ + 1; tI = 0; jI = 0; \
        kbI = (const char*)(ri.K + (size_t)B0_ * 32 * HD); vbI = (const char*)(ri.V + (size_t)B0_ * 32 * HD); \
        const int qrow_ = 32 * wid < ri.nq ? 32 * wid + r32 : ri.nq - 1; const bf16_t* qp_ = ri.Q + (size_t)qrow_ * HD + hi * 8; \
        _Pragma("unroll") for (int d0 = 0; d0 < 8; ++d0) asm volatile("global_load_dwordx4 %0, %1, off" : "=v"(qn[d0]) : "v"(qp_ + d0 * 16) : "memory"); \
        qmark = issued; } while (0)
#define W3_ISSUE(kC_) do { for (;;) { \
        if (tI >= 5) { if (kI + 1 >= nU || kI >= (kC_) + 1) break; ++kI; W3_SETUP_I(); } \
        if (issued - consumed >= NSLOT) break; \
        __builtin_amdgcn_global_load_lds((const unsigned*)(kbI + (size_t)jI * (32 * HD * 2) + klane), (lds_u32*)(size_t)(ldsb + islot * SLOT + wid * 1024), 16, 0, 2); \
        __builtin_amdgcn_global_load_lds((const unsigned*)(vbI + (size_t)jI * (32 * HD * 2) + vlane), (lds_u32*)(size_t)(ldsb + islot * SLOT + BLK_K + wid * 1024), 16, 0, 2); \
        ++issued; islot = islot == NSLOT - 1 ? 0 : islot + 1; \
        jI += 5; while (tI < 5 && jI >= nbI) { ++tI; jI = tI; } } } while (0)
    asm volatile("s_waitcnt lgkmcnt(0)" ::: "memory"); __builtin_amdgcn_s_barrier(); asm volatile("" ::: "memory");
    W3_ISSUE(-1);
    int spos = 0;
#pragma unroll 1
    for (int kC = 0; kC < nU; ++kC) {
        if (W_TOUCH2 == 2 && kC == nU - 1 && F.vcu < 256 && wid < 3) {
            const int ln_ = tid_from(wid) & 63, cu_ = F.vcu; const char* tp_;
            if (wid == 0) tp_ = (const char*)(ws + OFF_WOUT) + (size_t)layer * D_MODEL * D_MODEL * 2 + ((size_t)cu_ * 64 + ln_) * 128;
            else if (wid == 1) tp_ = (ln_ < 32 ? (const char*)(ws + OFF_WBS) + (size_t)layer * D_MODEL * SSM_W * 2 : (const char*)(ws + OFF_WBA) + (size_t)layer * D_MODEL * ATT_W * 2) + ((size_t)cu_ * 32 + (ln_ & 31)) * 128;
            else tp_ = (const char*)(ws + OFF_WGLU) + (size_t)layer * SSM_W * SSM_W * 2 + ((size_t)cu_ * 16 + (ln_ & 15)) * 128;
            __builtin_amdgcn_global_load_lds((const unsigned*)tp_, (lds_u32*)(size_t)(ldsb + 155648 + wid * 256), 4, 0, 0);
        }
        int skv; const swa::Ref u = attn_ref(ws, F.vcu + kC * F.G, skv);
        const int I0 = u.P0, i0 = I0 + 32 * wid;
        const bool wact = 32 * wid < u.nq;
        const int B0 = (I0 >= 128 ? I0 - 128 : 0) >> 5;
        const int kfirst = i0 >= 128 ? i0 - 128 : 0, nblk = wact ? ((i0 - kfirst) >> 5) + 1 : 0, fw = (kfirst >> 5) - B0;
        const int nbtot = ((I0 + u.nq - 32) >> 5) - B0 + 1;
        float m_reg = -1e30f, l_reg = 0.f; f32x16 o[4] = {};
#pragma unroll 1
        for (int t = 0; t < 5; ++t) {
            const int cnt = t < nbtot ? (nbtot - t + 4) / 5 : 0;
            if (cnt == 0) continue;
            TS_BEGIN(31);
            { const int endp = spos + cnt; wait_vm_ops(2 * (issued - endp) + (qmark >= endp ? 8 : 0) + (smark >= endp ? nst : 0)); }
            asm volatile("s_waitcnt lgkmcnt(0)" ::: "memory"); __builtin_amdgcn_s_barrier(); asm volatile("" ::: "memory");
            if (t == 0) {
                asm volatile("" : "+v"(qn[0]), "+v"(qn[1]), "+v"(qn[2]), "+v"(qn[3]), "+v"(qn[4]), "+v"(qn[5]), "+v"(qn[6]), "+v"(qn[7]));
#pragma unroll
                for (int d0 = 0; d0 < 8; ++d0) qr[d0] = qn[d0];
            }
            TS_END(31); TS_BEGIN(34);
            consumed = spos; W3_ISSUE(kC);
            TS_END(34); TS_BEGIN(32);
            const int rj = (t - fw) % 5, j = fw + (rj < 0 ? rj + 5 : rj);
            if (j < fw + nblk) {
                const int slot = (spos + (j - t) / 5) % NSLOT, k0 = (B0 + j) * 32;
                const LAS unsigned char* kb = lds + slot * SLOT;
                f32x16 p = {};
#pragma unroll
                for (int d0 = 0; d0 < 8; ++d0) { const bf16x8 kf = *(const LAS bf16x8*)(kb + koff[d0 & 3] + (d0 >> 2) * 128);
                    p = __builtin_amdgcn_mfma_f32_32x32x16_bf16(kf, qr[d0], p, 0, 0, 0); }
                if (k0 == i0 || k0 + 128 == i0) {
                    const int dq = i0 + r32 - k0 - 4 * hi; const float NEG = -__builtin_inff();
#pragma unroll
                    for (int r = 0; r < 16; ++r) { const int c = (r & 3) + 8 * (r >> 2); if ((unsigned)(dq - c) >= 129u) p[r] = NEG; }
                }
                float pmax = p[0];
#pragma unroll
                for (int r = 1; r < 16; ++r) pmax = fmaxf(pmax, p[r]);
                { auto rr = __builtin_amdgcn_permlane32_swap(__float_as_uint(pmax), __float_as_uint(pmax), false, false); pmax = fmaxf(__uint_as_float(rr[0]), __uint_as_float(rr[1])); }
                float mn, alpha;
                if (__builtin_expect(__all((pmax - m_reg) * SCALE <= THR), 1)) { mn = m_reg; alpha = 1.f; }
                else { mn = fmaxf(m_reg, pmax); alpha = __builtin_amdgcn_exp2f((m_reg - mn) * C2); m_reg = mn; }
                const float mnL = -mn * C2;
#pragma unroll
                for (int r = 0; r < 16; ++r) p[r] = __builtin_amdgcn_exp2f(fmaf(p[r], C2, mnL));
                float ps = 0.f;
#pragma unroll
                for (int r = 0; r < 16; ++r) ps += p[r];
                { auto rr = __builtin_amdgcn_permlane32_swap(__float_as_uint(ps), __float_as_uint(ps), false, false); ps = __uint_as_float(rr[0]) + __uint_as_float(rr[1]); }
                l_reg = l_reg * alpha + ps;
                bf16x8 pa0, pa1;
#define W3_PK4(B_, OUT) do { unsigned a0 = cvtpk(p[B_+0], p[B_+1]), a1 = cvtpk(p[B_+2], p[B_+3]), b0 = cvtpk(p[B_+4], p[B_+5]), b1 = cvtpk(p[B_+6], p[B_+7]); \
                auto r0 = __builtin_amdgcn_permlane32_swap(a0, b0, false, false); auto r1 = __builtin_amdgcn_permlane32_swap(a1, b1, false, false); \
                u32x4 w = {r0[0], r1[0], r0[1], r1[1]}; OUT = *reinterpret_cast<bf16x8*>(&w); } while (0)
                W3_PK4(0, pa0); W3_PK4(8, pa1);
#undef W3_PK4
                if (__any(alpha < 1.f)) {
                    if (hi == 0) al_l[r32] = alpha;
                    asm volatile("s_waitcnt lgkmcnt(0)" ::: "memory");
#pragma unroll
                    for (int d_ = 0; d_ < 4; ++d_)
#pragma unroll
                        for (int r = 0; r < 16; ++r) o[d_][r] *= al_l[crow(r, hi)];
                }
                const unsigned vb0 = vrb + (unsigned)(slot * SLOT);
#define W3_TR(dst, off) asm volatile("ds_read_b64_tr_b16 %0, %1 offset:%2" : "=&v"(dst) : "v"(vb0), "i"(off) : "memory")
#define W3_PV(d0) do { s16x4 l0, l1, h0, h1; W3_TR(l0, (d0) * 512); W3_TR(h0, (d0) * 512 + 2048); W3_TR(l1, (d0) * 512 + 4096); W3_TR(h1, (d0) * 512 + 6144); \
                asm volatile("s_waitcnt lgkmcnt(0)" ::: "memory"); W3_SBAR(); \
                o[d0] = __builtin_amdgcn_mfma_f32_32x32x16_bf16(pa0, (bf16x8){l0[0], l0[1], l0[2], l0[3], h0[0], h0[1], h0[2], h0[3]}, o[d0], 0, 0, 0); \
                o[d0] = __builtin_amdgcn_mfma_f32_32x32x16_bf16(pa1, (bf16x8){l1[0], l1[1], l1[2], l1[3], h1[0], h1[1], h1[2], h1[3]}, o[d0], 0, 0, 0); } while (0)
                W3_PV(0); W3_PV(1); W3_PV(2); W3_PV(3);
#undef W3_PV
#undef W3_TR
            }
            spos += cnt;
            TS_END(32);
        }
        TS_BEGIN(33);
        if (wact) {
            if (hi == 0) li_l[r32] = l_reg;
            asm volatile("s_waitcnt lgkmcnt(0)" ::: "memory");
            float rli[16];
#pragma unroll
            for (int r = 0; r < 16; ++r) rli[r] = __builtin_amdgcn_rcpf(li_l[crow(r, hi)]);
            { const float lse = m_reg * C2 + __builtin_amdgcn_logf(l_reg); const unsigned lo_ = (unsigned)((32 * wid + r32) * u.lpitch) * 4u;
              asm volatile("global_store_dword %0, %1, %2" :: "v"(lo_), "v"(lse), "s"(u.L) : "memory"); }
            const int OP = u.opitch; const bf16_t* Ow = u.O + (size_t)(32 * wid) * OP;
            const unsigned lane_off = (unsigned)(4 * hi * OP + 4 * r32) * 2u;
#pragma unroll
            for (int r = 0; r < 16; ++r) { const unsigned vo = lane_off + (unsigned)(((r & 3) + 8 * (r >> 2)) * OP) * 2u;
                typedef unsigned u32x2_ __attribute__((ext_vector_type(2)));
                u32x2_ w; w.x = cvtpk(o[0][r] * rli[r], o[1][r] * rli[r]); w.y = cvtpk(o[2][r] * rli[r], o[3][r] * rli[r]);
                asm volatile("global_store_dwordx2 %0, %1, %2" :: "v"(vo), "v"(w), "s"(Ow) : "memory"); }
            smark = issued; nst = 17;
        } else { smark = -1; nst = 0; }
        TS_END(33);
    }
#undef W3_ISSUE
#undef W3_SETUP_I
    asm volatile("s_waitcnt lgkmcnt(0)" ::: "memory"); __builtin_amdgcn_s_barrier(); asm volatile("" ::: "memory");
}
#undef W3_KSWZ
#undef W3_SBAR
}


__device__ __forceinline__ void attn_phase(const Frame& F, unsigned char* ws, int layer, unsigned long long& ts_sum, unsigned long long& ts_t0) {
#if ATTN_DMA == 3
    wsa3::phase(F, ws, layer, ts_sum, ts_t0);
    return;
#endif
#if ATTN_DMA == 2
#if EXP_HALF == 2
    if (F.vcu & 1) return;
    for (int L = F.vcu; L < N_ATTN_BLOCKS; L += F.G) { for (int e = 0; e < 2; ++e) { int skv; const swa::Ref cur = attn_ref(ws, L + e, skv); wsa2::unit(cur, F.lds, F.wave); } }
    return;
#endif
    for (int L = F.vcu; L < N_ATTN_BLOCKS; L += F.G) { int skv; const swa::Ref cur = attn_ref(ws, L, skv); wsa2::unit(cur, F.lds, F.wave); }
    return;
#elif ATTN_DMA == 1
    for (int L = F.vcu; L < N_ATTN_BLOCKS; L += F.G) { int skv; const swa::Ref cur = attn_ref(ws, L, skv); swa::block_dma<bf16_t, bf16_t>(cur, skv, 129, (char*)F.lds, F.wave); }
    return;
#endif
    int L = F.vcu; if (L >= N_ATTN_BLOCKS) return;
    char* lds = (char*)F.lds;
    int skv, skvn; swa::Ref cur = attn_ref(ws, L, skv);
    swa::Seam<bf16_t> S;
    swa::causal_swa_prime<bf16_t, bf16_t>(cur, 129, lds, S, F.wave);
    for (;;) {
        const int Ln = L + F.G; const bool last = Ln >= N_ATTN_BLOCKS;
        swa::Ref nxt = cur; skvn = skv; if (!last) nxt = attn_ref(ws, Ln, skvn);
        swa::causal_swa_block<bf16_t, bf16_t>(cur, nxt, skv, 129, lds, S, F.wave);
        if (last) break;
        cur = nxt; skv = skvn; L = Ln;
    }
}

namespace wsa {
using swa::f32x16; using swa::s16x4; using swa::crow; using swa::cvtpk; using swa::v_st; using swa::v_rd_base; using swa::SCALE; using swa::THR;
constexpr int VBUF = 8192;
constexpr int WAVE_LDS = 2 * VBUF + 256;
struct Item { const bf16_t* Q; const bf16_t* K; const bf16_t* V; bf16_t* O; float* L; int i0, pitch, opitch, lpitch; };
constexpr int N_ITEMS = 3 * 2048;
__device__ __forceinline__ Item decode(unsigned char* ws, int it) {
    const int gi = it >> 11, r = it & 2047, b = r >> 8, h = (r >> 6) & 3;
    int c, qw, d;
    if (gi == 0) { c = 0; qw = r & 63; d = 1; } else if (gi == 1) { c = (r >> 4) & 3; qw = r & 15; d = 4; } else { c = (r >> 2) & 15; qw = r & 3; d = 16; }
    Item x; x.i0 = 32 * qw; x.pitch = HD; x.opitch = d * ATT_W; x.lpitch = d * 4;
    const size_t hb = ((size_t)(gi * BATCH + b) * HPG + h) * SEQ * HD + (size_t)c * (SEQ / d) * HD, kstep = (size_t)3 * BATCH * HPG * SEQ * HD;
    const bf16_t* qkv = (const bf16_t*)(ws + OFF_QKV);
    const size_t tok0 = (size_t)b * SEQ + c + (size_t)x.i0 * d;
    x.Q = qkv + hb + (size_t)x.i0 * HD; x.K = qkv + kstep + hb; x.V = qkv + 2 * kstep + hb;
    x.O = (bf16_t*)(ws + OFF_AO) + ((size_t)gi * MTOK + tok0) * ATT_W + h * HD;
    x.L = (float*)(ws + OFF_ALSE) + ((size_t)gi * MTOK + tok0) * 4 + h;
    return x;
}
#define WSA_SBAR() __builtin_amdgcn_sched_barrier(0)
__device__ __forceinline__ void wave_item(const Item& it, LAS unsigned char* wl, int lane) {
    const int r32 = lane & 31, hi = lane >> 5, pitch = it.pitch;
    LAS float* li_l = (LAS float*)(wl + 2 * VBUF); LAS float* al_l = li_l + 32;
    const int kfirst = it.i0 >= 128 ? it.i0 - 128 : 0, nblk = ((it.i0 - kfirst) >> 5) + 1;
    const bf16_t* qp = it.Q + (size_t)r32 * pitch + hi * 8;
    const bf16_t* kp = it.K + (size_t)(kfirst + r32) * pitch + hi * 8;
    const int vkey = lane >> 4, vch = (lane & 15) * 8;
    const bf16_t* vp = it.V + (size_t)(kfirst + vkey) * pitch + vch;
    int vst_off[8];
#pragma unroll
    for (int i = 0; i < 8; ++i) vst_off[i] = v_st(vkey + 4 * i, vch);
    bf16x8 qr[8], kf[8], vs[8];
#pragma unroll
    for (int d0 = 0; d0 < 8; ++d0) qr[d0] = *(const bf16x8*)(qp + d0 * 16);
#pragma unroll
    for (int d0 = 0; d0 < 8; ++d0) kf[d0] = *(const bf16x8*)(kp + d0 * 16);
#pragma unroll
    for (int i = 0; i < 8; ++i) vs[i] = *(const bf16x8*)(vp + (size_t)(4 * i) * pitch);
#pragma unroll
    for (int i = 0; i < 8; ++i) *(LAS bf16x8*)(wl + vst_off[i]) = vs[i];
    float m_reg = -1e30f, l_reg = 0.f; f32x16 o[4] = {};
    const unsigned vbase = (unsigned)(size_t)wl + (unsigned)v_rd_base(lane);
    constexpr float C2 = 1.4426950408889634f * SCALE;
#pragma unroll 1
    for (int blk = 0; blk < nblk; ++blk) {
        const int k0 = kfirst + 32 * blk; const bool more = blk + 1 < nblk;
        if (more) {
#pragma unroll
            for (int i = 0; i < 8; ++i) vs[i] = *(const bf16x8*)(vp + (size_t)(32 * (blk + 1) + 4 * i) * pitch);
        }
        f32x16 p = {};
#pragma unroll
        for (int d0 = 0; d0 < 8; ++d0) p = __builtin_amdgcn_mfma_f32_32x32x16_bf16(kf[d0], qr[d0], p, 0, 0, 0);
        if (more) {
#pragma unroll
            for (int d0 = 0; d0 < 8; ++d0) kf[d0] = *(const bf16x8*)(kp + (size_t)(32 * (blk + 1)) * pitch + d0 * 16);
        }
        if (k0 == it.i0 || k0 + 128 == it.i0) {
            const int dq = it.i0 + r32 - k0 - 4 * hi; const float NEG = -__builtin_inff();
#pragma unroll
            for (int r = 0; r < 16; ++r) { const int c = (r & 3) + 8 * (r >> 2); if ((unsigned)(dq - c) >= 129u) p[r] = NEG; }
        }
        float pmax = p[0];
#pragma unroll
        for (int r = 1; r < 16; ++r) pmax = fmaxf(pmax, p[r]);
        { auto rr = __builtin_amdgcn_permlane32_swap(__float_as_uint(pmax), __float_as_uint(pmax), false, false); pmax = fmaxf(__uint_as_float(rr[0]), __uint_as_float(rr[1])); }
        float mn, alpha;
        if (__builtin_expect(__all((pmax - m_reg) * SCALE <= THR), 1)) { mn = m_reg; alpha = 1.f; }
        else { mn = fmaxf(m_reg, pmax); alpha = __builtin_amdgcn_exp2f((m_reg - mn) * C2); m_reg = mn; }
        const float mnL = -mn * C2;
#pragma unroll
        for (int r = 0; r < 16; ++r) p[r] = __builtin_amdgcn_exp2f(fmaf(p[r], C2, mnL));
        float ps = 0.f;
#pragma unroll
        for (int r = 0; r < 16; ++r) ps += p[r];
        { auto rr = __builtin_amdgcn_permlane32_swap(__float_as_uint(ps), __float_as_uint(ps), false, false); ps = __uint_as_float(rr[0]) + __uint_as_float(rr[1]); }
        l_reg = l_reg * alpha + ps;
        bf16x8 pa0, pa1;
#define WSA_PK4(B_, OUT) do { unsigned a0 = cvtpk(p[B_+0], p[B_+1]), a1 = cvtpk(p[B_+2], p[B_+3]), b0 = cvtpk(p[B_+4], p[B_+5]), b1 = cvtpk(p[B_+6], p[B_+7]); \
        auto r0 = __builtin_amdgcn_permlane32_swap(a0, b0, false, false); auto r1 = __builtin_amdgcn_permlane32_swap(a1, b1, false, false); \
        u32x4 w = {r0[0], r1[0], r0[1], r1[1]}; OUT = *reinterpret_cast<bf16x8*>(&w); } while (0)
        WSA_PK4(0, pa0); WSA_PK4(8, pa1);
#undef WSA_PK4
        if (__any(alpha < 1.f)) {
            if (hi == 0) al_l[r32] = alpha;
            asm volatile("s_waitcnt lgkmcnt(0)" ::: "memory");
#pragma unroll
            for (int d_ = 0; d_ < 4; ++d_)
#pragma unroll
                for (int r = 0; r < 16; ++r) o[d_][r] *= al_l[crow(r, hi)];
        }
        const unsigned vb0 = vbase + (unsigned)((blk & 1) * VBUF);
#define WSA_TR(dst, off) asm volatile("ds_read_b64_tr_b16 %0, %1 offset:%2" : "=&v"(dst) : "v"(vb0), "i"(off) : "memory")
#define WSA_PV(d0) do { s16x4 l0, l1, h0, h1; WSA_TR(l0, (d0) * 512); WSA_TR(h0, (d0) * 512 + 2048); WSA_TR(l1, (d0) * 512 + 4096); WSA_TR(h1, (d0) * 512 + 6144); \
        asm volatile("s_waitcnt lgkmcnt(0)" ::: "memory"); WSA_SBAR(); \
        o[d0] = __builtin_amdgcn_mfma_f32_32x32x16_bf16(pa0, (bf16x8){l0[0], l0[1], l0[2], l0[3], h0[0], h0[1], h0[2], h0[3]}, o[d0], 0, 0, 0); \
        o[d0] = __builtin_amdgcn_mfma_f32_32x32x16_bf16(pa1, (bf16x8){l1[0], l1[1], l1[2], l1[3], h1[0], h1[1], h1[2], h1[3]}, o[d0], 0, 0, 0); } while (0)
        WSA_PV(0); WSA_PV(1); WSA_PV(2); WSA_PV(3);
#undef WSA_PV
#undef WSA_TR
        if (more) {
            LAS unsigned char* nb = wl + ((blk + 1) & 1) * VBUF;
#pragma unroll
            for (int i = 0; i < 8; ++i) *(LAS bf16x8*)(nb + vst_off[i]) = vs[i];
        }
        asm volatile("s_waitcnt lgkmcnt(0)" ::: "memory");
    }
    if (hi == 0) li_l[r32] = l_reg;
    asm volatile("s_waitcnt lgkmcnt(0)" ::: "memory");
    float rli[16];
#pragma unroll
    for (int r = 0; r < 16; ++r) rli[r] = __builtin_amdgcn_rcpf(li_l[crow(r, hi)]);
    if (hi == 0) it.L[(size_t)r32 * it.lpitch] = m_reg * C2 + __builtin_amdgcn_logf(l_reg);
    const int OP = it.opitch;
#pragma unroll
    for (int r = 0; r < 16; ++r) { const int orow = crow(r, hi);
#pragma unroll
        for (int d0 = 0; d0 < 4; ++d0) { const float v = o[d0][r] * rli[r];
            const float vn = __builtin_bit_cast(float, __builtin_amdgcn_mov_dpp(__builtin_bit_cast(int, v), 0xB1, 0xF, 0xF, true));
            if ((r32 & 1) == 0) *(unsigned*)(it.O + (size_t)orow * OP + d0 * 32 + r32) = cvtpk(v, vn); } }
    asm volatile("s_waitcnt lgkmcnt(0)" ::: "memory");
}
#undef WSA_SBAR
__device__ __forceinline__ void phase(const Frame& F, unsigned char* ws) {
    const int lane = tid_from(F.wave) & 63;
    LAS unsigned char* wl = F.lds + F.wave * WAVE_LDS;
#pragma unroll 1
    for (int it = F.vcu * NWAVES + F.wave; it < N_ITEMS; it += F.G * NWAVES) { const Item x = decode(ws, it); wave_item(x, wl, lane); }
}
}

namespace s5 {
constexpr size_t T_WST = 2 * MiB;
constexpr size_t T_WO = 10 * MiB;
constexpr size_t T_KT = 18 * MiB;
constexpr size_t T_A16 = 20 * MiB;
constexpr int RSTR = 528;
constexpr int U_OFF = 0, L_OFF = 128 * RSTR;
constexpr int LDS_NEED = 2 * 128 * RSTR + 4096;
__device__ __forceinline__ void tables_wg(const Args& a, LAS unsigned char* lds, int lg, int wave_s) {
    typedef float f32x2 __attribute__((ext_vector_type(2)));
    LAS f32x2* PW = (LAS f32x2*)lds; LAS f32x2* BB = PW + 17 * 64; LAS f32x2* CT = BB + 64 * 16;
    const int tid = tid_from(wave_s); unsigned char* ws = a.p.ws;
    if (tid < 64) {
        const int idx = lg * 64 + tid;
        const float lre = fminf(inptr(a, IN_LRE)[idx], -1e-4f), lim = inptr(a, IN_LIM)[idx], dt = expf(inptr(a, IN_LDT)[lg]);
        const float ar = lre * dt, b = lim * dt, ea = expf(ar), sb = sinf(b), cb = cosf(b);
        const float Are = ea * cb, Aim = ea * sb, sh = sinf(0.5f * b);
        const float Dre = expm1f(ar) * cb - 2.0f * sh * sh, Dim = Aim;
        const float den = lre * lre + lim * lim;
        const float cre = (Dre * lre + Dim * lim) / den, cim = (Dim * lre - Dre * lim) / den;
        float* A = (float*)(ws + OFF_S5 + S5_A); float* Bb = (float*)(ws + OFF_S5 + S5_BB);
        A[idx * 2] = Are; A[idx * 2 + 1] = Aim;
        const float* bre = inptr(a, IN_BRE) + idx * 16; const float* bim = inptr(a, IN_BIM) + idx * 16;
        for (int c = 0; c < 16; ++c) { const float br = bre[c], bi = bim[c]; const f32x2 v = {cre * br - cim * bi, cre * bi + cim * br};
            Bb[(idx * 16 + c) * 2] = v.x; Bb[(idx * 16 + c) * 2 + 1] = v.y; BB[tid * 16 + c] = v; }
        float pr = 1.f, pi = 0.f; asm volatile("" : "+v"(pr), "+v"(pi));
        for (int k = 0; k <= 16; ++k) { PW[k * 64 + tid] = (f32x2){pr, pi}; const float nr = pr * Are - pi * Aim, ni = pr * Aim + pi * Are; pr = nr; pi = ni; }
        const f32x2 a16 = PW[16 * 64 + tid];
        ((f32x2*)(ws + OFF_S5 + T_A16))[idx] = a16;
    } else {
        const float* cr = inptr(a, IN_CRE) + (size_t)lg * 1024; const float* ci = inptr(a, IN_CIM) + (size_t)lg * 1024;
        for (int e = tid - 64; e < 1024; e += NTHREADS - 64) { const int c = e >> 6, pp = e & 63; CT[pp * 16 + c] = (f32x2){cr[e], ci[e]}; }
    }
    __syncthreads();
    bf16_t* WST = (bf16_t*)(ws + OFF_S5 + T_WST) + (size_t)lg * 128 * 256;
    for (int e = tid; e < 4096; e += NTHREADS) {
        const int i = e >> 5, kk0 = (e & 31) * 8, s = kk0 >> 4, c0 = kk0 & 15, pp = i & 63; const bool im = i >= 64;
        const f32x2 w = PW[(15 - s) * 64 + pp]; float v[8];
#pragma unroll
        for (int j = 0; j < 8; ++j) { const f32x2 bb = BB[pp * 16 + c0 + j]; v[j] = im ? (w.x * bb.y + w.y * bb.x) : (w.x * bb.x - w.y * bb.y); }
        u32x4 o; o.x = pk2(v[0], v[1]); o.y = pk2(v[2], v[3]); o.z = pk2(v[4], v[5]); o.w = pk2(v[6], v[7]);
        *(u32x4*)(WST + (size_t)((((i >> 4) * 8 + ((e & 31) >> 2)) * 64 + ((e & 31) & 3) * 16 + (i & 15)) * 8)) = o;
    }
    bf16_t* WO = (bf16_t*)(ws + OFF_S5 + T_WO) + (size_t)lg * 256 * 128;
    for (int e = tid; e < 4096; e += NTHREADS) {
        const int row = e >> 4, i0 = (e & 15) * 8, t = row >> 4, c = row & 15; float v[8];
#pragma unroll
        for (int j = 0; j < 8; ++j) { const int ip = i0 + j, pp = ip & 63; const f32x2 cc = CT[pp * 16 + c], w = PW[(t + 1) * 64 + pp];
            v[j] = ip < 64 ? (cc.x * w.x - cc.y * w.y) : -(cc.x * w.y + cc.y * w.x); }
        u32x4 o; o.x = pk2(v[0], v[1]); o.y = pk2(v[2], v[3]); o.z = pk2(v[4], v[5]); o.w = pk2(v[6], v[7]);
        *(u32x4*)(WO + (size_t)(((t * 4 + ((e & 15) >> 2)) * 64 + ((e & 15) & 3) * 16 + c) * 8)) = o;
    }
    bf16_t* KT = (bf16_t*)(ws + OFF_S5 + T_KT) + (size_t)lg * 17 * 256;
    { const int la = tid >> 5, c = (tid >> 1) & 15, h = tid & 1; float acc[8];
#pragma unroll
      for (int j = 0; j < 8; ++j) acc[j] = 0.f;
      for (int pp = 0; pp < 64; ++pp) { const f32x2 cc = CT[pp * 16 + c], w = PW[la * 64 + pp]; const float zr = cc.x * w.x - cc.y * w.y, zi = cc.x * w.y + cc.y * w.x;
#pragma unroll
          for (int j = 0; j < 8; ++j) { const f32x2 bb = BB[pp * 16 + 8 * h + j]; acc[j] += zr * bb.x - zi * bb.y; } }
      u32x4 o; o.x = pk2(acc[0], acc[1]); o.y = pk2(acc[2], acc[3]); o.z = pk2(acc[4], acc[5]); o.w = pk2(acc[6], acc[7]);
      *(u32x4*)(KT + ((la + 1) * 16 + c) * 16 + 8 * h) = o;
      if (tid < 32) { unsigned z_ = 0u; asm volatile("" : "+v"(z_)); *(u32x4*)(KT + tid * 8) = (u32x4){z_, z_, z_, z_}; } }
    __syncthreads();
}
__device__ __forceinline__ void unit(LAS unsigned char* lds, unsigned char* ws, int layer, int b, int g, int wave_s, const float* dsk_l) {
    const int tid = tid_from(wave_s), wave = wave_s, lane = tid & 63, q = lane >> 4, r16 = lane & 15;
    const int lg = layer * 32 + g;
    const bf16_t* usrc = (const bf16_t*)(ws + OFF_UG) + (size_t)(b * SSM_NG + g) * SEQ * 16;
    if (W_TOUCH2 == 1) {
        const int ln_ = tid_from(wave_s) & 63, cu_ = b * SSM_NG + g;
        const char* tp_ = nullptr;
        if (wave == 0) tp_ = (const char*)(ws + OFF_WOUT) + (size_t)layer * D_MODEL * D_MODEL * 2 + ((size_t)cu_ * 64 + ln_) * 128;
        else if (wave == 1) tp_ = (ln_ < 32 ? (const char*)(ws + OFF_WBS) + (size_t)layer * D_MODEL * SSM_W * 2 : (const char*)(ws + OFF_WBA) + (size_t)layer * D_MODEL * ATT_W * 2) + ((size_t)cu_ * 32 + (ln_ & 31)) * 128;
        else if (wave == 2) tp_ = (const char*)(ws + OFF_WGLU) + (size_t)layer * SSM_W * SSM_W * 2 + ((size_t)cu_ * 16 + (ln_ & 15)) * 128;
        if (wave < 3) __builtin_amdgcn_global_load_lds((const unsigned*)tp_, (LAS unsigned*)(lds + 143360 + wave * 256), 4, 0, 0);
    }
    __builtin_amdgcn_s_waitcnt(0);
    bf16x8 uv[8], af[8], kfA[8], wfA[4], kfB[8], wfB[4];
#pragma unroll
    for (int k = 0; k < 8; ++k) uv[k] = __builtin_nontemporal_load((const bf16x8*)(usrc + (size_t)(tid + NTHREADS * k) * 8));
    { const bf16_t* W = (const bf16_t*)(ws + OFF_S5 + T_WST) + (size_t)lg * 128 * 256 + (size_t)(wave * 8 * 64 + lane) * 8;
#pragma unroll
      for (int ks = 0; ks < 8; ++ks) af[ks] = __builtin_nontemporal_load((const bf16x8*)(W + ks * 512));
      const bf16_t* KT = (const bf16_t*)(ws + OFF_S5 + T_KT) + (size_t)lg * 17 * 256;
      const bf16_t* WO = (const bf16_t*)(ws + OFF_S5 + T_WO) + (size_t)lg * 256 * 128;
#pragma unroll
      for (int ks = 0; ks < 8; ++ks) { const int lagA = wave - (2 * ks + (q >> 1)) + 1, lagB = (15 - wave) - (2 * ks + (q >> 1)) + 1;
          kfA[ks] = *(const bf16x8*)(KT + ((lagA > 0 ? lagA : 0) * 16 + r16) * 16 + 8 * (q & 1)); kfB[ks] = *(const bf16x8*)(KT + ((lagB > 0 ? lagB : 0) * 16 + r16) * 16 + 8 * (q & 1)); }
#pragma unroll
      for (int k2 = 0; k2 < 4; ++k2) { wfA[k2] = __builtin_nontemporal_load((const bf16x8*)(WO + (size_t)((wave * 4 + k2) * 64 + lane) * 8)); wfB[k2] = __builtin_nontemporal_load((const bf16x8*)(WO + (size_t)(((15 - wave) * 4 + k2) * 64 + lane) * 8)); } }
#pragma unroll
    for (int k = 0; k < 8; ++k) { const int piece = tid + NTHREADS * k, tok = piece >> 1, half = piece & 1;
        *(LAS bf16x8*)(lds + U_OFF + (tok >> 4) * RSTR + (tok & 15) * 32 + half * 16) = uv[k]; }
    asm volatile("s_waitcnt lgkmcnt(0)" ::: "memory"); __builtin_amdgcn_s_barrier(); asm volatile("" ::: "memory");
    {
      for (int nt = 0; nt < 8; ++nt) {
          f32x4 acc = {0.f, 0.f, 0.f, 0.f};
          const LAS unsigned char* ub = lds + U_OFF + (nt * 16 + r16) * RSTR + q * 16;
#pragma unroll
          for (int ks = 0; ks < 8; ++ks) acc = __builtin_amdgcn_mfma_f32_16x16x32_bf16(af[ks], *(const LAS bf16x8*)(ub + ks * 64), acc, 0, 0, 0);
          *(LAS f32x4*)(lds + L_OFF + (nt * 16 + r16) * RSTR + (wave * 16 + 4 * q) * 4) = acc;
      } }
    asm volatile("s_waitcnt lgkmcnt(0)" ::: "memory"); __builtin_amdgcn_s_barrier(); asm volatile("" ::: "memory");
    {
        typedef float f32x2 __attribute__((ext_vector_type(2)));
        const f32x2 a16 = ((const f32x2*)(ws + OFF_S5 + T_A16))[lg * 64 + lane];
        LAS float* EW = (LAS float*)(lds + 2 * 128 * RSTR);
        float lre[16], lim[16], qre[16], qim[16];
#pragma unroll
        for (int jj = 0; jj < 16; ++jj) { const LAS float* row = (const LAS float*)(lds + L_OFF + (wave * 16 + jj) * RSTR); lre[jj] = row[lane]; lim[jj] = row[64 + lane]; }
        float sre = 0.f, sim = 0.f;
#pragma unroll
        for (int jj = 0; jj < 16; ++jj) { qre[jj] = sre; qim[jj] = sim;
            const float nre = a16.x * sre - a16.y * sim + lre[jj], nim = a16.x * sim + a16.y * sre + lim[jj]; sre = nre; sim = nim; }
        EW[wave * 128 + lane] = sre; EW[wave * 128 + 64 + lane] = sim;
        float pr = a16.x, pi = a16.y;
#pragma unroll
        for (int k = 0; k < 4; ++k) { const float nr = pr * pr - pi * pi, ni = 2.f * pr * pi; pr = nr; pi = ni; }
        __syncthreads();
        float ere[7], eim[7];
#pragma unroll
        for (int v = 0; v < 7; ++v) { ere[v] = EW[v * 128 + lane]; eim[v] = EW[v * 128 + 64 + lane]; }
        float gre = 0.f, gim = 0.f;
#pragma unroll
        for (int v = 0; v < 7; ++v) if (v < wave) { const float nre = pr * gre - pi * gim + ere[v], nim = pr * gim + pi * gre + eim[v]; gre = nre; gim = nim; }
#pragma unroll
        for (int jj = 0; jj < 16; ++jj) {
            LAS bf16_t* row = (LAS bf16_t*)(lds + L_OFF + (wave * 16 + jj) * RSTR);
            row[lane] = f2bf(qre[jj] + gre); row[64 + lane] = f2bf(qim[jj] + gim);
            const float nre = a16.x * gre - a16.y * gim, nim = a16.x * gim + a16.y * gre; gre = nre; gim = nim;
        }
    }
    __syncthreads();
    {
      bf16_t* ypre = (bf16_t*)(ws + OFF_YPRE) + (size_t)b * SEQ * SSM_W + g * 16 + 4 * q;
      const f32x4 dk = *(const f32x4*)(dsk_l + g * 16 + 4 * q);
#pragma unroll
      for (int tt = 0; tt < 2; ++tt) {
          const int t = tt ? 15 - wave : wave, nks = (t >> 1) + 1;
          bf16x8 kf[8], wf[4];
#pragma unroll
          for (int ks = 0; ks < 8; ++ks) kf[ks] = tt ? kfB[ks] : kfA[ks];
#pragma unroll
          for (int k2 = 0; k2 < 4; ++k2) wf[k2] = tt ? wfB[k2] : wfA[k2];
#pragma unroll 1
          for (int nt = 0; nt < 8; ++nt) {
              f32x4 acc = {0.f, 0.f, 0.f, 0.f}, accB = {0.f, 0.f, 0.f, 0.f}, accC = {0.f, 0.f, 0.f, 0.f};
              const LAS unsigned char* ub = lds + U_OFF + (nt * 16 + r16) * RSTR + q * 16;
              const LAS unsigned char* sb = lds + L_OFF + (nt * 16 + r16) * RSTR + q * 16;
#pragma unroll
              for (int ks = 0; ks < 8; ks += 2) { if (ks < nks) acc = __builtin_amdgcn_mfma_f32_16x16x32_bf16(kf[ks], *(const LAS bf16x8*)(ub + ks * 64), acc, 0, 0, 0);
                  if (ks + 1 < nks) accB = __builtin_amdgcn_mfma_f32_16x16x32_bf16(kf[ks + 1], *(const LAS bf16x8*)(ub + (ks + 1) * 64), accB, 0, 0, 0); }
#pragma unroll
              for (int k2 = 0; k2 < 4; ++k2) accC = __builtin_amdgcn_mfma_f32_16x16x32_bf16(wf[k2], *(const LAS bf16x8*)(sb + k2 * 64), accC, 0, 0, 0);
              acc = acc + accB + accC;
              const int tok = 16 * (nt * 16 + r16) + t;
              typedef unsigned u32x2_ __attribute__((ext_vector_type(2)));
              const u32x2_ uu = *(const LAS u32x2_*)(lds + U_OFF + (nt * 16 + r16) * RSTR + t * 32 + q * 8);
              const float y0 = gelu_fast(acc[0] + dk[0] * blo(uu.x)), y1 = gelu_fast(acc[1] + dk[1] * bhi(uu.x)), y2 = gelu_fast(acc[2] + dk[2] * blo(uu.y)), y3 = gelu_fast(acc[3] + dk[3] * bhi(uu.y));
              *(unsigned long long*)(ypre + (size_t)tok * SSM_W) = (unsigned long long)pk2(y0, y1) | ((unsigned long long)pk2(y2, y3) << 32);
          }
      } }
    __syncthreads();
}
}


namespace p4 {
constexpr int XT = 8192, WT = 65536, SLOT = XT + WT;
constexpr int RED_OFF = 2 * SLOT, RED2_OFF = RED_OFF + 2048;
constexpr int JUNK_OFF = RED2_OFF + 2048;
static_assert(JUNK_OFF + 2048 <= MISC_OFF, "P4 LDS map");
constexpr size_t OFF_MG = OFF_T4;
typedef unsigned u32x2 __attribute__((ext_vector_type(2)));
#define P4_WAIT_V(n) asm volatile("s_waitcnt vmcnt(" #n ")" ::: "memory")
#define P4_WAIT_L(n) asm volatile("s_waitcnt lgkmcnt(" #n ")" ::: "memory")
#define P4_BAR __builtin_amdgcn_s_barrier()

struct G64 { const bf16_t* X; const bf16_t* W; int lxs, lws; };
struct Geo { int rr, ch0, foff, wave; };
__device__ __forceinline__ Geo make_geo(int wave, int lane) {
    Geo g; g.rr = lane >> 3; g.ch0 = (lane & 7) ^ (g.rr >> 1); g.wave = wave;
    const int fr = lane & 15, fq = lane >> 4;
    g.foff = fr * 128 + ((fq ^ (fr >> 1)) & 7) * 16;
    return g;
}
__device__ __forceinline__ void stage64_piece(LAS unsigned char* lds, const Geo& g, const G64& d, int kt, int slot, int p) {
    const unsigned ldsw = (unsigned)g.wave * 1024u;
    if (p == 0) { const unsigned vo = ((unsigned)g.rr << d.lxs) + (unsigned)((g.ch0 ^ ((g.wave & 1) << 2)) * 16);
        __builtin_amdgcn_global_load_lds((const unsigned*)((const char*)d.X + (size_t)kt * 128 + ((size_t)(8 * g.wave) << d.lxs) + vo), (LAS unsigned*)(lds + slot * SLOT + ldsw), 16, 0, 0); }
    else { const int i = p - 1; const unsigned vo = ((unsigned)(16 * (g.rr >> 2) + (g.rr & 3)) << d.lws) + (unsigned)((g.ch0 ^ ((i & 1) << 2)) * 16);
        __builtin_amdgcn_global_load_lds((const unsigned*)((const char*)d.W + (size_t)kt * 128 + ((size_t)(64 * g.wave + 32 * (i & 1) + 4 * (i >> 1)) << d.lws) + vo), (LAS unsigned*)(lds + slot * SLOT + XT + ldsw * 8 + i * 1024), 16, 0, 0); }
}
__device__ __forceinline__ void stage64(LAS unsigned char* lds, const Geo& g, const G64& d, int kt, int slot, int parts) {
    if (parts & 1) stage64_piece(lds, g, d, kt, slot, 0);
    if (parts & 2) {
#pragma unroll
        for (int p = 1; p < 9; ++p) stage64_piece(lds, g, d, kt, slot, p);
    }
}
template <int NKT>
__device__ __forceinline__ void run64(f32x4 (&acc)[4][4], LAS unsigned char* lds, const Geo& g, const G64& cur, const G64& nxt, int nparts, int rot, int nrot) {
#define P4_READS(k) do { _Pragma("unroll") for (int m = 0; m < 4; ++m) xf[m] = *(const LAS bf16x8*)(sb + (g.foff ^ ((k) * 64)) + m * 2048); \
        _Pragma("unroll") for (int n = 0; n < 4; ++n) wf[n] = *(const LAS bf16x8*)(sb + XT + g.wave * 8192 + (g.foff ^ ((k) * 64)) + n * 2048); } while (0)
#define P4_MFMA(e) do { acc[((e) >> 2) & 3][(e) & 3] = __builtin_amdgcn_mfma_f32_16x16x32_bf16(wf[(e) & 3], xf[((e) >> 2) & 3], acc[((e) >> 2) & 3][(e) & 3], 0, 0, 0); } while (0)
#pragma unroll 1
    for (int kt = 0; kt + 1 < NKT; ++kt) {
        const int slot = kt & 1, ktn = (kt + 1 + rot) & (NKT - 1);
        P4_WAIT_V(0); P4_WAIT_L(0); P4_BAR;
        const LAS unsigned char* sb = lds + slot * SLOT; bf16x8 xf[4], wf[4];
        P4_READS(0);
#pragma unroll
        for (int i = 0; i < 5; ++i) { P4_MFMA(3 * i); P4_MFMA(3 * i + 1); P4_MFMA(3 * i + 2); stage64_piece(lds, g, cur, ktn, slot ^ 1, i); __builtin_amdgcn_sched_barrier(0); }
        P4_MFMA(15);
        __builtin_amdgcn_sched_barrier(0);
        P4_READS(1);
#pragma unroll
        for (int i = 0; i < 4; ++i) { P4_MFMA(4 * i); P4_MFMA(4 * i + 1); P4_MFMA(4 * i + 2); P4_MFMA(4 * i + 3); stage64_piece(lds, g, cur, ktn, slot ^ 1, 5 + i); __builtin_amdgcn_sched_barrier(0); }
    }
    {   const int kt = NKT - 1, slot = kt & 1;
        P4_WAIT_V(0); P4_WAIT_L(0); P4_BAR;
        if (nparts) stage64(lds, g, nxt, nrot, slot ^ 1, nparts);
        const LAS unsigned char* sb = lds + slot * SLOT; bf16x8 xf[4], wf[4];
#pragma unroll
        for (int k = 0; k < 2; ++k) { P4_READS(k);
#pragma unroll
            for (int e = 0; e < 16; ++e) P4_MFMA(e); }
    }
    P4_WAIT_L(0); P4_BAR;
#undef P4_READS
#undef P4_MFMA
}
__device__ __forceinline__ float sum_q(float v) {
    v += __builtin_bit_cast(float, __builtin_amdgcn_ds_swizzle(__builtin_bit_cast(int, v), 0x401F));
    const auto rr = __builtin_amdgcn_permlane32_swap(__float_as_uint(v), __float_as_uint(v), false, false);
    return __uint_as_float(rr[0]) + __uint_as_float(rr[1]);
}
#define P4_ZERO(A) do { _Pragma("unroll") for (int m_ = 0; m_ < 4; ++m_) _Pragma("unroll") for (int n_ = 0; n_ < 4; ++n_) A[m_][n_] = (f32x4){0.f, 0.f, 0.f, 0.f}; } while (0)

__device__ __forceinline__ void unit(const Args& a, LAS unsigned char* lds, unsigned char* ws, int layer, int u, unsigned long long& ts_sum, unsigned long long& ts_t0, int wave_s, bool dry = false) {
    const int tid = tid_from(wave_s), wave = wave_s, lane = tid & 63, q = lane >> 4, r16 = lane & 15;
    const size_t row0 = (size_t)u * 64;
    const bf16_t* gz = (const bf16_t*)(ws + OFF_GZ);
    const unsigned lo5 = (unsigned)(r16 * SSM_W + 16 * q), lo10 = (unsigned)(r16 * D_MODEL + 16 * q); static_assert(GZ_W == D_MODEL, "lop == lo10");
#define lop lo10
    const bf16_t* projr = gz + row0 * GZ_W;
    const unsigned char* g8r = (const unsigned char*)(ws + OFF_G8) + row0 * G8_W; const unsigned lo8 = (unsigned)(r16 * G8_W + 16 * q);
    bf16_t* Y1 = (bf16_t*)(ws + OFF_YPRE) + row0 * SSM_W;
    bf16_t* YA = (bf16_t*)(ws + OFF_AO) + row0 * ATT_W;
    bf16_t* YS = (bf16_t*)(ws + OFF_AO) + ((size_t)MTOK + row0) * ATT_W;
    bf16_t* MG = (bf16_t*)(ws + OFF_MG) + row0 * D_MODEL;
    if (W_TOUCH && layer + 1 < DEPTH && u < 256) {
        const char* wn_ = (const char*)(ws + OFF_WIN) + (size_t)(layer + 1) * IN_COLS * D_MODEL * 2 + ((size_t)u * 512 + (size_t)wave * 64 + (size_t)(tid_from(wave_s) & 63)) * 128;
        __builtin_amdgcn_global_load_lds((const unsigned*)wn_, (LAS unsigned*)(lds + JUNK_OFF + wave * 256), 4, 0, 0);
    }
    { const Geo geo0 = make_geo(wave, lane); const G64 dGLU0{Y1, (const bf16_t*)(ws + OFF_WGLU) + (size_t)layer * SSM_W * SSM_W, 10, 10}; stage64(lds, geo0, dGLU0, u & 7, 0, 3); }
    TS_BEGIN(41);
    {
        const int cc = (tid & 63) * 8, rb = tid >> 6, j = cc >> 7;
        const bf16_t* ao = (const bf16_t*)(ws + OFF_AO); const float* ls = (const float*)(ws + OFF_ALSE);
#pragma unroll 1
        for (int kb = 0; kb < 8; kb += 4) {
            u32x4 a0[4], a1[4], a2[4], za[4]; float l0[4], l1[4], l2[4];
#pragma unroll
            for (int i = 0; i < 4; ++i) { const int row = rb + 8 * (kb + i); const size_t tok = row0 + row;
                l0[i] = ls[((size_t)0 * MTOK + tok) * 4 + j]; l1[i] = ls[((size_t)1 * MTOK + tok) * 4 + j]; l2[i] = ls[((size_t)2 * MTOK + tok) * 4 + j];
                a0[i] = __builtin_nontemporal_load((const u32x4*)(ao + ((size_t)0 * MTOK + tok) * ATT_W + cc)); a1[i] = __builtin_nontemporal_load((const u32x4*)(ao + ((size_t)1 * MTOK + tok) * ATT_W + cc)); a2[i] = __builtin_nontemporal_load((const u32x4*)(ao + ((size_t)2 * MTOK + tok) * ATT_W + cc));
                za[i] = __builtin_nontemporal_load((const u32x4*)(gz + tok * GZ_W + GZ_ZA + cc)); }
#pragma unroll
            for (int i = 0; i < 4; ++i) { const int row = rb + 8 * (kb + i);
                const float mx = fmaxf(l0[i], fmaxf(l1[i], l2[i])); float w0 = __builtin_amdgcn_exp2f(l0[i] - mx), w1 = __builtin_amdgcn_exp2f(l1[i] - mx), w2 = __builtin_amdgcn_exp2f(l2[i] - mx);
                const float iw = __builtin_amdgcn_rcpf(w0 + w1 + w2); w0 *= iw; w1 *= iw; w2 *= iw;
#define MRG(A0, A1, A2, Z) pk2((w0 * blo(A0) + w1 * blo(A1) + w2 * blo(A2)) * blo(Z), (w0 * bhi(A0) + w1 * bhi(A1) + w2 * bhi(A2)) * bhi(Z))
                u32x4 y; y.x = MRG(a0[i].x, a1[i].x, a2[i].x, za[i].x); y.y = MRG(a0[i].y, a1[i].y, a2[i].y, za[i].y); y.z = MRG(a0[i].z, a1[i].z, a2[i].z, za[i].z); y.w = MRG(a0[i].w, a1[i].w, a2[i].w, za[i].w);
#undef MRG
                *(u32x4*)(YA + (size_t)row * ATT_W + cc) = y; }
        }
    }
    VM_WAIT(); __syncthreads();
    TS_END(41); TS_BEGIN(42);
    const int nbw = wave * 64;
    const int r8 = u & 7, r16t = u & 15;
    const Geo geo = make_geo(wave, lane);
    const G64 dGLU{Y1, (const bf16_t*)(ws + OFF_WGLU) + (size_t)layer * SSM_W * SSM_W, 10, 10};
    const bf16_t* WBSl = (const bf16_t*)(ws + OFF_WBS) + (size_t)layer * D_MODEL * SSM_W; const bf16_t* WBAl = (const bf16_t*)(ws + OFF_WBA) + (size_t)layer * D_MODEL * ATT_W;
    const bf16_t* WOl = (const bf16_t*)(ws + OFF_WOUT) + (size_t)layer * D_MODEL * D_MODEL;
    const G64 dOUT0{MG, WOl, 11, 11}, dOUT1{MG, WOl + (size_t)512 * D_MODEL, 11, 11};
    {
        f32x4 acc[4][4]; P4_ZERO(acc);
        const G64 dBS0{YS, WBSl, 10, 10};
        const float* bg = inptr(a, IN_BGLU) + layer * SSM_W;
        f32x4 b4[4];
#pragma unroll
        for (int n = 0; n < 4; ++n) b4[n] = *(const f32x4*)(bg + (nbw + n * 4) + (unsigned)(((tid_from(wave_s) >> 4) & 3) * 16));
        run64<8>(acc, lds, geo, dGLU, dBS0, 2, r8, r8);
        {   u32x4 y1[4][2], zs[4][2];
#pragma unroll
            for (int m = 0; m < 4; ++m)
#pragma unroll
                for (int h = 0; h < 2; ++h) { y1[m][h] = *(const u32x4*)(Y1 + (m * 16 * SSM_W + nbw + h * 8) + lo5); zs[m][h] = __builtin_nontemporal_load((const u32x4*)(projr + (GZ_ZS + m * 16 * GZ_W + nbw + h * 8) + lop)); }
#pragma unroll
            for (int m = 0; m < 4; ++m) { u32x4 o[2];
#pragma unroll
                for (int n = 0; n < 4; ++n) { const unsigned yx = y1[m][n >> 1][(n & 1) * 2], yy = y1[m][n >> 1][(n & 1) * 2 + 1], zx = zs[m][n >> 1][(n & 1) * 2], zy = zs[m][n >> 1][(n & 1) * 2 + 1];
                    o[n >> 1][(n & 1) * 2] = pk2(blo(yx) * sig_fast(acc[m][n][0] + b4[n][0]) * blo(zx), bhi(yx) * sig_fast(acc[m][n][1] + b4[n][1]) * bhi(zx));
                    o[n >> 1][(n & 1) * 2 + 1] = pk2(blo(yy) * sig_fast(acc[m][n][2] + b4[n][2]) * blo(zy), bhi(yy) * sig_fast(acc[m][n][3] + b4[n][3]) * bhi(zy)); }
#pragma unroll
                for (int h = 0; h < 2; ++h) *(u32x4*)(YS + (m * 16 * SSM_W + nbw + h * 8) + lo5) = o[h]; }
        }
        VM_WAIT(); __syncthreads();
        stage64(lds, geo, dBS0, r8, 0, 1);
    }
    TS_END(42); TS_BEGIN(43);
#pragma unroll 1
    for (int ps = 0; ps < 2; ++ps) {
        f32x4 as[4][4], aa[4][4]; P4_ZERO(as); P4_ZERO(aa);
        const G64 dBS{YS, WBSl + (size_t)ps * 512 * SSM_W, 10, 10}, dBA{YA, WBAl + (size_t)ps * 512 * ATT_W, 10, 10};
        const G64 dBSn{YS, WBSl + (size_t)512 * SSM_W, 10, 10};
        run64<8>(as, lds, geo, dBS, dBA, 3, r8, r8);
        if (ps == 0) run64<8>(aa, lds, geo, dBA, dBSn, 3, r8, r8);
        else run64<8>(aa, lds, geo, dBA, dOUT0, 2, r8, r16t);
        {   u32x4 gs[4], ga[4];
#pragma unroll
            for (int m = 0; m < 4; ++m) { const int bo = m * 16 * G8_W + ps * 512 + nbw; gs[m] = __builtin_nontemporal_load((const u32x4*)(g8r + (G8_GS + bo) + lo8)); ga[m] = __builtin_nontemporal_load((const u32x4*)(g8r + (G8_GA + bo) + lo8)); }
#define P4_UB(w, e) ((float)(((w) >> (8 * (e))) & 0xffu) * (1.0f / 255.0f))
#pragma unroll
            for (int m = 0; m < 4; ++m) { u32x4 o[2];
#pragma unroll
                for (int n = 0; n < 4; ++n) { const unsigned gsw = gs[m][n], gaw = ga[m][n];
                    o[n >> 1][(n & 1) * 2] = pk2(P4_UB(gsw, 0) * as[m][n][0] + P4_UB(gaw, 0) * aa[m][n][0], P4_UB(gsw, 1) * as[m][n][1] + P4_UB(gaw, 1) * aa[m][n][1]);
                    o[n >> 1][(n & 1) * 2 + 1] = pk2(P4_UB(gsw, 2) * as[m][n][2] + P4_UB(gaw, 2) * aa[m][n][2], P4_UB(gsw, 3) * as[m][n][3] + P4_UB(gaw, 3) * aa[m][n][3]); }
#pragma unroll
                for (int h = 0; h < 2; ++h) *(u32x4*)(MG + (m * 16 * D_MODEL + ps * 512 + nbw + h * 8) + lo10) = o[h]; }
#undef P4_UB
        }
    }
    VM_WAIT(); __syncthreads();
    stage64(lds, geo, dOUT0, r16t, 0, 1);
    TS_END(43); TS_BEGIN(44);
    {
        f32x4 acc0[4][4], acc1[4][4]; P4_ZERO(acc0); P4_ZERO(acc1);
        run64<16>(acc0, lds, geo, dOUT0, dOUT1, 3, r16t, r16t);
        run64<16>(acc1, lds, geo, dOUT1, dOUT1, 0, r16t, 0);
        TS_END(44); TS_BEGIN(45);
        LAS float* RED = (LAS float*)(lds + RED_OFF); LAS float* RED2 = (LAS float*)(lds + RED2_OFF);
        float inv[4];
#pragma unroll
        for (int m = 0; m < 4; ++m) { float s = 0.f;
#pragma unroll
            for (int n = 0; n < 4; ++n) { s += (acc0[m][n][0] * acc0[m][n][0] + acc0[m][n][1] * acc0[m][n][1]) + (acc0[m][n][2] * acc0[m][n][2] + acc0[m][n][3] * acc0[m][n][3]);
                                          s += (acc1[m][n][0] * acc1[m][n][0] + acc1[m][n][1] * acc1[m][n][1]) + (acc1[m][n][2] * acc1[m][n][2] + acc1[m][n][3] * acc1[m][n][3]); }
            s = sum_q(s); if (q == 0) RED[(m * 16 + r16) * 8 + wave] = s; }
        __syncthreads();
#pragma unroll
        for (int m = 0; m < 4; ++m) { const LAS f32x4* rp = (const LAS f32x4*)(RED + (m * 16 + r16) * 8); const f32x4 r0 = rp[0], r1 = rp[1];
            inv[m] = rsqrtf(((r0[0] + r0[1]) + (r0[2] + r0[3]) + (r1[0] + r1[1]) + (r1[2] + r1[3])) * (1.0f / D_MODEL) + RMS_EPS); }
        const float* pg = inptr(a, IN_POSTG) + layer * D_MODEL; float* xor_ = a.p.out + row0 * D_MODEL; bf16_t* xbr = (bf16_t*)(ws + OFF_XB) + row0 * D_MODEL;
        float s2[4] = {0.f, 0.f, 0.f, 0.f};
        const unsigned lq4 = (unsigned)(((tid_from(wave_s) >> 4) & 3) * 16);
#define P4_RES(ACC, PS) do { f32x4 g4[4]; u32x4 xp[4][2]; \
            _Pragma("unroll") for (int n = 0; n < 4; ++n) g4[n] = *(const f32x4*)(pg + ((PS) * 512 + nbw + n * 4) + lq4); \
            _Pragma("unroll") for (int m = 0; m < 4; ++m) _Pragma("unroll") for (int h = 0; h < 2; ++h) xp[m][h] = *(const u32x4*)(xbr + (m * 16 * D_MODEL + (PS) * 512 + nbw + h * 8) + lo10); \
            __builtin_amdgcn_s_waitcnt(0);     \
            _Pragma("unroll") for (int m = 0; m < 4; ++m) { u32x4 o[2]; \
                _Pragma("unroll") for (int n = 0; n < 4; ++n) { const int bo = m * 16 * D_MODEL + (PS) * 512 + nbw + n * 4; const unsigned px = xp[m][n >> 1][(n & 1) * 2], py = xp[m][n >> 1][(n & 1) * 2 + 1]; \
                    f32x4 xv = {blo(px), bhi(px), blo(py), bhi(py)}; xv = xv + ACC[m][n] * inv[m] * g4[n]; \
                    o[n >> 1][(n & 1) * 2] = pk2(xv[0], xv[1]); o[n >> 1][(n & 1) * 2 + 1] = pk2(xv[2], xv[3]); \
                    if (!dry && layer == DEPTH - 1) *(f32x4*)(xor_ + bo + lo10) = xv; \
                    s2[m] += (xv[0] * xv[0] + xv[1] * xv[1]) + (xv[2] * xv[2] + xv[3] * xv[3]); } \
                if (!dry) { if (layer != DEPTH - 1) { _Pragma("unroll") for (int h = 0; h < 2; ++h) *(u32x4*)(xbr + (m * 16 * D_MODEL + (PS) * 512 + nbw + h * 8) + lo10) = o[h]; } } \
                else { asm volatile("" :: "v"(o[0].x), "v"(o[0].y), "v"(o[1].x), "v"(o[1].y)); } } } while (0)
        P4_RES(acc0, 0); P4_RES(acc1, 1);
#undef P4_RES
#pragma unroll
        for (int m = 0; m < 4; ++m) { const float s = sum_q(s2[m]); if (q == 0) RED2[(m * 16 + r16) * 8 + wave] = s; }
        __syncthreads();
        if (wave == 0 && !dry) { const int tl = tid_from(wave_s) & 63;
            const LAS f32x4* rp = (const LAS f32x4*)(RED2 + tl * 8); const f32x4 r0 = rp[0], r1 = rp[1];
            ((float*)(ws + OFF_ROWSS))[row0 + tl] = (r0[0] + r0[1]) + (r0[2] + r0[3]) + (r1[0] + r1[1]) + (r1[2] + r1[3]); }
    }
    VM_WAIT(); __syncthreads();
    TS_END(45);
}
#undef P4_ZERO
#undef lop
}

__device__ __forceinline__ void p0_transpose_item(const float* W, const float* rs, int K, int N, bf16_t* WT, LAS float* scr, int item, int lane, bool vperm, bool ntst) {
    const int nblk = N / 32, kb = item / nblk, nb = item % nblk, k0 = 64 * kb, n0 = 32 * nb;
    const int kr = lane >> 3, n4 = (lane & 7) * 4;
    f32x4 v[8];
#pragma unroll
    for (int i = 0; i < 8; ++i) v[i] = __builtin_nontemporal_load((const f32x4*)(W + (size_t)(k0 + 8 * i + kr) * N + n0 + n4));
    if (rs) {
#pragma unroll
        for (int i = 0; i < 8; ++i) v[i] = v[i] * rs[k0 + 8 * i + kr];
    }
#pragma unroll
    for (int i = 0; i < 8; ++i) { LAS float* d = scr + (8 * i + kr) * 33 + n4; d[0] = v[i][0]; d[1] = v[i][1]; d[2] = v[i][2]; d[3] = v[i][3]; }
    LDS_WAIT(); asm volatile("" ::: "memory");
    const int c = lane & 7;
#pragma unroll
    for (int j = 0; j < 4; ++j) { const int n = (lane >> 3) + 8 * j; const LAS float* s = scr + (8 * c) * 33 + n;
        u32x4 o; o.x = pk2(s[0 * 33], s[1 * 33]); o.y = pk2(s[2 * 33], s[3 * 33]); o.z = pk2(s[4 * 33], s[5 * 33]); o.w = pk2(s[6 * 33], s[7 * 33]);
        int nd = n0 + n;
        if (vperm && nd >= C_V && nd < C_ZA) { const int cc = nd & 127; nd = (nd & ~127) + (cc & 3) * 32 + (cc >> 2); }
        if (ntst) __builtin_nontemporal_store(o, (u32x4*)(WT + (size_t)nd * K + k0 + 8 * c)); else *(u32x4*)(WT + (size_t)nd * K + k0 + 8 * c) = o; }
    LDS_WAIT(); asm volatile("" ::: "memory");
}
__device__ __forceinline__ void p0_prologue(const Frame& F, const Args& a) {
    const int lane_ = tid_from(F.wave) & 63;
    LAS float* scr = (LAS float*)(F.lds + F.wave * 16384);
    const int gw = F.vcu * NWAVES + F.wave, NGW = F.G * NWAVES;
    constexpr int I_IN = (D_MODEL / 64) * (IN_COLS / 32), I_GLU = (SSM_W / 64) * (SSM_W / 32), I_BS = (SSM_W / 64) * (D_MODEL / 32), I_OUT = (D_MODEL / 64) * (D_MODEL / 32);
    constexpr int PER_L = I_IN + I_GLU + 2 * I_BS + I_OUT, NITEMS = DEPTH * PER_L;
    unsigned char* ws = a.p.ws;
    for (int lg = F.vcu; lg < DEPTH * SSM_NG; lg += F.G) s5::tables_wg(a, F.lds, lg, F.wave);
    constexpr int NTAB = DEPTH * SSM_NG, RA = 7;
    const bool bal = F.G > NTAB && RA * NGW < NITEMS;
    const int NA = bal ? RA * NGW : NITEMS, gw2 = gw - NTAB * NWAVES, NGW2 = (F.G - NTAB) * NWAVES;
    for (int k = 0; ; ++k) {
        const int it = (!bal || k < RA) ? gw + k * NGW : (gw2 >= 0 ? NA + gw2 + (k - RA) * NGW2 : NITEMS);
        if (it >= NITEMS || (bal && k < RA && it >= NA)) break;
        const int l = it / PER_L; int r = it - l * PER_L;
        int widx, K, N; size_t dst;
        if (r < I_IN) { widx = IN_WIN; K = D_MODEL; N = IN_COLS; dst = OFF_WIN; }
        else if ((r -= I_IN) < I_GLU) { widx = IN_WGLU; K = SSM_W; N = SSM_W; dst = OFF_WGLU; }
        else if ((r -= I_GLU) < I_BS) { widx = IN_WBS; K = SSM_W; N = D_MODEL; dst = OFF_WBS; }
        else if ((r -= I_BS) < I_BS) { widx = IN_WBA; K = ATT_W; N = D_MODEL; dst = OFF_WBA; }
        else { r -= I_BS; widx = IN_WOUT; K = D_MODEL; N = D_MODEL; dst = OFF_WOUT; }
        const float* W = inptr(a, widx) + (size_t)l * K * N;
        const float* rs = (widx == IN_WIN) ? inptr(a, IN_PREG) + l * D_MODEL : nullptr;
        p0_transpose_item(W, rs, K, N, (bf16_t*)(ws + dst) + (size_t)l * K * N, scr, r, lane_, ATTN_DMA == 3 && widx == IN_WIN, l > 0);
    }
    const float* X = inptr(a, IN_X);
    for (int m = gw; m < MTOK; m += 2 * NGW) {
        const int m1 = m + NGW; const bool has1 = m1 < MTOK;
        const f32x4* xr0 = (const f32x4*)(X + (size_t)m * D_MODEL) + lane_; const f32x4* xr1 = (const f32x4*)(X + (size_t)(has1 ? m1 : m) * D_MODEL) + lane_;
        f32x4 v0[4], v1[4];
#pragma unroll
        for (int j = 0; j < 4; ++j) { v0[j] = __builtin_nontemporal_load(xr0 + 64 * j); v1[j] = __builtin_nontemporal_load(xr1 + 64 * j); }
#pragma unroll
        for (int r = 0; r < 2; ++r) {
            if (r == 1 && !has1) break;
            const int mm = r ? m1 : m;
            unsigned long long* o8 = (unsigned long long*)((bf16_t*)(ws + OFF_XB) + (size_t)mm * D_MODEL) + lane_;
            float sq = 0.f;
#pragma unroll
            for (int j = 0; j < 4; ++j) { const f32x4 v = r ? v1[j] : v0[j]; sq += (v[0] * v[0] + v[1] * v[1]) + (v[2] * v[2] + v[3] * v[3]);
                o8[64 * j] = (unsigned long long)pk2(v[0], v[1]) | ((unsigned long long)pk2(v[2], v[3]) << 32); }
            sq = wave_sum(sq);
            if (lane_ == 0) ((float*)(ws + OFF_ROWSS))[mm] = sq;
        }
    }
}

constexpr int N_PHASES = 1 + 3 * DEPTH;
__global__ void __launch_bounds__(NTHREADS, 2) mega(Args a) {
    extern __shared__ __attribute__((aligned(16))) unsigned char lds_raw[];
    Frame F; F.lds = (LAS unsigned char*)lds_raw; F.wave = __builtin_amdgcn_readfirstlane((int)threadIdx.x >> 6);
    F.G = gridDim.x; { const int bx = blockIdx.x; F.vcu = (F.G % 8 == 0) ? (bx % 8) * (F.G / 8) + bx / 8 : bx; }
    volatile LAS unsigned* MISC = (volatile LAS unsigned*)(F.lds + MISC_OFF);
    { const int t0_ = tid_from(F.wave); if (t0_ < 64) MISC[t0_] = 0u; }
    __syncthreads();
    const bool grouped = (F.G % 8 == 0) && (a.ph_lo == 0) && (a.ph_hi == N_PHASES);
    unsigned* bw = (unsigned*)(a.p.ws + OFF_CTL) + CW_BAR + a.bar_region * XCD_BAR_WORDS;
    XcdBarrier gbar = xcd_barrier_post(bw, MISC + 8, F.wave, (unsigned)F.G);
    XcdBarrier lbar = gbar;
    if (grouped) lbar = xcd_barrier_post(bw + (1 + (blockIdx.x & 7)) * XCD_BAR_WORDS, MISC + 10, F.wave, (unsigned)F.G / 8u);
    unsigned long long ts_sum = 0, ts_t0 = 0;
    TS_BEGIN(100);
    for (int ph = a.ph_lo; ph < a.ph_hi; ++ph) {
        TS_BEGIN(9); if (ph > 0 && (ph - 1) % 3 == 0) TS_BEGIN(93); if (ph > 0 && (ph - 1) % 3 == 1) TS_BEGIN(91); if (ph > 0 && (ph - 1) % 3 == 2) TS_BEGIN(92);
        if (ph > a.ph_lo) { if (ph == 1 || !grouped) xcd_barrier(gbar); else xcd_barrier(lbar); }
        if (GRP_DELAY_NS != 0 && grouped && ph == 1) {
            const unsigned long long ticks_ = (unsigned long long)((blockIdx.x & 7) % GRP_DELAY_MOD) * (GRP_DELAY_NS / 10), t0_ = __builtin_amdgcn_s_memrealtime();
            while (__builtin_amdgcn_s_memrealtime() - t0_ < ticks_) __builtin_amdgcn_s_sleep(8);
        }
        TS_END(9); if (ph > 0 && (ph - 1) % 3 == 0) TS_END(93); if (ph > 0 && (ph - 1) % 3 == 1) TS_END(91); if (ph > 0 && (ph - 1) % 3 == 2) TS_END(92);
#if PROBE_DUP == 6
        if (ph > a.ph_lo) { if (ph == 1 || !grouped) xcd_barrier(gbar); else xcd_barrier(lbar); }
#endif
        size_t wz_ = 0; asm volatile("" : "+s"(wz_)); unsigned char* ws = a.p.ws + wz_;
        int vcu_ = F.vcu; asm volatile("" : "+s"(vcu_));
        Frame Fp; Fp.lds = F.lds; Fp.wave = F.wave; Fp.G = F.G; Fp.vcu = vcu_;
#if PROBE_DUP == 5
        if (ph == 0) {
#pragma unroll 1
            for (int rep = 0; rep < 2; ++rep) { p0_prologue(Fp, a); __syncthreads(); }
            continue; }
#endif
        if (ph == 0) { TS_BEGIN(10); p0_prologue(Fp, a); TS_END(10); continue; }
        const int l = (ph - 1) / 3, k = (ph - 1) % 3;
        if (k == 0) {
            TS_BEGIN(1); if (l == 0) TS_BEGIN(18); if (l == 3) TS_BEGIN(19);
            pg8::Gemm g{(const bf16_t*)(ws + OFF_XB), (const bf16_t*)(ws + OFF_WIN) + (size_t)l * IN_COLS * D_MODEL, MTOK, IN_COLS, D_MODEL, P1_XROT ? 8 * (((int)blockIdx.x & 7) >> 2) : 0};
            int bid_ = blockIdx.x; asm volatile("" : "+s"(bid_));
            pg8::StaticOrder S; S.init(MTOK, IN_COLS, Fp.G, bid_);
            pg8::EpiInProj E{ws, (const float*)(ws + OFF_ROWSS)};
#if PROBE_DUP == 1
#pragma unroll 1
            for (int rep = 0; rep < 2; ++rep)
#endif
            pg8::gemm_phase<pg8::EpiInProj, pg8::StaticOrder, true, true>(Fp.lds, g, S, E, Fp.wave, ts_sum, ts_t0);
            TS_END(1); if (l == 0) TS_END(18); if (l == 3) TS_END(19);
        }
#if EXP_HALF
        else if (EXP_HALF == 1 && (blockIdx.x & 7) >= 4) { }
#endif
        else if (k == 1) {
            TS_BEGIN(2);
#if PROBE_DUP == 2
#pragma unroll 1
            for (int rep = 0; rep < 2; ++rep)
#endif
            for (int u = Fp.vcu; u < BATCH * SSM_NG; u += Fp.G) s5::unit(Fp.lds, ws, l, u >> 5, u & 31, Fp.wave, inptr(a, IN_DSKIP) + l * SSM_W);
            TS_END(2); TS_BEGIN(3);
#if PROBE_DUP == 3
#pragma unroll 1
            for (int rep = 0; rep < 2; ++rep)
#endif
#if ATTN_WAVE
            wsa::phase(Fp, ws);
            __syncthreads();
#else
            attn_phase(Fp, ws, l, ts_sum, ts_t0);
#endif
            TS_END(3);
        }
        else {
            TS_BEGIN(4);
#if PROBE_DUP == 4
#pragma unroll 1
            for (int rep = 0; rep < 2; ++rep)
            for (int u = Fp.vcu; u < MTOK / 64; u += Fp.G) p4::unit(a, Fp.lds, ws, l, u, ts_sum, ts_t0, Fp.wave, rep == 0);
#else
#if EXP_HALF == 2
            if (!(Fp.vcu & 1)) for (int u = Fp.vcu; u < MTOK / 64; u += Fp.G) { for (int e = 0; e < 2; ++e) p4::unit(a, Fp.lds, ws, l, u + e, ts_sum, ts_t0, Fp.wave); }
#else
            for (int u = Fp.vcu; u < MTOK / 64; u += Fp.G) p4::unit(a, Fp.lds, ws, l, u, ts_sum, ts_t0, Fp.wave);
#endif
#endif
            TS_END(4);
        }
    }
    TS_END(100);
    if (TS_ID != 0 && blockIdx.x == 0 && tid_from(F.wave) == 0) { asm volatile("s_waitcnt vmcnt(0)" ::: "memory"); a.p.out[0] += (float)ts_sum * 0.001f; }
}

#ifndef ONE_LAUNCH
#define ONE_LAUNCH 1
#endif
#ifndef OPT_P0
#define OPT_P0 1
#endif
#ifndef OPT_P1
#define OPT_P1 1
#endif
#ifndef OPT_P2
#define OPT_P2 1
#endif
#ifndef OPT_P4
#define OPT_P4 1
#endif
extern "C" void kernel_launch(void* const* d_in, const int* in_sizes, int n_in, void* d_out, int out_size, void* d_ws, size_t ws_size, hipStream_t stream) {
    static int grid = 0;
    if (grid == 0) {
        if (n_in != 17 || out_size != MTOK * D_MODEL || ws_size < WS_END) { fprintf(stderr, "kernel_launch: unexpected shapes/workspace (n_in %d out %d ws %zu)\n", n_in, out_size, ws_size); grid = -1; return; }
        int dev = 0, cus = 0, per_cu = 0;
        if (hipGetDevice(&dev) != hipSuccess || hipDeviceGetAttribute(&cus, hipDeviceAttributeMultiprocessorCount, dev) != hipSuccess) { grid = -1; return; }
        if (hipFuncSetAttribute((const void*)mega, hipFuncAttributeMaxDynamicSharedMemorySize, LDS_BYTES) != hipSuccess) { fprintf(stderr, "kernel_launch: hipFuncSetAttribute failed\n"); grid = -1; return; }
        if (hipOccupancyMaxActiveBlocksPerMultiprocessor(&per_cu, (const void*)mega, NTHREADS, LDS_BYTES) != hipSuccess || per_cu < 1) { fprintf(stderr, "kernel_launch: occupancy query says %d blocks/CU\n", per_cu); per_cu = 1; }
        (void)hipGetLastError();
        grid = cus * (per_cu < 1 ? 1 : 1);
    }
    if (grid < 0) return;
    Params p{};
    for (int i = 0; i < N_IN; ++i) p.in[i] = (const float*)d_in[i];
    p.out = (float*)d_out; p.ws = (unsigned char*)d_ws;
    unsigned char* ws = p.ws;
#if ONE_LAUNCH
    (void)hipMemsetAsync(ws + OFF_CTL + (size_t)CW_BAR * 4, 0, (size_t)9 * XCD_BAR_WORDS * 4, stream);
#else
    (void)hipMemsetAsync(ws + OFF_CTL, 0, CTL_ZERO_BYTES, stream);
#endif
#if EXP_MEMSET2
    (void)hipMemsetAsync(ws + OFF_T2, 0, CTL_ZERO_BYTES, stream);
#endif
    int bar_region = 0;
    auto launch_mega = [&](int lo, int hi) { Args a{}; a.p = p; a.ph_lo = lo; a.ph_hi = hi; a.bar_region = bar_region++; a.pad = 0;
        hipLaunchKernelGGL(mega, dim3(grid), dim3(NTHREADS), LDS_BYTES, stream, a); };
    bf16_t* WIN = (bf16_t*)(ws + OFF_WIN); bf16_t* WGLU = (bf16_t*)(ws + OFF_WGLU); bf16_t* WBS = (bf16_t*)(ws + OFF_WBS); bf16_t* WBA = (bf16_t*)(ws + OFF_WBA); bf16_t* WOUT = (bf16_t*)(ws + OFF_WOUT);
    bf16_t* XB = (bf16_t*)(ws + OFF_XB); bf16_t* PROJ = (bf16_t*)(ws + OFF_PROJ); bf16_t* YPRE = (bf16_t*)(ws + OFF_YPRE); bf16_t* AO = (bf16_t*)(ws + OFF_AO);
    bf16_t* T2 = (bf16_t*)(ws + OFF_T2); bf16_t* T4 = (bf16_t*)(ws + OFF_T4); bf16_t* T5 = AO + (size_t)MTOK * ATT_W; float* OUTF = (float*)(ws + OFF_PROJ);
    const float* ROWSS = (const float*)(ws + OFF_ROWSS);
#if ONE_LAUNCH
    launch_mega(0, N_PHASES);
    return;
#endif
#if OPT_P0
    launch_mega(0, 1);
#else
    const dim3 tb(32, 8);
    for (int l = 0; l < DEPTH; ++l) {
        nv::k_transpose<<<dim3(IN_COLS / 32, D_MODEL / 32), tb, 0, stream>>>(p.in[IN_WIN] + (size_t)l * D_MODEL * IN_COLS, p.in[IN_PREG] + l * D_MODEL, WIN + (size_t)l * IN_COLS * D_MODEL, D_MODEL, IN_COLS);
        nv::k_transpose<<<dim3(SSM_W / 32, SSM_W / 32), tb, 0, stream>>>(p.in[IN_WGLU] + (size_t)l * SSM_W * SSM_W, nullptr, WGLU + (size_t)l * SSM_W * SSM_W, SSM_W, SSM_W);
        nv::k_transpose<<<dim3(D_MODEL / 32, SSM_W / 32), tb, 0, stream>>>(p.in[IN_WBS] + (size_t)l * SSM_W * D_MODEL, nullptr, WBS + (size_t)l * D_MODEL * SSM_W, SSM_W, D_MODEL);
        nv::k_transpose<<<dim3(D_MODEL / 32, ATT_W / 32), tb, 0, stream>>>(p.in[IN_WBA] + (size_t)l * ATT_W * D_MODEL, nullptr, WBA + (size_t)l * D_MODEL * ATT_W, ATT_W, D_MODEL);
        nv::k_transpose<<<dim3(D_MODEL / 32, D_MODEL / 32), tb, 0, stream>>>(p.in[IN_WOUT] + (size_t)l * D_MODEL * D_MODEL, nullptr, WOUT + (size_t)l * D_MODEL * D_MODEL, D_MODEL, D_MODEL);
    }
    nv::k_s5_tables<<<DEPTH * SSM_NG, 64, 0, stream>>>(p);
    nv::k_rows_x<<<MTOK, 256, 0, stream>>>(p);
#endif
    for (int l = 0; l < DEPTH; ++l) {
#if OPT_P1
        launch_mega(1 + 3 * l, 2 + 3 * l);
#else
        nv::k_gemm<nv::EpiInProj><<<dim3(IN_COLS / 128, MTOK / 128), 256, 0, stream>>>(XB, D_MODEL, WIN + (size_t)l * IN_COLS * D_MODEL, D_MODEL, D_MODEL, nv::EpiInProj{ROWSS, PROJ});
#endif
#if OPT_P2
        launch_mega(2 + 3 * l, 3 + 3 * l);
#else
        nv::k_attn<<<MTOK * 12 / 4, 256, 0, stream>>>(p);
        nv::k_s5<<<BATCH * SSM_NG, 64, 0, stream>>>(p, l);
#endif
#if OPT_P4
        launch_mega(3 + 3 * l, 4 + 3 * l);
#else
        nv::k_p4a<<<MTOK * SSM_W / 256, 256, 0, stream>>>(p, l);
        nv::k_gemm<nv::EpiGlu><<<dim3(SSM_W / 128, MTOK / 128), 256, 0, stream>>>(YPRE, SSM_W, WGLU + (size_t)l * SSM_W * SSM_W, SSM_W, SSM_W, nv::EpiGlu{YPRE, PROJ, p.in[IN_BGLU] + l * SSM_W, T2});
        nv::k_merge<<<MTOK * ATT_W / 256, 256, 0, stream>>>(p);
        nv::k_gemm<nv::EpiGate1><<<dim3(D_MODEL / 128, MTOK / 128), 256, 0, stream>>>(T2, SSM_W, WBS + (size_t)l * D_MODEL * SSM_W, SSM_W, SSM_W, nv::EpiGate1{PROJ, T4});
        nv::k_gemm<nv::EpiGate2><<<dim3(D_MODEL / 128, MTOK / 128), 256, 0, stream>>>(AO, ATT_W, WBA + (size_t)l * D_MODEL * ATT_W, ATT_W, ATT_W, nv::EpiGate2{PROJ, T4, T5});
        nv::k_gemm<nv::EpiF32><<<dim3(D_MODEL / 128, MTOK / 128), 256, 0, stream>>>(T5, D_MODEL, WOUT + (size_t)l * D_MODEL * D_MODEL, D_MODEL, D_MODEL, nv::EpiF32{OUTF, D_MODEL});
        nv::k_postnorm<<<MTOK, 256, 0, stream>>>(p, l, OUTF);
#endif
    }
}
```

```cpp
#include <hip/hip_runtime.h>
#include <cstdio>
#include <cstdint>
#ifndef ATTN_DMA
#define ATTN_DMA 3
#endif
#ifndef ATTN_WAVE
#define ATTN_WAVE 0
#endif
#ifndef EXP_MEMSET2
#define EXP_MEMSET2 0
#endif
#ifndef EXP_HALF
#define EXP_HALF 0
#endif
#ifndef EXP_NOSTORE
#define EXP_NOSTORE 0
#endif
#ifndef TS_ID
#define TS_ID 0
#endif
#ifndef P1_NT
#define P1_NT 0
#endif
#ifndef P1_SHAPE
#define P1_SHAPE 1
#endif
#ifndef BAR_TOUCH
#define BAR_TOUCH 1
#endif
#ifndef W_TOUCH
#define W_TOUCH (!BAR_TOUCH)
#endif
#ifndef W_TOUCH2
#define W_TOUCH2 (BAR_TOUCH ? 0 : 2)
#endif
#ifndef SEAM_RELAX
#define SEAM_RELAX 1
#endif
#ifndef GRP_DELAY_NS
#define GRP_DELAY_NS 0
#endif
#ifndef GRP_DELAY_MOD
#define GRP_DELAY_MOD 2
#endif
#define TS_BEGIN(id) do { if (TS_ID == (id)) ts_t0 = __builtin_amdgcn_s_memrealtime(); } while (0)
#define TS_END(id) do { if (TS_ID == (id)) ts_sum += __builtin_amdgcn_s_memrealtime() - ts_t0; } while (0)

constexpr int D_MODEL = 1024, BATCH = 8, SEQ = 2048, DEPTH = 4, MTOK = BATCH * SEQ;
constexpr int SSM_W = 512, SSM_CH = 16, SSM_NG = 32, SSM_P = 64;
constexpr int HD = 128, HPG = 4, NGRP = 3, ATT_W = 512, IN_COLS = 8192;
constexpr int C_US = 0, C_ZS = 512, C_Q = 1024, C_K = 2560, C_V = 4096, C_ZA = 5632, C_GS = 6144, C_GA = 7168;
constexpr int GZ_W = 1024, GZ_ZS = 0, GZ_ZA = 512, G8_W = 2048, G8_GS = 0, G8_GA = 1024;
constexpr float RMS_EPS = 1e-6f;
constexpr float ATT_C2 = 0.08838834764831845f * 1.4426950408889634f;

constexpr size_t MiB = 1u << 20;
constexpr size_t OFF_CTL = 0;
constexpr size_t OFF_WIN = 370 * MiB;
constexpr size_t OFF_WGLU = 434 * MiB;
constexpr size_t OFF_WBS = 436 * MiB;
constexpr size_t OFF_WBA = 440 * MiB;
constexpr size_t OFF_WOUT = 444 * MiB;
constexpr size_t OFF_S5 = 452 * MiB;
constexpr size_t OFF_XB = 473 * MiB;
constexpr size_t OFF_ROWSS = 505 * MiB;
constexpr size_t OFF_PROJ = 1 * MiB;
constexpr size_t OFF_GZ = OFF_PROJ, OFF_G8 = OFF_PROJ + 32 * MiB, OFF_QKV = OFF_PROJ + 96 * MiB;
constexpr size_t OFF_YPRE = 257 * MiB;
constexpr size_t OFF_AO = 273 * MiB;
constexpr size_t OFF_ALSE = 321 * MiB;
constexpr size_t OFF_T2 = 322 * MiB;
constexpr size_t OFF_UG = OFF_T2;
constexpr size_t OFF_T4 = 338 * MiB;
constexpr size_t WS_END = 506 * MiB;
constexpr size_t S5_A = 0;
constexpr size_t S5_BB = 1 * MiB;

typedef unsigned short bf16_t;
typedef short bf16x8 __attribute__((ext_vector_type(8)));
typedef float f32x4 __attribute__((ext_vector_type(4)));
typedef unsigned u32x4 __attribute__((ext_vector_type(4)));

__device__ __forceinline__ float bf2f(bf16_t h) { return __uint_as_float(((unsigned)h) << 16); }
__device__ __forceinline__ bf16_t f2bf(float f) { unsigned u = __float_as_uint(f); return (bf16_t)((u + 0x7fffu + ((u >> 16) & 1u)) >> 16); }
__device__ __forceinline__ float sigmoidf_(float v) { return 1.0f / (1.0f + __expf(-v)); }
__device__ __forceinline__ float siluf_(float v) { return v / (1.0f + __expf(-v)); }
__device__ __forceinline__ float gelu_tanh(float x) {
    const float z = 0.7978845608028654f * (x + 0.044715f * x * x * x);
    const float t = 1.0f - 2.0f / (1.0f + __expf(2.0f * z));
    return 0.5f * x * (1.0f + t);
}
__device__ __forceinline__ float wave_sum(float v) {
    v += __builtin_bit_cast(float, __builtin_amdgcn_ds_swizzle(__builtin_bit_cast(int, v), 0x041F));
    v += __builtin_bit_cast(float, __builtin_amdgcn_ds_swizzle(__builtin_bit_cast(int, v), 0x081F));
    v += __builtin_bit_cast(float, __builtin_amdgcn_ds_swizzle(__builtin_bit_cast(int, v), 0x101F));
    v += __builtin_bit_cast(float, __builtin_amdgcn_ds_swizzle(__builtin_bit_cast(int, v), 0x201F));
    v += __builtin_bit_cast(float, __builtin_amdgcn_ds_swizzle(__builtin_bit_cast(int, v), 0x401F));
    const auto rr = __builtin_amdgcn_permlane32_swap(__float_as_uint(v), __float_as_uint(v), false, false);
    return __uint_as_float(rr[0]) + __uint_as_float(rr[1]);
}
__device__ __forceinline__ float sig_fast(float v) { return __builtin_amdgcn_rcpf(1.0f + __builtin_amdgcn_exp2f(-1.4426950408889634f * v)); }
__device__ __forceinline__ float gelu_fast(float x) {
    const float z2 = 1.5957691216057308f * (x + 0.044715f * x * x * x);
    return x * sig_fast(z2);
}
__device__ __forceinline__ float blo(unsigned w) { return __uint_as_float(w << 16); }
__device__ __forceinline__ float bhi(unsigned w) { return __uint_as_float(w & 0xffff0000u); }
enum { IN_X = 0, IN_PREG, IN_WIN, IN_LRE, IN_LIM, IN_LDT, IN_BRE, IN_BIM, IN_CRE, IN_CIM, IN_DSKIP, IN_WGLU, IN_BGLU, IN_WBS, IN_WBA, IN_WOUT, IN_POSTG, N_IN };
struct Params { const float* in[N_IN]; float* out; unsigned char* ws; };
__device__ __forceinline__ int tid_from(int wave_s) { unsigned z = 0u; asm volatile("" : "+v"(z)); return (wave_s << 6) | (int)__builtin_amdgcn_mbcnt_hi(~0u, __builtin_amdgcn_mbcnt_lo(~0u, z)); }

namespace nv {
__global__ void k_transpose(const float* __restrict__ W, const float* __restrict__ rs, bf16_t* __restrict__ Wt, int K, int N) {
    __shared__ float tile[32][33];
    const int n0 = blockIdx.x * 32, k0 = blockIdx.y * 32, tx = threadIdx.x, ty = threadIdx.y;
    for (int i = ty; i < 32; i += 8) { const int k = k0 + i; tile[i][tx] = W[(size_t)k * N + n0 + tx] * (rs ? rs[k] : 1.0f); }
    __syncthreads();
    for (int i = ty; i < 32; i += 8) { const int n = n0 + i; Wt[(size_t)n * K + k0 + tx] = f2bf(tile[tx][i]); }
}
__global__ void k_s5_tables(Params p) {
    const int lg = blockIdx.x, pp = threadIdx.x, idx = lg * 64 + pp;
    const float lre = fminf(p.in[IN_LRE][idx], -1e-4f), lim = p.in[IN_LIM][idx], dt = expf(p.in[IN_LDT][lg]);
    const float a = lre * dt, b = lim * dt, ea = expf(a), sb = sinf(b), cb = cosf(b);
    const float Are = ea * cb, Aim = ea * sb, sh = sinf(0.5f * b);
    const float Dre = expm1f(a) * cb - 2.0f * sh * sh, Dim = Aim;
    const float den = lre * lre + lim * lim;
    const float cre = (Dre * lre + Dim * lim) / den, cim = (Dim * lre - Dre * lim) / den;
    float* A = (float*)(p.ws + OFF_S5 + S5_A); float* Bb = (float*)(p.ws + OFF_S5 + S5_BB);
    A[idx * 2] = Are; A[idx * 2 + 1] = Aim;
    for (int c = 0; c < 16; ++c) { const float br = p.in[IN_BRE][idx * 16 + c], bi = p.in[IN_BIM][idx * 16 + c];
        Bb[(idx * 16 + c) * 2] = cre * br - cim * bi; Bb[(idx * 16 + c) * 2 + 1] = cre * bi + cim * br; }
}
__global__ void k_rows_x(Params p) {
    const int row = blockIdx.x, t = threadIdx.x;
    const f32x4 v = ((const f32x4*)(p.in[IN_X] + (size_t)row * D_MODEL))[t];
    ((f32x4*)(p.out + (size_t)row * D_MODEL))[t] = v;
    bf16_t* xb = (bf16_t*)(p.ws + OFF_XB) + (size_t)row * D_MODEL + t * 4;
    xb[0] = f2bf(v[0]); xb[1] = f2bf(v[1]); xb[2] = f2bf(v[2]); xb[3] = f2bf(v[3]);
    float ss = wave_sum(v[0] * v[0] + v[1] * v[1] + v[2] * v[2] + v[3] * v[3]);
    __shared__ float s[4];
    if ((t & 63) == 0) s[t >> 6] = ss;
    __syncthreads();
    if (t == 0) ((float*)(p.ws + OFF_ROWSS))[row] = s[0] + s[1] + s[2] + s[3];
}
template <class Epi> __global__ __launch_bounds__(256) void k_gemm(const bf16_t* __restrict__ A, int lda, const bf16_t* __restrict__ Bt, int ldb, int K, Epi epi) {
    const int tid = threadIdx.x, wave = tid >> 6, lane = tid & 63, wr = wave >> 1, wc = wave & 1;
    const int row0 = blockIdx.y * 128 + wr * 64, col0 = blockIdx.x * 128 + wc * 64;
    f32x4 acc[4][4];
    for (int i = 0; i < 4; ++i) for (int j = 0; j < 4; ++j) acc[i][j] = (f32x4){0.f, 0.f, 0.f, 0.f};
    const bf16_t* ap = A + (size_t)(row0 + (lane & 15)) * lda + 8 * (lane >> 4);
    const bf16_t* bp = Bt + (size_t)(col0 + (lane & 15)) * ldb + 8 * (lane >> 4);
    for (int k0 = 0; k0 < K; k0 += 32) {
        bf16x8 a[4], b[4];
#pragma unroll
        for (int i = 0; i < 4; ++i) { a[i] = *(const bf16x8*)(ap + (size_t)i * 16 * lda + k0); b[i] = *(const bf16x8*)(bp + (size_t)i * 16 * ldb + k0); }
#pragma unroll
        for (int i = 0; i < 4; ++i)
#pragma unroll
            for (int j = 0; j < 4; ++j) acc[i][j] = __builtin_amdgcn_mfma_f32_16x16x32_bf16(a[i], b[j], acc[i][j], 0, 0, 0);
    }
#pragma unroll
    for (int i = 0; i < 4; ++i)
#pragma unroll
        for (int j = 0; j < 4; ++j)
#pragma unroll
            for (int r = 0; r < 4; ++r) epi(row0 + i * 16 + (lane >> 4) * 4 + r, col0 + j * 16 + (lane & 15), acc[i][j][r]);
}
struct EpiInProj { const float* rowss; bf16_t* proj;
    __device__ void operator()(int row, int col, float acc) const {
        float v = acc * rsqrtf(rowss[row] * (1.0f / D_MODEL) + RMS_EPS);
        if ((col >= C_ZS && col < C_Q) || (col >= C_ZA && col < C_GS)) v = siluf_(v);
        else if (col >= C_GS) v = sigmoidf_(v);
        proj[(size_t)row * IN_COLS + col] = f2bf(v);
    } };
struct EpiGlu { const bf16_t* y1; const bf16_t* proj; const float* b_glu; bf16_t* ys;
    __device__ void operator()(int row, int col, float acc) const {
        const float gate = sigmoidf_(acc + b_glu[col]);
        ys[(size_t)row * SSM_W + col] = f2bf(bf2f(y1[(size_t)row * SSM_W + col]) * gate * bf2f(proj[(size_t)row * IN_COLS + C_ZS + col]));
    } };
struct EpiGate1 { const bf16_t* proj; bf16_t* m1;
    __device__ void operator()(int row, int col, float acc) const { m1[(size_t)row * D_MODEL + col] = f2bf(bf2f(proj[(size_t)row * IN_COLS + C_GS + col]) * acc); } };
struct EpiGate2 { const bf16_t* proj; const bf16_t* m1; bf16_t* mg;
    __device__ void operator()(int row, int col, float acc) const {
        mg[(size_t)row * D_MODEL + col] = f2bf(bf2f(m1[(size_t)row * D_MODEL + col]) + bf2f(proj[(size_t)row * IN_COLS + C_GA + col]) * acc); } };
struct EpiF32 { float* C; int ldc;
    __device__ void operator()(int row, int col, float acc) const { C[(size_t)row * ldc + col] = acc; } };

__global__ __launch_bounds__(256) void k_attn(Params p) {
    const int wave = threadIdx.x >> 6, lane = threadIdx.x & 63;
    const long wid = (long)blockIdx.x * 4 + wave;
    const int j = (int)(wid & 3), gi = (int)((wid >> 2) % 3), tok = (int)(wid / 12);
    const int d = gi == 0 ? 1 : (gi == 1 ? 4 : 16);
    const int t = tok % SEQ, i = t / d;
    const bf16_t* proj = (const bf16_t*)(p.ws + OFF_PROJ);
    const int hc = (gi * 4 + j) * HD + 2 * lane;
    const unsigned qq = *(const unsigned*)(proj + (size_t)tok * IN_COLS + C_Q + hc);
    const float q0 = bf2f((bf16_t)(qq & 0xffff)), q1 = bf2f((bf16_t)(qq >> 16));
    float m = -1e30f, l = 0.f, o0 = 0.f, o1 = 0.f;
    const int nk = i < 128 ? i : 128;
    for (int jj = nk; jj >= 0; --jj) {
        const size_t kt = (size_t)(tok - jj * d);
        const unsigned kk = *(const unsigned*)(proj + kt * IN_COLS + C_K + hc);
        const unsigned vv = *(const unsigned*)(proj + kt * IN_COLS + C_V + hc);
        float s = q0 * bf2f((bf16_t)(kk & 0xffff)) + q1 * bf2f((bf16_t)(kk >> 16));
        s = wave_sum(s) * ATT_C2;
        const float mn = fmaxf(m, s), al = exp2f(m - mn), pr = exp2f(s - mn);
        l = l * al + pr; o0 = o0 * al + pr * bf2f((bf16_t)(vv & 0xffff)); o1 = o1 * al + pr * bf2f((bf16_t)(vv >> 16)); m = mn;
    }
    const float il = 1.0f / l;
    bf16_t* ao = (bf16_t*)(p.ws + OFF_AO) + ((size_t)gi * MTOK + tok) * ATT_W + j * HD + 2 * lane;
    *(unsigned*)ao = (unsigned)f2bf(o0 * il) | ((unsigned)f2bf(o1 * il) << 16);
    if (lane == 0) ((float*)(p.ws + OFF_ALSE))[((size_t)gi * MTOK + tok) * 4 + j] = m + log2f(l);
}
__global__ __launch_bounds__(64) void k_s5(Params p, int layer) {
    const int b = blockIdx.x >> 5, g = blockIdx.x & 31, lane = threadIdx.x;
    const int idx = ((layer * 32 + g) * 64 + lane);
    const float* A = (const float*)(p.ws + OFF_S5 + S5_A); const float* Bb = (const float*)(p.ws + OFF_S5 + S5_BB);
    const float Are = A[idx * 2], Aim = A[idx * 2 + 1];
    float bre[16], bim[16], cre[16], cim[16];
#pragma unroll
    for (int c = 0; c < 16; ++c) { bre[c] = Bb[(idx * 16 + c) * 2]; bim[c] = Bb[(idx * 16 + c) * 2 + 1];
        cre[c] = p.in[IN_CRE][(size_t)((layer * 32 + g) * 16 + c) * 64 + lane]; cim[c] = p.in[IN_CIM][(size_t)((layer * 32 + g) * 16 + c) * 64 + lane]; }
    const bf16_t* proj = (const bf16_t*)(p.ws + OFF_PROJ); bf16_t* ypre = (bf16_t*)(p.ws + OFF_YPRE);
    float sre = 0.f, sim = 0.f;
    for (int t = 0; t < SEQ; ++t) {
        const size_t tok = (size_t)b * SEQ + t;
        const bf16x8 u0 = *(const bf16x8*)(proj + tok * IN_COLS + C_US + g * 16), u1 = *(const bf16x8*)(proj + tok * IN_COLS + C_US + g * 16 + 8);
        float dre = 0.f, dim = 0.f;
#pragma unroll
        for (int c = 0; c < 8; ++c) { const float ua = bf2f((bf16_t)u0[c]), ub = bf2f((bf16_t)u1[c]);
            dre += bre[c] * ua + bre[c + 8] * ub; dim += bim[c] * ua + bim[c + 8] * ub; }
        const float nre = Are * sre - Aim * sim + dre, nim = Are * sim + Aim * sre + dim;
        sre = nre; sim = nim;
        float mine = 0.f;
#pragma unroll
        for (int c = 0; c < 16; ++c) { const float y = wave_sum(cre[c] * sre - cim[c] * sim); if (lane == c) mine = y; }
        if (lane < 16) ypre[tok * SSM_W + g * 16 + lane] = f2bf(mine);
    }
}
__global__ void k_p4a(Params p, int layer) {
    const size_t e = (size_t)blockIdx.x * 256 + threadIdx.x; const size_t row = e >> 9; const int col = (int)(e & 511);
    bf16_t* ypre = (bf16_t*)(p.ws + OFF_YPRE); const bf16_t* proj = (const bf16_t*)(p.ws + OFF_PROJ);
    const float y0 = bf2f(ypre[e]) + p.in[IN_DSKIP][layer * SSM_W + col] * bf2f(proj[row * IN_COLS + C_US + col]);
    ypre[e] = f2bf(gelu_tanh(y0));
}
__global__ void k_merge(Params p) {
    const size_t e = (size_t)blockIdx.x * 256 + threadIdx.x; const size_t row = e >> 9; const int col = (int)(e & 511), j = col >> 7;
    bf16_t* ao = (bf16_t*)(p.ws + OFF_AO); const float* ls = (const float*)(p.ws + OFF_ALSE); const bf16_t* proj = (const bf16_t*)(p.ws + OFF_PROJ);
    const float l0 = ls[((size_t)0 * MTOK + row) * 4 + j], l1 = ls[((size_t)1 * MTOK + row) * 4 + j], l2 = ls[((size_t)2 * MTOK + row) * 4 + j];
    const float mx = fmaxf(l0, fmaxf(l1, l2)), w0 = exp2f(l0 - mx), w1 = exp2f(l1 - mx), w2 = exp2f(l2 - mx);
    const float y = (w0 * bf2f(ao[e]) + w1 * bf2f(ao[(size_t)MTOK * ATT_W + e]) + w2 * bf2f(ao[(size_t)2 * MTOK * ATT_W + e])) / (w0 + w1 + w2);
    ao[e] = f2bf(y * bf2f(proj[row * IN_COLS + C_ZA + col]));
}
__global__ void k_postnorm(Params p, int layer, const float* o) {
    const int row = blockIdx.x, t = threadIdx.x;
    const f32x4 v = ((const f32x4*)(o + (size_t)row * D_MODEL))[t];
    __shared__ float s[4], s2[4];
    float ss = wave_sum(v[0] * v[0] + v[1] * v[1] + v[2] * v[2] + v[3] * v[3]);
    if ((t & 63) == 0) s[t >> 6] = ss;
    __syncthreads();
    const float inv = rsqrtf((s[0] + s[1] + s[2] + s[3]) * (1.0f / D_MODEL) + RMS_EPS);
    const f32x4 g = ((const f32x4*)(p.in[IN_POSTG] + layer * D_MODEL))[t];
    f32x4 xv = ((f32x4*)(p.out + (size_t)row * D_MODEL))[t];
    xv = xv + v * inv * g;
    ((f32x4*)(p.out + (size_t)row * D_MODEL))[t] = xv;
    bf16_t* xb = (bf16_t*)(p.ws + OFF_XB) + (size_t)row * D_MODEL + t * 4;
    xb[0] = f2bf(xv[0]); xb[1] = f2bf(xv[1]); xb[2] = f2bf(xv[2]); xb[3] = f2bf(xv[3]);
    float q = wave_sum(xv[0] * xv[0] + xv[1] * xv[1] + xv[2] * xv[2] + xv[3] * xv[3]);
    if ((t & 63) == 0) s2[t >> 6] = q;
    __syncthreads();
    if (t == 0) ((float*)(p.ws + OFF_ROWSS))[row] = s2[0] + s2[1] + s2[2] + s2[3];
}
}

namespace pg8 {
#define PG8_LAS __attribute__((address_space(3)))
typedef unsigned short bf16_t;
typedef short bf16x8 __attribute__((ext_vector_type(8)));
typedef float f32x4 __attribute__((ext_vector_type(4)));
typedef unsigned u32x4 __attribute__((ext_vector_type(4)));
constexpr int BM = 256, BK = 64, HALF = 128, HTB = HALF * BK * 2  , STAGE_BYTES = 8 * HTB, NXCD = 8, WGM = 8;

__host__ __device__ __forceinline__ int lds_byte(int r, int c) { const int st = (r >> 4) * 2 + (c >> 5), rr = r & 15, cc = c & 31, ob = rr * 64 + cc * 2; return st * 1024 + (ob ^ (((ob >> 9) & 1) << 5)); }
__host__ __device__ __forceinline__ void stage_rc(int b, int& R, int& C) { const int st = b / 1024, sb = b % 1024, swz = sb ^ (((sb >> 9) & 1) << 5); R = (st >> 1) * 16 + swz / 64; C = (st & 1) * 32 + (swz % 64) / 2; }
__host__ __device__ __forceinline__ int perm32(int rho) { const int n = rho >> 4, i = rho & 15; return 8 * (i >> 2) + 4 * n + (i & 3); }

struct Unit { int pm, pn; };
struct Gemm { const bf16_t* A; const bf16_t* Bt; int M, N, K; };

struct StaticOrder {
    int nM, nN, nwg, G, c;
    __host__ __device__ void init(int M, int N, int G_, int c_) { nM = M / BM; nN = N / BM; nwg = nM * nN; G = G_; c = c_; }
    __host__ __device__ bool next(int i, Unit& u) const {
        const long L = (long)i * G + c; if (L >= nwg) return false;
        int wgid = (int)L; { const int q = nwg / NXCD, r = nwg % NXCD, xcd = wgid % NXCD, off = wgid / NXCD; wgid = (xcd < r ? xcd * (q + 1) : r * (q + 1) + (xcd - r) * q) + off; }
        const int nig = WGM * nN, gid = wgid / nig, fm = gid * WGM, gsz = (nM - fm) < WGM ? (nM - fm) : WGM;
        u.pm = fm + ((wgid % nig) % gsz); u.pn = (wgid % nig) / gsz;
        if (P1_SHAPE && G == 256 && nM == 64 && nN == 32) {
            const int b = c % 8, j = c / 8;
            u.pm = b * 8 + 4 * (i >> 2) + (j & 3); u.pn = 8 * ((i + b) & 3) + (j >> 2);
        }
        return true;
    }
    __device__ __forceinline__ void a_ready(const Unit&) const {}
    __device__ __forceinline__ void done(const Unit&) const {}
};

__device__ __forceinline__ unsigned cvt_pk_bf16(float lo, float hi) { unsigned r; asm volatile("v_cvt_pk_bf16_f32 %0, %1, %2" : "=v"(r) : "v"(lo), "v"(hi)); return r; }
template <class Epi, class Sched, bool ALIGN_EPI = false, bool SP2 = false>
__device__ __forceinline__ void gemm_phase(PG8_LAS unsigned char* lds, const Gemm g, const Sched& S, const Epi& E, int wave_s, unsigned long long& ts_sum, unsigned long long& ts_t0) {
    const int tid = tid_from(wave_s), wid = wave_s, lane = tid & 63, wr = wid >> 2, wc = wid & 3, fr = lane & 15, fq = lane >> 4;
    const int K = g.K, nt = K / BK;
    unsigned voffA[2], voffB[2];
#pragma unroll
    for (int i = 0; i < 2; ++i) { int R, C; stage_rc(tid * 16 + i * 8192, R, C); const int Rb = Epi::PERM ? ((R & ~31) + perm32(R & 31)) : R;
        voffA[i] = (unsigned)(R * K + C) * 2u; voffB[i] = (unsigned)(Rb * K + C) * 2u; }
    const size_t kstep = (size_t)(BK * 2);
    const size_t hstep = (size_t)HALF * K * 2;
    const size_t tstep = 2 * hstep;
    const unsigned ldsw = (unsigned)wid * 1024u;
    const int aoff = lds_byte(wr * 64 + fr, fq * 8), boff = lds_byte(wc * 32 + fr, fq * 8);
#define PG8_SA(b, h) (((b) * 2 + (h)) * HTB)
#define PG8_SB(b, h) ((4 + (b) * 2 + (h)) * HTB)
#define PG8_STAGE(bufoff, gbase, voff) do { _Pragma("unroll") for (int _i = 0; _i < 2; ++_i) \
        __builtin_amdgcn_global_load_lds((const unsigned*)((const char*)(gbase) + (voff)[_i]), (PG8_LAS unsigned*)(lds + (bufoff) + ldsw + _i * 8192), 16, 0, 0); } while (0)
#define PG8_LDA(dst, b, h) do { _Pragma("unroll") for (int m = 0; m < 4; ++m) _Pragma("unroll") for (int k = 0; k < 2; ++k) dst[m][k] = *(const PG8_LAS bf16x8*)(lds + PG8_SA(b, h) + aoff + m * 2048 + k * 1024); } while (0)
#define PG8_LDB(dst, b, h) do { _Pragma("unroll") for (int n = 0; n < 2; ++n) _Pragma("unroll") for (int k = 0; k < 2; ++k) dst[n][k] = *(const PG8_LAS bf16x8*)(lds + PG8_SB(b, h) + boff + n * 2048 + k * 1024); } while (0)
#define PG8_MMA(ai, bj, At, Bt) do { __builtin_amdgcn_s_setprio(1); _Pragma("unroll") for (int m = 0; m < 4; ++m) _Pragma("unroll") for (int n = 0; n < 2; ++n) _Pragma("unroll") for (int k = 0; k < 2; ++k) \
        acc[ai][bj][m][n] = __builtin_amdgcn_mfma_f32_16x16x32_bf16(Bt[n][k], At[m][k], acc[ai][bj][m][n], 0, 0, 0); __builtin_amdgcn_s_setprio(0); } while (0)
#define PG8_WAIT_V(n) asm volatile("s_waitcnt vmcnt(" #n ")" ::: "memory")
#define PG8_WAIT_L(n) asm volatile("s_waitcnt lgkmcnt(" #n ")" ::: "memory")
#define PG8_BAR __builtin_amdgcn_s_barrier()
#define PG8_SCHED __builtin_amdgcn_sched_barrier(0)
    Unit cur, nxt; int ui = 0;
    if (!S.next(0, cur)) return;
    f32x4 acc[2][2][4][2];
#pragma unroll
    for (int a = 0; a < 2; ++a)
#pragma unroll
        for (int b = 0; b < 2; ++b)
#pragma unroll
            for (int m = 0; m < 4; ++m)
#pragma unroll
                for (int n = 0; n < 2; ++n) acc[a][b][m][n] = (f32x4){0.f, 0.f, 0.f, 0.f};
    bf16x8 At[4][2], B0[2][2], B1[2][2];
    const char* cA = (const char*)g.A + (size_t)cur.pm * tstep; const char* cB = (const char*)g.Bt + (size_t)cur.pn * tstep;
    S.a_ready(cur);
    if constexpr (SP2) {
        PG8_STAGE(PG8_SB(0, 0), cB, voffB); PG8_STAGE(PG8_SB(0, 1), cB + hstep, voffB); PG8_STAGE(PG8_SA(0, 0), cA, voffA); PG8_STAGE(PG8_SA(0, 1), cA + hstep, voffA);
        if (wr == 1) PG8_BAR;
        PG8_WAIT_V(2); PG8_BAR;
        PG8_STAGE(PG8_SB(1, 0), cB + kstep, voffB); PG8_STAGE(PG8_SA(1, 0), cA + kstep, voffA); PG8_STAGE(PG8_SB(1, 1), cB + hstep + kstep, voffB);
        PG8_WAIT_V(6); PG8_BAR;
    } else {
        PG8_STAGE(PG8_SB(0, 0), cB, voffB); PG8_STAGE(PG8_SA(0, 0), cA, voffA); PG8_STAGE(PG8_SB(0, 1), cB + hstep, voffB); PG8_STAGE(PG8_SA(0, 1), cA + hstep, voffA);
        if (wr == 1) PG8_BAR;
        PG8_WAIT_V(4); PG8_BAR;
        PG8_STAGE(PG8_SB(1, 0), cB + kstep, voffB); PG8_STAGE(PG8_SA(1, 0), cA + kstep, voffA); PG8_STAGE(PG8_SB(1, 1), cB + hstep + kstep, voffB);
        PG8_WAIT_V(6); PG8_BAR;
    }
    for (;;) {
        const bool has_next = S.next(ui + 1, nxt);
        const char* nA = has_next ? (const char*)g.A + (size_t)nxt.pm * tstep : cA; const char* nB = has_next ? (const char*)g.Bt + (size_t)nxt.pn * tstep : cB;
        if constexpr (Epi::ROWSUMS)
            __builtin_amdgcn_global_load_lds((const unsigned*)(E.rowss + cur.pm * BM + 32 * wid + (tid_from(wave_s) & 31)), (PG8_LAS unsigned*)(lds + STAGE_BYTES + (ui & 1) * 2048 + wid * 256), 4, 0, 0);
        for (int t = 0; t < nt; t += 2) {
            const bool last = (t == nt - 2);
            const char* a1 = cA + (size_t)(t + 1) * kstep;
            const char* a2 = last ? nA : cA + (size_t)(t + 2) * kstep; const char* b2 = last ? nB : cB + (size_t)(t + 2) * kstep;
            const char* a3 = a2 + kstep; const char* b3 = b2 + kstep;
            if (last && has_next) S.a_ready(nxt);
            if constexpr (SP2) {
            const unsigned seam = (unsigned)__builtin_amdgcn_readfirstlane((Epi::ROWSUMS && SEAM_RELAX && t == 0 && ui > 0) ? 1 : 0);
            PG8_LDB(B0, 0, 0); PG8_LDB(B1, 0, 1); PG8_SCHED; PG8_LDA(At, 0, 0); PG8_STAGE(PG8_SA(1, 1), a1 + hstep, voffA);
            asm volatile("s_waitcnt vmcnt(25)\n\ts_cmp_lg_u32 %0, 0\n\ts_cbranch_scc1 1\n\ts_waitcnt vmcnt(8)" :: "s"(seam) : "scc", "memory");
            PG8_WAIT_L(0); PG8_BAR; PG8_MMA(0, 0, At, B0); PG8_MMA(0, 1, At, B1); PG8_BAR; PG8_SCHED;
            PG8_LDA(At, 0, 1); PG8_STAGE(PG8_SB(0, 0), b2, voffB); PG8_STAGE(PG8_SB(0, 1), b2 + hstep, voffB); PG8_STAGE(PG8_SA(0, 0), a2, voffA);
            asm volatile("s_waitcnt vmcnt(25)\n\ts_cmp_lg_u32 %0, 0\n\ts_cbranch_scc1 1\n\ts_waitcnt vmcnt(8)" :: "s"(seam) : "scc", "memory");
            PG8_WAIT_L(0); PG8_BAR; PG8_MMA(1, 0, At, B0); PG8_MMA(1, 1, At, B1); PG8_BAR; PG8_SCHED;
            PG8_LDB(B0, 1, 0); PG8_LDB(B1, 1, 1); PG8_SCHED; PG8_LDA(At, 1, 0); PG8_STAGE(PG8_SA(0, 1), a2 + hstep, voffA);
            PG8_WAIT_V(8); PG8_WAIT_L(0); PG8_BAR; PG8_MMA(0, 0, At, B0); PG8_MMA(0, 1, At, B1); PG8_BAR; PG8_SCHED;
            PG8_LDA(At, 1, 1); PG8_STAGE(PG8_SB(1, 0), b3, voffB); PG8_STAGE(PG8_SB(1, 1), b3 + hstep, voffB); PG8_STAGE(PG8_SA(1, 0), a3, voffA);
            PG8_WAIT_V(8); PG8_WAIT_L(0); PG8_BAR; PG8_MMA(1, 0, At, B0); PG8_MMA(1, 1, At, B1); PG8_BAR; PG8_SCHED;
            } else {
            PG8_LDB(B0, 0, 0); PG8_SCHED; PG8_LDA(At, 0, 0); PG8_STAGE(PG8_SA(1, 1), a1 + hstep, voffA);
            PG8_WAIT_L(8); PG8_BAR; PG8_WAIT_L(0); PG8_MMA(0, 0, At, B0); PG8_BAR; PG8_SCHED;
            PG8_LDB(B1, 0, 1); PG8_STAGE(PG8_SB(0, 0), b2, voffB);
            PG8_BAR; PG8_WAIT_L(0); PG8_MMA(0, 1, At, B1); PG8_BAR;
            PG8_LDA(At, 0, 1); PG8_STAGE(PG8_SA(0, 0), a2, voffA);
            PG8_BAR; PG8_WAIT_L(0); PG8_MMA(1, 0, At, B0); PG8_BAR; PG8_SCHED;
            PG8_STAGE(PG8_SB(0, 1), b2 + hstep, voffB);
            PG8_WAIT_V(6); PG8_BAR; PG8_MMA(1, 1, At, B1); PG8_BAR;
            PG8_LDB(B0, 1, 0); PG8_SCHED; PG8_LDA(At, 1, 0); PG8_STAGE(PG8_SA(0, 1), a2 + hstep, voffA);
            PG8_WAIT_L(8); PG8_BAR; PG8_WAIT_L(0); PG8_MMA(0, 0, At, B0); PG8_BAR; PG8_SCHED;
            PG8_LDB(B1, 1, 1); PG8_STAGE(PG8_SB(1, 0), b3, voffB);
            PG8_BAR; PG8_WAIT_L(0); PG8_MMA(0, 1, At, B1); PG8_BAR;
            PG8_LDA(At, 1, 1); PG8_STAGE(PG8_SA(1, 0), a3, voffA);
            PG8_BAR; PG8_WAIT_L(0); PG8_MMA(1, 0, At, B0); PG8_BAR; PG8_SCHED;
            PG8_STAGE(PG8_SB(1, 1), b3 + hstep, voffB);
            PG8_WAIT_V(6); PG8_BAR; PG8_MMA(1, 1, At, B1); PG8_BAR;
            }
        }
        if constexpr (ALIGN_EPI) { if (wr == 0) PG8_BAR; }
        TS_BEGIN(11);
        if constexpr (!Epi::AFTER_DRAIN) { E(acc, cur, wr, wc, fr, fq, (const PG8_LAS float*)(lds + STAGE_BYTES + (ui & 1) * 2048)); S.done(cur); }
        TS_END(11);
        if (!has_next) break;
#pragma unroll
        for (int a = 0; a < 2; ++a)
#pragma unroll
            for (int b = 0; b < 2; ++b)
#pragma unroll
                for (int m = 0; m < 4; ++m)
#pragma unroll
                    for (int n = 0; n < 2; ++n) acc[a][b][m][n] = (f32x4){0.f, 0.f, 0.f, 0.f};
        cur = nxt; cA = nA; cB = nB; ++ui;
        if constexpr (ALIGN_EPI) { if (wr == 1) PG8_BAR; }
    }
    PG8_WAIT_V(0);
    if constexpr (!ALIGN_EPI) { if (wr == 0) PG8_BAR; }
    PG8_BAR;
    if constexpr (Epi::AFTER_DRAIN) { E.fused(acc, cur, wr, wc, fr, fq, lds, wid, lane); S.done(cur); }
#undef PG8_SA
#undef PG8_SB
#undef PG8_STAGE
#undef PG8_LDA
#undef PG8_LDB
#undef PG8_MMA
#undef PG8_WAIT_V
#undef PG8_WAIT_L
#undef PG8_BAR
#undef PG8_SCHED
}
}

namespace pg8 {
struct EpiInProj {
    static constexpr bool PERM = true, AFTER_DRAIN = false, ROWSUMS = true;
    unsigned char* ws; const float* rowss;
    __device__ __forceinline__ void operator()(const f32x4 (&acc)[2][2][4][2], const Unit& u, int wr, int wc, int fr, int fq, const PG8_LAS float* rs) const {
        const int row0 = u.pm * BM + wr * 64 + fr, colt = u.pn * BM, cl = wc * 32 + 8 * fq;
        const int mode = (colt >= C_GS) ? 2 : (((colt >= C_ZS && colt < C_Q) || (colt >= C_ZA && colt < C_GS)) ? 1 : 0);
        bf16_t* base; int kind = 0, sh = 0; size_t bjs;
        if (colt < C_ZS) { base = (bf16_t*)(ws + OFF_UG) + (size_t)(colt >> 4) * SEQ * 16; bjs = (size_t)8 * SEQ * 16; kind = 1; }
        else if (colt < C_Q) { base = (bf16_t*)(ws + OFF_GZ) + GZ_ZS + (colt - C_ZS); bjs = HALF; }
        else if (colt < C_ZA) { const int j = (colt - C_Q) >> 8, kd = j / 6, jj = j - 6 * kd, gi = jj >> 1; sh = 2 * gi; kind = 2;
            base = (bf16_t*)(ws + OFF_QKV) + ((size_t)((kd * 3 + gi) * BATCH) * HPG + 2 * (jj & 1)) * SEQ * HD; bjs = (size_t)SEQ * HD; }
        else if (colt < C_GS) { base = (bf16_t*)(ws + OFF_GZ) + GZ_ZA + (colt - C_ZA); bjs = HALF; }
        else { base = (bf16_t*)(ws + OFF_G8); bjs = HALF; kind = 3; }
        float inv[2][4];
#pragma unroll
        for (int ai = 0; ai < 2; ++ai)
#pragma unroll
            for (int m = 0; m < 4; ++m) { const int rl = wr * 64 + fr + ai * HALF + m * 16; inv[ai][m] = rsqrtf(rs[(rl >> 5) * 64 + (rl & 31)] * (1.0f / D_MODEL) + RMS_EPS); }
#pragma unroll
        for (int ai = 0; ai < 2; ++ai)
#pragma unroll
            for (int m = 0; m < 4; ++m) {
                const int row = row0 + ai * HALF + m * 16, b = row >> 11, t = row & (SEQ - 1);
                unsigned ro;
                if (kind == 3) { const unsigned go = (unsigned)row * G8_W + (unsigned)(colt - C_GS) + (unsigned)cl;
#pragma unroll
                    for (int bj = 0; bj < 2; ++bj) { const f32x4 v0 = acc[ai][bj][m][0] * inv[ai][m], v1 = acc[ai][bj][m][1] * inv[ai][m]; unsigned lo = 0u, hi = 0u;
#pragma unroll
                        for (int e = 0; e < 4; ++e) { const float s0 = __builtin_amdgcn_rcpf(1.0f + __builtin_amdgcn_exp2f(-1.4426950408889634f * v0[e])), s1 = __builtin_amdgcn_rcpf(1.0f + __builtin_amdgcn_exp2f(-1.4426950408889634f * v1[e]));
                            lo |= (unsigned)(s0 * 255.0f + 0.5f) << (8 * e); hi |= (unsigned)(s1 * 255.0f + 0.5f) << (8 * e); }
                        { typedef unsigned u32x2g __attribute__((ext_vector_type(2))); const u32x2g gw_ = {lo, hi};
                          asm volatile("global_store_dwordx2 %0, %1, %2" :: "v"(go + (unsigned)(bj * HALF)), "v"(gw_), "s"(base) : "memory"); } }
                    continue; }
                if (kind == 0) ro = ((unsigned)row * GZ_W + (unsigned)cl) * 2u;
                else if (kind == 1) ro = (((unsigned)(b * SSM_NG + (cl >> 4)) * SEQ + (unsigned)t) * 16u + (unsigned)(cl & 8)) * 2u;
                else { const int pos = ((t & ((1 << sh) - 1)) << (11 - sh)) + (t >> sh); ro = (((unsigned)b * HPG * SEQ + (unsigned)pos) * HD + (unsigned)cl) * 2u; }
#pragma unroll
                for (int bj = 0; bj < 2; ++bj) {
                    f32x4 v0 = acc[ai][bj][m][0] * inv[ai][m], v1 = acc[ai][bj][m][1] * inv[ai][m];
                    if (mode != 0) {
#pragma unroll
                        for (int e = 0; e < 4; ++e) {
                            const float s0 = __builtin_amdgcn_rcpf(1.0f + __builtin_amdgcn_exp2f(-1.4426950408889634f * v0[e]));
                            const float s1 = __builtin_amdgcn_rcpf(1.0f + __builtin_amdgcn_exp2f(-1.4426950408889634f * v1[e]));
                            v0[e] = (mode == 1) ? v0[e] * s0 : s0; v1[e] = (mode == 1) ? v1[e] * s1 : s1;
                        }
                    }
                    u32x4 w; w.x = cvt_pk_bf16(v0[0], v0[1]); w.y = cvt_pk_bf16(v0[2], v0[3]); w.z = cvt_pk_bf16(v1[0], v1[1]); w.w = cvt_pk_bf16(v1[2], v1[3]);
#if EXP_NOSTORE
                    asm volatile("" :: "v"(w.x), "v"(w.y), "v"(w.z), "v"(w.w));
#else
#if P1_NT
                    __builtin_nontemporal_store(w, (u32x4*)(rowp + bj * bjs));
#else
                    asm volatile("global_store_dwordx4 %0, %1, %2" :: "v"(ro + (unsigned)bj * (unsigned)bjs * 2u), "v"(w), "s"(base) : "memory");
#endif
#endif
                }
            }
    }
};
}

#define LAS __attribute__((address_space(3)))
#define GAS __attribute__((address_space(1)))
#define LDS_WAIT() asm volatile("s_waitcnt lgkmcnt(0)" ::: "memory")
#define VM_WAIT() asm volatile("s_waitcnt vmcnt(0)" ::: "memory")
__device__ __forceinline__ unsigned pk2(float lo, float hi) { return (unsigned)f2bf(lo) | ((unsigned)f2bf(hi) << 16); }
#define XB_TMO      128
#define XB_XCNT(j)  (256  + 64 * (j))
#define XB_XSUB(j)  (1280 + 64 * (j))
#define XB_XGEN(j)  (2304 + 64 * (j))
#define XB_TOP      3328
#define XB_TOPGEN   3392
#define XCD_BAR_WORDS 3456
#define XB_SPIN_CAP (1u << 18)

__device__ __forceinline__ unsigned xb_ld(unsigned* p)              { return __hip_atomic_load(p, __ATOMIC_RELAXED, __HIP_MEMORY_SCOPE_AGENT); }
__device__ __forceinline__ unsigned xb_add(unsigned* p, unsigned v) { return __hip_atomic_fetch_add(p, v, __ATOMIC_RELAXED, __HIP_MEMORY_SCOPE_AGENT); }
__device__ __forceinline__ unsigned xb_xcc_id() { return (unsigned)__builtin_amdgcn_s_getreg((3 << 11) | 20) & 0xFu; }
#define XB_SPIN(cond, bar) do { unsigned _sp = 0; while (cond) { __builtin_amdgcn_s_sleep(1); \
    if ((++_sp & 255u) == 0u) { if (xb_ld(&(bar)[XB_TMO])) break; if (_sp > XB_SPIN_CAP) { atomicAdd(&(bar)[XB_TMO], 1u); break; } } } } while (0)

struct XcdBarrier {
    int w;
    unsigned G;
    unsigned* bar; unsigned x;
    volatile LAS unsigned* st;
};

__device__ __forceinline__ XcdBarrier xcd_barrier_post(unsigned* bar, volatile LAS unsigned* st, int wave_s, unsigned G) {
    XcdBarrier b; b.w = wave_s; b.G = G; b.bar = bar; b.x = xb_xcc_id(); b.st = st;
    if (tid_from(wave_s) == 0) (void)xb_add(&bar[XB_XCNT(b.x)], 1u);
    return b;
}
__device__ __forceinline__ void xcd_barrier_complete(unsigned* bar, unsigned x, unsigned& nloc, unsigned& nx, unsigned G) {
    unsigned sum, cnt, mine, sp = 0u;
    for (;;) {
        sum = 0u; cnt = 0u; mine = 0u;
#pragma unroll
        for (unsigned j = 0; j < 16; ++j) { const unsigned c = xb_ld(&bar[XB_XCNT(j)]); sum += c; cnt += (c > 0u) ? 1u : 0u; mine = (j == x) ? c : mine; }
        if (sum == G) break;
        __builtin_amdgcn_s_sleep(1);
        if ((++sp & 255u) == 0u) { if (xb_ld(&bar[XB_TMO])) break; if (sp > XB_SPIN_CAP) { atomicAdd(&bar[XB_TMO], 1u); break; } }
    }
    nloc = mine > 0u ? mine : 1u; nx = cnt > 0u ? cnt : 1u;
}

struct BarTouch { const char* p[6]; int n[6]; };
__device__ __forceinline__ void xcd_barrier(const XcdBarrier& b, const BarTouch* bt = nullptr, LAS unsigned char* junk = nullptr) {
    asm volatile("s_waitcnt vmcnt(0)" ::: "memory");
    __syncthreads();
    if (bt != nullptr && b.w != 0) {
        const int li_ = (b.w - 1) * 64 + (tid_from(b.w) & 63);
#pragma unroll
        for (int r = 0; r < 6; ++r) { const int n_ = bt->n[r];
            for (int i0 = 0; i0 < n_; i0 += 448) { int i = i0 + li_; i = i < n_ ? i : n_ - 1;
                __builtin_amdgcn_global_load_lds((const unsigned*)(bt->p[r] + (size_t)i * 128), (LAS unsigned*)(junk + b.w * 256), 4, 0, 0); } }
    }
    if (tid_from(b.w) == 0) {
        unsigned* bar = b.bar;
        __builtin_amdgcn_s_waitcnt(0);
        unsigned nloc = b.st[0], nx = b.st[1];
        if (nloc == 0u) { xcd_barrier_complete(bar, b.x, nloc, nx, b.G); b.st[0] = nloc; b.st[1] = nx; }
        const unsigned old = xb_add(&bar[XB_XSUB(b.x)], 1u);
        const unsigned gen = old / nloc;
        if (old + 1u == (gen + 1u) * nloc) {
            __builtin_amdgcn_fence(__ATOMIC_RELEASE, "agent");
            asm volatile("s_waitcnt vmcnt(0)" ::: "memory");
            const unsigned og = xb_add(&bar[XB_TOP], 1u);
            const unsigned tg = og / nx;
            if (og + 1u == (tg + 1u) * nx) xb_add(&bar[XB_TOPGEN], 1u);
            else XB_SPIN(xb_ld(&bar[XB_TOPGEN]) == tg, bar);
            __builtin_amdgcn_fence(__ATOMIC_ACQUIRE, "agent");
            xb_add(&bar[XB_XGEN(b.x)], 1u);
            asm volatile("s_waitcnt vmcnt(0)" ::: "memory");
        } else {
            XB_SPIN(xb_ld(&bar[XB_XGEN(b.x)]) == gen, bar);
            __builtin_amdgcn_fence(__ATOMIC_ACQUIRE, "agent");
            asm volatile("s_waitcnt vmcnt(0)" ::: "memory");
        }
    }
    __syncthreads();
}

constexpr int NWAVES = 8, NTHREADS = NWAVES * 64;
constexpr int RING_BYTES = 131072;
constexpr int LDS_BYTES = 163840;
constexpr int MISC_OFF = LDS_BYTES - 256;
constexpr int CW_BAR = 4096;
constexpr int N_BAR_REGIONS = 32;
constexpr size_t CTL_ZERO_BYTES = 1 * MiB;
static_assert((CW_BAR + N_BAR_REGIONS * XCD_BAR_WORDS) * 4 <= (int)CTL_ZERO_BYTES, "ctl");

#ifndef PROBE_DUP
#define PROBE_DUP 0
#endif
struct Frame { LAS unsigned char* lds; int wave, vcu, G; };

struct Args { Params p; int ph_lo, ph_hi, bar_region, pad; };
__device__ __forceinline__ const float* inptr(const Args& a, int i) { int z; asm volatile("s_mov_b32 %0, 0" : "=s"(z)); return a.p.in[i + z]; }

namespace swa {
constexpr int D = 128; constexpr float THR = 8.f; constexpr bool WSKIP = true;
constexpr float SCALE = 0.08838834764831845f;
constexpr int NW = 8, QBLK = 32, KVBLK = 64, QB = NW * QBLK;
constexpr int SHM_V = KVBLK * D * 2, SHM_K = KVBLK * D * 2;
constexpr int ATTN_LDS_BYTES = 2 * SHM_V + 2 * SHM_K + NW * 64 * 4;

typedef short s16x4 __attribute__((ext_vector_type(4)));
typedef float f32x16 __attribute__((ext_vector_type(16)));
template <class A, class Bt> struct same_t { static constexpr bool v = false; };
template <class A> struct same_t<A, A> { static constexpr bool v = true; };

#define KSWZ(row, colB) ((row) * 256 + ((colB) ^ (((row) & 7) << 4)))
#define SBAR() __builtin_amdgcn_sched_barrier(0)
__device__ __forceinline__ int v_st(int k, int c) { const int kk = (k & ~0xC) | ((k & 4) << 1) | ((k & 8) >> 1); return ((kk >> 3) * 4 + (c >> 5)) * 512 + ((kk & 7) * 32 + (c & 31)) * 2; }
__device__ __forceinline__ int v_rd_base(int lane) { return ((lane & 3) << 3) | (((lane >> 2) & 3) << 6) | (((lane >> 4) & 1) << 5) | (((lane >> 5) & 1) << 8); }
constexpr int v_rd_off(int d0, int ks, int half) { return d0 * 512 + ks * 4096 + half * 2048; }
__device__ __forceinline__ int crow(int r, int hi) { return (r & 3) + 8 * (r >> 2) + 4 * hi; }
__device__ __forceinline__ unsigned cvtpk(float lo, float hi) {
    unsigned r; asm volatile("v_cvt_pk_bf16_f32 %0, %1, %2" : "=v"(r) : "v"(lo), "v"(hi)); return r;
}
__device__ __forceinline__ bf16x8 pack8(f32x4 a, f32x4 b) {
    u32x4 w = {cvtpk(a[0], a[1]), cvtpk(a[2], a[3]), cvtpk(b[0], b[1]), cvtpk(b[2], b[3])};
    return *reinterpret_cast<bf16x8*>(&w);
}
template <class T> __device__ __forceinline__ bf16x8 load8(const T* p) {
    if constexpr (same_t<T, float>::v) { return pack8(*(const f32x4*)p, *(const f32x4*)(p + 4)); }
    else { return *reinterpret_cast<const bf16x8*>(p); }
}
__device__ __forceinline__ void mask_tile(f32x16& p0, f32x16& p1, int dq, unsigned W) {
    const float NEG = -__builtin_inff();
#pragma unroll
    for (int r = 0; r < 16; ++r) {
        const int c = (r & 3) + 8 * (r >> 2);
        if ((unsigned)(dq - c) >= W) p0[r] = NEG;
        if ((unsigned)(dq - c - 32) >= W) p1[r] = NEG;
    }
}
__device__ __forceinline__ void partialSM(f32x16& p0, f32x16& p1, float& m_reg, float& mn, float& alpha) {
    float pmax = p0[0]; for (int r = 1; r < 16; ++r) pmax = fmaxf(pmax, p0[r]); for (int r = 0; r < 16; ++r) pmax = fmaxf(pmax, p1[r]);
    { auto rr = __builtin_amdgcn_permlane32_swap(__float_as_uint(pmax), __float_as_uint(pmax), false, false);
      pmax = fmaxf(__uint_as_float(rr[0]), __uint_as_float(rr[1])); }
    constexpr float C2 = 1.4426950408889634f * SCALE;
    if (__builtin_expect(__all((pmax - m_reg) * SCALE <= THR), 1)) { mn = m_reg; alpha = 1.f; }
    else { mn = fmaxf(m_reg, pmax); alpha = __builtin_amdgcn_exp2f((m_reg - mn) * C2); m_reg = mn; }
    const float mnL = -mn * C2;
    for (int r = 0; r < 16; ++r) p0[r] = fmaf(p0[r], C2, mnL); for (int r = 0; r < 16; ++r) p1[r] = fmaf(p1[r], C2, mnL);
    for (int r = 0; r < 16; ++r) p0[r] = __builtin_amdgcn_exp2f(p0[r]);
}
__device__ __forceinline__ void finishSM(f32x16& p0, f32x16& p1, float alpha, float& l_reg, bf16x8& pa0, bf16x8& pa1, bf16x8& pa2, bf16x8& pa3) {
    for (int r = 0; r < 16; ++r) p1[r] = __builtin_amdgcn_exp2f(p1[r]);
    float ps = 0; for (int r = 0; r < 16; ++r) ps += p0[r]; for (int r = 0; r < 16; ++r) ps += p1[r];
    { auto rr = __builtin_amdgcn_permlane32_swap(__float_as_uint(ps), __float_as_uint(ps), false, false);
      ps = __uint_as_float(rr[0]) + __uint_as_float(rr[1]); }
    l_reg = l_reg * alpha + ps;
#define PK4(P, B_, OUT) do { unsigned a0 = cvtpk(P[B_+0], P[B_+1]), a1 = cvtpk(P[B_+2], P[B_+3]);                          \
        unsigned b0 = cvtpk(P[B_+4], P[B_+5]), b1 = cvtpk(P[B_+6], P[B_+7]);                                             \
        auto r0 = __builtin_amdgcn_permlane32_swap(a0, b0, false, false); auto r1 = __builtin_amdgcn_permlane32_swap(a1, b1, false, false); \
        u32x4 w = {r0[0], r1[0], r0[1], r1[1]}; OUT = *reinterpret_cast<bf16x8*>(&w); } while (0)
    PK4(p0, 0, pa0); PK4(p0, 8, pa1); PK4(p1, 0, pa2); PK4(p1, 8, pa3);
#undef PK4
}
template <int KB, bool SK>
__device__ __forceinline__ void qkt(f32x16& p0, f32x16& p1, const char* K_lds, int r32, int hi, const bf16x8* qr, bool act) {
    if (SK && !act) { const float NEG = -__builtin_inff();
#pragma unroll
        for (int r = 0; r < 16; ++r) { p0[r] = NEG; p1[r] = NEG; } return; }
    p0 = f32x16{}; p1 = f32x16{};
    const char* kb[4];
#pragma unroll
    for (int dd = 0; dd < 4; ++dd) kb[dd] = K_lds + KB * SHM_K + KSWZ(r32, (dd * 16 + hi * 8) * 2);
#pragma unroll
    for (int d0 = 0; d0 < 8; ++d0) { const char* a = kb[d0 & 3] + (d0 >> 2) * 128;
        bf16x8 b0 = *reinterpret_cast<const bf16x8*>(a);
        bf16x8 b1 = *reinterpret_cast<const bf16x8*>(a + 32 * 256);
        p0 = __builtin_amdgcn_mfma_f32_32x32x16_bf16(b0, qr[d0], p0, 0, 0, 0);
        p1 = __builtin_amdgcn_mfma_f32_32x32x16_bf16(b1, qr[d0], p1, 0, 0, 0); }
}
template <int VB, bool SK>
__device__ __forceinline__ void pv_tile(f32x16* o, int vb0, bf16x8 pa0, bf16x8 pa1, bf16x8 pa2, bf16x8 pa3, bool act) {
    if (SK && !act) return;
#define TRRD(dst, off) asm volatile("ds_read_b64_tr_b16 %0, %1 offset:%2" : "=&v"(dst) : "v"(vb0), "i"(off) : "memory")
#define PV_D0(d0) do { s16x4 l0, l1, l2, l3, h0, h1, h2, h3; constexpr int b_ = VB * SHM_V + v_rd_off(d0, 0, 0);     \
        TRRD(l0, b_); TRRD(h0, b_ + 2048); TRRD(l1, b_ + 4096); TRRD(h1, b_ + 6144); TRRD(l2, b_ + 8192); TRRD(h2, b_ + 10240); TRRD(l3, b_ + 12288); TRRD(h3, b_ + 14336); \
        asm volatile("s_waitcnt lgkmcnt(0)" ::: "memory"); SBAR();                 \
        o[d0] = __builtin_amdgcn_mfma_f32_32x32x16_bf16(pa0, (bf16x8){l0[0], l0[1], l0[2], l0[3], h0[0], h0[1], h0[2], h0[3]}, o[d0], 0, 0, 0);   \
        o[d0] = __builtin_amdgcn_mfma_f32_32x32x16_bf16(pa1, (bf16x8){l1[0], l1[1], l1[2], l1[3], h1[0], h1[1], h1[2], h1[3]}, o[d0], 0, 0, 0);   \
        o[d0] = __builtin_amdgcn_mfma_f32_32x32x16_bf16(pa2, (bf16x8){l2[0], l2[1], l2[2], l2[3], h2[0], h2[1], h2[2], h2[3]}, o[d0], 0, 0, 0);   \
        o[d0] = __builtin_amdgcn_mfma_f32_32x32x16_bf16(pa3, (bf16x8){l3[0], l3[1], l3[2], l3[3], h3[0], h3[1], h3[2], h3[3]}, o[d0], 0, 0, 0); } while (0)
    PV_D0(0); PV_D0(1); PV_D0(2); PV_D0(3);
#undef PV_D0
#undef TRRD
}

template <class TIn, class TOut> struct BlockRef { const TIn* Q; const TIn* K; const TIn* V; TOut* O; float* L; int P0, pitch, opitch, lpitch, nq; };
template <class TIn> struct Seam {
    bf16x8 qr[8];
    bf16x8 st_v0, st_v1, st_k0, st_k1; f32x4 sf0, sf1, sf2, sf3;
    f32x4 tq[16];
};
__device__ __forceinline__ int swa_jlo(int P0, int W) { const int lowk = P0 - W + 1; return lowk > 0 ? lowk / KVBLK : 0; }
#define ROW(p, k0, rr) ((p) + (size_t)((k0) + (rr)) * PITCH_ + sc)
#define VMW() asm volatile("s_waitcnt vmcnt(0)" ::: "memory")
#define VMWN(n) asm volatile("s_waitcnt vmcnt(%0)" :: "i"(n) : "memory")
#define SLOAD_H(Kp, Vp, k0) do { S.st_v0 = load8<TIn>(ROW(Vp, k0, sr)); S.st_v1 = load8<TIn>(ROW(Vp, k0, 32 + sr));              \
                         S.st_k0 = load8<TIn>(ROW(Kp, k0, sr)); S.st_k1 = load8<TIn>(ROW(Kp, k0, 32 + sr)); } while (0)
#define SWRITE_HK(bf) do { *(bf16x8*)(K_lds + (bf) * SHM_K + kws) = S.st_k0; *(bf16x8*)(K_lds + (bf) * SHM_K + kws + 32 * 256) = S.st_k1; } while (0)
#define SWRITE_HV(bf) do { *(bf16x8*)(V_lds + (bf) * SHM_V + vst0) = S.st_v0; *(bf16x8*)(V_lds + (bf) * SHM_V + vst1) = S.st_v1; } while (0)
#define SWRITE_H(bf) do { SWRITE_HV(bf); SWRITE_HK(bf); } while (0)
#define SLOAD_F(p, k0) do { S.sf0 = *(const f32x4*)ROW(p, k0, sr); S.sf1 = *(const f32x4*)(ROW(p, k0, sr) + 4);                \
                            S.sf2 = *(const f32x4*)ROW(p, k0, 32 + sr); S.sf3 = *(const f32x4*)(ROW(p, k0, 32 + sr) + 4); } while (0)
#define SWRITE_KF(bf) do { *(bf16x8*)(K_lds + (bf) * SHM_K + kws) = pack8(S.sf0, S.sf1); *(bf16x8*)(K_lds + (bf) * SHM_K + kws + 32 * 256) = pack8(S.sf2, S.sf3); } while (0)
#define SWRITE_VF(bf) do { *(bf16x8*)(V_lds + (bf) * SHM_V + vst0) = pack8(S.sf0, S.sf1); *(bf16x8*)(V_lds + (bf) * SHM_V + vst1) = pack8(S.sf2, S.sf3); } while (0)
template <class TIn, class TOut>
__device__ __forceinline__ void causal_swa_prime(const BlockRef<TIn, TOut>& cur, int W, char* lds, Seam<TIn>& S, int wave_s) {
    constexpr bool F32 = same_t<TIn, float>::v;
    const int tid = tid_from(wave_s), wid = wave_s, lane = tid & 63, r32 = lane & 31, hi = lane >> 5;
    const int sr = tid >> 4, sc = (tid & 15) * 8, kws = KSWZ(sr, sc * 2); char* K_lds = lds + 2 * SHM_V;
    const int kb0 = swa_jlo(cur.P0, W) * KVBLK;
    const int PITCH_ = cur.pitch; const int qrow_ = (wid * QBLK + r32 < cur.nq) ? wid * QBLK + r32 : cur.nq - 1;
    for (int d0 = 0; d0 < 8; ++d0) S.qr[d0] = load8<TIn>(cur.Q + (size_t)qrow_ * PITCH_ + d0 * 16 + hi * 8);
    if constexpr (F32) { SLOAD_F((const float*)cur.K, kb0); VMW(); SWRITE_KF(0); SBAR(); SLOAD_F((const float*)cur.V, kb0); }
    else { SLOAD_H(cur.K, cur.V, kb0); VMW(); SWRITE_HK(0); }
    __syncthreads();
}
template <class TIn, class TOut>
__device__ __forceinline__ void causal_swa_block(const BlockRef<TIn, TOut>& cur, const BlockRef<TIn, TOut>& nxt, int skv, int W, char* lds, Seam<TIn>& S, int wave_s) {
    constexpr bool F32 = same_t<TIn, float>::v;
    const int tid = tid_from(wave_s), wid = wave_s, lane = tid & 63, r32 = lane & 31, hi = lane >> 5;
    int PITCH_ = cur.pitch; const bool wact = (wid * QBLK < cur.nq);
    const int j_lo = swa_jlo(cur.P0, W);
    int j_hi = (cur.P0 + QB - 1) / KVBLK + 1; if (j_hi > skv / KVBLK) j_hi = skv / KVBLK;
    const int NT = j_hi - j_lo;
    const int kbn = swa_jlo(nxt.P0, W) * KVBLK;
    const int qlo = cur.P0 + wid * QBLK, qm = qlo + r32 - 4 * hi;
    char* V_lds = lds; char* K_lds = lds + 2 * SHM_V;
    float* ws = (float*)(lds + 2 * SHM_V + 2 * SHM_K) + wid * 64; float* li_l = ws, * al_l = ws + 32;
    float m_reg = -1e30f, l_reg = 0; f32x16 o[4] = {};
    const int sr = tid >> 4, sc = (tid & 15) * 8, vst0 = v_st(sr, sc), vst1 = v_st(32 + sr, sc), kws = KSWZ(sr, sc * 2);
    const int vb0 = (int)(uintptr_t)V_lds + v_rd_base(lane);
    const TIn* Kh = cur.K; const TIn* Vh = cur.V;
#define RESC(a) do { if (__any((a) < 1.f)) { if (hi == 0) al_l[r32] = (a); asm volatile("s_waitcnt lgkmcnt(0)" ::: "memory");              \
                     for (int d_ = 0; d_ < 4; ++d_) for (int r = 0; r < 16; ++r) o[d_][r] *= al_l[crow(r, hi)]; } } while (0)
#define KBASE(t) ((j_lo + (t)) * KVBLK)
#define ACT(t) (wact && KBASE(t) <= qlo + QBLK - 1 && KBASE(t) + KVBLK - 1 >= qlo - W + 1)
#define MASKT(P0_, P1_, t) do { const int kb_ = KBASE(t); if ((!SK || ACT(t)) && (kb_ + KVBLK - 1 > qlo || kb_ <= qlo + QBLK - 1 - W)) mask_tile(P0_, P1_, qm - kb_, (unsigned)W); } while (0)
    constexpr int NQL = F32 ? 16 : 8;
    constexpr bool SK = WSKIP && !F32;
#define SEAM_K0() do { VMWN(NQL); if constexpr (F32) { SWRITE_KF(0); SBAR(); SLOAD_F((const float*)nxt.V, kbn); } else { SWRITE_HK(0); } SBAR(); } while (0)
    f32x16 pA0, pA1, pB0, pB1; float mnA, mnB, alA, alB; bf16x8 pa0, pa1, pa2, pa3;
    if constexpr (F32) { VMW(); SWRITE_VF(0); SBAR(); } else { SWRITE_HV(0); SBAR(); }
    if (NT > 1) { if constexpr (F32) SLOAD_F((const float*)Kh, KBASE(1)); else SLOAD_H(Kh, Vh, KBASE(1)); }
    SBAR(); qkt<0, SK>(pA0, pA1, K_lds, r32, hi, S.qr, ACT(0));
    if constexpr (F32) { if (NT > 1) { VMW(); SWRITE_KF(1); SBAR(); SLOAD_F((const float*)Vh, KBASE(1)); } }
    MASKT(pA0, pA1, 0); partialSM(pA0, pA1, m_reg, mnA, alA);
    if (NT > 1) { VMW(); if constexpr (F32) { SWRITE_VF(1); SBAR(); if (NT > 2) SLOAD_F((const float*)Kh, KBASE(2)); } else SWRITE_H(1); }
    __syncthreads();
#define HALF_STEP(PX0, PX1, mnX, alX, PY0, PY1, alY, t, KB, VB, SB) do {                                                      \
        SBAR(); if constexpr (!F32) { if ((t) + 1 < NT) { SLOAD_H(Kh, Vh, KBASE((t) + 1)); SBAR(); } }     \
        qkt<KB, SK>(PX0, PX1, K_lds, r32, hi, S.qr, ACT(t));                                             \
        finishSM(PY0, PY1, alY, l_reg, pa0, pa1, pa2, pa3); SBAR();                                                           \
        if constexpr (F32) { if ((t) + 1 < NT) { VMW(); SWRITE_KF(SB); SBAR(); SLOAD_F((const float*)Vh, KBASE((t) + 1)); SBAR(); } }  \
        pv_tile<VB, SK>(o, vb0, pa0, pa1, pa2, pa3, ACT((t) - 1)); MASKT(PX0, PX1, (t)); partialSM(PX0, PX1, m_reg, mnX, alX);                                        \
        __syncthreads();                                                                                                      \
        if ((t) + 1 < NT) { VMW(); if constexpr (F32) { SWRITE_VF(SB); SBAR(); if ((t) + 2 < NT) SLOAD_F((const float*)Kh, KBASE((t) + 2)); } \
                            else { SWRITE_H(SB); } }                                                                          \
        RESC(alX); __syncthreads(); } while (0)
    for (int t = 1; t + 1 < NT; t += 2) {
        HALF_STEP(pB0, pB1, mnB, alB, pA0, pA1, alA, t, 1, 0, 0);
        HALF_STEP(pA0, pA1, mnA, alA, pB0, pB1, alB, t + 1, 0, 1, 1);
    }
    const bool even = (NT & 1) == 0;
    if (even) { SBAR(); qkt<1, SK>(pB0, pB1, K_lds, r32, hi, S.qr, ACT(NT - 1)); SBAR(); }
#define QROW(e) (nxt.Q + (size_t)(wid * QBLK + r32) * D + ((e) >> 1) * 16 + hi * 8 + ((e) & 1) * 4)
    if constexpr (F32) { SLOAD_F((const float*)nxt.K, kbn); SBAR();
#pragma unroll
        for (int e = 0; e < 8; ++e) S.tq[e] = *(const f32x4*)QROW(e); }
    else { PITCH_ = nxt.pitch; SLOAD_H(nxt.K, nxt.V, kbn); SBAR();
        const int qrow_ = (wid * QBLK + r32 < nxt.nq) ? wid * QBLK + r32 : nxt.nq - 1;
#pragma unroll
        for (int d0 = 0; d0 < 8; ++d0) S.qr[d0] = load8<TIn>(nxt.Q + (size_t)qrow_ * PITCH_ + d0 * 16 + hi * 8); }
    SBAR();
    finishSM(pA0, pA1, alA, l_reg, pa0, pa1, pa2, pa3); SBAR();
    if constexpr (F32) {
#pragma unroll
        for (int e = 8; e < 16; ++e) S.tq[e] = *(const f32x4*)QROW(e); SBAR(); }
#undef QROW
    pv_tile<0, SK>(o, vb0, pa0, pa1, pa2, pa3, ACT(even ? NT - 2 : NT - 1));
    if (even) { MASKT(pB0, pB1, NT - 1); partialSM(pB0, pB1, m_reg, mnB, alB); __syncthreads(); RESC(alB);
        finishSM(pB0, pB1, alB, l_reg, pa0, pa1, pa2, pa3); SBAR(); pv_tile<1, SK>(o, vb0, pa0, pa1, pa2, pa3, ACT(NT - 1)); }
    SBAR(); SEAM_K0();
    if (hi == 0) li_l[r32] = l_reg; asm volatile("s_waitcnt lgkmcnt(0)" ::: "memory");
    float rli[16];
#pragma unroll
    for (int r = 0; r < 16; ++r) rli[r] = __builtin_amdgcn_rcpf(li_l[crow(r, hi)]);
    const int OP_ = cur.opitch; TOut* Ow = cur.O + (size_t)(wid * QBLK) * OP_;
    if (wact) {
    if (hi == 0) cur.L[(size_t)(wid * QBLK + r32) * cur.lpitch] = m_reg * (1.4426950408889634f * SCALE) + __builtin_amdgcn_logf(l_reg);
#pragma unroll
    for (int r = 0; r < 16; ++r) { const int orow = crow(r, hi);
#pragma unroll
        for (int d0 = 0; d0 < 4; ++d0) { const float v = o[d0][r] * rli[r];
            if constexpr (same_t<TOut, float>::v) { Ow[(size_t)orow * OP_ + d0 * 32 + r32] = v; }
            else { const float vn = __builtin_bit_cast(float, __builtin_amdgcn_mov_dpp(__builtin_bit_cast(int, v), 0xB1, 0xF, 0xF, true));
                   if ((r32 & 1) == 0) *(unsigned*)(Ow + (size_t)orow * OP_ + d0 * 32 + r32) = cvtpk(v, vn); } } }
    }
    if constexpr (F32) {
#pragma unroll
        for (int d0 = 0; d0 < 8; ++d0) S.qr[d0] = pack8(S.tq[2 * d0], S.tq[2 * d0 + 1]); }
    __syncthreads();
#undef RESC
#undef KBASE
#undef ACT
#undef MASKT
#undef SEAM_K0
#undef HALF_STEP
}
#undef ROW
#undef VMW
#undef VMWN
#undef SLOAD_H
#undef SWRITE_HK
#undef SWRITE_HV
#undef SWRITE_H
#undef SLOAD_F
#undef SWRITE_KF
#undef SWRITE_VF

constexpr int DMA_KR = 0, DMA_VR = 3 * SHM_K, DMA_SCR = DMA_VR + 3 * SHM_V, DMA_LDS_BYTES = DMA_SCR + NW * 64 * 4;
template <class TIn, class TOut>
__device__ __forceinline__ void block_dma(const BlockRef<TIn, TOut>& cur, int skv, int W, char* lds, int wave_s) {
    const int tid = tid_from(wave_s), wid = wave_s, lane = tid & 63, r32 = lane & 31, hi = lane >> 5;
    const int j_lo = swa_jlo(cur.P0, W);
    int j_hi = (cur.P0 + QB - 1) / KVBLK + 1; if (j_hi > skv / KVBLK) j_hi = skv / KVBLK;
    const int NT = j_hi - j_lo, PITCH_ = cur.pitch;
    const bool wact = (wid * QBLK < cur.nq);
    const int qlo = cur.P0 + wid * QBLK, qm = qlo + r32 - 4 * hi;
    float* wsf = (float*)(lds + DMA_SCR) + wid * 64; float* li_l = wsf; float* al_l = wsf + 32;
    int kOff[2], vOff[2];
#pragma unroll
    for (int j = 0; j < 2; ++j) kOff[j] = (4 * (2 * wid + j) + (lane >> 4)) * PITCH_ + (((lane & 15) ^ ((lane >> 4) + 4 * j)) * 8);
    { const int kk = wid * 8 + ((lane & 31) >> 2), k = (kk & ~0xC) | ((kk & 4) << 1) | ((kk & 8) >> 1);
#pragma unroll
      for (int j = 0; j < 2; ++j) vOff[j] = k * PITCH_ + (((2 * j + (lane >> 5)) & 3) * 32 + (lane & 3) * 8); }
    typedef __attribute__((address_space(3))) unsigned lds_u32;
    const unsigned ldsb = (unsigned)(size_t)(__attribute__((address_space(3))) char*)lds;
#define DMA_TILE(t, slot) do { const TIn* kt_ = cur.K + (size_t)(j_lo + (t)) * KVBLK * PITCH_; const TIn* vt_ = cur.V + (size_t)(j_lo + (t)) * KVBLK * PITCH_; \
        _Pragma("unroll") for (int j = 0; j < 2; ++j) { \
            __builtin_amdgcn_global_load_lds((const unsigned*)(kt_ + kOff[j]), (lds_u32*)(size_t)(ldsb + DMA_KR + (slot) * SHM_K + (2 * wid + j) * 1024), 16, 0, 0); \
            __builtin_amdgcn_global_load_lds((const unsigned*)(vt_ + vOff[j]), (lds_u32*)(size_t)(ldsb + DMA_VR + (slot) * SHM_V + (2 * wid + j) * 1024), 16, 0, 0); } } while (0)
    bf16x8 qr[8];
    { const int qrow_ = (wid * QBLK + r32 < cur.nq) ? wid * QBLK + r32 : cur.nq - 1;
#pragma unroll
      for (int d0 = 0; d0 < 8; ++d0) qr[d0] = load8<TIn>(cur.Q + (size_t)qrow_ * PITCH_ + d0 * 16 + hi * 8); }
    DMA_TILE(0, 0);
    if (NT > 1) DMA_TILE(1, 1);
    float m_reg = -1e30f, l_reg = 0; f32x16 o[4] = {};
    const int vbase = (int)ldsb + DMA_VR + v_rd_base(lane);
    int slot = 0, slot2 = 2;
#pragma unroll 1
    for (int t = 0; t < NT; ++t) {
        if (t + 1 < NT) asm volatile("s_waitcnt vmcnt(4)" ::: "memory"); else asm volatile("s_waitcnt vmcnt(0)" ::: "memory");
        asm volatile("s_waitcnt lgkmcnt(0)" ::: "memory"); __builtin_amdgcn_s_barrier(); asm volatile("" ::: "memory");
        if (t + 2 < NT) DMA_TILE(t + 2, slot2);
        const int kb_ = (j_lo + t) * KVBLK;
        const bool act = wact && kb_ <= qlo + QBLK - 1 && kb_ + KVBLK - 1 >= qlo - W + 1;
        if (act) {
            f32x16 p0, p1; float mn, al; bf16x8 pa0, pa1, pa2, pa3;
            SBAR(); qkt<0, false>(p0, p1, lds + DMA_KR + slot * SHM_K, r32, hi, qr, true);
            if (kb_ + KVBLK - 1 > qlo || kb_ <= qlo + QBLK - 1 - W) mask_tile(p0, p1, qm - kb_, (unsigned)W);
            partialSM(p0, p1, m_reg, mn, al);
            finishSM(p0, p1, al, l_reg, pa0, pa1, pa2, pa3); SBAR();
            if (__any(al < 1.f)) { if (hi == 0) al_l[r32] = al; asm volatile("s_waitcnt lgkmcnt(0)" ::: "memory");
                for (int d_ = 0; d_ < 4; ++d_) for (int r = 0; r < 16; ++r) o[d_][r] *= al_l[crow(r, hi)]; }
            pv_tile<0, false>(o, vbase + slot * SHM_V, pa0, pa1, pa2, pa3, true);
        }
        slot = slot == 2 ? 0 : slot + 1; slot2 = slot2 == 2 ? 0 : slot2 + 1;
    }
#undef DMA_TILE
    if (wact) {
        if (hi == 0) li_l[r32] = l_reg; asm volatile("s_waitcnt lgkmcnt(0)" ::: "memory");
        float rli[16];
#pragma unroll
        for (int r = 0; r < 16; ++r) rli[r] = __builtin_amdgcn_rcpf(li_l[crow(r, hi)]);
        const int OP_ = cur.opitch; TOut* Ow = cur.O + (size_t)(wid * QBLK) * OP_;
        if (hi == 0) cur.L[(size_t)(wid * QBLK + r32) * cur.lpitch] = m_reg * (1.4426950408889634f * SCALE) + __builtin_amdgcn_logf(l_reg);
#pragma unroll
        for (int r = 0; r < 16; ++r) { const int orow = crow(r, hi);
#pragma unroll
            for (int d0 = 0; d0 < 4; ++d0) { const float v = o[d0][r] * rli[r];
                const float vn = __builtin_bit_cast(float, __builtin_amdgcn_mov_dpp(__builtin_bit_cast(int, v), 0xB1, 0xF, 0xF, true));
                if ((r32 & 1) == 0) *(unsigned*)(Ow + (size_t)orow * OP_ + d0 * 32 + r32) = cvtpk(v, vn); } }
    }
    asm volatile("s_waitcnt lgkmcnt(0)" ::: "memory"); __builtin_amdgcn_s_barrier(); asm volatile("" ::: "memory");
}
typedef BlockRef<bf16_t, bf16_t> Ref;
}
#undef KSWZ

__device__ __forceinline__ swa::Ref attn_ref(unsigned char* ws, int L, int& skv) {
    int gi, b, h, c, qb;
    if (L < 256) { gi = 0; b = L >> 5; h = (L >> 3) & 3; qb = L & 7; c = 0; }
    else if (L < 512) { L -= 256; gi = 1; b = L >> 5; h = (L >> 3) & 3; c = (L >> 1) & 3; qb = L & 1; }
    else { L -= 512; gi = 2; const int v = L & 255, idx = (v & 31) * 2 + (L >> 8); b = v >> 5; h = idx >> 4; c = idx & 15; qb = 0; }
    const int d = gi == 0 ? 1 : (gi == 1 ? 4 : 16);
    const int n = SEQ / d;
    const size_t hb = ((size_t)(gi * BATCH + b) * HPG + h) * SEQ * HD + (size_t)c * n * HD, kstep = (size_t)3 * BATCH * HPG * SEQ * HD;
    const bf16_t* qkv = (const bf16_t*)(ws + OFF_QKV);
    const size_t tok0 = (size_t)b * SEQ + c + (size_t)qb * 256 * d;
    swa::Ref r;
    r.Q = qkv + hb + (size_t)qb * 256 * HD; r.K = qkv + kstep + hb; r.V = qkv + 2 * kstep + hb;
    r.O = (bf16_t*)(ws + OFF_AO) + ((size_t)gi * MTOK + tok0) * ATT_W + h * HD; r.opitch = d * ATT_W;
    r.L = (float*)(ws + OFF_ALSE) + ((size_t)gi * MTOK + tok0) * 4 + h; r.lpitch = d * 4;
    r.P0 = qb * 256; r.pitch = HD; r.nq = gi == 2 ? 128 : 256;
    skv = SEQ / d;
    return r;
}
namespace wsa2 {
using swa::f32x16; using swa::s16x4; using swa::crow; using swa::cvtpk; using swa::v_rd_base; using swa::SCALE; using swa::THR;
constexpr int BLK_K = 8192, SLOT = 16384, NSLOT = 9, SCR = NSLOT * SLOT, LDS_NEED = SCR + NWAVES * 256;
static_assert(LDS_NEED <= MISC_OFF, "wsa2 LDS");
#define W2_KSWZ(row, colB) ((row) * 256 + ((colB) ^ (((row) & 7) << 4)))
#define W2_SBAR() __builtin_amdgcn_sched_barrier(0)
__device__ __forceinline__ void unit(const swa::Ref& u, LAS unsigned char* lds, int wave_s) {
    const int tid = tid_from(wave_s), wid = wave_s, lane = tid & 63, r32 = lane & 31, hi = lane >> 5;
    const int I0 = u.P0, i0 = I0 + 32 * wid;
    const bool wact = 32 * wid < u.nq;
    const int B0 = (I0 >= 128 ? I0 - 128 : 0) >> 5;
    const int kfirst = i0 >= 128 ? i0 - 128 : 0, nblk = wact ? ((i0 - kfirst) >> 5) + 1 : 0, fw = (kfirst >> 5) - B0;
    const int ilast = I0 + u.nq - 32, klast = ilast >= 128 ? ilast - 128 : 0;
    const int nbtot = (ilast >> 5) - B0 + 1, niter = ((ilast - klast) >> 5) + 1;
    const int krow = 4 * wid + (lane >> 4), kchunk = (lane & 15) ^ (4 * (wid & 1) + (lane >> 4));
    const int kk = (wid >> 1) * 8 + ((lane & 31) >> 2), vkey = (kk & ~0xC) | ((kk & 4) << 1) | ((kk & 8) >> 1), vcol = ((2 * (wid & 1) + (lane >> 5)) & 3) * 32 + (lane & 3) * 8;
    const bf16_t* ksrc = u.K + (size_t)(B0 * 32 + krow) * HD + kchunk * 8;
    const bf16_t* vsrc = u.V + (size_t)(B0 * 32 + vkey) * HD + vcol;
    typedef __attribute__((address_space(3))) unsigned lds_u32;
    const unsigned ldsb = (unsigned)(size_t)lds;
#define W2_DMA(b, slot) do { __builtin_amdgcn_global_load_lds((const unsigned*)(ksrc + (size_t)(b) * 32 * HD), (lds_u32*)(size_t)(ldsb + (slot) * SLOT + wid * 1024), 16, 0, 0); \
        __builtin_amdgcn_global_load_lds((const unsigned*)(vsrc + (size_t)(b) * 32 * HD), (lds_u32*)(size_t)(ldsb + (slot) * SLOT + BLK_K + wid * 1024), 16, 0, 0); } while (0)
    for (int b = 0; b < 8 && b < nbtot; ++b) W2_DMA(b, b);
    bf16x8 qr[8];
    { const int qrow = wact ? 32 * wid + r32 : u.nq - 1;
#pragma unroll
      for (int d0 = 0; d0 < 8; ++d0) qr[d0] = *(const bf16x8*)(u.Q + (size_t)qrow * HD + d0 * 16 + hi * 8); }
    LAS float* li_l = (LAS float*)(lds + SCR + wid * 256); LAS float* al_l = li_l + 32;
    float m_reg = -1e30f, l_reg = 0.f; f32x16 o[4] = {};
    constexpr float C2 = 1.4426950408889634f * SCALE;
    int koff[4];
#pragma unroll
    for (int dd = 0; dd < 4; ++dd) koff[dd] = W2_KSWZ(r32, (dd * 16 + hi * 8) * 2);
    const unsigned vrb = ldsb + BLK_K + (unsigned)v_rd_base(lane);
#pragma unroll 1
    for (int i = 0; i < niter; ++i) {
        asm volatile("s_waitcnt vmcnt(0)" ::: "memory");
        asm volatile("s_waitcnt lgkmcnt(0)" ::: "memory"); __builtin_amdgcn_s_barrier(); asm volatile("" ::: "memory");
        if (i + 8 < nbtot) { const int s8 = (i + 8) % NSLOT; W2_DMA(i + 8, s8); }
        if (i < nblk) {
            const int rel = fw + i, slot = rel % NSLOT, k0 = (B0 + rel) * 32;
            const LAS unsigned char* kb = lds + slot * SLOT;
            f32x16 p = {};
#pragma unroll
            for (int d0 = 0; d0 < 8; ++d0) { const bf16x8 kf = *(const LAS bf16x8*)(kb + koff[d0 & 3] + (d0 >> 2) * 128);
                p = __builtin_amdgcn_mfma_f32_32x32x16_bf16(kf, qr[d0], p, 0, 0, 0); }
            if (k0 == i0 || k0 + 128 == i0) {
                const int dq = i0 + r32 - k0 - 4 * hi; const float NEG = -__builtin_inff();
#pragma unroll
                for (int r = 0; r < 16; ++r) { const int c = (r & 3) + 8 * (r >> 2); if ((unsigned)(dq - c) >= 129u) p[r] = NEG; }
            }
            float pmax = p[0];
#pragma unroll
            for (int r = 1; r < 16; ++r) pmax = fmaxf(pmax, p[r]);
            { auto rr = __builtin_amdgcn_permlane32_swap(__float_as_uint(pmax), __float_as_uint(pmax), false, false); pmax = fmaxf(__uint_as_float(rr[0]), __uint_as_float(rr[1])); }
            float mn, alpha;
            if (__builtin_expect(__all((pmax - m_reg) * SCALE <= THR), 1)) { mn = m_reg; alpha = 1.f; }
            else { mn = fmaxf(m_reg, pmax); alpha = __builtin_amdgcn_exp2f((m_reg - mn) * C2); m_reg = mn; }
            const float mnL = -mn * C2;
#pragma unroll
            for (int r = 0; r < 16; ++r) p[r] = __builtin_amdgcn_exp2f(fmaf(p[r], C2, mnL));
            float ps = 0.f;
#pragma unroll
            for (int r = 0; r < 16; ++r) ps += p[r];
            { auto rr = __builtin_amdgcn_permlane32_swap(__float_as_uint(ps), __float_as_uint(ps), false, false); ps = __uint_as_float(rr[0]) + __uint_as_float(rr[1]); }
            l_reg = l_reg * alpha + ps;
            bf16x8 pa0, pa1;
#define W2_PK4(B_, OUT) do { unsigned a0 = cvtpk(p[B_+0], p[B_+1]), a1 = cvtpk(p[B_+2], p[B_+3]), b0 = cvtpk(p[B_+4], p[B_+5]), b1 = cvtpk(p[B_+6], p[B_+7]); \
            auto r0 = __builtin_amdgcn_permlane32_swap(a0, b0, false, false); auto r1 = __builtin_amdgcn_permlane32_swap(a1, b1, false, false); \
            u32x4 w = {r0[0], r1[0], r0[1], r1[1]}; OUT = *reinterpret_cast<bf16x8*>(&w); } while (0)
            W2_PK4(0, pa0); W2_PK4(8, pa1);
#undef W2_PK4
            if (__any(alpha < 1.f)) {
                if (hi == 0) al_l[r32] = alpha;
                asm volatile("s_waitcnt lgkmcnt(0)" ::: "memory");
#pragma unroll
                for (int d_ = 0; d_ < 4; ++d_)
#pragma unroll
                    for (int r = 0; r < 16; ++r) o[d_][r] *= al_l[crow(r, hi)];
            }
            const unsigned vb0 = vrb + (unsigned)(slot * SLOT);
#define W2_TR(dst, off) asm volatile("ds_read_b64_tr_b16 %0, %1 offset:%2" : "=&v"(dst) : "v"(vb0), "i"(off) : "memory")
#define W2_PV(d0) do { s16x4 l0, l1, h0, h1; W2_TR(l0, (d0) * 512); W2_TR(h0, (d0) * 512 + 2048); W2_TR(l1, (d0) * 512 + 4096); W2_TR(h1, (d0) * 512 + 6144); \
            asm volatile("s_waitcnt lgkmcnt(0)" ::: "memory"); W2_SBAR(); \
            o[d0] = __builtin_amdgcn_mfma_f32_32x32x16_bf16(pa0, (bf16x8){l0[0], l0[1], l0[2], l0[3], h0[0], h0[1], h0[2], h0[3]}, o[d0], 0, 0, 0); \
            o[d0] = __builtin_amdgcn_mfma_f32_32x32x16_bf16(pa1, (bf16x8){l1[0], l1[1], l1[2], l1[3], h1[0], h1[1], h1[2], h1[3]}, o[d0], 0, 0, 0); } while (0)
            W2_PV(0); W2_PV(1); W2_PV(2); W2_PV(3);
#undef W2_PV
#undef W2_TR
        }
    }
#undef W2_DMA
    if (wact) {
        if (hi == 0) li_l[r32] = l_reg;
        asm volatile("s_waitcnt lgkmcnt(0)" ::: "memory");
        float rli[16];
#pragma unroll
        for (int r = 0; r < 16; ++r) rli[r] = __builtin_amdgcn_rcpf(li_l[crow(r, hi)]);
        if (hi == 0) u.L[(size_t)(32 * wid + r32) * u.lpitch] = m_reg * C2 + __builtin_amdgcn_logf(l_reg);
        const int OP = u.opitch; bf16_t* Ow = u.O + (size_t)(32 * wid) * OP;
#pragma unroll
        for (int r = 0; r < 16; ++r) { const int orow = crow(r, hi);
#pragma unroll
            for (int d0 = 0; d0 < 4; ++d0) { const float v = o[d0][r] * rli[r];
                const float vn = __builtin_bit_cast(float, __builtin_amdgcn_mov_dpp(__builtin_bit_cast(int, v), 0xB1, 0xF, 0xF, true));
                if ((r32 & 1) == 0) *(unsigned*)(Ow + (size_t)orow * OP + d0 * 32 + r32) = cvtpk(v, vn); } }
    }
    asm volatile("s_waitcnt lgkmcnt(0)" ::: "memory"); __builtin_amdgcn_s_barrier(); asm volatile("" ::: "memory");
}
#undef W2_KSWZ
#undef W2_SBAR
}

constexpr int N_ATTN_BLOCKS = 1024;

namespace wsa3 {
using swa::f32x16; using swa::s16x4; using swa::crow; using swa::cvtpk; using swa::v_rd_base; using swa::SCALE; using swa::THR;
constexpr int BLK_K = 8192, SLOT = 16384, NSLOT = 9, SCR = NSLOT * SLOT, LDS_NEED = SCR + NWAVES * 256;
static_assert(LDS_NEED <= MISC_OFF, "wsa3 LDS");
#define W3_KSWZ(row, colB) ((row) * 256 + ((colB) ^ (((row) & 7) << 4)))
#define W3_SBAR() __builtin_amdgcn_sched_barrier(0)
__device__ __forceinline__ void wait_vm_ops(int n) {
    switch (n >> 1) {
    case 0: asm volatile("s_waitcnt vmcnt(0)" ::: "memory"); break;
    case 1: asm volatile("s_waitcnt vmcnt(2)" ::: "memory"); break;
    case 2: asm volatile("s_waitcnt vmcnt(4)" ::: "memory"); break;
    case 3: asm volatile("s_waitcnt vmcnt(6)" ::: "memory"); break;
    case 4: asm volatile("s_waitcnt vmcnt(8)" ::: "memory"); break;
    case 5: asm volatile("s_waitcnt vmcnt(10)" ::: "memory"); break;
    case 6: asm volatile("s_waitcnt vmcnt(12)" ::: "memory"); break;
    case 7: asm volatile("s_waitcnt vmcnt(14)" ::: "memory"); break;
    case 8: asm volatile("s_waitcnt vmcnt(16)" ::: "memory"); break;
    case 9: asm volatile("s_waitcnt vmcnt(18)" ::: "memory"); break;
    case 10: asm volatile("s_waitcnt vmcnt(20)" ::: "memory"); break;
    case 11: asm volatile("s_waitcnt vmcnt(22)" ::: "memory"); break;
    case 12: asm volatile("s_waitcnt vmcnt(24)" ::: "memory"); break;
    case 13: asm volatile("s_waitcnt vmcnt(26)" ::: "memory"); break;
    case 14: asm volatile("s_waitcnt vmcnt(28)" ::: "memory"); break;
    case 15: asm volatile("s_waitcnt vmcnt(30)" ::: "memory"); break;
    case 16: asm volatile("s_waitcnt vmcnt(32)" ::: "memory"); break;
    case 17: asm volatile("s_waitcnt vmcnt(34)" ::: "memory"); break;
    case 18: asm volatile("s_waitcnt vmcnt(36)" ::: "memory"); break;
    case 19: asm volatile("s_waitcnt vmcnt(38)" ::: "memory"); break;
    case 20: asm volatile("s_waitcnt vmcnt(40)" ::: "memory"); break;
    case 21: asm volatile("s_waitcnt vmcnt(42)" ::: "memory"); break;
    case 22: asm volatile("s_waitcnt vmcnt(44)" ::: "memory"); break;
    case 23: asm volatile("s_waitcnt vmcnt(46)" ::: "memory"); break;
    case 24: asm volatile("s_waitcnt vmcnt(48)" ::: "memory"); break;
    case 25: asm volatile("s_waitcnt vmcnt(50)" ::: "memory"); break;
    case 26: asm volatile("s_waitcnt vmcnt(52)" ::: "memory"); break;
    case 27: asm volatile("s_waitcnt vmcnt(54)" ::: "memory"); break;
    case 28: asm volatile("s_waitcnt vmcnt(56)" ::: "memory"); break;
    case 29: asm volatile("s_waitcnt vmcnt(58)" ::: "memory"); break;
    case 30: asm volatile("s_waitcnt vmcnt(60)" ::: "memory"); break;
    default: asm volatile("s_waitcnt vmcnt(62)" ::: "memory"); break;
    }
}
__device__ __forceinline__ void phase(const Frame& F, unsigned char* ws, int layer, unsigned long long& ts_sum, unsigned long long& ts_t0) {
    const int wid = F.wave, tid = tid_from(wid), lane = tid & 63, r32 = lane & 31, hi = lane >> 5;
    LAS unsigned char* lds = F.lds;
    const int nU = F.vcu < N_ATTN_BLOCKS ? (N_ATTN_BLOCKS - 1 - F.vcu) / F.G + 1 : 0;
    if (nU == 0) return;
    const int krow = 4 * wid + (lane >> 4), kchunk = (lane & 15) ^ (4 * (wid & 1) + (lane >> 4));
    const int kk = (wid >> 1) * 8 + ((lane & 31) >> 2), vkey = (kk & ~0xC) | ((kk & 4) << 1) | ((kk & 8) >> 1), vcol = ((2 * (wid & 1) + (lane >> 5)) & 3) * 32 + (lane & 3) * 8;
    const unsigned klane = (unsigned)(krow * HD + kchunk * 8) * 2u, vlane = (unsigned)(vkey * HD + vcol) * 2u;
    typedef __attribute__((address_space(3))) unsigned lds_u32;
    const unsigned ldsb = (unsigned)(size_t)lds;
    LAS float* li_l = (LAS float*)(lds + SCR + wid * 256); LAS float* al_l = li_l + 32;
    constexpr float C2 = 1.4426950408889634f * SCALE;
    int koff[4];
#pragma unroll
    for (int dd = 0; dd < 4; ++dd) koff[dd] = W3_KSWZ(r32, (dd * 16 + hi * 8) * 2);
    const unsigned vrb = ldsb + BLK_K + (unsigned)v_rd_base(lane);
    int kI = -1, tI = 5, jI = 0, nbI = 0, issued = 0, consumed = 0, islot = 0, qmark = -1, smark = -1, nst = 0;
    const char* kbI = nullptr; const char* vbI = nullptr;
    bf16x8 qn[8], qr[8];
#define W3_SETUP_I() do { int skv_; const swa::Ref ri = attn_ref(ws, F.vcu + kI * F.G, skv_); \
        const int I0_ = ri.P0, B0_ = (I0_ >= 128 ? I0_ - 128 : 0) >> 5; nbI = ((I0_ + ri.nq - 32) >> 5) - B0_ + 1; tI = 0; jI = 0; \
        kbI = (const char*)(ri.K + (size_t)B0_ * 32 * HD); vbI = (const char*)(ri.V + (size_t)B0_ * 32 * HD); \
        const int qrow_ = 32 * wid < ri.nq ? 32 * wid + r32 : ri.nq - 1; const bf16_t* qp_ = ri.Q + (size_t)qrow_ * HD + hi * 8; \
        _Pragma("unroll") for (int d0 = 0; d0 < 8; ++d0) asm volatile("global_load_dwordx4 %0, %1, off" : "=v"(qn[d0]) : "v"(qp_ + d0 * 16) : "memory"); \
        qmark = issued; } while (0)
#define W3_ISSUE(kC_) do { for (;;) { \
        if (tI >= 5) { if (kI + 1 >= nU || kI >= (kC_) + 1) break; ++kI; W3_SETUP_I(); } \
        if (issued - consumed >= NSLOT) break; \
        __builtin_amdgcn_global_load_lds((const unsigned*)(kbI + (size_t)jI * (32 * HD * 2) + klane), (lds_u32*)(size_t)(ldsb + islot * SLOT + wid * 1024), 16, 0, 2); \
        __builtin_amdgcn_global_load_lds((const unsigned*)(vbI + (size_t)jI * (32 * HD * 2) + vlane), (lds_u32*)(size_t)(ldsb + islot * SLOT + BLK_K + wid * 1024), 16, 0, 2); \
        ++issued; islot = islot == NSLOT - 1 ? 0 : islot + 1; \
        jI += 5; while (tI < 5 && jI >= nbI) { ++tI; jI = tI; } } } while (0)
    asm volatile("s_waitcnt lgkmcnt(0)" ::: "memory"); __builtin_amdgcn_s_barrier(); asm volatile("" ::: "memory");
    W3_ISSUE(-1);
    int spos = 0;
#pragma unroll 1
    for (int kC = 0; kC < nU; ++kC) {
        if (W_TOUCH2 == 2 && kC == nU - 1 && F.vcu < 256 && wid < 3) {
            const int ln_ = tid_from(wid) & 63, cu_ = F.vcu; const char* tp_;
            if (wid == 0) tp_ = (const char*)(ws + OFF_WOUT) + (size_t)layer * D_MODEL * D_MODEL * 2 + ((size_t)cu_ * 64 + ln_) * 128;
            else if (wid == 1) tp_ = (ln_ < 32 ? (const char*)(ws + OFF_WBS) + (size_t)layer * D_MODEL * SSM_W * 2 : (const char*)(ws + OFF_WBA) + (size_t)layer * D_MODEL * ATT_W * 2) + ((size_t)cu_ * 32 + (ln_ & 31)) * 128;
            else tp_ = (const char*)(ws + OFF_WGLU) + (size_t)layer * SSM_W * SSM_W * 2 + ((size_t)cu_ * 16 + (ln_ & 15)) * 128;
            __builtin_amdgcn_global_load_lds((const unsigned*)tp_, (lds_u32*)(size_t)(ldsb + 155648 + wid * 256), 4, 0, 0);
        }
        int skv; const swa::Ref u = attn_ref(ws, F.vcu + kC * F.G, skv);
        const int I0 = u.P0, i0 = I0 + 32 * wid;
        const bool wact = 32 * wid < u.nq;
        const int B0 = (I0 >= 128 ? I0 - 128 : 0) >> 5;
        const int kfirst = i0 >= 128 ? i0 - 128 : 0, nblk = wact ? ((i0 - kfirst) >> 5) + 1 : 0, fw = (kfirst >> 5) - B0;
        const int nbtot = ((I0 + u.nq - 32) >> 5) - B0 + 1;
        float m_reg = -1e30f, l_reg = 0.f; f32x16 o[4] = {};
#pragma unroll 1
        for (int t = 0; t < 5; ++t) {
            const int cnt = t < nbtot ? (nbtot - t + 4) / 5 : 0;
            if (cnt == 0) continue;
            TS_BEGIN(31);
            { const int endp = spos + cnt; wait_vm_ops(2 * (issued - endp) + (qmark >= endp ? 8 : 0) + (smark >= endp ? nst : 0)); }
            asm volatile("s_waitcnt lgkmcnt(0)" ::: "memory"); __builtin_amdgcn_s_barrier(); asm volatile("" ::: "memory");
            if (t == 0) {
                asm volatile("" : "+v"(qn[0]), "+v"(qn[1]), "+v"(qn[2]), "+v"(qn[3]), "+v"(qn[4]), "+v"(qn[5]), "+v"(qn[6]), "+v"(qn[7]));
#pragma unroll
                for (int d0 = 0; d0 < 8; ++d0) qr[d0] = qn[d0];
            }
            TS_END(31); TS_BEGIN(34);
            consumed = spos; W3_ISSUE(kC);
            TS_END(34); TS_BEGIN(32);
            const int rj = (t - fw) % 5, j = fw + (rj < 0 ? rj + 5 : rj);
            if (j < fw + nblk) {
                const int slot = (spos + (j - t) / 5) % NSLOT, k0 = (B0 + j) * 32;
                const LAS unsigned char* kb = lds + slot * SLOT;
                f32x16 p = {};
#pragma unroll
                for (int d0 = 0; d0 < 8; ++d0) { const bf16x8 kf = *(const LAS bf16x8*)(kb + koff[d0 & 3] + (d0 >> 2) * 128);
                    p = __builtin_amdgcn_mfma_f32_32x32x16_bf16(kf, qr[d0], p, 0, 0, 0); }
                if (k0 == i0 || k0 + 128 == i0) {
                    const int dq = i0 + r32 - k0 - 4 * hi; const float NEG = -__builtin_inff();
#pragma unroll
                    for (int r = 0; r < 16; ++r) { const int c = (r & 3) + 8 * (r >> 2); if ((unsigned)(dq - c) >= 129u) p[r] = NEG; }
                }
                float pmax = p[0];
#pragma unroll
                for (int r = 1; r < 16; ++r) pmax = fmaxf(pmax, p[r]);
                { auto rr = __builtin_amdgcn_permlane32_swap(__float_as_uint(pmax), __float_as_uint(pmax), false, false); pmax = fmaxf(__uint_as_float(rr[0]), __uint_as_float(rr[1])); }
                float mn, alpha;
                if (__builtin_expect(__all((pmax - m_reg) * SCALE <= THR), 1)) { mn = m_reg; alpha = 1.f; }
                else { mn = fmaxf(m_reg, pmax); alpha = __builtin_amdgcn_exp2f((m_reg - mn) * C2); m_reg = mn; }
                const float mnL = -mn * C2;
#pragma unroll
                for (int r = 0; r < 16; ++r) p[r] = __builtin_amdgcn_exp2f(fmaf(p[r], C2, mnL));
                float ps = 0.f;
#pragma unroll
                for (int r = 0; r < 16; ++r) ps += p[r];
                { auto rr = __builtin_amdgcn_permlane32_swap(__float_as_uint(ps), __float_as_uint(ps), false, false); ps = __uint_as_float(rr[0]) + __uint_as_float(rr[1]); }
                l_reg = l_reg * alpha + ps;
                bf16x8 pa0, pa1;
#define W3_PK4(B_, OUT) do { unsigned a0 = cvtpk(p[B_+0], p[B_+1]), a1 = cvtpk(p[B_+2], p[B_+3]), b0 = cvtpk(p[B_+4], p[B_+5]), b1 = cvtpk(p[B_+6], p[B_+7]); \
                auto r0 = __builtin_amdgcn_permlane32_swap(a0, b0, false, false); auto r1 = __builtin_amdgcn_permlane32_swap(a1, b1, false, false); \
                u32x4 w = {r0[0], r1[0], r0[1], r1[1]}; OUT = *reinterpret_cast<bf16x8*>(&w); } while (0)
                W3_PK4(0, pa0); W3_PK4(8, pa1);
#undef W3_PK4
                if (__any(alpha < 1.f)) {
                    if (hi == 0) al_l[r32] = alpha;
                    asm volatile("s_waitcnt lgkmcnt(0)" ::: "memory");
#pragma unroll
                    for (int d_ = 0; d_ < 4; ++d_)
#pragma unroll
                        for (int r = 0; r < 16; ++r) o[d_][r] *= al_l[crow(r, hi)];
                }
                const unsigned vb0 = vrb + (unsigned)(slot * SLOT);
#define W3_TR(dst, off) asm volatile("ds_read_b64_tr_b16 %0, %1 offset:%2" : "=&v"(dst) : "v"(vb0), "i"(off) : "memory")
#define W3_PV(d0) do { s16x4 l0, l1, h0, h1; W3_TR(l0, (d0) * 512); W3_TR(h0, (d0) * 512 + 2048); W3_TR(l1, (d0) * 512 + 4096); W3_TR(h1, (d0) * 512 + 6144); \
                asm volatile("s_waitcnt lgkmcnt(0)" ::: "memory"); W3_SBAR(); \
                o[d0] = __builtin_amdgcn_mfma_f32_32x32x16_bf16(pa0, (bf16x8){l0[0], l0[1], l0[2], l0[3], h0[0], h0[1], h0[2], h0[3]}, o[d0], 0, 0, 0); \
                o[d0] = __builtin_amdgcn_mfma_f32_32x32x16_bf16(pa1, (bf16x8){l1[0], l1[1], l1[2], l1[3], h1[0], h1[1], h1[2], h1[3]}, o[d0], 0, 0, 0); } while (0)
                W3_PV(0); W3_PV(1); W3_PV(2); W3_PV(3);
#undef W3_PV
#undef W3_TR
            }
            spos += cnt;
            TS_END(32);
        }
        TS_BEGIN(33);
        if (wact) {
            if (hi == 0) li_l[r32] = l_reg;
            asm volatile("s_waitcnt lgkmcnt(0)" ::: "memory");
            float rli[16];
#pragma unroll
            for (int r = 0; r < 16; ++r) rli[r] = __builtin_amdgcn_rcpf(li_l[crow(r, hi)]);
            { const float lse = m_reg * C2 + __builtin_amdgcn_logf(l_reg); const unsigned lo_ = (unsigned)((32 * wid + r32) * u.lpitch) * 4u;
              asm volatile("global_store_dword %0, %1, %2" :: "v"(lo_), "v"(lse), "s"(u.L) : "memory"); }
            const int OP = u.opitch; const bf16_t* Ow = u.O + (size_t)(32 * wid) * OP;
            const unsigned lane_off = (unsigned)(4 * hi * OP + 4 * r32) * 2u;
#pragma unroll
            for (int r = 0; r < 16; ++r) { const unsigned vo = lane_off + (unsigned)(((r & 3) + 8 * (r >> 2)) * OP) * 2u;
                typedef unsigned u32x2_ __attribute__((ext_vector_type(2)));
                u32x2_ w; w.x = cvtpk(o[0][r] * rli[r], o[1][r] * rli[r]); w.y = cvtpk(o[2][r] * rli[r], o[3][r] * rli[r]);
                asm volatile("global_store_dwordx2 %0, %1, %2" :: "v"(vo), "v"(w), "s"(Ow) : "memory"); }
            smark = issued; nst = 17;
        } else { smark = -1; nst = 0; }
        TS_END(33);
    }
#undef W3_ISSUE
#undef W3_SETUP_I
    asm volatile("s_waitcnt lgkmcnt(0)" ::: "memory"); __builtin_amdgcn_s_barrier(); asm volatile("" ::: "memory");
}
#undef W3_KSWZ
#undef W3_SBAR
}


__device__ __forceinline__ void attn_phase(const Frame& F, unsigned char* ws, int layer, unsigned long long& ts_sum, unsigned long long& ts_t0) {
#if ATTN_DMA == 3
    wsa3::phase(F, ws, layer, ts_sum, ts_t0);
    return;
#endif
#if ATTN_DMA == 2
#if EXP_HALF == 2
    if (F.vcu & 1) return;
    for (int L = F.vcu; L < N_ATTN_BLOCKS; L += F.G) { for (int e = 0; e < 2; ++e) { int skv; const swa::Ref cur = attn_ref(ws, L + e, skv); wsa2::unit(cur, F.lds, F.wave); } }
    return;
#endif
    for (int L = F.vcu; L < N_ATTN_BLOCKS; L += F.G) { int skv; const swa::Ref cur = attn_ref(ws, L, skv); wsa2::unit(cur, F.lds, F.wave); }
    return;
#elif ATTN_DMA == 1
    for (int L = F.vcu; L < N_ATTN_BLOCKS; L += F.G) { int skv; const swa::Ref cur = attn_ref(ws, L, skv); swa::block_dma<bf16_t, bf16_t>(cur, skv, 129, (char*)F.lds, F.wave); }
    return;
#endif
    int L = F.vcu; if (L >= N_ATTN_BLOCKS) return;
    char* lds = (char*)F.lds;
    int skv, skvn; swa::Ref cur = attn_ref(ws, L, skv);
    swa::Seam<bf16_t> S;
    swa::causal_swa_prime<bf16_t, bf16_t>(cur, 129, lds, S, F.wave);
    for (;;) {
        const int Ln = L + F.G; const bool last = Ln >= N_ATTN_BLOCKS;
        swa::Ref nxt = cur; skvn = skv; if (!last) nxt = attn_ref(ws, Ln, skvn);
        swa::causal_swa_block<bf16_t, bf16_t>(cur, nxt, skv, 129, lds, S, F.wave);
        if (last) break;
        cur = nxt; skv = skvn; L = Ln;
    }
}

namespace wsa {
using swa::f32x16; using swa::s16x4; using swa::crow; using swa::cvtpk; using swa::v_st; using swa::v_rd_base; using swa::SCALE; using swa::THR;
constexpr int VBUF = 8192;
constexpr int WAVE_LDS = 2 * VBUF + 256;
struct Item { const bf16_t* Q; const bf16_t* K; const bf16_t* V; bf16_t* O; float* L; int i0, pitch, opitch, lpitch; };
constexpr int N_ITEMS = 3 * 2048;
__device__ __forceinline__ Item decode(unsigned char* ws, int it) {
    const int gi = it >> 11, r = it & 2047, b = r >> 8, h = (r >> 6) & 3;
    int c, qw, d;
    if (gi == 0) { c = 0; qw = r & 63; d = 1; } else if (gi == 1) { c = (r >> 4) & 3; qw = r & 15; d = 4; } else { c = (r >> 2) & 15; qw = r & 3; d = 16; }
    Item x; x.i0 = 32 * qw; x.pitch = HD; x.opitch = d * ATT_W; x.lpitch = d * 4;
    const size_t hb = ((size_t)(gi * BATCH + b) * HPG + h) * SEQ * HD + (size_t)c * (SEQ / d) * HD, kstep = (size_t)3 * BATCH * HPG * SEQ * HD;
    const bf16_t* qkv = (const bf16_t*)(ws + OFF_QKV);
    const size_t tok0 = (size_t)b * SEQ + c + (size_t)x.i0 * d;
    x.Q = qkv + hb + (size_t)x.i0 * HD; x.K = qkv + kstep + hb; x.V = qkv + 2 * kstep + hb;
    x.O = (bf16_t*)(ws + OFF_AO) + ((size_t)gi * MTOK + tok0) * ATT_W + h * HD;
    x.L = (float*)(ws + OFF_ALSE) + ((size_t)gi * MTOK + tok0) * 4 + h;
    return x;
}
#define WSA_SBAR() __builtin_amdgcn_sched_barrier(0)
__device__ __forceinline__ void wave_item(const Item& it, LAS unsigned char* wl, int lane) {
    const int r32 = lane & 31, hi = lane >> 5, pitch = it.pitch;
    LAS float* li_l = (LAS float*)(wl + 2 * VBUF); LAS float* al_l = li_l + 32;
    const int kfirst = it.i0 >= 128 ? it.i0 - 128 : 0, nblk = ((it.i0 - kfirst) >> 5) + 1;
    const bf16_t* qp = it.Q + (size_t)r32 * pitch + hi * 8;
    const bf16_t* kp = it.K + (size_t)(kfirst + r32) * pitch + hi * 8;
    const int vkey = lane >> 4, vch = (lane & 15) * 8;
    const bf16_t* vp = it.V + (size_t)(kfirst + vkey) * pitch + vch;
    int vst_off[8];
#pragma unroll
    for (int i = 0; i < 8; ++i) vst_off[i] = v_st(vkey + 4 * i, vch);
    bf16x8 qr[8], kf[8], vs[8];
#pragma unroll
    for (int d0 = 0; d0 < 8; ++d0) qr[d0] = *(const bf16x8*)(qp + d0 * 16);
#pragma unroll
    for (int d0 = 0; d0 < 8; ++d0) kf[d0] = *(const bf16x8*)(kp + d0 * 16);
#pragma unroll
    for (int i = 0; i < 8; ++i) vs[i] = *(const bf16x8*)(vp + (size_t)(4 * i) * pitch);
#pragma unroll
    for (int i = 0; i < 8; ++i) *(LAS bf16x8*)(wl + vst_off[i]) = vs[i];
    float m_reg = -1e30f, l_reg = 0.f; f32x16 o[4] = {};
    const unsigned vbase = (unsigned)(size_t)wl + (unsigned)v_rd_base(lane);
    constexpr float C2 = 1.4426950408889634f * SCALE;
#pragma unroll 1
    for (int blk = 0; blk < nblk; ++blk) {
        const int k0 = kfirst + 32 * blk; const bool more = blk + 1 < nblk;
        if (more) {
#pragma unroll
            for (int i = 0; i < 8; ++i) vs[i] = *(const bf16x8*)(vp + (size_t)(32 * (blk + 1) + 4 * i) * pitch);
        }
        f32x16 p = {};
#pragma unroll
        for (int d0 = 0; d0 < 8; ++d0) p = __builtin_amdgcn_mfma_f32_32x32x16_bf16(kf[d0], qr[d0], p, 0, 0, 0);
        if (more) {
#pragma unroll
            for (int d0 = 0; d0 < 8; ++d0) kf[d0] = *(const bf16x8*)(kp + (size_t)(32 * (blk + 1)) * pitch + d0 * 16);
        }
        if (k0 == it.i0 || k0 + 128 == it.i0) {
            const int dq = it.i0 + r32 - k0 - 4 * hi; const float NEG = -__builtin_inff();
#pragma unroll
            for (int r = 0; r < 16; ++r) { const int c = (r & 3) + 8 * (r >> 2); if ((unsigned)(dq - c) >= 129u) p[r] = NEG; }
        }
        float pmax = p[0];
#pragma unroll
        for (int r = 1; r < 16; ++r) pmax = fmaxf(pmax, p[r]);
        { auto rr = __builtin_amdgcn_permlane32_swap(__float_as_uint(pmax), __float_as_uint(pmax), false, false); pmax = fmaxf(__uint_as_float(rr[0]), __uint_as_float(rr[1])); }
        float mn, alpha;
        if (__builtin_expect(__all((pmax - m_reg) * SCALE <= THR), 1)) { mn = m_reg; alpha = 1.f; }
        else { mn = fmaxf(m_reg, pmax); alpha = __builtin_amdgcn_exp2f((m_reg - mn) * C2); m_reg = mn; }
        const float mnL = -mn * C2;
#pragma unroll
        for (int r = 0; r < 16; ++r) p[r] = __builtin_amdgcn_exp2f(fmaf(p[r], C2, mnL));
        float ps = 0.f;
#pragma unroll
        for (int r = 0; r < 16; ++r) ps += p[r];
        { auto rr = __builtin_amdgcn_permlane32_swap(__float_as_uint(ps), __float_as_uint(ps), false, false); ps = __uint_as_float(rr[0]) + __uint_as_float(rr[1]); }
        l_reg = l_reg * alpha + ps;
        bf16x8 pa0, pa1;
#define WSA_PK4(B_, OUT) do { unsigned a0 = cvtpk(p[B_+0], p[B_+1]), a1 = cvtpk(p[B_+2], p[B_+3]), b0 = cvtpk(p[B_+4], p[B_+5]), b1 = cvtpk(p[B_+6], p[B_+7]); \
        auto r0 = __builtin_amdgcn_permlane32_swap(a0, b0, false, false); auto r1 = __builtin_amdgcn_permlane32_swap(a1, b1, false, false); \
        u32x4 w = {r0[0], r1[0], r0[1], r1[1]}; OUT = *reinterpret_cast<bf16x8*>(&w); } while (0)
        WSA_PK4(0, pa0); WSA_PK4(8, pa1);
#undef WSA_PK4
        if (__any(alpha < 1.f)) {
            if (hi == 0) al_l[r32] = alpha;
            asm volatile("s_waitcnt lgkmcnt(0)" ::: "memory");
#pragma unroll
            for (int d_ = 0; d_ < 4; ++d_)
#pragma unroll
                for (int r = 0; r < 16; ++r) o[d_][r] *= al_l[crow(r, hi)];
        }
        const unsigned vb0 = vbase + (unsigned)((blk & 1) * VBUF);
#define WSA_TR(dst, off) asm volatile("ds_read_b64_tr_b16 %0, %1 offset:%2" : "=&v"(dst) : "v"(vb0), "i"(off) : "memory")
#define WSA_PV(d0) do { s16x4 l0, l1, h0, h1; WSA_TR(l0, (d0) * 512); WSA_TR(h0, (d0) * 512 + 2048); WSA_TR(l1, (d0) * 512 + 4096); WSA_TR(h1, (d0) * 512 + 6144); \
        asm volatile("s_waitcnt lgkmcnt(0)" ::: "memory"); WSA_SBAR(); \
        o[d0] = __builtin_amdgcn_mfma_f32_32x32x16_bf16(pa0, (bf16x8){l0[0], l0[1], l0[2], l0[3], h0[0], h0[1], h0[2], h0[3]}, o[d0], 0, 0, 0); \
        o[d0] = __builtin_amdgcn_mfma_f32_32x32x16_bf16(pa1, (bf16x8){l1[0], l1[1], l1[2], l1[3], h1[0], h1[1], h1[2], h1[3]}, o[d0], 0, 0, 0); } while (0)
        WSA_PV(0); WSA_PV(1); WSA_PV(2); WSA_PV(3);
#undef WSA_PV
#undef WSA_TR
        if (more) {
            LAS unsigned char* nb = wl + ((blk + 1) & 1) * VBUF;
#pragma unroll
            for (int i = 0; i < 8; ++i) *(LAS bf16x8*)(nb + vst_off[i]) = vs[i];
        }
        asm volatile("s_waitcnt lgkmcnt(0)" ::: "memory");
    }
    if (hi == 0) li_l[r32] = l_reg;
    asm volatile("s_waitcnt lgkmcnt(0)" ::: "memory");
    float rli[16];
#pragma unroll
    for (int r = 0; r < 16; ++r) rli[r] = __builtin_amdgcn_rcpf(li_l[crow(r, hi)]);
    if (hi == 0) it.L[(size_t)r32 * it.lpitch] = m_reg * C2 + __builtin_amdgcn_logf(l_reg);
    const int OP = it.opitch;
#pragma unroll
    for (int r = 0; r < 16; ++r) { const int orow = crow(r, hi);
#pragma unroll
        for (int d0 = 0; d0 < 4; ++d0) { const float v = o[d0][r] * rli[r];
            const float vn = __builtin_bit_cast(float, __builtin_amdgcn_mov_dpp(__builtin_bit_cast(int, v), 0xB1, 0xF, 0xF, true));
            if ((r32 & 1) == 0) *(unsigned*)(it.O + (size_t)orow * OP + d0 * 32 + r32) = cvtpk(v, vn); } }
    asm volatile("s_waitcnt lgkmcnt(0)" ::: "memory");
}
#undef WSA_SBAR
__device__ __forceinline__ void phase(const Frame& F, unsigned char* ws) {
    const int lane = tid_from(F.wave) & 63;
    LAS unsigned char* wl = F.lds + F.wave * WAVE_LDS;
#pragma unroll 1
    for (int it = F.vcu * NWAVES + F.wave; it < N_ITEMS; it += F.G * NWAVES) { const Item x = decode(ws, it); wave_item(x, wl, lane); }
}
}

namespace s5 {
constexpr size_t T_WST = 2 * MiB;
constexpr size_t T_WO = 10 * MiB;
constexpr size_t T_KT = 18 * MiB;
constexpr size_t T_A16 = 20 * MiB;
constexpr int RSTR = 528;
constexpr int U_OFF = 0, L_OFF = 128 * RSTR;
constexpr int LDS_NEED = 2 * 128 * RSTR + 4096;
__device__ __forceinline__ void tables_wg(const Args& a, LAS unsigned char* lds, int lg, int wave_s) {
    typedef float f32x2 __attribute__((ext_vector_type(2)));
    LAS f32x2* PW = (LAS f32x2*)lds; LAS f32x2* BB = PW + 17 * 64; LAS f32x2* CT = BB + 64 * 16;
    const int tid = tid_from(wave_s); unsigned char* ws = a.p.ws;
    if (tid < 64) {
        const int idx = lg * 64 + tid;
        const float lre = fminf(inptr(a, IN_LRE)[idx], -1e-4f), lim = inptr(a, IN_LIM)[idx], dt = expf(inptr(a, IN_LDT)[lg]);
        const float ar = lre * dt, b = lim * dt, ea = expf(ar), sb = sinf(b), cb = cosf(b);
        const float Are = ea * cb, Aim = ea * sb, sh = sinf(0.5f * b);
        const float Dre = expm1f(ar) * cb - 2.0f * sh * sh, Dim = Aim;
        const float den = lre * lre + lim * lim;
        const float cre = (Dre * lre + Dim * lim) / den, cim = (Dim * lre - Dre * lim) / den;
        float* A = (float*)(ws + OFF_S5 + S5_A); float* Bb = (float*)(ws + OFF_S5 + S5_BB);
        A[idx * 2] = Are; A[idx * 2 + 1] = Aim;
        const float* bre = inptr(a, IN_BRE) + idx * 16; const float* bim = inptr(a, IN_BIM) + idx * 16;
        for (int c = 0; c < 16; ++c) { const float br = bre[c], bi = bim[c]; const f32x2 v = {cre * br - cim * bi, cre * bi + cim * br};
            Bb[(idx * 16 + c) * 2] = v.x; Bb[(idx * 16 + c) * 2 + 1] = v.y; BB[tid * 16 + c] = v; }
        float pr = 1.f, pi = 0.f; asm volatile("" : "+v"(pr), "+v"(pi));
        for (int k = 0; k <= 16; ++k) { PW[k * 64 + tid] = (f32x2){pr, pi}; const float nr = pr * Are - pi * Aim, ni = pr * Aim + pi * Are; pr = nr; pi = ni; }
        const f32x2 a16 = PW[16 * 64 + tid];
        ((f32x2*)(ws + OFF_S5 + T_A16))[idx] = a16;
    } else {
        const float* cr = inptr(a, IN_CRE) + (size_t)lg * 1024; const float* ci = inptr(a, IN_CIM) + (size_t)lg * 1024;
        for (int e = tid - 64; e < 1024; e += NTHREADS - 64) { const int c = e >> 6, pp = e & 63; CT[pp * 16 + c] = (f32x2){cr[e], ci[e]}; }
    }
    __syncthreads();
    bf16_t* WST = (bf16_t*)(ws + OFF_S5 + T_WST) + (size_t)lg * 128 * 256;
    for (int e = tid; e < 4096; e += NTHREADS) {
        const int i = e >> 5, kk0 = (e & 31) * 8, s = kk0 >> 4, c0 = kk0 & 15, pp = i & 63; const bool im = i >= 64;
        const f32x2 w = PW[(15 - s) * 64 + pp]; float v[8];
#pragma unroll
        for (int j = 0; j < 8; ++j) { const f32x2 bb = BB[pp * 16 + c0 + j]; v[j] = im ? (w.x * bb.y + w.y * bb.x) : (w.x * bb.x - w.y * bb.y); }
        u32x4 o; o.x = pk2(v[0], v[1]); o.y = pk2(v[2], v[3]); o.z = pk2(v[4], v[5]); o.w = pk2(v[6], v[7]);
        *(u32x4*)(WST + (size_t)((((i >> 4) * 8 + ((e & 31) >> 2)) * 64 + ((e & 31) & 3) * 16 + (i & 15)) * 8)) = o;
    }
    bf16_t* WO = (bf16_t*)(ws + OFF_S5 + T_WO) + (size_t)lg * 256 * 128;
    for (int e = tid; e < 4096; e += NTHREADS) {
        const int row = e >> 4, i0 = (e & 15) * 8, t = row >> 4, c = row & 15; float v[8];
#pragma unroll
        for (int j = 0; j < 8; ++j) { const int ip = i0 + j, pp = ip & 63; const f32x2 cc = CT[pp * 16 + c], w = PW[(t + 1) * 64 + pp];
            v[j] = ip < 64 ? (cc.x * w.x - cc.y * w.y) : -(cc.x * w.y + cc.y * w.x); }
        u32x4 o; o.x = pk2(v[0], v[1]); o.y = pk2(v[2], v[3]); o.z = pk2(v[4], v[5]); o.w = pk2(v[6], v[7]);
        *(u32x4*)(WO + (size_t)(((t * 4 + ((e & 15) >> 2)) * 64 + ((e & 15) & 3) * 16 + c) * 8)) = o;
    }
    bf16_t* KT = (bf16_t*)(ws + OFF_S5 + T_KT) + (size_t)lg * 17 * 256;
    { const int la = tid >> 5, c = (tid >> 1) & 15, h = tid & 1; float acc[8];
#pragma unroll
      for (int j = 0; j < 8; ++j) acc[j] = 0.f;
      for (int pp = 0; pp < 64; ++pp) { const f32x2 cc = CT[pp * 16 + c], w = PW[la * 64 + pp]; const float zr = cc.x * w.x - cc.y * w.y, zi = cc.x * w.y + cc.y * w.x;
#pragma unroll
          for (int j = 0; j < 8; ++j) { const f32x2 bb = BB[pp * 16 + 8 * h + j]; acc[j] += zr * bb.x - zi * bb.y; } }
      u32x4 o; o.x = pk2(acc[0], acc[1]); o.y = pk2(acc[2], acc[3]); o.z = pk2(acc[4], acc[5]); o.w = pk2(acc[6], acc[7]);
      *(u32x4*)(KT + ((la + 1) * 16 + c) * 16 + 8 * h) = o;
      if (tid < 32) { unsigned z_ = 0u; asm volatile("" : "+v"(z_)); *(u32x4*)(KT + tid * 8) = (u32x4){z_, z_, z_, z_}; } }
    __syncthreads();
}
__device__ __forceinline__ void unit(LAS unsigned char* lds, unsigned char* ws, int layer, int b, int g, int wave_s, const float* dsk_l) {
    const int tid = tid_from(wave_s), wave = wave_s, lane = tid & 63, q = lane >> 4, r16 = lane & 15;
    const int lg = layer * 32 + g;
    const bf16_t* usrc = (const bf16_t*)(ws + OFF_UG) + (size_t)(b * SSM_NG + g) * SEQ * 16;
    if (W_TOUCH2 == 1) {
        const int ln_ = tid_from(wave_s) & 63, cu_ = b * SSM_NG + g;
        const char* tp_ = nullptr;
        if (wave == 0) tp_ = (const char*)(ws + OFF_WOUT) + (size_t)layer * D_MODEL * D_MODEL * 2 + ((size_t)cu_ * 64 + ln_) * 128;
        else if (wave == 1) tp_ = (ln_ < 32 ? (const char*)(ws + OFF_WBS) + (size_t)layer * D_MODEL * SSM_W * 2 : (const char*)(ws + OFF_WBA) + (size_t)layer * D_MODEL * ATT_W * 2) + ((size_t)cu_ * 32 + (ln_ & 31)) * 128;
        else if (wave == 2) tp_ = (const char*)(ws + OFF_WGLU) + (size_t)layer * SSM_W * SSM_W * 2 + ((size_t)cu_ * 16 + (ln_ & 15)) * 128;
        if (wave < 3) __builtin_amdgcn_global_load_lds((const unsigned*)tp_, (LAS unsigned*)(lds + 143360 + wave * 256), 4, 0, 0);
    }
    __builtin_amdgcn_s_waitcnt(0);
    bf16x8 uv[8], af[8], kfA[8], wfA[4], kfB[8], wfB[4];
#pragma unroll
    for (int k = 0; k < 8; ++k) uv[k] = __builtin_nontemporal_load((const bf16x8*)(usrc + (size_t)(tid + NTHREADS * k) * 8));
    { const bf16_t* W = (const bf16_t*)(ws + OFF_S5 + T_WST) + (size_t)lg * 128 * 256 + (size_t)(wave * 8 * 64 + lane) * 8;
#pragma unroll
      for (int ks = 0; ks < 8; ++ks) af[ks] = __builtin_nontemporal_load((const bf16x8*)(W + ks * 512));
      const bf16_t* KT = (const bf16_t*)(ws + OFF_S5 + T_KT) + (size_t)lg * 17 * 256;
      const bf16_t* WO = (const bf16_t*)(ws + OFF_S5 + T_WO) + (size_t)lg * 256 * 128;
#pragma unroll
      for (int ks = 0; ks < 8; ++ks) { const int lagA = wave - (2 * ks + (q >> 1)) + 1, lagB = (15 - wave) - (2 * ks + (q >> 1)) + 1;
          kfA[ks] = *(const bf16x8*)(KT + ((lagA > 0 ? lagA : 0) * 16 + r16) * 16 + 8 * (q & 1)); kfB[ks] = *(const bf16x8*)(KT + ((lagB > 0 ? lagB : 0) * 16 + r16) * 16 + 8 * (q & 1)); }
#pragma unroll
      for (int k2 = 0; k2 < 4; ++k2) { wfA[k2] = __builtin_nontemporal_load((const bf16x8*)(WO + (size_t)((wave * 4 + k2) * 64 + lane) * 8)); wfB[k2] = __builtin_nontemporal_load((const bf16x8*)(WO + (size_t)(((15 - wave) * 4 + k2) * 64 + lane) * 8)); } }
#pragma unroll
    for (int k = 0; k < 8; ++k) { const int piece = tid + NTHREADS * k, tok = piece >> 1, half = piece & 1;
        *(LAS bf16x8*)(lds + U_OFF + (tok >> 4) * RSTR + (tok & 15) * 32 + half * 16) = uv[k]; }
    asm volatile("s_waitcnt lgkmcnt(0)" ::: "memory"); __builtin_amdgcn_s_barrier(); asm volatile("" ::: "memory");
    {
      for (int nt = 0; nt < 8; ++nt) {
          f32x4 acc = {0.f, 0.f, 0.f, 0.f};
          const LAS unsigned char* ub = lds + U_OFF + (nt * 16 + r16) * RSTR + q * 16;
#pragma unroll
          for (int ks = 0; ks < 8; ++ks) acc = __builtin_amdgcn_mfma_f32_16x16x32_bf16(af[ks], *(const LAS bf16x8*)(ub + ks * 64), acc, 0, 0, 0);
          *(LAS f32x4*)(lds + L_OFF + (nt * 16 + r16) * RSTR + (wave * 16 + 4 * q) * 4) = acc;
      } }
    asm volatile("s_waitcnt lgkmcnt(0)" ::: "memory"); __builtin_amdgcn_s_barrier(); asm volatile("" ::: "memory");
    {
        typedef float f32x2 __attribute__((ext_vector_type(2)));
        const f32x2 a16 = ((const f32x2*)(ws + OFF_S5 + T_A16))[lg * 64 + lane];
        LAS float* EW = (LAS float*)(lds + 2 * 128 * RSTR);
        float lre[16], lim[16], qre[16], qim[16];
#pragma unroll
        for (int jj = 0; jj < 16; ++jj) { const LAS float* row = (const LAS float*)(lds + L_OFF + (wave * 16 + jj) * RSTR); lre[jj] = row[lane]; lim[jj] = row[64 + lane]; }
        float sre = 0.f, sim = 0.f;
#pragma unroll
        for (int jj = 0; jj < 16; ++jj) { qre[jj] = sre; qim[jj] = sim;
            const float nre = a16.x * sre - a16.y * sim + lre[jj], nim = a16.x * sim + a16.y * sre + lim[jj]; sre = nre; sim = nim; }
        EW[wave * 128 + lane] = sre; EW[wave * 128 + 64 + lane] = sim;
        float pr = a16.x, pi = a16.y;
#pragma unroll
        for (int k = 0; k < 4; ++k) { const float nr = pr * pr - pi * pi, ni = 2.f * pr * pi; pr = nr; pi = ni; }
        __syncthreads();
        float ere[7], eim[7];
#pragma unroll
        for (int v = 0; v < 7; ++v) { ere[v] = EW[v * 128 + lane]; eim[v] = EW[v * 128 + 64 + lane]; }
        float gre = 0.f, gim = 0.f;
#pragma unroll
        for (int v = 0; v < 7; ++v) if (v < wave) { const float nre = pr * gre - pi * gim + ere[v], nim = pr * gim + pi * gre + eim[v]; gre = nre; gim = nim; }
#pragma unroll
        for (int jj = 0; jj < 16; ++jj) {
            LAS bf16_t* row = (LAS bf16_t*)(lds + L_OFF + (wave * 16 + jj) * RSTR);
            row[lane] = f2bf(qre[jj] + gre); row[64 + lane] = f2bf(qim[jj] + gim);
            const float nre = a16.x * gre - a16.y * gim, nim = a16.x * gim + a16.y * gre; gre = nre; gim = nim;
        }
    }
    __syncthreads();
    {
      bf16_t* ypre = (bf16_t*)(ws + OFF_YPRE) + (size_t)b * SEQ * SSM_W + g * 16 + 4 * q;
      const f32x4 dk = *(const f32x4*)(dsk_l + g * 16 + 4 * q);
#pragma unroll
      for (int tt = 0; tt < 2; ++tt) {
          const int t = tt ? 15 - wave : wave, nks = (t >> 1) + 1;
          bf16x8 kf[8], wf[4];
#pragma unroll
          for (int ks = 0; ks < 8; ++ks) kf[ks] = tt ? kfB[ks] : kfA[ks];
#pragma unroll
          for (int k2 = 0; k2 < 4; ++k2) wf[k2] = tt ? wfB[k2] : wfA[k2];
#pragma unroll 1
          for (int nt = 0; nt < 8; ++nt) {
              f32x4 acc = {0.f, 0.f, 0.f, 0.f}, accB = {0.f, 0.f, 0.f, 0.f}, accC = {0.f, 0.f, 0.f, 0.f};
              const LAS unsigned char* ub = lds + U_OFF + (nt * 16 + r16) * RSTR + q * 16;
              const LAS unsigned char* sb = lds + L_OFF + (nt * 16 + r16) * RSTR + q * 16;
#pragma unroll
              for (int ks = 0; ks < 8; ks += 2) { if (ks < nks) acc = __builtin_amdgcn_mfma_f32_16x16x32_bf16(kf[ks], *(const LAS bf16x8*)(ub + ks * 64), acc, 0, 0, 0);
                  if (ks + 1 < nks) accB = __builtin_amdgcn_mfma_f32_16x16x32_bf16(kf[ks + 1], *(const LAS bf16x8*)(ub + (ks + 1) * 64), accB, 0, 0, 0); }
#pragma unroll
              for (int k2 = 0; k2 < 4; ++k2) accC = __builtin_amdgcn_mfma_f32_16x16x32_bf16(wf[k2], *(const LAS bf16x8*)(sb + k2 * 64), accC, 0, 0, 0);
              acc = acc + accB + accC;
              const int tok = 16 * (nt * 16 + r16) + t;
              typedef unsigned u32x2_ __attribute__((ext_vector_type(2)));
              const u32x2_ uu = *(const LAS u32x2_*)(lds + U_OFF + (nt * 16 + r16) * RSTR + t * 32 + q * 8);
              const float y0 = gelu_fast(acc[0] + dk[0] * blo(uu.x)), y1 = gelu_fast(acc[1] + dk[1] * bhi(uu.x)), y2 = gelu_fast(acc[2] + dk[2] * blo(uu.y)), y3 = gelu_fast(acc[3] + dk[3] * bhi(uu.y));
              *(unsigned long long*)(ypre + (size_t)tok * SSM_W) = (unsigned long long)pk2(y0, y1) | ((unsigned long long)pk2(y2, y3) << 32);
          }
      } }
    __syncthreads();
}
}


namespace p4 {
constexpr int XT = 8192, WT = 65536, SLOT = XT + WT;
constexpr int RED_OFF = 2 * SLOT, RED2_OFF = RED_OFF + 2048;
constexpr int JUNK_OFF = RED2_OFF + 2048;
static_assert(JUNK_OFF + 2048 <= MISC_OFF, "P4 LDS map");
constexpr size_t OFF_MG = OFF_T4;
typedef unsigned u32x2 __attribute__((ext_vector_type(2)));
#define P4_WAIT_V(n) asm volatile("s_waitcnt vmcnt(" #n ")" ::: "memory")
#define P4_WAIT_L(n) asm volatile("s_waitcnt lgkmcnt(" #n ")" ::: "memory")
#define P4_BAR __builtin_amdgcn_s_barrier()

struct G64 { const bf16_t* X; const bf16_t* W; int lxs, lws; };
struct Geo { int rr, ch0, foff, wave; };
__device__ __forceinline__ Geo make_geo(int wave, int lane) {
    Geo g; g.rr = lane >> 3; g.ch0 = (lane & 7) ^ (g.rr >> 1); g.wave = wave;
    const int fr = lane & 15, fq = lane >> 4;
    g.foff = fr * 128 + ((fq ^ (fr >> 1)) & 7) * 16;
    return g;
}
__device__ __forceinline__ void stage64_piece(LAS unsigned char* lds, const Geo& g, const G64& d, int kt, int slot, int p) {
    const unsigned ldsw = (unsigned)g.wave * 1024u;
    if (p == 0) { const unsigned vo = ((unsigned)g.rr << d.lxs) + (unsigned)((g.ch0 ^ ((g.wave & 1) << 2)) * 16);
        __builtin_amdgcn_global_load_lds((const unsigned*)((const char*)d.X + (size_t)kt * 128 + ((size_t)(8 * g.wave) << d.lxs) + vo), (LAS unsigned*)(lds + slot * SLOT + ldsw), 16, 0, 0); }
    else { const int i = p - 1; const unsigned vo = ((unsigned)(16 * (g.rr >> 2) + (g.rr & 3)) << d.lws) + (unsigned)((g.ch0 ^ ((i & 1) << 2)) * 16);
        __builtin_amdgcn_global_load_lds((const unsigned*)((const char*)d.W + (size_t)kt * 128 + ((size_t)(64 * g.wave + 32 * (i & 1) + 4 * (i >> 1)) << d.lws) + vo), (LAS unsigned*)(lds + slot * SLOT + XT + ldsw * 8 + i * 1024), 16, 0, 0); }
}
__device__ __forceinline__ void stage64(LAS unsigned char* lds, const Geo& g, const G64& d, int kt, int slot, int parts) {
    if (parts & 1) stage64_piece(lds, g, d, kt, slot, 0);
    if (parts & 2) {
#pragma unroll
        for (int p = 1; p < 9; ++p) stage64_piece(lds, g, d, kt, slot, p);
    }
}
template <int NKT>
__device__ __forceinline__ void run64(f32x4 (&acc)[4][4], LAS unsigned char* lds, const Geo& g, const G64& cur, const G64& nxt, int nparts, int rot, int nrot) {
#define P4_READS(k) do { _Pragma("unroll") for (int m = 0; m < 4; ++m) xf[m] = *(const LAS bf16x8*)(sb + (g.foff ^ ((k) * 64)) + m * 2048); \
        _Pragma("unroll") for (int n = 0; n < 4; ++n) wf[n] = *(const LAS bf16x8*)(sb + XT + g.wave * 8192 + (g.foff ^ ((k) * 64)) + n * 2048); } while (0)
#define P4_MFMA(e) do { acc[((e) >> 2) & 3][(e) & 3] = __builtin_amdgcn_mfma_f32_16x16x32_bf16(wf[(e) & 3], xf[((e) >> 2) & 3], acc[((e) >> 2) & 3][(e) & 3], 0, 0, 0); } while (0)
#pragma unroll 1
    for (int kt = 0; kt + 1 < NKT; ++kt) {
        const int slot = kt & 1, ktn = (kt + 1 + rot) & (NKT - 1);
        P4_WAIT_V(0); P4_WAIT_L(0); P4_BAR;
        const LAS unsigned char* sb = lds + slot * SLOT; bf16x8 xf[4], wf[4];
        P4_READS(0);
#pragma unroll
        for (int i = 0; i < 5; ++i) { P4_MFMA(3 * i); P4_MFMA(3 * i + 1); P4_MFMA(3 * i + 2); stage64_piece(lds, g, cur, ktn, slot ^ 1, i); __builtin_amdgcn_sched_barrier(0); }
        P4_MFMA(15);
        __builtin_amdgcn_sched_barrier(0);
        P4_READS(1);
#pragma unroll
        for (int i = 0; i < 4; ++i) { P4_MFMA(4 * i); P4_MFMA(4 * i + 1); P4_MFMA(4 * i + 2); P4_MFMA(4 * i + 3); stage64_piece(lds, g, cur, ktn, slot ^ 1, 5 + i); __builtin_amdgcn_sched_barrier(0); }
    }
    {   const int kt = NKT - 1, slot = kt & 1;
        P4_WAIT_V(0); P4_WAIT_L(0); P4_BAR;
        if (nparts) stage64(lds, g, nxt, nrot, slot ^ 1, nparts);
        const LAS unsigned char* sb = lds + slot * SLOT; bf16x8 xf[4], wf[4];
#pragma unroll
        for (int k = 0; k < 2; ++k) { P4_READS(k);
#pragma unroll
            for (int e = 0; e < 16; ++e) P4_MFMA(e); }
    }
    P4_WAIT_L(0); P4_BAR;
#undef P4_READS
#undef P4_MFMA
}
__device__ __forceinline__ float sum_q(float v) {
    v += __builtin_bit_cast(float, __builtin_amdgcn_ds_swizzle(__builtin_bit_cast(int, v), 0x401F));
    const auto rr = __builtin_amdgcn_permlane32_swap(__float_as_uint(v), __float_as_uint(v), false, false);
    return __uint_as_float(rr[0]) + __uint_as_float(rr[1]);
}
#define P4_ZERO(A) do { _Pragma("unroll") for (int m_ = 0; m_ < 4; ++m_) _Pragma("unroll") for (int n_ = 0; n_ < 4; ++n_) A[m_][n_] = (f32x4){0.f, 0.f, 0.f, 0.f}; } while (0)

__device__ __forceinline__ void unit(const Args& a, LAS unsigned char* lds, unsigned char* ws, int layer, int u, unsigned long long& ts_sum, unsigned long long& ts_t0, int wave_s, bool dry = false) {
    const int tid = tid_from(wave_s), wave = wave_s, lane = tid & 63, q = lane >> 4, r16 = lane & 15;
    const size_t row0 = (size_t)u * 64;
    const bf16_t* gz = (const bf16_t*)(ws + OFF_GZ);
    const unsigned lo5 = (unsigned)(r16 * SSM_W + 16 * q), lo10 = (unsigned)(r16 * D_MODEL + 16 * q); static_assert(GZ_W == D_MODEL, "lop == lo10");
#define lop lo10
    const bf16_t* projr = gz + row0 * GZ_W;
    const unsigned char* g8r = (const unsigned char*)(ws + OFF_G8) + row0 * G8_W; const unsigned lo8 = (unsigned)(r16 * G8_W + 16 * q);
    bf16_t* Y1 = (bf16_t*)(ws + OFF_YPRE) + row0 * SSM_W;
    bf16_t* YA = (bf16_t*)(ws + OFF_AO) + row0 * ATT_W;
    bf16_t* YS = (bf16_t*)(ws + OFF_AO) + ((size_t)MTOK + row0) * ATT_W;
    bf16_t* MG = (bf16_t*)(ws + OFF_MG) + row0 * D_MODEL;
    if (W_TOUCH && layer + 1 < DEPTH && u < 256) {
        const char* wn_ = (const char*)(ws + OFF_WIN) + (size_t)(layer + 1) * IN_COLS * D_MODEL * 2 + ((size_t)u * 512 + (size_t)wave * 64 + (size_t)(tid_from(wave_s) & 63)) * 128;
        __builtin_amdgcn_global_load_lds((const unsigned*)wn_, (LAS unsigned*)(lds + JUNK_OFF + wave * 256), 4, 0, 0);
    }
    { const Geo geo0 = make_geo(wave, lane); const G64 dGLU0{Y1, (const bf16_t*)(ws + OFF_WGLU) + (size_t)layer * SSM_W * SSM_W, 10, 10}; stage64(lds, geo0, dGLU0, u & 7, 0, 3); }
    TS_BEGIN(41);
    {
        const int cc = (tid & 63) * 8, rb = tid >> 6, j = cc >> 7;
        const bf16_t* ao = (const bf16_t*)(ws + OFF_AO); const float* ls = (const float*)(ws + OFF_ALSE);
#pragma unroll 1
        for (int kb = 0; kb < 8; kb += 4) {
            u32x4 a0[4], a1[4], a2[4], za[4]; float l0[4], l1[4], l2[4];
#pragma unroll
            for (int i = 0; i < 4; ++i) { const int row = rb + 8 * (kb + i); const size_t tok = row0 + row;
                l0[i] = ls[((size_t)0 * MTOK + tok) * 4 + j]; l1[i] = ls[((size_t)1 * MTOK + tok) * 4 + j]; l2[i] = ls[((size_t)2 * MTOK + tok) * 4 + j];
                a0[i] = __builtin_nontemporal_load((const u32x4*)(ao + ((size_t)0 * MTOK + tok) * ATT_W + cc)); a1[i] = __builtin_nontemporal_load((const u32x4*)(ao + ((size_t)1 * MTOK + tok) * ATT_W + cc)); a2[i] = __builtin_nontemporal_load((const u32x4*)(ao + ((size_t)2 * MTOK + tok) * ATT_W + cc));
                za[i] = __builtin_nontemporal_load((const u32x4*)(gz + tok * GZ_W + GZ_ZA + cc)); }
#pragma unroll
            for (int i = 0; i < 4; ++i) { const int row = rb + 8 * (kb + i);
                const float mx = fmaxf(l0[i], fmaxf(l1[i], l2[i])); float w0 = __builtin_amdgcn_exp2f(l0[i] - mx), w1 = __builtin_amdgcn_exp2f(l1[i] - mx), w2 = __builtin_amdgcn_exp2f(l2[i] - mx);
                const float iw = __builtin_amdgcn_rcpf(w0 + w1 + w2); w0 *= iw; w1 *= iw; w2 *= iw;
#define MRG(A0, A1, A2, Z) pk2((w0 * blo(A0) + w1 * blo(A1) + w2 * blo(A2)) * blo(Z), (w0 * bhi(A0) + w1 * bhi(A1) + w2 * bhi(A2)) * bhi(Z))
                u32x4 y; y.x = MRG(a0[i].x, a1[i].x, a2[i].x, za[i].x); y.y = MRG(a0[i].y, a1[i].y, a2[i].y, za[i].y); y.z = MRG(a0[i].z, a1[i].z, a2[i].z, za[i].z); y.w = MRG(a0[i].w, a1[i].w, a2[i].w, za[i].w);
#undef MRG
                *(u32x4*)(YA + (size_t)row * ATT_W + cc) = y; }
        }
    }
    VM_WAIT(); __syncthreads();
    TS_END(41); TS_BEGIN(42);
    const int nbw = wave * 64;
    const int r8 = u & 7, r16t = u & 15;
    const Geo geo = make_geo(wave, lane);
    const G64 dGLU{Y1, (const bf16_t*)(ws + OFF_WGLU) + (size_t)layer * SSM_W * SSM_W, 10, 10};
    const bf16_t* WBSl = (const bf16_t*)(ws + OFF_WBS) + (size_t)layer * D_MODEL * SSM_W; const bf16_t* WBAl = (const bf16_t*)(ws + OFF_WBA) + (size_t)layer * D_MODEL * ATT_W;
    const bf16_t* WOl = (const bf16_t*)(ws + OFF_WOUT) + (size_t)layer * D_MODEL * D_MODEL;
    const G64 dOUT0{MG, WOl, 11, 11}, dOUT1{MG, WOl + (size_t)512 * D_MODEL, 11, 11};
    {
        f32x4 acc[4][4]; P4_ZERO(acc);
        const G64 dBS0{YS, WBSl, 10, 10};
        const float* bg = inptr(a, IN_BGLU) + layer * SSM_W;
        f32x4 b4[4];
#pragma unroll
        for (int n = 0; n < 4; ++n) b4[n] = *(const f32x4*)(bg + (nbw + n * 4) + (unsigned)(((tid_from(wave_s) >> 4) & 3) * 16));
        run64<8>(acc, lds, geo, dGLU, dBS0, 2, r8, r8);
        {   u32x4 y1[4][2], zs[4][2];
#pragma unroll
            for (int m = 0; m < 4; ++m)
#pragma unroll
                for (int h = 0; h < 2; ++h) { y1[m][h] = *(const u32x4*)(Y1 + (m * 16 * SSM_W + nbw + h * 8) + lo5); zs[m][h] = __builtin_nontemporal_load((const u32x4*)(projr + (GZ_ZS + m * 16 * GZ_W + nbw + h * 8) + lop)); }
#pragma unroll
            for (int m = 0; m < 4; ++m) { u32x4 o[2];
#pragma unroll
                for (int n = 0; n < 4; ++n) { const unsigned yx = y1[m][n >> 1][(n & 1) * 2], yy = y1[m][n >> 1][(n & 1) * 2 + 1], zx = zs[m][n >> 1][(n & 1) * 2], zy = zs[m][n >> 1][(n & 1) * 2 + 1];
                    o[n >> 1][(n & 1) * 2] = pk2(blo(yx) * sig_fast(acc[m][n][0] + b4[n][0]) * blo(zx), bhi(yx) * sig_fast(acc[m][n][1] + b4[n][1]) * bhi(zx));
                    o[n >> 1][(n & 1) * 2 + 1] = pk2(blo(yy) * sig_fast(acc[m][n][2] + b4[n][2]) * blo(zy), bhi(yy) * sig_fast(acc[m][n][3] + b4[n][3]) * bhi(zy)); }
#pragma unroll
                for (int h = 0; h < 2; ++h) *(u32x4*)(YS + (m * 16 * SSM_W + nbw + h * 8) + lo5) = o[h]; }
        }
        VM_WAIT(); __syncthreads();
        stage64(lds, geo, dBS0, r8, 0, 1);
    }
    TS_END(42); TS_BEGIN(43);
#pragma unroll 1
    for (int ps = 0; ps < 2; ++ps) {
        f32x4 as[4][4], aa[4][4]; P4_ZERO(as); P4_ZERO(aa);
        const G64 dBS{YS, WBSl + (size_t)ps * 512 * SSM_W, 10, 10}, dBA{YA, WBAl + (size_t)ps * 512 * ATT_W, 10, 10};
        const G64 dBSn{YS, WBSl + (size_t)512 * SSM_W, 10, 10};
        run64<8>(as, lds, geo, dBS, dBA, 3, r8, r8);
        if (ps == 0) run64<8>(aa, lds, geo, dBA, dBSn, 3, r8, r8);
        else run64<8>(aa, lds, geo, dBA, dOUT0, 2, r8, r16t);
        {   u32x4 gs[4], ga[4];
#pragma unroll
            for (int m = 0; m < 4; ++m) { const int bo = m * 16 * G8_W + ps * 512 + nbw; gs[m] = __builtin_nontemporal_load((const u32x4*)(g8r + (G8_GS + bo) + lo8)); ga[m] = __builtin_nontemporal_load((const u32x4*)(g8r + (G8_GA + bo) + lo8)); }
#define P4_UB(w, e) ((float)(((w) >> (8 * (e))) & 0xffu) * (1.0f / 255.0f))
#pragma unroll
            for (int m = 0; m < 4; ++m) { u32x4 o[2];
#pragma unroll
                for (int n = 0; n < 4; ++n) { const unsigned gsw = gs[m][n], gaw = ga[m][n];
                    o[n >> 1][(n & 1) * 2] = pk2(P4_UB(gsw, 0) * as[m][n][0] + P4_UB(gaw, 0) * aa[m][n][0], P4_UB(gsw, 1) * as[m][n][1] + P4_UB(gaw, 1) * aa[m][n][1]);
                    o[n >> 1][(n & 1) * 2 + 1] = pk2(P4_UB(gsw, 2) * as[m][n][2] + P4_UB(gaw, 2) * aa[m][n][2], P4_UB(gsw, 3) * as[m][n][3] + P4_UB(gaw, 3) * aa[m][n][3]); }
#pragma unroll
                for (int h = 0; h < 2; ++h) *(u32x4*)(MG + (m * 16 * D_MODEL + ps * 512 + nbw + h * 8) + lo10) = o[h]; }
#undef P4_UB
        }
    }
    VM_WAIT(); __syncthreads();
    stage64(lds, geo, dOUT0, r16t, 0, 1);
    TS_END(43); TS_BEGIN(44);
    {
        f32x4 acc0[4][4], acc1[4][4]; P4_ZERO(acc0); P4_ZERO(acc1);
        run64<16>(acc0, lds, geo, dOUT0, dOUT1, 3, r16t, r16t);
        run64<16>(acc1, lds, geo, dOUT1, dOUT1, 0, r16t, 0);
        TS_END(44); TS_BEGIN(45);
        LAS float* RED = (LAS float*)(lds + RED_OFF); LAS float* RED2 = (LAS float*)(lds + RED2_OFF);
        float inv[4];
#pragma unroll
        for (int m = 0; m < 4; ++m) { float s = 0.f;
#pragma unroll
            for (int n = 0; n < 4; ++n) { s += (acc0[m][n][0] * acc0[m][n][0] + acc0[m][n][1] * acc0[m][n][1]) + (acc0[m][n][2] * acc0[m][n][2] + acc0[m][n][3] * acc0[m][n][3]);
                                          s += (acc1[m][n][0] * acc1[m][n][0] + acc1[m][n][1] * acc1[m][n][1]) + (acc1[m][n][2] * acc1[m][n][2] + acc1[m][n][3] * acc1[m][n][3]); }
            s = sum_q(s); if (q == 0) RED[(m * 16 + r16) * 8 + wave] = s; }
        __syncthreads();
#pragma unroll
        for (int m = 0; m < 4; ++m) { const LAS f32x4* rp = (const LAS f32x4*)(RED + (m * 16 + r16) * 8); const f32x4 r0 = rp[0], r1 = rp[1];
            inv[m] = rsqrtf(((r0[0] + r0[1]) + (r0[2] + r0[3]) + (r1[0] + r1[1]) + (r1[2] + r1[3])) * (1.0f / D_MODEL) + RMS_EPS); }
        const float* pg = inptr(a, IN_POSTG) + layer * D_MODEL; float* xor_ = a.p.out + row0 * D_MODEL; bf16_t* xbr = (bf16_t*)(ws + OFF_XB) + row0 * D_MODEL;
        float s2[4] = {0.f, 0.f, 0.f, 0.f};
        const unsigned lq4 = (unsigned)(((tid_from(wave_s) >> 4) & 3) * 16);
#define P4_RES(ACC, PS) do { f32x4 g4[4]; u32x4 xp[4][2]; \
            _Pragma("unroll") for (int n = 0; n < 4; ++n) g4[n] = *(const f32x4*)(pg + ((PS) * 512 + nbw + n * 4) + lq4); \
            _Pragma("unroll") for (int m = 0; m < 4; ++m) _Pragma("unroll") for (int h = 0; h < 2; ++h) xp[m][h] = *(const u32x4*)(xbr + (m * 16 * D_MODEL + (PS) * 512 + nbw + h * 8) + lo10); \
            __builtin_amdgcn_s_waitcnt(0);     \
            _Pragma("unroll") for (int m = 0; m < 4; ++m) { u32x4 o[2]; \
                _Pragma("unroll") for (int n = 0; n < 4; ++n) { const int bo = m * 16 * D_MODEL + (PS) * 512 + nbw + n * 4; const unsigned px = xp[m][n >> 1][(n & 1) * 2], py = xp[m][n >> 1][(n & 1) * 2 + 1]; \
                    f32x4 xv = {blo(px), bhi(px), blo(py), bhi(py)}; xv = xv + ACC[m][n] * inv[m] * g4[n]; \
                    o[n >> 1][(n & 1) * 2] = pk2(xv[0], xv[1]); o[n >> 1][(n & 1) * 2 + 1] = pk2(xv[2], xv[3]); \
                    if (!dry && layer == DEPTH - 1) *(f32x4*)(xor_ + bo + lo10) = xv; \
                    s2[m] += (xv[0] * xv[0] + xv[1] * xv[1]) + (xv[2] * xv[2] + xv[3] * xv[3]); } \
                if (!dry) { if (layer != DEPTH - 1) { _Pragma("unroll") for (int h = 0; h < 2; ++h) *(u32x4*)(xbr + (m * 16 * D_MODEL + (PS) * 512 + nbw + h * 8) + lo10) = o[h]; } } \
                else { asm volatile("" :: "v"(o[0].x), "v"(o[0].y), "v"(o[1].x), "v"(o[1].y)); } } } while (0)
        P4_RES(acc0, 0); P4_RES(acc1, 1);
#undef P4_RES
#pragma unroll
        for (int m = 0; m < 4; ++m) { const float s = sum_q(s2[m]); if (q == 0) RED2[(m * 16 + r16) * 8 + wave] = s; }
        __syncthreads();
        if (wave == 0 && !dry) { const int tl = tid_from(wave_s) & 63;
            const LAS f32x4* rp = (const LAS f32x4*)(RED2 + tl * 8); const f32x4 r0 = rp[0], r1 = rp[1];
            ((float*)(ws + OFF_ROWSS))[row0 + tl] = (r0[0] + r0[1]) + (r0[2] + r0[3]) + (r1[0] + r1[1]) + (r1[2] + r1[3]); }
    }
    VM_WAIT(); __syncthreads();
    TS_END(45);
}
#undef P4_ZERO
#undef lop
}

__device__ __forceinline__ void p0_transpose_item(const float* W, const float* rs, int K, int N, bf16_t* WT, LAS float* scr, int item, int lane, bool vperm, bool ntst) {
    const int nblk = N / 32, kb = item / nblk, nb = item % nblk, k0 = 64 * kb, n0 = 32 * nb;
    const int kr = lane >> 3, n4 = (lane & 7) * 4;
    f32x4 v[8];
#pragma unroll
    for (int i = 0; i < 8; ++i) v[i] = __builtin_nontemporal_load((const f32x4*)(W + (size_t)(k0 + 8 * i + kr) * N + n0 + n4));
    if (rs) {
#pragma unroll
        for (int i = 0; i < 8; ++i) v[i] = v[i] * rs[k0 + 8 * i + kr];
    }
#pragma unroll
    for (int i = 0; i < 8; ++i) { LAS float* d = scr + (8 * i + kr) * 33 + n4; d[0] = v[i][0]; d[1] = v[i][1]; d[2] = v[i][2]; d[3] = v[i][3]; }
    LDS_WAIT(); asm volatile("" ::: "memory");
    const int c = lane & 7;
#pragma unroll
    for (int j = 0; j < 4; ++j) { const int n = (lane >> 3) + 8 * j; const LAS float* s = scr + (8 * c) * 33 + n;
        u32x4 o; o.x = pk2(s[0 * 33], s[1 * 33]); o.y = pk2(s[2 * 33], s[3 * 33]); o.z = pk2(s[4 * 33], s[5 * 33]); o.w = pk2(s[6 * 33], s[7 * 33]);
        int nd = n0 + n;
        if (vperm && nd >= C_V && nd < C_ZA) { const int cc = nd & 127; nd = (nd & ~127) + (cc & 3) * 32 + (cc >> 2); }
        if (ntst) __builtin_nontemporal_store(o, (u32x4*)(WT + (size_t)nd * K + k0 + 8 * c)); else *(u32x4*)(WT + (size_t)nd * K + k0 + 8 * c) = o; }
    LDS_WAIT(); asm volatile("" ::: "memory");
}
__device__ __forceinline__ void p0_prologue(const Frame& F, const Args& a) {
    const int lane_ = tid_from(F.wave) & 63;
    LAS float* scr = (LAS float*)(F.lds + F.wave * 16384);
    const int gw = F.vcu * NWAVES + F.wave, NGW = F.G * NWAVES;
    constexpr int I_IN = (D_MODEL / 64) * (IN_COLS / 32), I_GLU = (SSM_W / 64) * (SSM_W / 32), I_BS = (SSM_W / 64) * (D_MODEL / 32), I_OUT = (D_MODEL / 64) * (D_MODEL / 32);
    constexpr int PER_L = I_IN + I_GLU + 2 * I_BS + I_OUT, NITEMS = DEPTH * PER_L;
    unsigned char* ws = a.p.ws;
    for (int lg = F.vcu; lg < DEPTH * SSM_NG; lg += F.G) s5::tables_wg(a, F.lds, lg, F.wave);
    constexpr int NTAB = DEPTH * SSM_NG, RA = 7;
    const bool bal = F.G > NTAB && RA * NGW < NITEMS;
    const int NA = bal ? RA * NGW : NITEMS, gw2 = gw - NTAB * NWAVES, NGW2 = (F.G - NTAB) * NWAVES;
    for (int k = 0; ; ++k) {
        const int it = (!bal || k < RA) ? gw + k * NGW : (gw2 >= 0 ? NA + gw2 + (k - RA) * NGW2 : NITEMS);
        if (it >= NITEMS || (bal && k < RA && it >= NA)) break;
        const int l = it / PER_L; int r = it - l * PER_L;
        int widx, K, N; size_t dst;
        if (r < I_IN) { widx = IN_WIN; K = D_MODEL; N = IN_COLS; dst = OFF_WIN; }
        else if ((r -= I_IN) < I_GLU) { widx = IN_WGLU; K = SSM_W; N = SSM_W; dst = OFF_WGLU; }
        else if ((r -= I_GLU) < I_BS) { widx = IN_WBS; K = SSM_W; N = D_MODEL; dst = OFF_WBS; }
        else if ((r -= I_BS) < I_BS) { widx = IN_WBA; K = ATT_W; N = D_MODEL; dst = OFF_WBA; }
        else { r -= I_BS; widx = IN_WOUT; K = D_MODEL; N = D_MODEL; dst = OFF_WOUT; }
        const float* W = inptr(a, widx) + (size_t)l * K * N;
        const float* rs = (widx == IN_WIN) ? inptr(a, IN_PREG) + l * D_MODEL : nullptr;
        p0_transpose_item(W, rs, K, N, (bf16_t*)(ws + dst) + (size_t)l * K * N, scr, r, lane_, ATTN_DMA == 3 && widx == IN_WIN, l > 0);
    }
    const float* X = inptr(a, IN_X);
    for (int m = gw; m < MTOK; m += 2 * NGW) {
        const int m1 = m + NGW; const bool has1 = m1 < MTOK;
        const f32x4* xr0 = (const f32x4*)(X + (size_t)m * D_MODEL) + lane_; const f32x4* xr1 = (const f32x4*)(X + (size_t)(has1 ? m1 : m) * D_MODEL) + lane_;
        f32x4 v0[4], v1[4];
#pragma unroll
        for (int j = 0; j < 4; ++j) { v0[j] = __builtin_nontemporal_load(xr0 + 64 * j); v1[j] = __builtin_nontemporal_load(xr1 + 64 * j); }
#pragma unroll
        for (int r = 0; r < 2; ++r) {
            if (r == 1 && !has1) break;
            const int mm = r ? m1 : m;
            unsigned long long* o8 = (unsigned long long*)((bf16_t*)(ws + OFF_XB) + (size_t)mm * D_MODEL) + lane_;
            float sq = 0.f;
#pragma unroll
            for (int j = 0; j < 4; ++j) { const f32x4 v = r ? v1[j] : v0[j]; sq += (v[0] * v[0] + v[1] * v[1]) + (v[2] * v[2] + v[3] * v[3]);
                o8[64 * j] = (unsigned long long)pk2(v[0], v[1]) | ((unsigned long long)pk2(v[2], v[3]) << 32); }
            sq = wave_sum(sq);
            if (lane_ == 0) ((float*)(ws + OFF_ROWSS))[mm] = sq;
        }
    }
}

constexpr int N_PHASES = 1 + 3 * DEPTH;
__global__ void __launch_bounds__(NTHREADS, 2) mega(Args a) {
    extern __shared__ __attribute__((aligned(16))) unsigned char lds_raw[];
    Frame F; F.lds = (LAS unsigned char*)lds_raw; F.wave = __builtin_amdgcn_readfirstlane((int)threadIdx.x >> 6);
    F.G = gridDim.x; { const int bx = blockIdx.x; F.vcu = (F.G % 8 == 0) ? (bx % 8) * (F.G / 8) + bx / 8 : bx; }
    volatile LAS unsigned* MISC = (volatile LAS unsigned*)(F.lds + MISC_OFF);
    { const int t0_ = tid_from(F.wave); if (t0_ < 64) MISC[t0_] = 0u; }
    __syncthreads();
    const bool grouped = (F.G % 8 == 0) && (a.ph_lo == 0) && (a.ph_hi == N_PHASES);
    unsigned* bw = (unsigned*)(a.p.ws + OFF_CTL) + CW_BAR + a.bar_region * XCD_BAR_WORDS;
    XcdBarrier gbar = xcd_barrier_post(bw, MISC + 8, F.wave, (unsigned)F.G);
    XcdBarrier lbar = gbar;
    if (grouped) lbar = xcd_barrier_post(bw + (1 + (blockIdx.x & 7)) * XCD_BAR_WORDS, MISC + 10, F.wave, (unsigned)F.G / 8u);
    unsigned long long ts_sum = 0, ts_t0 = 0;
    TS_BEGIN(100);
    for (int ph = a.ph_lo; ph < a.ph_hi; ++ph) {
        TS_BEGIN(9); if (ph > 0 && (ph - 1) % 3 == 0) TS_BEGIN(93); if (ph > 0 && (ph - 1) % 3 == 1) TS_BEGIN(91); if (ph > 0 && (ph - 1) % 3 == 2) TS_BEGIN(92);
        if (ph > a.ph_lo) {
            if (ph == 1 || !grouped) xcd_barrier(gbar);
            else if (BAR_TOUCH && F.vcu < 256) {
                const int l_ = (ph - 1) / 3, k_ = (ph - 1) % 3; size_t wq_ = 0; asm volatile("" : "+s"(wq_)); const char* wsb = (const char*)a.p.ws + wq_;
                BarTouch bt; for (int r = 0; r < 6; ++r) { bt.p[r] = wsb; bt.n[r] = 0; }
                if (k_ == 1) {
                    const size_t lg_ = (size_t)l_ * 32 + (F.vcu & 31);
                    bt.p[0] = wsb + OFF_S5 + s5::T_WST + lg_ * 128 * 256 * 2; bt.n[0] = 512; bt.p[1] = wsb + OFF_S5 + s5::T_WO + lg_ * 256 * 128 * 2; bt.n[1] = 512;
                    bt.p[2] = wsb + OFF_S5 + s5::T_KT + lg_ * 17 * 256 * 2; bt.n[2] = 68;
                } else if (k_ == 2) {
                    bt.p[0] = wsb + OFF_WOUT + (size_t)l_ * D_MODEL * D_MODEL * 2 + (size_t)F.vcu * 64 * 128; bt.n[0] = 64;
                    bt.p[1] = wsb + OFF_WBS + (size_t)l_ * D_MODEL * SSM_W * 2 + (size_t)F.vcu * 32 * 128; bt.n[1] = 32;
                    bt.p[2] = wsb + OFF_WBA + (size_t)l_ * D_MODEL * ATT_W * 2 + (size_t)F.vcu * 32 * 128; bt.n[2] = 32;
                    bt.p[3] = wsb + OFF_WGLU + (size_t)l_ * SSM_W * SSM_W * 2 + (size_t)F.vcu * 16 * 128; bt.n[3] = 16;
                    if (l_ + 1 < DEPTH) { bt.p[4] = wsb + OFF_WIN + (size_t)(l_ + 1) * IN_COLS * D_MODEL * 2 + (size_t)F.vcu * 512 * 128; bt.n[4] = 512; }
                }
                xcd_barrier(lbar, &bt, F.lds);
            }
            else xcd_barrier(lbar);
        }
        if (GRP_DELAY_NS != 0 && grouped && ph == 1) {
            const unsigned long long ticks_ = (unsigned long long)((blockIdx.x & 7) % GRP_DELAY_MOD) * (GRP_DELAY_NS / 10), t0_ = __builtin_amdgcn_s_memrealtime();
            while (__builtin_amdgcn_s_memrealtime() - t0_ < ticks_) __builtin_amdgcn_s_sleep(8);
        }
        TS_END(9); if (ph > 0 && (ph - 1) % 3 == 0) TS_END(93); if (ph > 0 && (ph - 1) % 3 == 1) TS_END(91); if (ph > 0 && (ph - 1) % 3 == 2) TS_END(92);
#if PROBE_DUP == 6
        if (ph > a.ph_lo) { if (ph == 1 || !grouped) xcd_barrier(gbar); else xcd_barrier(lbar); }
#endif
        size_t wz_ = 0; asm volatile("" : "+s"(wz_)); unsigned char* ws = a.p.ws + wz_;
        int vcu_ = F.vcu; asm volatile("" : "+s"(vcu_));
        Frame Fp; Fp.lds = F.lds; Fp.wave = F.wave; Fp.G = F.G; Fp.vcu = vcu_;
#if PROBE_DUP == 5
        if (ph == 0) {
#pragma unroll 1
            for (int rep = 0; rep < 2; ++rep) { p0_prologue(Fp, a); __syncthreads(); }
            continue; }
#endif
        if (ph == 0) { TS_BEGIN(10); p0_prologue(Fp, a); TS_END(10); continue; }
        const int l = (ph - 1) / 3, k = (ph - 1) % 3;
        if (k == 0) {
            TS_BEGIN(1); if (l == 0) TS_BEGIN(18); if (l == 3) TS_BEGIN(19);
            pg8::Gemm g{(const bf16_t*)(ws + OFF_XB), (const bf16_t*)(ws + OFF_WIN) + (size_t)l * IN_COLS * D_MODEL, MTOK, IN_COLS, D_MODEL};
            int bid_ = blockIdx.x; asm volatile("" : "+s"(bid_));
            pg8::StaticOrder S; S.init(MTOK, IN_COLS, Fp.G, bid_);
            pg8::EpiInProj E{ws, (const float*)(ws + OFF_ROWSS)};
#if PROBE_DUP == 1
#pragma unroll 1
            for (int rep = 0; rep < 2; ++rep)
#endif
            pg8::gemm_phase<pg8::EpiInProj, pg8::StaticOrder, true, true>(Fp.lds, g, S, E, Fp.wave, ts_sum, ts_t0);
            TS_END(1); if (l == 0) TS_END(18); if (l == 3) TS_END(19);
        }
#if EXP_HALF
        else if (EXP_HALF == 1 && (blockIdx.x & 7) >= 4) { }
#endif
        else if (k == 1) {
            TS_BEGIN(2);
#if PROBE_DUP == 2
#pragma unroll 1
            for (int rep = 0; rep < 2; ++rep)
#endif
            for (int u = Fp.vcu; u < BATCH * SSM_NG; u += Fp.G) s5::unit(Fp.lds, ws, l, u >> 5, u & 31, Fp.wave, inptr(a, IN_DSKIP) + l * SSM_W);
            TS_END(2); TS_BEGIN(3);
#if PROBE_DUP == 3
#pragma unroll 1
            for (int rep = 0; rep < 2; ++rep)
#endif
#if ATTN_WAVE
            wsa::phase(Fp, ws);
            __syncthreads();
#else
            attn_phase(Fp, ws, l, ts_sum, ts_t0);
#endif
            TS_END(3);
        }
        else {
            TS_BEGIN(4);
#if PROBE_DUP == 4
#pragma unroll 1
            for (int rep = 0; rep < 2; ++rep)
            for (int u = Fp.vcu; u < MTOK / 64; u += Fp.G) p4::unit(a, Fp.lds, ws, l, u, ts_sum, ts_t0, Fp.wave, rep == 0);
#else
#if EXP_HALF == 2
            if (!(Fp.vcu & 1)) for (int u = Fp.vcu; u < MTOK / 64; u += Fp.G) { for (int e = 0; e < 2; ++e) p4::unit(a, Fp.lds, ws, l, u + e, ts_sum, ts_t0, Fp.wave); }
#else
            for (int u = Fp.vcu; u < MTOK / 64; u += Fp.G) p4::unit(a, Fp.lds, ws, l, u, ts_sum, ts_t0, Fp.wave);
#endif
#endif
            TS_END(4);
        }
    }
    TS_END(100);
    if (TS_ID != 0 && blockIdx.x == 0 && tid_from(F.wave) == 0) { asm volatile("s_waitcnt vmcnt(0)" ::: "memory"); a.p.out[0] += (float)ts_sum * 0.001f; }
}

#ifndef ONE_LAUNCH
#define ONE_LAUNCH 1
#endif
#ifndef OPT_P0
#define OPT_P0 1
#endif
#ifndef OPT_P1
#define OPT_P1 1
#endif
#ifndef OPT_P2
#define OPT_P2 1
#endif
#ifndef OPT_P4
#define OPT_P4 1
#endif
extern "C" void kernel_launch(void* const* d_in, const int* in_sizes, int n_in, void* d_out, int out_size, void* d_ws, size_t ws_size, hipStream_t stream) {
    static int grid = 0;
    if (grid == 0) {
        if (n_in != 17 || out_size != MTOK * D_MODEL || ws_size < WS_END) { fprintf(stderr, "kernel_launch: unexpected shapes/workspace (n_in %d out %d ws %zu)\n", n_in, out_size, ws_size); grid = -1; return; }
        int dev = 0, cus = 0, per_cu = 0;
        if (hipGetDevice(&dev) != hipSuccess || hipDeviceGetAttribute(&cus, hipDeviceAttributeMultiprocessorCount, dev) != hipSuccess) { grid = -1; return; }
        if (hipFuncSetAttribute((const void*)mega, hipFuncAttributeMaxDynamicSharedMemorySize, LDS_BYTES) != hipSuccess) { fprintf(stderr, "kernel_launch: hipFuncSetAttribute failed\n"); grid = -1; return; }
        if (hipOccupancyMaxActiveBlocksPerMultiprocessor(&per_cu, (const void*)mega, NTHREADS, LDS_BYTES) != hipSuccess || per_cu < 1) { fprintf(stderr, "kernel_launch: occupancy query says %d blocks/CU\n", per_cu); per_cu = 1; }
        (void)hipGetLastError();
        grid = cus * (per_cu < 1 ? 1 : 1);
    }
    if (grid < 0) return;
    Params p{};
    for (int i = 0; i < N_IN; ++i) p.in[i] = (const float*)d_in[i];
    p.out = (float*)d_out; p.ws = (unsigned char*)d_ws;
    unsigned char* ws = p.ws;
#if ONE_LAUNCH
    (void)hipMemsetAsync(ws + OFF_CTL + (size_t)CW_BAR * 4, 0, (size_t)9 * XCD_BAR_WORDS * 4, stream);
#else
    (void)hipMemsetAsync(ws + OFF_CTL, 0, CTL_ZERO_BYTES, stream);
#endif
#if EXP_MEMSET2
    (void)hipMemsetAsync(ws + OFF_T2, 0, CTL_ZERO_BYTES, stream);
#endif
    int bar_region = 0;
    auto launch_mega = [&](int lo, int hi) { Args a{}; a.p = p; a.ph_lo = lo; a.ph_hi = hi; a.bar_region = bar_region++; a.pad = 0;
        hipLaunchKernelGGL(mega, dim3(grid), dim3(NTHREADS), LDS_BYTES, stream, a); };
    bf16_t* WIN = (bf16_t*)(ws + OFF_WIN); bf16_t* WGLU = (bf16_t*)(ws + OFF_WGLU); bf16_t* WBS = (bf16_t*)(ws + OFF_WBS); bf16_t* WBA = (bf16_t*)(ws + OFF_WBA); bf16_t* WOUT = (bf16_t*)(ws + OFF_WOUT);
    bf16_t* XB = (bf16_t*)(ws + OFF_XB); bf16_t* PROJ = (bf16_t*)(ws + OFF_PROJ); bf16_t* YPRE = (bf16_t*)(ws + OFF_YPRE); bf16_t* AO = (bf16_t*)(ws + OFF_AO);
    bf16_t* T2 = (bf16_t*)(ws + OFF_T2); bf16_t* T4 = (bf16_t*)(ws + OFF_T4); bf16_t* T5 = AO + (size_t)MTOK * ATT_W; float* OUTF = (float*)(ws + OFF_PROJ);
    const float* ROWSS = (const float*)(ws + OFF_ROWSS);
#if ONE_LAUNCH
    launch_mega(0, N_PHASES);
    return;
#endif
#if OPT_P0
    launch_mega(0, 1);
#else
    const dim3 tb(32, 8);
    for (int l = 0; l < DEPTH; ++l) {
        nv::k_transpose<<<dim3(IN_COLS / 32, D_MODEL / 32), tb, 0, stream>>>(p.in[IN_WIN] + (size_t)l * D_MODEL * IN_COLS, p.in[IN_PREG] + l * D_MODEL, WIN + (size_t)l * IN_COLS * D_MODEL, D_MODEL, IN_COLS);
        nv::k_transpose<<<dim3(SSM_W / 32, SSM_W / 32), tb, 0, stream>>>(p.in[IN_WGLU] + (size_t)l * SSM_W * SSM_W, nullptr, WGLU + (size_t)l * SSM_W * SSM_W, SSM_W, SSM_W);
        nv::k_transpose<<<dim3(D_MODEL / 32, SSM_W / 32), tb, 0, stream>>>(p.in[IN_WBS] + (size_t)l * SSM_W * D_MODEL, nullptr, WBS + (size_t)l * D_MODEL * SSM_W, SSM_W, D_MODEL);
        nv::k_transpose<<<dim3(D_MODEL / 32, ATT_W / 32), tb, 0, stream>>>(p.in[IN_WBA] + (size_t)l * ATT_W * D_MODEL, nullptr, WBA + (size_t)l * D_MODEL * ATT_W, ATT_W, D_MODEL);
        nv::k_transpose<<<dim3(D_MODEL / 32, D_MODEL / 32), tb, 0, stream>>>(p.in[IN_WOUT] + (size_t)l * D_MODEL * D_MODEL, nullptr, WOUT + (size_t)l * D_MODEL * D_MODEL, D_MODEL, D_MODEL);
    }
    nv::k_s5_tables<<<DEPTH * SSM_NG, 64, 0, stream>>>(p);
    nv::k_rows_x<<<MTOK, 256, 0, stream>>>(p);
#endif
    for (int l = 0; l < DEPTH; ++l) {
#if OPT_P1
        launch_mega(1 + 3 * l, 2 + 3 * l);
#else
        nv::k_gemm<nv::EpiInProj><<<dim3(IN_COLS / 128, MTOK / 128), 256, 0, stream>>>(XB, D_MODEL, WIN + (size_t)l * IN_COLS * D_MODEL, D_MODEL, D_MODEL, nv::EpiInProj{ROWSS, PROJ});
#endif
#if OPT_P2
        launch_mega(2 + 3 * l, 3 + 3 * l);
#else
        nv::k_attn<<<MTOK * 12 / 4, 256, 0, stream>>>(p);
        nv::k_s5<<<BATCH * SSM_NG, 64, 0, stream>>>(p, l);
#endif
#if OPT_P4
        launch_mega(3 + 3 * l, 4 + 3 * l);
#else
        nv::k_p4a<<<MTOK * SSM_W / 256, 256, 0, stream>>>(p, l);
        nv::k_gemm<nv::EpiGlu><<<dim3(SSM_W / 128, MTOK / 128), 256, 0, stream>>>(YPRE, SSM_W, WGLU + (size_t)l * SSM_W * SSM_W, SSM_W, SSM_W, nv::EpiGlu{YPRE, PROJ, p.in[IN_BGLU] + l * SSM_W, T2});
        nv::k_merge<<<MTOK * ATT_W / 256, 256, 0, stream>>>(p);
        nv::k_gemm<nv::EpiGate1><<<dim3(D_MODEL / 128, MTOK / 128), 256, 0, stream>>>(T2, SSM_W, WBS + (size_t)l * D_MODEL * SSM_W, SSM_W, SSM_W, nv::EpiGate1{PROJ, T4});
        nv::k_gemm<nv::EpiGate2><<<dim3(D_MODEL / 128, MTOK / 128), 256, 0, stream>>>(AO, ATT_W, WBA + (size_t)l * D_MODEL * ATT_W, ATT_W, ATT_W, nv::EpiGate2{PROJ, T4, T5});
        nv::k_gemm<nv::EpiF32><<<dim3(D_MODEL / 128, MTOK / 128), 256, 0, stream>>>(T5, D_MODEL, WOUT + (size_t)l * D_MODEL * D_MODEL, D_MODEL, D_MODEL, nv::EpiF32{OUTF, D_MODEL});
        nv::k_postnorm<<<MTOK, 256, 0, stream>>>(p, l, OUTF);
#endif
    }
}
```

```cpp
#include <hip/hip_runtime.h>
#include <cstdio>
#include <cstdint>
#ifndef ATTN_DMA
#define ATTN_DMA 3
#endif
#ifndef ATTN_WAVE
#define ATTN_WAVE 0
#endif
#ifndef EXP_MEMSET2
#define EXP_MEMSET2 0
#endif
#ifndef EXP_HALF
#define EXP_HALF 0
#endif
#ifndef EXP_NOSTORE
#define EXP_NOSTORE 0
#endif
#ifndef TS_ID
#define TS_ID 0
#endif
#ifndef P1_NT
#define P1_NT 0
#endif
#ifndef P1_SHAPE
#define P1_SHAPE 1
#endif
#ifndef BAR_TOUCH_S5
#define BAR_TOUCH_S5 0
#endif
#ifndef BAR_TOUCH
#define BAR_TOUCH 1
#endif
#ifndef W_TOUCH
#define W_TOUCH (!BAR_TOUCH)
#endif
#ifndef W_TOUCH2
#define W_TOUCH2 (BAR_TOUCH ? 0 : 2)
#endif
#ifndef SEAM_RELAX
#define SEAM_RELAX 1
#endif
#ifndef GRP_DELAY_NS
#define GRP_DELAY_NS 0
#endif
#ifndef GRP_DELAY_MOD
#define GRP_DELAY_MOD 2
#endif
#define TS_BEGIN(id) do { if (TS_ID == (id)) ts_t0 = __builtin_amdgcn_s_memrealtime(); } while (0)
#define TS_END(id) do { if (TS_ID == (id)) ts_sum += __builtin_amdgcn_s_memrealtime() - ts_t0; } while (0)

constexpr int D_MODEL = 1024, BATCH = 8, SEQ = 2048, DEPTH = 4, MTOK = BATCH * SEQ;
constexpr int SSM_W = 512, SSM_CH = 16, SSM_NG = 32, SSM_P = 64;
constexpr int HD = 128, HPG = 4, NGRP = 3, ATT_W = 512, IN_COLS = 8192;
constexpr int C_US = 0, C_ZS = 512, C_Q = 1024, C_K = 2560, C_V = 4096, C_ZA = 5632, C_GS = 6144, C_GA = 7168;
constexpr int GZ_W = 1024, GZ_ZS = 0, GZ_ZA = 512, G8_W = 2048, G8_GS = 0, G8_GA = 1024;
constexpr float RMS_EPS = 1e-6f;
constexpr float ATT_C2 = 0.08838834764831845f * 1.4426950408889634f;

constexpr size_t MiB = 1u << 20;
constexpr size_t OFF_CTL = 0;
constexpr size_t OFF_WIN = 370 * MiB;
constexpr size_t OFF_WGLU = 434 * MiB;
constexpr size_t OFF_WBS = 436 * MiB;
constexpr size_t OFF_WBA = 440 * MiB;
constexpr size_t OFF_WOUT = 444 * MiB;
constexpr size_t OFF_S5 = 452 * MiB;
constexpr size_t OFF_XB = 473 * MiB;
constexpr size_t OFF_ROWSS = 505 * MiB;
constexpr size_t OFF_PROJ = 1 * MiB;
constexpr size_t OFF_GZ = OFF_PROJ, OFF_G8 = OFF_PROJ + 32 * MiB, OFF_QKV = OFF_PROJ + 96 * MiB;
constexpr size_t OFF_YPRE = 257 * MiB;
constexpr size_t OFF_AO = 273 * MiB;
constexpr size_t OFF_ALSE = 321 * MiB;
constexpr size_t OFF_T2 = 322 * MiB;
constexpr size_t OFF_UG = OFF_T2;
constexpr size_t OFF_T4 = 338 * MiB;
constexpr size_t WS_END = 506 * MiB;
constexpr size_t S5_A = 0;
constexpr size_t S5_BB = 1 * MiB;

typedef unsigned short bf16_t;
typedef short bf16x8 __attribute__((ext_vector_type(8)));
typedef float f32x4 __attribute__((ext_vector_type(4)));
typedef unsigned u32x4 __attribute__((ext_vector_type(4)));

__device__ __forceinline__ float bf2f(bf16_t h) { return __uint_as_float(((unsigned)h) << 16); }
__device__ __forceinline__ bf16_t f2bf(float f) { unsigned u = __float_as_uint(f); return (bf16_t)((u + 0x7fffu + ((u >> 16) & 1u)) >> 16); }
__device__ __forceinline__ float sigmoidf_(float v) { return 1.0f / (1.0f + __expf(-v)); }
__device__ __forceinline__ float siluf_(float v) { return v / (1.0f + __expf(-v)); }
__device__ __forceinline__ float gelu_tanh(float x) {
    const float z = 0.7978845608028654f * (x + 0.044715f * x * x * x);
    const float t = 1.0f - 2.0f / (1.0f + __expf(2.0f * z));
    return 0.5f * x * (1.0f + t);
}
__device__ __forceinline__ float wave_sum(float v) {
    v += __builtin_bit_cast(float, __builtin_amdgcn_ds_swizzle(__builtin_bit_cast(int, v), 0x041F));
    v += __builtin_bit_cast(float, __builtin_amdgcn_ds_swizzle(__builtin_bit_cast(int, v), 0x081F));
    v += __builtin_bit_cast(float, __builtin_amdgcn_ds_swizzle(__builtin_bit_cast(int, v), 0x101F));
    v += __builtin_bit_cast(float, __builtin_amdgcn_ds_swizzle(__builtin_bit_cast(int, v), 0x201F));
    v += __builtin_bit_cast(float, __builtin_amdgcn_ds_swizzle(__builtin_bit_cast(int, v), 0x401F));
    const auto rr = __builtin_amdgcn_permlane32_swap(__float_as_uint(v), __float_as_uint(v), false, false);
    return __uint_as_float(rr[0]) + __uint_as_float(rr[1]);
}
__device__ __forceinline__ float sig_fast(float v) { return __builtin_amdgcn_rcpf(1.0f + __builtin_amdgcn_exp2f(-1.4426950408889634f * v)); }
__device__ __forceinline__ float gelu_fast(float x) {
    const float z2 = 1.5957691216057308f * (x + 0.044715f * x * x * x);
    return x * sig_fast(z2);
}
__device__ __forceinline__ float blo(unsigned w) { return __uint_as_float(w << 16); }
__device__ __forceinline__ float bhi(unsigned w) { return __uint_as_float(w & 0xffff0000u); }
enum { IN_X = 0, IN_PREG, IN_WIN, IN_LRE, IN_LIM, IN_LDT, IN_BRE, IN_BIM, IN_CRE, IN_CIM, IN_DSKIP, IN_WGLU, IN_BGLU, IN_WBS, IN_WBA, IN_WOUT, IN_POSTG, N_IN };
struct Params { const float* in[N_IN]; float* out; unsigned char* ws; };
__device__ __forceinline__ int tid_from(int wave_s) { unsigned z = 0u; asm volatile("" : "+v"(z)); return (wave_s << 6) | (int)__builtin_amdgcn_mbcnt_hi(~0u, __builtin_amdgcn_mbcnt_lo(~0u, z)); }

namespace nv {
__global__ void k_transpose(const float* __restrict__ W, const float* __restrict__ rs, bf16_t* __restrict__ Wt, int K, int N) {
    __shared__ float tile[32][33];
    const int n0 = blockIdx.x * 32, k0 = blockIdx.y * 32, tx = threadIdx.x, ty = threadIdx.y;
    for (int i = ty; i < 32; i += 8) { const int k = k0 + i; tile[i][tx] = W[(size_t)k * N + n0 + tx] * (rs ? rs[k] : 1.0f); }
    __syncthreads();
    for (int i = ty; i < 32; i += 8) { const int n = n0 + i; Wt[(size_t)n * K + k0 + tx] = f2bf(tile[tx][i]); }
}
__global__ void k_s5_tables(Params p) {
    const int lg = blockIdx.x, pp = threadIdx.x, idx = lg * 64 + pp;
    const float lre = fminf(p.in[IN_LRE][idx], -1e-4f), lim = p.in[IN_LIM][idx], dt = expf(p.in[IN_LDT][lg]);
    const float a = lre * dt, b = lim * dt, ea = expf(a), sb = sinf(b), cb = cosf(b);
    const float Are = ea * cb, Aim = ea * sb, sh = sinf(0.5f * b);
    const float Dre = expm1f(a) * cb - 2.0f * sh * sh, Dim = Aim;
    const float den = lre * lre + lim * lim;
    const float cre = (Dre * lre + Dim * lim) / den, cim = (Dim * lre - Dre * lim) / den;
    float* A = (float*)(p.ws + OFF_S5 + S5_A); float* Bb = (float*)(p.ws + OFF_S5 + S5_BB);
    A[idx * 2] = Are; A[idx * 2 + 1] = Aim;
    for (int c = 0; c < 16; ++c) { const float br = p.in[IN_BRE][idx * 16 + c], bi = p.in[IN_BIM][idx * 16 + c];
        Bb[(idx * 16 + c) * 2] = cre * br - cim * bi; Bb[(idx * 16 + c) * 2 + 1] = cre * bi + cim * br; }
}
__global__ void k_rows_x(Params p) {
    const int row = blockIdx.x, t = threadIdx.x;
    const f32x4 v = ((const f32x4*)(p.in[IN_X] + (size_t)row * D_MODEL))[t];
    ((f32x4*)(p.out + (size_t)row * D_MODEL))[t] = v;
    bf16_t* xb = (bf16_t*)(p.ws + OFF_XB) + (size_t)row * D_MODEL + t * 4;
    xb[0] = f2bf(v[0]); xb[1] = f2bf(v[1]); xb[2] = f2bf(v[2]); xb[3] = f2bf(v[3]);
    float ss = wave_sum(v[0] * v[0] + v[1] * v[1] + v[2] * v[2] + v[3] * v[3]);
    __shared__ float s[4];
    if ((t & 63) == 0) s[t >> 6] = ss;
    __syncthreads();
    if (t == 0) ((float*)(p.ws + OFF_ROWSS))[row] = s[0] + s[1] + s[2] + s[3];
}
template <class Epi> __global__ __launch_bounds__(256) void k_gemm(const bf16_t* __restrict__ A, int lda, const bf16_t* __restrict__ Bt, int ldb, int K, Epi epi) {
    const int tid = threadIdx.x, wave = tid >> 6, lane = tid & 63, wr = wave >> 1, wc = wave & 1;
    const int row0 = blockIdx.y * 128 + wr * 64, col0 = blockIdx.x * 128 + wc * 64;
    f32x4 acc[4][4];
    for (int i = 0; i < 4; ++i) for (int j = 0; j < 4; ++j) acc[i][j] = (f32x4){0.f, 0.f, 0.f, 0.f};
    const bf16_t* ap = A + (size_t)(row0 + (lane & 15)) * lda + 8 * (lane >> 4);
    const bf16_t* bp = Bt + (size_t)(col0 + (lane & 15)) * ldb + 8 * (lane >> 4);
    for (int k0 = 0; k0 < K; k0 += 32) {
        bf16x8 a[4], b[4];
#pragma unroll
        for (int i = 0; i < 4; ++i) { a[i] = *(const bf16x8*)(ap + (size_t)i * 16 * lda + k0); b[i] = *(const bf16x8*)(bp + (size_t)i * 16 * ldb + k0); }
#pragma unroll
        for (int i = 0; i < 4; ++i)
#pragma unroll
            for (int j = 0; j < 4; ++j) acc[i][j] = __builtin_amdgcn_mfma_f32_16x16x32_bf16(a[i], b[j], acc[i][j], 0, 0, 0);
    }
#pragma unroll
    for (int i = 0; i < 4; ++i)
#pragma unroll
        for (int j = 0; j < 4; ++j)
#pragma unroll
            for (int r = 0; r < 4; ++r) epi(row0 + i * 16 + (lane >> 4) * 4 + r, col0 + j * 16 + (lane & 15), acc[i][j][r]);
}
struct EpiInProj { const float* rowss; bf16_t* proj;
    __device__ void operator()(int row, int col, float acc) const {
        float v = acc * rsqrtf(rowss[row] * (1.0f / D_MODEL) + RMS_EPS);
        if ((col >= C_ZS && col < C_Q) || (col >= C_ZA && col < C_GS)) v = siluf_(v);
        else if (col >= C_GS) v = sigmoidf_(v);
        proj[(size_t)row * IN_COLS + col] = f2bf(v);
    } };
struct EpiGlu { const bf16_t* y1; const bf16_t* proj; const float* b_glu; bf16_t* ys;
    __device__ void operator()(int row, int col, float acc) const {
        const float gate = sigmoidf_(acc + b_glu[col]);
        ys[(size_t)row * SSM_W + col] = f2bf(bf2f(y1[(size_t)row * SSM_W + col]) * gate * bf2f(proj[(size_t)row * IN_COLS + C_ZS + col]));
    } };
struct EpiGate1 { const bf16_t* proj; bf16_t* m1;
    __device__ void operator()(int row, int col, float acc) const { m1[(size_t)row * D_MODEL + col] = f2bf(bf2f(proj[(size_t)row * IN_COLS + C_GS + col]) * acc); } };
struct EpiGate2 { const bf16_t* proj; const bf16_t* m1; bf16_t* mg;
    __device__ void operator()(int row, int col, float acc) const {
        mg[(size_t)row * D_MODEL + col] = f2bf(bf2f(m1[(size_t)row * D_MODEL + col]) + bf2f(proj[(size_t)row * IN_COLS + C_GA + col]) * acc); } };
struct EpiF32 { float* C; int ldc;
    __device__ void operator()(int row, int col, float acc) const { C[(size_t)row * ldc + col] = acc; } };

__global__ __launch_bounds__(256) void k_attn(Params p) {
    const int wave = threadIdx.x >> 6, lane = threadIdx.x & 63;
    const long wid = (long)blockIdx.x * 4 + wave;
    const int j = (int)(wid & 3), gi = (int)((wid >> 2) % 3), tok = (int)(wid / 12);
    const int d = gi == 0 ? 1 : (gi == 1 ? 4 : 16);
    const int t = tok % SEQ, i = t / d;
    const bf16_t* proj = (const bf16_t*)(p.ws + OFF_PROJ);
    const int hc = (gi * 4 + j) * HD + 2 * lane;
    const unsigned qq = *(const unsigned*)(proj + (size_t)tok * IN_COLS + C_Q + hc);
    const float q0 = bf2f((bf16_t)(qq & 0xffff)), q1 = bf2f((bf16_t)(qq >> 16));
    float m = -1e30f, l = 0.f, o0 = 0.f, o1 = 0.f;
    const int nk = i < 128 ? i : 128;
    for (int jj = nk; jj >= 0; --jj) {
        const size_t kt = (size_t)(tok - jj * d);
        const unsigned kk = *(const unsigned*)(proj + kt * IN_COLS + C_K + hc);
        const unsigned vv = *(const unsigned*)(proj + kt * IN_COLS + C_V + hc);
        float s = q0 * bf2f((bf16_t)(kk & 0xffff)) + q1 * bf2f((bf16_t)(kk >> 16));
        s = wave_sum(s) * ATT_C2;
        const float mn = fmaxf(m, s), al = exp2f(m - mn), pr = exp2f(s - mn);
        l = l * al + pr; o0 = o0 * al + pr * bf2f((bf16_t)(vv & 0xffff)); o1 = o1 * al + pr * bf2f((bf16_t)(vv >> 16)); m = mn;
    }
    const float il = 1.0f / l;
    bf16_t* ao = (bf16_t*)(p.ws + OFF_AO) + ((size_t)gi * MTOK + tok) * ATT_W + j * HD + 2 * lane;
    *(unsigned*)ao = (unsigned)f2bf(o0 * il) | ((unsigned)f2bf(o1 * il) << 16);
    if (lane == 0) ((float*)(p.ws + OFF_ALSE))[((size_t)gi * MTOK + tok) * 4 + j] = m + log2f(l);
}
__global__ __launch_bounds__(64) void k_s5(Params p, int layer) {
    const int b = blockIdx.x >> 5, g = blockIdx.x & 31, lane = threadIdx.x;
    const int idx = ((layer * 32 + g) * 64 + lane);
    const float* A = (const float*)(p.ws + OFF_S5 + S5_A); const float* Bb = (const float*)(p.ws + OFF_S5 + S5_BB);
    const float Are = A[idx * 2], Aim = A[idx * 2 + 1];
    float bre[16], bim[16], cre[16], cim[16];
#pragma unroll
    for (int c = 0; c < 16; ++c) { bre[c] = Bb[(idx * 16 + c) * 2]; bim[c] = Bb[(idx * 16 + c) * 2 + 1];
        cre[c] = p.in[IN_CRE][(size_t)((layer * 32 + g) * 16 + c) * 64 + lane]; cim[c] = p.in[IN_CIM][(size_t)((layer * 32 + g) * 16 + c) * 64 + lane]; }
    const bf16_t* proj = (const bf16_t*)(p.ws + OFF_PROJ); bf16_t* ypre = (bf16_t*)(p.ws + OFF_YPRE);
    float sre = 0.f, sim = 0.f;
    for (int t = 0; t < SEQ; ++t) {
        const size_t tok = (size_t)b * SEQ + t;
        const bf16x8 u0 = *(const bf16x8*)(proj + tok * IN_COLS + C_US + g * 16), u1 = *(const bf16x8*)(proj + tok * IN_COLS + C_US + g * 16 + 8);
        float dre = 0.f, dim = 0.f;
#pragma unroll
        for (int c = 0; c < 8; ++c) { const float ua = bf2f((bf16_t)u0[c]), ub = bf2f((bf16_t)u1[c]);
            dre += bre[c] * ua + bre[c + 8] * ub; dim += bim[c] * ua + bim[c + 8] * ub; }
        const float nre = Are * sre - Aim * sim + dre, nim = Are * sim + Aim * sre + dim;
        sre = nre; sim = nim;
        float mine = 0.f;
#pragma unroll
        for (int c = 0; c < 16; ++c) { const float y = wave_sum(cre[c] * sre - cim[c] * sim); if (lane == c) mine = y; }
        if (lane < 16) ypre[tok * SSM_W + g * 16 + lane] = f2bf(mine);
    }
}
__global__ void k_p4a(Params p, int layer) {
    const size_t e = (size_t)blockIdx.x * 256 + threadIdx.x; const size_t row = e >> 9; const int col = (int)(e & 511);
    bf16_t* ypre = (bf16_t*)(p.ws + OFF_YPRE); const bf16_t* proj = (const bf16_t*)(p.ws + OFF_PROJ);
    const float y0 = bf2f(ypre[e]) + p.in[IN_DSKIP][layer * SSM_W + col] * bf2f(proj[row * IN_COLS + C_US + col]);
    ypre[e] = f2bf(gelu_tanh(y0));
}
__global__ void k_merge(Params p) {
    const size_t e = (size_t)blockIdx.x * 256 + threadIdx.x; const size_t row = e >> 9; const int col = (int)(e & 511), j = col >> 7;
    bf16_t* ao = (bf16_t*)(p.ws + OFF_AO); const float* ls = (const float*)(p.ws + OFF_ALSE); const bf16_t* proj = (const bf16_t*)(p.ws + OFF_PROJ);
    const float l0 = ls[((size_t)0 * MTOK + row) * 4 + j], l1 = ls[((size_t)1 * MTOK + row) * 4 + j], l2 = ls[((size_t)2 * MTOK + row) * 4 + j];
    const float mx = fmaxf(l0, fmaxf(l1, l2)), w0 = exp2f(l0 - mx), w1 = exp2f(l1 - mx), w2 = exp2f(l2 - mx);
    const float y = (w0 * bf2f(ao[e]) + w1 * bf2f(ao[(size_t)MTOK * ATT_W + e]) + w2 * bf2f(ao[(size_t)2 * MTOK * ATT_W + e])) / (w0 + w1 + w2);
    ao[e] = f2bf(y * bf2f(proj[row * IN_COLS + C_ZA + col]));
}
__global__ void k_postnorm(Params p, int layer, const float* o) {
    const int row = blockIdx.x, t = threadIdx.x;
    const f32x4 v = ((const f32x4*)(o + (size_t)row * D_MODEL))[t];
    __shared__ float s[4], s2[4];
    float ss = wave_sum(v[0] * v[0] + v[1] * v[1] + v[2] * v[2] + v[3] * v[3]);
    if ((t & 63) == 0) s[t >> 6] = ss;
    __syncthreads();
    const float inv = rsqrtf((s[0] + s[1] + s[2] + s[3]) * (1.0f / D_MODEL) + RMS_EPS);
    const f32x4 g = ((const f32x4*)(p.in[IN_POSTG] + layer * D_MODEL))[t];
    f32x4 xv = ((f32x4*)(p.out + (size_t)row * D_MODEL))[t];
    xv = xv + v * inv * g;
    ((f32x4*)(p.out + (size_t)row * D_MODEL))[t] = xv;
    bf16_t* xb = (bf16_t*)(p.ws + OFF_XB) + (size_t)row * D_MODEL + t * 4;
    xb[0] = f2bf(xv[0]); xb[1] = f2bf(xv[1]); xb[2] = f2bf(xv[2]); xb[3] = f2bf(xv[3]);
    float q = wave_sum(xv[0] * xv[0] + xv[1] * xv[1] + xv[2] * xv[2] + xv[3] * xv[3]);
    if ((t & 63) == 0) s2[t >> 6] = q;
    __syncthreads();
    if (t == 0) ((float*)(p.ws + OFF_ROWSS))[row] = s2[0] + s2[1] + s2[2] + s2[3];
}
}

namespace pg8 {
#define PG8_LAS __attribute__((address_space(3)))
typedef unsigned short bf16_t;
typedef short bf16x8 __attribute__((ext_vector_type(8)));
typedef float f32x4 __attribute__((ext_vector_type(4)));
typedef unsigned u32x4 __attribute__((ext_vector_type(4)));
constexpr int BM = 256, BK = 64, HALF = 128, HTB = HALF * BK * 2  , STAGE_BYTES = 8 * HTB, NXCD = 8, WGM = 8;

__host__ __device__ __forceinline__ int lds_byte(int r, int c) { const int st = (r >> 4) * 2 + (c >> 5), rr = r & 15, cc = c & 31, ob = rr * 64 + cc * 2; return st * 1024 + (ob ^ (((ob >> 9) & 1) << 5)); }
__host__ __device__ __forceinline__ void stage_rc(int b, int& R, int& C) { const int st = b / 1024, sb = b % 1024, swz = sb ^ (((sb >> 9) & 1) << 5); R = (st >> 1) * 16 + swz / 64; C = (st & 1) * 32 + (swz % 64) / 2; }
__host__ __device__ __forceinline__ int perm32(int rho) { const int n = rho >> 4, i = rho & 15; return 8 * (i >> 2) + 4 * n + (i & 3); }

struct Unit { int pm, pn; };
struct Gemm { const bf16_t* A; const bf16_t* Bt; int M, N, K; };

struct StaticOrder {
    int nM, nN, nwg, G, c;
    __host__ __device__ void init(int M, int N, int G_, int c_) { nM = M / BM; nN = N / BM; nwg = nM * nN; G = G_; c = c_; }
    __host__ __device__ bool next(int i, Unit& u) const {
        const long L = (long)i * G + c; if (L >= nwg) return false;
        int wgid = (int)L; { const int q = nwg / NXCD, r = nwg % NXCD, xcd = wgid % NXCD, off = wgid / NXCD; wgid = (xcd < r ? xcd * (q + 1) : r * (q + 1) + (xcd - r) * q) + off; }
        const int nig = WGM * nN, gid = wgid / nig, fm = gid * WGM, gsz = (nM - fm) < WGM ? (nM - fm) : WGM;
        u.pm = fm + ((wgid % nig) % gsz); u.pn = (wgid % nig) / gsz;
        if (P1_SHAPE && G == 256 && nM == 64 && nN == 32) {
            const int b = c % 8, j = c / 8;
            u.pm = b * 8 + 4 * (i >> 2) + (j & 3); u.pn = 8 * ((i + b) & 3) + (j >> 2);
        }
        return true;
    }
    __device__ __forceinline__ void a_ready(const Unit&) const {}
    __device__ __forceinline__ void done(const Unit&) const {}
};

__device__ __forceinline__ unsigned cvt_pk_bf16(float lo, float hi) { unsigned r; asm volatile("v_cvt_pk_bf16_f32 %0, %1, %2" : "=v"(r) : "v"(lo), "v"(hi)); return r; }
template <class Epi, class Sched, bool ALIGN_EPI = false, bool SP2 = false>
__device__ __forceinline__ void gemm_phase(PG8_LAS unsigned char* lds, const Gemm g, const Sched& S, const Epi& E, int wave_s, unsigned long long& ts_sum, unsigned long long& ts_t0) {
    const int tid = tid_from(wave_s), wid = wave_s, lane = tid & 63, wr = wid >> 2, wc = wid & 3, fr = lane & 15, fq = lane >> 4;
    const int K = g.K, nt = K / BK;
    unsigned voffA[2], voffB[2];
#pragma unroll
    for (int i = 0; i < 2; ++i) { int R, C; stage_rc(tid * 16 + i * 8192, R, C); const int Rb = Epi::PERM ? ((R & ~31) + perm32(R & 31)) : R;
        voffA[i] = (unsigned)(R * K + C) * 2u; voffB[i] = (unsigned)(Rb * K + C) * 2u; }
    const size_t kstep = (size_t)(BK * 2);
    const size_t hstep = (size_t)HALF * K * 2;
    const size_t tstep = 2 * hstep;
    const unsigned ldsw = (unsigned)wid * 1024u;
    const int aoff = lds_byte(wr * 64 + fr, fq * 8), boff = lds_byte(wc * 32 + fr, fq * 8);
#define PG8_SA(b, h) (((b) * 2 + (h)) * HTB)
#define PG8_SB(b, h) ((4 + (b) * 2 + (h)) * HTB)
#define PG8_STAGE(bufoff, gbase, voff) do { _Pragma("unroll") for (int _i = 0; _i < 2; ++_i) \
        __builtin_amdgcn_global_load_lds((const unsigned*)((const char*)(gbase) + (voff)[_i]), (PG8_LAS unsigned*)(lds + (bufoff) + ldsw + _i * 8192), 16, 0, 0); } while (0)
#define PG8_LDA(dst, b, h) do { _Pragma("unroll") for (int m = 0; m < 4; ++m) _Pragma("unroll") for (int k = 0; k < 2; ++k) dst[m][k] = *(const PG8_LAS bf16x8*)(lds + PG8_SA(b, h) + aoff + m * 2048 + k * 1024); } while (0)
#define PG8_LDB(dst, b, h) do { _Pragma("unroll") for (int n = 0; n < 2; ++n) _Pragma("unroll") for (int k = 0; k < 2; ++k) dst[n][k] = *(const PG8_LAS bf16x8*)(lds + PG8_SB(b, h) + boff + n * 2048 + k * 1024); } while (0)
#define PG8_MMA(ai, bj, At, Bt) do { __builtin_amdgcn_s_setprio(1); _Pragma("unroll") for (int m = 0; m < 4; ++m) _Pragma("unroll") for (int n = 0; n < 2; ++n) _Pragma("unroll") for (int k = 0; k < 2; ++k) \
        acc[ai][bj][m][n] = __builtin_amdgcn_mfma_f32_16x16x32_bf16(Bt[n][k], At[m][k], acc[ai][bj][m][n], 0, 0, 0); __builtin_amdgcn_s_setprio(0); } while (0)
#define PG8_WAIT_V(n) asm volatile("s_waitcnt vmcnt(" #n ")" ::: "memory")
#define PG8_WAIT_L(n) asm volatile("s_waitcnt lgkmcnt(" #n ")" ::: "memory")
#define PG8_BAR __builtin_amdgcn_s_barrier()
#define PG8_SCHED __builtin_amdgcn_sched_barrier(0)
    Unit cur, nxt; int ui = 0;
    if (!S.next(0, cur)) return;
    f32x4 acc[2][2][4][2];
#pragma unroll
    for (int a = 0; a < 2; ++a)
#pragma unroll
        for (int b = 0; b < 2; ++b)
#pragma unroll
            for (int m = 0; m < 4; ++m)
#pragma unroll
                for (int n = 0; n < 2; ++n) acc[a][b][m][n] = (f32x4){0.f, 0.f, 0.f, 0.f};
    bf16x8 At[4][2], B0[2][2], B1[2][2];
    const char* cA = (const char*)g.A + (size_t)cur.pm * tstep; const char* cB = (const char*)g.Bt + (size_t)cur.pn * tstep;
    S.a_ready(cur);
    if constexpr (SP2) {
        PG8_STAGE(PG8_SB(0, 0), cB, voffB); PG8_STAGE(PG8_SB(0, 1), cB + hstep, voffB); PG8_STAGE(PG8_SA(0, 0), cA, voffA); PG8_STAGE(PG8_SA(0, 1), cA + hstep, voffA);
        if (wr == 1) PG8_BAR;
        PG8_WAIT_V(2); PG8_BAR;
        PG8_STAGE(PG8_SB(1, 0), cB + kstep, voffB); PG8_STAGE(PG8_SA(1, 0), cA + kstep, voffA); PG8_STAGE(PG8_SB(1, 1), cB + hstep + kstep, voffB);
        PG8_WAIT_V(6); PG8_BAR;
    } else {
        PG8_STAGE(PG8_SB(0, 0), cB, voffB); PG8_STAGE(PG8_SA(0, 0), cA, voffA); PG8_STAGE(PG8_SB(0, 1), cB + hstep, voffB); PG8_STAGE(PG8_SA(0, 1), cA + hstep, voffA);
        if (wr == 1) PG8_BAR;
        PG8_WAIT_V(4); PG8_BAR;
        PG8_STAGE(PG8_SB(1, 0), cB + kstep, voffB); PG8_STAGE(PG8_SA(1, 0), cA + kstep, voffA); PG8_STAGE(PG8_SB(1, 1), cB + hstep + kstep, voffB);
        PG8_WAIT_V(6); PG8_BAR;
    }
    for (;;) {
        const bool has_next = S.next(ui + 1, nxt);
        const char* nA = has_next ? (const char*)g.A + (size_t)nxt.pm * tstep : cA; const char* nB = has_next ? (const char*)g.Bt + (size_t)nxt.pn * tstep : cB;
        if constexpr (Epi::ROWSUMS)
            __builtin_amdgcn_global_load_lds((const unsigned*)(E.rowss + cur.pm * BM + 32 * wid + (tid_from(wave_s) & 31)), (PG8_LAS unsigned*)(lds + STAGE_BYTES + (ui & 1) * 2048 + wid * 256), 4, 0, 0);
        for (int t = 0; t < nt; t += 2) {
            const bool last = (t == nt - 2);
            const char* a1 = cA + (size_t)(t + 1) * kstep;
            const char* a2 = last ? nA : cA + (size_t)(t + 2) * kstep; const char* b2 = last ? nB : cB + (size_t)(t + 2) * kstep;
            const char* a3 = a2 + kstep; const char* b3 = b2 + kstep;
            if (last && has_next) S.a_ready(nxt);
            if constexpr (SP2) {
            const unsigned seam = (unsigned)__builtin_amdgcn_readfirstlane((Epi::ROWSUMS && SEAM_RELAX && t == 0 && ui > 0) ? 1 : 0);
            PG8_LDB(B0, 0, 0); PG8_LDB(B1, 0, 1); PG8_SCHED; PG8_LDA(At, 0, 0); PG8_STAGE(PG8_SA(1, 1), a1 + hstep, voffA);
            asm volatile("s_waitcnt vmcnt(25)\n\ts_cmp_lg_u32 %0, 0\n\ts_cbranch_scc1 1\n\ts_waitcnt vmcnt(8)" :: "s"(seam) : "scc", "memory");
            PG8_WAIT_L(0); PG8_BAR; PG8_MMA(0, 0, At, B0); PG8_MMA(0, 1, At, B1); PG8_BAR; PG8_SCHED;
            PG8_LDA(At, 0, 1); PG8_STAGE(PG8_SB(0, 0), b2, voffB); PG8_STAGE(PG8_SB(0, 1), b2 + hstep, voffB); PG8_STAGE(PG8_SA(0, 0), a2, voffA);
            asm volatile("s_waitcnt vmcnt(25)\n\ts_cmp_lg_u32 %0, 0\n\ts_cbranch_scc1 1\n\ts_waitcnt vmcnt(8)" :: "s"(seam) : "scc", "memory");
            PG8_WAIT_L(0); PG8_BAR; PG8_MMA(1, 0, At, B0); PG8_MMA(1, 1, At, B1); PG8_BAR; PG8_SCHED;
            PG8_LDB(B0, 1, 0); PG8_LDB(B1, 1, 1); PG8_SCHED; PG8_LDA(At, 1, 0); PG8_STAGE(PG8_SA(0, 1), a2 + hstep, voffA);
            PG8_WAIT_V(8); PG8_WAIT_L(0); PG8_BAR; PG8_MMA(0, 0, At, B0); PG8_MMA(0, 1, At, B1); PG8_BAR; PG8_SCHED;
            PG8_LDA(At, 1, 1); PG8_STAGE(PG8_SB(1, 0), b3, voffB); PG8_STAGE(PG8_SB(1, 1), b3 + hstep, voffB); PG8_STAGE(PG8_SA(1, 0), a3, voffA);
            PG8_WAIT_V(8); PG8_WAIT_L(0); PG8_BAR; PG8_MMA(1, 0, At, B0); PG8_MMA(1, 1, At, B1); PG8_BAR; PG8_SCHED;
            } else {
            PG8_LDB(B0, 0, 0); PG8_SCHED; PG8_LDA(At, 0, 0); PG8_STAGE(PG8_SA(1, 1), a1 + hstep, voffA);
            PG8_WAIT_L(8); PG8_BAR; PG8_WAIT_L(0); PG8_MMA(0, 0, At, B0); PG8_BAR; PG8_SCHED;
            PG8_LDB(B1, 0, 1); PG8_STAGE(PG8_SB(0, 0), b2, voffB);
            PG8_BAR; PG8_WAIT_L(0); PG8_MMA(0, 1, At, B1); PG8_BAR;
            PG8_LDA(At, 0, 1); PG8_STAGE(PG8_SA(0, 0), a2, voffA);
            PG8_BAR; PG8_WAIT_L(0); PG8_MMA(1, 0, At, B0); PG8_BAR; PG8_SCHED;
            PG8_STAGE(PG8_SB(0, 1), b2 + hstep, voffB);
            PG8_WAIT_V(6); PG8_BAR; PG8_MMA(1, 1, At, B1); PG8_BAR;
            PG8_LDB(B0, 1, 0); PG8_SCHED; PG8_LDA(At, 1, 0); PG8_STAGE(PG8_SA(0, 1), a2 + hstep, voffA);
            PG8_WAIT_L(8); PG8_BAR; PG8_WAIT_L(0); PG8_MMA(0, 0, At, B0); PG8_BAR; PG8_SCHED;
            PG8_LDB(B1, 1, 1); PG8_STAGE(PG8_SB(1, 0), b3, voffB);
            PG8_BAR; PG8_WAIT_L(0); PG8_MMA(0, 1, At, B1); PG8_BAR;
            PG8_LDA(At, 1, 1); PG8_STAGE(PG8_SA(1, 0), a3, voffA);
            PG8_BAR; PG8_WAIT_L(0); PG8_MMA(1, 0, At, B0); PG8_BAR; PG8_SCHED;
            PG8_STAGE(PG8_SB(1, 1), b3 + hstep, voffB);
            PG8_WAIT_V(6); PG8_BAR; PG8_MMA(1, 1, At, B1); PG8_BAR;
            }
        }
        if constexpr (ALIGN_EPI) { if (wr == 0) PG8_BAR; }
        TS_BEGIN(11);
        if constexpr (!Epi::AFTER_DRAIN) { E(acc, cur, wr, wc, fr, fq, (const PG8_LAS float*)(lds + STAGE_BYTES + (ui & 1) * 2048)); S.done(cur); }
        TS_END(11);
        if (!has_next) break;
#pragma unroll
        for (int a = 0; a < 2; ++a)
#pragma unroll
            for (int b = 0; b < 2; ++b)
#pragma unroll
                for (int m = 0; m < 4; ++m)
#pragma unroll
                    for (int n = 0; n < 2; ++n) acc[a][b][m][n] = (f32x4){0.f, 0.f, 0.f, 0.f};
        cur = nxt; cA = nA; cB = nB; ++ui;
        if constexpr (ALIGN_EPI) { if (wr == 1) PG8_BAR; }
    }
    PG8_WAIT_V(0);
    if constexpr (!ALIGN_EPI) { if (wr == 0) PG8_BAR; }
    PG8_BAR;
    if constexpr (Epi::AFTER_DRAIN) { E.fused(acc, cur, wr, wc, fr, fq, lds, wid, lane); S.done(cur); }
#undef PG8_SA
#undef PG8_SB
#undef PG8_STAGE
#undef PG8_LDA
#undef PG8_LDB
#undef PG8_MMA
#undef PG8_WAIT_V
#undef PG8_WAIT_L
#undef PG8_BAR
#undef PG8_SCHED
}
}

namespace pg8 {
struct EpiInProj {
    static constexpr bool PERM = true, AFTER_DRAIN = false, ROWSUMS = true;
    unsigned char* ws; const float* rowss;
    __device__ __forceinline__ void operator()(const f32x4 (&acc)[2][2][4][2], const Unit& u, int wr, int wc, int fr, int fq, const PG8_LAS float* rs) const {
        const int row0 = u.pm * BM + wr * 64 + fr, colt = u.pn * BM, cl = wc * 32 + 8 * fq;
        const int mode = (colt >= C_GS) ? 2 : (((colt >= C_ZS && colt < C_Q) || (colt >= C_ZA && colt < C_GS)) ? 1 : 0);
        bf16_t* base; int kind = 0, sh = 0; size_t bjs;
        if (colt < C_ZS) { base = (bf16_t*)(ws + OFF_UG) + (size_t)(colt >> 4) * SEQ * 16; bjs = (size_t)8 * SEQ * 16; kind = 1; }
        else if (colt < C_Q) { base = (bf16_t*)(ws + OFF_GZ) + GZ_ZS + (colt - C_ZS); bjs = HALF; }
        else if (colt < C_ZA) { const int j = (colt - C_Q) >> 8, kd = j / 6, jj = j - 6 * kd, gi = jj >> 1; sh = 2 * gi; kind = 2;
            base = (bf16_t*)(ws + OFF_QKV) + ((size_t)((kd * 3 + gi) * BATCH) * HPG + 2 * (jj & 1)) * SEQ * HD; bjs = (size_t)SEQ * HD; }
        else if (colt < C_GS) { base = (bf16_t*)(ws + OFF_GZ) + GZ_ZA + (colt - C_ZA); bjs = HALF; }
        else { base = (bf16_t*)(ws + OFF_G8); bjs = HALF; kind = 3; }
        float inv[2][4];
#pragma unroll
        for (int ai = 0; ai < 2; ++ai)
#pragma unroll
            for (int m = 0; m < 4; ++m) { const int rl = wr * 64 + fr + ai * HALF + m * 16; inv[ai][m] = rsqrtf(rs[(rl >> 5) * 64 + (rl & 31)] * (1.0f / D_MODEL) + RMS_EPS); }
#pragma unroll
        for (int ai = 0; ai < 2; ++ai)
#pragma unroll
            for (int m = 0; m < 4; ++m) {
                const int row = row0 + ai * HALF + m * 16, b = row >> 11, t = row & (SEQ - 1);
                unsigned ro;
                if (kind == 3) { const unsigned go = (unsigned)row * G8_W + (unsigned)(colt - C_GS) + (unsigned)cl;
#pragma unroll
                    for (int bj = 0; bj < 2; ++bj) { const f32x4 v0 = acc[ai][bj][m][0] * inv[ai][m], v1 = acc[ai][bj][m][1] * inv[ai][m]; unsigned lo = 0u, hi = 0u;
#pragma unroll
                        for (int e = 0; e < 4; ++e) { const float s0 = __builtin_amdgcn_rcpf(1.0f + __builtin_amdgcn_exp2f(-1.4426950408889634f * v0[e])), s1 = __builtin_amdgcn_rcpf(1.0f + __builtin_amdgcn_exp2f(-1.4426950408889634f * v1[e]));
                            lo |= (unsigned)(s0 * 255.0f + 0.5f) << (8 * e); hi |= (unsigned)(s1 * 255.0f + 0.5f) << (8 * e); }
                        { typedef unsigned u32x2g __attribute__((ext_vector_type(2))); const u32x2g gw_ = {lo, hi};
                          asm volatile("global_store_dwordx2 %0, %1, %2" :: "v"(go + (unsigned)(bj * HALF)), "v"(gw_), "s"(base) : "memory"); } }
                    continue; }
                if (kind == 0) ro = ((unsigned)row * GZ_W + (unsigned)cl) * 2u;
                else if (kind == 1) ro = (((unsigned)(b * SSM_NG + (cl >> 4)) * SEQ + (unsigned)t) * 16u + (unsigned)(cl & 8)) * 2u;
                else { const int pos = ((t & ((1 << sh) - 1)) << (11 - sh)) + (t >> sh); ro = (((unsigned)b * HPG * SEQ + (unsigned)pos) * HD + (unsigned)cl) * 2u; }
#pragma unroll
                for (int bj = 0; bj < 2; ++bj) {
                    f32x4 v0 = acc[ai][bj][m][0] * inv[ai][m], v1 = acc[ai][bj][m][1] * inv[ai][m];
                    if (mode != 0) {
#pragma unroll
                        for (int e = 0; e < 4; ++e) {
                            const float s0 = __builtin_amdgcn_rcpf(1.0f + __builtin_amdgcn_exp2f(-1.4426950408889634f * v0[e]));
                            const float s1 = __builtin_amdgcn_rcpf(1.0f + __builtin_amdgcn_exp2f(-1.4426950408889634f * v1[e]));
                            v0[e] = (mode == 1) ? v0[e] * s0 : s0; v1[e] = (mode == 1) ? v1[e] * s1 : s1;
                        }
                    }
                    u32x4 w; w.x = cvt_pk_bf16(v0[0], v0[1]); w.y = cvt_pk_bf16(v0[2], v0[3]); w.z = cvt_pk_bf16(v1[0], v1[1]); w.w = cvt_pk_bf16(v1[2], v1[3]);
#if EXP_NOSTORE
                    asm volatile("" :: "v"(w.x), "v"(w.y), "v"(w.z), "v"(w.w));
#else
#if P1_NT
                    __builtin_nontemporal_store(w, (u32x4*)(rowp + bj * bjs));
#else
                    asm volatile("global_store_dwordx4 %0, %1, %2" :: "v"(ro + (unsigned)bj * (unsigned)bjs * 2u), "v"(w), "s"(base) : "memory");
#endif
#endif
                }
            }
    }
};
}

#define LAS __attribute__((address_space(3)))
#define GAS __attribute__((address_space(1)))
#define LDS_WAIT() asm volatile("s_waitcnt lgkmcnt(0)" ::: "memory")
#define VM_WAIT() asm volatile("s_waitcnt vmcnt(0)" ::: "memory")
__device__ __forceinline__ unsigned pk2(float lo, float hi) { return (unsigned)f2bf(lo) | ((unsigned)f2bf(hi) << 16); }
#define XB_TMO      128
#define XB_XCNT(j)  (256  + 64 * (j))
#define XB_XSUB(j)  (1280 + 64 * (j))
#define XB_XGEN(j)  (2304 + 64 * (j))
#define XB_TOP      3328
#define XB_TOPGEN   3392
#define XCD_BAR_WORDS 3456
#define XB_SPIN_CAP (1u << 18)

__device__ __forceinline__ unsigned xb_ld(unsigned* p)              { return __hip_atomic_load(p, __ATOMIC_RELAXED, __HIP_MEMORY_SCOPE_AGENT); }
__device__ __forceinline__ unsigned xb_add(unsigned* p, unsigned v) { return __hip_atomic_fetch_add(p, v, __ATOMIC_RELAXED, __HIP_MEMORY_SCOPE_AGENT); }
__device__ __forceinline__ unsigned xb_xcc_id() { return (unsigned)__builtin_amdgcn_s_getreg((3 << 11) | 20) & 0xFu; }
#define XB_SPIN(cond, bar) do { unsigned _sp = 0; while (cond) { __builtin_amdgcn_s_sleep(1); \
    if ((++_sp & 255u) == 0u) { if (xb_ld(&(bar)[XB_TMO])) break; if (_sp > XB_SPIN_CAP) { atomicAdd(&(bar)[XB_TMO], 1u); break; } } } } while (0)

struct XcdBarrier {
    int w;
    unsigned G;
    unsigned* bar; unsigned x;
    volatile LAS unsigned* st;
};

__device__ __forceinline__ XcdBarrier xcd_barrier_post(unsigned* bar, volatile LAS unsigned* st, int wave_s, unsigned G) {
    XcdBarrier b; b.w = wave_s; b.G = G; b.bar = bar; b.x = xb_xcc_id(); b.st = st;
    if (tid_from(wave_s) == 0) (void)xb_add(&bar[XB_XCNT(b.x)], 1u);
    return b;
}
__device__ __forceinline__ void xcd_barrier_complete(unsigned* bar, unsigned x, unsigned& nloc, unsigned& nx, unsigned G) {
    unsigned sum, cnt, mine, sp = 0u;
    for (;;) {
        sum = 0u; cnt = 0u; mine = 0u;
#pragma unroll
        for (unsigned j = 0; j < 16; ++j) { const unsigned c = xb_ld(&bar[XB_XCNT(j)]); sum += c; cnt += (c > 0u) ? 1u : 0u; mine = (j == x) ? c : mine; }
        if (sum == G) break;
        __builtin_amdgcn_s_sleep(1);
        if ((++sp & 255u) == 0u) { if (xb_ld(&bar[XB_TMO])) break; if (sp > XB_SPIN_CAP) { atomicAdd(&bar[XB_TMO], 1u); break; } }
    }
    nloc = mine > 0u ? mine : 1u; nx = cnt > 0u ? cnt : 1u;
}

struct BarTouch { const char* p[6]; int n[6]; };
__device__ __forceinline__ void xcd_barrier(const XcdBarrier& b, const BarTouch* bt = nullptr, LAS unsigned char* junk = nullptr) {
    asm volatile("s_waitcnt vmcnt(0)" ::: "memory");
    __syncthreads();
    if (bt != nullptr && b.w != 0) {
        const int li_ = (b.w - 1) * 64 + (tid_from(b.w) & 63);
#pragma unroll
        for (int r = 0; r < 6; ++r) { const int n_ = bt->n[r];
            for (int i0 = 0; i0 < n_; i0 += 448) { int i = i0 + li_; i = i < n_ ? i : n_ - 1;
                __builtin_amdgcn_global_load_lds((const unsigned*)(bt->p[r] + (size_t)i * 128), (LAS unsigned*)(junk + b.w * 256), 4, 0, 0); } }
    }
    if (tid_from(b.w) == 0) {
        unsigned* bar = b.bar;
        __builtin_amdgcn_s_waitcnt(0);
        unsigned nloc = b.st[0], nx = b.st[1];
        if (nloc == 0u) { xcd_barrier_complete(bar, b.x, nloc, nx, b.G); b.st[0] = nloc; b.st[1] = nx; }
        const unsigned old = xb_add(&bar[XB_XSUB(b.x)], 1u);
        const unsigned gen = old / nloc;
        if (old + 1u == (gen + 1u) * nloc) {
            __builtin_amdgcn_fence(__ATOMIC_RELEASE, "agent");
            asm volatile("s_waitcnt vmcnt(0)" ::: "memory");
            const unsigned og = xb_add(&bar[XB_TOP], 1u);
            const unsigned tg = og / nx;
            if (og + 1u == (tg + 1u) * nx) xb_add(&bar[XB_TOPGEN], 1u);
            else XB_SPIN(xb_ld(&bar[XB_TOPGEN]) == tg, bar);
            __builtin_amdgcn_fence(__ATOMIC_ACQUIRE, "agent");
            xb_add(&bar[XB_XGEN(b.x)], 1u);
            asm volatile("s_waitcnt vmcnt(0)" ::: "memory");
        } else {
            XB_SPIN(xb_ld(&bar[XB_XGEN(b.x)]) == gen, bar);
            __builtin_amdgcn_fence(__ATOMIC_ACQUIRE, "agent");
            asm volatile("s_waitcnt vmcnt(0)" ::: "memory");
        }
    }
    __syncthreads();
}

constexpr int NWAVES = 8, NTHREADS = NWAVES * 64;
constexpr int RING_BYTES = 131072;
constexpr int LDS_BYTES = 163840;
constexpr int MISC_OFF = LDS_BYTES - 256;
constexpr int CW_BAR = 4096;
constexpr int N_BAR_REGIONS = 32;
constexpr size_t CTL_ZERO_BYTES = 1 * MiB;
static_assert((CW_BAR + N_BAR_REGIONS * XCD_BAR_WORDS) * 4 <= (int)CTL_ZERO_BYTES, "ctl");

#ifndef PROBE_DUP
#define PROBE_DUP 0
#endif
struct Frame { LAS unsigned char* lds; int wave, vcu, G; };

struct Args { Params p; int ph_lo, ph_hi, bar_region, pad; };
__device__ __forceinline__ const float* inptr(const Args& a, int i) { int z; asm volatile("s_mov_b32 %0, 0" : "=s"(z)); return a.p.in[i + z]; }

namespace swa {
constexpr int D = 128; constexpr float THR = 8.f; constexpr bool WSKIP = true;
constexpr float SCALE = 0.08838834764831845f;
constexpr int NW = 8, QBLK = 32, KVBLK = 64, QB = NW * QBLK;
constexpr int SHM_V = KVBLK * D * 2, SHM_K = KVBLK * D * 2;
constexpr int ATTN_LDS_BYTES = 2 * SHM_V + 2 * SHM_K + NW * 64 * 4;

typedef short s16x4 __attribute__((ext_vector_type(4)));
typedef float f32x16 __attribute__((ext_vector_type(16)));
template <class A, class Bt> struct same_t { static constexpr bool v = false; };
template <class A> struct same_t<A, A> { static constexpr bool v = true; };

#define KSWZ(row, colB) ((row) * 256 + ((colB) ^ (((row) & 7) << 4)))
#define SBAR() __builtin_amdgcn_sched_barrier(0)
__device__ __forceinline__ int v_st(int k, int c) { const int kk = (k & ~0xC) | ((k & 4) << 1) | ((k & 8) >> 1); return ((kk >> 3) * 4 + (c >> 5)) * 512 + ((kk & 7) * 32 + (c & 31)) * 2; }
__device__ __forceinline__ int v_rd_base(int lane) { return ((lane & 3) << 3) | (((lane >> 2) & 3) << 6) | (((lane >> 4) & 1) << 5) | (((lane >> 5) & 1) << 8); }
constexpr int v_rd_off(int d0, int ks, int half) { return d0 * 512 + ks * 4096 + half * 2048; }
__device__ __forceinline__ int crow(int r, int hi) { return (r & 3) + 8 * (r >> 2) + 4 * hi; }
__device__ __forceinline__ unsigned cvtpk(float lo, float hi) {
    unsigned r; asm volatile("v_cvt_pk_bf16_f32 %0, %1, %2" : "=v"(r) : "v"(lo), "v"(hi)); return r;
}
__device__ __forceinline__ bf16x8 pack8(f32x4 a, f32x4 b) {
    u32x4 w = {cvtpk(a[0], a[1]), cvtpk(a[2], a[3]), cvtpk(b[0], b[1]), cvtpk(b[2], b[3])};
    return *reinterpret_cast<bf16x8*>(&w);
}
template <class T> __device__ __forceinline__ bf16x8 load8(const T* p) {
    if constexpr (same_t<T, float>::v) { return pack8(*(const f32x4*)p, *(const f32x4*)(p + 4)); }
    else { return *reinterpret_cast<const bf16x8*>(p); }
}
__device__ __forceinline__ void mask_tile(f32x16& p0, f32x16& p1, int dq, unsigned W) {
    const float NEG = -__builtin_inff();
#pragma unroll
    for (int r = 0; r < 16; ++r) {
        const int c = (r & 3) + 8 * (r >> 2);
        if ((unsigned)(dq - c) >= W) p0[r] = NEG;
        if ((unsigned)(dq - c - 32) >= W) p1[r] = NEG;
    }
}
__device__ __forceinline__ void partialSM(f32x16& p0, f32x16& p1, float& m_reg, float& mn, float& alpha) {
    float pmax = p0[0]; for (int r = 1; r < 16; ++r) pmax = fmaxf(pmax, p0[r]); for (int r = 0; r < 16; ++r) pmax = fmaxf(pmax, p1[r]);
    { auto rr = __builtin_amdgcn_permlane32_swap(__float_as_uint(pmax), __float_as_uint(pmax), false, false);
      pmax = fmaxf(__uint_as_float(rr[0]), __uint_as_float(rr[1])); }
    constexpr float C2 = 1.4426950408889634f * SCALE;
    if (__builtin_expect(__all((pmax - m_reg) * SCALE <= THR), 1)) { mn = m_reg; alpha = 1.f; }
    else { mn = fmaxf(m_reg, pmax); alpha = __builtin_amdgcn_exp2f((m_reg - mn) * C2); m_reg = mn; }
    const float mnL = -mn * C2;
    for (int r = 0; r < 16; ++r) p0[r] = fmaf(p0[r], C2, mnL); for (int r = 0; r < 16; ++r) p1[r] = fmaf(p1[r], C2, mnL);
    for (int r = 0; r < 16; ++r) p0[r] = __builtin_amdgcn_exp2f(p0[r]);
}
__device__ __forceinline__ void finishSM(f32x16& p0, f32x16& p1, float alpha, float& l_reg, bf16x8& pa0, bf16x8& pa1, bf16x8& pa2, bf16x8& pa3) {
    for (int r = 0; r < 16; ++r) p1[r] = __builtin_amdgcn_exp2f(p1[r]);
    float ps = 0; for (int r = 0; r < 16; ++r) ps += p0[r]; for (int r = 0; r < 16; ++r) ps += p1[r];
    { auto rr = __builtin_amdgcn_permlane32_swap(__float_as_uint(ps), __float_as_uint(ps), false, false);
      ps = __uint_as_float(rr[0]) + __uint_as_float(rr[1]); }
    l_reg = l_reg * alpha + ps;
#define PK4(P, B_, OUT) do { unsigned a0 = cvtpk(P[B_+0], P[B_+1]), a1 = cvtpk(P[B_+2], P[B_+3]);                          \
        unsigned b0 = cvtpk(P[B_+4], P[B_+5]), b1 = cvtpk(P[B_+6], P[B_+7]);                                             \
        auto r0 = __builtin_amdgcn_permlane32_swap(a0, b0, false, false); auto r1 = __builtin_amdgcn_permlane32_swap(a1, b1, false, false); \
        u32x4 w = {r0[0], r1[0], r0[1], r1[1]}; OUT = *reinterpret_cast<bf16x8*>(&w); } while (0)
    PK4(p0, 0, pa0); PK4(p0, 8, pa1); PK4(p1, 0, pa2); PK4(p1, 8, pa3);
#undef PK4
}
template <int KB, bool SK>
__device__ __forceinline__ void qkt(f32x16& p0, f32x16& p1, const char* K_lds, int r32, int hi, const bf16x8* qr, bool act) {
    if (SK && !act) { const float NEG = -__builtin_inff();
#pragma unroll
        for (int r = 0; r < 16; ++r) { p0[r] = NEG; p1[r] = NEG; } return; }
    p0 = f32x16{}; p1 = f32x16{};
    const char* kb[4];
#pragma unroll
    for (int dd = 0; dd < 4; ++dd) kb[dd] = K_lds + KB * SHM_K + KSWZ(r32, (dd * 16 + hi * 8) * 2);
#pragma unroll
    for (int d0 = 0; d0 < 8; ++d0) { const char* a = kb[d0 & 3] + (d0 >> 2) * 128;
        bf16x8 b0 = *reinterpret_cast<const bf16x8*>(a);
        bf16x8 b1 = *reinterpret_cast<const bf16x8*>(a + 32 * 256);
        p0 = __builtin_amdgcn_mfma_f32_32x32x16_bf16(b0, qr[d0], p0, 0, 0, 0);
        p1 = __builtin_amdgcn_mfma_f32_32x32x16_bf16(b1, qr[d0], p1, 0, 0, 0); }
}
template <int VB, bool SK>
__device__ __forceinline__ void pv_tile(f32x16* o, int vb0, bf16x8 pa0, bf16x8 pa1, bf16x8 pa2, bf16x8 pa3, bool act) {
    if (SK && !act) return;
#define TRRD(dst, off) asm volatile("ds_read_b64_tr_b16 %0, %1 offset:%2" : "=&v"(dst) : "v"(vb0), "i"(off) : "memory")
#define PV_D0(d0) do { s16x4 l0, l1, l2, l3, h0, h1, h2, h3; constexpr int b_ = VB * SHM_V + v_rd_off(d0, 0, 0);     \
        TRRD(l0, b_); TRRD(h0, b_ + 2048); TRRD(l1, b_ + 4096); TRRD(h1, b_ + 6144); TRRD(l2, b_ + 8192); TRRD(h2, b_ + 10240); TRRD(l3, b_ + 12288); TRRD(h3, b_ + 14336); \
        asm volatile("s_waitcnt lgkmcnt(0)" ::: "memory"); SBAR();                 \
        o[d0] = __builtin_amdgcn_mfma_f32_32x32x16_bf16(pa0, (bf16x8){l0[0], l0[1], l0[2], l0[3], h0[0], h0[1], h0[2], h0[3]}, o[d0], 0, 0, 0);   \
        o[d0] = __builtin_amdgcn_mfma_f32_32x32x16_bf16(pa1, (bf16x8){l1[0], l1[1], l1[2], l1[3], h1[0], h1[1], h1[2], h1[3]}, o[d0], 0, 0, 0);   \
        o[d0] = __builtin_amdgcn_mfma_f32_32x32x16_bf16(pa2, (bf16x8){l2[0], l2[1], l2[2], l2[3], h2[0], h2[1], h2[2], h2[3]}, o[d0], 0, 0, 0);   \
        o[d0] = __builtin_amdgcn_mfma_f32_32x32x16_bf16(pa3, (bf16x8){l3[0], l3[1], l3[2], l3[3], h3[0], h3[1], h3[2], h3[3]}, o[d0], 0, 0, 0); } while (0)
    PV_D0(0); PV_D0(1); PV_D0(2); PV_D0(3);
#undef PV_D0
#undef TRRD
}

template <class TIn, class TOut> struct BlockRef { const TIn* Q; const TIn* K; const TIn* V; TOut* O; float* L; int P0, pitch, opitch, lpitch, nq; };
template <class TIn> struct Seam {
    bf16x8 qr[8];
    bf16x8 st_v0, st_v1, st_k0, st_k1; f32x4 sf0, sf1, sf2, sf3;
    f32x4 tq[16];
};
__device__ __forceinline__ int swa_jlo(int P0, int W) { const int lowk = P0 - W + 1; return lowk > 0 ? lowk / KVBLK : 0; }
#define ROW(p, k0, rr) ((p) + (size_t)((k0) + (rr)) * PITCH_ + sc)
#define VMW() asm volatile("s_waitcnt vmcnt(0)" ::: "memory")
#define VMWN(n) asm volatile("s_waitcnt vmcnt(%0)" :: "i"(n) : "memory")
#define SLOAD_H(Kp, Vp, k0) do { S.st_v0 = load8<TIn>(ROW(Vp, k0, sr)); S.st_v1 = load8<TIn>(ROW(Vp, k0, 32 + sr));              \
                         S.st_k0 = load8<TIn>(ROW(Kp, k0, sr)); S.st_k1 = load8<TIn>(ROW(Kp, k0, 32 + sr)); } while (0)
#define SWRITE_HK(bf) do { *(bf16x8*)(K_lds + (bf) * SHM_K + kws) = S.st_k0; *(bf16x8*)(K_lds + (bf) * SHM_K + kws + 32 * 256) = S.st_k1; } while (0)
#define SWRITE_HV(bf) do { *(bf16x8*)(V_lds + (bf) * SHM_V + vst0) = S.st_v0; *(bf16x8*)(V_lds + (bf) * SHM_V + vst1) = S.st_v1; } while (0)
#define SWRITE_H(bf) do { SWRITE_HV(bf); SWRITE_HK(bf); } while (0)
#define SLOAD_F(p, k0) do { S.sf0 = *(const f32x4*)ROW(p, k0, sr); S.sf1 = *(const f32x4*)(ROW(p, k0, sr) + 4);                \
                            S.sf2 = *(const f32x4*)ROW(p, k0, 32 + sr); S.sf3 = *(const f32x4*)(ROW(p, k0, 32 + sr) + 4); } while (0)
#define SWRITE_KF(bf) do { *(bf16x8*)(K_lds + (bf) * SHM_K + kws) = pack8(S.sf0, S.sf1); *(bf16x8*)(K_lds + (bf) * SHM_K + kws + 32 * 256) = pack8(S.sf2, S.sf3); } while (0)
#define SWRITE_VF(bf) do { *(bf16x8*)(V_lds + (bf) * SHM_V + vst0) = pack8(S.sf0, S.sf1); *(bf16x8*)(V_lds + (bf) * SHM_V + vst1) = pack8(S.sf2, S.sf3); } while (0)
template <class TIn, class TOut>
__device__ __forceinline__ void causal_swa_prime(const BlockRef<TIn, TOut>& cur, int W, char* lds, Seam<TIn>& S, int wave_s) {
    constexpr bool F32 = same_t<TIn, float>::v;
    const int tid = tid_from(wave_s), wid = wave_s, lane = tid & 63, r32 = lane & 31, hi = lane >> 5;
    const int sr = tid >> 4, sc = (tid & 15) * 8, kws = KSWZ(sr, sc * 2); char* K_lds = lds + 2 * SHM_V;
    const int kb0 = swa_jlo(cur.P0, W) * KVBLK;
    const int PITCH_ = cur.pitch; const int qrow_ = (wid * QBLK + r32 < cur.nq) ? wid * QBLK + r32 : cur.nq - 1;
    for (int d0 = 0; d0 < 8; ++d0) S.qr[d0] = load8<TIn>(cur.Q + (size_t)qrow_ * PITCH_ + d0 * 16 + hi * 8);
    if constexpr (F32) { SLOAD_F((const float*)cur.K, kb0); VMW(); SWRITE_KF(0); SBAR(); SLOAD_F((const float*)cur.V, kb0); }
    else { SLOAD_H(cur.K, cur.V, kb0); VMW(); SWRITE_HK(0); }
    __syncthreads();
}
template <class TIn, class TOut>
__device__ __forceinline__ void causal_swa_block(const BlockRef<TIn, TOut>& cur, const BlockRef<TIn, TOut>& nxt, int skv, int W, char* lds, Seam<TIn>& S, int wave_s) {
    constexpr bool F32 = same_t<TIn, float>::v;
    const int tid = tid_from(wave_s), wid = wave_s, lane = tid & 63, r32 = lane & 31, hi = lane >> 5;
    int PITCH_ = cur.pitch; const bool wact = (wid * QBLK < cur.nq);
    const int j_lo = swa_jlo(cur.P0, W);
    int j_hi = (cur.P0 + QB - 1) / KVBLK + 1; if (j_hi > skv / KVBLK) j_hi = skv / KVBLK;
    const int NT = j_hi - j_lo;
    const int kbn = swa_jlo(nxt.P0, W) * KVBLK;
    const int qlo = cur.P0 + wid * QBLK, qm = qlo + r32 - 4 * hi;
    char* V_lds = lds; char* K_lds = lds + 2 * SHM_V;
    float* ws = (float*)(lds + 2 * SHM_V + 2 * SHM_K) + wid * 64; float* li_l = ws, * al_l = ws + 32;
    float m_reg = -1e30f, l_reg = 0; f32x16 o[4] = {};
    const int sr = tid >> 4, sc = (tid & 15) * 8, vst0 = v_st(sr, sc), vst1 = v_st(32 + sr, sc), kws = KSWZ(sr, sc * 2);
    const int vb0 = (int)(uintptr_t)V_lds + v_rd_base(lane);
    const TIn* Kh = cur.K; const TIn* Vh = cur.V;
#define RESC(a) do { if (__any((a) < 1.f)) { if (hi == 0) al_l[r32] = (a); asm volatile("s_waitcnt lgkmcnt(0)" ::: "memory");              \
                     for (int d_ = 0; d_ < 4; ++d_) for (int r = 0; r < 16; ++r) o[d_][r] *= al_l[crow(r, hi)]; } } while (0)
#define KBASE(t) ((j_lo + (t)) * KVBLK)
#define ACT(t) (wact && KBASE(t) <= qlo + QBLK - 1 && KBASE(t) + KVBLK - 1 >= qlo - W + 1)
#define MASKT(P0_, P1_, t) do { const int kb_ = KBASE(t); if ((!SK || ACT(t)) && (kb_ + KVBLK - 1 > qlo || kb_ <= qlo + QBLK - 1 - W)) mask_tile(P0_, P1_, qm - kb_, (unsigned)W); } while (0)
    constexpr int NQL = F32 ? 16 : 8;
    constexpr bool SK = WSKIP && !F32;
#define SEAM_K0() do { VMWN(NQL); if constexpr (F32) { SWRITE_KF(0); SBAR(); SLOAD_F((const float*)nxt.V, kbn); } else { SWRITE_HK(0); } SBAR(); } while (0)
    f32x16 pA0, pA1, pB0, pB1; float mnA, mnB, alA, alB; bf16x8 pa0, pa1, pa2, pa3;
    if constexpr (F32) { VMW(); SWRITE_VF(0); SBAR(); } else { SWRITE_HV(0); SBAR(); }
    if (NT > 1) { if constexpr (F32) SLOAD_F((const float*)Kh, KBASE(1)); else SLOAD_H(Kh, Vh, KBASE(1)); }
    SBAR(); qkt<0, SK>(pA0, pA1, K_lds, r32, hi, S.qr, ACT(0));
    if constexpr (F32) { if (NT > 1) { VMW(); SWRITE_KF(1); SBAR(); SLOAD_F((const float*)Vh, KBASE(1)); } }
    MASKT(pA0, pA1, 0); partialSM(pA0, pA1, m_reg, mnA, alA);
    if (NT > 1) { VMW(); if constexpr (F32) { SWRITE_VF(1); SBAR(); if (NT > 2) SLOAD_F((const float*)Kh, KBASE(2)); } else SWRITE_H(1); }
    __syncthreads();
#define HALF_STEP(PX0, PX1, mnX, alX, PY0, PY1, alY, t, KB, VB, SB) do {                                                      \
        SBAR(); if constexpr (!F32) { if ((t) + 1 < NT) { SLOAD_H(Kh, Vh, KBASE((t) + 1)); SBAR(); } }     \
        qkt<KB, SK>(PX0, PX1, K_lds, r32, hi, S.qr, ACT(t));                                             \
        finishSM(PY0, PY1, alY, l_reg, pa0, pa1, pa2, pa3); SBAR();                                                           \
        if constexpr (F32) { if ((t) + 1 < NT) { VMW(); SWRITE_KF(SB); SBAR(); SLOAD_F((const float*)Vh, KBASE((t) + 1)); SBAR(); } }  \
        pv_tile<VB, SK>(o, vb0, pa0, pa1, pa2, pa3, ACT((t) - 1)); MASKT(PX0, PX1, (t)); partialSM(PX0, PX1, m_reg, mnX, alX);                                        \
        __syncthreads();                                                                                                      \
        if ((t) + 1 < NT) { VMW(); if constexpr (F32) { SWRITE_VF(SB); SBAR(); if ((t) + 2 < NT) SLOAD_F((const float*)Kh, KBASE((t) + 2)); } \
                            else { SWRITE_H(SB); } }                                                                          \
        RESC(alX); __syncthreads(); } while (0)
    for (int t = 1; t + 1 < NT; t += 2) {
        HALF_STEP(pB0, pB1, mnB, alB, pA0, pA1, alA, t, 1, 0, 0);
        HALF_STEP(pA0, pA1, mnA, alA, pB0, pB1, alB, t + 1, 0, 1, 1);
    }
    const bool even = (NT & 1) == 0;
    if (even) { SBAR(); qkt<1, SK>(pB0, pB1, K_lds, r32, hi, S.qr, ACT(NT - 1)); SBAR(); }
#define QROW(e) (nxt.Q + (size_t)(wid * QBLK + r32) * D + ((e) >> 1) * 16 + hi * 8 + ((e) & 1) * 4)
    if constexpr (F32) { SLOAD_F((const float*)nxt.K, kbn); SBAR();
#pragma unroll
        for (int e = 0; e < 8; ++e) S.tq[e] = *(const f32x4*)QROW(e); }
    else { PITCH_ = nxt.pitch; SLOAD_H(nxt.K, nxt.V, kbn); SBAR();
        const int qrow_ = (wid * QBLK + r32 < nxt.nq) ? wid * QBLK + r32 : nxt.nq - 1;
#pragma unroll
        for (int d0 = 0; d0 < 8; ++d0) S.qr[d0] = load8<TIn>(nxt.Q + (size_t)qrow_ * PITCH_ + d0 * 16 + hi * 8); }
    SBAR();
    finishSM(pA0, pA1, alA, l_reg, pa0, pa1, pa2, pa3); SBAR();
    if constexpr (F32) {
#pragma unroll
        for (int e = 8; e < 16; ++e) S.tq[e] = *(const f32x4*)QROW(e); SBAR(); }
#undef QROW
    pv_tile<0, SK>(o, vb0, pa0, pa1, pa2, pa3, ACT(even ? NT - 2 : NT - 1));
    if (even) { MASKT(pB0, pB1, NT - 1); partialSM(pB0, pB1, m_reg, mnB, alB); __syncthreads(); RESC(alB);
        finishSM(pB0, pB1, alB, l_reg, pa0, pa1, pa2, pa3); SBAR(); pv_tile<1, SK>(o, vb0, pa0, pa1, pa2, pa3, ACT(NT - 1)); }
    SBAR(); SEAM_K0();
    if (hi == 0) li_l[r32] = l_reg; asm volatile("s_waitcnt lgkmcnt(0)" ::: "memory");
    float rli[16];
#pragma unroll
    for (int r = 0; r < 16; ++r) rli[r] = __builtin_amdgcn_rcpf(li_l[crow(r, hi)]);
    const int OP_ = cur.opitch; TOut* Ow = cur.O + (size_t)(wid * QBLK) * OP_;
    if (wact) {
    if (hi == 0) cur.L[(size_t)(wid * QBLK + r32) * cur.lpitch] = m_reg * (1.4426950408889634f * SCALE) + __builtin_amdgcn_logf(l_reg);
#pragma unroll
    for (int r = 0; r < 16; ++r) { const int orow = crow(r, hi);
#pragma unroll
        for (int d0 = 0; d0 < 4; ++d0) { const float v = o[d0][r] * rli[r];
            if constexpr (same_t<TOut, float>::v) { Ow[(size_t)orow * OP_ + d0 * 32 + r32] = v; }
            else { const float vn = __builtin_bit_cast(float, __builtin_amdgcn_mov_dpp(__builtin_bit_cast(int, v), 0xB1, 0xF, 0xF, true));
                   if ((r32 & 1) == 0) *(unsigned*)(Ow + (size_t)orow * OP_ + d0 * 32 + r32) = cvtpk(v, vn); } } }
    }
    if constexpr (F32) {
#pragma unroll
        for (int d0 = 0; d0 < 8; ++d0) S.qr[d0] = pack8(S.tq[2 * d0], S.tq[2 * d0 + 1]); }
    __syncthreads();
#undef RESC
#undef KBASE
#undef ACT
#undef MASKT
#undef SEAM_K0
#undef HALF_STEP
}
#undef ROW
#undef VMW
#undef VMWN
#undef SLOAD_H
#undef SWRITE_HK
#undef SWRITE_HV
#undef SWRITE_H
#undef SLOAD_F
#undef SWRITE_KF
#undef SWRITE_VF

constexpr int DMA_KR = 0, DMA_VR = 3 * SHM_K, DMA_SCR = DMA_VR + 3 * SHM_V, DMA_LDS_BYTES = DMA_SCR + NW * 64 * 4;
template <class TIn, class TOut>
__device__ __forceinline__ void block_dma(const BlockRef<TIn, TOut>& cur, int skv, int W, char* lds, int wave_s) {
    const int tid = tid_from(wave_s), wid = wave_s, lane = tid & 63, r32 = lane & 31, hi = lane >> 5;
    const int j_lo = swa_jlo(cur.P0, W);
    int j_hi = (cur.P0 + QB - 1) / KVBLK + 1; if (j_hi > skv / KVBLK) j_hi = skv / KVBLK;
    const int NT = j_hi - j_lo, PITCH_ = cur.pitch;
    const bool wact = (wid * QBLK < cur.nq);
    const int qlo = cur.P0 + wid * QBLK, qm = qlo + r32 - 4 * hi;
    float* wsf = (float*)(lds + DMA_SCR) + wid * 64; float* li_l = wsf; float* al_l = wsf + 32;
    int kOff[2], vOff[2];
#pragma unroll
    for (int j = 0; j < 2; ++j) kOff[j] = (4 * (2 * wid + j) + (lane >> 4)) * PITCH_ + (((lane & 15) ^ ((lane >> 4) + 4 * j)) * 8);
    { const int kk = wid * 8 + ((lane & 31) >> 2), k = (kk & ~0xC) | ((kk & 4) << 1) | ((kk & 8) >> 1);
#pragma unroll
      for (int j = 0; j < 2; ++j) vOff[j] = k * PITCH_ + (((2 * j + (lane >> 5)) & 3) * 32 + (lane & 3) * 8); }
    typedef __attribute__((address_space(3))) unsigned lds_u32;
    const unsigned ldsb = (unsigned)(size_t)(__attribute__((address_space(3))) char*)lds;
#define DMA_TILE(t, slot) do { const TIn* kt_ = cur.K + (size_t)(j_lo + (t)) * KVBLK * PITCH_; const TIn* vt_ = cur.V + (size_t)(j_lo + (t)) * KVBLK * PITCH_; \
        _Pragma("unroll") for (int j = 0; j < 2; ++j) { \
            __builtin_amdgcn_global_load_lds((const unsigned*)(kt_ + kOff[j]), (lds_u32*)(size_t)(ldsb + DMA_KR + (slot) * SHM_K + (2 * wid + j) * 1024), 16, 0, 0); \
            __builtin_amdgcn_global_load_lds((const unsigned*)(vt_ + vOff[j]), (lds_u32*)(size_t)(ldsb + DMA_VR + (slot) * SHM_V + (2 * wid + j) * 1024), 16, 0, 0); } } while (0)
    bf16x8 qr[8];
    { const int qrow_ = (wid * QBLK + r32 < cur.nq) ? wid * QBLK + r32 : cur.nq - 1;
#pragma unroll
      for (int d0 = 0; d0 < 8; ++d0) qr[d0] = load8<TIn>(cur.Q + (size_t)qrow_ * PITCH_ + d0 * 16 + hi * 8); }
    DMA_TILE(0, 0);
    if (NT > 1) DMA_TILE(1, 1);
    float m_reg = -1e30f, l_reg = 0; f32x16 o[4] = {};
    const int vbase = (int)ldsb + DMA_VR + v_rd_base(lane);
    int slot = 0, slot2 = 2;
#pragma unroll 1
    for (int t = 0; t < NT; ++t) {
        if (t + 1 < NT) asm volatile("s_waitcnt vmcnt(4)" ::: "memory"); else asm volatile("s_waitcnt vmcnt(0)" ::: "memory");
        asm volatile("s_waitcnt lgkmcnt(0)" ::: "memory"); __builtin_amdgcn_s_barrier(); asm volatile("" ::: "memory");
        if (t + 2 < NT) DMA_TILE(t + 2, slot2);
        const int kb_ = (j_lo + t) * KVBLK;
        const bool act = wact && kb_ <= qlo + QBLK - 1 && kb_ + KVBLK - 1 >= qlo - W + 1;
        if (act) {
            f32x16 p0, p1; float mn, al; bf16x8 pa0, pa1, pa2, pa3;
            SBAR(); qkt<0, false>(p0, p1, lds + DMA_KR + slot * SHM_K, r32, hi, qr, true);
            if (kb_ + KVBLK - 1 > qlo || kb_ <= qlo + QBLK - 1 - W) mask_tile(p0, p1, qm - kb_, (unsigned)W);
            partialSM(p0, p1, m_reg, mn, al);
            finishSM(p0, p1, al, l_reg, pa0, pa1, pa2, pa3); SBAR();
            if (__any(al < 1.f)) { if (hi == 0) al_l[r32] = al; asm volatile("s_waitcnt lgkmcnt(0)" ::: "memory");
                for (int d_ = 0; d_ < 4; ++d_) for (int r = 0; r < 16; ++r) o[d_][r] *= al_l[crow(r, hi)]; }
            pv_tile<0, false>(o, vbase + slot * SHM_V, pa0, pa1, pa2, pa3, true);
        }
        slot = slot == 2 ? 0 : slot + 1; slot2 = slot2 == 2 ? 0 : slot2 + 1;
    }
#undef DMA_TILE
    if (wact) {
        if (hi == 0) li_l[r32] = l_reg; asm volatile("s_waitcnt lgkmcnt(0)" ::: "memory");
        float rli[16];
#pragma unroll
        for (int r = 0; r < 16; ++r) rli[r] = __builtin_amdgcn_rcpf(li_l[crow(r, hi)]);
        const int OP_ = cur.opitch; TOut* Ow = cur.O + (size_t)(wid * QBLK) * OP_;
        if (hi == 0) cur.L[(size_t)(wid * QBLK + r32) * cur.lpitch] = m_reg * (1.4426950408889634f * SCALE) + __builtin_amdgcn_logf(l_reg);
#pragma unroll
        for (int r = 0; r < 16; ++r) { const int orow = crow(r, hi);
#pragma unroll
            for (int d0 = 0; d0 < 4; ++d0) { const float v = o[d0][r] * rli[r];
                const float vn = __builtin_bit_cast(float, __builtin_amdgcn_mov_dpp(__builtin_bit_cast(int, v), 0xB1, 0xF, 0xF, true));
                if ((r32 & 1) == 0) *(unsigned*)(Ow + (size_t)orow * OP_ + d0 * 32 + r32) = cvtpk(v, vn); } }
    }
    asm volatile("s_waitcnt lgkmcnt(0)" ::: "memory"); __builtin_amdgcn_s_barrier(); asm volatile("" ::: "memory");
}
typedef BlockRef<bf16_t, bf16_t> Ref;
}
#undef KSWZ

__device__ __forceinline__ swa::Ref attn_ref(unsigned char* ws, int L, int& skv) {
    int gi, b, h, c, qb;
    if (L < 256) { gi = 0; b = L >> 5; h = (L >> 3) & 3; qb = L & 7; c = 0; }
    else if (L < 512) { L -= 256; gi = 1; b = L >> 5; h = (L >> 3) & 3; c = (L >> 1) & 3; qb = L & 1; }
    else { L -= 512; gi = 2; const int v = L & 255, idx = (v & 31) * 2 + (L >> 8); b = v >> 5; h = idx >> 4; c = idx & 15; qb = 0; }
    const int d = gi == 0 ? 1 : (gi == 1 ? 4 : 16);
    const int n = SEQ / d;
    const size_t hb = ((size_t)(gi * BATCH + b) * HPG + h) * SEQ * HD + (size_t)c * n * HD, kstep = (size_t)3 * BATCH * HPG * SEQ * HD;
    const bf16_t* qkv = (const bf16_t*)(ws + OFF_QKV);
    const size_t tok0 = (size_t)b * SEQ + c + (size_t)qb * 256 * d;
    swa::Ref r;
    r.Q = qkv + hb + (size_t)qb * 256 * HD; r.K = qkv + kstep + hb; r.V = qkv + 2 * kstep + hb;
    r.O = (bf16_t*)(ws + OFF_AO) + ((size_t)gi * MTOK + tok0) * ATT_W + h * HD; r.opitch = d * ATT_W;
    r.L = (float*)(ws + OFF_ALSE) + ((size_t)gi * MTOK + tok0) * 4 + h; r.lpitch = d * 4;
    r.P0 = qb * 256; r.pitch = HD; r.nq = gi == 2 ? 128 : 256;
    skv = SEQ / d;
    return r;
}
namespace wsa2 {
using swa::f32x16; using swa::s16x4; using swa::crow; using swa::cvtpk; using swa::v_rd_base; using swa::SCALE; using swa::THR;
constexpr int BLK_K = 8192, SLOT = 16384, NSLOT = 9, SCR = NSLOT * SLOT, LDS_NEED = SCR + NWAVES * 256;
static_assert(LDS_NEED <= MISC_OFF, "wsa2 LDS");
#define W2_KSWZ(row, colB) ((row) * 256 + ((colB) ^ (((row) & 7) << 4)))
#define W2_SBAR() __builtin_amdgcn_sched_barrier(0)
__device__ __forceinline__ void unit(const swa::Ref& u, LAS unsigned char* lds, int wave_s) {
    const int tid = tid_from(wave_s), wid = wave_s, lane = tid & 63, r32 = lane & 31, hi = lane >> 5;
    const int I0 = u.P0, i0 = I0 + 32 * wid;
    const bool wact = 32 * wid < u.nq;
    const int B0 = (I0 >= 128 ? I0 - 128 : 0) >> 5;
    const int kfirst = i0 >= 128 ? i0 - 128 : 0, nblk = wact ? ((i0 - kfirst) >> 5) + 1 : 0, fw = (kfirst >> 5) - B0;
    const int ilast = I0 + u.nq - 32, klast = ilast >= 128 ? ilast - 128 : 0;
    const int nbtot = (ilast >> 5) - B0 + 1, niter = ((ilast - klast) >> 5) + 1;
    const int krow = 4 * wid + (lane >> 4), kchunk = (lane & 15) ^ (4 * (wid & 1) + (lane >> 4));
    const int kk = (wid >> 1) * 8 + ((lane & 31) >> 2), vkey = (kk & ~0xC) | ((kk & 4) << 1) | ((kk & 8) >> 1), vcol = ((2 * (wid & 1) + (lane >> 5)) & 3) * 32 + (lane & 3) * 8;
    const bf16_t* ksrc = u.K + (size_t)(B0 * 32 + krow) * HD + kchunk * 8;
    const bf16_t* vsrc = u.V + (size_t)(B0 * 32 + vkey) * HD + vcol;
    typedef __attribute__((address_space(3))) unsigned lds_u32;
    const unsigned ldsb = (unsigned)(size_t)lds;
#define W2_DMA(b, slot) do { __builtin_amdgcn_global_load_lds((const unsigned*)(ksrc + (size_t)(b) * 32 * HD), (lds_u32*)(size_t)(ldsb + (slot) * SLOT + wid * 1024), 16, 0, 0); \
        __builtin_amdgcn_global_load_lds((const unsigned*)(vsrc + (size_t)(b) * 32 * HD), (lds_u32*)(size_t)(ldsb + (slot) * SLOT + BLK_K + wid * 1024), 16, 0, 0); } while (0)
    for (int b = 0; b < 8 && b < nbtot; ++b) W2_DMA(b, b);
    bf16x8 qr[8];
    { const int qrow = wact ? 32 * wid + r32 : u.nq - 1;
#pragma unroll
      for (int d0 = 0; d0 < 8; ++d0) qr[d0] = *(const bf16x8*)(u.Q + (size_t)qrow * HD + d0 * 16 + hi * 8); }
    LAS float* li_l = (LAS float*)(lds + SCR + wid * 256); LAS float* al_l = li_l + 32;
    float m_reg = -1e30f, l_reg = 0.f; f32x16 o[4] = {};
    constexpr float C2 = 1.4426950408889634f * SCALE;
    int koff[4];
#pragma unroll
    for (int dd = 0; dd < 4; ++dd) koff[dd] = W2_KSWZ(r32, (dd * 16 + hi * 8) * 2);
    const unsigned vrb = ldsb + BLK_K + (unsigned)v_rd_base(lane);
#pragma unroll 1
    for (int i = 0; i < niter; ++i) {
        asm volatile("s_waitcnt vmcnt(0)" ::: "memory");
        asm volatile("s_waitcnt lgkmcnt(0)" ::: "memory"); __builtin_amdgcn_s_barrier(); asm volatile("" ::: "memory");
        if (i + 8 < nbtot) { const int s8 = (i + 8) % NSLOT; W2_DMA(i + 8, s8); }
        if (i < nblk) {
            const int rel = fw + i, slot = rel % NSLOT, k0 = (B0 + rel) * 32;
            const LAS unsigned char* kb = lds + slot * SLOT;
            f32x16 p = {};
#pragma unroll
            for (int d0 = 0; d0 < 8; ++d0) { const bf16x8 kf = *(const LAS bf16x8*)(kb + koff[d0 & 3] + (d0 >> 2) * 128);
                p = __builtin_amdgcn_mfma_f32_32x32x16_bf16(kf, qr[d0], p, 0, 0, 0); }
            if (k0 == i0 || k0 + 128 == i0) {
                const int dq = i0 + r32 - k0 - 4 * hi; const float NEG = -__builtin_inff();
#pragma unroll
                for (int r = 0; r < 16; ++r) { const int c = (r & 3) + 8 * (r >> 2); if ((unsigned)(dq - c) >= 129u) p[r] = NEG; }
            }
            float pmax = p[0];
#pragma unroll
            for (int r = 1; r < 16; ++r) pmax = fmaxf(pmax, p[r]);
            { auto rr = __builtin_amdgcn_permlane32_swap(__float_as_uint(pmax), __float_as_uint(pmax), false, false); pmax = fmaxf(__uint_as_float(rr[0]), __uint_as_float(rr[1])); }
            float mn, alpha;
            if (__builtin_expect(__all((pmax - m_reg) * SCALE <= THR), 1)) { mn = m_reg; alpha = 1.f; }
            else { mn = fmaxf(m_reg, pmax); alpha = __builtin_amdgcn_exp2f((m_reg - mn) * C2); m_reg = mn; }
            const float mnL = -mn * C2;
#pragma unroll
            for (int r = 0; r < 16; ++r) p[r] = __builtin_amdgcn_exp2f(fmaf(p[r], C2, mnL));
            float ps = 0.f;
#pragma unroll
            for (int r = 0; r < 16; ++r) ps += p[r];
            { auto rr = __builtin_amdgcn_permlane32_swap(__float_as_uint(ps), __float_as_uint(ps), false, false); ps = __uint_as_float(rr[0]) + __uint_as_float(rr[1]); }
            l_reg = l_reg * alpha + ps;
            bf16x8 pa0, pa1;
#define W2_PK4(B_, OUT) do { unsigned a0 = cvtpk(p[B_+0], p[B_+1]), a1 = cvtpk(p[B_+2], p[B_+3]), b0 = cvtpk(p[B_+4], p[B_+5]), b1 = cvtpk(p[B_+6], p[B_+7]); \
            auto r0 = __builtin_amdgcn_permlane32_swap(a0, b0, false, false); auto r1 = __builtin_amdgcn_permlane32_swap(a1, b1, false, false); \
            u32x4 w = {r0[0], r1[0], r0[1], r1[1]}; OUT = *reinterpret_cast<bf16x8*>(&w); } while (0)
            W2_PK4(0, pa0); W2_PK4(8, pa1);
#undef W2_PK4
            if (__any(alpha < 1.f)) {
                if (hi == 0) al_l[r32] = alpha;
                asm volatile("s_waitcnt lgkmcnt(0)" ::: "memory");
#pragma unroll
                for (int d_ = 0; d_ < 4; ++d_)
#pragma unroll
                    for (int r = 0; r < 16; ++r) o[d_][r] *= al_l[crow(r, hi)];
            }
            const unsigned vb0 = vrb + (unsigned)(slot * SLOT);
#define W2_TR(dst, off) asm volatile("ds_read_b64_tr_b16 %0, %1 offset:%2" : "=&v"(dst) : "v"(vb0), "i"(off) : "memory")
#define W2_PV(d0) do { s16x4 l0, l1, h0, h1; W2_TR(l0, (d0) * 512); W2_TR(h0, (d0) * 512 + 2048); W2_TR(l1, (d0) * 512 + 4096); W2_TR(h1, (d0) * 512 + 6144); \
            asm volatile("s_waitcnt lgkmcnt(0)" ::: "memory"); W2_SBAR(); \
            o[d0] = __builtin_amdgcn_mfma_f32_32x32x16_bf16(pa0, (bf16x8){l0[0], l0[1], l0[2], l0[3], h0[0], h0[1], h0[2], h0[3]}, o[d0], 0, 0, 0); \
            o[d0] = __builtin_amdgcn_mfma_f32_32x32x16_bf16(pa1, (bf16x8){l1[0], l1[1], l1[2], l1[3], h1[0], h1[1], h1[2], h1[3]}, o[d0], 0, 0, 0); } while (0)
            W2_PV(0); W2_PV(1); W2_PV(2); W2_PV(3);
#undef W2_PV
#undef W2_TR
        }
    }
#undef W2_DMA
    if (wact) {
        if (hi == 0) li_l[r32] = l_reg;
        asm volatile("s_waitcnt lgkmcnt(0)" ::: "memory");
        float rli[16];
#pragma unroll
        for (int r = 0; r < 16; ++r) rli[r] = __builtin_amdgcn_rcpf(li_l[crow(r, hi)]);
        if (hi == 0) u.L[(size_t)(32 * wid + r32) * u.lpitch] = m_reg * C2 + __builtin_amdgcn_logf(l_reg);
        const int OP = u.opitch; bf16_t* Ow = u.O + (size_t)(32 * wid) * OP;
#pragma unroll
        for (int r = 0; r < 16; ++r) { const int orow = crow(r, hi);
#pragma unroll
            for (int d0 = 0; d0 < 4; ++d0) { const float v = o[d0][r] * rli[r];
                const float vn = __builtin_bit_cast(float, __builtin_amdgcn_mov_dpp(__builtin_bit_cast(int, v), 0xB1, 0xF, 0xF, true));
                if ((r32 & 1) == 0) *(unsigned*)(Ow + (size_t)orow * OP + d0 * 32 + r32) = cvtpk(v, vn); } }
    }
    asm volatile("s_waitcnt lgkmcnt(0)" ::: "memory"); __builtin_amdgcn_s_barrier(); asm volatile("" ::: "memory");
}
#undef W2_KSWZ
#undef W2_SBAR
}

constexpr int N_ATTN_BLOCKS = 1024;

namespace wsa3 {
using swa::f32x16; using swa::s16x4; using swa::crow; using swa::cvtpk; using swa::v_rd_base; using swa::SCALE; using swa::THR;
constexpr int BLK_K = 8192, SLOT = 16384, NSLOT = 9, SCR = NSLOT * SLOT, LDS_NEED = SCR + NWAVES * 256;
static_assert(LDS_NEED <= MISC_OFF, "wsa3 LDS");
#define W3_KSWZ(row, colB) ((row) * 256 + ((colB) ^ (((row) & 7) << 4)))
#define W3_SBAR() __builtin_amdgcn_sched_barrier(0)
__device__ __forceinline__ void wait_vm_ops(int n) {
    switch (n >> 1) {
    case 0: asm volatile("s_waitcnt vmcnt(0)" ::: "memory"); break;
    case 1: asm volatile("s_waitcnt vmcnt(2)" ::: "memory"); break;
    case 2: asm volatile("s_waitcnt vmcnt(4)" ::: "memory"); break;
    case 3: asm volatile("s_waitcnt vmcnt(6)" ::: "memory"); break;
    case 4: asm volatile("s_waitcnt vmcnt(8)" ::: "memory"); break;
    case 5: asm volatile("s_waitcnt vmcnt(10)" ::: "memory"); break;
    case 6: asm volatile("s_waitcnt vmcnt(12)" ::: "memory"); break;
    case 7: asm volatile("s_waitcnt vmcnt(14)" ::: "memory"); break;
    case 8: asm volatile("s_waitcnt vmcnt(16)" ::: "memory"); break;
    case 9: asm volatile("s_waitcnt vmcnt(18)" ::: "memory"); break;
    case 10: asm volatile("s_waitcnt vmcnt(20)" ::: "memory"); break;
    case 11: asm volatile("s_waitcnt vmcnt(22)" ::: "memory"); break;
    case 12: asm volatile("s_waitcnt vmcnt(24)" ::: "memory"); break;
    case 13: asm volatile("s_waitcnt vmcnt(26)" ::: "memory"); break;
    case 14: asm volatile("s_waitcnt vmcnt(28)" ::: "memory"); break;
    case 15: asm volatile("s_waitcnt vmcnt(30)" ::: "memory"); break;
    case 16: asm volatile("s_waitcnt vmcnt(32)" ::: "memory"); break;
    case 17: asm volatile("s_waitcnt vmcnt(34)" ::: "memory"); break;
    case 18: asm volatile("s_waitcnt vmcnt(36)" ::: "memory"); break;
    case 19: asm volatile("s_waitcnt vmcnt(38)" ::: "memory"); break;
    case 20: asm volatile("s_waitcnt vmcnt(40)" ::: "memory"); break;
    case 21: asm volatile("s_waitcnt vmcnt(42)" ::: "memory"); break;
    case 22: asm volatile("s_waitcnt vmcnt(44)" ::: "memory"); break;
    case 23: asm volatile("s_waitcnt vmcnt(46)" ::: "memory"); break;
    case 24: asm volatile("s_waitcnt vmcnt(48)" ::: "memory"); break;
    case 25: asm volatile("s_waitcnt vmcnt(50)" ::: "memory"); break;
    case 26: asm volatile("s_waitcnt vmcnt(52)" ::: "memory"); break;
    case 27: asm volatile("s_waitcnt vmcnt(54)" ::: "memory"); break;
    case 28: asm volatile("s_waitcnt vmcnt(56)" ::: "memory"); break;
    case 29: asm volatile("s_waitcnt vmcnt(58)" ::: "memory"); break;
    case 30: asm volatile("s_waitcnt vmcnt(60)" ::: "memory"); break;
    default: asm volatile("s_waitcnt vmcnt(62)" ::: "memory"); break;
    }
}
__device__ __forceinline__ void phase(const Frame& F, unsigned char* ws, int layer, unsigned long long& ts_sum, unsigned long long& ts_t0) {
    const int wid = F.wave, tid = tid_from(wid), lane = tid & 63, r32 = lane & 31, hi = lane >> 5;
    LAS unsigned char* lds = F.lds;
    const int nU = F.vcu < N_ATTN_BLOCKS ? (N_ATTN_BLOCKS - 1 - F.vcu) / F.G + 1 : 0;
    if (nU == 0) return;
    const int krow = 4 * wid + (lane >> 4), kchunk = (lane & 15) ^ (4 * (wid & 1) + (lane >> 4));
    const int kk = (wid >> 1) * 8 + ((lane & 31) >> 2), vkey = (kk & ~0xC) | ((kk & 4) << 1) | ((kk & 8) >> 1), vcol = ((2 * (wid & 1) + (lane >> 5)) & 3) * 32 + (lane & 3) * 8;
    const unsigned klane = (unsigned)(krow * HD + kchunk * 8) * 2u, vlane = (unsigned)(vkey * HD + vcol) * 2u;
    typedef __attribute__((address_space(3))) unsigned lds_u32;
    const unsigned ldsb = (unsigned)(size_t)lds;
    LAS float* li_l = (LAS float*)(lds + SCR + wid * 256); LAS float* al_l = li_l + 32;
    constexpr float C2 = 1.4426950408889634f * SCALE;
    int koff[4];
#pragma unroll
    for (int dd = 0; dd < 4; ++dd) koff[dd] = W3_KSWZ(r32, (dd * 16 + hi * 8) * 2);
    const unsigned vrb = ldsb + BLK_K + (unsigned)v_rd_base(lane);
    int kI = -1, tI = 5, jI = 0, nbI = 0, issued = 0, consumed = 0, islot = 0, qmark = -1, smark = -1, nst = 0;
    const char* kbI = nullptr; const char* vbI = nullptr;
    bf16x8 qn[8], qr[8];
#define W3_SETUP_I() do { int skv_; const swa::Ref ri = attn_ref(ws, F.vcu + kI * F.G, skv_); \
        const int I0_ = ri.P0, B0_ = (I0_ >= 128 ? I0_ - 128 : 0) >> 5; nbI = ((I0_ + ri.nq - 32) >> 5) - B0_ + 1; tI = 0; jI = 0; \
        kbI = (const char*)(ri.K + (size_t)B0_ * 32 * HD); vbI = (const char*)(ri.V + (size_t)B0_ * 32 * HD); \
        const int qrow_ = 32 * wid < ri.nq ? 32 * wid + r32 : ri.nq - 1; const bf16_t* qp_ = ri.Q + (size_t)qrow_ * HD + hi * 8; \
        _Pragma("unroll") for (int d0 = 0; d0 < 8; ++d0) asm volatile("global_load_dwordx4 %0, %1, off" : "=v"(qn[d0]) : "v"(qp_ + d0 * 16) : "memory"); \
        qmark = issued; } while (0)
#define W3_ISSUE(kC_) do { for (;;) { \
        if (tI >= 5) { if (kI + 1 >= nU || kI >= (kC_) + 1) break; ++kI; W3_SETUP_I(); } \
        if (issued - consumed >= NSLOT) break; \
        __builtin_amdgcn_global_load_lds((const unsigned*)(kbI + (size_t)jI * (32 * HD * 2) + klane), (lds_u32*)(size_t)(ldsb + islot * SLOT + wid * 1024), 16, 0, 2); \
        __builtin_amdgcn_global_load_lds((const unsigned*)(vbI + (size_t)jI * (32 * HD * 2) + vlane), (lds_u32*)(size_t)(ldsb + islot * SLOT + BLK_K + wid * 1024), 16, 0, 2); \
        ++issued; islot = islot == NSLOT - 1 ? 0 : islot + 1; \
        jI += 5; while (tI < 5 && jI >= nbI) { ++tI; jI = tI; } } } while (0)
    asm volatile("s_waitcnt lgkmcnt(0)" ::: "memory"); __builtin_amdgcn_s_barrier(); asm volatile("" ::: "memory");
    W3_ISSUE(-1);
    int spos = 0;
#pragma unroll 1
    for (int kC = 0; kC < nU; ++kC) {
        if (W_TOUCH2 == 2 && kC == nU - 1 && F.vcu < 256 && wid < 3) {
            const int ln_ = tid_from(wid) & 63, cu_ = F.vcu; const char* tp_;
            if (wid == 0) tp_ = (const char*)(ws + OFF_WOUT) + (size_t)layer * D_MODEL * D_MODEL * 2 + ((size_t)cu_ * 64 + ln_) * 128;
            else if (wid == 1) tp_ = (ln_ < 32 ? (const char*)(ws + OFF_WBS) + (size_t)layer * D_MODEL * SSM_W * 2 : (const char*)(ws + OFF_WBA) + (size_t)layer * D_MODEL * ATT_W * 2) + ((size_t)cu_ * 32 + (ln_ & 31)) * 128;
            else tp_ = (const char*)(ws + OFF_WGLU) + (size_t)layer * SSM_W * SSM_W * 2 + ((size_t)cu_ * 16 + (ln_ & 15)) * 128;
            __builtin_amdgcn_global_load_lds((const unsigned*)tp_, (lds_u32*)(size_t)(ldsb + 155648 + wid * 256), 4, 0, 0);
        }
        int skv; const swa::Ref u = attn_ref(ws, F.vcu + kC * F.G, skv);
        const int I0 = u.P0, i0 = I0 + 32 * wid;
        const bool wact = 32 * wid < u.nq;
        const int B0 = (I0 >= 128 ? I0 - 128 : 0) >> 5;
        const int kfirst = i0 >= 128 ? i0 - 128 : 0, nblk = wact ? ((i0 - kfirst) >> 5) + 1 : 0, fw = (kfirst >> 5) - B0;
        const int nbtot = ((I0 + u.nq - 32) >> 5) - B0 + 1;
        float m_reg = -1e30f, l_reg = 0.f; f32x16 o[4] = {};
#pragma unroll 1
        for (int t = 0; t < 5; ++t) {
            const int cnt = t < nbtot ? (nbtot - t + 4) / 5 : 0;
            if (cnt == 0) continue;
            TS_BEGIN(31);
            { const int endp = spos + cnt; wait_vm_ops(2 * (issued - endp) + (qmark >= endp ? 8 : 0) + (smark >= endp ? nst : 0)); }
            asm volatile("s_waitcnt lgkmcnt(0)" ::: "memory"); __builtin_amdgcn_s_barrier(); asm volatile("" ::: "memory");
            if (t == 0) {
                asm volatile("" : "+v"(qn[0]), "+v"(qn[1]), "+v"(qn[2]), "+v"(qn[3]), "+v"(qn[4]), "+v"(qn[5]), "+v"(qn[6]), "+v"(qn[7]));
#pragma unroll
                for (int d0 = 0; d0 < 8; ++d0) qr[d0] = qn[d0];
            }
            TS_END(31); TS_BEGIN(34);
            consumed = spos; W3_ISSUE(kC);
            TS_END(34); TS_BEGIN(32);
            const int rj = (t - fw) % 5, j = fw + (rj < 0 ? rj + 5 : rj);
            if (j < fw + nblk) {
                const int slot = (spos + (j - t) / 5) % NSLOT, k0 = (B0 + j) * 32;
                const LAS unsigned char* kb = lds + slot * SLOT;
                f32x16 p = {};
#pragma unroll
                for (int d0 = 0; d0 < 8; ++d0) { const bf16x8 kf = *(const LAS bf16x8*)(kb + koff[d0 & 3] + (d0 >> 2) * 128);
                    p = __builtin_amdgcn_mfma_f32_32x32x16_bf16(kf, qr[d0], p, 0, 0, 0); }
                if (k0 == i0 || k0 + 128 == i0) {
                    const int dq = i0 + r32 - k0 - 4 * hi; const float NEG = -__builtin_inff();
#pragma unroll
                    for (int r = 0; r < 16; ++r) { const int c = (r & 3) + 8 * (r >> 2); if ((unsigned)(dq - c) >= 129u) p[r] = NEG; }
                }
                float pmax = p[0];
#pragma unroll
                for (int r = 1; r < 16; ++r) pmax = fmaxf(pmax, p[r]);
                { auto rr = __builtin_amdgcn_permlane32_swap(__float_as_uint(pmax), __float_as_uint(pmax), false, false); pmax = fmaxf(__uint_as_float(rr[0]), __uint_as_float(rr[1])); }
                float mn, alpha;
                if (__builtin_expect(__all((pmax - m_reg) * SCALE <= THR), 1)) { mn = m_reg; alpha = 1.f; }
                else { mn = fmaxf(m_reg, pmax); alpha = __builtin_amdgcn_exp2f((m_reg - mn) * C2); m_reg = mn; }
                const float mnL = -mn * C2;
#pragma unroll
                for (int r = 0; r < 16; ++r) p[r] = __builtin_amdgcn_exp2f(fmaf(p[r], C2, mnL));
                float ps = 0.f;
#pragma unroll
                for (int r = 0; r < 16; ++r) ps += p[r];
                { auto rr = __builtin_amdgcn_permlane32_swap(__float_as_uint(ps), __float_as_uint(ps), false, false); ps = __uint_as_float(rr[0]) + __uint_as_float(rr[1]); }
                l_reg = l_reg * alpha + ps;
                bf16x8 pa0, pa1;
#define W3_PK4(B_, OUT) do { unsigned a0 = cvtpk(p[B_+0], p[B_+1]), a1 = cvtpk(p[B_+2], p[B_+3]), b0 = cvtpk(p[B_+4], p[B_+5]), b1 = cvtpk(p[B_+6], p[B_+7]); \
                auto r0 = __builtin_amdgcn_permlane32_swap(a0, b0, false, false); auto r1 = __builtin_amdgcn_permlane32_swap(a1, b1, false, false); \
                u32x4 w = {r0[0], r1[0], r0[1], r1[1]}; OUT = *reinterpret_cast<bf16x8*>(&w); } while (0)
                W3_PK4(0, pa0); W3_PK4(8, pa1);
#undef W3_PK4
                if (__any(alpha < 1.f)) {
                    if (hi == 0) al_l[r32] = alpha;
                    asm volatile("s_waitcnt lgkmcnt(0)" ::: "memory");
#pragma unroll
                    for (int d_ = 0; d_ < 4; ++d_)
#pragma unroll
                        for (int r = 0; r < 16; ++r) o[d_][r] *= al_l[crow(r, hi)];
                }
                const unsigned vb0 = vrb + (unsigned)(slot * SLOT);
#define W3_TR(dst, off) asm volatile("ds_read_b64_tr_b16 %0, %1 offset:%2" : "=&v"(dst) : "v"(vb0), "i"(off) : "memory")
#define W3_PV(d0) do { s16x4 l0, l1, h0, h1; W3_TR(l0, (d0) * 512); W3_TR(h0, (d0) * 512 + 2048); W3_TR(l1, (d0) * 512 + 4096); W3_TR(h1, (d0) * 512 + 6144); \
                asm volatile("s_waitcnt lgkmcnt(0)" ::: "memory"); W3_SBAR(); \
                o[d0] = __builtin_amdgcn_mfma_f32_32x32x16_bf16(pa0, (bf16x8){l0[0], l0[1], l0[2], l0[3], h0[0], h0[1], h0[2], h0[3]}, o[d0], 0, 0, 0); \
                o[d0] = __builtin_amdgcn_mfma_f32_32x32x16_bf16(pa1, (bf16x8){l1[0], l1[1], l1[2], l1[3], h1[0], h1[1], h1[2], h1[3]}, o[d0], 0, 0, 0); } while (0)
                W3_PV(0); W3_PV(1); W3_PV(2); W3_PV(3);
#undef W3_PV
#undef W3_TR
            }
            spos += cnt;
            TS_END(32);
        }
        TS_BEGIN(33);
        if (wact) {
            if (hi == 0) li_l[r32] = l_reg;
            asm volatile("s_waitcnt lgkmcnt(0)" ::: "memory");
            float rli[16];
#pragma unroll
            for (int r = 0; r < 16; ++r) rli[r] = __builtin_amdgcn_rcpf(li_l[crow(r, hi)]);
            { const float lse = m_reg * C2 + __builtin_amdgcn_logf(l_reg); const unsigned lo_ = (unsigned)((32 * wid + r32) * u.lpitch) * 4u;
              asm volatile("global_store_dword %0, %1, %2" :: "v"(lo_), "v"(lse), "s"(u.L) : "memory"); }
            const int OP = u.opitch; const bf16_t* Ow = u.O + (size_t)(32 * wid) * OP;
            const unsigned lane_off = (unsigned)(4 * hi * OP + 4 * r32) * 2u;
#pragma unroll
            for (int r = 0; r < 16; ++r) { const unsigned vo = lane_off + (unsigned)(((r & 3) + 8 * (r >> 2)) * OP) * 2u;
                typedef unsigned u32x2_ __attribute__((ext_vector_type(2)));
                u32x2_ w; w.x = cvtpk(o[0][r] * rli[r], o[1][r] * rli[r]); w.y = cvtpk(o[2][r] * rli[r], o[3][r] * rli[r]);
                asm volatile("global_store_dwordx2 %0, %1, %2" :: "v"(vo), "v"(w), "s"(Ow) : "memory"); }
            smark = issued; nst = 17;
        } else { smark = -1; nst = 0; }
        TS_END(33);
    }
#undef W3_ISSUE
#undef W3_SETUP_I
    asm volatile("s_waitcnt lgkmcnt(0)" ::: "memory"); __builtin_amdgcn_s_barrier(); asm volatile("" ::: "memory");
}
#undef W3_KSWZ
#undef W3_SBAR
}


__device__ __forceinline__ void attn_phase(const Frame& F, unsigned char* ws, int layer, unsigned long long& ts_sum, unsigned long long& ts_t0) {
#if ATTN_DMA == 3
    wsa3::phase(F, ws, layer, ts_sum, ts_t0);
    return;
#endif
#if ATTN_DMA == 2
#if EXP_HALF == 2
    if (F.vcu & 1) return;
    for (int L = F.vcu; L < N_ATTN_BLOCKS; L += F.G) { for (int e = 0; e < 2; ++e) { int skv; const swa::Ref cur = attn_ref(ws, L + e, skv); wsa2::unit(cur, F.lds, F.wave); } }
    return;
#endif
    for (int L = F.vcu; L < N_ATTN_BLOCKS; L += F.G) { int skv; const swa::Ref cur = attn_ref(ws, L, skv); wsa2::unit(cur, F.lds, F.wave); }
    return;
#elif ATTN_DMA == 1
    for (int L = F.vcu; L < N_ATTN_BLOCKS; L += F.G) { int skv; const swa::Ref cur = attn_ref(ws, L, skv); swa::block_dma<bf16_t, bf16_t>(cur, skv, 129, (char*)F.lds, F.wave); }
    return;
#endif
    int L = F.vcu; if (L >= N_ATTN_BLOCKS) return;
    char* lds = (char*)F.lds;
    int skv, skvn; swa::Ref cur = attn_ref(ws, L, skv);
    swa::Seam<bf16_t> S;
    swa::causal_swa_prime<bf16_t, bf16_t>(cur, 129, lds, S, F.wave);
    for (;;) {
        const int Ln = L + F.G; const bool last = Ln >= N_ATTN_BLOCKS;
        swa::Ref nxt = cur; skvn = skv; if (!last) nxt = attn_ref(ws, Ln, skvn);
        swa::causal_swa_block<bf16_t, bf16_t>(cur, nxt, skv, 129, lds, S, F.wave);
        if (last) break;
        cur = nxt; skv = skvn; L = Ln;
    }
}

namespace wsa {
using swa::f32x16; using swa::s16x4; using swa::crow; using swa::cvtpk; using swa::v_st; using swa::v_rd_base; using swa::SCALE; using swa::THR;
constexpr int VBUF = 8192;
constexpr int WAVE_LDS = 2 * VBUF + 256;
struct Item { const bf16_t* Q; const bf16_t* K; const bf16_t* V; bf16_t* O; float* L; int i0, pitch, opitch, lpitch; };
constexpr int N_ITEMS = 3 * 2048;
__device__ __forceinline__ Item decode(unsigned char* ws, int it) {
    const int gi = it >> 11, r = it & 2047, b = r >> 8, h = (r >> 6) & 3;
    int c, qw, d;
    if (gi == 0) { c = 0; qw = r & 63; d = 1; } else if (gi == 1) { c = (r >> 4) & 3; qw = r & 15; d = 4; } else { c = (r >> 2) & 15; qw = r & 3; d = 16; }
    Item x; x.i0 = 32 * qw; x.pitch = HD; x.opitch = d * ATT_W; x.lpitch = d * 4;
    const size_t hb = ((size_t)(gi * BATCH + b) * HPG + h) * SEQ * HD + (size_t)c * (SEQ / d) * HD, kstep = (size_t)3 * BATCH * HPG * SEQ * HD;
    const bf16_t* qkv = (const bf16_t*)(ws + OFF_QKV);
    const size_t tok0 = (size_t)b * SEQ + c + (size_t)x.i0 * d;
    x.Q = qkv + hb + (size_t)x.i0 * HD; x.K = qkv + kstep + hb; x.V = qkv + 2 * kstep + hb;
    x.O = (bf16_t*)(ws + OFF_AO) + ((size_t)gi * MTOK + tok0) * ATT_W + h * HD;
    x.L = (float*)(ws + OFF_ALSE) + ((size_t)gi * MTOK + tok0) * 4 + h;
    return x;
}
#define WSA_SBAR() __builtin_amdgcn_sched_barrier(0)
__device__ __forceinline__ void wave_item(const Item& it, LAS unsigned char* wl, int lane) {
    const int r32 = lane & 31, hi = lane >> 5, pitch = it.pitch;
    LAS float* li_l = (LAS float*)(wl + 2 * VBUF); LAS float* al_l = li_l + 32;
    const int kfirst = it.i0 >= 128 ? it.i0 - 128 : 0, nblk = ((it.i0 - kfirst) >> 5) + 1;
    const bf16_t* qp = it.Q + (size_t)r32 * pitch + hi * 8;
    const bf16_t* kp = it.K + (size_t)(kfirst + r32) * pitch + hi * 8;
    const int vkey = lane >> 4, vch = (lane & 15) * 8;
    const bf16_t* vp = it.V + (size_t)(kfirst + vkey) * pitch + vch;
    int vst_off[8];
#pragma unroll
    for (int i = 0; i < 8; ++i) vst_off[i] = v_st(vkey + 4 * i, vch);
    bf16x8 qr[8], kf[8], vs[8];
#pragma unroll
    for (int d0 = 0; d0 < 8; ++d0) qr[d0] = *(const bf16x8*)(qp + d0 * 16);
#pragma unroll
    for (int d0 = 0; d0 < 8; ++d0) kf[d0] = *(const bf16x8*)(kp + d0 * 16);
#pragma unroll
    for (int i = 0; i < 8; ++i) vs[i] = *(const bf16x8*)(vp + (size_t)(4 * i) * pitch);
#pragma unroll
    for (int i = 0; i < 8; ++i) *(LAS bf16x8*)(wl + vst_off[i]) = vs[i];
    float m_reg = -1e30f, l_reg = 0.f; f32x16 o[4] = {};
    const unsigned vbase = (unsigned)(size_t)wl + (unsigned)v_rd_base(lane);
    constexpr float C2 = 1.4426950408889634f * SCALE;
#pragma unroll 1
    for (int blk = 0; blk < nblk; ++blk) {
        const int k0 = kfirst + 32 * blk; const bool more = blk + 1 < nblk;
        if (more) {
#pragma unroll
            for (int i = 0; i < 8; ++i) vs[i] = *(const bf16x8*)(vp + (size_t)(32 * (blk + 1) + 4 * i) * pitch);
        }
        f32x16 p = {};
#pragma unroll
        for (int d0 = 0; d0 < 8; ++d0) p = __builtin_amdgcn_mfma_f32_32x32x16_bf16(kf[d0], qr[d0], p, 0, 0, 0);
        if (more) {
#pragma unroll
            for (int d0 = 0; d0 < 8; ++d0) kf[d0] = *(const bf16x8*)(kp + (size_t)(32 * (blk + 1)) * pitch + d0 * 16);
        }
        if (k0 == it.i0 || k0 + 128 == it.i0) {
            const int dq = it.i0 + r32 - k0 - 4 * hi; const float NEG = -__builtin_inff();
#pragma unroll
            for (int r = 0; r < 16; ++r) { const int c = (r & 3) + 8 * (r >> 2); if ((unsigned)(dq - c) >= 129u) p[r] = NEG; }
        }
        float pmax = p[0];
#pragma unroll
        for (int r = 1; r < 16; ++r) pmax = fmaxf(pmax, p[r]);
        { auto rr = __builtin_amdgcn_permlane32_swap(__float_as_uint(pmax), __float_as_uint(pmax), false, false); pmax = fmaxf(__uint_as_float(rr[0]), __uint_as_float(rr[1])); }
        float mn, alpha;
        if (__builtin_expect(__all((pmax - m_reg) * SCALE <= THR), 1)) { mn = m_reg; alpha = 1.f; }
        else { mn = fmaxf(m_reg, pmax); alpha = __builtin_amdgcn_exp2f((m_reg - mn) * C2); m_reg = mn; }
        const float mnL = -mn * C2;
#pragma unroll
        for (int r = 0; r < 16; ++r) p[r] = __builtin_amdgcn_exp2f(fmaf(p[r], C2, mnL));
        float ps = 0.f;
#pragma unroll
        for (int r = 0; r < 16; ++r) ps += p[r];
        { auto rr = __builtin_amdgcn_permlane32_swap(__float_as_uint(ps), __float_as_uint(ps), false, false); ps = __uint_as_float(rr[0]) + __uint_as_float(rr[1]); }
        l_reg = l_reg * alpha + ps;
        bf16x8 pa0, pa1;
#define WSA_PK4(B_, OUT) do { unsigned a0 = cvtpk(p[B_+0], p[B_+1]), a1 = cvtpk(p[B_+2], p[B_+3]), b0 = cvtpk(p[B_+4], p[B_+5]), b1 = cvtpk(p[B_+6], p[B_+7]); \
        auto r0 = __builtin_amdgcn_permlane32_swap(a0, b0, false, false); auto r1 = __builtin_amdgcn_permlane32_swap(a1, b1, false, false); \
        u32x4 w = {r0[0], r1[0], r0[1], r1[1]}; OUT = *reinterpret_cast<bf16x8*>(&w); } while (0)
        WSA_PK4(0, pa0); WSA_PK4(8, pa1);
#undef WSA_PK4
        if (__any(alpha < 1.f)) {
            if (hi == 0) al_l[r32] = alpha;
            asm volatile("s_waitcnt lgkmcnt(0)" ::: "memory");
#pragma unroll
            for (int d_ = 0; d_ < 4; ++d_)
#pragma unroll
                for (int r = 0; r < 16; ++r) o[d_][r] *= al_l[crow(r, hi)];
        }
        const unsigned vb0 = vbase + (unsigned)((blk & 1) * VBUF);
#define WSA_TR(dst, off) asm volatile("ds_read_b64_tr_b16 %0, %1 offset:%2" : "=&v"(dst) : "v"(vb0), "i"(off) : "memory")
#define WSA_PV(d0) do { s16x4 l0, l1, h0, h1; WSA_TR(l0, (d0) * 512); WSA_TR(h0, (d0) * 512 + 2048); WSA_TR(l1, (d0) * 512 + 4096); WSA_TR(h1, (d0) * 512 + 6144); \
        asm volatile("s_waitcnt lgkmcnt(0)" ::: "memory"); WSA_SBAR(); \
        o[d0] = __builtin_amdgcn_mfma_f32_32x32x16_bf16(pa0, (bf16x8){l0[0], l0[1], l0[2], l0[3], h0[0], h0[1], h0[2], h0[3]}, o[d0], 0, 0, 0); \
        o[d0] = __builtin_amdgcn_mfma_f32_32x32x16_bf16(pa1, (bf16x8){l1[0], l1[1], l1[2], l1[3], h1[0], h1[1], h1[2], h1[3]}, o[d0], 0, 0, 0); } while (0)
        WSA_PV(0); WSA_PV(1); WSA_PV(2); WSA_PV(3);
#undef WSA_PV
#undef WSA_TR
        if (more) {
            LAS unsigned char* nb = wl + ((blk + 1) & 1) * VBUF;
#pragma unroll
            for (int i = 0; i < 8; ++i) *(LAS bf16x8*)(nb + vst_off[i]) = vs[i];
        }
        asm volatile("s_waitcnt lgkmcnt(0)" ::: "memory");
    }
    if (hi == 0) li_l[r32] = l_reg;
    asm volatile("s_waitcnt lgkmcnt(0)" ::: "memory");
    float rli[16];
#pragma unroll
    for (int r = 0; r < 16; ++r) rli[r] = __builtin_amdgcn_rcpf(li_l[crow(r, hi)]);
    if (hi == 0) it.L[(size_t)r32 * it.lpitch] = m_reg * C2 + __builtin_amdgcn_logf(l_reg);
    const int OP = it.opitch;
#pragma unroll
    for (int r = 0; r < 16; ++r) { const int orow = crow(r, hi);
#pragma unroll
        for (int d0 = 0; d0 < 4; ++d0) { const float v = o[d0][r] * rli[r];
            const float vn = __builtin_bit_cast(float, __builtin_amdgcn_mov_dpp(__builtin_bit_cast(int, v), 0xB1, 0xF, 0xF, true));
            if ((r32 & 1) == 0) *(unsigned*)(it.O + (size_t)orow * OP + d0 * 32 + r32) = cvtpk(v, vn); } }
    asm volatile("s_waitcnt lgkmcnt(0)" ::: "memory");
}
#undef WSA_SBAR
__device__ __forceinline__ void phase(const Frame& F, unsigned char* ws) {
    const int lane = tid_from(F.wave) & 63;
    LAS unsigned char* wl = F.lds + F.wave * WAVE_LDS;
#pragma unroll 1
    for (int it = F.vcu * NWAVES + F.wave; it < N_ITEMS; it += F.G * NWAVES) { const Item x = decode(ws, it); wave_item(x, wl, lane); }
}
}

namespace s5 {
constexpr size_t T_WST = 2 * MiB;
constexpr size_t T_WO = 10 * MiB;
constexpr size_t T_KT = 18 * MiB;
constexpr size_t T_A16 = 20 * MiB;
constexpr int RSTR = 528;
constexpr int U_OFF = 0, L_OFF = 128 * RSTR;
constexpr int LDS_NEED = 2 * 128 * RSTR + 4096;
__device__ __forceinline__ void tables_wg(const Args& a, LAS unsigned char* lds, int lg, int wave_s) {
    typedef float f32x2 __attribute__((ext_vector_type(2)));
    LAS f32x2* PW = (LAS f32x2*)lds; LAS f32x2* BB = PW + 17 * 64; LAS f32x2* CT = BB + 64 * 16;
    const int tid = tid_from(wave_s); unsigned char* ws = a.p.ws;
    if (tid < 64) {
        const int idx = lg * 64 + tid;
        const float lre = fminf(inptr(a, IN_LRE)[idx], -1e-4f), lim = inptr(a, IN_LIM)[idx], dt = expf(inptr(a, IN_LDT)[lg]);
        const float ar = lre * dt, b = lim * dt, ea = expf(ar), sb = sinf(b), cb = cosf(b);
        const float Are = ea * cb, Aim = ea * sb, sh = sinf(0.5f * b);
        const float Dre = expm1f(ar) * cb - 2.0f * sh * sh, Dim = Aim;
        const float den = lre * lre + lim * lim;
        const float cre = (Dre * lre + Dim * lim) / den, cim = (Dim * lre - Dre * lim) / den;
        float* A = (float*)(ws + OFF_S5 + S5_A); float* Bb = (float*)(ws + OFF_S5 + S5_BB);
        A[idx * 2] = Are; A[idx * 2 + 1] = Aim;
        const float* bre = inptr(a, IN_BRE) + idx * 16; const float* bim = inptr(a, IN_BIM) + idx * 16;
        for (int c = 0; c < 16; ++c) { const float br = bre[c], bi = bim[c]; const f32x2 v = {cre * br - cim * bi, cre * bi + cim * br};
            Bb[(idx * 16 + c) * 2] = v.x; Bb[(idx * 16 + c) * 2 + 1] = v.y; BB[tid * 16 + c] = v; }
        float pr = 1.f, pi = 0.f; asm volatile("" : "+v"(pr), "+v"(pi));
        for (int k = 0; k <= 16; ++k) { PW[k * 64 + tid] = (f32x2){pr, pi}; const float nr = pr * Are - pi * Aim, ni = pr * Aim + pi * Are; pr = nr; pi = ni; }
        const f32x2 a16 = PW[16 * 64 + tid];
        ((f32x2*)(ws + OFF_S5 + T_A16))[idx] = a16;
    } else {
        const float* cr = inptr(a, IN_CRE) + (size_t)lg * 1024; const float* ci = inptr(a, IN_CIM) + (size_t)lg * 1024;
        for (int e = tid - 64; e < 1024; e += NTHREADS - 64) { const int c = e >> 6, pp = e & 63; CT[pp * 16 + c] = (f32x2){cr[e], ci[e]}; }
    }
    __syncthreads();
    bf16_t* WST = (bf16_t*)(ws + OFF_S5 + T_WST) + (size_t)lg * 128 * 256;
    for (int e = tid; e < 4096; e += NTHREADS) {
        const int i = e >> 5, kk0 = (e & 31) * 8, s = kk0 >> 4, c0 = kk0 & 15, pp = i & 63; const bool im = i >= 64;
        const f32x2 w = PW[(15 - s) * 64 + pp]; float v[8];
#pragma unroll
        for (int j = 0; j < 8; ++j) { const f32x2 bb = BB[pp * 16 + c0 + j]; v[j] = im ? (w.x * bb.y + w.y * bb.x) : (w.x * bb.x - w.y * bb.y); }
        u32x4 o; o.x = pk2(v[0], v[1]); o.y = pk2(v[2], v[3]); o.z = pk2(v[4], v[5]); o.w = pk2(v[6], v[7]);
        *(u32x4*)(WST + (size_t)((((i >> 4) * 8 + ((e & 31) >> 2)) * 64 + ((e & 31) & 3) * 16 + (i & 15)) * 8)) = o;
    }
    bf16_t* WO = (bf16_t*)(ws + OFF_S5 + T_WO) + (size_t)lg * 256 * 128;
    for (int e = tid; e < 4096; e += NTHREADS) {
        const int row = e >> 4, i0 = (e & 15) * 8, t = row >> 4, c = row & 15; float v[8];
#pragma unroll
        for (int j = 0; j < 8; ++j) { const int ip = i0 + j, pp = ip & 63; const f32x2 cc = CT[pp * 16 + c], w = PW[(t + 1) * 64 + pp];
            v[j] = ip < 64 ? (cc.x * w.x - cc.y * w.y) : -(cc.x * w.y + cc.y * w.x); }
        u32x4 o; o.x = pk2(v[0], v[1]); o.y = pk2(v[2], v[3]); o.z = pk2(v[4], v[5]); o.w = pk2(v[6], v[7]);
        *(u32x4*)(WO + (size_t)(((t * 4 + ((e & 15) >> 2)) * 64 + ((e & 15) & 3) * 16 + c) * 8)) = o;
    }
    bf16_t* KT = (bf16_t*)(ws + OFF_S5 + T_KT) + (size_t)lg * 17 * 256;
    { const int la = tid >> 5, c = (tid >> 1) & 15, h = tid & 1; float acc[8];
#pragma unroll
      for (int j = 0; j < 8; ++j) acc[j] = 0.f;
      for (int pp = 0; pp < 64; ++pp) { const f32x2 cc = CT[pp * 16 + c], w = PW[la * 64 + pp]; const float zr = cc.x * w.x - cc.y * w.y, zi = cc.x * w.y + cc.y * w.x;
#pragma unroll
          for (int j = 0; j < 8; ++j) { const f32x2 bb = BB[pp * 16 + 8 * h + j]; acc[j] += zr * bb.x - zi * bb.y; } }
      u32x4 o; o.x = pk2(acc[0], acc[1]); o.y = pk2(acc[2], acc[3]); o.z = pk2(acc[4], acc[5]); o.w = pk2(acc[6], acc[7]);
      *(u32x4*)(KT + ((la + 1) * 16 + c) * 16 + 8 * h) = o;
      if (tid < 32) { unsigned z_ = 0u; asm volatile("" : "+v"(z_)); *(u32x4*)(KT + tid * 8) = (u32x4){z_, z_, z_, z_}; } }
    __syncthreads();
}
__device__ __forceinline__ void unit(LAS unsigned char* lds, unsigned char* ws, int layer, int b, int g, int wave_s, const float* dsk_l) {
    const int tid = tid_from(wave_s), wave = wave_s, lane = tid & 63, q = lane >> 4, r16 = lane & 15;
    const int lg = layer * 32 + g;
    const bf16_t* usrc = (const bf16_t*)(ws + OFF_UG) + (size_t)(b * SSM_NG + g) * SEQ * 16;
    if (W_TOUCH2 == 1) {
        const int ln_ = tid_from(wave_s) & 63, cu_ = b * SSM_NG + g;
        const char* tp_ = nullptr;
        if (wave == 0) tp_ = (const char*)(ws + OFF_WOUT) + (size_t)layer * D_MODEL * D_MODEL * 2 + ((size_t)cu_ * 64 + ln_) * 128;
        else if (wave == 1) tp_ = (ln_ < 32 ? (const char*)(ws + OFF_WBS) + (size_t)layer * D_MODEL * SSM_W * 2 : (const char*)(ws + OFF_WBA) + (size_t)layer * D_MODEL * ATT_W * 2) + ((size_t)cu_ * 32 + (ln_ & 31)) * 128;
        else if (wave == 2) tp_ = (const char*)(ws + OFF_WGLU) + (size_t)layer * SSM_W * SSM_W * 2 + ((size_t)cu_ * 16 + (ln_ & 15)) * 128;
        if (wave < 3) __builtin_amdgcn_global_load_lds((const unsigned*)tp_, (LAS unsigned*)(lds + 143360 + wave * 256), 4, 0, 0);
    }
    __builtin_amdgcn_s_waitcnt(0);
    bf16x8 uv[8], af[8], kfA[8], wfA[4], kfB[8], wfB[4];
#pragma unroll
    for (int k = 0; k < 8; ++k) uv[k] = __builtin_nontemporal_load((const bf16x8*)(usrc + (size_t)(tid + NTHREADS * k) * 8));
    { const bf16_t* W = (const bf16_t*)(ws + OFF_S5 + T_WST) + (size_t)lg * 128 * 256 + (size_t)(wave * 8 * 64 + lane) * 8;
#pragma unroll
      for (int ks = 0; ks < 8; ++ks) af[ks] = __builtin_nontemporal_load((const bf16x8*)(W + ks * 512));
      const bf16_t* KT = (const bf16_t*)(ws + OFF_S5 + T_KT) + (size_t)lg * 17 * 256;
      const bf16_t* WO = (const bf16_t*)(ws + OFF_S5 + T_WO) + (size_t)lg * 256 * 128;
#pragma unroll
      for (int ks = 0; ks < 8; ++ks) { const int lagA = wave - (2 * ks + (q >> 1)) + 1, lagB = (15 - wave) - (2 * ks + (q >> 1)) + 1;
          kfA[ks] = *(const bf16x8*)(KT + ((lagA > 0 ? lagA : 0) * 16 + r16) * 16 + 8 * (q & 1)); kfB[ks] = *(const bf16x8*)(KT + ((lagB > 0 ? lagB : 0) * 16 + r16) * 16 + 8 * (q & 1)); }
#pragma unroll
      for (int k2 = 0; k2 < 4; ++k2) { wfA[k2] = __builtin_nontemporal_load((const bf16x8*)(WO + (size_t)((wave * 4 + k2) * 64 + lane) * 8)); wfB[k2] = __builtin_nontemporal_load((const bf16x8*)(WO + (size_t)(((15 - wave) * 4 + k2) * 64 + lane) * 8)); } }
#pragma unroll
    for (int k = 0; k < 8; ++k) { const int piece = tid + NTHREADS * k, tok = piece >> 1, half = piece & 1;
        *(LAS bf16x8*)(lds + U_OFF + (tok >> 4) * RSTR + (tok & 15) * 32 + half * 16) = uv[k]; }
    asm volatile("s_waitcnt lgkmcnt(0)" ::: "memory"); __builtin_amdgcn_s_barrier(); asm volatile("" ::: "memory");
    {
      for (int nt = 0; nt < 8; ++nt) {
          f32x4 acc = {0.f, 0.f, 0.f, 0.f};
          const LAS unsigned char* ub = lds + U_OFF + (nt * 16 + r16) * RSTR + q * 16;
#pragma unroll
          for (int ks = 0; ks < 8; ++ks) acc = __builtin_amdgcn_mfma_f32_16x16x32_bf16(af[ks], *(const LAS bf16x8*)(ub + ks * 64), acc, 0, 0, 0);
          *(LAS f32x4*)(lds + L_OFF + (nt * 16 + r16) * RSTR + (wave * 16 + 4 * q) * 4) = acc;
      } }
    asm volatile("s_waitcnt lgkmcnt(0)" ::: "memory"); __builtin_amdgcn_s_barrier(); asm volatile("" ::: "memory");
    {
        typedef float f32x2 __attribute__((ext_vector_type(2)));
        const f32x2 a16 = ((const f32x2*)(ws + OFF_S5 + T_A16))[lg * 64 + lane];
        LAS float* EW = (LAS float*)(lds + 2 * 128 * RSTR);
        float lre[16], lim[16], qre[16], qim[16];
#pragma unroll
        for (int jj = 0; jj < 16; ++jj) { const LAS float* row = (const LAS float*)(lds + L_OFF + (wave * 16 + jj) * RSTR); lre[jj] = row[lane]; lim[jj] = row[64 + lane]; }
        float sre = 0.f, sim = 0.f;
#pragma unroll
        for (int jj = 0; jj < 16; ++jj) { qre[jj] = sre; qim[jj] = sim;
            const float nre = a16.x * sre - a16.y * sim + lre[jj], nim = a16.x * sim + a16.y * sre + lim[jj]; sre = nre; sim = nim; }
        EW[wave * 128 + lane] = sre; EW[wave * 128 + 64 + lane] = sim;
        float pr = a16.x, pi = a16.y;
#pragma unroll
        for (int k = 0; k < 4; ++k) { const float nr = pr * pr - pi * pi, ni = 2.f * pr * pi; pr = nr; pi = ni; }
        __syncthreads();
        float ere[7], eim[7];
#pragma unroll
        for (int v = 0; v < 7; ++v) { ere[v] = EW[v * 128 + lane]; eim[v] = EW[v * 128 + 64 + lane]; }
        float gre = 0.f, gim = 0.f;
#pragma unroll
        for (int v = 0; v < 7; ++v) if (v < wave) { const float nre = pr * gre - pi * gim + ere[v], nim = pr * gim + pi * gre + eim[v]; gre = nre; gim = nim; }
#pragma unroll
        for (int jj = 0; jj < 16; ++jj) {
            LAS bf16_t* row = (LAS bf16_t*)(lds + L_OFF + (wave * 16 + jj) * RSTR);
            row[lane] = f2bf(qre[jj] + gre); row[64 + lane] = f2bf(qim[jj] + gim);
            const float nre = a16.x * gre - a16.y * gim, nim = a16.x * gim + a16.y * gre; gre = nre; gim = nim;
        }
    }
    __syncthreads();
    {
      bf16_t* ypre = (bf16_t*)(ws + OFF_YPRE) + (size_t)b * SEQ * SSM_W + g * 16 + 4 * q;
      const f32x4 dk = *(const f32x4*)(dsk_l + g * 16 + 4 * q);
#pragma unroll
      for (int tt = 0; tt < 2; ++tt) {
          const int t = tt ? 15 - wave : wave, nks = (t >> 1) + 1;
          bf16x8 kf[8], wf[4];
#pragma unroll
          for (int ks = 0; ks < 8; ++ks) kf[ks] = tt ? kfB[ks] : kfA[ks];
#pragma unroll
          for (int k2 = 0; k2 < 4; ++k2) wf[k2] = tt ? wfB[k2] : wfA[k2];
#pragma unroll 1
          for (int nt = 0; nt < 8; ++nt) {
              f32x4 acc = {0.f, 0.f, 0.f, 0.f}, accB = {0.f, 0.f, 0.f, 0.f}, accC = {0.f, 0.f, 0.f, 0.f};
              const LAS unsigned char* ub = lds + U_OFF + (nt * 16 + r16) * RSTR + q * 16;
              const LAS unsigned char* sb = lds + L_OFF + (nt * 16 + r16) * RSTR + q * 16;
#pragma unroll
              for (int ks = 0; ks < 8; ks += 2) { if (ks < nks) acc = __builtin_amdgcn_mfma_f32_16x16x32_bf16(kf[ks], *(const LAS bf16x8*)(ub + ks * 64), acc, 0, 0, 0);
                  if (ks + 1 < nks) accB = __builtin_amdgcn_mfma_f32_16x16x32_bf16(kf[ks + 1], *(const LAS bf16x8*)(ub + (ks + 1) * 64), accB, 0, 0, 0); }
#pragma unroll
              for (int k2 = 0; k2 < 4; ++k2) accC = __builtin_amdgcn_mfma_f32_16x16x32_bf16(wf[k2], *(const LAS bf16x8*)(sb + k2 * 64), accC, 0, 0, 0);
              acc = acc + accB + accC;
              const int tok = 16 * (nt * 16 + r16) + t;
              typedef unsigned u32x2_ __attribute__((ext_vector_type(2)));
              const u32x2_ uu = *(const LAS u32x2_*)(lds + U_OFF + (nt * 16 + r16) * RSTR + t * 32 + q * 8);
              const float y0 = gelu_fast(acc[0] + dk[0] * blo(uu.x)), y1 = gelu_fast(acc[1] + dk[1] * bhi(uu.x)), y2 = gelu_fast(acc[2] + dk[2] * blo(uu.y)), y3 = gelu_fast(acc[3] + dk[3] * bhi(uu.y));
              *(unsigned long long*)(ypre + (size_t)tok * SSM_W) = (unsigned long long)pk2(y0, y1) | ((unsigned long long)pk2(y2, y3) << 32);
          }
      } }
    __syncthreads();
}
}


namespace p4 {
constexpr int XT = 8192, WT = 65536, SLOT = XT + WT;
constexpr int RED_OFF = 2 * SLOT, RED2_OFF = RED_OFF + 2048;
constexpr int JUNK_OFF = RED2_OFF + 2048;
static_assert(JUNK_OFF + 2048 <= MISC_OFF, "P4 LDS map");
constexpr size_t OFF_MG = OFF_T4;
typedef unsigned u32x2 __attribute__((ext_vector_type(2)));
#define P4_WAIT_V(n) asm volatile("s_waitcnt vmcnt(" #n ")" ::: "memory")
#define P4_WAIT_L(n) asm volatile("s_waitcnt lgkmcnt(" #n ")" ::: "memory")
#define P4_BAR __builtin_amdgcn_s_barrier()

struct G64 { const bf16_t* X; const bf16_t* W; int lxs, lws; };
struct Geo { int rr, ch0, foff, wave; };
__device__ __forceinline__ Geo make_geo(int wave, int lane) {
    Geo g; g.rr = lane >> 3; g.ch0 = (lane & 7) ^ (g.rr >> 1); g.wave = wave;
    const int fr = lane & 15, fq = lane >> 4;
    g.foff = fr * 128 + ((fq ^ (fr >> 1)) & 7) * 16;
    return g;
}
__device__ __forceinline__ void stage64_piece(LAS unsigned char* lds, const Geo& g, const G64& d, int kt, int slot, int p) {
    const unsigned ldsw = (unsigned)g.wave * 1024u;
    if (p == 0) { const unsigned vo = ((unsigned)g.rr << d.lxs) + (unsigned)((g.ch0 ^ ((g.wave & 1) << 2)) * 16);
        __builtin_amdgcn_global_load_lds((const unsigned*)((const char*)d.X + (size_t)kt * 128 + ((size_t)(8 * g.wave) << d.lxs) + vo), (LAS unsigned*)(lds + slot * SLOT + ldsw), 16, 0, 0); }
    else { const int i = p - 1; const unsigned vo = ((unsigned)(16 * (g.rr >> 2) + (g.rr & 3)) << d.lws) + (unsigned)((g.ch0 ^ ((i & 1) << 2)) * 16);
        __builtin_amdgcn_global_load_lds((const unsigned*)((const char*)d.W + (size_t)kt * 128 + ((size_t)(64 * g.wave + 32 * (i & 1) + 4 * (i >> 1)) << d.lws) + vo), (LAS unsigned*)(lds + slot * SLOT + XT + ldsw * 8 + i * 1024), 16, 0, 0); }
}
__device__ __forceinline__ void stage64(LAS unsigned char* lds, const Geo& g, const G64& d, int kt, int slot, int parts) {
    if (parts & 1) stage64_piece(lds, g, d, kt, slot, 0);
    if (parts & 2) {
#pragma unroll
        for (int p = 1; p < 9; ++p) stage64_piece(lds, g, d, kt, slot, p);
    }
}
template <int NKT>
__device__ __forceinline__ void run64(f32x4 (&acc)[4][4], LAS unsigned char* lds, const Geo& g, const G64& cur, const G64& nxt, int nparts, int rot, int nrot) {
#define P4_READS(k) do { _Pragma("unroll") for (int m = 0; m < 4; ++m) xf[m] = *(const LAS bf16x8*)(sb + (g.foff ^ ((k) * 64)) + m * 2048); \
        _Pragma("unroll") for (int n = 0; n < 4; ++n) wf[n] = *(const LAS bf16x8*)(sb + XT + g.wave * 8192 + (g.foff ^ ((k) * 64)) + n * 2048); } while (0)
#define P4_MFMA(e) do { acc[((e) >> 2) & 3][(e) & 3] = __builtin_amdgcn_mfma_f32_16x16x32_bf16(wf[(e) & 3], xf[((e) >> 2) & 3], acc[((e) >> 2) & 3][(e) & 3], 0, 0, 0); } while (0)
#pragma unroll 1
    for (int kt = 0; kt + 1 < NKT; ++kt) {
        const int slot = kt & 1, ktn = (kt + 1 + rot) & (NKT - 1);
        P4_WAIT_V(0); P4_WAIT_L(0); P4_BAR;
        const LAS unsigned char* sb = lds + slot * SLOT; bf16x8 xf[4], wf[4];
        P4_READS(0);
#pragma unroll
        for (int i = 0; i < 5; ++i) { P4_MFMA(3 * i); P4_MFMA(3 * i + 1); P4_MFMA(3 * i + 2); stage64_piece(lds, g, cur, ktn, slot ^ 1, i); __builtin_amdgcn_sched_barrier(0); }
        P4_MFMA(15);
        __builtin_amdgcn_sched_barrier(0);
        P4_READS(1);
#pragma unroll
        for (int i = 0; i < 4; ++i) { P4_MFMA(4 * i); P4_MFMA(4 * i + 1); P4_MFMA(4 * i + 2); P4_MFMA(4 * i + 3); stage64_piece(lds, g, cur, ktn, slot ^ 1, 5 + i); __builtin_amdgcn_sched_barrier(0); }
    }
    {   const int kt = NKT - 1, slot = kt & 1;
        P4_WAIT_V(0); P4_WAIT_L(0); P4_BAR;
        if (nparts) stage64(lds, g, nxt, nrot, slot ^ 1, nparts);
        const LAS unsigned char* sb = lds + slot * SLOT; bf16x8 xf[4], wf[4];
#pragma unroll
        for (int k = 0; k < 2; ++k) { P4_READS(k);
#pragma unroll
            for (int e = 0; e < 16; ++e) P4_MFMA(e); }
    }
    P4_WAIT_L(0); P4_BAR;
#undef P4_READS
#undef P4_MFMA
}
__device__ __forceinline__ float sum_q(float v) {
    v += __builtin_bit_cast(float, __builtin_amdgcn_ds_swizzle(__builtin_bit_cast(int, v), 0x401F));
    const auto rr = __builtin_amdgcn_permlane32_swap(__float_as_uint(v), __float_as_uint(v), false, false);
    return __uint_as_float(rr[0]) + __uint_as_float(rr[1]);
}
#define P4_ZERO(A) do { _Pragma("unroll") for (int m_ = 0; m_ < 4; ++m_) _Pragma("unroll") for (int n_ = 0; n_ < 4; ++n_) A[m_][n_] = (f32x4){0.f, 0.f, 0.f, 0.f}; } while (0)

__device__ __forceinline__ void unit(const Args& a, LAS unsigned char* lds, unsigned char* ws, int layer, int u, unsigned long long& ts_sum, unsigned long long& ts_t0, int wave_s, bool dry = false) {
    const int tid = tid_from(wave_s), wave = wave_s, lane = tid & 63, q = lane >> 4, r16 = lane & 15;
    const size_t row0 = (size_t)u * 64;
    const bf16_t* gz = (const bf16_t*)(ws + OFF_GZ);
    const unsigned lo5 = (unsigned)(r16 * SSM_W + 16 * q), lo10 = (unsigned)(r16 * D_MODEL + 16 * q); static_assert(GZ_W == D_MODEL, "lop == lo10");
#define lop lo10
    const bf16_t* projr = gz + row0 * GZ_W;
    const unsigned char* g8r = (const unsigned char*)(ws + OFF_G8) + row0 * G8_W; const unsigned lo8 = (unsigned)(r16 * G8_W + 16 * q);
    bf16_t* Y1 = (bf16_t*)(ws + OFF_YPRE) + row0 * SSM_W;
    bf16_t* YA = (bf16_t*)(ws + OFF_AO) + row0 * ATT_W;
    bf16_t* YS = (bf16_t*)(ws + OFF_AO) + ((size_t)MTOK + row0) * ATT_W;
    bf16_t* MG = (bf16_t*)(ws + OFF_MG) + row0 * D_MODEL;
    if (W_TOUCH && layer + 1 < DEPTH && u < 256) {
        const char* wn_ = (const char*)(ws + OFF_WIN) + (size_t)(layer + 1) * IN_COLS * D_MODEL * 2 + ((size_t)u * 512 + (size_t)wave * 64 + (size_t)(tid_from(wave_s) & 63)) * 128;
        __builtin_amdgcn_global_load_lds((const unsigned*)wn_, (LAS unsigned*)(lds + JUNK_OFF + wave * 256), 4, 0, 0);
    }
    { const Geo geo0 = make_geo(wave, lane); const G64 dGLU0{Y1, (const bf16_t*)(ws + OFF_WGLU) + (size_t)layer * SSM_W * SSM_W, 10, 10}; stage64(lds, geo0, dGLU0, u & 7, 0, 3); }
    TS_BEGIN(41);
    {
        const int cc = (tid & 63) * 8, rb = tid >> 6, j = cc >> 7;
        const bf16_t* ao = (const bf16_t*)(ws + OFF_AO); const float* ls = (const float*)(ws + OFF_ALSE);
#pragma unroll 1
        for (int kb = 0; kb < 8; kb += 4) {
            u32x4 a0[4], a1[4], a2[4], za[4]; float l0[4], l1[4], l2[4];
#pragma unroll
            for (int i = 0; i < 4; ++i) { const int row = rb + 8 * (kb + i); const size_t tok = row0 + row;
                l0[i] = ls[((size_t)0 * MTOK + tok) * 4 + j]; l1[i] = ls[((size_t)1 * MTOK + tok) * 4 + j]; l2[i] = ls[((size_t)2 * MTOK + tok) * 4 + j];
                a0[i] = __builtin_nontemporal_load((const u32x4*)(ao + ((size_t)0 * MTOK + tok) * ATT_W + cc)); a1[i] = __builtin_nontemporal_load((const u32x4*)(ao + ((size_t)1 * MTOK + tok) * ATT_W + cc)); a2[i] = __builtin_nontemporal_load((const u32x4*)(ao + ((size_t)2 * MTOK + tok) * ATT_W + cc));
                za[i] = __builtin_nontemporal_load((const u32x4*)(gz + tok * GZ_W + GZ_ZA + cc)); }
#pragma unroll
            for (int i = 0; i < 4; ++i) { const int row = rb + 8 * (kb + i);
                const float mx = fmaxf(l0[i], fmaxf(l1[i], l2[i])); float w0 = __builtin_amdgcn_exp2f(l0[i] - mx), w1 = __builtin_amdgcn_exp2f(l1[i] - mx), w2 = __builtin_amdgcn_exp2f(l2[i] - mx);
                const float iw = __builtin_amdgcn_rcpf(w0 + w1 + w2); w0 *= iw; w1 *= iw; w2 *= iw;
#define MRG(A0, A1, A2, Z) pk2((w0 * blo(A0) + w1 * blo(A1) + w2 * blo(A2)) * blo(Z), (w0 * bhi(A0) + w1 * bhi(A1) + w2 * bhi(A2)) * bhi(Z))
                u32x4 y; y.x = MRG(a0[i].x, a1[i].x, a2[i].x, za[i].x); y.y = MRG(a0[i].y, a1[i].y, a2[i].y, za[i].y); y.z = MRG(a0[i].z, a1[i].z, a2[i].z, za[i].z); y.w = MRG(a0[i].w, a1[i].w, a2[i].w, za[i].w);
#undef MRG
                *(u32x4*)(YA + (size_t)row * ATT_W + cc) = y; }
        }
    }
    VM_WAIT(); __syncthreads();
    TS_END(41); TS_BEGIN(42);
    const int nbw = wave * 64;
    const int r8 = u & 7, r16t = u & 15;
    const Geo geo = make_geo(wave, lane);
    const G64 dGLU{Y1, (const bf16_t*)(ws + OFF_WGLU) + (size_t)layer * SSM_W * SSM_W, 10, 10};
    const bf16_t* WBSl = (const bf16_t*)(ws + OFF_WBS) + (size_t)layer * D_MODEL * SSM_W; const bf16_t* WBAl = (const bf16_t*)(ws + OFF_WBA) + (size_t)layer * D_MODEL * ATT_W;
    const bf16_t* WOl = (const bf16_t*)(ws + OFF_WOUT) + (size_t)layer * D_MODEL * D_MODEL;
    const G64 dOUT0{MG, WOl, 11, 11}, dOUT1{MG, WOl + (size_t)512 * D_MODEL, 11, 11};
    {
        f32x4 acc[4][4]; P4_ZERO(acc);
        const G64 dBS0{YS, WBSl, 10, 10};
        const float* bg = inptr(a, IN_BGLU) + layer * SSM_W;
        f32x4 b4[4];
#pragma unroll
        for (int n = 0; n < 4; ++n) b4[n] = *(const f32x4*)(bg + (nbw + n * 4) + (unsigned)(((tid_from(wave_s) >> 4) & 3) * 16));
        run64<8>(acc, lds, geo, dGLU, dBS0, 2, r8, r8);
        {   u32x4 y1[4][2], zs[4][2];
#pragma unroll
            for (int m = 0; m < 4; ++m)
#pragma unroll
                for (int h = 0; h < 2; ++h) { y1[m][h] = *(const u32x4*)(Y1 + (m * 16 * SSM_W + nbw + h * 8) + lo5); zs[m][h] = __builtin_nontemporal_load((const u32x4*)(projr + (GZ_ZS + m * 16 * GZ_W + nbw + h * 8) + lop)); }
#pragma unroll
            for (int m = 0; m < 4; ++m) { u32x4 o[2];
#pragma unroll
                for (int n = 0; n < 4; ++n) { const unsigned yx = y1[m][n >> 1][(n & 1) * 2], yy = y1[m][n >> 1][(n & 1) * 2 + 1], zx = zs[m][n >> 1][(n & 1) * 2], zy = zs[m][n >> 1][(n & 1) * 2 + 1];
                    o[n >> 1][(n & 1) * 2] = pk2(blo(yx) * sig_fast(acc[m][n][0] + b4[n][0]) * blo(zx), bhi(yx) * sig_fast(acc[m][n][1] + b4[n][1]) * bhi(zx));
                    o[n >> 1][(n & 1) * 2 + 1] = pk2(blo(yy) * sig_fast(acc[m][n][2] + b4[n][2]) * blo(zy), bhi(yy) * sig_fast(acc[m][n][3] + b4[n][3]) * bhi(zy)); }
#pragma unroll
                for (int h = 0; h < 2; ++h) *(u32x4*)(YS + (m * 16 * SSM_W + nbw + h * 8) + lo5) = o[h]; }
        }
        VM_WAIT(); __syncthreads();
        stage64(lds, geo, dBS0, r8, 0, 1);
    }
    TS_END(42); TS_BEGIN(43);
#pragma unroll 1
    for (int ps = 0; ps < 2; ++ps) {
        f32x4 as[4][4], aa[4][4]; P4_ZERO(as); P4_ZERO(aa);
        const G64 dBS{YS, WBSl + (size_t)ps * 512 * SSM_W, 10, 10}, dBA{YA, WBAl + (size_t)ps * 512 * ATT_W, 10, 10};
        const G64 dBSn{YS, WBSl + (size_t)512 * SSM_W, 10, 10};
        run64<8>(as, lds, geo, dBS, dBA, 3, r8, r8);
        if (ps == 0) run64<8>(aa, lds, geo, dBA, dBSn, 3, r8, r8);
        else run64<8>(aa, lds, geo, dBA, dOUT0, 2, r8, r16t);
        {   u32x4 gs[4], ga[4];
#pragma unroll
            for (int m = 0; m < 4; ++m) { const int bo = m * 16 * G8_W + ps * 512 + nbw; gs[m] = __builtin_nontemporal_load((const u32x4*)(g8r + (G8_GS + bo) + lo8)); ga[m] = __builtin_nontemporal_load((const u32x4*)(g8r + (G8_GA + bo) + lo8)); }
#define P4_UB(w, e) ((float)(((w) >> (8 * (e))) & 0xffu) * (1.0f / 255.0f))
#pragma unroll
            for (int m = 0; m < 4; ++m) { u32x4 o[2];
#pragma unroll
                for (int n = 0; n < 4; ++n) { const unsigned gsw = gs[m][n], gaw = ga[m][n];
                    o[n >> 1][(n & 1) * 2] = pk2(P4_UB(gsw, 0) * as[m][n][0] + P4_UB(gaw, 0) * aa[m][n][0], P4_UB(gsw, 1) * as[m][n][1] + P4_UB(gaw, 1) * aa[m][n][1]);
                    o[n >> 1][(n & 1) * 2 + 1] = pk2(P4_UB(gsw, 2) * as[m][n][2] + P4_UB(gaw, 2) * aa[m][n][2], P4_UB(gsw, 3) * as[m][n][3] + P4_UB(gaw, 3) * aa[m][n][3]); }
#pragma unroll
                for (int h = 0; h < 2; ++h) *(u32x4*)(MG + (m * 16 * D_MODEL + ps * 512 + nbw + h * 8) + lo10) = o[h]; }
#undef P4_UB
        }
    }
    VM_WAIT(); __syncthreads();
    stage64(lds, geo, dOUT0, r16t, 0, 1);
    TS_END(43); TS_BEGIN(44);
    {
        f32x4 acc0[4][4], acc1[4][4]; P4_ZERO(acc0); P4_ZERO(acc1);
        run64<16>(acc0, lds, geo, dOUT0, dOUT1, 3, r16t, r16t);
        run64<16>(acc1, lds, geo, dOUT1, dOUT1, 0, r16t, 0);
        TS_END(44); TS_BEGIN(45);
        LAS float* RED = (LAS float*)(lds + RED_OFF); LAS float* RED2 = (LAS float*)(lds + RED2_OFF);
        float inv[4];
#pragma unroll
        for (int m = 0; m < 4; ++m) { float s = 0.f;
#pragma unroll
            for (int n = 0; n < 4; ++n) { s += (acc0[m][n][0] * acc0[m][n][0] + acc0[m][n][1] * acc0[m][n][1]) + (acc0[m][n][2] * acc0[m][n][2] + acc0[m][n][3] * acc0[m][n][3]);
                                          s += (acc1[m][n][0] * acc1[m][n][0] + acc1[m][n][1] * acc1[m][n][1]) + (acc1[m][n][2] * acc1[m][n][2] + acc1[m][n][3] * acc1[m][n][3]); }
            s = sum_q(s); if (q == 0) RED[(m * 16 + r16) * 8 + wave] = s; }
        __syncthreads();
#pragma unroll
        for (int m = 0; m < 4; ++m) { const LAS f32x4* rp = (const LAS f32x4*)(RED + (m * 16 + r16) * 8); const f32x4 r0 = rp[0], r1 = rp[1];
            inv[m] = rsqrtf(((r0[0] + r0[1]) + (r0[2] + r0[3]) + (r1[0] + r1[1]) + (r1[2] + r1[3])) * (1.0f / D_MODEL) + RMS_EPS); }
        const float* pg = inptr(a, IN_POSTG) + layer * D_MODEL; float* xor_ = a.p.out + row0 * D_MODEL; bf16_t* xbr = (bf16_t*)(ws + OFF_XB) + row0 * D_MODEL;
        float s2[4] = {0.f, 0.f, 0.f, 0.f};
        const unsigned lq4 = (unsigned)(((tid_from(wave_s) >> 4) & 3) * 16);
#define P4_RES(ACC, PS) do { f32x4 g4[4]; u32x4 xp[4][2]; \
            _Pragma("unroll") for (int n = 0; n < 4; ++n) g4[n] = *(const f32x4*)(pg + ((PS) * 512 + nbw + n * 4) + lq4); \
            _Pragma("unroll") for (int m = 0; m < 4; ++m) _Pragma("unroll") for (int h = 0; h < 2; ++h) xp[m][h] = *(const u32x4*)(xbr + (m * 16 * D_MODEL + (PS) * 512 + nbw + h * 8) + lo10); \
            __builtin_amdgcn_s_waitcnt(0);     \
            _Pragma("unroll") for (int m = 0; m < 4; ++m) { u32x4 o[2]; \
                _Pragma("unroll") for (int n = 0; n < 4; ++n) { const int bo = m * 16 * D_MODEL + (PS) * 512 + nbw + n * 4; const unsigned px = xp[m][n >> 1][(n & 1) * 2], py = xp[m][n >> 1][(n & 1) * 2 + 1]; \
                    f32x4 xv = {blo(px), bhi(px), blo(py), bhi(py)}; xv = xv + ACC[m][n] * inv[m] * g4[n]; \
                    o[n >> 1][(n & 1) * 2] = pk2(xv[0], xv[1]); o[n >> 1][(n & 1) * 2 + 1] = pk2(xv[2], xv[3]); \
                    if (!dry && layer == DEPTH - 1) *(f32x4*)(xor_ + bo + lo10) = xv; \
                    s2[m] += (xv[0] * xv[0] + xv[1] * xv[1]) + (xv[2] * xv[2] + xv[3] * xv[3]); } \
                if (!dry) { if (layer != DEPTH - 1) { _Pragma("unroll") for (int h = 0; h < 2; ++h) *(u32x4*)(xbr + (m * 16 * D_MODEL + (PS) * 512 + nbw + h * 8) + lo10) = o[h]; } } \
                else { asm volatile("" :: "v"(o[0].x), "v"(o[0].y), "v"(o[1].x), "v"(o[1].y)); } } } while (0)
        P4_RES(acc0, 0); P4_RES(acc1, 1);
#undef P4_RES
#pragma unroll
        for (int m = 0; m < 4; ++m) { const float s = sum_q(s2[m]); if (q == 0) RED2[(m * 16 + r16) * 8 + wave] = s; }
        __syncthreads();
        if (wave == 0 && !dry) { const int tl = tid_from(wave_s) & 63;
            const LAS f32x4* rp = (const LAS f32x4*)(RED2 + tl * 8); const f32x4 r0 = rp[0], r1 = rp[1];
            ((float*)(ws + OFF_ROWSS))[row0 + tl] = (r0[0] + r0[1]) + (r0[2] + r0[3]) + (r1[0] + r1[1]) + (r1[2] + r1[3]); }
    }
    VM_WAIT(); __syncthreads();
    TS_END(45);
}
#undef P4_ZERO
#undef lop
}

__device__ __forceinline__ void p0_transpose_item(const float* W, const float* rs, int K, int N, bf16_t* WT, LAS float* scr, int item, int lane, bool vperm, bool ntst) {
    const int nblk = N / 32, kb = item / nblk, nb = item % nblk, k0 = 64 * kb, n0 = 32 * nb;
    const int kr = lane >> 3, n4 = (lane & 7) * 4;
    f32x4 v[8];
#pragma unroll
    for (int i = 0; i < 8; ++i) v[i] = __builtin_nontemporal_load((const f32x4*)(W + (size_t)(k0 + 8 * i + kr) * N + n0 + n4));
    if (rs) {
#pragma unroll
        for (int i = 0; i < 8; ++i) v[i] = v[i] * rs[k0 + 8 * i + kr];
    }
#pragma unroll
    for (int i = 0; i < 8; ++i) { LAS float* d = scr + (8 * i + kr) * 33 + n4; d[0] = v[i][0]; d[1] = v[i][1]; d[2] = v[i][2]; d[3] = v[i][3]; }
    LDS_WAIT(); asm volatile("" ::: "memory");
    const int c = lane & 7;
#pragma unroll
    for (int j = 0; j < 4; ++j) { const int n = (lane >> 3) + 8 * j; const LAS float* s = scr + (8 * c) * 33 + n;
        u32x4 o; o.x = pk2(s[0 * 33], s[1 * 33]); o.y = pk2(s[2 * 33], s[3 * 33]); o.z = pk2(s[4 * 33], s[5 * 33]); o.w = pk2(s[6 * 33], s[7 * 33]);
        int nd = n0 + n;
        if (vperm && nd >= C_V && nd < C_ZA) { const int cc = nd & 127; nd = (nd & ~127) + (cc & 3) * 32 + (cc >> 2); }
        if (ntst) __builtin_nontemporal_store(o, (u32x4*)(WT + (size_t)nd * K + k0 + 8 * c)); else *(u32x4*)(WT + (size_t)nd * K + k0 + 8 * c) = o; }
    LDS_WAIT(); asm volatile("" ::: "memory");
}
__device__ __forceinline__ void p0_prologue(const Frame& F, const Args& a) {
    const int lane_ = tid_from(F.wave) & 63;
    LAS float* scr = (LAS float*)(F.lds + F.wave * 16384);
    const int gw = F.vcu * NWAVES + F.wave, NGW = F.G * NWAVES;
    constexpr int I_IN = (D_MODEL / 64) * (IN_COLS / 32), I_GLU = (SSM_W / 64) * (SSM_W / 32), I_BS = (SSM_W / 64) * (D_MODEL / 32), I_OUT = (D_MODEL / 64) * (D_MODEL / 32);
    constexpr int PER_L = I_IN + I_GLU + 2 * I_BS + I_OUT, NITEMS = DEPTH * PER_L;
    unsigned char* ws = a.p.ws;
    for (int lg = F.vcu; lg < DEPTH * SSM_NG; lg += F.G) s5::tables_wg(a, F.lds, lg, F.wave);
    constexpr int NTAB = DEPTH * SSM_NG, RA = 7;
    const bool bal = F.G > NTAB && RA * NGW < NITEMS;
    const int NA = bal ? RA * NGW : NITEMS, gw2 = gw - NTAB * NWAVES, NGW2 = (F.G - NTAB) * NWAVES;
    for (int k = 0; ; ++k) {
        const int it = (!bal || k < RA) ? gw + k * NGW : (gw2 >= 0 ? NA + gw2 + (k - RA) * NGW2 : NITEMS);
        if (it >= NITEMS || (bal && k < RA && it >= NA)) break;
        const int l = it / PER_L; int r = it - l * PER_L;
        int widx, K, N; size_t dst;
        if (r < I_IN) { widx = IN_WIN; K = D_MODEL; N = IN_COLS; dst = OFF_WIN; }
        else if ((r -= I_IN) < I_GLU) { widx = IN_WGLU; K = SSM_W; N = SSM_W; dst = OFF_WGLU; }
        else if ((r -= I_GLU) < I_BS) { widx = IN_WBS; K = SSM_W; N = D_MODEL; dst = OFF_WBS; }
        else if ((r -= I_BS) < I_BS) { widx = IN_WBA; K = ATT_W; N = D_MODEL; dst = OFF_WBA; }
        else { r -= I_BS; widx = IN_WOUT; K = D_MODEL; N = D_MODEL; dst = OFF_WOUT; }
        const float* W = inptr(a, widx) + (size_t)l * K * N;
        const float* rs = (widx == IN_WIN) ? inptr(a, IN_PREG) + l * D_MODEL : nullptr;
        p0_transpose_item(W, rs, K, N, (bf16_t*)(ws + dst) + (size_t)l * K * N, scr, r, lane_, ATTN_DMA == 3 && widx == IN_WIN, l > 0);
    }
    const float* X = inptr(a, IN_X);
    for (int m = gw; m < MTOK; m += 2 * NGW) {
        const int m1 = m + NGW; const bool has1 = m1 < MTOK;
        const f32x4* xr0 = (const f32x4*)(X + (size_t)m * D_MODEL) + lane_; const f32x4* xr1 = (const f32x4*)(X + (size_t)(has1 ? m1 : m) * D_MODEL) + lane_;
        f32x4 v0[4], v1[4];
#pragma unroll
        for (int j = 0; j < 4; ++j) { v0[j] = __builtin_nontemporal_load(xr0 + 64 * j); v1[j] = __builtin_nontemporal_load(xr1 + 64 * j); }
#pragma unroll
        for (int r = 0; r < 2; ++r) {
            if (r == 1 && !has1) break;
            const int mm = r ? m1 : m;
            unsigned long long* o8 = (unsigned long long*)((bf16_t*)(ws + OFF_XB) + (size_t)mm * D_MODEL) + lane_;
            float sq = 0.f;
#pragma unroll
            for (int j = 0; j < 4; ++j) { const f32x4 v = r ? v1[j] : v0[j]; sq += (v[0] * v[0] + v[1] * v[1]) + (v[2] * v[2] + v[3] * v[3]);
                o8[64 * j] = (unsigned long long)pk2(v[0], v[1]) | ((unsigned long long)pk2(v[2], v[3]) << 32); }
            sq = wave_sum(sq);
            if (lane_ == 0) ((float*)(ws + OFF_ROWSS))[mm] = sq;
        }
    }
}

constexpr int N_PHASES = 1 + 3 * DEPTH;
__global__ void __launch_bounds__(NTHREADS, 2) mega(Args a) {
    extern __shared__ __attribute__((aligned(16))) unsigned char lds_raw[];
    Frame F; F.lds = (LAS unsigned char*)lds_raw; F.wave = __builtin_amdgcn_readfirstlane((int)threadIdx.x >> 6);
    F.G = gridDim.x; { const int bx = blockIdx.x; F.vcu = (F.G % 8 == 0) ? (bx % 8) * (F.G / 8) + bx / 8 : bx; }
    volatile LAS unsigned* MISC = (volatile LAS unsigned*)(F.lds + MISC_OFF);
    { const int t0_ = tid_from(F.wave); if (t0_ < 64) MISC[t0_] = 0u; }
    __syncthreads();
    const bool grouped = (F.G % 8 == 0) && (a.ph_lo == 0) && (a.ph_hi == N_PHASES);
    unsigned* bw = (unsigned*)(a.p.ws + OFF_CTL) + CW_BAR + a.bar_region * XCD_BAR_WORDS;
    XcdBarrier gbar = xcd_barrier_post(bw, MISC + 8, F.wave, (unsigned)F.G);
    XcdBarrier lbar = gbar;
    if (grouped) lbar = xcd_barrier_post(bw + (1 + (blockIdx.x & 7)) * XCD_BAR_WORDS, MISC + 10, F.wave, (unsigned)F.G / 8u);
    unsigned long long ts_sum = 0, ts_t0 = 0;
    TS_BEGIN(100);
    for (int ph = a.ph_lo; ph < a.ph_hi; ++ph) {
        TS_BEGIN(9); if (ph > 0 && (ph - 1) % 3 == 0) TS_BEGIN(93); if (ph > 0 && (ph - 1) % 3 == 1) TS_BEGIN(91); if (ph > 0 && (ph - 1) % 3 == 2) TS_BEGIN(92);
        if (ph > a.ph_lo) {
            if (ph == 1 || !grouped) xcd_barrier(gbar);
            else if (BAR_TOUCH && F.vcu < 256) {
                const int l_ = (ph - 1) / 3, k_ = (ph - 1) % 3; size_t wq_ = 0; asm volatile("" : "+s"(wq_)); const char* wsb = (const char*)a.p.ws + wq_;
                BarTouch bt; for (int r = 0; r < 6; ++r) { bt.p[r] = wsb; bt.n[r] = 0; }
                if (k_ == 1 && BAR_TOUCH_S5) {
                    const size_t lg_ = (size_t)l_ * 32 + (F.vcu & 31);
                    bt.p[0] = wsb + OFF_S5 + s5::T_WST + lg_ * 128 * 256 * 2; bt.n[0] = 512; bt.p[1] = wsb + OFF_S5 + s5::T_WO + lg_ * 256 * 128 * 2; bt.n[1] = 512;
                    bt.p[2] = wsb + OFF_S5 + s5::T_KT + lg_ * 17 * 256 * 2; bt.n[2] = 68;
                } else if (k_ == 2) {
                    bt.p[0] = wsb + OFF_WOUT + (size_t)l_ * D_MODEL * D_MODEL * 2 + (size_t)F.vcu * 64 * 128; bt.n[0] = 64;
                    bt.p[1] = wsb + OFF_WBS + (size_t)l_ * D_MODEL * SSM_W * 2 + (size_t)F.vcu * 32 * 128; bt.n[1] = 32;
                    bt.p[2] = wsb + OFF_WBA + (size_t)l_ * D_MODEL * ATT_W * 2 + (size_t)F.vcu * 32 * 128; bt.n[2] = 32;
                    bt.p[3] = wsb + OFF_WGLU + (size_t)l_ * SSM_W * SSM_W * 2 + (size_t)F.vcu * 16 * 128; bt.n[3] = 16;
                    if (l_ + 1 < DEPTH) { bt.p[4] = wsb + OFF_WIN + (size_t)(l_ + 1) * IN_COLS * D_MODEL * 2 + (size_t)F.vcu * 512 * 128; bt.n[4] = 512; }
                }
                xcd_barrier(lbar, &bt, F.lds);
            }
            else xcd_barrier(lbar);
        }
        if (GRP_DELAY_NS != 0 && grouped && ph == 1) {
            const unsigned long long ticks_ = (unsigned long long)((blockIdx.x & 7) % GRP_DELAY_MOD) * (GRP_DELAY_NS / 10), t0_ = __builtin_amdgcn_s_memrealtime();
            while (__builtin_amdgcn_s_memrealtime() - t0_ < ticks_) __builtin_amdgcn_s_sleep(8);
        }
        TS_END(9); if (ph > 0 && (ph - 1) % 3 == 0) TS_END(93); if (ph > 0 && (ph - 1) % 3 == 1) TS_END(91); if (ph > 0 && (ph - 1) % 3 == 2) TS_END(92);
#if PROBE_DUP == 6
        if (ph > a.ph_lo) { if (ph == 1 || !grouped) xcd_barrier(gbar); else xcd_barrier(lbar); }
#endif
        size_t wz_ = 0; asm volatile("" : "+s"(wz_)); unsigned char* ws = a.p.ws + wz_;
        int vcu_ = F.vcu; asm volatile("" : "+s"(vcu_));
        Frame Fp; Fp.lds = F.lds; Fp.wave = F.wave; Fp.G = F.G; Fp.vcu = vcu_;
#if PROBE_DUP == 5
        if (ph == 0) {
#pragma unroll 1
            for (int rep = 0; rep < 2; ++rep) { p0_prologue(Fp, a); __syncthreads(); }
            continue; }
#endif
        if (ph == 0) { TS_BEGIN(10); p0_prologue(Fp, a); TS_END(10); continue; }
        const int l = (ph - 1) / 3, k = (ph - 1) % 3;
        if (k == 0) {
            TS_BEGIN(1); if (l == 0) TS_BEGIN(18); if (l == 3) TS_BEGIN(19);
            pg8::Gemm g{(const bf16_t*)(ws + OFF_XB), (const bf16_t*)(ws + OFF_WIN) + (size_t)l * IN_COLS * D_MODEL, MTOK, IN_COLS, D_MODEL};
            int bid_ = blockIdx.x; asm volatile("" : "+s"(bid_));
            pg8::StaticOrder S; S.init(MTOK, IN_COLS, Fp.G, bid_);
            pg8::EpiInProj E{ws, (const float*)(ws + OFF_ROWSS)};
#if PROBE_DUP == 1
#pragma unroll 1
            for (int rep = 0; rep < 2; ++rep)
#endif
            pg8::gemm_phase<pg8::EpiInProj, pg8::StaticOrder, true, true>(Fp.lds, g, S, E, Fp.wave, ts_sum, ts_t0);
            TS_END(1); if (l == 0) TS_END(18); if (l == 3) TS_END(19);
        }
#if EXP_HALF
        else if (EXP_HALF == 1 && (blockIdx.x & 7) >= 4) { }
#endif
        else if (k == 1) {
            TS_BEGIN(2);
#if PROBE_DUP == 2
#pragma unroll 1
            for (int rep = 0; rep < 2; ++rep)
#endif
            for (int u = Fp.vcu; u < BATCH * SSM_NG; u += Fp.G) s5::unit(Fp.lds, ws, l, u >> 5, u & 31, Fp.wave, inptr(a, IN_DSKIP) + l * SSM_W);
            TS_END(2); TS_BEGIN(3);
#if PROBE_DUP == 3
#pragma unroll 1
            for (int rep = 0; rep < 2; ++rep)
#endif
#if ATTN_WAVE
            wsa::phase(Fp, ws);
            __syncthreads();
#else
            attn_phase(Fp, ws, l, ts_sum, ts_t0);
#endif
            TS_END(3);
        }
        else {
            TS_BEGIN(4);
#if PROBE_DUP == 4
#pragma unroll 1
            for (int rep = 0; rep < 2; ++rep)
            for (int u = Fp.vcu; u < MTOK / 64; u += Fp.G) p4::unit(a, Fp.lds, ws, l, u, ts_sum, ts_t0, Fp.wave, rep == 0);
#else
#if EXP_HALF == 2
            if (!(Fp.vcu & 1)) for (int u = Fp.vcu; u < MTOK / 64; u += Fp.G) { for (int e = 0; e < 2; ++e) p4::unit(a, Fp.lds, ws, l, u + e, ts_sum, ts_t0, Fp.wave); }
#else
            for (int u = Fp.vcu; u < MTOK / 64; u += Fp.G) p4::unit(a, Fp.lds, ws, l, u, ts_sum, ts_t0, Fp.wave);
#endif
#endif
            TS_END(4);
        }
    }
    TS_END(100);
    if (TS_ID != 0 && blockIdx.x == 0 && tid_from(F.wave) == 0) { asm volatile("s_waitcnt vmcnt(0)" ::: "memory"); a.p.out[0] += (float)ts_sum * 0.001f; }
}

#ifndef ONE_LAUNCH
#define ONE_LAUNCH 1
#endif
#ifndef OPT_P0
#define OPT_P0 1
#endif
#ifndef OPT_P1
#define OPT_P1 1
#endif
#ifndef OPT_P2
#define OPT_P2 1
#endif
#ifndef OPT_P4
#define OPT_P4 1
#endif
extern "C" void kernel_launch(void* const* d_in, const int* in_sizes, int n_in, void* d_out, int out_size, void* d_ws, size_t ws_size, hipStream_t stream) {
    static int grid = 0;
    if (grid == 0) {
        if (n_in != 17 || out_size != MTOK * D_MODEL || ws_size < WS_END) { fprintf(stderr, "kernel_launch: unexpected shapes/workspace (n_in %d out %d ws %zu)\n", n_in, out_size, ws_size); grid = -1; return; }
        int dev = 0, cus = 0, per_cu = 0;
        if (hipGetDevice(&dev) != hipSuccess || hipDeviceGetAttribute(&cus, hipDeviceAttributeMultiprocessorCount, dev) != hipSuccess) { grid = -1; return; }
        if (hipFuncSetAttribute((const void*)mega, hipFuncAttributeMaxDynamicSharedMemorySize, LDS_BYTES) != hipSuccess) { fprintf(stderr, "kernel_launch: hipFuncSetAttribute failed\n"); grid = -1; return; }
        if (hipOccupancyMaxActiveBlocksPerMultiprocessor(&per_cu, (const void*)mega, NTHREADS, LDS_BYTES) != hipSuccess || per_cu < 1) { fprintf(stderr, "kernel_launch: occupancy query says %d blocks/CU\n", per_cu); per_cu = 1; }
        (void)hipGetLastError();
        grid = cus * (per_cu < 1 ? 1 : 1);
    }
    if (grid < 0) return;
    Params p{};
    for (int i = 0; i < N_IN; ++i) p.in[i] = (const float*)d_in[i];
    p.out = (float*)d_out; p.ws = (unsigned char*)d_ws;
    unsigned char* ws = p.ws;
#if ONE_LAUNCH
    (void)hipMemsetAsync(ws + OFF_CTL + (size_t)CW_BAR * 4, 0, (size_t)9 * XCD_BAR_WORDS * 4, stream);
#else
    (void)hipMemsetAsync(ws + OFF_CTL, 0, CTL_ZERO_BYTES, stream);
#endif
#if EXP_MEMSET2
    (void)hipMemsetAsync(ws + OFF_T2, 0, CTL_ZERO_BYTES, stream);
#endif
    int bar_region = 0;
    auto launch_mega = [&](int lo, int hi) { Args a{}; a.p = p; a.ph_lo = lo; a.ph_hi = hi; a.bar_region = bar_region++; a.pad = 0;
        hipLaunchKernelGGL(mega, dim3(grid), dim3(NTHREADS), LDS_BYTES, stream, a); };
    bf16_t* WIN = (bf16_t*)(ws + OFF_WIN); bf16_t* WGLU = (bf16_t*)(ws + OFF_WGLU); bf16_t* WBS = (bf16_t*)(ws + OFF_WBS); bf16_t* WBA = (bf16_t*)(ws + OFF_WBA); bf16_t* WOUT = (bf16_t*)(ws + OFF_WOUT);
    bf16_t* XB = (bf16_t*)(ws + OFF_XB); bf16_t* PROJ = (bf16_t*)(ws + OFF_PROJ); bf16_t* YPRE = (bf16_t*)(ws + OFF_YPRE); bf16_t* AO = (bf16_t*)(ws + OFF_AO);
    bf16_t* T2 = (bf16_t*)(ws + OFF_T2); bf16_t* T4 = (bf16_t*)(ws + OFF_T4); bf16_t* T5 = AO + (size_t)MTOK * ATT_W; float* OUTF = (float*)(ws + OFF_PROJ);
    const float* ROWSS = (const float*)(ws + OFF_ROWSS);
#if ONE_LAUNCH
    launch_mega(0, N_PHASES);
    return;
#endif
#if OPT_P0
    launch_mega(0, 1);
#else
    const dim3 tb(32, 8);
    for (int l = 0; l < DEPTH; ++l) {
        nv::k_transpose<<<dim3(IN_COLS / 32, D_MODEL / 32), tb, 0, stream>>>(p.in[IN_WIN] + (size_t)l * D_MODEL * IN_COLS, p.in[IN_PREG] + l * D_MODEL, WIN + (size_t)l * IN_COLS * D_MODEL, D_MODEL, IN_COLS);
        nv::k_transpose<<<dim3(SSM_W / 32, SSM_W / 32), tb, 0, stream>>>(p.in[IN_WGLU] + (size_t)l * SSM_W * SSM_W, nullptr, WGLU + (size_t)l * SSM_W * SSM_W, SSM_W, SSM_W);
        nv::k_transpose<<<dim3(D_MODEL / 32, SSM_W / 32), tb, 0, stream>>>(p.in[IN_WBS] + (size_t)l * SSM_W * D_MODEL, nullptr, WBS + (size_t)l * D_MODEL * SSM_W, SSM_W, D_MODEL);
        nv::k_transpose<<<dim3(D_MODEL / 32, ATT_W / 32), tb, 0, stream>>>(p.in[IN_WBA] + (size_t)l * ATT_W * D_MODEL, nullptr, WBA + (size_t)l * D_MODEL * ATT_W, ATT_W, D_MODEL);
        nv::k_transpose<<<dim3(D_MODEL / 32, D_MODEL / 32), tb, 0, stream>>>(p.in[IN_WOUT] + (size_t)l * D_MODEL * D_MODEL, nullptr, WOUT + (size_t)l * D_MODEL * D_MODEL, D_MODEL, D_MODEL);
    }
    nv::k_s5_tables<<<DEPTH * SSM_NG, 64, 0, stream>>>(p);
    nv::k_rows_x<<<MTOK, 256, 0, stream>>>(p);
#endif
    for (int l = 0; l < DEPTH; ++l) {
#if OPT_P1
        launch_mega(1 + 3 * l, 2 + 3 * l);
#else
        nv::k_gemm<nv::EpiInProj><<<dim3(IN_COLS / 128, MTOK / 128), 256, 0, stream>>>(XB, D_MODEL, WIN + (size_t)l * IN_COLS * D_MODEL, D_MODEL, D_MODEL, nv::EpiInProj{ROWSS, PROJ});
#endif
#if OPT_P2
        launch_mega(2 + 3 * l, 3 + 3 * l);
#else
        nv::k_attn<<<MTOK * 12 / 4, 256, 0, stream>>>(p);
        nv::k_s5<<<BATCH * SSM_NG, 64, 0, stream>>>(p, l);
#endif
#if OPT_P4
        launch_mega(3 + 3 * l, 4 + 3 * l);
#else
        nv::k_p4a<<<MTOK * SSM_W / 256, 256, 0, stream>>>(p, l);
        nv::k_gemm<nv::EpiGlu><<<dim3(SSM_W / 128, MTOK / 128), 256, 0, stream>>>(YPRE, SSM_W, WGLU + (size_t)l * SSM_W * SSM_W, SSM_W, SSM_W, nv::EpiGlu{YPRE, PROJ, p.in[IN_BGLU] + l * SSM_W, T2});
        nv::k_merge<<<MTOK * ATT_W / 256, 256, 0, stream>>>(p);
        nv::k_gemm<nv::EpiGate1><<<dim3(D_MODEL / 128, MTOK / 128), 256, 0, stream>>>(T2, SSM_W, WBS + (size_t)l * D_MODEL * SSM_W, SSM_W, SSM_W, nv::EpiGate1{PROJ, T4});
        nv::k_gemm<nv::EpiGate2><<<dim3(D_MODEL / 128, MTOK / 128), 256, 0, stream>>>(AO, ATT_W, WBA + (size_t)l * D_MODEL * ATT_W, ATT_W, ATT_W, nv::EpiGate2{PROJ, T4, T5});
        nv::k_gemm<nv::EpiF32><<<dim3(D_MODEL / 128, MTOK / 128), 256, 0, stream>>>(T5, D_MODEL, WOUT + (size_t)l * D_MODEL * D_MODEL, D_MODEL, D_MODEL, nv::EpiF32{OUTF, D_MODEL});
        nv::k_postnorm<<<MTOK, 256, 0, stream>>>(p, l, OUTF);
#endif
    }
}
```

```cpp
#include <hip/hip_runtime.h>
#include <cstdio>
#include <cstdint>
#ifndef ATTN_DMA
#define ATTN_DMA 3
#endif
#ifndef ATTN_WAVE
#define ATTN_WAVE 0
#endif
#ifndef EXP_MEMSET2
#define EXP_MEMSET2 0
#endif
#ifndef EXP_HALF
#define EXP_HALF 0
#endif
#ifndef EXP_NOSTORE
#define EXP_NOSTORE 0
#endif
#ifndef TS_ID
#define TS_ID 0
#endif
#ifndef P1_NT
#define P1_NT 0
#endif
#ifndef P1_SHAPE
#define P1_SHAPE 1
#endif
#ifndef BAR_TOUCH_S5
#define BAR_TOUCH_S5 0
#endif
#ifndef BAR_TOUCH
#define BAR_TOUCH 1
#endif
#ifndef W_TOUCH
#define W_TOUCH (!BAR_TOUCH)
#endif
#ifndef W_TOUCH2
#define W_TOUCH2 (BAR_TOUCH ? 0 : 2)
#endif
#ifndef SEAM_RELAX
#define SEAM_RELAX 1
#endif
#ifndef GRP_DELAY_NS
#define GRP_DELAY_NS 0
#endif
#ifndef GRP_DELAY_MOD
#define GRP_DELAY_MOD 2
#endif
#define TS_BEGIN(id) do { if (TS_ID == (id)) ts_t0 = __builtin_amdgcn_s_memrealtime(); } while (0)
#define TS_END(id) do { if (TS_ID == (id)) ts_sum += __builtin_amdgcn_s_memrealtime() - ts_t0; } while (0)

constexpr int D_MODEL = 1024, BATCH = 8, SEQ = 2048, DEPTH = 4, MTOK = BATCH * SEQ;
constexpr int SSM_W = 512, SSM_CH = 16, SSM_NG = 32, SSM_P = 64;
constexpr int HD = 128, HPG = 4, NGRP = 3, ATT_W = 512, IN_COLS = 8192;
constexpr int C_US = 0, C_ZS = 512, C_Q = 1024, C_K = 2560, C_V = 4096, C_ZA = 5632, C_GS = 6144, C_GA = 7168;
constexpr int GZ_W = 1024, GZ_ZS = 0, GZ_ZA = 512, G8_W = 2048, G8_GS = 0, G8_GA = 1024;
constexpr float RMS_EPS = 1e-6f;
constexpr float ATT_C2 = 0.08838834764831845f * 1.4426950408889634f;

constexpr size_t MiB = 1u << 20;
constexpr size_t OFF_CTL = 0;
constexpr size_t OFF_WIN = 370 * MiB;
constexpr size_t OFF_WGLU = 434 * MiB;
constexpr size_t OFF_WBS = 436 * MiB;
constexpr size_t OFF_WBA = 440 * MiB;
constexpr size_t OFF_WOUT = 444 * MiB;
constexpr size_t OFF_S5 = 452 * MiB;
constexpr size_t OFF_XB = 473 * MiB;
constexpr size_t OFF_ROWSS = 505 * MiB;
constexpr size_t OFF_PROJ = 1 * MiB;
constexpr size_t OFF_GZ = OFF_PROJ, OFF_G8 = OFF_PROJ + 32 * MiB, OFF_QKV = OFF_PROJ + 96 * MiB;
constexpr size_t OFF_YPRE = 257 * MiB;
constexpr size_t OFF_AO = 273 * MiB;
constexpr size_t OFF_ALSE = 321 * MiB;
constexpr size_t OFF_T2 = 322 * MiB;
constexpr size_t OFF_UG = OFF_T2;
constexpr size_t OFF_T4 = 338 * MiB;
constexpr size_t WS_END = 506 * MiB;
constexpr size_t S5_A = 0;
constexpr size_t S5_BB = 1 * MiB;

typedef unsigned short bf16_t;
typedef short bf16x8 __attribute__((ext_vector_type(8)));
typedef float f32x4 __attribute__((ext_vector_type(4)));
typedef unsigned u32x4 __attribute__((ext_vector_type(4)));

__device__ __forceinline__ float bf2f(bf16_t h) { return __uint_as_float(((unsigned)h) << 16); }
__device__ __forceinline__ bf16_t f2bf(float f) { unsigned u = __float_as_uint(f); return (bf16_t)((u + 0x7fffu + ((u >> 16) & 1u)) >> 16); }
__device__ __forceinline__ float sigmoidf_(float v) { return 1.0f / (1.0f + __expf(-v)); }
__device__ __forceinline__ float siluf_(float v) { return v / (1.0f + __expf(-v)); }
__device__ __forceinline__ float gelu_tanh(float x) {
    const float z = 0.7978845608028654f * (x + 0.044715f * x * x * x);
    const float t = 1.0f - 2.0f / (1.0f + __expf(2.0f * z));
    return 0.5f * x * (1.0f + t);
}
__device__ __forceinline__ float wave_sum(float v) {
    v += __builtin_bit_cast(float, __builtin_amdgcn_ds_swizzle(__builtin_bit_cast(int, v), 0x041F));
    v += __builtin_bit_cast(float, __builtin_amdgcn_ds_swizzle(__builtin_bit_cast(int, v), 0x081F));
    v += __builtin_bit_cast(float, __builtin_amdgcn_ds_swizzle(__builtin_bit_cast(int, v), 0x101F));
    v += __builtin_bit_cast(float, __builtin_amdgcn_ds_swizzle(__builtin_bit_cast(int, v), 0x201F));
    v += __builtin_bit_cast(float, __builtin_amdgcn_ds_swizzle(__builtin_bit_cast(int, v), 0x401F));
    const auto rr = __builtin_amdgcn_permlane32_swap(__float_as_uint(v), __float_as_uint(v), false, false);
    return __uint_as_float(rr[0]) + __uint_as_float(rr[1]);
}
__device__ __forceinline__ float sig_fast(float v) { return __builtin_amdgcn_rcpf(1.0f + __builtin_amdgcn_exp2f(-1.4426950408889634f * v)); }
__device__ __forceinline__ float gelu_fast(float x) {
    const float z2 = 1.5957691216057308f * (x + 0.044715f * x * x * x);
    return x * sig_fast(z2);
}
__device__ __forceinline__ float blo(unsigned w) { return __uint_as_float(w << 16); }
__device__ __forceinline__ float bhi(unsigned w) { return __uint_as_float(w & 0xffff0000u); }
enum { IN_X = 0, IN_PREG, IN_WIN, IN_LRE, IN_LIM, IN_LDT, IN_BRE, IN_BIM, IN_CRE, IN_CIM, IN_DSKIP, IN_WGLU, IN_BGLU, IN_WBS, IN_WBA, IN_WOUT, IN_POSTG, N_IN };
struct Params { const float* in[N_IN]; float* out; unsigned char* ws; };
__device__ __forceinline__ int tid_from(int wave_s) { unsigned z = 0u; asm volatile("" : "+v"(z)); return (wave_s << 6) | (int)__builtin_amdgcn_mbcnt_hi(~0u, __builtin_amdgcn_mbcnt_lo(~0u, z)); }

namespace nv {
__global__ void k_transpose(const float* __restrict__ W, const float* __restrict__ rs, bf16_t* __restrict__ Wt, int K, int N) {
    __shared__ float tile[32][33];
    const int n0 = blockIdx.x * 32, k0 = blockIdx.y * 32, tx = threadIdx.x, ty = threadIdx.y;
    for (int i = ty; i < 32; i += 8) { const int k = k0 + i; tile[i][tx] = W[(size_t)k * N + n0 + tx] * (rs ? rs[k] : 1.0f); }
    __syncthreads();
    for (int i = ty; i < 32; i += 8) { const int n = n0 + i; Wt[(size_t)n * K + k0 + tx] = f2bf(tile[tx][i]); }
}
__global__ void k_s5_tables(Params p) {
    const int lg = blockIdx.x, pp = threadIdx.x, idx = lg * 64 + pp;
    const float lre = fminf(p.in[IN_LRE][idx], -1e-4f), lim = p.in[IN_LIM][idx], dt = expf(p.in[IN_LDT][lg]);
    const float a = lre * dt, b = lim * dt, ea = expf(a), sb = sinf(b), cb = cosf(b);
    const float Are = ea * cb, Aim = ea * sb, sh = sinf(0.5f * b);
    const float Dre = expm1f(a) * cb - 2.0f * sh * sh, Dim = Aim;
    const float den = lre * lre + lim * lim;
    const float cre = (Dre * lre + Dim * lim) / den, cim = (Dim * lre - Dre * lim) / den;
    float* A = (float*)(p.ws + OFF_S5 + S5_A); float* Bb = (float*)(p.ws + OFF_S5 + S5_BB);
    A[idx * 2] = Are; A[idx * 2 + 1] = Aim;
    for (int c = 0; c < 16; ++c) { const float br = p.in[IN_BRE][idx * 16 + c], bi = p.in[IN_BIM][idx * 16 + c];
        Bb[(idx * 16 + c) * 2] = cre * br - cim * bi; Bb[(idx * 16 + c) * 2 + 1] = cre * bi + cim * br; }
}
__global__ void k_rows_x(Params p) {
    const int row = blockIdx.x, t = threadIdx.x;
    const f32x4 v = ((const f32x4*)(p.in[IN_X] + (size_t)row * D_MODEL))[t];
    ((f32x4*)(p.out + (size_t)row * D_MODEL))[t] = v;
    bf16_t* xb = (bf16_t*)(p.ws + OFF_XB) + (size_t)row * D_MODEL + t * 4;
    xb[0] = f2bf(v[0]); xb[1] = f2bf(v[1]); xb[2] = f2bf(v[2]); xb[3] = f2bf(v[3]);
    float ss = wave_sum(v[0] * v[0] + v[1] * v[1] + v[2] * v[2] + v[3] * v[3]);
    __shared__ float s[4];
    if ((t & 63) == 0) s[t >> 6] = ss;
    __syncthreads();
    if (t == 0) ((float*)(p.ws + OFF_ROWSS))[row] = s[0] + s[1] + s[2] + s[3];
}
template <class Epi> __global__ __launch_bounds__(256) void k_gemm(const bf16_t* __restrict__ A, int lda, const bf16_t* __restrict__ Bt, int ldb, int K, Epi epi) {
    const int tid = threadIdx.x, wave = tid >> 6, lane = tid & 63, wr = wave >> 1, wc = wave & 1;
    const int row0 = blockIdx.y * 128 + wr * 64, col0 = blockIdx.x * 128 + wc * 64;
    f32x4 acc[4][4];
    for (int i = 0; i < 4; ++i) for (int j = 0; j < 4; ++j) acc[i][j] = (f32x4){0.f, 0.f, 0.f, 0.f};
    const bf16_t* ap = A + (size_t)(row0 + (lane & 15)) * lda + 8 * (lane >> 4);
    const bf16_t* bp = Bt + (size_t)(col0 + (lane & 15)) * ldb + 8 * (lane >> 4);
    for (int k0 = 0; k0 < K; k0 += 32) {
        bf16x8 a[4], b[4];
#pragma unroll
        for (int i = 0; i < 4; ++i) { a[i] = *(const bf16x8*)(ap + (size_t)i * 16 * lda + k0); b[i] = *(const bf16x8*)(bp + (size_t)i * 16 * ldb + k0); }
#pragma unroll
        for (int i = 0; i < 4; ++i)
#pragma unroll
            for (int j = 0; j < 4; ++j) acc[i][j] = __builtin_amdgcn_mfma_f32_16x16x32_bf16(a[i], b[j], acc[i][j], 0, 0, 0);
    }
#pragma unroll
    for (int i = 0; i < 4; ++i)
#pragma unroll
        for (int j = 0; j < 4; ++j)
#pragma unroll
            for (int r = 0; r < 4; ++r) epi(row0 + i * 16 + (lane >> 4) * 4 + r, col0 + j * 16 + (lane & 15), acc[i][j][r]);
}
struct EpiInProj { const float* rowss; bf16_t* proj;
    __device__ void operator()(int row, int col, float acc) const {
        float v = acc * rsqrtf(rowss[row] * (1.0f / D_MODEL) + RMS_EPS);
        if ((col >= C_ZS && col < C_Q) || (col >= C_ZA && col < C_GS)) v = siluf_(v);
        else if (col >= C_GS) v = sigmoidf_(v);
        proj[(size_t)row * IN_COLS + col] = f2bf(v);
    } };
struct EpiGlu { const bf16_t* y1; const bf16_t* proj; const float* b_glu; bf16_t* ys;
    __device__ void operator()(int row, int col, float acc) const {
        const float gate = sigmoidf_(acc + b_glu[col]);
        ys[(size_t)row * SSM_W + col] = f2bf(bf2f(y1[(size_t)row * SSM_W + col]) * gate * bf2f(proj[(size_t)row * IN_COLS + C_ZS + col]));
    } };
struct EpiGate1 { const bf16_t* proj; bf16_t* m1;
    __device__ void operator()(int row, int col, float acc) const { m1[(size_t)row * D_MODEL + col] = f2bf(bf2f(proj[(size_t)row * IN_COLS + C_GS + col]) * acc); } };
struct EpiGate2 { const bf16_t* proj; const bf16_t* m1; bf16_t* mg;
    __device__ void operator()(int row, int col, float acc) const {
        mg[(size_t)row * D_MODEL + col] = f2bf(bf2f(m1[(size_t)row * D_MODEL + col]) + bf2f(proj[(size_t)row * IN_COLS + C_GA + col]) * acc); } };
struct EpiF32 { float* C; int ldc;
    __device__ void operator()(int row, int col, float acc) const { C[(size_t)row * ldc + col] = acc; } };

__global__ __launch_bounds__(256) void k_attn(Params p) {
    const int wave = threadIdx.x >> 6, lane = threadIdx.x & 63;
    const long wid = (long)blockIdx.x * 4 + wave;
    const int j = (int)(wid & 3), gi = (int)((wid >> 2) % 3), tok = (int)(wid / 12);
    const int d = gi == 0 ? 1 : (gi == 1 ? 4 : 16);
    const int t = tok % SEQ, i = t / d;
    const bf16_t* proj = (const bf16_t*)(p.ws + OFF_PROJ);
    const int hc = (gi * 4 + j) * HD + 2 * lane;
    const unsigned qq = *(const unsigned*)(proj + (size_t)tok * IN_COLS + C_Q + hc);
    const float q0 = bf2f((bf16_t)(qq & 0xffff)), q1 = bf2f((bf16_t)(qq >> 16));
    float m = -1e30f, l = 0.f, o0 = 0.f, o1 = 0.f;
    const int nk = i < 128 ? i : 128;
    for (int jj = nk; jj >= 0; --jj) {
        const size_t kt = (size_t)(tok - jj * d);
        const unsigned kk = *(const unsigned*)(proj + kt * IN_COLS + C_K + hc);
        const unsigned vv = *(const unsigned*)(proj + kt * IN_COLS + C_V + hc);
        float s = q0 * bf2f((bf16_t)(kk & 0xffff)) + q1 * bf2f((bf16_t)(kk >> 16));
        s = wave_sum(s) * ATT_C2;
        const float mn = fmaxf(m, s), al = exp2f(m - mn), pr = exp2f(s - mn);
        l = l * al + pr; o0 = o0 * al + pr * bf2f((bf16_t)(vv & 0xffff)); o1 = o1 * al + pr * bf2f((bf16_t)(vv >> 16)); m = mn;
    }
    const float il = 1.0f / l;
    bf16_t* ao = (bf16_t*)(p.ws + OFF_AO) + ((size_t)gi * MTOK + tok) * ATT_W + j * HD + 2 * lane;
    *(unsigned*)ao = (unsigned)f2bf(o0 * il) | ((unsigned)f2bf(o1 * il) << 16);
    if (lane == 0) ((float*)(p.ws + OFF_ALSE))[((size_t)gi * MTOK + tok) * 4 + j] = m + log2f(l);
}
__global__ __launch_bounds__(64) void k_s5(Params p, int layer) {
    const int b = blockIdx.x >> 5, g = blockIdx.x & 31, lane = threadIdx.x;
    const int idx = ((layer * 32 + g) * 64 + lane);
    const float* A = (const float*)(p.ws + OFF_S5 + S5_A); const float* Bb = (const float*)(p.ws + OFF_S5 + S5_BB);
    const float Are = A[idx * 2], Aim = A[idx * 2 + 1];
    float bre[16], bim[16], cre[16], cim[16];
#pragma unroll
    for (int c = 0; c < 16; ++c) { bre[c] = Bb[(idx * 16 + c) * 2]; bim[c] = Bb[(idx * 16 + c) * 2 + 1];
        cre[c] = p.in[IN_CRE][(size_t)((layer * 32 + g) * 16 + c) * 64 + lane]; cim[c] = p.in[IN_CIM][(size_t)((layer * 32 + g) * 16 + c) * 64 + lane]; }
    const bf16_t* proj = (const bf16_t*)(p.ws + OFF_PROJ); bf16_t* ypre = (bf16_t*)(p.ws + OFF_YPRE);
    float sre = 0.f, sim = 0.f;
    for (int t = 0; t < SEQ; ++t) {
        const size_t tok = (size_t)b * SEQ + t;
        const bf16x8 u0 = *(const bf16x8*)(proj + tok * IN_COLS + C_US + g * 16), u1 = *(const bf16x8*)(proj + tok * IN_COLS + C_US + g * 16 + 8);
        float dre = 0.f, dim = 0.f;
#pragma unroll
        for (int c = 0; c < 8; ++c) { const float ua = bf2f((bf16_t)u0[c]), ub = bf2f((bf16_t)u1[c]);
            dre += bre[c] * ua + bre[c + 8] * ub; dim += bim[c] * ua + bim[c + 8] * ub; }
        const float nre = Are * sre - Aim * sim + dre, nim = Are * sim + Aim * sre + dim;
        sre = nre; sim = nim;
        float mine = 0.f;
#pragma unroll
        for (int c = 0; c < 16; ++c) { const float y = wave_sum(cre[c] * sre - cim[c] * sim); if (lane == c) mine = y; }
        if (lane < 16) ypre[tok * SSM_W + g * 16 + lane] = f2bf(mine);
    }
}
__global__ void k_p4a(Params p, int layer) {
    const size_t e = (size_t)blockIdx.x * 256 + threadIdx.x; const size_t row = e >> 9; const int col = (int)(e & 511);
    bf16_t* ypre = (bf16_t*)(p.ws + OFF_YPRE); const bf16_t* proj = (const bf16_t*)(p.ws + OFF_PROJ);
    const float y0 = bf2f(ypre[e]) + p.in[IN_DSKIP][layer * SSM_W + col] * bf2f(proj[row * IN_COLS + C_US + col]);
    ypre[e] = f2bf(gelu_tanh(y0));
}
__global__ void k_merge(Params p) {
    const size_t e = (size_t)blockIdx.x * 256 + threadIdx.x; const size_t row = e >> 9; const int col = (int)(e & 511), j = col >> 7;
    bf16_t* ao = (bf16_t*)(p.ws + OFF_AO); const float* ls = (const float*)(p.ws + OFF_ALSE); const bf16_t* proj = (const bf16_t*)(p.ws + OFF_PROJ);
    const float l0 = ls[((size_t)0 * MTOK + row) * 4 + j], l1 = ls[((size_t)1 * MTOK + row) * 4 + j], l2 = ls[((size_t)2 * MTOK + row) * 4 + j];
    const float mx = fmaxf(l0, fmaxf(l1, l2)), w0 = exp2f(l0 - mx), w1 = exp2f(l1 - mx), w2 = exp2f(l2 - mx);
    const float y = (w0 * bf2f(ao[e]) + w1 * bf2f(ao[(size_t)MTOK * ATT_W + e]) + w2 * bf2f(ao[(size_t)2 * MTOK * ATT_W + e])) / (w0 + w1 + w2);
    ao[e] = f2bf(y * bf2f(proj[row * IN_COLS + C_ZA + col]));
}
__global__ void k_postnorm(Params p, int layer, const float* o) {
    const int row = blockIdx.x, t = threadIdx.x;
    const f32x4 v = ((const f32x4*)(o + (size_t)row * D_MODEL))[t];
    __shared__ float s[4], s2[4];
    float ss = wave_sum(v[0] * v[0] + v[1] * v[1] + v[2] * v[2] + v[3] * v[3]);
    if ((t & 63) == 0) s[t >> 6] = ss;
    __syncthreads();
    const float inv = rsqrtf((s[0] + s[1] + s[2] + s[3]) * (1.0f / D_MODEL) + RMS_EPS);
    const f32x4 g = ((const f32x4*)(p.in[IN_POSTG] + layer * D_MODEL))[t];
    f32x4 xv = ((f32x4*)(p.out + (size_t)row * D_MODEL))[t];
    xv = xv + v * inv * g;
    ((f32x4*)(p.out + (size_t)row * D_MODEL))[t] = xv;
    bf16_t* xb = (bf16_t*)(p.ws + OFF_XB) + (size_t)row * D_MODEL + t * 4;
    xb[0] = f2bf(xv[0]); xb[1] = f2bf(xv[1]); xb[2] = f2bf(xv[2]); xb[3] = f2bf(xv[3]);
    float q = wave_sum(xv[0] * xv[0] + xv[1] * xv[1] + xv[2] * xv[2] + xv[3] * xv[3]);
    if ((t & 63) == 0) s2[t >> 6] = q;
    __syncthreads();
    if (t == 0) ((float*)(p.ws + OFF_ROWSS))[row] = s2[0] + s2[1] + s2[2] + s2[3];
}
}

namespace pg8 {
#define PG8_LAS __attribute__((address_space(3)))
typedef unsigned short bf16_t;
typedef short bf16x8 __attribute__((ext_vector_type(8)));
typedef float f32x4 __attribute__((ext_vector_type(4)));
typedef unsigned u32x4 __attribute__((ext_vector_type(4)));
constexpr int BM = 256, BK = 64, HALF = 128, HTB = HALF * BK * 2  , STAGE_BYTES = 8 * HTB, NXCD = 8, WGM = 8;

__host__ __device__ __forceinline__ int lds_byte(int r, int c) { const int st = (r >> 4) * 2 + (c >> 5), rr = r & 15, cc = c & 31, ob = rr * 64 + cc * 2; return st * 1024 + (ob ^ (((ob >> 9) & 1) << 5)); }
__host__ __device__ __forceinline__ void stage_rc(int b, int& R, int& C) { const int st = b / 1024, sb = b % 1024, swz = sb ^ (((sb >> 9) & 1) << 5); R = (st >> 1) * 16 + swz / 64; C = (st & 1) * 32 + (swz % 64) / 2; }
__host__ __device__ __forceinline__ int perm32(int rho) { const int n = rho >> 4, i = rho & 15; return 8 * (i >> 2) + 4 * n + (i & 3); }

struct Unit { int pm, pn; };
struct Gemm { const bf16_t* A; const bf16_t* Bt; int M, N, K; };

struct StaticOrder {
    int nM, nN, nwg, G, c;
    __host__ __device__ void init(int M, int N, int G_, int c_) { nM = M / BM; nN = N / BM; nwg = nM * nN; G = G_; c = c_; }
    __host__ __device__ bool next(int i, Unit& u) const {
        const long L = (long)i * G + c; if (L >= nwg) return false;
        int wgid = (int)L; { const int q = nwg / NXCD, r = nwg % NXCD, xcd = wgid % NXCD, off = wgid / NXCD; wgid = (xcd < r ? xcd * (q + 1) : r * (q + 1) + (xcd - r) * q) + off; }
        const int nig = WGM * nN, gid = wgid / nig, fm = gid * WGM, gsz = (nM - fm) < WGM ? (nM - fm) : WGM;
        u.pm = fm + ((wgid % nig) % gsz); u.pn = (wgid % nig) / gsz;
        if (P1_SHAPE && G == 256 && nM == 64 && nN == 32) {
            const int b = c % 8, j = c / 8;
            u.pm = b * 8 + 4 * (i >> 2) + (j & 3); u.pn = 8 * ((i + b) & 3) + (j >> 2);
        }
        return true;
    }
    __device__ __forceinline__ void a_ready(const Unit&) const {}
    __device__ __forceinline__ void done(const Unit&) const {}
};

__device__ __forceinline__ unsigned cvt_pk_bf16(float lo, float hi) { unsigned r; asm volatile("v_cvt_pk_bf16_f32 %0, %1, %2" : "=v"(r) : "v"(lo), "v"(hi)); return r; }
template <class Epi, class Sched, bool ALIGN_EPI = false, bool SP2 = false>
__device__ __forceinline__ void gemm_phase(PG8_LAS unsigned char* lds, const Gemm g, const Sched& S, const Epi& E, int wave_s, unsigned long long& ts_sum, unsigned long long& ts_t0) {
    const int tid = tid_from(wave_s), wid = wave_s, lane = tid & 63, wr = wid >> 2, wc = wid & 3, fr = lane & 15, fq = lane >> 4;
    const int K = g.K, nt = K / BK;
    unsigned voffA[2], voffB[2];
#pragma unroll
    for (int i = 0; i < 2; ++i) { int R, C; stage_rc(tid * 16 + i * 8192, R, C); const int Rb = Epi::PERM ? ((R & ~31) + perm32(R & 31)) : R;
        voffA[i] = (unsigned)(R * K + C) * 2u; voffB[i] = (unsigned)(Rb * K + C) * 2u; }
    const size_t kstep = (size_t)(BK * 2);
    const size_t hstep = (size_t)HALF * K * 2;
    const size_t tstep = 2 * hstep;
    const unsigned ldsw = (unsigned)wid * 1024u;
    const int aoff = lds_byte(wr * 64 + fr, fq * 8), boff = lds_byte(wc * 32 + fr, fq * 8);
#define PG8_SA(b, h) (((b) * 2 + (h)) * HTB)
#define PG8_SB(b, h) ((4 + (b) * 2 + (h)) * HTB)
#define PG8_STAGE(bufoff, gbase, voff) do { _Pragma("unroll") for (int _i = 0; _i < 2; ++_i) \
        __builtin_amdgcn_global_load_lds((const unsigned*)((const char*)(gbase) + (voff)[_i]), (PG8_LAS unsigned*)(lds + (bufoff) + ldsw + _i * 8192), 16, 0, 0); } while (0)
#define PG8_LDA(dst, b, h) do { _Pragma("unroll") for (int m = 0; m < 4; ++m) _Pragma("unroll") for (int k = 0; k < 2; ++k) dst[m][k] = *(const PG8_LAS bf16x8*)(lds + PG8_SA(b, h) + aoff + m * 2048 + k * 1024); } while (0)
#define PG8_LDB(dst, b, h) do { _Pragma("unroll") for (int n = 0; n < 2; ++n) _Pragma("unroll") for (int k = 0; k < 2; ++k) dst[n][k] = *(const PG8_LAS bf16x8*)(lds + PG8_SB(b, h) + boff + n * 2048 + k * 1024); } while (0)
#define PG8_MMA(ai, bj, At, Bt) do { __builtin_amdgcn_s_setprio(1); _Pragma("unroll") for (int m = 0; m < 4; ++m) _Pragma("unroll") for (int n = 0; n < 2; ++n) _Pragma("unroll") for (int k = 0; k < 2; ++k) \
        acc[ai][bj][m][n] = __builtin_amdgcn_mfma_f32_16x16x32_bf16(Bt[n][k], At[m][k], acc[ai][bj][m][n], 0, 0, 0); __builtin_amdgcn_s_setprio(0); } while (0)
#define PG8_WAIT_V(n) asm volatile("s_waitcnt vmcnt(" #n ")" ::: "memory")
#define PG8_WAIT_L(n) asm volatile("s_waitcnt lgkmcnt(" #n ")" ::: "memory")
#define PG8_BAR __builtin_amdgcn_s_barrier()
#define PG8_SCHED __builtin_amdgcn_sched_barrier(0)
    Unit cur, nxt; int ui = 0;
    if (!S.next(0, cur)) return;
    f32x4 acc[2][2][4][2];
#pragma unroll
    for (int a = 0; a < 2; ++a)
#pragma unroll
        for (int b = 0; b < 2; ++b)
#pragma unroll
            for (int m = 0; m < 4; ++m)
#pragma unroll
                for (int n = 0; n < 2; ++n) acc[a][b][m][n] = (f32x4){0.f, 0.f, 0.f, 0.f};
    bf16x8 At[4][2], B0[2][2], B1[2][2];
    const char* cA = (const char*)g.A + (size_t)cur.pm * tstep; const char* cB = (const char*)g.Bt + (size_t)cur.pn * tstep;
    S.a_ready(cur);
    if constexpr (SP2) {
        PG8_STAGE(PG8_SB(0, 0), cB, voffB); PG8_STAGE(PG8_SB(0, 1), cB + hstep, voffB); PG8_STAGE(PG8_SA(0, 0), cA, voffA); PG8_STAGE(PG8_SA(0, 1), cA + hstep, voffA);
        if (wr == 1) PG8_BAR;
        PG8_WAIT_V(2); PG8_BAR;
        PG8_STAGE(PG8_SB(1, 0), cB + kstep, voffB); PG8_STAGE(PG8_SA(1, 0), cA + kstep, voffA); PG8_STAGE(PG8_SB(1, 1), cB + hstep + kstep, voffB);
        PG8_WAIT_V(6); PG8_BAR;
    } else {
        PG8_STAGE(PG8_SB(0, 0), cB, voffB); PG8_STAGE(PG8_SA(0, 0), cA, voffA); PG8_STAGE(PG8_SB(0, 1), cB + hstep, voffB); PG8_STAGE(PG8_SA(0, 1), cA + hstep, voffA);
        if (wr == 1) PG8_BAR;
        PG8_WAIT_V(4); PG8_BAR;
        PG8_STAGE(PG8_SB(1, 0), cB + kstep, voffB); PG8_STAGE(PG8_SA(1, 0), cA + kstep, voffA); PG8_STAGE(PG8_SB(1, 1), cB + hstep + kstep, voffB);
        PG8_WAIT_V(6); PG8_BAR;
    }
    for (;;) {
        const bool has_next = S.next(ui + 1, nxt);
        const char* nA = has_next ? (const char*)g.A + (size_t)nxt.pm * tstep : cA; const char* nB = has_next ? (const char*)g.Bt + (size_t)nxt.pn * tstep : cB;
        if constexpr (Epi::ROWSUMS)
            __builtin_amdgcn_global_load_lds((const unsigned*)(E.rowss + cur.pm * BM + 32 * wid + (tid_from(wave_s) & 31)), (PG8_LAS unsigned*)(lds + STAGE_BYTES + (ui & 1) * 2048 + wid * 256), 4, 0, 0);
        for (int t = 0; t < nt; t += 2) {
            const bool last = (t == nt - 2);
            const char* a1 = cA + (size_t)(t + 1) * kstep;
            const char* a2 = last ? nA : cA + (size_t)(t + 2) * kstep; const char* b2 = last ? nB : cB + (size_t)(t + 2) * kstep;
            const char* a3 = a2 + kstep; const char* b3 = b2 + kstep;
            if (last && has_next) S.a_ready(nxt);
            if constexpr (SP2) {
            const unsigned seam = (unsigned)__builtin_amdgcn_readfirstlane((Epi::ROWSUMS && SEAM_RELAX && t == 0 && ui > 0) ? 1 : 0);
            PG8_LDB(B0, 0, 0); PG8_LDB(B1, 0, 1); PG8_SCHED; PG8_LDA(At, 0, 0); PG8_STAGE(PG8_SA(1, 1), a1 + hstep, voffA);
            asm volatile("s_waitcnt vmcnt(25)\n\ts_cmp_lg_u32 %0, 0\n\ts_cbranch_scc1 1\n\ts_waitcnt vmcnt(8)" :: "s"(seam) : "scc", "memory");
            PG8_WAIT_L(0); PG8_BAR; PG8_MMA(0, 0, At, B0); PG8_MMA(0, 1, At, B1); PG8_BAR; PG8_SCHED;
            PG8_LDA(At, 0, 1); PG8_STAGE(PG8_SB(0, 0), b2, voffB); PG8_STAGE(PG8_SB(0, 1), b2 + hstep, voffB); PG8_STAGE(PG8_SA(0, 0), a2, voffA);
            asm volatile("s_waitcnt vmcnt(25)\n\ts_cmp_lg_u32 %0, 0\n\ts_cbranch_scc1 1\n\ts_waitcnt vmcnt(8)" :: "s"(seam) : "scc", "memory");
            PG8_WAIT_L(0); PG8_BAR; PG8_MMA(1, 0, At, B0); PG8_MMA(1, 1, At, B1); PG8_BAR; PG8_SCHED;
            PG8_LDB(B0, 1, 0); PG8_LDB(B1, 1, 1); PG8_SCHED; PG8_LDA(At, 1, 0); PG8_STAGE(PG8_SA(0, 1), a2 + hstep, voffA);
            PG8_WAIT_V(8); PG8_WAIT_L(0); PG8_BAR; PG8_MMA(0, 0, At, B0); PG8_MMA(0, 1, At, B1); PG8_BAR; PG8_SCHED;
            PG8_LDA(At, 1, 1); PG8_STAGE(PG8_SB(1, 0), b3, voffB); PG8_STAGE(PG8_SB(1, 1), b3 + hstep, voffB); PG8_STAGE(PG8_SA(1, 0), a3, voffA);
            PG8_WAIT_V(8); PG8_WAIT_L(0); PG8_BAR; PG8_MMA(1, 0, At, B0); PG8_MMA(1, 1, At, B1); PG8_BAR; PG8_SCHED;
            } else {
            PG8_LDB(B0, 0, 0); PG8_SCHED; PG8_LDA(At, 0, 0); PG8_STAGE(PG8_SA(1, 1), a1 + hstep, voffA);
            PG8_WAIT_L(8); PG8_BAR; PG8_WAIT_L(0); PG8_MMA(0, 0, At, B0); PG8_BAR; PG8_SCHED;
            PG8_LDB(B1, 0, 1); PG8_STAGE(PG8_SB(0, 0), b2, voffB);
            PG8_BAR; PG8_WAIT_L(0); PG8_MMA(0, 1, At, B1); PG8_BAR;
            PG8_LDA(At, 0, 1); PG8_STAGE(PG8_SA(0, 0), a2, voffA);
            PG8_BAR; PG8_WAIT_L(0); PG8_MMA(1, 0, At, B0); PG8_BAR; PG8_SCHED;
            PG8_STAGE(PG8_SB(0, 1), b2 + hstep, voffB);
            PG8_WAIT_V(6); PG8_BAR; PG8_MMA(1, 1, At, B1); PG8_BAR;
            PG8_LDB(B0, 1, 0); PG8_SCHED; PG8_LDA(At, 1, 0); PG8_STAGE(PG8_SA(0, 1), a2 + hstep, voffA);
            PG8_WAIT_L(8); PG8_BAR; PG8_WAIT_L(0); PG8_MMA(0, 0, At, B0); PG8_BAR; PG8_SCHED;
            PG8_LDB(B1, 1, 1); PG8_STAGE(PG8_SB(1, 0), b3, voffB);
            PG8_BAR; PG8_WAIT_L(0); PG8_MMA(0, 1, At, B1); PG8_BAR;
            PG8_LDA(At, 1, 1); PG8_STAGE(PG8_SA(1, 0), a3, voffA);
            PG8_BAR; PG8_WAIT_L(0); PG8_MMA(1, 0, At, B0); PG8_BAR; PG8_SCHED;
            PG8_STAGE(PG8_SB(1, 1), b3 + hstep, voffB);
            PG8_WAIT_V(6); PG8_BAR; PG8_MMA(1, 1, At, B1); PG8_BAR;
            }
        }
        if constexpr (ALIGN_EPI) { if (wr == 0) PG8_BAR; }
        TS_BEGIN(11);
        if constexpr (!Epi::AFTER_DRAIN) { E(acc, cur, wr, wc, fr, fq, (const PG8_LAS float*)(lds + STAGE_BYTES + (ui & 1) * 2048)); S.done(cur); }
        TS_END(11);
        if (!has_next) break;
#pragma unroll
        for (int a = 0; a < 2; ++a)
#pragma unroll
            for (int b = 0; b < 2; ++b)
#pragma unroll
                for (int m = 0; m < 4; ++m)
#pragma unroll
                    for (int n = 0; n < 2; ++n) acc[a][b][m][n] = (f32x4){0.f, 0.f, 0.f, 0.f};
        cur = nxt; cA = nA; cB = nB; ++ui;
        if constexpr (ALIGN_EPI) { if (wr == 1) PG8_BAR; }
    }
    PG8_WAIT_V(0);
    if constexpr (!ALIGN_EPI) { if (wr == 0) PG8_BAR; }
    PG8_BAR;
    if constexpr (Epi::AFTER_DRAIN) { E.fused(acc, cur, wr, wc, fr, fq, lds, wid, lane); S.done(cur); }
#undef PG8_SA
#undef PG8_SB
#undef PG8_STAGE
#undef PG8_LDA
#undef PG8_LDB
#undef PG8_MMA
#undef PG8_WAIT_V
#undef PG8_WAIT_L
#undef PG8_BAR
#undef PG8_SCHED
}
}

namespace pg8 {
struct EpiInProj {
    static constexpr bool PERM = true, AFTER_DRAIN = false, ROWSUMS = true;
    unsigned char* ws; const float* rowss;
    __device__ __forceinline__ void operator()(const f32x4 (&acc)[2][2][4][2], const Unit& u, int wr, int wc, int fr, int fq, const PG8_LAS float* rs) const {
        const int row0 = u.pm * BM + wr * 64 + fr, colt = u.pn * BM, cl = wc * 32 + 8 * fq;
        const int mode = (colt >= C_GS) ? 2 : (((colt >= C_ZS && colt < C_Q) || (colt >= C_ZA && colt < C_GS)) ? 1 : 0);
        bf16_t* base; int kind = 0, sh = 0; size_t bjs;
        if (colt < C_ZS) { base = (bf16_t*)(ws + OFF_UG) + (size_t)(colt >> 4) * SEQ * 16; bjs = (size_t)8 * SEQ * 16; kind = 1; }
        else if (colt < C_Q) { base = (bf16_t*)(ws + OFF_GZ) + GZ_ZS + (colt - C_ZS); bjs = HALF; }
        else if (colt < C_ZA) { const int j = (colt - C_Q) >> 8, kd = j / 6, jj = j - 6 * kd, gi = jj >> 1; sh = 2 * gi; kind = 2;
            base = (bf16_t*)(ws + OFF_QKV) + ((size_t)((kd * 3 + gi) * BATCH) * HPG + 2 * (jj & 1)) * SEQ * HD; bjs = (size_t)SEQ * HD; }
        else if (colt < C_GS) { base = (bf16_t*)(ws + OFF_GZ) + GZ_ZA + (colt - C_ZA); bjs = HALF; }
        else { base = (bf16_t*)(ws + OFF_G8); bjs = HALF; kind = 3; }
        float inv[2][4];
#pragma unroll
        for (int ai = 0; ai < 2; ++ai)
#pragma unroll
            for (int m = 0; m < 4; ++m) { const int rl = wr * 64 + fr + ai * HALF + m * 16; inv[ai][m] = rsqrtf(rs[(rl >> 5) * 64 + (rl & 31)] * (1.0f / D_MODEL) + RMS_EPS); }
#pragma unroll
        for (int ai = 0; ai < 2; ++ai)
#pragma unroll
            for (int m = 0; m < 4; ++m) {
                const int row = row0 + ai * HALF + m * 16, b = row >> 11, t = row & (SEQ - 1);
                unsigned ro;
                if (kind == 3) { const unsigned go = (unsigned)row * G8_W + (unsigned)(colt - C_GS) + (unsigned)cl;
#pragma unroll
                    for (int bj = 0; bj < 2; ++bj) { const f32x4 v0 = acc[ai][bj][m][0] * inv[ai][m], v1 = acc[ai][bj][m][1] * inv[ai][m]; unsigned lo = 0u, hi = 0u;
#pragma unroll
                        for (int e = 0; e < 4; ++e) { const float s0 = __builtin_amdgcn_rcpf(1.0f + __builtin_amdgcn_exp2f(-1.4426950408889634f * v0[e])), s1 = __builtin_amdgcn_rcpf(1.0f + __builtin_amdgcn_exp2f(-1.4426950408889634f * v1[e]));
                            lo |= (unsigned)(s0 * 255.0f + 0.5f) << (8 * e); hi |= (unsigned)(s1 * 255.0f + 0.5f) << (8 * e); }
                        { typedef unsigned u32x2g __attribute__((ext_vector_type(2))); const u32x2g gw_ = {lo, hi};
                          asm volatile("global_store_dwordx2 %0, %1, %2" :: "v"(go + (unsigned)(bj * HALF)), "v"(gw_), "s"(base) : "memory"); } }
                    continue; }
                if (kind == 0) ro = ((unsigned)row * GZ_W + (unsigned)cl) * 2u;
                else if (kind == 1) ro = (((unsigned)(b * SSM_NG + (cl >> 4)) * SEQ + (unsigned)t) * 16u + (unsigned)(cl & 8)) * 2u;
                else { const int pos = ((t & ((1 << sh) - 1)) << (11 - sh)) + (t >> sh); ro = (((unsigned)b * HPG * SEQ + (unsigned)pos) * HD + (unsigned)cl) * 2u; }
#pragma unroll
                for (int bj = 0; bj < 2; ++bj) {
                    f32x4 v0 = acc[ai][bj][m][0] * inv[ai][m], v1 = acc[ai][bj][m][1] * inv[ai][m];
                    if (mode != 0) {
#pragma unroll
                        for (int e = 0; e < 4; ++e) {
                            const float s0 = __builtin_amdgcn_rcpf(1.0f + __builtin_amdgcn_exp2f(-1.4426950408889634f * v0[e]));
                            const float s1 = __builtin_amdgcn_rcpf(1.0f + __builtin_amdgcn_exp2f(-1.4426950408889634f * v1[e]));
                            v0[e] = (mode == 1) ? v0[e] * s0 : s0; v1[e] = (mode == 1) ? v1[e] * s1 : s1;
                        }
                    }
                    u32x4 w; w.x = cvt_pk_bf16(v0[0], v0[1]); w.y = cvt_pk_bf16(v0[2], v0[3]); w.z = cvt_pk_bf16(v1[0], v1[1]); w.w = cvt_pk_bf16(v1[2], v1[3]);
#if EXP_NOSTORE
                    asm volatile("" :: "v"(w.x), "v"(w.y), "v"(w.z), "v"(w.w));
#else
#if P1_NT
                    __builtin_nontemporal_store(w, (u32x4*)(rowp + bj * bjs));
#else
                    asm volatile("global_store_dwordx4 %0, %1, %2" :: "v"(ro + (unsigned)bj * (unsigned)bjs * 2u), "v"(w), "s"(base) : "memory");
#endif
#endif
                }
            }
    }
};
}

#define LAS __attribute__((address_space(3)))
#define GAS __attribute__((address_space(1)))
#define LDS_WAIT() asm volatile("s_waitcnt lgkmcnt(0)" ::: "memory")
#define VM_WAIT() asm volatile("s_waitcnt vmcnt(0)" ::: "memory")
__device__ __forceinline__ unsigned pk2(float lo, float hi) { return (unsigned)f2bf(lo) | ((unsigned)f2bf(hi) << 16); }
#define XB_TMO      128
#define XB_XCNT(j)  (256  + 64 * (j))
#define XB_XSUB(j)  (1280 + 64 * (j))
#define XB_XGEN(j)  (2304 + 64 * (j))
#define XB_TOP      3328
#define XB_TOPGEN   3392
#define XCD_BAR_WORDS 3456
#define XB_SPIN_CAP (1u << 18)

__device__ __forceinline__ unsigned xb_ld(unsigned* p)              { return __hip_atomic_load(p, __ATOMIC_RELAXED, __HIP_MEMORY_SCOPE_AGENT); }
__device__ __forceinline__ unsigned xb_add(unsigned* p, unsigned v) { return __hip_atomic_fetch_add(p, v, __ATOMIC_RELAXED, __HIP_MEMORY_SCOPE_AGENT); }
__device__ __forceinline__ unsigned xb_xcc_id() { return (unsigned)__builtin_amdgcn_s_getreg((3 << 11) | 20) & 0xFu; }
#define XB_SPIN(cond, bar) do { unsigned _sp = 0; while (cond) { __builtin_amdgcn_s_sleep(1); \
    if ((++_sp & 255u) == 0u) { if (xb_ld(&(bar)[XB_TMO])) break; if (_sp > XB_SPIN_CAP) { atomicAdd(&(bar)[XB_TMO], 1u); break; } } } } while (0)

struct XcdBarrier {
    int w;
    unsigned G;
    unsigned* bar; unsigned x;
    volatile LAS unsigned* st;
};

__device__ __forceinline__ XcdBarrier xcd_barrier_post(unsigned* bar, volatile LAS unsigned* st, int wave_s, unsigned G) {
    XcdBarrier b; b.w = wave_s; b.G = G; b.bar = bar; b.x = xb_xcc_id(); b.st = st;
    if (tid_from(wave_s) == 0) (void)xb_add(&bar[XB_XCNT(b.x)], 1u);
    return b;
}
__device__ __forceinline__ void xcd_barrier_complete(unsigned* bar, unsigned x, unsigned& nloc, unsigned& nx, unsigned G) {
    unsigned sum, cnt, mine, sp = 0u;
    for (;;) {
        sum = 0u; cnt = 0u; mine = 0u;
#pragma unroll
        for (unsigned j = 0; j < 16; ++j) { const unsigned c = xb_ld(&bar[XB_XCNT(j)]); sum += c; cnt += (c > 0u) ? 1u : 0u; mine = (j == x) ? c : mine; }
        if (sum == G) break;
        __builtin_amdgcn_s_sleep(1);
        if ((++sp & 255u) == 0u) { if (xb_ld(&bar[XB_TMO])) break; if (sp > XB_SPIN_CAP) { atomicAdd(&bar[XB_TMO], 1u); break; } }
    }
    nloc = mine > 0u ? mine : 1u; nx = cnt > 0u ? cnt : 1u;
}

struct BarTouch { const char* p[6]; int n[6]; int sh[6]; int pitch[6]; };
__device__ __forceinline__ void xcd_barrier(const XcdBarrier& b, const BarTouch* bt = nullptr, LAS unsigned char* junk = nullptr) {
    asm volatile("s_waitcnt vmcnt(0)" ::: "memory");
    __syncthreads();
    if (bt != nullptr && b.w != 0) {
        const int li_ = (b.w - 1) * 64 + (tid_from(b.w) & 63);
#pragma unroll
        for (int r = 0; r < 6; ++r) { const int n_ = bt->n[r];
            for (int i0 = 0; i0 < n_; i0 += 448) { int i = i0 + li_; i = i < n_ ? i : n_ - 1;
                __builtin_amdgcn_global_load_lds((const unsigned*)(bt->p[r] + (size_t)(i >> bt->sh[r]) * bt->pitch[r] + (size_t)(i & ((1 << bt->sh[r]) - 1)) * 128), (LAS unsigned*)(junk + b.w * 256), 4, 0, 0); } }
    }
    if (tid_from(b.w) == 0) {
        unsigned* bar = b.bar;
        __builtin_amdgcn_s_waitcnt(0);
        unsigned nloc = b.st[0], nx = b.st[1];
        if (nloc == 0u) { xcd_barrier_complete(bar, b.x, nloc, nx, b.G); b.st[0] = nloc; b.st[1] = nx; }
        const unsigned old = xb_add(&bar[XB_XSUB(b.x)], 1u);
        const unsigned gen = old / nloc;
        if (old + 1u == (gen + 1u) * nloc) {
            __builtin_amdgcn_fence(__ATOMIC_RELEASE, "agent");
            asm volatile("s_waitcnt vmcnt(0)" ::: "memory");
            const unsigned og = xb_add(&bar[XB_TOP], 1u);
            const unsigned tg = og / nx;
            if (og + 1u == (tg + 1u) * nx) xb_add(&bar[XB_TOPGEN], 1u);
            else XB_SPIN(xb_ld(&bar[XB_TOPGEN]) == tg, bar);
            __builtin_amdgcn_fence(__ATOMIC_ACQUIRE, "agent");
            xb_add(&bar[XB_XGEN(b.x)], 1u);
            asm volatile("s_waitcnt vmcnt(0)" ::: "memory");
        } else {
            XB_SPIN(xb_ld(&bar[XB_XGEN(b.x)]) == gen, bar);
            __builtin_amdgcn_fence(__ATOMIC_ACQUIRE, "agent");
            asm volatile("s_waitcnt vmcnt(0)" ::: "memory");
        }
    }
    __syncthreads();
}

constexpr int NWAVES = 8, NTHREADS = NWAVES * 64;
constexpr int RING_BYTES = 131072;
constexpr int LDS_BYTES = 163840;
constexpr int MISC_OFF = LDS_BYTES - 256;
constexpr int CW_BAR = 4096;
constexpr int N_BAR_REGIONS = 32;
constexpr size_t CTL_ZERO_BYTES = 1 * MiB;
static_assert((CW_BAR + N_BAR_REGIONS * XCD_BAR_WORDS) * 4 <= (int)CTL_ZERO_BYTES, "ctl");

#ifndef PROBE_DUP
#define PROBE_DUP 0
#endif
struct Frame { LAS unsigned char* lds; int wave, vcu, G; };

struct Args { Params p; int ph_lo, ph_hi, bar_region, pad; };
__device__ __forceinline__ const float* inptr(const Args& a, int i) { int z; asm volatile("s_mov_b32 %0, 0" : "=s"(z)); return a.p.in[i + z]; }

namespace swa {
constexpr int D = 128; constexpr float THR = 8.f; constexpr bool WSKIP = true;
constexpr float SCALE = 0.08838834764831845f;
constexpr int NW = 8, QBLK = 32, KVBLK = 64, QB = NW * QBLK;
constexpr int SHM_V = KVBLK * D * 2, SHM_K = KVBLK * D * 2;
constexpr int ATTN_LDS_BYTES = 2 * SHM_V + 2 * SHM_K + NW * 64 * 4;

typedef short s16x4 __attribute__((ext_vector_type(4)));
typedef float f32x16 __attribute__((ext_vector_type(16)));
template <class A, class Bt> struct same_t { static constexpr bool v = false; };
template <class A> struct same_t<A, A> { static constexpr bool v = true; };

#define KSWZ(row, colB) ((row) * 256 + ((colB) ^ (((row) & 7) << 4)))
#define SBAR() __builtin_amdgcn_sched_barrier(0)
__device__ __forceinline__ int v_st(int k, int c) { const int kk = (k & ~0xC) | ((k & 4) << 1) | ((k & 8) >> 1); return ((kk >> 3) * 4 + (c >> 5)) * 512 + ((kk & 7) * 32 + (c & 31)) * 2; }
__device__ __forceinline__ int v_rd_base(int lane) { return ((lane & 3) << 3) | (((lane >> 2) & 3) << 6) | (((lane >> 4) & 1) << 5) | (((lane >> 5) & 1) << 8); }
constexpr int v_rd_off(int d0, int ks, int half) { return d0 * 512 + ks * 4096 + half * 2048; }
__device__ __forceinline__ int crow(int r, int hi) { return (r & 3) + 8 * (r >> 2) + 4 * hi; }
__device__ __forceinline__ unsigned cvtpk(float lo, float hi) {
    unsigned r; asm volatile("v_cvt_pk_bf16_f32 %0, %1, %2" : "=v"(r) : "v"(lo), "v"(hi)); return r;
}
__device__ __forceinline__ bf16x8 pack8(f32x4 a, f32x4 b) {
    u32x4 w = {cvtpk(a[0], a[1]), cvtpk(a[2], a[3]), cvtpk(b[0], b[1]), cvtpk(b[2], b[3])};
    return *reinterpret_cast<bf16x8*>(&w);
}
template <class T> __device__ __forceinline__ bf16x8 load8(const T* p) {
    if constexpr (same_t<T, float>::v) { return pack8(*(const f32x4*)p, *(const f32x4*)(p + 4)); }
    else { return *reinterpret_cast<const bf16x8*>(p); }
}
__device__ __forceinline__ void mask_tile(f32x16& p0, f32x16& p1, int dq, unsigned W) {
    const float NEG = -__builtin_inff();
#pragma unroll
    for (int r = 0; r < 16; ++r) {
        const int c = (r & 3) + 8 * (r >> 2);
        if ((unsigned)(dq - c) >= W) p0[r] = NEG;
        if ((unsigned)(dq - c - 32) >= W) p1[r] = NEG;
    }
}
__device__ __forceinline__ void partialSM(f32x16& p0, f32x16& p1, float& m_reg, float& mn, float& alpha) {
    float pmax = p0[0]; for (int r = 1; r < 16; ++r) pmax = fmaxf(pmax, p0[r]); for (int r = 0; r < 16; ++r) pmax = fmaxf(pmax, p1[r]);
    { auto rr = __builtin_amdgcn_permlane32_swap(__float_as_uint(pmax), __float_as_uint(pmax), false, false);
      pmax = fmaxf(__uint_as_float(rr[0]), __uint_as_float(rr[1])); }
    constexpr float C2 = 1.4426950408889634f * SCALE;
    if (__builtin_expect(__all((pmax - m_reg) * SCALE <= THR), 1)) { mn = m_reg; alpha = 1.f; }
    else { mn = fmaxf(m_reg, pmax); alpha = __builtin_amdgcn_exp2f((m_reg - mn) * C2); m_reg = mn; }
    const float mnL = -mn * C2;
    for (int r = 0; r < 16; ++r) p0[r] = fmaf(p0[r], C2, mnL); for (int r = 0; r < 16; ++r) p1[r] = fmaf(p1[r], C2, mnL);
    for (int r = 0; r < 16; ++r) p0[r] = __builtin_amdgcn_exp2f(p0[r]);
}
__device__ __forceinline__ void finishSM(f32x16& p0, f32x16& p1, float alpha, float& l_reg, bf16x8& pa0, bf16x8& pa1, bf16x8& pa2, bf16x8& pa3) {
    for (int r = 0; r < 16; ++r) p1[r] = __builtin_amdgcn_exp2f(p1[r]);
    float ps = 0; for (int r = 0; r < 16; ++r) ps += p0[r]; for (int r = 0; r < 16; ++r) ps += p1[r];
    { auto rr = __builtin_amdgcn_permlane32_swap(__float_as_uint(ps), __float_as_uint(ps), false, false);
      ps = __uint_as_float(rr[0]) + __uint_as_float(rr[1]); }
    l_reg = l_reg * alpha + ps;
#define PK4(P, B_, OUT) do { unsigned a0 = cvtpk(P[B_+0], P[B_+1]), a1 = cvtpk(P[B_+2], P[B_+3]);                          \
        unsigned b0 = cvtpk(P[B_+4], P[B_+5]), b1 = cvtpk(P[B_+6], P[B_+7]);                                             \
        auto r0 = __builtin_amdgcn_permlane32_swap(a0, b0, false, false); auto r1 = __builtin_amdgcn_permlane32_swap(a1, b1, false, false); \
        u32x4 w = {r0[0], r1[0], r0[1], r1[1]}; OUT = *reinterpret_cast<bf16x8*>(&w); } while (0)
    PK4(p0, 0, pa0); PK4(p0, 8, pa1); PK4(p1, 0, pa2); PK4(p1, 8, pa3);
#undef PK4
}
template <int KB, bool SK>
__device__ __forceinline__ void qkt(f32x16& p0, f32x16& p1, const char* K_lds, int r32, int hi, const bf16x8* qr, bool act) {
    if (SK && !act) { const float NEG = -__builtin_inff();
#pragma unroll
        for (int r = 0; r < 16; ++r) { p0[r] = NEG; p1[r] = NEG; } return; }
    p0 = f32x16{}; p1 = f32x16{};
    const char* kb[4];
#pragma unroll
    for (int dd = 0; dd < 4; ++dd) kb[dd] = K_lds + KB * SHM_K + KSWZ(r32, (dd * 16 + hi * 8) * 2);
#pragma unroll
    for (int d0 = 0; d0 < 8; ++d0) { const char* a = kb[d0 & 3] + (d0 >> 2) * 128;
        bf16x8 b0 = *reinterpret_cast<const bf16x8*>(a);
        bf16x8 b1 = *reinterpret_cast<const bf16x8*>(a + 32 * 256);
        p0 = __builtin_amdgcn_mfma_f32_32x32x16_bf16(b0, qr[d0], p0, 0, 0, 0);
        p1 = __builtin_amdgcn_mfma_f32_32x32x16_bf16(b1, qr[d0], p1, 0, 0, 0); }
}
template <int VB, bool SK>
__device__ __forceinline__ void pv_tile(f32x16* o, int vb0, bf16x8 pa0, bf16x8 pa1, bf16x8 pa2, bf16x8 pa3, bool act) {
    if (SK && !act) return;
#define TRRD(dst, off) asm volatile("ds_read_b64_tr_b16 %0, %1 offset:%2" : "=&v"(dst) : "v"(vb0), "i"(off) : "memory")
#define PV_D0(d0) do { s16x4 l0, l1, l2, l3, h0, h1, h2, h3; constexpr int b_ = VB * SHM_V + v_rd_off(d0, 0, 0);     \
        TRRD(l0, b_); TRRD(h0, b_ + 2048); TRRD(l1, b_ + 4096); TRRD(h1, b_ + 6144); TRRD(l2, b_ + 8192); TRRD(h2, b_ + 10240); TRRD(l3, b_ + 12288); TRRD(h3, b_ + 14336); \
        asm volatile("s_waitcnt lgkmcnt(0)" ::: "memory"); SBAR();                 \
        o[d0] = __builtin_amdgcn_mfma_f32_32x32x16_bf16(pa0, (bf16x8){l0[0], l0[1], l0[2], l0[3], h0[0], h0[1], h0[2], h0[3]}, o[d0], 0, 0, 0);   \
        o[d0] = __builtin_amdgcn_mfma_f32_32x32x16_bf16(pa1, (bf16x8){l1[0], l1[1], l1[2], l1[3], h1[0], h1[1], h1[2], h1[3]}, o[d0], 0, 0, 0);   \
        o[d0] = __builtin_amdgcn_mfma_f32_32x32x16_bf16(pa2, (bf16x8){l2[0], l2[1], l2[2], l2[3], h2[0], h2[1], h2[2], h2[3]}, o[d0], 0, 0, 0);   \
        o[d0] = __builtin_amdgcn_mfma_f32_32x32x16_bf16(pa3, (bf16x8){l3[0], l3[1], l3[2], l3[3], h3[0], h3[1], h3[2], h3[3]}, o[d0], 0, 0, 0); } while (0)
    PV_D0(0); PV_D0(1); PV_D0(2); PV_D0(3);
#undef PV_D0
#undef TRRD
}

template <class TIn, class TOut> struct BlockRef { const TIn* Q; const TIn* K; const TIn* V; TOut* O; float* L; int P0, pitch, opitch, lpitch, nq; };
template <class TIn> struct Seam {
    bf16x8 qr[8];
    bf16x8 st_v0, st_v1, st_k0, st_k1; f32x4 sf0, sf1, sf2, sf3;
    f32x4 tq[16];
};
__device__ __forceinline__ int swa_jlo(int P0, int W) { const int lowk = P0 - W + 1; return lowk > 0 ? lowk / KVBLK : 0; }
#define ROW(p, k0, rr) ((p) + (size_t)((k0) + (rr)) * PITCH_ + sc)
#define VMW() asm volatile("s_waitcnt vmcnt(0)" ::: "memory")
#define VMWN(n) asm volatile("s_waitcnt vmcnt(%0)" :: "i"(n) : "memory")
#define SLOAD_H(Kp, Vp, k0) do { S.st_v0 = load8<TIn>(ROW(Vp, k0, sr)); S.st_v1 = load8<TIn>(ROW(Vp, k0, 32 + sr));              \
                         S.st_k0 = load8<TIn>(ROW(Kp, k0, sr)); S.st_k1 = load8<TIn>(ROW(Kp, k0, 32 + sr)); } while (0)
#define SWRITE_HK(bf) do { *(bf16x8*)(K_lds + (bf) * SHM_K + kws) = S.st_k0; *(bf16x8*)(K_lds + (bf) * SHM_K + kws + 32 * 256) = S.st_k1; } while (0)
#define SWRITE_HV(bf) do { *(bf16x8*)(V_lds + (bf) * SHM_V + vst0) = S.st_v0; *(bf16x8*)(V_lds + (bf) * SHM_V + vst1) = S.st_v1; } while (0)
#define SWRITE_H(bf) do { SWRITE_HV(bf); SWRITE_HK(bf); } while (0)
#define SLOAD_F(p, k0) do { S.sf0 = *(const f32x4*)ROW(p, k0, sr); S.sf1 = *(const f32x4*)(ROW(p, k0, sr) + 4);                \
                            S.sf2 = *(const f32x4*)ROW(p, k0, 32 + sr); S.sf3 = *(const f32x4*)(ROW(p, k0, 32 + sr) + 4); } while (0)
#define SWRITE_KF(bf) do { *(bf16x8*)(K_lds + (bf) * SHM_K + kws) = pack8(S.sf0, S.sf1); *(bf16x8*)(K_lds + (bf) * SHM_K + kws + 32 * 256) = pack8(S.sf2, S.sf3); } while (0)
#define SWRITE_VF(bf) do { *(bf16x8*)(V_lds + (bf) * SHM_V + vst0) = pack8(S.sf0, S.sf1); *(bf16x8*)(V_lds + (bf) * SHM_V + vst1) = pack8(S.sf2, S.sf3); } while (0)
template <class TIn, class TOut>
__device__ __forceinline__ void causal_swa_prime(const BlockRef<TIn, TOut>& cur, int W, char* lds, Seam<TIn>& S, int wave_s) {
    constexpr bool F32 = same_t<TIn, float>::v;
    const int tid = tid_from(wave_s), wid = wave_s, lane = tid & 63, r32 = lane & 31, hi = lane >> 5;
    const int sr = tid >> 4, sc = (tid & 15) * 8, kws = KSWZ(sr, sc * 2); char* K_lds = lds + 2 * SHM_V;
    const int kb0 = swa_jlo(cur.P0, W) * KVBLK;
    const int PITCH_ = cur.pitch; const int qrow_ = (wid * QBLK + r32 < cur.nq) ? wid * QBLK + r32 : cur.nq - 1;
    for (int d0 = 0; d0 < 8; ++d0) S.qr[d0] = load8<TIn>(cur.Q + (size_t)qrow_ * PITCH_ + d0 * 16 + hi * 8);
    if constexpr (F32) { SLOAD_F((const float*)cur.K, kb0); VMW(); SWRITE_KF(0); SBAR(); SLOAD_F((const float*)cur.V, kb0); }
    else { SLOAD_H(cur.K, cur.V, kb0); VMW(); SWRITE_HK(0); }
    __syncthreads();
}
template <class TIn, class TOut>
__device__ __forceinline__ void causal_swa_block(const BlockRef<TIn, TOut>& cur, const BlockRef<TIn, TOut>& nxt, int skv, int W, char* lds, Seam<TIn>& S, int wave_s) {
    constexpr bool F32 = same_t<TIn, float>::v;
    const int tid = tid_from(wave_s), wid = wave_s, lane = tid & 63, r32 = lane & 31, hi = lane >> 5;
    int PITCH_ = cur.pitch; const bool wact = (wid * QBLK < cur.nq);
    const int j_lo = swa_jlo(cur.P0, W);
    int j_hi = (cur.P0 + QB - 1) / KVBLK + 1; if (j_hi > skv / KVBLK) j_hi = skv / KVBLK;
    const int NT = j_hi - j_lo;
    const int kbn = swa_jlo(nxt.P0, W) * KVBLK;
    const int qlo = cur.P0 + wid * QBLK, qm = qlo + r32 - 4 * hi;
    char* V_lds = lds; char* K_lds = lds + 2 * SHM_V;
    float* ws = (float*)(lds + 2 * SHM_V + 2 * SHM_K) + wid * 64; float* li_l = ws, * al_l = ws + 32;
    float m_reg = -1e30f, l_reg = 0; f32x16 o[4] = {};
    const int sr = tid >> 4, sc = (tid & 15) * 8, vst0 = v_st(sr, sc), vst1 = v_st(32 + sr, sc), kws = KSWZ(sr, sc * 2);
    const int vb0 = (int)(uintptr_t)V_lds + v_rd_base(lane);
    const TIn* Kh = cur.K; const TIn* Vh = cur.V;
#define RESC(a) do { if (__any((a) < 1.f)) { if (hi == 0) al_l[r32] = (a); asm volatile("s_waitcnt lgkmcnt(0)" ::: "memory");              \
                     for (int d_ = 0; d_ < 4; ++d_) for (int r = 0; r < 16; ++r) o[d_][r] *= al_l[crow(r, hi)]; } } while (0)
#define KBASE(t) ((j_lo + (t)) * KVBLK)
#define ACT(t) (wact && KBASE(t) <= qlo + QBLK - 1 && KBASE(t) + KVBLK - 1 >= qlo - W + 1)
#define MASKT(P0_, P1_, t) do { const int kb_ = KBASE(t); if ((!SK || ACT(t)) && (kb_ + KVBLK - 1 > qlo || kb_ <= qlo + QBLK - 1 - W)) mask_tile(P0_, P1_, qm - kb_, (unsigned)W); } while (0)
    constexpr int NQL = F32 ? 16 : 8;
    constexpr bool SK = WSKIP && !F32;
#define SEAM_K0() do { VMWN(NQL); if constexpr (F32) { SWRITE_KF(0); SBAR(); SLOAD_F((const float*)nxt.V, kbn); } else { SWRITE_HK(0); } SBAR(); } while (0)
    f32x16 pA0, pA1, pB0, pB1; float mnA, mnB, alA, alB; bf16x8 pa0, pa1, pa2, pa3;
    if constexpr (F32) { VMW(); SWRITE_VF(0); SBAR(); } else { SWRITE_HV(0); SBAR(); }
    if (NT > 1) { if constexpr (F32) SLOAD_F((const float*)Kh, KBASE(1)); else SLOAD_H(Kh, Vh, KBASE(1)); }
    SBAR(); qkt<0, SK>(pA0, pA1, K_lds, r32, hi, S.qr, ACT(0));
    if constexpr (F32) { if (NT > 1) { VMW(); SWRITE_KF(1); SBAR(); SLOAD_F((const float*)Vh, KBASE(1)); } }
    MASKT(pA0, pA1, 0); partialSM(pA0, pA1, m_reg, mnA, alA);
    if (NT > 1) { VMW(); if constexpr (F32) { SWRITE_VF(1); SBAR(); if (NT > 2) SLOAD_F((const float*)Kh, KBASE(2)); } else SWRITE_H(1); }
    __syncthreads();
#define HALF_STEP(PX0, PX1, mnX, alX, PY0, PY1, alY, t, KB, VB, SB) do {                                                      \
        SBAR(); if constexpr (!F32) { if ((t) + 1 < NT) { SLOAD_H(Kh, Vh, KBASE((t) + 1)); SBAR(); } }     \
        qkt<KB, SK>(PX0, PX1, K_lds, r32, hi, S.qr, ACT(t));                                             \
        finishSM(PY0, PY1, alY, l_reg, pa0, pa1, pa2, pa3); SBAR();                                                           \
        if constexpr (F32) { if ((t) + 1 < NT) { VMW(); SWRITE_KF(SB); SBAR(); SLOAD_F((const float*)Vh, KBASE((t) + 1)); SBAR(); } }  \
        pv_tile<VB, SK>(o, vb0, pa0, pa1, pa2, pa3, ACT((t) - 1)); MASKT(PX0, PX1, (t)); partialSM(PX0, PX1, m_reg, mnX, alX);                                        \
        __syncthreads();                                                                                                      \
        if ((t) + 1 < NT) { VMW(); if constexpr (F32) { SWRITE_VF(SB); SBAR(); if ((t) + 2 < NT) SLOAD_F((const float*)Kh, KBASE((t) + 2)); } \
                            else { SWRITE_H(SB); } }                                                                          \
        RESC(alX); __syncthreads(); } while (0)
    for (int t = 1; t + 1 < NT; t += 2) {
        HALF_STEP(pB0, pB1, mnB, alB, pA0, pA1, alA, t, 1, 0, 0);
        HALF_STEP(pA0, pA1, mnA, alA, pB0, pB1, alB, t + 1, 0, 1, 1);
    }
    const bool even = (NT & 1) == 0;
    if (even) { SBAR(); qkt<1, SK>(pB0, pB1, K_lds, r32, hi, S.qr, ACT(NT - 1)); SBAR(); }
#define QROW(e) (nxt.Q + (size_t)(wid * QBLK + r32) * D + ((e) >> 1) * 16 + hi * 8 + ((e) & 1) * 4)
    if constexpr (F32) { SLOAD_F((const float*)nxt.K, kbn); SBAR();
#pragma unroll
        for (int e = 0; e < 8; ++e) S.tq[e] = *(const f32x4*)QROW(e); }
    else { PITCH_ = nxt.pitch; SLOAD_H(nxt.K, nxt.V, kbn); SBAR();
        const int qrow_ = (wid * QBLK + r32 < nxt.nq) ? wid * QBLK + r32 : nxt.nq - 1;
#pragma unroll
        for (int d0 = 0; d0 < 8; ++d0) S.qr[d0] = load8<TIn>(nxt.Q + (size_t)qrow_ * PITCH_ + d0 * 16 + hi * 8); }
    SBAR();
    finishSM(pA0, pA1, alA, l_reg, pa0, pa1, pa2, pa3); SBAR();
    if constexpr (F32) {
#pragma unroll
        for (int e = 8; e < 16; ++e) S.tq[e] = *(const f32x4*)QROW(e); SBAR(); }
#undef QROW
    pv_tile<0, SK>(o, vb0, pa0, pa1, pa2, pa3, ACT(even ? NT - 2 : NT - 1));
    if (even) { MASKT(pB0, pB1, NT - 1); partialSM(pB0, pB1, m_reg, mnB, alB); __syncthreads(); RESC(alB);
        finishSM(pB0, pB1, alB, l_reg, pa0, pa1, pa2, pa3); SBAR(); pv_tile<1, SK>(o, vb0, pa0, pa1, pa2, pa3, ACT(NT - 1)); }
    SBAR(); SEAM_K0();
    if (hi == 0) li_l[r32] = l_reg; asm volatile("s_waitcnt lgkmcnt(0)" ::: "memory");
    float rli[16];
#pragma unroll
    for (int r = 0; r < 16; ++r) rli[r] = __builtin_amdgcn_rcpf(li_l[crow(r, hi)]);
    const int OP_ = cur.opitch; TOut* Ow = cur.O + (size_t)(wid * QBLK) * OP_;
    if (wact) {
    if (hi == 0) cur.L[(size_t)(wid * QBLK + r32) * cur.lpitch] = m_reg * (1.4426950408889634f * SCALE) + __builtin_amdgcn_logf(l_reg);
#pragma unroll
    for (int r = 0; r < 16; ++r) { const int orow = crow(r, hi);
#pragma unroll
        for (int d0 = 0; d0 < 4; ++d0) { const float v = o[d0][r] * rli[r];
            if constexpr (same_t<TOut, float>::v) { Ow[(size_t)orow * OP_ + d0 * 32 + r32] = v; }
            else { const float vn = __builtin_bit_cast(float, __builtin_amdgcn_mov_dpp(__builtin_bit_cast(int, v), 0xB1, 0xF, 0xF, true));
                   if ((r32 & 1) == 0) *(unsigned*)(Ow + (size_t)orow * OP_ + d0 * 32 + r32) = cvtpk(v, vn); } } }
    }
    if constexpr (F32) {
#pragma unroll
        for (int d0 = 0; d0 < 8; ++d0) S.qr[d0] = pack8(S.tq[2 * d0], S.tq[2 * d0 + 1]); }
    __syncthreads();
#undef RESC
#undef KBASE
#undef ACT
#undef MASKT
#undef SEAM_K0
#undef HALF_STEP
}
#undef ROW
#undef VMW
#undef VMWN
#undef SLOAD_H
#undef SWRITE_HK
#undef SWRITE_HV
#undef SWRITE_H
#undef SLOAD_F
#undef SWRITE_KF
#undef SWRITE_VF

constexpr int DMA_KR = 0, DMA_VR = 3 * SHM_K, DMA_SCR = DMA_VR + 3 * SHM_V, DMA_LDS_BYTES = DMA_SCR + NW * 64 * 4;
template <class TIn, class TOut>
__device__ __forceinline__ void block_dma(const BlockRef<TIn, TOut>& cur, int skv, int W, char* lds, int wave_s) {
    const int tid = tid_from(wave_s), wid = wave_s, lane = tid & 63, r32 = lane & 31, hi = lane >> 5;
    const int j_lo = swa_jlo(cur.P0, W);
    int j_hi = (cur.P0 + QB - 1) / KVBLK + 1; if (j_hi > skv / KVBLK) j_hi = skv / KVBLK;
    const int NT = j_hi - j_lo, PITCH_ = cur.pitch;
    const bool wact = (wid * QBLK < cur.nq);
    const int qlo = cur.P0 + wid * QBLK, qm = qlo + r32 - 4 * hi;
    float* wsf = (float*)(lds + DMA_SCR) + wid * 64; float* li_l = wsf; float* al_l = wsf + 32;
    int kOff[2], vOff[2];
#pragma unroll
    for (int j = 0; j < 2; ++j) kOff[j] = (4 * (2 * wid + j) + (lane >> 4)) * PITCH_ + (((lane & 15) ^ ((lane >> 4) + 4 * j)) * 8);
    { const int kk = wid * 8 + ((lane & 31) >> 2), k = (kk & ~0xC) | ((kk & 4) << 1) | ((kk & 8) >> 1);
#pragma unroll
      for (int j = 0; j < 2; ++j) vOff[j] = k * PITCH_ + (((2 * j + (lane >> 5)) & 3) * 32 + (lane & 3) * 8); }
    typedef __attribute__((address_space(3))) unsigned lds_u32;
    const unsigned ldsb = (unsigned)(size_t)(__attribute__((address_space(3))) char*)lds;
#define DMA_TILE(t, slot) do { const TIn* kt_ = cur.K + (size_t)(j_lo + (t)) * KVBLK * PITCH_; const TIn* vt_ = cur.V + (size_t)(j_lo + (t)) * KVBLK * PITCH_; \
        _Pragma("unroll") for (int j = 0; j < 2; ++j) { \
            __builtin_amdgcn_global_load_lds((const unsigned*)(kt_ + kOff[j]), (lds_u32*)(size_t)(ldsb + DMA_KR + (slot) * SHM_K + (2 * wid + j) * 1024), 16, 0, 0); \
            __builtin_amdgcn_global_load_lds((const unsigned*)(vt_ + vOff[j]), (lds_u32*)(size_t)(ldsb + DMA_VR + (slot) * SHM_V + (2 * wid + j) * 1024), 16, 0, 0); } } while (0)
    bf16x8 qr[8];
    { const int qrow_ = (wid * QBLK + r32 < cur.nq) ? wid * QBLK + r32 : cur.nq - 1;
#pragma unroll
      for (int d0 = 0; d0 < 8; ++d0) qr[d0] = load8<TIn>(cur.Q + (size_t)qrow_ * PITCH_ + d0 * 16 + hi * 8); }
    DMA_TILE(0, 0);
    if (NT > 1) DMA_TILE(1, 1);
    float m_reg = -1e30f, l_reg = 0; f32x16 o[4] = {};
    const int vbase = (int)ldsb + DMA_VR + v_rd_base(lane);
    int slot = 0, slot2 = 2;
#pragma unroll 1
    for (int t = 0; t < NT; ++t) {
        if (t + 1 < NT) asm volatile("s_waitcnt vmcnt(4)" ::: "memory"); else asm volatile("s_waitcnt vmcnt(0)" ::: "memory");
        asm volatile("s_waitcnt lgkmcnt(0)" ::: "memory"); __builtin_amdgcn_s_barrier(); asm volatile("" ::: "memory");
        if (t + 2 < NT) DMA_TILE(t + 2, slot2);
        const int kb_ = (j_lo + t) * KVBLK;
        const bool act = wact && kb_ <= qlo + QBLK - 1 && kb_ + KVBLK - 1 >= qlo - W + 1;
        if (act) {
            f32x16 p0, p1; float mn, al; bf16x8 pa0, pa1, pa2, pa3;
            SBAR(); qkt<0, false>(p0, p1, lds + DMA_KR + slot * SHM_K, r32, hi, qr, true);
            if (kb_ + KVBLK - 1 > qlo || kb_ <= qlo + QBLK - 1 - W) mask_tile(p0, p1, qm - kb_, (unsigned)W);
            partialSM(p0, p1, m_reg, mn, al);
            finishSM(p0, p1, al, l_reg, pa0, pa1, pa2, pa3); SBAR();
            if (__any(al < 1.f)) { if (hi == 0) al_l[r32] = al; asm volatile("s_waitcnt lgkmcnt(0)" ::: "memory");
                for (int d_ = 0; d_ < 4; ++d_) for (int r = 0; r < 16; ++r) o[d_][r] *= al_l[crow(r, hi)]; }
            pv_tile<0, false>(o, vbase + slot * SHM_V, pa0, pa1, pa2, pa3, true);
        }
        slot = slot == 2 ? 0 : slot + 1; slot2 = slot2 == 2 ? 0 : slot2 + 1;
    }
#undef DMA_TILE
    if (wact) {
        if (hi == 0) li_l[r32] = l_reg; asm volatile("s_waitcnt lgkmcnt(0)" ::: "memory");
        float rli[16];
#pragma unroll
        for (int r = 0; r < 16; ++r) rli[r] = __builtin_amdgcn_rcpf(li_l[crow(r, hi)]);
        const int OP_ = cur.opitch; TOut* Ow = cur.O + (size_t)(wid * QBLK) * OP_;
        if (hi == 0) cur.L[(size_t)(wid * QBLK + r32) * cur.lpitch] = m_reg * (1.4426950408889634f * SCALE) + __builtin_amdgcn_logf(l_reg);
#pragma unroll
        for (int r = 0; r < 16; ++r) { const int orow = crow(r, hi);
#pragma unroll
            for (int d0 = 0; d0 < 4; ++d0) { const float v = o[d0][r] * rli[r];
                const float vn = __builtin_bit_cast(float, __builtin_amdgcn_mov_dpp(__builtin_bit_cast(int, v), 0xB1, 0xF, 0xF, true));
                if ((r32 & 1) == 0) *(unsigned*)(Ow + (size_t)orow * OP_ + d0 * 32 + r32) = cvtpk(v, vn); } }
    }
    asm volatile("s_waitcnt lgkmcnt(0)" ::: "memory"); __builtin_amdgcn_s_barrier(); asm volatile("" ::: "memory");
}
typedef BlockRef<bf16_t, bf16_t> Ref;
}
#undef KSWZ

__device__ __forceinline__ swa::Ref attn_ref(unsigned char* ws, int L, int& skv) {
    int gi, b, h, c, qb;
    if (L < 256) { gi = 0; b = L >> 5; h = (L >> 3) & 3; qb = L & 7; c = 0; }
    else if (L < 512) { L -= 256; gi = 1; b = L >> 5; h = (L >> 3) & 3; c = (L >> 1) & 3; qb = L & 1; }
    else { L -= 512; gi = 2; const int v = L & 255, idx = (v & 31) * 2 + (L >> 8); b = v >> 5; h = idx >> 4; c = idx & 15; qb = 0; }
    const int d = gi == 0 ? 1 : (gi == 1 ? 4 : 16);
    const int n = SEQ / d;
    const size_t hb = ((size_t)(gi * BATCH + b) * HPG + h) * SEQ * HD + (size_t)c * n * HD, kstep = (size_t)3 * BATCH * HPG * SEQ * HD;
    const bf16_t* qkv = (const bf16_t*)(ws + OFF_QKV);
    const size_t tok0 = (size_t)b * SEQ + c + (size_t)qb * 256 * d;
    swa::Ref r;
    r.Q = qkv + hb + (size_t)qb * 256 * HD; r.K = qkv + kstep + hb; r.V = qkv + 2 * kstep + hb;
    r.O = (bf16_t*)(ws + OFF_AO) + ((size_t)gi * MTOK + tok0) * ATT_W + h * HD; r.opitch = d * ATT_W;
    r.L = (float*)(ws + OFF_ALSE) + ((size_t)gi * MTOK + tok0) * 4 + h; r.lpitch = d * 4;
    r.P0 = qb * 256; r.pitch = HD; r.nq = gi == 2 ? 128 : 256;
    skv = SEQ / d;
    return r;
}
namespace wsa2 {
using swa::f32x16; using swa::s16x4; using swa::crow; using swa::cvtpk; using swa::v_rd_base; using swa::SCALE; using swa::THR;
constexpr int BLK_K = 8192, SLOT = 16384, NSLOT = 9, SCR = NSLOT * SLOT, LDS_NEED = SCR + NWAVES * 256;
static_assert(LDS_NEED <= MISC_OFF, "wsa2 LDS");
#define W2_KSWZ(row, colB) ((row) * 256 + ((colB) ^ (((row) & 7) << 4)))
#define W2_SBAR() __builtin_amdgcn_sched_barrier(0)
__device__ __forceinline__ void unit(const swa::Ref& u, LAS unsigned char* lds, int wave_s) {
    const int tid = tid_from(wave_s), wid = wave_s, lane = tid & 63, r32 = lane & 31, hi = lane >> 5;
    const int I0 = u.P0, i0 = I0 + 32 * wid;
    const bool wact = 32 * wid < u.nq;
    const int B0 = (I0 >= 128 ? I0 - 128 : 0) >> 5;
    const int kfirst = i0 >= 128 ? i0 - 128 : 0, nblk = wact ? ((i0 - kfirst) >> 5) + 1 : 0, fw = (kfirst >> 5) - B0;
    const int ilast = I0 + u.nq - 32, klast = ilast >= 128 ? ilast - 128 : 0;
    const int nbtot = (ilast >> 5) - B0 + 1, niter = ((ilast - klast) >> 5) + 1;
    const int krow = 4 * wid + (lane >> 4), kchunk = (lane & 15) ^ (4 * (wid & 1) + (lane >> 4));
    const int kk = (wid >> 1) * 8 + ((lane & 31) >> 2), vkey = (kk & ~0xC) | ((kk & 4) << 1) | ((kk & 8) >> 1), vcol = ((2 * (wid & 1) + (lane >> 5)) & 3) * 32 + (lane & 3) * 8;
    const bf16_t* ksrc = u.K + (size_t)(B0 * 32 + krow) * HD + kchunk * 8;
    const bf16_t* vsrc = u.V + (size_t)(B0 * 32 + vkey) * HD + vcol;
    typedef __attribute__((address_space(3))) unsigned lds_u32;
    const unsigned ldsb = (unsigned)(size_t)lds;
#define W2_DMA(b, slot) do { __builtin_amdgcn_global_load_lds((const unsigned*)(ksrc + (size_t)(b) * 32 * HD), (lds_u32*)(size_t)(ldsb + (slot) * SLOT + wid * 1024), 16, 0, 0); \
        __builtin_amdgcn_global_load_lds((const unsigned*)(vsrc + (size_t)(b) * 32 * HD), (lds_u32*)(size_t)(ldsb + (slot) * SLOT + BLK_K + wid * 1024), 16, 0, 0); } while (0)
    for (int b = 0; b < 8 && b < nbtot; ++b) W2_DMA(b, b);
    bf16x8 qr[8];
    { const int qrow = wact ? 32 * wid + r32 : u.nq - 1;
#pragma unroll
      for (int d0 = 0; d0 < 8; ++d0) qr[d0] = *(const bf16x8*)(u.Q + (size_t)qrow * HD + d0 * 16 + hi * 8); }
    LAS float* li_l = (LAS float*)(lds + SCR + wid * 256); LAS float* al_l = li_l + 32;
    float m_reg = -1e30f, l_reg = 0.f; f32x16 o[4] = {};
    constexpr float C2 = 1.4426950408889634f * SCALE;
    int koff[4];
#pragma unroll
    for (int dd = 0; dd < 4; ++dd) koff[dd] = W2_KSWZ(r32, (dd * 16 + hi * 8) * 2);
    const unsigned vrb = ldsb + BLK_K + (unsigned)v_rd_base(lane);
#pragma unroll 1
    for (int i = 0; i < niter; ++i) {
        asm volatile("s_waitcnt vmcnt(0)" ::: "memory");
        asm volatile("s_waitcnt lgkmcnt(0)" ::: "memory"); __builtin_amdgcn_s_barrier(); asm volatile("" ::: "memory");
        if (i + 8 < nbtot) { const int s8 = (i + 8) % NSLOT; W2_DMA(i + 8, s8); }
        if (i < nblk) {
            const int rel = fw + i, slot = rel % NSLOT, k0 = (B0 + rel) * 32;
            const LAS unsigned char* kb = lds + slot * SLOT;
            f32x16 p = {};
#pragma unroll
            for (int d0 = 0; d0 < 8; ++d0) { const bf16x8 kf = *(const LAS bf16x8*)(kb + koff[d0 & 3] + (d0 >> 2) * 128);
                p = __builtin_amdgcn_mfma_f32_32x32x16_bf16(kf, qr[d0], p, 0, 0, 0); }
            if (k0 == i0 || k0 + 128 == i0) {
                const int dq = i0 + r32 - k0 - 4 * hi; const float NEG = -__builtin_inff();
#pragma unroll
                for (int r = 0; r < 16; ++r) { const int c = (r & 3) + 8 * (r >> 2); if ((unsigned)(dq - c) >= 129u) p[r] = NEG; }
            }
            float pmax = p[0];
#pragma unroll
            for (int r = 1; r < 16; ++r) pmax = fmaxf(pmax, p[r]);
            { auto rr = __builtin_amdgcn_permlane32_swap(__float_as_uint(pmax), __float_as_uint(pmax), false, false); pmax = fmaxf(__uint_as_float(rr[0]), __uint_as_float(rr[1])); }
            float mn, alpha;
            if (__builtin_expect(__all((pmax - m_reg) * SCALE <= THR), 1)) { mn = m_reg; alpha = 1.f; }
            else { mn = fmaxf(m_reg, pmax); alpha = __builtin_amdgcn_exp2f((m_reg - mn) * C2); m_reg = mn; }
            const float mnL = -mn * C2;
#pragma unroll
            for (int r = 0; r < 16; ++r) p[r] = __builtin_amdgcn_exp2f(fmaf(p[r], C2, mnL));
            float ps = 0.f;
#pragma unroll
            for (int r = 0; r < 16; ++r) ps += p[r];
            { auto rr = __builtin_amdgcn_permlane32_swap(__float_as_uint(ps), __float_as_uint(ps), false, false); ps = __uint_as_float(rr[0]) + __uint_as_float(rr[1]); }
            l_reg = l_reg * alpha + ps;
            bf16x8 pa0, pa1;
#define W2_PK4(B_, OUT) do { unsigned a0 = cvtpk(p[B_+0], p[B_+1]), a1 = cvtpk(p[B_+2], p[B_+3]), b0 = cvtpk(p[B_+4], p[B_+5]), b1 = cvtpk(p[B_+6], p[B_+7]); \
            auto r0 = __builtin_amdgcn_permlane32_swap(a0, b0, false, false); auto r1 = __builtin_amdgcn_permlane32_swap(a1, b1, false, false); \
            u32x4 w = {r0[0], r1[0], r0[1], r1[1]}; OUT = *reinterpret_cast<bf16x8*>(&w); } while (0)
            W2_PK4(0, pa0); W2_PK4(8, pa1);
#undef W2_PK4
            if (__any(alpha < 1.f)) {
                if (hi == 0) al_l[r32] = alpha;
                asm volatile("s_waitcnt lgkmcnt(0)" ::: "memory");
#pragma unroll
                for (int d_ = 0; d_ < 4; ++d_)
#pragma unroll
                    for (int r = 0; r < 16; ++r) o[d_][r] *= al_l[crow(r, hi)];
            }
            const unsigned vb0 = vrb + (unsigned)(slot * SLOT);
#define W2_TR(dst, off) asm volatile("ds_read_b64_tr_b16 %0, %1 offset:%2" : "=&v"(dst) : "v"(vb0), "i"(off) : "memory")
#define W2_PV(d0) do { s16x4 l0, l1, h0, h1; W2_TR(l0, (d0) * 512); W2_TR(h0, (d0) * 512 + 2048); W2_TR(l1, (d0) * 512 + 4096); W2_TR(h1, (d0) * 512 + 6144); \
            asm volatile("s_waitcnt lgkmcnt(0)" ::: "memory"); W2_SBAR(); \
            o[d0] = __builtin_amdgcn_mfma_f32_32x32x16_bf16(pa0, (bf16x8){l0[0], l0[1], l0[2], l0[3], h0[0], h0[1], h0[2], h0[3]}, o[d0], 0, 0, 0); \
            o[d0] = __builtin_amdgcn_mfma_f32_32x32x16_bf16(pa1, (bf16x8){l1[0], l1[1], l1[2], l1[3], h1[0], h1[1], h1[2], h1[3]}, o[d0], 0, 0, 0); } while (0)
            W2_PV(0); W2_PV(1); W2_PV(2); W2_PV(3);
#undef W2_PV
#undef W2_TR
        }
    }
#undef W2_DMA
    if (wact) {
        if (hi == 0) li_l[r32] = l_reg;
        asm volatile("s_waitcnt lgkmcnt(0)" ::: "memory");
        float rli[16];
#pragma unroll
        for (int r = 0; r < 16; ++r) rli[r] = __builtin_amdgcn_rcpf(li_l[crow(r, hi)]);
        if (hi == 0) u.L[(size_t)(32 * wid + r32) * u.lpitch] = m_reg * C2 + __builtin_amdgcn_logf(l_reg);
        const int OP = u.opitch; bf16_t* Ow = u.O + (size_t)(32 * wid) * OP;
#pragma unroll
        for (int r = 0; r < 16; ++r) { const int orow = crow(r, hi);
#pragma unroll
            for (int d0 = 0; d0 < 4; ++d0) { const float v = o[d0][r] * rli[r];
                const float vn = __builtin_bit_cast(float, __builtin_amdgcn_mov_dpp(__builtin_bit_cast(int, v), 0xB1, 0xF, 0xF, true));
                if ((r32 & 1) == 0) *(unsigned*)(Ow + (size_t)orow * OP + d0 * 32 + r32) = cvtpk(v, vn); } }
    }
    asm volatile("s_waitcnt lgkmcnt(0)" ::: "memory"); __builtin_amdgcn_s_barrier(); asm volatile("" ::: "memory");
}
#undef W2_KSWZ
#undef W2_SBAR
}

constexpr int N_ATTN_BLOCKS = 1024;

namespace wsa3 {
using swa::f32x16; using swa::s16x4; using swa::crow; using swa::cvtpk; using swa::v_rd_base; using swa::SCALE; using swa::THR;
constexpr int BLK_K = 8192, SLOT = 16384, NSLOT = 9, SCR = NSLOT * SLOT, LDS_NEED = SCR + NWAVES * 256;
static_assert(LDS_NEED <= MISC_OFF, "wsa3 LDS");
#define W3_KSWZ(row, colB) ((row) * 256 + ((colB) ^ (((row) & 7) << 4)))
#define W3_SBAR() __builtin_amdgcn_sched_barrier(0)
__device__ __forceinline__ void wait_vm_ops(int n) {
    switch (n >> 1) {
    case 0: asm volatile("s_waitcnt vmcnt(0)" ::: "memory"); break;
    case 1: asm volatile("s_waitcnt vmcnt(2)" ::: "memory"); break;
    case 2: asm volatile("s_waitcnt vmcnt(4)" ::: "memory"); break;
    case 3: asm volatile("s_waitcnt vmcnt(6)" ::: "memory"); break;
    case 4: asm volatile("s_waitcnt vmcnt(8)" ::: "memory"); break;
    case 5: asm volatile("s_waitcnt vmcnt(10)" ::: "memory"); break;
    case 6: asm volatile("s_waitcnt vmcnt(12)" ::: "memory"); break;
    case 7: asm volatile("s_waitcnt vmcnt(14)" ::: "memory"); break;
    case 8: asm volatile("s_waitcnt vmcnt(16)" ::: "memory"); break;
    case 9: asm volatile("s_waitcnt vmcnt(18)" ::: "memory"); break;
    case 10: asm volatile("s_waitcnt vmcnt(20)" ::: "memory"); break;
    case 11: asm volatile("s_waitcnt vmcnt(22)" ::: "memory"); break;
    case 12: asm volatile("s_waitcnt vmcnt(24)" ::: "memory"); break;
    case 13: asm volatile("s_waitcnt vmcnt(26)" ::: "memory"); break;
    case 14: asm volatile("s_waitcnt vmcnt(28)" ::: "memory"); break;
    case 15: asm volatile("s_waitcnt vmcnt(30)" ::: "memory"); break;
    case 16: asm volatile("s_waitcnt vmcnt(32)" ::: "memory"); break;
    case 17: asm volatile("s_waitcnt vmcnt(34)" ::: "memory"); break;
    case 18: asm volatile("s_waitcnt vmcnt(36)" ::: "memory"); break;
    case 19: asm volatile("s_waitcnt vmcnt(38)" ::: "memory"); break;
    case 20: asm volatile("s_waitcnt vmcnt(40)" ::: "memory"); break;
    case 21: asm volatile("s_waitcnt vmcnt(42)" ::: "memory"); break;
    case 22: asm volatile("s_waitcnt vmcnt(44)" ::: "memory"); break;
    case 23: asm volatile("s_waitcnt vmcnt(46)" ::: "memory"); break;
    case 24: asm volatile("s_waitcnt vmcnt(48)" ::: "memory"); break;
    case 25: asm volatile("s_waitcnt vmcnt(50)" ::: "memory"); break;
    case 26: asm volatile("s_waitcnt vmcnt(52)" ::: "memory"); break;
    case 27: asm volatile("s_waitcnt vmcnt(54)" ::: "memory"); break;
    case 28: asm volatile("s_waitcnt vmcnt(56)" ::: "memory"); break;
    case 29: asm volatile("s_waitcnt vmcnt(58)" ::: "memory"); break;
    case 30: asm volatile("s_waitcnt vmcnt(60)" ::: "memory"); break;
    default: asm volatile("s_waitcnt vmcnt(62)" ::: "memory"); break;
    }
}
__device__ __forceinline__ void phase(const Frame& F, unsigned char* ws, int layer, unsigned long long& ts_sum, unsigned long long& ts_t0) {
    const int wid = F.wave, tid = tid_from(wid), lane = tid & 63, r32 = lane & 31, hi = lane >> 5;
    LAS unsigned char* lds = F.lds;
    const int nU = F.vcu < N_ATTN_BLOCKS ? (N_ATTN_BLOCKS - 1 - F.vcu) / F.G + 1 : 0;
    if (nU == 0) return;
    const int krow = 4 * wid + (lane >> 4), kchunk = (lane & 15) ^ (4 * (wid & 1) + (lane >> 4));
    const int kk = (wid >> 1) * 8 + ((lane & 31) >> 2), vkey = (kk & ~0xC) | ((kk & 4) << 1) | ((kk & 8) >> 1), vcol = ((2 * (wid & 1) + (lane >> 5)) & 3) * 32 + (lane & 3) * 8;
    const unsigned klane = (unsigned)(krow * HD + kchunk * 8) * 2u, vlane = (unsigned)(vkey * HD + vcol) * 2u;
    typedef __attribute__((address_space(3))) unsigned lds_u32;
    const unsigned ldsb = (unsigned)(size_t)lds;
    LAS float* li_l = (LAS float*)(lds + SCR + wid * 256); LAS float* al_l = li_l + 32;
    constexpr float C2 = 1.4426950408889634f * SCALE;
    int koff[4];
#pragma unroll
    for (int dd = 0; dd < 4; ++dd) koff[dd] = W3_KSWZ(r32, (dd * 16 + hi * 8) * 2);
    const unsigned vrb = ldsb + BLK_K + (unsigned)v_rd_base(lane);
    int kI = -1, tI = 5, jI = 0, nbI = 0, issued = 0, consumed = 0, islot = 0, qmark = -1, smark = -1, nst = 0;
    const char* kbI = nullptr; const char* vbI = nullptr;
    bf16x8 qn[8], qr[8];
#define W3_SETUP_I() do { int skv_; const swa::Ref ri = attn_ref(ws, F.vcu + kI * F.G, skv_); \
        const int I0_ = ri.P0, B0_ = (I0_ >= 128 ? I0_ - 128 : 0) >> 5; nbI = ((I0_ + ri.nq - 32) >> 5) - B0_ + 1; tI = 0; jI = 0; \
        kbI = (const char*)(ri.K + (size_t)B0_ * 32 * HD); vbI = (const char*)(ri.V + (size_t)B0_ * 32 * HD); \
        const int qrow_ = 32 * wid < ri.nq ? 32 * wid + r32 : ri.nq - 1; const bf16_t* qp_ = ri.Q + (size_t)qrow_ * HD + hi * 8; \
        _Pragma("unroll") for (int d0 = 0; d0 < 8; ++d0) asm volatile("global_load_dwordx4 %0, %1, off" : "=v"(qn[d0]) : "v"(qp_ + d0 * 16) : "memory"); \
        qmark = issued; } while (0)
#define W3_ISSUE(kC_) do { for (;;) { \
        if (tI >= 5) { if (kI + 1 >= nU || kI >= (kC_) + 1) break; ++kI; W3_SETUP_I(); } \
        if (issued - consumed >= NSLOT) break; \
        __builtin_amdgcn_global_load_lds((const unsigned*)(kbI + (size_t)jI * (32 * HD * 2) + klane), (lds_u32*)(size_t)(ldsb + islot * SLOT + wid * 1024), 16, 0, 2); \
        __builtin_amdgcn_global_load_lds((const unsigned*)(vbI + (size_t)jI * (32 * HD * 2) + vlane), (lds_u32*)(size_t)(ldsb + islot * SLOT + BLK_K + wid * 1024), 16, 0, 2); \
        ++issued; islot = islot == NSLOT - 1 ? 0 : islot + 1; \
        jI += 5; while (tI < 5 && jI >= nbI) { ++tI; jI = tI; } } } while (0)
    asm volatile("s_waitcnt lgkmcnt(0)" ::: "memory"); __builtin_amdgcn_s_barrier(); asm volatile("" ::: "memory");
    W3_ISSUE(-1);
    int spos = 0;
#pragma unroll 1
    for (int kC = 0; kC < nU; ++kC) {
        if (W_TOUCH2 == 2 && kC == nU - 1 && F.vcu < 256 && wid < 3) {
            const int ln_ = tid_from(wid) & 63, cu_ = F.vcu; const char* tp_;
            if (wid == 0) tp_ = (const char*)(ws + OFF_WOUT) + (size_t)layer * D_MODEL * D_MODEL * 2 + ((size_t)cu_ * 64 + ln_) * 128;
            else if (wid == 1) tp_ = (ln_ < 32 ? (const char*)(ws + OFF_WBS) + (size_t)layer * D_MODEL * SSM_W * 2 : (const char*)(ws + OFF_WBA) + (size_t)layer * D_MODEL * ATT_W * 2) + ((size_t)cu_ * 32 + (ln_ & 31)) * 128;
            else tp_ = (const char*)(ws + OFF_WGLU) + (size_t)layer * SSM_W * SSM_W * 2 + ((size_t)cu_ * 16 + (ln_ & 15)) * 128;
            __builtin_amdgcn_global_load_lds((const unsigned*)tp_, (lds_u32*)(size_t)(ldsb + 155648 + wid * 256), 4, 0, 0);
        }
        int skv; const swa::Ref u = attn_ref(ws, F.vcu + kC * F.G, skv);
        const int I0 = u.P0, i0 = I0 + 32 * wid;
        const bool wact = 32 * wid < u.nq;
        const int B0 = (I0 >= 128 ? I0 - 128 : 0) >> 5;
        const int kfirst = i0 >= 128 ? i0 - 128 : 0, nblk = wact ? ((i0 - kfirst) >> 5) + 1 : 0, fw = (kfirst >> 5) - B0;
        const int nbtot = ((I0 + u.nq - 32) >> 5) - B0 + 1;
        float m_reg = -1e30f, l_reg = 0.f; f32x16 o[4] = {};
#pragma unroll 1
        for (int t = 0; t < 5; ++t) {
            const int cnt = t < nbtot ? (nbtot - t + 4) / 5 : 0;
            if (cnt == 0) continue;
            TS_BEGIN(31);
            { const int endp = spos + cnt; wait_vm_ops(2 * (issued - endp) + (qmark >= endp ? 8 : 0) + (smark >= endp ? nst : 0)); }
            asm volatile("s_waitcnt lgkmcnt(0)" ::: "memory"); __builtin_amdgcn_s_barrier(); asm volatile("" ::: "memory");
            if (t == 0) {
                asm volatile("" : "+v"(qn[0]), "+v"(qn[1]), "+v"(qn[2]), "+v"(qn[3]), "+v"(qn[4]), "+v"(qn[5]), "+v"(qn[6]), "+v"(qn[7]));
#pragma unroll
                for (int d0 = 0; d0 < 8; ++d0) qr[d0] = qn[d0];
            }
            TS_END(31); TS_BEGIN(34);
            consumed = spos; W3_ISSUE(kC);
            TS_END(34); TS_BEGIN(32);
            const int rj = (t - fw) % 5, j = fw + (rj < 0 ? rj + 5 : rj);
            if (j < fw + nblk) {
                const int slot = (spos + (j - t) / 5) % NSLOT, k0 = (B0 + j) * 32;
                const LAS unsigned char* kb = lds + slot * SLOT;
                f32x16 p = {};
#pragma unroll
                for (int d0 = 0; d0 < 8; ++d0) { const bf16x8 kf = *(const LAS bf16x8*)(kb + koff[d0 & 3] + (d0 >> 2) * 128);
                    p = __builtin_amdgcn_mfma_f32_32x32x16_bf16(kf, qr[d0], p, 0, 0, 0); }
                if (k0 == i0 || k0 + 128 == i0) {
                    const int dq = i0 + r32 - k0 - 4 * hi; const float NEG = -__builtin_inff();
#pragma unroll
                    for (int r = 0; r < 16; ++r) { const int c = (r & 3) + 8 * (r >> 2); if ((unsigned)(dq - c) >= 129u) p[r] = NEG; }
                }
                float pmax = p[0];
#pragma unroll
                for (int r = 1; r < 16; ++r) pmax = fmaxf(pmax, p[r]);
                { auto rr = __builtin_amdgcn_permlane32_swap(__float_as_uint(pmax), __float_as_uint(pmax), false, false); pmax = fmaxf(__uint_as_float(rr[0]), __uint_as_float(rr[1])); }
                float mn, alpha;
                if (__builtin_expect(__all((pmax - m_reg) * SCALE <= THR), 1)) { mn = m_reg; alpha = 1.f; }
                else { mn = fmaxf(m_reg, pmax); alpha = __builtin_amdgcn_exp2f((m_reg - mn) * C2); m_reg = mn; }
                const float mnL = -mn * C2;
#pragma unroll
                for (int r = 0; r < 16; ++r) p[r] = __builtin_amdgcn_exp2f(fmaf(p[r], C2, mnL));
                float ps = 0.f;
#pragma unroll
                for (int r = 0; r < 16; ++r) ps += p[r];
                { auto rr = __builtin_amdgcn_permlane32_swap(__float_as_uint(ps), __float_as_uint(ps), false, false); ps = __uint_as_float(rr[0]) + __uint_as_float(rr[1]); }
                l_reg = l_reg * alpha + ps;
                bf16x8 pa0, pa1;
#define W3_PK4(B_, OUT) do { unsigned a0 = cvtpk(p[B_+0], p[B_+1]), a1 = cvtpk(p[B_+2], p[B_+3]), b0 = cvtpk(p[B_+4], p[B_+5]), b1 = cvtpk(p[B_+6], p[B_+7]); \
                auto r0 = __builtin_amdgcn_permlane32_swap(a0, b0, false, false); auto r1 = __builtin_amdgcn_permlane32_swap(a1, b1, false, false); \
                u32x4 w = {r0[0], r1[0], r0[1], r1[1]}; OUT = *reinterpret_cast<bf16x8*>(&w); } while (0)
                W3_PK4(0, pa0); W3_PK4(8, pa1);
#undef W3_PK4
                if (__any(alpha < 1.f)) {
                    if (hi == 0) al_l[r32] = alpha;
                    asm volatile("s_waitcnt lgkmcnt(0)" ::: "memory");
#pragma unroll
                    for (int d_ = 0; d_ < 4; ++d_)
#pragma unroll
                        for (int r = 0; r < 16; ++r) o[d_][r] *= al_l[crow(r, hi)];
                }
                const unsigned vb0 = vrb + (unsigned)(slot * SLOT);
#define W3_TR(dst, off) asm volatile("ds_read_b64_tr_b16 %0, %1 offset:%2" : "=&v"(dst) : "v"(vb0), "i"(off) : "memory")
#define W3_PV(d0) do { s16x4 l0, l1, h0, h1; W3_TR(l0, (d0) * 512); W3_TR(h0, (d0) * 512 + 2048); W3_TR(l1, (d0) * 512 + 4096); W3_TR(h1, (d0) * 512 + 6144); \
                asm volatile("s_waitcnt lgkmcnt(0)" ::: "memory"); W3_SBAR(); \
                o[d0] = __builtin_amdgcn_mfma_f32_32x32x16_bf16(pa0, (bf16x8){l0[0], l0[1], l0[2], l0[3], h0[0], h0[1], h0[2], h0[3]}, o[d0], 0, 0, 0); \
                o[d0] = __builtin_amdgcn_mfma_f32_32x32x16_bf16(pa1, (bf16x8){l1[0], l1[1], l1[2], l1[3], h1[0], h1[1], h1[2], h1[3]}, o[d0], 0, 0, 0); } while (0)
                W3_PV(0); W3_PV(1); W3_PV(2); W3_PV(3);
#undef W3_PV
#undef W3_TR
            }
            spos += cnt;
            TS_END(32);
        }
        TS_BEGIN(33);
        if (wact) {
            if (hi == 0) li_l[r32] = l_reg;
            asm volatile("s_waitcnt lgkmcnt(0)" ::: "memory");
            float rli[16];
#pragma unroll
            for (int r = 0; r < 16; ++r) rli[r] = __builtin_amdgcn_rcpf(li_l[crow(r, hi)]);
            { const float lse = m_reg * C2 + __builtin_amdgcn_logf(l_reg); const unsigned lo_ = (unsigned)((32 * wid + r32) * u.lpitch) * 4u;
              asm volatile("global_store_dword %0, %1, %2" :: "v"(lo_), "v"(lse), "s"(u.L) : "memory"); }
            const int OP = u.opitch; const bf16_t* Ow = u.O + (size_t)(32 * wid) * OP;
            const unsigned lane_off = (unsigned)(4 * hi * OP + 4 * r32) * 2u;
#pragma unroll
            for (int r = 0; r < 16; ++r) { const unsigned vo = lane_off + (unsigned)(((r & 3) + 8 * (r >> 2)) * OP) * 2u;
                typedef unsigned u32x2_ __attribute__((ext_vector_type(2)));
                u32x2_ w; w.x = cvtpk(o[0][r] * rli[r], o[1][r] * rli[r]); w.y = cvtpk(o[2][r] * rli[r], o[3][r] * rli[r]);
                asm volatile("global_store_dwordx2 %0, %1, %2" :: "v"(vo), "v"(w), "s"(Ow) : "memory"); }
            smark = issued; nst = 17;
        } else { smark = -1; nst = 0; }
        TS_END(33);
    }
#undef W3_ISSUE
#undef W3_SETUP_I
    asm volatile("s_waitcnt lgkmcnt(0)" ::: "memory"); __builtin_amdgcn_s_barrier(); asm volatile("" ::: "memory");
}
#undef W3_KSWZ
#undef W3_SBAR
}


__device__ __forceinline__ void attn_phase(const Frame& F, unsigned char* ws, int layer, unsigned long long& ts_sum, unsigned long long& ts_t0) {
#if ATTN_DMA == 3
    wsa3::phase(F, ws, layer, ts_sum, ts_t0);
    return;
#endif
#if ATTN_DMA == 2
#if EXP_HALF == 2
    if (F.vcu & 1) return;
    for (int L = F.vcu; L < N_ATTN_BLOCKS; L += F.G) { for (int e = 0; e < 2; ++e) { int skv; const swa::Ref cur = attn_ref(ws, L + e, skv); wsa2::unit(cur, F.lds, F.wave); } }
    return;
#endif
    for (int L = F.vcu; L < N_ATTN_BLOCKS; L += F.G) { int skv; const swa::Ref cur = attn_ref(ws, L, skv); wsa2::unit(cur, F.lds, F.wave); }
    return;
#elif ATTN_DMA == 1
    for (int L = F.vcu; L < N_ATTN_BLOCKS; L += F.G) { int skv; const swa::Ref cur = attn_ref(ws, L, skv); swa::block_dma<bf16_t, bf16_t>(cur, skv, 129, (char*)F.lds, F.wave); }
    return;
#endif
    int L = F.vcu; if (L >= N_ATTN_BLOCKS) return;
    char* lds = (char*)F.lds;
    int skv, skvn; swa::Ref cur = attn_ref(ws, L, skv);
    swa::Seam<bf16_t> S;
    swa::causal_swa_prime<bf16_t, bf16_t>(cur, 129, lds, S, F.wave);
    for (;;) {
        const int Ln = L + F.G; const bool last = Ln >= N_ATTN_BLOCKS;
        swa::Ref nxt = cur; skvn = skv; if (!last) nxt = attn_ref(ws, Ln, skvn);
        swa::causal_swa_block<bf16_t, bf16_t>(cur, nxt, skv, 129, lds, S, F.wave);
        if (last) break;
        cur = nxt; skv = skvn; L = Ln;
    }
}

namespace wsa {
using swa::f32x16; using swa::s16x4; using swa::crow; using swa::cvtpk; using swa::v_st; using swa::v_rd_base; using swa::SCALE; using swa::THR;
constexpr int VBUF = 8192;
constexpr int WAVE_LDS = 2 * VBUF + 256;
struct Item { const bf16_t* Q; const bf16_t* K; const bf16_t* V; bf16_t* O; float* L; int i0, pitch, opitch, lpitch; };
constexpr int N_ITEMS = 3 * 2048;
__device__ __forceinline__ Item decode(unsigned char* ws, int it) {
    const int gi = it >> 11, r = it & 2047, b = r >> 8, h = (r >> 6) & 3;
    int c, qw, d;
    if (gi == 0) { c = 0; qw = r & 63; d = 1; } else if (gi == 1) { c = (r >> 4) & 3; qw = r & 15; d = 4; } else { c = (r >> 2) & 15; qw = r & 3; d = 16; }
    Item x; x.i0 = 32 * qw; x.pitch = HD; x.opitch = d * ATT_W; x.lpitch = d * 4;
    const size_t hb = ((size_t)(gi * BATCH + b) * HPG + h) * SEQ * HD + (size_t)c * (SEQ / d) * HD, kstep = (size_t)3 * BATCH * HPG * SEQ * HD;
    const bf16_t* qkv = (const bf16_t*)(ws + OFF_QKV);
    const size_t tok0 = (size_t)b * SEQ + c + (size_t)x.i0 * d;
    x.Q = qkv + hb + (size_t)x.i0 * HD; x.K = qkv + kstep + hb; x.V = qkv + 2 * kstep + hb;
    x.O = (bf16_t*)(ws + OFF_AO) + ((size_t)gi * MTOK + tok0) * ATT_W + h * HD;
    x.L = (float*)(ws + OFF_ALSE) + ((size_t)gi * MTOK + tok0) * 4 + h;
    return x;
}
#define WSA_SBAR() __builtin_amdgcn_sched_barrier(0)
__device__ __forceinline__ void wave_item(const Item& it, LAS unsigned char* wl, int lane) {
    const int r32 = lane & 31, hi = lane >> 5, pitch = it.pitch;
    LAS float* li_l = (LAS float*)(wl + 2 * VBUF); LAS float* al_l = li_l + 32;
    const int kfirst = it.i0 >= 128 ? it.i0 - 128 : 0, nblk = ((it.i0 - kfirst) >> 5) + 1;
    const bf16_t* qp = it.Q + (size_t)r32 * pitch + hi * 8;
    const bf16_t* kp = it.K + (size_t)(kfirst + r32) * pitch + hi * 8;
    const int vkey = lane >> 4, vch = (lane & 15) * 8;
    const bf16_t* vp = it.V + (size_t)(kfirst + vkey) * pitch + vch;
    int vst_off[8];
#pragma unroll
    for (int i = 0; i < 8; ++i) vst_off[i] = v_st(vkey + 4 * i, vch);
    bf16x8 qr[8], kf[8], vs[8];
#pragma unroll
    for (int d0 = 0; d0 < 8; ++d0) qr[d0] = *(const bf16x8*)(qp + d0 * 16);
#pragma unroll
    for (int d0 = 0; d0 < 8; ++d0) kf[d0] = *(const bf16x8*)(kp + d0 * 16);
#pragma unroll
    for (int i = 0; i < 8; ++i) vs[i] = *(const bf16x8*)(vp + (size_t)(4 * i) * pitch);
#pragma unroll
    for (int i = 0; i < 8; ++i) *(LAS bf16x8*)(wl + vst_off[i]) = vs[i];
    float m_reg = -1e30f, l_reg = 0.f; f32x16 o[4] = {};
    const unsigned vbase = (unsigned)(size_t)wl + (unsigned)v_rd_base(lane);
    constexpr float C2 = 1.4426950408889634f * SCALE;
#pragma unroll 1
    for (int blk = 0; blk < nblk; ++blk) {
        const int k0 = kfirst + 32 * blk; const bool more = blk + 1 < nblk;
        if (more) {
#pragma unroll
            for (int i = 0; i < 8; ++i) vs[i] = *(const bf16x8*)(vp + (size_t)(32 * (blk + 1) + 4 * i) * pitch);
        }
        f32x16 p = {};
#pragma unroll
        for (int d0 = 0; d0 < 8; ++d0) p = __builtin_amdgcn_mfma_f32_32x32x16_bf16(kf[d0], qr[d0], p, 0, 0, 0);
        if (more) {
#pragma unroll
            for (int d0 = 0; d0 < 8; ++d0) kf[d0] = *(const bf16x8*)(kp + (size_t)(32 * (blk + 1)) * pitch + d0 * 16);
        }
        if (k0 == it.i0 || k0 + 128 == it.i0) {
            const int dq = it.i0 + r32 - k0 - 4 * hi; const float NEG = -__builtin_inff();
#pragma unroll
            for (int r = 0; r < 16; ++r) { const int c = (r & 3) + 8 * (r >> 2); if ((unsigned)(dq - c) >= 129u) p[r] = NEG; }
        }
        float pmax = p[0];
#pragma unroll
        for (int r = 1; r < 16; ++r) pmax = fmaxf(pmax, p[r]);
        { auto rr = __builtin_amdgcn_permlane32_swap(__float_as_uint(pmax), __float_as_uint(pmax), false, false); pmax = fmaxf(__uint_as_float(rr[0]), __uint_as_float(rr[1])); }
        float mn, alpha;
        if (__builtin_expect(__all((pmax - m_reg) * SCALE <= THR), 1)) { mn = m_reg; alpha = 1.f; }
        else { mn = fmaxf(m_reg, pmax); alpha = __builtin_amdgcn_exp2f((m_reg - mn) * C2); m_reg = mn; }
        const float mnL = -mn * C2;
#pragma unroll
        for (int r = 0; r < 16; ++r) p[r] = __builtin_amdgcn_exp2f(fmaf(p[r], C2, mnL));
        float ps = 0.f;
#pragma unroll
        for (int r = 0; r < 16; ++r) ps += p[r];
        { auto rr = __builtin_amdgcn_permlane32_swap(__float_as_uint(ps), __float_as_uint(ps), false, false); ps = __uint_as_float(rr[0]) + __uint_as_float(rr[1]); }
        l_reg = l_reg * alpha + ps;
        bf16x8 pa0, pa1;
#define WSA_PK4(B_, OUT) do { unsigned a0 = cvtpk(p[B_+0], p[B_+1]), a1 = cvtpk(p[B_+2], p[B_+3]), b0 = cvtpk(p[B_+4], p[B_+5]), b1 = cvtpk(p[B_+6], p[B_+7]); \
        auto r0 = __builtin_amdgcn_permlane32_swap(a0, b0, false, false); auto r1 = __builtin_amdgcn_permlane32_swap(a1, b1, false, false); \
        u32x4 w = {r0[0], r1[0], r0[1], r1[1]}; OUT = *reinterpret_cast<bf16x8*>(&w); } while (0)
        WSA_PK4(0, pa0); WSA_PK4(8, pa1);
#undef WSA_PK4
        if (__any(alpha < 1.f)) {
            if (hi == 0) al_l[r32] = alpha;
            asm volatile("s_waitcnt lgkmcnt(0)" ::: "memory");
#pragma unroll
            for (int d_ = 0; d_ < 4; ++d_)
#pragma unroll
                for (int r = 0; r < 16; ++r) o[d_][r] *= al_l[crow(r, hi)];
        }
        const unsigned vb0 = vbase + (unsigned)((blk & 1) * VBUF);
#define WSA_TR(dst, off) asm volatile("ds_read_b64_tr_b16 %0, %1 offset:%2" : "=&v"(dst) : "v"(vb0), "i"(off) : "memory")
#define WSA_PV(d0) do { s16x4 l0, l1, h0, h1; WSA_TR(l0, (d0) * 512); WSA_TR(h0, (d0) * 512 + 2048); WSA_TR(l1, (d0) * 512 + 4096); WSA_TR(h1, (d0) * 512 + 6144); \
        asm volatile("s_waitcnt lgkmcnt(0)" ::: "memory"); WSA_SBAR(); \
        o[d0] = __builtin_amdgcn_mfma_f32_32x32x16_bf16(pa0, (bf16x8){l0[0], l0[1], l0[2], l0[3], h0[0], h0[1], h0[2], h0[3]}, o[d0], 0, 0, 0); \
        o[d0] = __builtin_amdgcn_mfma_f32_32x32x16_bf16(pa1, (bf16x8){l1[0], l1[1], l1[2], l1[3], h1[0], h1[1], h1[2], h1[3]}, o[d0], 0, 0, 0); } while (0)
        WSA_PV(0); WSA_PV(1); WSA_PV(2); WSA_PV(3);
#undef WSA_PV
#undef WSA_TR
        if (more) {
            LAS unsigned char* nb = wl + ((blk + 1) & 1) * VBUF;
#pragma unroll
            for (int i = 0; i < 8; ++i) *(LAS bf16x8*)(nb + vst_off[i]) = vs[i];
        }
        asm volatile("s_waitcnt lgkmcnt(0)" ::: "memory");
    }
    if (hi == 0) li_l[r32] = l_reg;
    asm volatile("s_waitcnt lgkmcnt(0)" ::: "memory");
    float rli[16];
#pragma unroll
    for (int r = 0; r < 16; ++r) rli[r] = __builtin_amdgcn_rcpf(li_l[crow(r, hi)]);
    if (hi == 0) it.L[(size_t)r32 * it.lpitch] = m_reg * C2 + __builtin_amdgcn_logf(l_reg);
    const int OP = it.opitch;
#pragma unroll
    for (int r = 0; r < 16; ++r) { const int orow = crow(r, hi);
#pragma unroll
        for (int d0 = 0; d0 < 4; ++d0) { const float v = o[d0][r] * rli[r];
            const float vn = __builtin_bit_cast(float, __builtin_amdgcn_mov_dpp(__builtin_bit_cast(int, v), 0xB1, 0xF, 0xF, true));
            if ((r32 & 1) == 0) *(unsigned*)(it.O + (size_t)orow * OP + d0 * 32 + r32) = cvtpk(v, vn); } }
    asm volatile("s_waitcnt lgkmcnt(0)" ::: "memory");
}
#undef WSA_SBAR
__device__ __forceinline__ void phase(const Frame& F, unsigned char* ws) {
    const int lane = tid_from(F.wave) & 63;
    LAS unsigned char* wl = F.lds + F.wave * WAVE_LDS;
#pragma unroll 1
    for (int it = F.vcu * NWAVES + F.wave; it < N_ITEMS; it += F.G * NWAVES) { const Item x = decode(ws, it); wave_item(x, wl, lane); }
}
}

namespace s5 {
constexpr size_t T_WST = 2 * MiB;
constexpr size_t T_WO = 10 * MiB;
constexpr size_t T_KT = 18 * MiB;
constexpr size_t T_A16 = 20 * MiB;
constexpr int RSTR = 528;
constexpr int U_OFF = 0, L_OFF = 128 * RSTR;
constexpr int LDS_NEED = 2 * 128 * RSTR + 4096;
__device__ __forceinline__ void tables_wg(const Args& a, LAS unsigned char* lds, int lg, int wave_s) {
    typedef float f32x2 __attribute__((ext_vector_type(2)));
    LAS f32x2* PW = (LAS f32x2*)lds; LAS f32x2* BB = PW + 17 * 64; LAS f32x2* CT = BB + 64 * 16;
    const int tid = tid_from(wave_s); unsigned char* ws = a.p.ws;
    if (tid < 64) {
        const int idx = lg * 64 + tid;
        const float lre = fminf(inptr(a, IN_LRE)[idx], -1e-4f), lim = inptr(a, IN_LIM)[idx], dt = expf(inptr(a, IN_LDT)[lg]);
        const float ar = lre * dt, b = lim * dt, ea = expf(ar), sb = sinf(b), cb = cosf(b);
        const float Are = ea * cb, Aim = ea * sb, sh = sinf(0.5f * b);
        const float Dre = expm1f(ar) * cb - 2.0f * sh * sh, Dim = Aim;
        const float den = lre * lre + lim * lim;
        const float cre = (Dre * lre + Dim * lim) / den, cim = (Dim * lre - Dre * lim) / den;
        float* A = (float*)(ws + OFF_S5 + S5_A); float* Bb = (float*)(ws + OFF_S5 + S5_BB);
        A[idx * 2] = Are; A[idx * 2 + 1] = Aim;
        const float* bre = inptr(a, IN_BRE) + idx * 16; const float* bim = inptr(a, IN_BIM) + idx * 16;
        for (int c = 0; c < 16; ++c) { const float br = bre[c], bi = bim[c]; const f32x2 v = {cre * br - cim * bi, cre * bi + cim * br};
            Bb[(idx * 16 + c) * 2] = v.x; Bb[(idx * 16 + c) * 2 + 1] = v.y; BB[tid * 16 + c] = v; }
        float pr = 1.f, pi = 0.f; asm volatile("" : "+v"(pr), "+v"(pi));
        for (int k = 0; k <= 16; ++k) { PW[k * 64 + tid] = (f32x2){pr, pi}; const float nr = pr * Are - pi * Aim, ni = pr * Aim + pi * Are; pr = nr; pi = ni; }
        const f32x2 a16 = PW[16 * 64 + tid];
        ((f32x2*)(ws + OFF_S5 + T_A16))[idx] = a16;
    } else {
        const float* cr = inptr(a, IN_CRE) + (size_t)lg * 1024; const float* ci = inptr(a, IN_CIM) + (size_t)lg * 1024;
        for (int e = tid - 64; e < 1024; e += NTHREADS - 64) { const int c = e >> 6, pp = e & 63; CT[pp * 16 + c] = (f32x2){cr[e], ci[e]}; }
    }
    __syncthreads();
    bf16_t* WST = (bf16_t*)(ws + OFF_S5 + T_WST) + (size_t)lg * 128 * 256;
    for (int e = tid; e < 4096; e += NTHREADS) {
        const int i = e >> 5, kk0 = (e & 31) * 8, s = kk0 >> 4, c0 = kk0 & 15, pp = i & 63; const bool im = i >= 64;
        const f32x2 w = PW[(15 - s) * 64 + pp]; float v[8];
#pragma unroll
        for (int j = 0; j < 8; ++j) { const f32x2 bb = BB[pp * 16 + c0 + j]; v[j] = im ? (w.x * bb.y + w.y * bb.x) : (w.x * bb.x - w.y * bb.y); }
        u32x4 o; o.x = pk2(v[0], v[1]); o.y = pk2(v[2], v[3]); o.z = pk2(v[4], v[5]); o.w = pk2(v[6], v[7]);
        *(u32x4*)(WST + (size_t)((((i >> 4) * 8 + ((e & 31) >> 2)) * 64 + ((e & 31) & 3) * 16 + (i & 15)) * 8)) = o;
    }
    bf16_t* WO = (bf16_t*)(ws + OFF_S5 + T_WO) + (size_t)lg * 256 * 128;
    for (int e = tid; e < 4096; e += NTHREADS) {
        const int row = e >> 4, i0 = (e & 15) * 8, t = row >> 4, c = row & 15; float v[8];
#pragma unroll
        for (int j = 0; j < 8; ++j) { const int ip = i0 + j, pp = ip & 63; const f32x2 cc = CT[pp * 16 + c], w = PW[(t + 1) * 64 + pp];
            v[j] = ip < 64 ? (cc.x * w.x - cc.y * w.y) : -(cc.x * w.y + cc.y * w.x); }
        u32x4 o; o.x = pk2(v[0], v[1]); o.y = pk2(v[2], v[3]); o.z = pk2(v[4], v[5]); o.w = pk2(v[6], v[7]);
        *(u32x4*)(WO + (size_t)(((t * 4 + ((e & 15) >> 2)) * 64 + ((e & 15) & 3) * 16 + c) * 8)) = o;
    }
    bf16_t* KT = (bf16_t*)(ws + OFF_S5 + T_KT) + (size_t)lg * 17 * 256;
    { const int la = tid >> 5, c = (tid >> 1) & 15, h = tid & 1; float acc[8];
#pragma unroll
      for (int j = 0; j < 8; ++j) acc[j] = 0.f;
      for (int pp = 0; pp < 64; ++pp) { const f32x2 cc = CT[pp * 16 + c], w = PW[la * 64 + pp]; const float zr = cc.x * w.x - cc.y * w.y, zi = cc.x * w.y + cc.y * w.x;
#pragma unroll
          for (int j = 0; j < 8; ++j) { const f32x2 bb = BB[pp * 16 + 8 * h + j]; acc[j] += zr * bb.x - zi * bb.y; } }
      u32x4 o; o.x = pk2(acc[0], acc[1]); o.y = pk2(acc[2], acc[3]); o.z = pk2(acc[4], acc[5]); o.w = pk2(acc[6], acc[7]);
      *(u32x4*)(KT + ((la + 1) * 16 + c) * 16 + 8 * h) = o;
      if (tid < 32) { unsigned z_ = 0u; asm volatile("" : "+v"(z_)); *(u32x4*)(KT + tid * 8) = (u32x4){z_, z_, z_, z_}; } }
    __syncthreads();
}
__device__ __forceinline__ void unit(LAS unsigned char* lds, unsigned char* ws, int layer, int b, int g, int wave_s, const float* dsk_l) {
    const int tid = tid_from(wave_s), wave = wave_s, lane = tid & 63, q = lane >> 4, r16 = lane & 15;
    const int lg = layer * 32 + g;
    const bf16_t* usrc = (const bf16_t*)(ws + OFF_UG) + (size_t)(b * SSM_NG + g) * SEQ * 16;
    if (W_TOUCH2 == 1) {
        const int ln_ = tid_from(wave_s) & 63, cu_ = b * SSM_NG + g;
        const char* tp_ = nullptr;
        if (wave == 0) tp_ = (const char*)(ws + OFF_WOUT) + (size_t)layer * D_MODEL * D_MODEL * 2 + ((size_t)cu_ * 64 + ln_) * 128;
        else if (wave == 1) tp_ = (ln_ < 32 ? (const char*)(ws + OFF_WBS) + (size_t)layer * D_MODEL * SSM_W * 2 : (const char*)(ws + OFF_WBA) + (size_t)layer * D_MODEL * ATT_W * 2) + ((size_t)cu_ * 32 + (ln_ & 31)) * 128;
        else if (wave == 2) tp_ = (const char*)(ws + OFF_WGLU) + (size_t)layer * SSM_W * SSM_W * 2 + ((size_t)cu_ * 16 + (ln_ & 15)) * 128;
        if (wave < 3) __builtin_amdgcn_global_load_lds((const unsigned*)tp_, (LAS unsigned*)(lds + 143360 + wave * 256), 4, 0, 0);
    }
    __builtin_amdgcn_s_waitcnt(0);
    bf16x8 uv[8], af[8], kfA[8], wfA[4], kfB[8], wfB[4];
#pragma unroll
    for (int k = 0; k < 8; ++k) uv[k] = __builtin_nontemporal_load((const bf16x8*)(usrc + (size_t)(tid + NTHREADS * k) * 8));
    { const bf16_t* W = (const bf16_t*)(ws + OFF_S5 + T_WST) + (size_t)lg * 128 * 256 + (size_t)(wave * 8 * 64 + lane) * 8;
#pragma unroll
      for (int ks = 0; ks < 8; ++ks) af[ks] = __builtin_nontemporal_load((const bf16x8*)(W + ks * 512));
      const bf16_t* KT = (const bf16_t*)(ws + OFF_S5 + T_KT) + (size_t)lg * 17 * 256;
      const bf16_t* WO = (const bf16_t*)(ws + OFF_S5 + T_WO) + (size_t)lg * 256 * 128;
#pragma unroll
      for (int ks = 0; ks < 8; ++ks) { const int lagA = wave - (2 * ks + (q >> 1)) + 1, lagB = (15 - wave) - (2 * ks + (q >> 1)) + 1;
          kfA[ks] = *(const bf16x8*)(KT + ((lagA > 0 ? lagA : 0) * 16 + r16) * 16 + 8 * (q & 1)); kfB[ks] = *(const bf16x8*)(KT + ((lagB > 0 ? lagB : 0) * 16 + r16) * 16 + 8 * (q & 1)); }
#pragma unroll
      for (int k2 = 0; k2 < 4; ++k2) { wfA[k2] = __builtin_nontemporal_load((const bf16x8*)(WO + (size_t)((wave * 4 + k2) * 64 + lane) * 8)); wfB[k2] = __builtin_nontemporal_load((const bf16x8*)(WO + (size_t)(((15 - wave) * 4 + k2) * 64 + lane) * 8)); } }
#pragma unroll
    for (int k = 0; k < 8; ++k) { const int piece = tid + NTHREADS * k, tok = piece >> 1, half = piece & 1;
        *(LAS bf16x8*)(lds + U_OFF + (tok >> 4) * RSTR + (tok & 15) * 32 + half * 16) = uv[k]; }
    asm volatile("s_waitcnt lgkmcnt(0)" ::: "memory"); __builtin_amdgcn_s_barrier(); asm volatile("" ::: "memory");
    {
      for (int nt = 0; nt < 8; ++nt) {
          f32x4 acc = {0.f, 0.f, 0.f, 0.f};
          const LAS unsigned char* ub = lds + U_OFF + (nt * 16 + r16) * RSTR + q * 16;
#pragma unroll
          for (int ks = 0; ks < 8; ++ks) acc = __builtin_amdgcn_mfma_f32_16x16x32_bf16(af[ks], *(const LAS bf16x8*)(ub + ks * 64), acc, 0, 0, 0);
          *(LAS f32x4*)(lds + L_OFF + (nt * 16 + r16) * RSTR + (wave * 16 + 4 * q) * 4) = acc;
      } }
    asm volatile("s_waitcnt lgkmcnt(0)" ::: "memory"); __builtin_amdgcn_s_barrier(); asm volatile("" ::: "memory");
    {
        typedef float f32x2 __attribute__((ext_vector_type(2)));
        const f32x2 a16 = ((const f32x2*)(ws + OFF_S5 + T_A16))[lg * 64 + lane];
        LAS float* EW = (LAS float*)(lds + 2 * 128 * RSTR);
        float lre[16], lim[16], qre[16], qim[16];
#pragma unroll
        for (int jj = 0; jj < 16; ++jj) { const LAS float* row = (const LAS float*)(lds + L_OFF + (wave * 16 + jj) * RSTR); lre[jj] = row[lane]; lim[jj] = row[64 + lane]; }
        float sre = 0.f, sim = 0.f;
#pragma unroll
        for (int jj = 0; jj < 16; ++jj) { qre[jj] = sre; qim[jj] = sim;
            const float nre = a16.x * sre - a16.y * sim + lre[jj], nim = a16.x * sim + a16.y * sre + lim[jj]; sre = nre; sim = nim; }
        EW[wave * 128 + lane] = sre; EW[wave * 128 + 64 + lane] = sim;
        float pr = a16.x, pi = a16.y;
#pragma unroll
        for (int k = 0; k < 4; ++k) { const float nr = pr * pr - pi * pi, ni = 2.f * pr * pi; pr = nr; pi = ni; }
        __syncthreads();
        float ere[7], eim[7];
#pragma unroll
        for (int v = 0; v < 7; ++v) { ere[v] = EW[v * 128 + lane]; eim[v] = EW[v * 128 + 64 + lane]; }
        float gre = 0.f, gim = 0.f;
#pragma unroll
        for (int v = 0; v < 7; ++v) if (v < wave) { const float nre = pr * gre - pi * gim + ere[v], nim = pr * gim + pi * gre + eim[v]; gre = nre; gim = nim; }
#pragma unroll
        for (int jj = 0; jj < 16; ++jj) {
            LAS bf16_t* row = (LAS bf16_t*)(lds + L_OFF + (wave * 16 + jj) * RSTR);
            row[lane] = f2bf(qre[jj] + gre); row[64 + lane] = f2bf(qim[jj] + gim);
            const float nre = a16.x * gre - a16.y * gim, nim = a16.x * gim + a16.y * gre; gre = nre; gim = nim;
        }
    }
    __syncthreads();
    {
      bf16_t* ypre = (bf16_t*)(ws + OFF_YPRE) + (size_t)b * SEQ * SSM_W + g * 16 + 4 * q;
      const f32x4 dk = *(const f32x4*)(dsk_l + g * 16 + 4 * q);
#pragma unroll
      for (int tt = 0; tt < 2; ++tt) {
          const int t = tt ? 15 - wave : wave, nks = (t >> 1) + 1;
          bf16x8 kf[8], wf[4];
#pragma unroll
          for (int ks = 0; ks < 8; ++ks) kf[ks] = tt ? kfB[ks] : kfA[ks];
#pragma unroll
          for (int k2 = 0; k2 < 4; ++k2) wf[k2] = tt ? wfB[k2] : wfA[k2];
#pragma unroll 1
          for (int nt = 0; nt < 8; ++nt) {
              f32x4 acc = {0.f, 0.f, 0.f, 0.f}, accB = {0.f, 0.f, 0.f, 0.f}, accC = {0.f, 0.f, 0.f, 0.f};
              const LAS unsigned char* ub = lds + U_OFF + (nt * 16 + r16) * RSTR + q * 16;
              const LAS unsigned char* sb = lds + L_OFF + (nt * 16 + r16) * RSTR + q * 16;
#pragma unroll
              for (int ks = 0; ks < 8; ks += 2) { if (ks < nks) acc = __builtin_amdgcn_mfma_f32_16x16x32_bf16(kf[ks], *(const LAS bf16x8*)(ub + ks * 64), acc, 0, 0, 0);
                  if (ks + 1 < nks) accB = __builtin_amdgcn_mfma_f32_16x16x32_bf16(kf[ks + 1], *(const LAS bf16x8*)(ub + (ks + 1) * 64), accB, 0, 0, 0); }
#pragma unroll
              for (int k2 = 0; k2 < 4; ++k2) accC = __builtin_amdgcn_mfma_f32_16x16x32_bf16(wf[k2], *(const LAS bf16x8*)(sb + k2 * 64), accC, 0, 0, 0);
              acc = acc + accB + accC;
              const int tok = 16 * (nt * 16 + r16) + t;
              typedef unsigned u32x2_ __attribute__((ext_vector_type(2)));
              const u32x2_ uu = *(const LAS u32x2_*)(lds + U_OFF + (nt * 16 + r16) * RSTR + t * 32 + q * 8);
              const float y0 = gelu_fast(acc[0] + dk[0] * blo(uu.x)), y1 = gelu_fast(acc[1] + dk[1] * bhi(uu.x)), y2 = gelu_fast(acc[2] + dk[2] * blo(uu.y)), y3 = gelu_fast(acc[3] + dk[3] * bhi(uu.y));
              *(unsigned long long*)(ypre + (size_t)tok * SSM_W) = (unsigned long long)pk2(y0, y1) | ((unsigned long long)pk2(y2, y3) << 32);
          }
      } }
    __syncthreads();
}
}


namespace p4 {
constexpr int XT = 8192, WT = 65536, SLOT = XT + WT;
constexpr int RED_OFF = 2 * SLOT, RED2_OFF = RED_OFF + 2048;
constexpr int JUNK_OFF = RED2_OFF + 2048;
static_assert(JUNK_OFF + 2048 <= MISC_OFF, "P4 LDS map");
constexpr size_t OFF_MG = OFF_T4;
typedef unsigned u32x2 __attribute__((ext_vector_type(2)));
#define P4_WAIT_V(n) asm volatile("s_waitcnt vmcnt(" #n ")" ::: "memory")
#define P4_WAIT_L(n) asm volatile("s_waitcnt lgkmcnt(" #n ")" ::: "memory")
#define P4_BAR __builtin_amdgcn_s_barrier()

struct G64 { const bf16_t* X; const bf16_t* W; int lxs, lws; };
struct Geo { int rr, ch0, foff, wave; };
__device__ __forceinline__ Geo make_geo(int wave, int lane) {
    Geo g; g.rr = lane >> 3; g.ch0 = (lane & 7) ^ (g.rr >> 1); g.wave = wave;
    const int fr = lane & 15, fq = lane >> 4;
    g.foff = fr * 128 + ((fq ^ (fr >> 1)) & 7) * 16;
    return g;
}
__device__ __forceinline__ void stage64_piece(LAS unsigned char* lds, const Geo& g, const G64& d, int kt, int slot, int p) {
    const unsigned ldsw = (unsigned)g.wave * 1024u;
    if (p == 0) { const unsigned vo = ((unsigned)g.rr << d.lxs) + (unsigned)((g.ch0 ^ ((g.wave & 1) << 2)) * 16);
        __builtin_amdgcn_global_load_lds((const unsigned*)((const char*)d.X + (size_t)kt * 128 + ((size_t)(8 * g.wave) << d.lxs) + vo), (LAS unsigned*)(lds + slot * SLOT + ldsw), 16, 0, 0); }
    else { const int i = p - 1; const unsigned vo = ((unsigned)(16 * (g.rr >> 2) + (g.rr & 3)) << d.lws) + (unsigned)((g.ch0 ^ ((i & 1) << 2)) * 16);
        __builtin_amdgcn_global_load_lds((const unsigned*)((const char*)d.W + (size_t)kt * 128 + ((size_t)(64 * g.wave + 32 * (i & 1) + 4 * (i >> 1)) << d.lws) + vo), (LAS unsigned*)(lds + slot * SLOT + XT + ldsw * 8 + i * 1024), 16, 0, 0); }
}
__device__ __forceinline__ void stage64(LAS unsigned char* lds, const Geo& g, const G64& d, int kt, int slot, int parts) {
    if (parts & 1) stage64_piece(lds, g, d, kt, slot, 0);
    if (parts & 2) {
#pragma unroll
        for (int p = 1; p < 9; ++p) stage64_piece(lds, g, d, kt, slot, p);
    }
}
template <int NKT>
__device__ __forceinline__ void run64(f32x4 (&acc)[4][4], LAS unsigned char* lds, const Geo& g, const G64& cur, const G64& nxt, int nparts, int rot, int nrot) {
#define P4_READS(k) do { _Pragma("unroll") for (int m = 0; m < 4; ++m) xf[m] = *(const LAS bf16x8*)(sb + (g.foff ^ ((k) * 64)) + m * 2048); \
        _Pragma("unroll") for (int n = 0; n < 4; ++n) wf[n] = *(const LAS bf16x8*)(sb + XT + g.wave * 8192 + (g.foff ^ ((k) * 64)) + n * 2048); } while (0)
#define P4_MFMA(e) do { acc[((e) >> 2) & 3][(e) & 3] = __builtin_amdgcn_mfma_f32_16x16x32_bf16(wf[(e) & 3], xf[((e) >> 2) & 3], acc[((e) >> 2) & 3][(e) & 3], 0, 0, 0); } while (0)
#pragma unroll 1
    for (int kt = 0; kt + 1 < NKT; ++kt) {
        const int slot = kt & 1, ktn = (kt + 1 + rot) & (NKT - 1);
        P4_WAIT_V(0); P4_WAIT_L(0); P4_BAR;
        const LAS unsigned char* sb = lds + slot * SLOT; bf16x8 xf[4], wf[4];
        P4_READS(0);
#pragma unroll
        for (int i = 0; i < 5; ++i) { P4_MFMA(3 * i); P4_MFMA(3 * i + 1); P4_MFMA(3 * i + 2); stage64_piece(lds, g, cur, ktn, slot ^ 1, i); __builtin_amdgcn_sched_barrier(0); }
        P4_MFMA(15);
        __builtin_amdgcn_sched_barrier(0);
        P4_READS(1);
#pragma unroll
        for (int i = 0; i < 4; ++i) { P4_MFMA(4 * i); P4_MFMA(4 * i + 1); P4_MFMA(4 * i + 2); P4_MFMA(4 * i + 3); stage64_piece(lds, g, cur, ktn, slot ^ 1, 5 + i); __builtin_amdgcn_sched_barrier(0); }
    }
    {   const int kt = NKT - 1, slot = kt & 1;
        P4_WAIT_V(0); P4_WAIT_L(0); P4_BAR;
        if (nparts) stage64(lds, g, nxt, nrot, slot ^ 1, nparts);
        const LAS unsigned char* sb = lds + slot * SLOT; bf16x8 xf[4], wf[4];
#pragma unroll
        for (int k = 0; k < 2; ++k) { P4_READS(k);
#pragma unroll
            for (int e = 0; e < 16; ++e) P4_MFMA(e); }
    }
    P4_WAIT_L(0); P4_BAR;
#undef P4_READS
#undef P4_MFMA
}
__device__ __forceinline__ float sum_q(float v) {
    v += __builtin_bit_cast(float, __builtin_amdgcn_ds_swizzle(__builtin_bit_cast(int, v), 0x401F));
    const auto rr = __builtin_amdgcn_permlane32_swap(__float_as_uint(v), __float_as_uint(v), false, false);
    return __uint_as_float(rr[0]) + __uint_as_float(rr[1]);
}
#define P4_ZERO(A) do { _Pragma("unroll") for (int m_ = 0; m_ < 4; ++m_) _Pragma("unroll") for (int n_ = 0; n_ < 4; ++n_) A[m_][n_] = (f32x4){0.f, 0.f, 0.f, 0.f}; } while (0)

__device__ __forceinline__ void unit(const Args& a, LAS unsigned char* lds, unsigned char* ws, int layer, int u, unsigned long long& ts_sum, unsigned long long& ts_t0, int wave_s, bool dry = false) {
    const int tid = tid_from(wave_s), wave = wave_s, lane = tid & 63, q = lane >> 4, r16 = lane & 15;
    const size_t row0 = (size_t)u * 64;
    const bf16_t* gz = (const bf16_t*)(ws + OFF_GZ);
    const unsigned lo5 = (unsigned)(r16 * SSM_W + 16 * q), lo10 = (unsigned)(r16 * D_MODEL + 16 * q); static_assert(GZ_W == D_MODEL, "lop == lo10");
#define lop lo10
    const bf16_t* projr = gz + row0 * GZ_W;
    const unsigned char* g8r = (const unsigned char*)(ws + OFF_G8) + row0 * G8_W; const unsigned lo8 = (unsigned)(r16 * G8_W + 16 * q);
    bf16_t* Y1 = (bf16_t*)(ws + OFF_YPRE) + row0 * SSM_W;
    bf16_t* YA = (bf16_t*)(ws + OFF_AO) + row0 * ATT_W;
    bf16_t* YS = (bf16_t*)(ws + OFF_AO) + ((size_t)MTOK + row0) * ATT_W;
    bf16_t* MG = (bf16_t*)(ws + OFF_MG) + row0 * D_MODEL;
    if (W_TOUCH && layer + 1 < DEPTH && u < 256) {
        const char* wn_ = (const char*)(ws + OFF_WIN) + (size_t)(layer + 1) * IN_COLS * D_MODEL * 2 + ((size_t)u * 512 + (size_t)wave * 64 + (size_t)(tid_from(wave_s) & 63)) * 128;
        __builtin_amdgcn_global_load_lds((const unsigned*)wn_, (LAS unsigned*)(lds + JUNK_OFF + wave * 256), 4, 0, 0);
    }
    { const Geo geo0 = make_geo(wave, lane); const G64 dGLU0{Y1, (const bf16_t*)(ws + OFF_WGLU) + (size_t)layer * SSM_W * SSM_W, 10, 10}; stage64(lds, geo0, dGLU0, u & 7, 0, 3); }
    TS_BEGIN(41);
    {
        const int cc = (tid & 63) * 8, rb = tid >> 6, j = cc >> 7;
        const bf16_t* ao = (const bf16_t*)(ws + OFF_AO); const float* ls = (const float*)(ws + OFF_ALSE);
#pragma unroll 1
        for (int kb = 0; kb < 8; kb += 4) {
            u32x4 a0[4], a1[4], a2[4], za[4]; float l0[4], l1[4], l2[4];
#pragma unroll
            for (int i = 0; i < 4; ++i) { const int row = rb + 8 * (kb + i); const size_t tok = row0 + row;
                l0[i] = ls[((size_t)0 * MTOK + tok) * 4 + j]; l1[i] = ls[((size_t)1 * MTOK + tok) * 4 + j]; l2[i] = ls[((size_t)2 * MTOK + tok) * 4 + j];
                a0[i] = __builtin_nontemporal_load((const u32x4*)(ao + ((size_t)0 * MTOK + tok) * ATT_W + cc)); a1[i] = __builtin_nontemporal_load((const u32x4*)(ao + ((size_t)1 * MTOK + tok) * ATT_W + cc)); a2[i] = __builtin_nontemporal_load((const u32x4*)(ao + ((size_t)2 * MTOK + tok) * ATT_W + cc));
                za[i] = __builtin_nontemporal_load((const u32x4*)(gz + tok * GZ_W + GZ_ZA + cc)); }
#pragma unroll
            for (int i = 0; i < 4; ++i) { const int row = rb + 8 * (kb + i);
                const float mx = fmaxf(l0[i], fmaxf(l1[i], l2[i])); float w0 = __builtin_amdgcn_exp2f(l0[i] - mx), w1 = __builtin_amdgcn_exp2f(l1[i] - mx), w2 = __builtin_amdgcn_exp2f(l2[i] - mx);
                const float iw = __builtin_amdgcn_rcpf(w0 + w1 + w2); w0 *= iw; w1 *= iw; w2 *= iw;
#define MRG(A0, A1, A2, Z) pk2((w0 * blo(A0) + w1 * blo(A1) + w2 * blo(A2)) * blo(Z), (w0 * bhi(A0) + w1 * bhi(A1) + w2 * bhi(A2)) * bhi(Z))
                u32x4 y; y.x = MRG(a0[i].x, a1[i].x, a2[i].x, za[i].x); y.y = MRG(a0[i].y, a1[i].y, a2[i].y, za[i].y); y.z = MRG(a0[i].z, a1[i].z, a2[i].z, za[i].z); y.w = MRG(a0[i].w, a1[i].w, a2[i].w, za[i].w);
#undef MRG
                *(u32x4*)(YA + (size_t)row * ATT_W + cc) = y; }
        }
    }
    VM_WAIT(); __syncthreads();
    TS_END(41); TS_BEGIN(42);
    const int nbw = wave * 64;
    const int r8 = u & 7, r16t = u & 15;
    const Geo geo = make_geo(wave, lane);
    const G64 dGLU{Y1, (const bf16_t*)(ws + OFF_WGLU) + (size_t)layer * SSM_W * SSM_W, 10, 10};
    const bf16_t* WBSl = (const bf16_t*)(ws + OFF_WBS) + (size_t)layer * D_MODEL * SSM_W; const bf16_t* WBAl = (const bf16_t*)(ws + OFF_WBA) + (size_t)layer * D_MODEL * ATT_W;
    const bf16_t* WOl = (const bf16_t*)(ws + OFF_WOUT) + (size_t)layer * D_MODEL * D_MODEL;
    const G64 dOUT0{MG, WOl, 11, 11}, dOUT1{MG, WOl + (size_t)512 * D_MODEL, 11, 11};
    {
        f32x4 acc[4][4]; P4_ZERO(acc);
        const G64 dBS0{YS, WBSl, 10, 10};
        const float* bg = inptr(a, IN_BGLU) + layer * SSM_W;
        f32x4 b4[4];
#pragma unroll
        for (int n = 0; n < 4; ++n) b4[n] = *(const f32x4*)(bg + (nbw + n * 4) + (unsigned)(((tid_from(wave_s) >> 4) & 3) * 16));
        run64<8>(acc, lds, geo, dGLU, dBS0, 2, r8, r8);
        {   u32x4 y1[4][2], zs[4][2];
#pragma unroll
            for (int m = 0; m < 4; ++m)
#pragma unroll
                for (int h = 0; h < 2; ++h) { y1[m][h] = *(const u32x4*)(Y1 + (m * 16 * SSM_W + nbw + h * 8) + lo5); zs[m][h] = __builtin_nontemporal_load((const u32x4*)(projr + (GZ_ZS + m * 16 * GZ_W + nbw + h * 8) + lop)); }
#pragma unroll
            for (int m = 0; m < 4; ++m) { u32x4 o[2];
#pragma unroll
                for (int n = 0; n < 4; ++n) { const unsigned yx = y1[m][n >> 1][(n & 1) * 2], yy = y1[m][n >> 1][(n & 1) * 2 + 1], zx = zs[m][n >> 1][(n & 1) * 2], zy = zs[m][n >> 1][(n & 1) * 2 + 1];
                    o[n >> 1][(n & 1) * 2] = pk2(blo(yx) * sig_fast(acc[m][n][0] + b4[n][0]) * blo(zx), bhi(yx) * sig_fast(acc[m][n][1] + b4[n][1]) * bhi(zx));
                    o[n >> 1][(n & 1) * 2 + 1] = pk2(blo(yy) * sig_fast(acc[m][n][2] + b4[n][2]) * blo(zy), bhi(yy) * sig_fast(acc[m][n][3] + b4[n][3]) * bhi(zy)); }
#pragma unroll
                for (int h = 0; h < 2; ++h) *(u32x4*)(YS + (m * 16 * SSM_W + nbw + h * 8) + lo5) = o[h]; }
        }
        VM_WAIT(); __syncthreads();
        stage64(lds, geo, dBS0, r8, 0, 1);
    }
    TS_END(42); TS_BEGIN(43);
#pragma unroll 1
    for (int ps = 0; ps < 2; ++ps) {
        f32x4 as[4][4], aa[4][4]; P4_ZERO(as); P4_ZERO(aa);
        const G64 dBS{YS, WBSl + (size_t)ps * 512 * SSM_W, 10, 10}, dBA{YA, WBAl + (size_t)ps * 512 * ATT_W, 10, 10};
        const G64 dBSn{YS, WBSl + (size_t)512 * SSM_W, 10, 10};
        run64<8>(as, lds, geo, dBS, dBA, 3, r8, r8);
        if (ps == 0) run64<8>(aa, lds, geo, dBA, dBSn, 3, r8, r8);
        else run64<8>(aa, lds, geo, dBA, dOUT0, 2, r8, r16t);
        {   u32x4 gs[4], ga[4];
#pragma unroll
            for (int m = 0; m < 4; ++m) { const int bo = m * 16 * G8_W + ps * 512 + nbw; gs[m] = __builtin_nontemporal_load((const u32x4*)(g8r + (G8_GS + bo) + lo8)); ga[m] = __builtin_nontemporal_load((const u32x4*)(g8r + (G8_GA + bo) + lo8)); }
#define P4_UB(w, e) ((float)(((w) >> (8 * (e))) & 0xffu) * (1.0f / 255.0f))
#pragma unroll
            for (int m = 0; m < 4; ++m) { u32x4 o[2];
#pragma unroll
                for (int n = 0; n < 4; ++n) { const unsigned gsw = gs[m][n], gaw = ga[m][n];
                    o[n >> 1][(n & 1) * 2] = pk2(P4_UB(gsw, 0) * as[m][n][0] + P4_UB(gaw, 0) * aa[m][n][0], P4_UB(gsw, 1) * as[m][n][1] + P4_UB(gaw, 1) * aa[m][n][1]);
                    o[n >> 1][(n & 1) * 2 + 1] = pk2(P4_UB(gsw, 2) * as[m][n][2] + P4_UB(gaw, 2) * aa[m][n][2], P4_UB(gsw, 3) * as[m][n][3] + P4_UB(gaw, 3) * aa[m][n][3]); }
#pragma unroll
                for (int h = 0; h < 2; ++h) *(u32x4*)(MG + (m * 16 * D_MODEL + ps * 512 + nbw + h * 8) + lo10) = o[h]; }
#undef P4_UB
        }
    }
    VM_WAIT(); __syncthreads();
    stage64(lds, geo, dOUT0, r16t, 0, 1);
    TS_END(43); TS_BEGIN(44);
    {
        f32x4 acc0[4][4], acc1[4][4]; P4_ZERO(acc0); P4_ZERO(acc1);
        run64<16>(acc0, lds, geo, dOUT0, dOUT1, 3, r16t, r16t);
        run64<16>(acc1, lds, geo, dOUT1, dOUT1, 0, r16t, 0);
        TS_END(44); TS_BEGIN(45);
        LAS float* RED = (LAS float*)(lds + RED_OFF); LAS float* RED2 = (LAS float*)(lds + RED2_OFF);
        float inv[4];
#pragma unroll
        for (int m = 0; m < 4; ++m) { float s = 0.f;
#pragma unroll
            for (int n = 0; n < 4; ++n) { s += (acc0[m][n][0] * acc0[m][n][0] + acc0[m][n][1] * acc0[m][n][1]) + (acc0[m][n][2] * acc0[m][n][2] + acc0[m][n][3] * acc0[m][n][3]);
                                          s += (acc1[m][n][0] * acc1[m][n][0] + acc1[m][n][1] * acc1[m][n][1]) + (acc1[m][n][2] * acc1[m][n][2] + acc1[m][n][3] * acc1[m][n][3]); }
            s = sum_q(s); if (q == 0) RED[(m * 16 + r16) * 8 + wave] = s; }
        __syncthreads();
#pragma unroll
        for (int m = 0; m < 4; ++m) { const LAS f32x4* rp = (const LAS f32x4*)(RED + (m * 16 + r16) * 8); const f32x4 r0 = rp[0], r1 = rp[1];
            inv[m] = rsqrtf(((r0[0] + r0[1]) + (r0[2] + r0[3]) + (r1[0] + r1[1]) + (r1[2] + r1[3])) * (1.0f / D_MODEL) + RMS_EPS); }
        const float* pg = inptr(a, IN_POSTG) + layer * D_MODEL; float* xor_ = a.p.out + row0 * D_MODEL; bf16_t* xbr = (bf16_t*)(ws + OFF_XB) + row0 * D_MODEL;
        float s2[4] = {0.f, 0.f, 0.f, 0.f};
        const unsigned lq4 = (unsigned)(((tid_from(wave_s) >> 4) & 3) * 16);
#define P4_RES(ACC, PS) do { f32x4 g4[4]; u32x4 xp[4][2]; \
            _Pragma("unroll") for (int n = 0; n < 4; ++n) g4[n] = *(const f32x4*)(pg + ((PS) * 512 + nbw + n * 4) + lq4); \
            _Pragma("unroll") for (int m = 0; m < 4; ++m) _Pragma("unroll") for (int h = 0; h < 2; ++h) xp[m][h] = *(const u32x4*)(xbr + (m * 16 * D_MODEL + (PS) * 512 + nbw + h * 8) + lo10); \
            __builtin_amdgcn_s_waitcnt(0);     \
            _Pragma("unroll") for (int m = 0; m < 4; ++m) { u32x4 o[2]; \
                _Pragma("unroll") for (int n = 0; n < 4; ++n) { const int bo = m * 16 * D_MODEL + (PS) * 512 + nbw + n * 4; const unsigned px = xp[m][n >> 1][(n & 1) * 2], py = xp[m][n >> 1][(n & 1) * 2 + 1]; \
                    f32x4 xv = {blo(px), bhi(px), blo(py), bhi(py)}; xv = xv + ACC[m][n] * inv[m] * g4[n]; \
                    o[n >> 1][(n & 1) * 2] = pk2(xv[0], xv[1]); o[n >> 1][(n & 1) * 2 + 1] = pk2(xv[2], xv[3]); \
                    if (!dry && layer == DEPTH - 1) *(f32x4*)(xor_ + bo + lo10) = xv; \
                    s2[m] += (xv[0] * xv[0] + xv[1] * xv[1]) + (xv[2] * xv[2] + xv[3] * xv[3]); } \
                if (!dry) { if (layer != DEPTH - 1) { _Pragma("unroll") for (int h = 0; h < 2; ++h) *(u32x4*)(xbr + (m * 16 * D_MODEL + (PS) * 512 + nbw + h * 8) + lo10) = o[h]; } } \
                else { asm volatile("" :: "v"(o[0].x), "v"(o[0].y), "v"(o[1].x), "v"(o[1].y)); } } } while (0)
        P4_RES(acc0, 0); P4_RES(acc1, 1);
#undef P4_RES
#pragma unroll
        for (int m = 0; m < 4; ++m) { const float s = sum_q(s2[m]); if (q == 0) RED2[(m * 16 + r16) * 8 + wave] = s; }
        __syncthreads();
        if (wave == 0 && !dry) { const int tl = tid_from(wave_s) & 63;
            const LAS f32x4* rp = (const LAS f32x4*)(RED2 + tl * 8); const f32x4 r0 = rp[0], r1 = rp[1];
            ((float*)(ws + OFF_ROWSS))[row0 + tl] = (r0[0] + r0[1]) + (r0[2] + r0[3]) + (r1[0] + r1[1]) + (r1[2] + r1[3]); }
    }
    VM_WAIT(); __syncthreads();
    TS_END(45);
}
#undef P4_ZERO
#undef lop
}

__device__ __forceinline__ void p0_transpose_item(const float* W, const float* rs, int K, int N, bf16_t* WT, LAS float* scr, int item, int lane, bool vperm, bool ntst) {
    const int nblk = N / 32, kb = item / nblk, nb = item % nblk, k0 = 64 * kb, n0 = 32 * nb;
    const int kr = lane >> 3, n4 = (lane & 7) * 4;
    f32x4 v[8];
#pragma unroll
    for (int i = 0; i < 8; ++i) v[i] = __builtin_nontemporal_load((const f32x4*)(W + (size_t)(k0 + 8 * i + kr) * N + n0 + n4));
    if (rs) {
#pragma unroll
        for (int i = 0; i < 8; ++i) v[i] = v[i] * rs[k0 + 8 * i + kr];
    }
#pragma unroll
    for (int i = 0; i < 8; ++i) { LAS float* d = scr + (8 * i + kr) * 33 + n4; d[0] = v[i][0]; d[1] = v[i][1]; d[2] = v[i][2]; d[3] = v[i][3]; }
    LDS_WAIT(); asm volatile("" ::: "memory");
    const int c = lane & 7;
#pragma unroll
    for (int j = 0; j < 4; ++j) { const int n = (lane >> 3) + 8 * j; const LAS float* s = scr + (8 * c) * 33 + n;
        u32x4 o; o.x = pk2(s[0 * 33], s[1 * 33]); o.y = pk2(s[2 * 33], s[3 * 33]); o.z = pk2(s[4 * 33], s[5 * 33]); o.w = pk2(s[6 * 33], s[7 * 33]);
        int nd = n0 + n;
        if (vperm && nd >= C_V && nd < C_ZA) { const int cc = nd & 127; nd = (nd & ~127) + (cc & 3) * 32 + (cc >> 2); }
        if (ntst) __builtin_nontemporal_store(o, (u32x4*)(WT + (size_t)nd * K + k0 + 8 * c)); else *(u32x4*)(WT + (size_t)nd * K + k0 + 8 * c) = o; }
    LDS_WAIT(); asm volatile("" ::: "memory");
}
__device__ __forceinline__ void p0_prologue(const Frame& F, const Args& a) {
    const int lane_ = tid_from(F.wave) & 63;
    LAS float* scr = (LAS float*)(F.lds + F.wave * 16384);
    const int gw = F.vcu * NWAVES + F.wave, NGW = F.G * NWAVES;
    constexpr int I_IN = (D_MODEL / 64) * (IN_COLS / 32), I_GLU = (SSM_W / 64) * (SSM_W / 32), I_BS = (SSM_W / 64) * (D_MODEL / 32), I_OUT = (D_MODEL / 64) * (D_MODEL / 32);
    constexpr int PER_L = I_IN + I_GLU + 2 * I_BS + I_OUT, NITEMS = DEPTH * PER_L;
    unsigned char* ws = a.p.ws;
    for (int lg = F.vcu; lg < DEPTH * SSM_NG; lg += F.G) s5::tables_wg(a, F.lds, lg, F.wave);
    constexpr int NTAB = DEPTH * SSM_NG, RA = 7;
    const bool bal = F.G > NTAB && RA * NGW < NITEMS;
    const int NA = bal ? RA * NGW : NITEMS, gw2 = gw - NTAB * NWAVES, NGW2 = (F.G - NTAB) * NWAVES;
    for (int k = 0; ; ++k) {
        const int it = (!bal || k < RA) ? gw + k * NGW : (gw2 >= 0 ? NA + gw2 + (k - RA) * NGW2 : NITEMS);
        if (it >= NITEMS || (bal && k < RA && it >= NA)) break;
        const int l = it / PER_L; int r = it - l * PER_L;
        int widx, K, N; size_t dst;
        if (r < I_IN) { widx = IN_WIN; K = D_MODEL; N = IN_COLS; dst = OFF_WIN; }
        else if ((r -= I_IN) < I_GLU) { widx = IN_WGLU; K = SSM_W; N = SSM_W; dst = OFF_WGLU; }
        else if ((r -= I_GLU) < I_BS) { widx = IN_WBS; K = SSM_W; N = D_MODEL; dst = OFF_WBS; }
        else if ((r -= I_BS) < I_BS) { widx = IN_WBA; K = ATT_W; N = D_MODEL; dst = OFF_WBA; }
        else { r -= I_BS; widx = IN_WOUT; K = D_MODEL; N = D_MODEL; dst = OFF_WOUT; }
        const float* W = inptr(a, widx) + (size_t)l * K * N;
        const float* rs = (widx == IN_WIN) ? inptr(a, IN_PREG) + l * D_MODEL : nullptr;
        p0_transpose_item(W, rs, K, N, (bf16_t*)(ws + dst) + (size_t)l * K * N, scr, r, lane_, ATTN_DMA == 3 && widx == IN_WIN, l > 0);
    }
    const float* X = inptr(a, IN_X);
    for (int m = gw; m < MTOK; m += 2 * NGW) {
        const int m1 = m + NGW; const bool has1 = m1 < MTOK;
        const f32x4* xr0 = (const f32x4*)(X + (size_t)m * D_MODEL) + lane_; const f32x4* xr1 = (const f32x4*)(X + (size_t)(has1 ? m1 : m) * D_MODEL) + lane_;
        f32x4 v0[4], v1[4];
#pragma unroll
        for (int j = 0; j < 4; ++j) { v0[j] = __builtin_nontemporal_load(xr0 + 64 * j); v1[j] = __builtin_nontemporal_load(xr1 + 64 * j); }
#pragma unroll
        for (int r = 0; r < 2; ++r) {
            if (r == 1 && !has1) break;
            const int mm = r ? m1 : m;
            unsigned long long* o8 = (unsigned long long*)((bf16_t*)(ws + OFF_XB) + (size_t)mm * D_MODEL) + lane_;
            float sq = 0.f;
#pragma unroll
            for (int j = 0; j < 4; ++j) { const f32x4 v = r ? v1[j] : v0[j]; sq += (v[0] * v[0] + v[1] * v[1]) + (v[2] * v[2] + v[3] * v[3]);
                o8[64 * j] = (unsigned long long)pk2(v[0], v[1]) | ((unsigned long long)pk2(v[2], v[3]) << 32); }
            sq = wave_sum(sq);
            if (lane_ == 0) ((float*)(ws + OFF_ROWSS))[mm] = sq;
        }
    }
}

constexpr int N_PHASES = 1 + 3 * DEPTH;
__global__ void __launch_bounds__(NTHREADS, 2) mega(Args a) {
    extern __shared__ __attribute__((aligned(16))) unsigned char lds_raw[];
    Frame F; F.lds = (LAS unsigned char*)lds_raw; F.wave = __builtin_amdgcn_readfirstlane((int)threadIdx.x >> 6);
    F.G = gridDim.x; { const int bx = blockIdx.x; F.vcu = (F.G % 8 == 0) ? (bx % 8) * (F.G / 8) + bx / 8 : bx; }
    volatile LAS unsigned* MISC = (volatile LAS unsigned*)(F.lds + MISC_OFF);
    { const int t0_ = tid_from(F.wave); if (t0_ < 64) MISC[t0_] = 0u; }
    __syncthreads();
    const bool grouped = (F.G % 8 == 0) && (a.ph_lo == 0) && (a.ph_hi == N_PHASES);
    unsigned* bw = (unsigned*)(a.p.ws + OFF_CTL) + CW_BAR + a.bar_region * XCD_BAR_WORDS;
    XcdBarrier gbar = xcd_barrier_post(bw, MISC + 8, F.wave, (unsigned)F.G);
    XcdBarrier lbar = gbar;
    if (grouped) lbar = xcd_barrier_post(bw + (1 + (blockIdx.x & 7)) * XCD_BAR_WORDS, MISC + 10, F.wave, (unsigned)F.G / 8u);
    unsigned long long ts_sum = 0, ts_t0 = 0;
    TS_BEGIN(100);
    for (int ph = a.ph_lo; ph < a.ph_hi; ++ph) {
        TS_BEGIN(9); if (ph > 0 && (ph - 1) % 3 == 0) TS_BEGIN(93); if (ph > 0 && (ph - 1) % 3 == 1) TS_BEGIN(91); if (ph > 0 && (ph - 1) % 3 == 2) TS_BEGIN(92);
        if (ph > a.ph_lo) {
            if (ph == 1 || !grouped) xcd_barrier(gbar);
            else if (BAR_TOUCH && F.vcu < 256) {
                const int l_ = (ph - 1) / 3, k_ = (ph - 1) % 3; size_t wq_ = 0; asm volatile("" : "+s"(wq_)); const char* wsb = (const char*)a.p.ws + wq_;
                BarTouch bt; for (int r = 0; r < 6; ++r) { bt.p[r] = wsb; bt.n[r] = 0; bt.sh[r] = 30; bt.pitch[r] = 0; }
                if (k_ == 1 && BAR_TOUCH_S5) {
                    const size_t lg_ = (size_t)l_ * 32 + (F.vcu & 31);
                    bt.p[0] = wsb + OFF_S5 + s5::T_WST + lg_ * 128 * 256 * 2; bt.n[0] = 512; bt.p[1] = wsb + OFF_S5 + s5::T_WO + lg_ * 256 * 128 * 2; bt.n[1] = 512;
                    bt.p[2] = wsb + OFF_S5 + s5::T_KT + lg_ * 17 * 256 * 2; bt.n[2] = 68;
                } else if (k_ == 0 && P1_SHAPE) {
                    const int grp_ = (0 + (int)(blockIdx.x & 7)) & 3;
                    bt.p[0] = wsb + OFF_WIN + ((size_t)l_ * IN_COLS + (size_t)grp_ * 2048 + (size_t)(F.vcu & 31) * 64) * D_MODEL * 2; bt.n[0] = 128; bt.sh[0] = 1; bt.pitch[0] = D_MODEL * 2;
                } else if (k_ == 2) {
                    bt.p[0] = wsb + OFF_WOUT + (size_t)l_ * D_MODEL * D_MODEL * 2 + (size_t)F.vcu * 64 * 128; bt.n[0] = 64;
                    bt.p[1] = wsb + OFF_WBS + (size_t)l_ * D_MODEL * SSM_W * 2 + (size_t)F.vcu * 32 * 128; bt.n[1] = 32;
                    bt.p[2] = wsb + OFF_WBA + (size_t)l_ * D_MODEL * ATT_W * 2 + (size_t)F.vcu * 32 * 128; bt.n[2] = 32;
                    bt.p[3] = wsb + OFF_WGLU + (size_t)l_ * SSM_W * SSM_W * 2 + (size_t)F.vcu * 16 * 128; bt.n[3] = 16;
                    if (l_ + 1 < DEPTH) { bt.p[4] = wsb + OFF_WIN + (size_t)(l_ + 1) * IN_COLS * D_MODEL * 2 + (size_t)F.vcu * 512 * 128; bt.n[4] = 512; }
                }
                xcd_barrier(lbar, &bt, F.lds);
            }
            else xcd_barrier(lbar);
        }
        if (GRP_DELAY_NS != 0 && grouped && ph == 1) {
            const unsigned long long ticks_ = (unsigned long long)((blockIdx.x & 7) % GRP_DELAY_MOD) * (GRP_DELAY_NS / 10), t0_ = __builtin_amdgcn_s_memrealtime();
            while (__builtin_amdgcn_s_memrealtime() - t0_ < ticks_) __builtin_amdgcn_s_sleep(8);
        }
        TS_END(9); if (ph > 0 && (ph - 1) % 3 == 0) TS_END(93); if (ph > 0 && (ph - 1) % 3 == 1) TS_END(91); if (ph > 0 && (ph - 1) % 3 == 2) TS_END(92);
#if PROBE_DUP == 6
        if (ph > a.ph_lo) { if (ph == 1 || !grouped) xcd_barrier(gbar); else xcd_barrier(lbar); }
#endif
        size_t wz_ = 0; asm volatile("" : "+s"(wz_)); unsigned char* ws = a.p.ws + wz_;
        int vcu_ = F.vcu; asm volatile("" : "+s"(vcu_));
        Frame Fp; Fp.lds = F.lds; Fp.wave = F.wave; Fp.G = F.G; Fp.vcu = vcu_;
#if PROBE_DUP == 5
        if (ph == 0) {
#pragma unroll 1
            for (int rep = 0; rep < 2; ++rep) { p0_prologue(Fp, a); __syncthreads(); }
            continue; }
#endif
        if (ph == 0) { TS_BEGIN(10); p0_prologue(Fp, a); TS_END(10); continue; }
        const int l = (ph - 1) / 3, k = (ph - 1) % 3;
        if (k == 0) {
            TS_BEGIN(1); if (l == 0) TS_BEGIN(18); if (l == 3) TS_BEGIN(19);
            pg8::Gemm g{(const bf16_t*)(ws + OFF_XB), (const bf16_t*)(ws + OFF_WIN) + (size_t)l * IN_COLS * D_MODEL, MTOK, IN_COLS, D_MODEL};
            int bid_ = blockIdx.x; asm volatile("" : "+s"(bid_));
            pg8::StaticOrder S; S.init(MTOK, IN_COLS, Fp.G, bid_);
            pg8::EpiInProj E{ws, (const float*)(ws + OFF_ROWSS)};
#if PROBE_DUP == 1
#pragma unroll 1
            for (int rep = 0; rep < 2; ++rep)
#endif
            pg8::gemm_phase<pg8::EpiInProj, pg8::StaticOrder, true, true>(Fp.lds, g, S, E, Fp.wave, ts_sum, ts_t0);
            TS_END(1); if (l == 0) TS_END(18); if (l == 3) TS_END(19);
        }
#if EXP_HALF
        else if (EXP_HALF == 1 && (blockIdx.x & 7) >= 4) { }
#endif
        else if (k == 1) {
            TS_BEGIN(2);
#if PROBE_DUP == 2
#pragma unroll 1
            for (int rep = 0; rep < 2; ++rep)
#endif
            for (int u = Fp.vcu; u < BATCH * SSM_NG; u += Fp.G) s5::unit(Fp.lds, ws, l, u >> 5, u & 31, Fp.wave, inptr(a, IN_DSKIP) + l * SSM_W);
            TS_END(2); TS_BEGIN(3);
#if PROBE_DUP == 3
#pragma unroll 1
            for (int rep = 0; rep < 2; ++rep)
#endif
#if ATTN_WAVE
            wsa::phase(Fp, ws);
            __syncthreads();
#else
            attn_phase(Fp, ws, l, ts_sum, ts_t0);
#endif
            TS_END(3);
        }
        else {
            TS_BEGIN(4);
#if PROBE_DUP == 4
#pragma unroll 1
            for (int rep = 0; rep < 2; ++rep)
            for (int u = Fp.vcu; u < MTOK / 64; u += Fp.G) p4::unit(a, Fp.lds, ws, l, u, ts_sum, ts_t0, Fp.wave, rep == 0);
#else
#if EXP_HALF == 2
            if (!(Fp.vcu & 1)) for (int u = Fp.vcu; u < MTOK / 64; u += Fp.G) { for (int e = 0; e < 2; ++e) p4::unit(a, Fp.lds, ws, l, u + e, ts_sum, ts_t0, Fp.wave); }
#else
            for (int u = Fp.vcu; u < MTOK / 64; u += Fp.G) p4::unit(a, Fp.lds, ws, l, u, ts_sum, ts_t0, Fp.wave);
#endif
#endif
            TS_END(4);
        }
    }
    TS_END(100);
    if (TS_ID != 0 && blockIdx.x == 0 && tid_from(F.wave) == 0) { asm volatile("s_waitcnt vmcnt(0)" ::: "memory"); a.p.out[0] += (float)ts_sum * 0.001f; }
}

#ifndef ONE_LAUNCH
#define ONE_LAUNCH 1
#endif
#ifndef OPT_P0
#define OPT_P0 1
#endif
#ifndef OPT_P1
#define OPT_P1 1
#endif
#ifndef OPT_P2
#define OPT_P2 1
#endif
#ifndef OPT_P4
#define OPT_P4 1
#endif
extern "C" void kernel_launch(void* const* d_in, const int* in_sizes, int n_in, void* d_out, int out_size, void* d_ws, size_t ws_size, hipStream_t stream) {
    static int grid = 0;
    if (grid == 0) {
        if (n_in != 17 || out_size != MTOK * D_MODEL || ws_size < WS_END) { fprintf(stderr, "kernel_launch: unexpected shapes/workspace (n_in %d out %d ws %zu)\n", n_in, out_size, ws_size); grid = -1; return; }
        int dev = 0, cus = 0, per_cu = 0;
        if (hipGetDevice(&dev) != hipSuccess || hipDeviceGetAttribute(&cus, hipDeviceAttributeMultiprocessorCount, dev) != hipSuccess) { grid = -1; return; }
        if (hipFuncSetAttribute((const void*)mega, hipFuncAttributeMaxDynamicSharedMemorySize, LDS_BYTES) != hipSuccess) { fprintf(stderr, "kernel_launch: hipFuncSetAttribute failed\n"); grid = -1; return; }
        if (hipOccupancyMaxActiveBlocksPerMultiprocessor(&per_cu, (const void*)mega, NTHREADS, LDS_BYTES) != hipSuccess || per_cu < 1) { fprintf(stderr, "kernel_launch: occupancy query says %d blocks/CU\n", per_cu); per_cu = 1; }
        (void)hipGetLastError();
        grid = cus * (per_cu < 1 ? 1 : 1);
    }
    if (grid < 0) return;
    Params p{};
    for (int i = 0; i < N_IN; ++i) p.in[i] = (const float*)d_in[i];
    p.out = (float*)d_out; p.ws = (unsigned char*)d_ws;
    unsigned char* ws = p.ws;
#if ONE_LAUNCH
    (void)hipMemsetAsync(ws + OFF_CTL + (size_t)CW_BAR * 4, 0, (size_t)9 * XCD_BAR_WORDS * 4, stream);
#else
    (void)hipMemsetAsync(ws + OFF_CTL, 0, CTL_ZERO_BYTES, stream);
#endif
#if EXP_MEMSET2
    (void)hipMemsetAsync(ws + OFF_T2, 0, CTL_ZERO_BYTES, stream);
#endif
    int bar_region = 0;
    auto launch_mega = [&](int lo, int hi) { Args a{}; a.p = p; a.ph_lo = lo; a.ph_hi = hi; a.bar_region = bar_region++; a.pad = 0;
        hipLaunchKernelGGL(mega, dim3(grid), dim3(NTHREADS), LDS_BYTES, stream, a); };
    bf16_t* WIN = (bf16_t*)(ws + OFF_WIN); bf16_t* WGLU = (bf16_t*)(ws + OFF_WGLU); bf16_t* WBS = (bf16_t*)(ws + OFF_WBS); bf16_t* WBA = (bf16_t*)(ws + OFF_WBA); bf16_t* WOUT = (bf16_t*)(ws + OFF_WOUT);
    bf16_t* XB = (bf16_t*)(ws + OFF_XB); bf16_t* PROJ = (bf16_t*)(ws + OFF_PROJ); bf16_t* YPRE = (bf16_t*)(ws + OFF_YPRE); bf16_t* AO = (bf16_t*)(ws + OFF_AO);
    bf16_t* T2 = (bf16_t*)(ws + OFF_T2); bf16_t* T4 = (bf16_t*)(ws + OFF_T4); bf16_t* T5 = AO + (size_t)MTOK * ATT_W; float* OUTF = (float*)(ws + OFF_PROJ);
    const float* ROWSS = (const float*)(ws + OFF_ROWSS);
#if ONE_LAUNCH
    launch_mega(0, N_PHASES);
    return;
#endif
#if OPT_P0
    launch_mega(0, 1);
#else
    const dim3 tb(32, 8);
    for (int l = 0; l < DEPTH; ++l) {
        nv::k_transpose<<<dim3(IN_COLS / 32, D_MODEL / 32), tb, 0, stream>>>(p.in[IN_WIN] + (size_t)l * D_MODEL * IN_COLS, p.in[IN_PREG] + l * D_MODEL, WIN + (size_t)l * IN_COLS * D_MODEL, D_MODEL, IN_COLS);
        nv::k_transpose<<<dim3(SSM_W / 32, SSM_W / 32), tb, 0, stream>>>(p.in[IN_WGLU] + (size_t)l * SSM_W * SSM_W, nullptr, WGLU + (size_t)l * SSM_W * SSM_W, SSM_W, SSM_W);
        nv::k_transpose<<<dim3(D_MODEL / 32, SSM_W / 32), tb, 0, stream>>>(p.in[IN_WBS] + (size_t)l * SSM_W * D_MODEL, nullptr, WBS + (size_t)l * D_MODEL * SSM_W, SSM_W, D_MODEL);
        nv::k_transpose<<<dim3(D_MODEL / 32, ATT_W / 32), tb, 0, stream>>>(p.in[IN_WBA] + (size_t)l * ATT_W * D_MODEL, nullptr, WBA + (size_t)l * D_MODEL * ATT_W, ATT_W, D_MODEL);
        nv::k_transpose<<<dim3(D_MODEL / 32, D_MODEL / 32), tb, 0, stream>>>(p.in[IN_WOUT] + (size_t)l * D_MODEL * D_MODEL, nullptr, WOUT + (size_t)l * D_MODEL * D_MODEL, D_MODEL, D_MODEL);
    }
    nv::k_s5_tables<<<DEPTH * SSM_NG, 64, 0, stream>>>(p);
    nv::k_rows_x<<<MTOK, 256, 0, stream>>>(p);
#endif
    for (int l = 0; l < DEPTH; ++l) {
#if OPT_P1
        launch_mega(1 + 3 * l, 2 + 3 * l);
#else
        nv::k_gemm<nv::EpiInProj><<<dim3(IN_COLS / 128, MTOK / 128), 256, 0, stream>>>(XB, D_MODEL, WIN + (size_t)l * IN_COLS * D_MODEL, D_MODEL, D_MODEL, nv::EpiInProj{ROWSS, PROJ});
#endif
#if OPT_P2
        launch_mega(2 + 3 * l, 3 + 3 * l);
#else
        nv::k_attn<<<MTOK * 12 / 4, 256, 0, stream>>>(p);
        nv::k_s5<<<BATCH * SSM_NG, 64, 0, stream>>>(p, l);
#endif
#if OPT_P4
        launch_mega(3 + 3 * l, 4 + 3 * l);
#else
        nv::k_p4a<<<MTOK * SSM_W / 256, 256, 0, stream>>>(p, l);
        nv::k_gemm<nv::EpiGlu><<<dim3(SSM_W / 128, MTOK / 128), 256, 0, stream>>>(YPRE, SSM_W, WGLU + (size_t)l * SSM_W * SSM_W, SSM_W, SSM_W, nv::EpiGlu{YPRE, PROJ, p.in[IN_BGLU] + l * SSM_W, T2});
        nv::k_merge<<<MTOK * ATT_W / 256, 256, 0, stream>>>(p);
        nv::k_gemm<nv::EpiGate1><<<dim3(D_MODEL / 128, MTOK / 128), 256, 0, stream>>>(T2, SSM_W, WBS + (size_t)l * D_MODEL * SSM_W, SSM_W, SSM_W, nv::EpiGate1{PROJ, T4});
        nv::k_gemm<nv::EpiGate2><<<dim3(D_MODEL / 128, MTOK / 128), 256, 0, stream>>>(AO, ATT_W, WBA + (size_t)l * D_MODEL * ATT_W, ATT_W, ATT_W, nv::EpiGate2{PROJ, T4, T5});
        nv::k_gemm<nv::EpiF32><<<dim3(D_MODEL / 128, MTOK / 128), 256, 0, stream>>>(T5, D_MODEL, WOUT + (size_t)l * D_MODEL * D_MODEL, D_MODEL, D_MODEL, nv::EpiF32{OUTF, D_MODEL});
        nv::k_postnorm<<<MTOK, 256, 0, stream>>>(p, l, OUTF);
#endif
    }
}
```
